# Optimizing an MI355X kernel written in HIP

```python
import jax
import jax.numpy as jnp
from jax import lax
import numpy as np

D_MODEL = 1024
BATCH = 8
SEQ = 2048
DEPTH = 2

N_MEM = 256
EXPAND = 2
D_INNER = EXPAND * D_MODEL
D_XATTN = D_INNER // 4
XATTN_HEADS = 4
XATTN_HEAD_DIM = D_XATTN // XATTN_HEADS
D_MIX = D_INNER - D_XATTN

MLSTM_HEADS = 4
MLSTM_HEAD_DIM = D_MIX // MLSTM_HEADS
MLSTM_CONV = 4
QKV_BLOCK = 4
N_QKV_BLOCKS = D_MIX // QKV_BLOCK
MLSTM_CHUNK = 64
ML_IN_W = D_MIX + D_XATTN + D_INNER

RWKV_HEAD_DIM = 64
RWKV_HEADS = D_MIX // RWKV_HEAD_DIM
DECAY_RANK = 64
ICLR_RANK = 64
VRES_RANK = 32
GATE_RANK = 128
RW_SHIFT_W = 3 * D_MIX + DECAY_RANK + ICLR_RANK + VRES_RANK + GATE_RANK
RW_IN_W = RW_SHIFT_W + D_XATTN + D_INNER

N_MLSTM = (DEPTH + 1) // 2
N_RWKV = DEPTH // 2

RMS_EPS = 1e-6
MHLN_EPS = 1e-5
RWKV_GN_EPS = 64e-5
L2_EPS = 1e-12

kernel_name = 'hybrid_mlstm_rwkv7_memxattn'


def rms_norm(x, g):
    xf = x.astype(jnp.float32)
    y = xf * lax.rsqrt(jnp.mean(xf * xf, axis=-1, keepdims=True) + RMS_EPS)
    return (y * g.astype(jnp.float32)).astype(x.dtype)


def head_norm(x, n_heads, eps):
    xf = x.astype(jnp.float32).reshape(x.shape[:-1] + (n_heads, -1))
    mu = jnp.mean(xf, axis=-1, keepdims=True)
    var = jnp.mean(jnp.square(xf - mu), axis=-1, keepdims=True)
    return ((xf - mu) * lax.rsqrt(var + eps)).reshape(x.shape)


def causal_dwconv(x, w, b):
    k_w, c = w.shape
    y = lax.conv_general_dilated(x, w[:, None, :].astype(x.dtype), window_strides=(1,),
                                 padding=[(k_w - 1, 0)], dimension_numbers=('NWC', 'WIO', 'NWC'),
                                 feature_group_count=c)
    return y + b.astype(x.dtype)


def blockdiag_linear(x, w):
    xb = x.reshape(x.shape[:-1] + w.shape[:2])
    return jnp.einsum('bsni,nio->bsno', xb, w.astype(x.dtype)).reshape(x.shape)


def token_shift_mix(p, mu):
    prev = jnp.pad(p, ((0, 0), (1, 0), (0, 0)))[:, :-1]
    return p + (prev - p) * mu.astype(p.dtype)


def mlstm_chunkwise(q, k, v, i_pre, logf):
    bsz, nh, seq, dh = q.shape
    n_chunks = seq // MLSTM_CHUNK

    def chunks(t):
        t = t.reshape(t.shape[:2] + (n_chunks, MLSTM_CHUNK) + t.shape[3:])
        return jnp.moveaxis(t, 2, 0)

    causal = jnp.tril(jnp.ones((MLSTM_CHUNK, MLSTM_CHUNK), dtype=bool))

    def step(carry, inp):
        c_st, n_st, m_st = carry
        qb, kb, vb, ib, fb = inp
        b = jnp.cumsum(fb, axis=-1)
        d_mat = jnp.where(causal, b[..., :, None] - b[..., None, :] + ib[..., None, :], -jnp.inf)
        inter = b + m_st[..., None]
        m_t = jnp.maximum(jnp.max(d_mat, axis=-1), inter)
        s = jnp.einsum('bhtd,bhsd->bhts', qb, kb) * jnp.exp(d_mat - m_t[..., None])
        g_in = jnp.exp(inter - m_t)
        num = jnp.einsum('bhts,bhse->bhte', s, vb) + g_in[..., None] * jnp.einsum('bhtd,bhde->bhte', qb, c_st)
        den = jnp.sum(s, axis=-1) + g_in * jnp.einsum('bhtd,bhd->bht', qb, n_st)
        h = num / jnp.maximum(jnp.abs(den), jnp.exp(-m_t))[..., None]
        b_last = b[..., -1]
        w_s = b_last[..., None] - b + ib
        m_new = jnp.maximum(b_last + m_st, jnp.max(w_s, axis=-1))
        kw = kb * jnp.exp(w_s - m_new[..., None])[..., None]
        g_old = jnp.exp(b_last + m_st - m_new)
        c_new = g_old[..., None, None] * c_st + jnp.einsum('bhsd,bhse->bhde', kw, vb)
        n_new = g_old[..., None] * n_st + jnp.sum(kw, axis=2)
        return (c_new, n_new, m_new), h

    init = (jnp.zeros((bsz, nh, dh, dh), jnp.float32), jnp.zeros((bsz, nh, dh), jnp.float32),
            jnp.zeros((bsz, nh), jnp.float32))
    _, hs = lax.scan(step, init, (chunks(q), chunks(k), chunks(v), chunks(i_pre), chunks(logf)))
    return jnp.moveaxis(hs, 0, 2).reshape(bsz, nh, seq, dh)


def mlstm_mixer(u, conv_w, conv_b, wq, wk, wv, w_gate, b_gate, mhn_g, skip):
    bsz, seq, _ = u.shape
    xc = jax.nn.silu(causal_dwconv(u, conv_w, conv_b))
    q = blockdiag_linear(xc, wq)
    k = blockdiag_linear(xc, wk)
    v = blockdiag_linear(u, wv)
    gates = (jnp.concatenate([q, k, v], axis=-1) @ w_gate.astype(u.dtype)).astype(jnp.float32) + b_gate
    i_pre = jnp.moveaxis(gates[..., :MLSTM_HEADS], -1, 1)
    logf = jax.nn.log_sigmoid(jnp.moveaxis(gates[..., MLSTM_HEADS:], -1, 1))

    def heads(t):
        return t.astype(jnp.float32).reshape(bsz, seq, MLSTM_HEADS, MLSTM_HEAD_DIM).transpose(0, 2, 1, 3)

    h = mlstm_chunkwise(heads(q), heads(k) * (MLSTM_HEAD_DIM ** -0.5), heads(v), i_pre, logf)
    h = h.transpose(0, 2, 1, 3).reshape(bsz, seq, D_MIX)
    h = head_norm(h, MLSTM_HEADS, MHLN_EPS) * mhn_g + skip * xc.astype(jnp.float32)
    return h, v


def wkv7_scan(r, w, k, v, a, b):
    bsz, _, nh, n = r.shape

    def step(state, inp):
        r_t, w_t, k_t, v_t, a_t, b_t = inp
        sa = jnp.einsum('bhij,bhj->bhi', state, a_t)
        state = (state * w_t[..., None, :] + sa[..., :, None] * b_t[..., None, :]
                 + v_t[..., :, None] * k_t[..., None, :])
        return state, jnp.einsum('bhij,bhj->bhi', state, r_t)

    s0 = jnp.zeros((bsz, nh, n, n), jnp.float32)
    xs = tuple(jnp.moveaxis(t, 1, 0) for t in (r, w, k, v, a, b))
    _, out = lax.scan(step, s0, xs)
    return jnp.moveaxis(out, 0, 1)


def rwkv7_mixer(p, v_first, w_lora2, w0, a_lora2, a0, v_lora2, v0, g_lora2, k_k, k_a, r_k, lnx_g, lnx_b):
    p = p.astype(jnp.float32)
    bsz, seq, _ = p.shape
    cuts = [D_MIX, 2 * D_MIX, 3 * D_MIX, 3 * D_MIX + DECAY_RANK, 3 * D_MIX + DECAY_RANK + ICLR_RANK,
            3 * D_MIX + DECAY_RANK + ICLR_RANK + VRES_RANK]
    r, k, v, wl, al, vl, gl = jnp.split(p, cuts, axis=-1)
    logw = -jax.nn.softplus(-(w0 + jnp.tanh(wl) @ w_lora2)) - 0.5
    decay = jnp.exp(-jnp.exp(logw))
    a = jax.nn.sigmoid(a0 + al @ a_lora2)
    v = v + (v_first.astype(jnp.float32) - v) * jax.nn.sigmoid(v0 + vl @ v_lora2)
    g = jax.nn.sigmoid(gl) @ g_lora2

    def heads(t):
        return t.reshape(bsz, seq, RWKV_HEADS, RWKV_HEAD_DIM)

    kk = heads(k * k_k)
    kk = kk / jnp.maximum(jnp.sqrt(jnp.sum(kk * kk, axis=-1, keepdims=True)), L2_EPS)
    k = k * (1.0 + (a - 1.0) * k_a)
    rh, kh, vh, ah = heads(r), heads(k), heads(v), heads(a)
    out = wkv7_scan(rh, heads(decay), kh, vh, -kk, kk * ah)
    out = head_norm(out.reshape(bsz, seq, D_MIX), RWKV_HEADS, RWKV_GN_EPS) * lnx_g + lnx_b
    bonus = jnp.sum(rh * kh * r_k, axis=-1, keepdims=True) * vh
    return (out + bonus.reshape(bsz, seq, D_MIX)) * g


def memory_attention(qm, mem_n, w_kv):
    bsz, seq, _ = qm.shape
    km, vm = jnp.split(mem_n @ w_kv.astype(mem_n.dtype), 2, axis=-1)
    q = qm.reshape(bsz, seq, XATTN_HEADS, XATTN_HEAD_DIM)
    km = km.reshape(bsz, -1, XATTN_HEADS, XATTN_HEAD_DIM)
    vm = vm.reshape(bsz, -1, XATTN_HEADS, XATTN_HEAD_DIM)
    s = jnp.einsum('bshd,bmhd->bhsm', q, km).astype(jnp.float32) * (XATTN_HEAD_DIM ** -0.5)
    pr = jax.nn.softmax(s, axis=-1)
    o = jnp.einsum('bhsm,bmhd->bshd', pr, vm.astype(jnp.float32))
    return o.reshape(bsz, seq, D_XATTN)


def setup_inputs(seed: int = 0) -> dict:
    key = jax.random.key(seed)
    ks = iter(jax.random.split(key, 48))
    f32 = jnp.float32

    def nrm(shape, scale):
        return jax.random.normal(next(ks), shape, f32) * scale

    def gain(shape):
        return 1.0 + nrm(shape, 0.02)

    x = nrm((BATCH, SEQ, D_MODEL), 1.0)
    mem = nrm((BATCH, N_MEM, D_MODEL), 1.0)
    norm_g = gain((DEPTH, D_MODEL))
    mem_norm_g = gain((DEPTH, D_MODEL))
    mem_kv_w = nrm((DEPTH, D_MODEL, 2 * D_XATTN), D_MODEL ** -0.5)
    w_out = nrm((DEPTH, D_INNER, D_MODEL), D_INNER ** -0.5)
    ml_w_in = nrm((N_MLSTM, D_MODEL, ML_IN_W), D_MODEL ** -0.5)
    ml_conv_w = nrm((N_MLSTM, MLSTM_CONV, D_MIX), MLSTM_CONV ** -0.5)
    ml_conv_b = nrm((N_MLSTM, D_MIX), 0.01)
    ml_wq = nrm((N_MLSTM, N_QKV_BLOCKS, QKV_BLOCK, QKV_BLOCK), QKV_BLOCK ** -0.5)
    ml_wk = nrm((N_MLSTM, N_QKV_BLOCKS, QKV_BLOCK, QKV_BLOCK), QKV_BLOCK ** -0.5)
    ml_wv = nrm((N_MLSTM, N_QKV_BLOCKS, QKV_BLOCK, QKV_BLOCK), QKV_BLOCK ** -0.5)
    ml_w_gate = nrm((N_MLSTM, 3 * D_MIX, 2 * MLSTM_HEADS), (3 * D_MIX) ** -0.5)
    fgate_bias = jnp.linspace(3.0, 6.0, MLSTM_HEADS, dtype=f32)
    ml_b_gate = jnp.concatenate([nrm((N_MLSTM, MLSTM_HEADS), 0.1),
                                 fgate_bias[None] + nrm((N_MLSTM, MLSTM_HEADS), 0.1)], axis=-1)
    ml_mhn_g = gain((N_MLSTM, D_MIX))
    ml_skip = gain((N_MLSTM, D_MIX))
    rw_w_in = nrm((N_RWKV, D_MODEL, RW_IN_W), D_MODEL ** -0.5)
    rw_mu = jax.random.uniform(next(ks), (N_RWKV, RW_SHIFT_W), f32, 0.0, 1.0)
    rw_w_lora2 = nrm((N_RWKV, DECAY_RANK, D_MIX), 0.5 * DECAY_RANK ** -0.5)
    chan = jnp.linspace(0.0, 1.0, D_MIX, dtype=f32)
    rw_w0 = (-6.5 + 5.0 * chan ** 0.85)[None] + nrm((N_RWKV, D_MIX), 0.1)
    rw_a_lora2 = nrm((N_RWKV, ICLR_RANK, D_MIX), 0.5 * ICLR_RANK ** -0.5)
    rw_a0 = nrm((N_RWKV, D_MIX), 0.1)
    rw_v_lora2 = nrm((N_RWKV, VRES_RANK, D_MIX), 0.5 * VRES_RANK ** -0.5)
    rw_v0 = 1.0 + nrm((N_RWKV, D_MIX), 0.1)
    rw_g_lora2 = nrm((N_RWKV, GATE_RANK, D_MIX), GATE_RANK ** -0.5)
    rw_k_k = 0.85 + nrm((N_RWKV, D_MIX), 0.02)
    rw_k_a = 1.0 + nrm((N_RWKV, D_MIX), 0.02)
    rw_r_k = -0.04 + nrm((N_RWKV, RWKV_HEADS, RWKV_HEAD_DIM), 0.02)
    rw_lnx_g = gain((N_RWKV, D_MIX))
    rw_lnx_b = nrm((N_RWKV, D_MIX), 0.01)
    final_g = gain((D_MODEL,))
    return {'x': x, 'mem': mem, 'norm_g': norm_g, 'mem_norm_g': mem_norm_g, 'mem_kv_w': mem_kv_w,
            'w_out': w_out, 'ml_w_in': ml_w_in, 'ml_conv_w': ml_conv_w, 'ml_conv_b': ml_conv_b,
            'ml_wq': ml_wq, 'ml_wk': ml_wk, 'ml_wv': ml_wv, 'ml_w_gate': ml_w_gate, 'ml_b_gate': ml_b_gate,
            'ml_mhn_g': ml_mhn_g, 'ml_skip': ml_skip, 'rw_w_in': rw_w_in, 'rw_mu': rw_mu,
            'rw_w_lora2': rw_w_lora2, 'rw_w0': rw_w0, 'rw_a_lora2': rw_a_lora2, 'rw_a0': rw_a0,
            'rw_v_lora2': rw_v_lora2, 'rw_v0': rw_v0, 'rw_g_lora2': rw_g_lora2, 'rw_k_k': rw_k_k,
            'rw_k_a': rw_k_a, 'rw_r_k': rw_r_k, 'rw_lnx_g': rw_lnx_g, 'rw_lnx_b': rw_lnx_b,
            'final_g': final_g}


def reference(x, mem, norm_g, mem_norm_g, mem_kv_w, w_out, ml_w_in, ml_conv_w, ml_conv_b, ml_wq, ml_wk,
              ml_wv, ml_w_gate, ml_b_gate, ml_mhn_g, ml_skip, rw_w_in, rw_mu, rw_w_lora2, rw_w0,
              rw_a_lora2, rw_a0, rw_v_lora2, rw_v0, rw_g_lora2, rw_k_k, rw_k_a, rw_r_k, rw_lnx_g,
              rw_lnx_b, final_g):
    v_first = None
    for i in range(DEPTH):
        j = i // 2
        h = rms_norm(x, norm_g[i])
        mem_n = rms_norm(mem, mem_norm_g[i])
        if i % 2 == 0:
            proj = h @ ml_w_in[j]
            u = proj[..., :D_MIX]
            qm = proj[..., D_MIX:D_MIX + D_XATTN]
            z = proj[..., D_MIX + D_XATTN:]
            y_mix, v_l = mlstm_mixer(u, ml_conv_w[j], ml_conv_b[j], ml_wq[j], ml_wk[j], ml_wv[j],
                                     ml_w_gate[j], ml_b_gate[j], ml_mhn_g[j], ml_skip[j])
            if i == 0:
                v_first = v_l
        else:
            proj = h @ rw_w_in[j]
            p = token_shift_mix(proj[..., :RW_SHIFT_W], rw_mu[j])
            qm = proj[..., RW_SHIFT_W:RW_SHIFT_W + D_XATTN]
            z = proj[..., RW_SHIFT_W + D_XATTN:]
            y_mix = rwkv7_mixer(p, v_first, rw_w_lora2[j], rw_w0[j], rw_a_lora2[j], rw_a0[j],
                                rw_v_lora2[j], rw_v0[j], rw_g_lora2[j], rw_k_k[j], rw_k_a[j],
                                rw_r_k[j], rw_lnx_g[j], rw_lnx_b[j])
        y_mem = memory_attention(qm, mem_n, mem_kv_w[i])
        y = jnp.concatenate([y_mix, y_mem], axis=-1) * jax.nn.silu(z.astype(jnp.float32))
        x = x + y.astype(x.dtype) @ w_out[i]
    return rms_norm(x, final_g)
```

```cpp
#include <hip/hip_runtime.h>
#include <cstdio>
#include <cstdint>

#define LAS __attribute__((address_space(3)))
typedef unsigned short bf16_t;
typedef short bf16x8 __attribute__((ext_vector_type(8)));
typedef short bf16x4 __attribute__((ext_vector_type(4)));
typedef float f32x4 __attribute__((ext_vector_type(4)));
typedef float f32x2 __attribute__((ext_vector_type(2)));
typedef unsigned u32x4 __attribute__((ext_vector_type(4)));
typedef unsigned u32x2 __attribute__((ext_vector_type(2)));

constexpr int NB = 8, SEQ = 2048, DM = 1024, NSEG = 4, SEGT = 512, MS = NB * SEGT;
constexpr int DMIX = 1536, DX = 512, DIN = 2048;
constexpr int ML_W = 4096, RW_SHIFT = 4896, RW_W = 7456;
constexpr int P1W = 5120, P2W = 2560;
constexpr size_t MiB = 1u << 20;
constexpr size_t OFF_WT0 = 0, OFF_WT1 = 8 * MiB, OFF_WO0T = 23 * MiB, OFF_WO1T = 27 * MiB, OFF_WKVT = 31 * MiB  ,
                 OFF_KMEM = 35 * MiB  , OFF_LORAT = 43 * MiB, OFF_MISC = 45 * MiB,
                 OFF_CST = 46 * MiB, OFF_NST = 65 * MiB, OFF_RST = 65 * MiB + 512 * 1024, OFF_H = 69 * MiB, OFF_VF = 77 * MiB,
                 OFF_SEG = 89 * MiB, OFF_MEMN = 248 * MiB;
constexpr size_t OFF_BAR = OFF_MISC, OFF_UTAIL = OFF_MISC + 64 * 1024, OFF_PTAIL = OFF_MISC + 256 * 1024;
constexpr size_t S0_P0 = 0, S0_Q = 32 * MiB, S0_K = 44 * MiB, S0_KT = 56 * MiB, S0_VT = 68 * MiB, S0_XC = 80 * MiB, S0_HRAW = 92 * MiB,
                 S0_YMEM = 116 * MiB, S0_Y = 120 * MiB, S0_GATE = 136 * MiB;
constexpr size_t S1_P1 = 0, S1_O = 0, S1_Y = 24 * MiB, S1_P2 = 40 * MiB, S1_W = 60 * MiB, S1_A = 84 * MiB, S1_B = 96 * MiB, S1_K = 108 * MiB,
                 S1_Q = 120 * MiB, S1_V = 132 * MiB, S1_G = 144 * MiB, S1_YMEM = 156 * MiB, S1_BRKR = 160 * MiB;
constexpr size_t S0_SLAB = 0  , S1_SLAB = 84 * MiB  ;
constexpr int LDS_BYTES = 150 * 1024;

struct P {
    const float *x, *mem, *norm_g, *mem_norm_g, *mem_kv_w, *w_out, *ml_w_in, *ml_conv_w, *ml_conv_b, *ml_wq, *ml_wk, *ml_wv, *ml_w_gate, *ml_b_gate,
        *ml_mhn_g, *ml_skip, *rw_w_in, *rw_mu, *rw_w_lora2, *rw_w0, *rw_a_lora2, *rw_a0, *rw_v_lora2, *rw_v0, *rw_g_lora2, *rw_k_k, *rw_k_a, *rw_r_k,
        *rw_lnx_g, *rw_lnx_b, *final_g;
    float* out; unsigned char* ws;
};

__device__ __forceinline__ bf16_t f2bf(float f) { unsigned u = __float_as_uint(f); u += 0x7FFFu + ((u >> 16) & 1u); return (bf16_t)(u >> 16); }
__device__ __forceinline__ float bf2f(bf16_t b) { return __uint_as_float(((unsigned)b) << 16); }
__device__ __forceinline__ unsigned pk2(float lo, float hi) { return (unsigned)f2bf(lo) | ((unsigned)f2bf(hi) << 16); }
__device__ __forceinline__ float bflo(unsigned u) { return __uint_as_float(u << 16); }
__device__ __forceinline__ float bfhi(unsigned u) { return __uint_as_float(u & 0xFFFF0000u); }
__device__ __forceinline__ float wsum(float v) {
#pragma unroll
    for (int o = 32; o >= 1; o >>= 1) v += __shfl_xor(v, o);
    return v;
}
__device__ __forceinline__ float sigmoidf_(float x) { return 1.0f / (1.0f + __expf(-x)); }
__device__ __forceinline__ float siluf_(float x) { return x / (1.0f + __expf(-x)); }
__device__ __forceinline__ float softplusf_(float z) { return fmaxf(z, 0.f) + log1pf(__expf(-fabsf(z))); }
template <int CTRL> __device__ __forceinline__ float dpp_add(float v) {
    return v + __int_as_float(__builtin_amdgcn_update_dpp(0, __float_as_int(v), CTRL, 0xF, 0xF, true));
}
__device__ __forceinline__ float row16_allsum(float v) {
    v = dpp_add<0xB1>(v);
    v = dpp_add<0x4E>(v);
    v = dpp_add<0x141>(v);
    v = dpp_add<0x140>(v);
    return v;
}
__device__ __forceinline__ void row16_allsum4(float& a, float& b, float& c, float& d) {
    asm volatile("s_nop 1\n\t"
        "v_add_f32_dpp %0, %0, %0 quad_perm:[1,0,3,2] row_mask:0xf bank_mask:0xf\n\t" "v_add_f32_dpp %1, %1, %1 quad_perm:[1,0,3,2] row_mask:0xf bank_mask:0xf\n\t"
        "v_add_f32_dpp %2, %2, %2 quad_perm:[1,0,3,2] row_mask:0xf bank_mask:0xf\n\t" "v_add_f32_dpp %3, %3, %3 quad_perm:[1,0,3,2] row_mask:0xf bank_mask:0xf\n\t"
        "v_add_f32_dpp %0, %0, %0 quad_perm:[2,3,0,1] row_mask:0xf bank_mask:0xf\n\t" "v_add_f32_dpp %1, %1, %1 quad_perm:[2,3,0,1] row_mask:0xf bank_mask:0xf\n\t"
        "v_add_f32_dpp %2, %2, %2 quad_perm:[2,3,0,1] row_mask:0xf bank_mask:0xf\n\t" "v_add_f32_dpp %3, %3, %3 quad_perm:[2,3,0,1] row_mask:0xf bank_mask:0xf\n\t"
        "v_add_f32_dpp %0, %0, %0 row_half_mirror row_mask:0xf bank_mask:0xf\n\t" "v_add_f32_dpp %1, %1, %1 row_half_mirror row_mask:0xf bank_mask:0xf\n\t"
        "v_add_f32_dpp %2, %2, %2 row_half_mirror row_mask:0xf bank_mask:0xf\n\t" "v_add_f32_dpp %3, %3, %3 row_half_mirror row_mask:0xf bank_mask:0xf\n\t"
        "v_add_f32_dpp %0, %0, %0 row_mirror row_mask:0xf bank_mask:0xf\n\t" "v_add_f32_dpp %1, %1, %1 row_mirror row_mask:0xf bank_mask:0xf\n\t"
        "v_add_f32_dpp %2, %2, %2 row_mirror row_mask:0xf bank_mask:0xf\n\t" "v_add_f32_dpp %3, %3, %3 row_mirror row_mask:0xf bank_mask:0xf\n\t"
        "s_nop 1"
        : "+v"(a), "+v"(b), "+v"(c), "+v"(d));
}
template <int N> __device__ __forceinline__ float dpp_shr_or1(float v) {
    return __int_as_float(__builtin_amdgcn_update_dpp(0x3f800000, __float_as_int(v), 0x110 + N, 0xF, 0xF, false));
}
__device__ __forceinline__ f32x4 mfma16(bf16x8 a, bf16x8 b, f32x4 c) { return __builtin_amdgcn_mfma_f32_16x16x32_bf16(a, b, c, 0, 0, 0); }

namespace pg8 {
constexpr int BM = 256, BK = 64, HALF = 128, HTB = HALF * BK * 2, STAGE_BYTES = 8 * HTB, NXCD = 8, WGM = 8;
__host__ __device__ __forceinline__ int lds_byte(int r, int c) { const int st = (r >> 4) * 2 + (c >> 5), rr = r & 15, cc = c & 31, ob = rr * 64 + cc * 2; return st * 1024 + (ob ^ (((ob >> 9) & 1) << 5)); }
__host__ __device__ __forceinline__ void stage_rc(int b, int& R, int& C) { const int st = b / 1024, sb = b % 1024, swz = sb ^ (((sb >> 9) & 1) << 5); R = (st >> 1) * 16 + swz / 64; C = (st & 1) * 32 + (swz % 64) / 2; }
__host__ __device__ __forceinline__ int perm32(int rho) { const int n = rho >> 4, i = rho & 15; return 8 * (i >> 2) + 4 * n + (i & 3); }

struct Unit { const char* A; const char* B; char* O; int ldc; int pad; };

__device__ __forceinline__ void remap(int wgid, int nM, int nN, int& pm, int& pn) {
    const int nwg = nM * nN;
    { const int q = nwg / NXCD, r = nwg % NXCD, xcd = wgid % NXCD, off = wgid / NXCD; wgid = (xcd < r ? xcd * (q + 1) : r * (q + 1) + (xcd - r) * q) + off; }
    const int nig = WGM * nN, gid = wgid / nig, fm = gid * WGM, gsz = (nM - fm) < WGM ? (nM - fm) : WGM;
    pm = fm + ((wgid % nig) % gsz); pn = (wgid % nig) / gsz;
}

struct EpiBf {
    static constexpr bool PERM = true;
    __device__ __forceinline__ void operator()(const f32x4 (&acc)[2][2][4][2], const Unit& u, int wr, int wc, int fr, int fq) const {
        asm volatile("" : "+v"(fr), "+v"(fq));
        bf16_t* base = (bf16_t*)u.O;
#pragma unroll
        for (int ai = 0; ai < 2; ++ai)
#pragma unroll
            for (int m = 0; m < 4; ++m) { bf16_t* rowp = base + (size_t)(ai * HALF + wr * 64 + m * 16 + fr) * u.ldc + wc * 32 + 8 * fq;
#pragma unroll
                for (int bj = 0; bj < 2; ++bj) { const f32x4 v0 = acc[ai][bj][m][0], v1 = acc[ai][bj][m][1];
                    u32x4 w; w.x = pk2(v0[0], v0[1]); w.y = pk2(v0[2], v0[3]); w.z = pk2(v1[0], v1[1]); w.w = pk2(v1[2], v1[3]);
                    *(u32x4*)(rowp + bj * HALF) = w; } }
    }
};
struct EpiAtomic {
    static constexpr bool PERM = false;
    __device__ __forceinline__ void operator()(const f32x4 (&acc)[2][2][4][2], const Unit& u, int wr, int wc, int fr, int fq) const {
        asm volatile("" : "+v"(fr), "+v"(fq));
        float* base = (float*)u.O;
#pragma unroll
        for (int ai = 0; ai < 2; ++ai)
#pragma unroll
            for (int m = 0; m < 4; ++m) { float* rowp = base + (size_t)(ai * HALF + wr * 64 + m * 16 + fr) * u.ldc + wc * 32 + 4 * fq;
#pragma unroll
                for (int bj = 0; bj < 2; ++bj)
#pragma unroll
                    for (int n = 0; n < 2; ++n) { const f32x4 v = acc[ai][bj][m][n]; float* q = rowp + bj * HALF + n * 16;
#pragma unroll
                        for (int e = 0; e < 4; ++e) (void)__hip_atomic_fetch_add(q + e, v[e], __ATOMIC_RELAXED, __HIP_MEMORY_SCOPE_AGENT); }
                __builtin_amdgcn_sched_barrier(0); }
    }
};

template <class Epi, class Sched>
__device__ __forceinline__ void gemm_phase(LAS unsigned char* lds, const int tid, const int ldk, const int Kloop, const Sched& S, const Epi& E) {
    const int wid = __builtin_amdgcn_readfirstlane(tid >> 6), lane = tid & 63, wr = wid >> 2, wc = wid & 3, fr = lane & 15, fq = lane >> 4;
    const int nt = Kloop / BK;
    unsigned voffA[2], voffB[2];
#pragma unroll
    for (int i = 0; i < 2; ++i) { int R, C; stage_rc(tid * 16 + i * 8192, R, C); const int Rb = Epi::PERM ? ((R & ~31) + perm32(R & 31)) : R;
        voffA[i] = (unsigned)(R * ldk + C) * 2u; voffB[i] = (unsigned)(Rb * ldk + C) * 2u; }
    const size_t kstep = (size_t)(BK * 2);
    const size_t hstep = (size_t)HALF * ldk * 2;
    const unsigned ldsw = (unsigned)wid * 1024u;
    const int aoff = lds_byte(wr * 64 + fr, fq * 8), boff = lds_byte(wc * 32 + fr, fq * 8);
#define PG8_SA(b, h) (((b) * 2 + (h)) * HTB)
#define PG8_SB(b, h) ((4 + (b) * 2 + (h)) * HTB)
#define PG8_STAGE(bufoff, gbase, voff) do { _Pragma("unroll") for (int _i = 0; _i < 2; ++_i) \
        __builtin_amdgcn_global_load_lds((const unsigned*)((const char*)(gbase) + (voff)[_i]), (LAS unsigned*)(lds + (bufoff) + ldsw + _i * 8192), 16, 0, 0); } while (0)
#define PG8_LDA(dst, b, h) do { _Pragma("unroll") for (int m = 0; m < 4; ++m) _Pragma("unroll") for (int k = 0; k < 2; ++k) dst[m][k] = *(const LAS bf16x8*)(lds + PG8_SA(b, h) + aoff + m * 2048 + k * 1024); } while (0)
#define PG8_LDB(dst, b, h) do { _Pragma("unroll") for (int n = 0; n < 2; ++n) _Pragma("unroll") for (int k = 0; k < 2; ++k) dst[n][k] = *(const LAS bf16x8*)(lds + PG8_SB(b, h) + boff + n * 2048 + k * 1024); } while (0)
#define PG8_MMA(ai, bj, At, Bt) do { __builtin_amdgcn_s_setprio(1); _Pragma("unroll") for (int m = 0; m < 4; ++m) _Pragma("unroll") for (int n = 0; n < 2; ++n) _Pragma("unroll") for (int k = 0; k < 2; ++k) \
        acc[ai][bj][m][n] = __builtin_amdgcn_mfma_f32_16x16x32_bf16(Bt[n][k], At[m][k], acc[ai][bj][m][n], 0, 0, 0); __builtin_amdgcn_s_setprio(0); } while (0)
#define PG8_WAIT_V(n) asm volatile("s_waitcnt vmcnt(" #n ")" ::: "memory")
#define PG8_WAIT_L(n) asm volatile("s_waitcnt lgkmcnt(" #n ")" ::: "memory")
#define PG8_BAR __builtin_amdgcn_s_barrier()
#define PG8_SCHED __builtin_amdgcn_sched_barrier(0)
    Unit cur, nxt; int ui = 0;
    if (!S.next(0, cur)) return;
    f32x4 acc[2][2][4][2];
#pragma unroll
    for (int a = 0; a < 2; ++a)
#pragma unroll
        for (int b = 0; b < 2; ++b)
#pragma unroll
            for (int m = 0; m < 4; ++m)
#pragma unroll
                for (int n = 0; n < 2; ++n) acc[a][b][m][n] = (f32x4){0.f, 0.f, 0.f, 0.f};
    bf16x8 At[4][2], B0[2][2], B1[2][2];
    const char* cA = cur.A; const char* cB = cur.B;
    PG8_STAGE(PG8_SB(0, 0), cB, voffB); PG8_STAGE(PG8_SA(0, 0), cA, voffA); PG8_STAGE(PG8_SB(0, 1), cB + hstep, voffB); PG8_STAGE(PG8_SA(0, 1), cA + hstep, voffA);
    if (wr == 1) PG8_BAR;
    PG8_WAIT_V(4); PG8_BAR;
    PG8_STAGE(PG8_SB(1, 0), cB + kstep, voffB); PG8_STAGE(PG8_SA(1, 0), cA + kstep, voffA); PG8_STAGE(PG8_SB(1, 1), cB + hstep + kstep, voffB);
    PG8_WAIT_V(6); PG8_BAR;
    for (;;) {
        const bool has_next = S.next(ui + 1, nxt);
        const char* nA = has_next ? nxt.A : cA; const char* nB = has_next ? nxt.B : cB;
        for (int t = 0; t < nt; t += 2) {
            const bool last = (t == nt - 2);
            const char* a1 = cA + (size_t)(t + 1) * kstep;
            const char* a2 = last ? nA : cA + (size_t)(t + 2) * kstep; const char* b2 = last ? nB : cB + (size_t)(t + 2) * kstep;
            const char* a3 = a2 + kstep; const char* b3 = b2 + kstep;
            PG8_LDB(B0, 0, 0); PG8_SCHED; PG8_LDA(At, 0, 0); PG8_STAGE(PG8_SA(1, 1), a1 + hstep, voffA);
            PG8_WAIT_L(8); PG8_BAR; PG8_WAIT_L(0); PG8_MMA(0, 0, At, B0); PG8_BAR; PG8_SCHED;
            PG8_LDB(B1, 0, 1); PG8_STAGE(PG8_SB(0, 0), b2, voffB);
            PG8_BAR; PG8_WAIT_L(0); PG8_MMA(0, 1, At, B1); PG8_BAR;
            PG8_LDA(At, 0, 1); PG8_STAGE(PG8_SA(0, 0), a2, voffA);
            PG8_BAR; PG8_WAIT_L(0); PG8_MMA(1, 0, At, B0); PG8_BAR; PG8_SCHED;
            PG8_STAGE(PG8_SB(0, 1), b2 + hstep, voffB);
            PG8_WAIT_V(6); PG8_BAR; PG8_MMA(1, 1, At, B1); PG8_BAR;
            PG8_LDB(B0, 1, 0); PG8_SCHED; PG8_LDA(At, 1, 0); PG8_STAGE(PG8_SA(0, 1), a2 + hstep, voffA);
            PG8_WAIT_L(8); PG8_BAR; PG8_WAIT_L(0); PG8_MMA(0, 0, At, B0); PG8_BAR; PG8_SCHED;
            PG8_LDB(B1, 1, 1); PG8_STAGE(PG8_SB(1, 0), b3, voffB);
            PG8_BAR; PG8_WAIT_L(0); PG8_MMA(0, 1, At, B1); PG8_BAR;
            PG8_LDA(At, 1, 1); PG8_STAGE(PG8_SA(1, 0), a3, voffA);
            PG8_BAR; PG8_WAIT_L(0); PG8_MMA(1, 0, At, B0); PG8_BAR; PG8_SCHED;
            PG8_STAGE(PG8_SB(1, 1), b3 + hstep, voffB);
            PG8_WAIT_V(6); PG8_BAR; PG8_MMA(1, 1, At, B1); PG8_BAR;
        }
        E(acc, cur, wr, wc, fr, fq);
        if (!has_next) break;
#pragma unroll
        for (int a = 0; a < 2; ++a)
#pragma unroll
            for (int b = 0; b < 2; ++b)
#pragma unroll
                for (int m = 0; m < 4; ++m)
#pragma unroll
                    for (int n = 0; n < 2; ++n) acc[a][b][m][n] = (f32x4){0.f, 0.f, 0.f, 0.f};
        cur = nxt; cA = nA; cB = nB; ++ui;
    }
    PG8_WAIT_V(0);
    if (wr == 0) PG8_BAR;
    PG8_BAR;
#undef PG8_SA
#undef PG8_SB
#undef PG8_STAGE
#undef PG8_LDA
#undef PG8_LDB
#undef PG8_MMA
#undef PG8_WAIT_V
#undef PG8_WAIT_L
#undef PG8_BAR
#undef PG8_SCHED
}
}

#define XB_TMO      128
#define XB_XCNT(j)  (256  + 64 * (j))
#define XB_XSUB(j)  (1280 + 64 * (j))
#define XB_XGEN(j)  (2304 + 64 * (j))
#define XB_TOP      3328
#define XB_TOPGEN   3392
#define XCD_BAR_WORDS 3456
#define XB_SPIN_CAP (1u << 18)
__device__ __forceinline__ unsigned xb_ld(unsigned* p)              { return __hip_atomic_load(p, __ATOMIC_RELAXED, __HIP_MEMORY_SCOPE_AGENT); }
__device__ __forceinline__ unsigned xb_add(unsigned* p, unsigned v) { return __hip_atomic_fetch_add(p, v, __ATOMIC_RELAXED, __HIP_MEMORY_SCOPE_AGENT); }
__device__ __forceinline__ unsigned xb_xcc_id() { return (unsigned)__builtin_amdgcn_s_getreg((3 << 11) | 20) & 0xFu; }
#define XB_SPIN(cond, bar) do { unsigned _sp = 0; while (cond) { __builtin_amdgcn_s_sleep(1); \
    if ((++_sp & 255u) == 0u) { if (xb_ld(&(bar)[XB_TMO])) break; if (_sp > XB_SPIN_CAP) { atomicAdd(&(bar)[XB_TMO], 1u); break; } } } } while (0)
struct XcdBarrier { unsigned* bar; unsigned x; volatile LAS unsigned* st; };
__device__ __forceinline__ XcdBarrier xcd_barrier_post(unsigned* bar, volatile LAS unsigned* st) {
    XcdBarrier b; b.bar = bar; b.x = xb_xcc_id(); b.st = st;
    if (threadIdx.x == 0) (void)xb_add(&bar[XB_XCNT(b.x)], 1u);
    return b;
}
__device__ __forceinline__ void xcd_barrier_complete(unsigned* bar, unsigned x, unsigned& nloc, unsigned& nx) {
    const unsigned G = gridDim.x * gridDim.y * gridDim.z;
    unsigned sum, cnt, mine, sp = 0u;
    for (;;) {
        sum = 0u; cnt = 0u; mine = 0u;
#pragma unroll
        for (unsigned j = 0; j < 16; ++j) { const unsigned c = xb_ld(&bar[XB_XCNT(j)]); sum += c; cnt += (c > 0u) ? 1u : 0u; mine = (j == x) ? c : mine; }
        if (sum == G) break;
        __builtin_amdgcn_s_sleep(1);
        if ((++sp & 255u) == 0u) { if (xb_ld(&bar[XB_TMO])) break; if (sp > XB_SPIN_CAP) { atomicAdd(&bar[XB_TMO], 1u); break; } }
    }
    nloc = mine > 0u ? mine : 1u; nx = cnt > 0u ? cnt : 1u;
}
__device__ __forceinline__ void xcd_barrier(const XcdBarrier& b) {
    asm volatile("s_waitcnt vmcnt(0)" ::: "memory");
    __syncthreads();
    int tid0 = threadIdx.x; asm volatile("" : "+v"(tid0));
    if (tid0 == 0) {
        unsigned* bar = b.bar;
        __builtin_amdgcn_s_waitcnt(0);
        unsigned nloc = b.st[0], nx = b.st[1];
        if (nloc == 0u) { xcd_barrier_complete(bar, b.x, nloc, nx); b.st[0] = nloc; b.st[1] = nx; }
        const unsigned old = xb_add(&bar[XB_XSUB(b.x)], 1u);
        const unsigned gen = old / nloc;
        if (old + 1u == (gen + 1u) * nloc) {
            __builtin_amdgcn_fence(__ATOMIC_RELEASE, "agent");
            asm volatile("s_waitcnt vmcnt(0)" ::: "memory");
            const unsigned og = xb_add(&bar[XB_TOP], 1u);
            const unsigned tg = og / nx;
            if (og + 1u == (tg + 1u) * nx) xb_add(&bar[XB_TOPGEN], 1u);
            else XB_SPIN(xb_ld(&bar[XB_TOPGEN]) == tg, bar);
            __builtin_amdgcn_fence(__ATOMIC_ACQUIRE, "agent");
            xb_add(&bar[XB_XGEN(b.x)], 1u);
            asm volatile("s_waitcnt vmcnt(0)" ::: "memory");
        } else {
            XB_SPIN(xb_ld(&bar[XB_XGEN(b.x)]) == gen, bar);
            __builtin_amdgcn_fence(__ATOMIC_ACQUIRE, "agent");
            asm volatile("s_waitcnt vmcnt(0)" ::: "memory");
        }
    }
    __syncthreads();
}

__device__ __forceinline__ void lds_barrier() { asm volatile("s_waitcnt lgkmcnt(0)" ::: "memory"); __builtin_amdgcn_s_barrier(); asm volatile("" ::: "memory"); }
struct Ctx { int tid, wv, lane, G, bid; LAS unsigned char* lds; unsigned char* seg; };

template <int MODE>
__device__ __forceinline__ void convT_tile(const Ctx& c, const float* src, int ldsrc, int Ksrc, int k0, int n0, bf16_t* dst, int ldd, int koff) {
    LAS float* tile = (LAS float*)c.lds;
    __syncthreads();
#pragma unroll
    for (int rep = 0; rep < 2; ++rep) {
        const int i = (c.tid >> 4) + 32 * rep, j4 = (c.tid & 15) * 4; const int n = n0 + j4; int sc = n;
        if (MODE == 1) sc = (n < RW_SHIFT) ? n : (n < P1W ? -1 : n - (P1W - RW_SHIFT));
        f32x4 v = (f32x4){0.f, 0.f, 0.f, 0.f};
        if (sc >= 0 && (k0 + i) < Ksrc) v = *(const f32x4*)(src + (size_t)(k0 + i) * ldsrc + sc);
        tile[i * 65 + j4 + 0] = v[0]; tile[i * 65 + j4 + 1] = v[1]; tile[i * 65 + j4 + 2] = v[2]; tile[i * 65 + j4 + 3] = v[3];
    }
    __syncthreads();
    { const int j = c.tid >> 3, i8 = (c.tid & 7) * 8;
      if (k0 + i8 < Ksrc) {
        u32x4 w; w.x = pk2(tile[(i8 + 0) * 65 + j], tile[(i8 + 1) * 65 + j]); w.y = pk2(tile[(i8 + 2) * 65 + j], tile[(i8 + 3) * 65 + j]);
        w.z = pk2(tile[(i8 + 4) * 65 + j], tile[(i8 + 5) * 65 + j]); w.w = pk2(tile[(i8 + 6) * 65 + j], tile[(i8 + 7) * 65 + j]);
        *(u32x4*)(dst + (size_t)(n0 + j) * ldd + koff + k0 + i8) = w; } }
}

__device__ __forceinline__ void rms_row_bf16(const float* src, const float* g, bf16_t* dst, int lane) {
    f32x4 v[4]; float ss = 0.f;
#pragma unroll
    for (int i = 0; i < 4; ++i) { v[i] = *(const f32x4*)(src + i * 256 + lane * 4); ss += v[i][0] * v[i][0] + v[i][1] * v[i][1] + v[i][2] * v[i][2] + v[i][3] * v[i][3]; }
    ss = wsum(ss); const float rs = rsqrtf(ss * (1.0f / 1024.0f) + 1e-6f);
#pragma unroll
    for (int i = 0; i < 4; ++i) { const f32x4 gg = *(const f32x4*)(g + i * 256 + lane * 4);
        u32x2 w; w.x = pk2(v[i][0] * rs * gg[0], v[i][1] * rs * gg[1]); w.y = pk2(v[i][2] * rs * gg[2], v[i][3] * rs * gg[3]);
        *(u32x2*)(dst + i * 256 + lane * 4) = w; }
}
__device__ __forceinline__ float add_slabs(const float* src, const bf16_t* slab, int r, int lane, f32x4 (&v)[4]) {
    float ss = 0.f;
#pragma unroll
    for (int i = 0; i < 4; ++i) { v[i] = *(const f32x4*)(src + i * 256 + lane * 4);
#pragma unroll
        for (int ks = 0; ks < 4; ++ks) { const u32x2 t = *(const u32x2*)(slab + ((size_t)ks * MS + r) * DM + i * 256 + lane * 4);
            v[i][0] += bflo(t.x); v[i][1] += bfhi(t.x); v[i][2] += bflo(t.y); v[i][3] += bfhi(t.y); }
        ss += v[i][0] * v[i][0] + v[i][1] * v[i][1] + v[i][2] * v[i][2] + v[i][3] * v[i][3]; }
    return wsum(ss);
}

__device__ __forceinline__ void phase_apre(const P& p, const Ctx& c, int seg) {
    bf16_t* H = (bf16_t*)(p.ws + OFF_H);
    for (int r = c.bid * 8 + c.wv; r < MS; r += c.G * 8) { const int b = r >> 9, tl = r & 511; const size_t grow = (size_t)b * SEQ + seg * SEGT + tl;
        rms_row_bf16(p.x + grow * DM, p.norm_g, H + (size_t)r * DM, c.lane); }
}
__device__ __forceinline__ void phase_a5(const P& p, const Ctx& c, int seg) {
    bf16_t* H = (bf16_t*)(p.ws + OFF_H); const bf16_t* slab = (const bf16_t*)(c.seg + S0_SLAB);
    for (int r = c.bid * 8 + c.wv; r < MS; r += c.G * 8) { const int b = r >> 9, tl = r & 511; const size_t grow = (size_t)b * SEQ + seg * SEGT + tl;
        f32x4 v[4]; const float ss = add_slabs(p.x + grow * DM, slab, r, c.lane, v); const float rs = rsqrtf(ss * (1.0f / 1024.0f) + 1e-6f);
#pragma unroll
        for (int i = 0; i < 4; ++i) { const f32x4 gg = *(const f32x4*)(p.norm_g + DM + i * 256 + c.lane * 4);
            *(f32x4*)(p.out + grow * DM + i * 256 + c.lane * 4) = v[i];
            u32x2 w; w.x = pk2(v[i][0] * rs * gg[0], v[i][1] * rs * gg[1]); w.y = pk2(v[i][2] * rs * gg[2], v[i][3] * rs * gg[3]);
            *(u32x2*)(H + (size_t)r * DM + i * 256 + c.lane * 4) = w; } }
}
__device__ __forceinline__ void phase_b5(const P& p, const Ctx& c, int seg) {
    const bf16_t* slab = (const bf16_t*)(c.seg + S1_SLAB);
    for (int r = c.bid * 8 + c.wv; r < MS; r += c.G * 8) { const int b = r >> 9, tl = r & 511; float* row = p.out + ((size_t)b * SEQ + seg * SEGT + tl) * DM;
        f32x4 v[4]; const float ss = add_slabs(row, slab, r, c.lane, v); const float rs = rsqrtf(ss * (1.0f / 1024.0f) + 1e-6f);
#pragma unroll
        for (int i = 0; i < 4; ++i) { const f32x4 gg = *(const f32x4*)(p.final_g + i * 256 + c.lane * 4); f32x4 o;
            o[0] = v[i][0] * rs * gg[0]; o[1] = v[i][1] * rs * gg[1]; o[2] = v[i][2] * rs * gg[2]; o[3] = v[i][3] * rs * gg[3]; *(f32x4*)(row + i * 256 + c.lane * 4) = o; } }
}

__device__ __forceinline__ void phase0(const P& p, const Ctx& c) {
    const int T0 = 16 * 64, T1 = 16 * 120, T2 = 32 * 16, T3 = 32 * 16, T4 = 16 * 16, T5 = 16 * 16, T6 = 24 * 5;
    const int TT = T0 + T1 + T2 + T3 + T4 + T5 + T6;
    for (int t = c.bid; t < TT; t += c.G) {
        int u = t;
        if (u < T0) { convT_tile<0>(c, p.ml_w_in, ML_W, 1024, (u & 15) * 64, (u >> 4) * 64, (bf16_t*)(p.ws + OFF_WT0), 1024, 0); continue; } u -= T0;
        if (u < T1) { convT_tile<1>(c, p.rw_w_in, RW_W, 1024, (u & 15) * 64, (u >> 4) * 64, (bf16_t*)(p.ws + OFF_WT1), 1024, 0); continue; } u -= T1;
        if (u < T2) { convT_tile<0>(c, p.w_out, DM, 2048, (u & 31) * 64, (u >> 5) * 64, (bf16_t*)(p.ws + OFF_WO0T), 2048, 0); continue; } u -= T2;
        if (u < T3) { convT_tile<0>(c, p.w_out + (size_t)DIN * DM, DM, 2048, (u & 31) * 64, (u >> 5) * 64, (bf16_t*)(p.ws + OFF_WO1T), 2048, 0); continue; } u -= T3;
        if (u < T4) { convT_tile<0>(c, p.mem_kv_w, DM, 1024, (u & 15) * 64, (u >> 4) * 64, (bf16_t*)(p.ws + OFF_WKVT), 1024, 0); continue; } u -= T4;
        if (u < T5) { convT_tile<0>(c, p.mem_kv_w + (size_t)DM * DM, DM, 1024, (u & 15) * 64, (u >> 4) * 64, (bf16_t*)(p.ws + OFF_WKVT + 2 * MiB), 1024, 0); continue; } u -= T5;
        { const int nt = u / 5, j = u % 5; bf16_t* L = (bf16_t*)(p.ws + OFF_LORAT);
          if (j == 0) convT_tile<0>(c, p.rw_w_lora2, DMIX, 64, 0, nt * 64, L, 288, 0);
          else if (j == 1) convT_tile<0>(c, p.rw_a_lora2, DMIX, 64, 0, nt * 64, L, 288, 64);
          else if (j == 2) convT_tile<0>(c, p.rw_v_lora2, DMIX, 32, 0, nt * 64, L, 288, 128);
          else convT_tile<0>(c, p.rw_g_lora2, DMIX, 128, (j - 3) * 64, nt * 64, L, 288, 160); }
    }
    for (int r = c.bid * 8 + c.wv; r < 2 * 2048; r += c.G * 8) { const int l = r >> 11, rr = r & 2047;
        rms_row_bf16(p.mem + (size_t)rr * DM, p.mem_norm_g + l * DM, (bf16_t*)(p.ws + OFF_MEMN) + (size_t)r * DM, c.lane); }
}

struct SchedA0 {
    const unsigned char* ws; unsigned char* seg; int G, c, nextra;
    __device__ __forceinline__ bool next(int i, pg8::Unit& u) const {
        const int L = i * G + c; if (L >= 256 + nextra) return false;
        if (L < 256) { int pm, pn; pg8::remap(L, 16, 16, pm, pn);
            u.A = (const char*)(ws + OFF_H) + (size_t)pm * 256 * 1024 * 2; u.B = (const char*)(ws + OFF_WT0) + (size_t)pn * 256 * 1024 * 2;
            u.O = (char*)(seg + S0_P0) + ((size_t)pm * 256 * ML_W + pn * 256) * 2; u.ldc = ML_W; return true; }
        const int e = L - 256, l = e >> 5, j = e & 31;
        const char* memn = (const char*)(ws + OFF_MEMN) + (size_t)l * 2048 * 1024 * 2; const char* wkv = (const char*)(ws + OFF_WKVT) + (size_t)l * 2 * MiB;
        char* kout = (char*)(ws + OFF_KMEM) + (size_t)l * 4 * MiB;
        if (j < 16) { const int pm = j >> 1, pn = j & 1;
            u.A = memn + (size_t)pm * 256 * 1024 * 2; u.B = wkv + (size_t)pn * 256 * 1024 * 2; u.O = kout + ((size_t)pm * 256 * 512 + pn * 256) * 2; u.ldc = 512; }
        else { const int jj = j - 16, pm = jj >> 3, pn = jj & 7;
            u.A = wkv + (size_t)(512 + pm * 256) * 1024 * 2; u.B = memn + (size_t)pn * 256 * 1024 * 2; u.O = kout + 2 * MiB + ((size_t)pm * 256 * 2048 + pn * 256) * 2; u.ldc = 2048; }
        return true;
    }
};
struct SchedB0 {
    const unsigned char* ws; unsigned char* seg; int G, c;
    __device__ __forceinline__ bool next(int i, pg8::Unit& u) const {
        const int L = i * G + c; if (L >= 480) return false;
        int pm, pn; pg8::remap(L, 16, 30, pm, pn);
        u.A = (const char*)(ws + OFF_H) + (size_t)pm * 256 * 1024 * 2; u.B = (const char*)(ws + OFF_WT1) + (size_t)pn * 256 * 1024 * 2;
        if (pn < 20) { u.O = (char*)(seg + S1_P1) + ((size_t)pm * 256 * P1W + pn * 256) * 2; u.ldc = P1W; }
        else { u.O = (char*)(seg + S1_P2) + ((size_t)pm * 256 * P2W + (pn - 20) * 256) * 2; u.ldc = P2W; }
        return true;
    }
};
struct SchedOut {
    const char* Y; const char* W; char* slab; int G, c;
    __device__ __forceinline__ bool next(int i, pg8::Unit& u) const {
        const int L = i * G + c; if (L >= 256) return false;
        const int ks = L >> 6; int pm, pn; pg8::remap(L & 63, 16, 4, pm, pn);
        u.A = Y + ((size_t)pm * 256 * DIN + ks * 512) * 2; u.B = W + ((size_t)pn * 256 * DIN + ks * 512) * 2;
        u.O = slab + (((size_t)ks * MS + pm * 256) * DM + pn * 256) * 2; u.ldc = DM; return true;
    }
};

__device__ __forceinline__ void phase_a1(const P& p, const Ctx& c, int seg) {
    const bf16_t* P0 = (const bf16_t*)(c.seg + S0_P0);
    bf16_t* Qb = (bf16_t*)(c.seg + S0_Q); bf16_t* Kb = (bf16_t*)(c.seg + S0_K); bf16_t* KT = (bf16_t*)(c.seg + S0_KT); bf16_t* VT = (bf16_t*)(c.seg + S0_VT);
    bf16_t* XC = (bf16_t*)(c.seg + S0_XC); bf16_t* VF = (bf16_t*)(p.ws + OFF_VF);
    float* IPRE = (float*)(c.seg + S0_GATE); float* LOGF = IPRE + 32 * SEGT;
    const bf16_t* UT = (const bf16_t*)(p.ws + OFF_UTAIL);
    LAS float* red = (LAS float*)c.lds;
    LAS bf16_t* kst = (LAS bf16_t*)(c.lds + 98304);
    LAS bf16_t* vst = kst + 1536 * 8;
    const int n = c.tid;
    float wq[4][4], wk[4][4], wv[4][4], G12[4][8], G3[4][8];
    if (n < 384) {
#pragma unroll
        for (int i = 0; i < 4; ++i) { const f32x4 a = *(const f32x4*)(p.ml_wq + n * 16 + i * 4), bb = *(const f32x4*)(p.ml_wk + n * 16 + i * 4), cc = *(const f32x4*)(p.ml_wv + n * 16 + i * 4);
#pragma unroll
            for (int o = 0; o < 4; ++o) { wq[i][o] = a[o]; wk[i][o] = bb[o]; wv[i][o] = cc[o]; } }
#pragma unroll
        for (int i = 0; i < 4; ++i)
#pragma unroll
            for (int g = 0; g < 8; ++g) { G12[i][g] = 0.f; G3[i][g] = 0.f; }
#pragma unroll
        for (int o = 0; o < 4; ++o) {
            const float* gq = p.ml_w_gate + (size_t)(n * 4 + o) * 8; const float* gk = p.ml_w_gate + (size_t)(DMIX + n * 4 + o) * 8; const float* gv = p.ml_w_gate + (size_t)(2 * DMIX + n * 4 + o) * 8;
            const f32x4 q0 = *(const f32x4*)gq, q1 = *(const f32x4*)(gq + 4), k0 = *(const f32x4*)gk, k1 = *(const f32x4*)(gk + 4), v0 = *(const f32x4*)gv, v1 = *(const f32x4*)(gv + 4);
#pragma unroll
            for (int i = 0; i < 4; ++i)
#pragma unroll
                for (int g = 0; g < 4; ++g) { G12[i][g] += wq[i][o] * q0[g] + wk[i][o] * k0[g]; G12[i][g + 4] += wq[i][o] * q1[g] + wk[i][o] * k1[g];
                    G3[i][g] += wv[i][o] * v0[g]; G3[i][g + 4] += wv[i][o] * v1[g]; }
        }
    }
#pragma unroll 1
    for (int it = c.bid; it < MS / 8; it += c.G) {
        const int row0 = it * 8, b = row0 >> 9, tl0 = row0 & 511;
        __syncthreads();
        if (n < 384) {
            float um[3][4];
#pragma unroll
            for (int j = 1; j <= 3; ++j) { u32x2 raw = (u32x2){0u, 0u};
                if (tl0 - j >= 0) raw = *(const u32x2*)(P0 + (unsigned)((row0 - j) * ML_W + n * 4));
                else if (seg > 0) raw = *(const u32x2*)(UT + (unsigned)((b * 3 + (3 - j)) * DMIX + n * 4));
                um[3 - j][0] = bflo(raw.x); um[3 - j][1] = bfhi(raw.x); um[3 - j][2] = bflo(raw.y); um[3 - j][3] = bfhi(raw.y); }
#pragma unroll 1
            for (int tt = 0; tt < 8; ++tt) {
                const unsigned row = (unsigned)(row0 + tt);
                const u32x2 raw = *(const u32x2*)(P0 + (unsigned)(row * ML_W + n * 4));
                float u[4] = {bflo(raw.x), bfhi(raw.x), bflo(raw.y), bfhi(raw.y)}, xc[4], q[4], k[4], v[4];
                { int nn = n; asm volatile("" : "+v"(nn));
                  const f32x4 cb = *(const f32x4*)(p.ml_conv_b + nn * 4), c0 = *(const f32x4*)(p.ml_conv_w + nn * 4), c1 = *(const f32x4*)(p.ml_conv_w + DMIX + nn * 4),
                              c2 = *(const f32x4*)(p.ml_conv_w + 2 * DMIX + nn * 4), c3 = *(const f32x4*)(p.ml_conv_w + 3 * DMIX + nn * 4);
#pragma unroll
                  for (int i = 0; i < 4; ++i) { const float y = cb[i] + c0[i] * um[0][i] + c1[i] * um[1][i] + c2[i] * um[2][i] + c3[i] * u[i]; xc[i] = siluf_(y); } }
                const float ks = 0.05103103630798288f;
#pragma unroll
                for (int o = 0; o < 4; ++o) { q[o] = xc[0] * wq[0][o] + xc[1] * wq[1][o] + xc[2] * wq[2][o] + xc[3] * wq[3][o];
                    k[o] = (xc[0] * wk[0][o] + xc[1] * wk[1][o] + xc[2] * wk[2][o] + xc[3] * wk[3][o]) * ks;
                    v[o] = u[0] * wv[0][o] + u[1] * wv[1][o] + u[2] * wv[2][o] + u[3] * wv[3][o]; }
#pragma unroll
                for (int g = 0; g < 8; ++g) red[(tt * 8 + g) * 384 + n] = xc[0] * G12[0][g] + xc[1] * G12[1][g] + xc[2] * G12[2][g] + xc[3] * G12[3][g] + u[0] * G3[0][g] + u[1] * G3[1][g] + u[2] * G3[2][g] + u[3] * G3[3][g];
                u32x2 w; w.x = pk2(q[0], q[1]); w.y = pk2(q[2], q[3]); *(u32x2*)(Qb + (unsigned)(row * DMIX + n * 4)) = w;
                w.x = pk2(k[0], k[1]); w.y = pk2(k[2], k[3]); *(u32x2*)(Kb + (unsigned)(row * DMIX + n * 4)) = w;
                w.x = pk2(xc[0], xc[1]); w.y = pk2(xc[2], xc[3]); *(u32x2*)(XC + (unsigned)(row * DMIX + n * 4)) = w;
                w.x = pk2(v[0], v[1]); w.y = pk2(v[2], v[3]); *(u32x2*)(VF + (unsigned)(row * DMIX + n * 4)) = w;
#pragma unroll
                for (int o = 0; o < 4; ++o) { kst[(n * 4 + o) * 8 + tt] = f2bf(k[o]); vst[(n * 4 + o) * 8 + tt] = f2bf(v[o]); }
#pragma unroll
                for (int i = 0; i < 4; ++i) { um[0][i] = um[1][i]; um[1][i] = um[2][i]; um[2][i] = u[i]; }
            }
            const int hd = n / 96, dch = (n % 96) * 4;
#pragma unroll
            for (int o = 0; o < 4; ++o) { const unsigned off = (unsigned)(((b * 4 + hd) * 384 + dch + o) * SEGT + tl0);
                *(u32x4*)(KT + off) = *(const LAS u32x4*)(kst + (n * 4 + o) * 8); *(u32x4*)(VT + off) = *(const LAS u32x4*)(vst + (n * 4 + o) * 8); }
        }
        __syncthreads();
        { const int v = c.tid >> 3, part = c.tid & 7; float s = 0.f;
#pragma unroll 8
          for (int i = 0; i < 48; ++i) s += red[v * 384 + part * 48 + i];
          s += __shfl_xor(s, 1); s += __shfl_xor(s, 2); s += __shfl_xor(s, 4);
          if (part == 0) { const int tt = v >> 3, g = v & 7; const float gate = s + p.ml_b_gate[g];
              if (g < 4) IPRE[(b * 4 + g) * SEGT + tl0 + tt] = gate; else LOGF[(b * 4 + g - 4) * SEGT + tl0 + tt] = -softplusf_(-gate); } }
    }
}

__device__ __forceinline__ void attn_item(const P& p, const Ctx& c, int layer, int it, const bf16_t* Qp, int ldq, bf16_t* YM) {
    const int b = it >> 3, head = (it >> 1) & 3, qb = it & 1;
    const bf16_t* Kg = (const bf16_t*)(p.ws + OFF_KMEM + (size_t)layer * 4 * MiB) + (size_t)(b * 256) * 512 + head * 128;
    const bf16_t* Vg = (const bf16_t*)(p.ws + OFF_KMEM + (size_t)layer * 4 * MiB + 2 * MiB) + (size_t)(head * 128) * 2048 + b * 256;
    LAS bf16_t* Ks = (LAS bf16_t*)c.lds;
    LAS bf16_t* Vs = Ks + 256 * 136;
    const int l15 = c.lane & 15, quad = c.lane >> 4;
    __syncthreads();
#pragma unroll
    for (int r = 0; r < 8; ++r) { const int id = c.tid + 512 * r; { const int i = id >> 4, c8 = (id & 15) * 8; *(LAS u32x4*)(Ks + i * 136 + c8) = *(const u32x4*)(Kg + (size_t)i * 512 + c8); }
        { const int i = id >> 5, c8 = (id & 31) * 8; *(LAS u32x4*)(Vs + i * 264 + c8) = *(const u32x4*)(Vg + (size_t)i * 2048 + c8); } }
    __syncthreads();
#pragma unroll 1
    for (int pass = 0; pass < 2; ++pass) {
        const int row0 = b * SEGT + qb * 256 + c.wv * 32 + pass * 16;
        bf16x8 qf[4];
#pragma unroll
        for (int kk = 0; kk < 4; ++kk) qf[kk] = *(const bf16x8*)(Qp + (size_t)(row0 + l15) * ldq + head * 128 + kk * 32 + quad * 8);
        f32x4 acc[16];
#pragma unroll
        for (int mt = 0; mt < 16; ++mt) { acc[mt] = (f32x4){0.f, 0.f, 0.f, 0.f};
#pragma unroll
            for (int kk = 0; kk < 4; ++kk) { const bf16x8 a = *(const LAS bf16x8*)(Ks + (mt * 16 + l15) * 136 + kk * 32 + quad * 8); acc[mt] = mfma16(a, qf[kk], acc[mt]); }
            if ((mt & 3) == 3) __builtin_amdgcn_sched_barrier(0); }
        float mx = -1e30f;
#pragma unroll
        for (int mt = 0; mt < 16; ++mt)
#pragma unroll
            for (int j = 0; j < 4; ++j) mx = fmaxf(mx, acc[mt][j]);
        mx = fmaxf(mx, __shfl_xor(mx, 16)); mx = fmaxf(mx, __shfl_xor(mx, 32));
        const float sc = 0.08838834764831845f * 1.4426950408889634f; float sm = 0.f;
#pragma unroll
        for (int mt = 0; mt < 16; ++mt)
#pragma unroll
            for (int j = 0; j < 4; ++j) { const float e = exp2f((acc[mt][j] - mx) * sc); acc[mt][j] = e; sm += e; }
        sm += __shfl_xor(sm, 16); sm += __shfl_xor(sm, 32);
        const float inv = 1.0f / sm;
        bf16x8 pa[8];
#pragma unroll
        for (int kp = 0; kp < 8; ++kp) {
            u32x4 aw; aw.x = pk2(acc[2 * kp][0] * inv, acc[2 * kp][1] * inv); aw.y = pk2(acc[2 * kp][2] * inv, acc[2 * kp][3] * inv);
            aw.z = pk2(acc[2 * kp + 1][0] * inv, acc[2 * kp + 1][1] * inv); aw.w = pk2(acc[2 * kp + 1][2] * inv, acc[2 * kp + 1][3] * inv);
            __builtin_memcpy(&pa[kp], &aw, 16); }
        __builtin_amdgcn_sched_barrier(0);
        f32x4 o[8];
#pragma unroll
        for (int nt = 0; nt < 8; ++nt) o[nt] = (f32x4){0.f, 0.f, 0.f, 0.f};
#pragma unroll
        for (int kp = 0; kp < 8; ++kp) {
            const bf16x8 a = pa[kp];
#pragma unroll
            for (int nt = 0; nt < 8; ++nt) { const LAS bf16_t* vp = Vs + (nt * 16 + l15) * 264 + 2 * kp * 16 + quad * 4;
                const u32x2 lo = *(const LAS u32x2*)vp, hi = *(const LAS u32x2*)(vp + 16); u32x4 bw = (u32x4){lo.x, lo.y, hi.x, hi.y}; bf16x8 bfr; __builtin_memcpy(&bfr, &bw, 16);
                o[nt] = mfma16(a, bfr, o[nt]); }
            __builtin_amdgcn_sched_barrier(0);
        }
#pragma unroll
        for (int nt = 0; nt < 8; ++nt)
#pragma unroll
            for (int j = 0; j < 4; ++j) YM[(size_t)(row0 + quad * 4 + j) * DX + head * 128 + nt * 16 + l15] = f2bf(o[nt][j]);
    }
}

__device__ __forceinline__ void mlstm_item(const P& p, const Ctx& c, int seg, int w, bool save) {
    const int b = w / 24, h = (w / 6) & 3, sl = w % 6;
    const bf16_t* Qb = (const bf16_t*)(c.seg + S0_Q); const bf16_t* Kb = (const bf16_t*)(c.seg + S0_K); const bf16_t* KT = (const bf16_t*)(c.seg + S0_KT); const bf16_t* VT = (const bf16_t*)(c.seg + S0_VT);
    const float* IPRE = (const float*)(c.seg + S0_GATE); const float* LOGF = IPRE + 32 * SEGT;
    float* HR = (float*)(c.seg + S0_HRAW);
    float* CST = (float*)(p.ws + OFF_CST) + (size_t)w * 64 * 384; float* NST = (float*)(p.ws + OFF_NST) + (size_t)w * 384;
    LAS bf16_t* Cimg = (LAS bf16_t*)c.lds;
    LAS bf16_t* Qs = Cimg + 64 * 392;
    LAS bf16_t* Ks = Qs + 64 * 136;
    LAS bf16_t* KTs = Ks + 64 * 136;
    LAS bf16_t* VTs = KTs + 128 * 72;
    LAS bf16_t* VWs = VTs + 64 * 72;
    LAS bf16_t* Sp = VWs + 64 * 72;
    LAS float* fl = (LAS float*)(Sp + 64 * 72);
    LAS float* bcum = fl; LAS float* ipr = fl + 64; LAS float* wgt = fl + 128; LAS float* gin = fl + 192; LAS float* qn = fl + 256; LAS float* rden = fl + 320;
    LAS float* gtotp = fl + 384; LAS float* nold = fl + 400; LAS float* nnew = fl + 800;
    const int l15c = c.lane & 15, quadc = c.lane >> 4, e16 = c.wv & 3, par = c.wv >> 2;
    f32x4 C[12];
    __syncthreads();
    if (seg > 0) {
#pragma unroll
        for (int j = 0; j < 12; ++j)
#pragma unroll
            for (int jj = 0; jj < 4; ++jj) C[j][jj] = CST[(size_t)(e16 * 16 + quadc * 4 + jj) * 384 + (2 * j + par) * 16 + l15c];
        if (c.tid < 384) nold[c.tid] = NST[c.tid];
    } else {
#pragma unroll
        for (int j = 0; j < 12; ++j) C[j] = (f32x4){0.f, 0.f, 0.f, 0.f};
        if (c.tid < 384) nold[c.tid] = 0.f;
    }
    u32x4 pq[2], pk[2], pt[2], pvt; float plf = 0.f, pip = 0.f;
    auto gl_piece = [&](int ch, int pp, int tidv) {
#pragma unroll
        for (int r = 0; r < 2; ++r) { const int id = tidv + 512 * r;
            { const int i = id >> 4, c8 = (id & 15) * 8; const size_t go = ((size_t)b * SEGT + ch * 64 + i) * DMIX + h * 384 + pp * 128 + c8; pq[r] = *(const u32x4*)(Qb + go); pk[r] = *(const u32x4*)(Kb + go); }
            { const int dd = id >> 3, c8 = (id & 7) * 8; pt[r] = *(const u32x4*)(KT + ((size_t)(b * 4 + h) * 384 + pp * 128 + dd) * SEGT + ch * 64 + c8); } } };
    auto gl_chunk = [&](int ch, int tidv) { const int i = tidv >> 3, c8 = (tidv & 7) * 8;
        pvt = *(const u32x4*)(VT + ((size_t)(b * 4 + h) * 384 + sl * 64 + i) * SEGT + ch * 64 + c8);
        if (c.wv == 0) { plf = LOGF[(b * 4 + h) * SEGT + ch * 64 + c.lane]; pip = IPRE[(b * 4 + h) * SEGT + ch * 64 + c.lane]; } };
    { int t0 = c.tid; asm volatile("" : "+v"(t0)); gl_chunk(0, t0); gl_piece(0, 0, t0); }
#pragma unroll 1
    for (int ch = 0; ch < 8; ++ch) {
        const int tl0 = ch * 64; const size_t row0 = (size_t)b * SEGT + tl0;
        int tidv = c.tid, l15 = l15c, quad = quadc;
        asm volatile("" : "+v"(tidv), "+v"(l15), "+v"(quad));
        lds_barrier();
        if (c.wv == 0) {
            float bc = plf;
#pragma unroll
            for (int o = 1; o < 64; o <<= 1) { const float t = __shfl_up(bc, o); if (c.lane >= o) bc += t; }
            const float bl = __shfl(bc, 63);
            bcum[c.lane] = bc; ipr[c.lane] = pip; wgt[c.lane] = __expf(bl - bc + pip); gin[c.lane] = __expf(bc);
            if (c.lane == 0) gtotp[0] = __expf(bl);
        }
#pragma unroll
        for (int j = 0; j < 12; ++j)
#pragma unroll
            for (int jj = 0; jj < 4; ++jj) Cimg[(e16 * 16 + quad * 4 + jj) * 392 + (2 * j + par) * 16 + l15] = f2bf(C[j][jj]);
        lds_barrier();
        { const int i = tidv >> 3, c8 = (tidv & 7) * 8;
          const u32x4 raw = pvt;
          *(LAS u32x4*)(VTs + i * 72 + c8) = raw;
          const f32x4 w0 = *(const LAS f32x4*)(wgt + c8), w1 = *(const LAS f32x4*)(wgt + c8 + 4);
          u32x4 sw; sw.x = pk2(bflo(raw.x) * w0[0], bfhi(raw.x) * w0[1]); sw.y = pk2(bflo(raw.y) * w0[2], bfhi(raw.y) * w0[3]);
          sw.z = pk2(bflo(raw.z) * w1[0], bfhi(raw.z) * w1[1]); sw.w = pk2(bflo(raw.w) * w1[2], bfhi(raw.w) * w1[3]);
          *(LAS u32x4*)(VWs + i * 72 + c8) = sw; }
        if (ch + 1 < 8) gl_chunk(ch + 1, tidv);
        const float gtot = gtotp[0];
#pragma unroll
        for (int j = 0; j < 12; ++j) C[j] *= gtot;
        f32x4 Sa[2], Ia[2]; Sa[0] = Sa[1] = Ia[0] = Ia[1] = (f32x4){0.f, 0.f, 0.f, 0.f};
        float qnacc = 0.f;
#pragma unroll
        for (int pp = 0; pp < 3; ++pp) {
            const int d0 = pp * 128;
            __builtin_amdgcn_sched_barrier(0);
            asm volatile("" : "+v"(tidv));
            lds_barrier();
#pragma unroll
            for (int r = 0; r < 2; ++r) { const int id = tidv + 512 * r;
                { const int i = id >> 4, c8 = (id & 15) * 8; *(LAS u32x4*)(Qs + i * 136 + c8) = pq[r]; *(LAS u32x4*)(Ks + i * 136 + c8) = pk[r]; }
                { const int dd = id >> 3, c8 = (id & 7) * 8; *(LAS u32x4*)(KTs + dd * 72 + c8) = pt[r]; } }
            lds_barrier();
            if (pp < 2) gl_piece(ch, pp + 1, tidv); else if (ch + 1 < 8) gl_piece(ch + 1, 0, tidv);
#pragma unroll
            for (int x = 0; x < 2; ++x) { const int ti = c.wv * 2 + x, tm = ti >> 2, tn = ti & 3;
#pragma unroll
                for (int kk = 0; kk < 4; ++kk) { const bf16x8 a = *(const LAS bf16x8*)(Qs + (tm * 16 + l15) * 136 + kk * 32 + quad * 8);
                    const bf16x8 bk = *(const LAS bf16x8*)(Ks + (tn * 16 + l15) * 136 + kk * 32 + quad * 8);
                    const bf16x8 bc = *(const LAS bf16x8*)(Cimg + (tn * 16 + l15) * 392 + d0 + kk * 32 + quad * 8);
                    Sa[x] = mfma16(a, bk, Sa[x]); Ia[x] = mfma16(a, bc, Ia[x]); } }
#pragma unroll
            for (int jl = 0; jl < 4; ++jl) { const int ntl = 2 * jl + par, j = pp * 4 + jl;
#pragma unroll
                for (int kk = 0; kk < 2; ++kk) { const bf16x8 a = *(const LAS bf16x8*)(VWs + (e16 * 16 + l15) * 72 + kk * 32 + quad * 8);
                    const bf16x8 bb = *(const LAS bf16x8*)(KTs + (ntl * 16 + l15) * 72 + kk * 32 + quad * 8); C[j] = mfma16(a, bb, C[j]); } }
            { const int t = tidv >> 3, part = tidv & 7;
              const u32x4 q0 = *(const LAS u32x4*)(Qs + t * 136 + part * 16), q1 = *(const LAS u32x4*)(Qs + t * 136 + part * 16 + 8);
              const LAS float* np = nold + d0 + part * 16; const f32x4 n0 = *(const LAS f32x4*)np, n1 = *(const LAS f32x4*)(np + 4), n2 = *(const LAS f32x4*)(np + 8), n3 = *(const LAS f32x4*)(np + 12);
              qnacc += bflo(q0.x) * n0[0] + bfhi(q0.x) * n0[1] + bflo(q0.y) * n0[2] + bfhi(q0.y) * n0[3] + bflo(q0.z) * n1[0] + bfhi(q0.z) * n1[1] + bflo(q0.w) * n1[2] + bfhi(q0.w) * n1[3]
                     + bflo(q1.x) * n2[0] + bfhi(q1.x) * n2[1] + bflo(q1.y) * n2[2] + bfhi(q1.y) * n2[3] + bflo(q1.z) * n3[0] + bfhi(q1.z) * n3[1] + bflo(q1.w) * n3[2] + bfhi(q1.w) * n3[3]; }
            { const int dd = tidv >> 2, part = tidv & 3;
              const u32x4 k0 = *(const LAS u32x4*)(KTs + dd * 72 + part * 16), k1 = *(const LAS u32x4*)(KTs + dd * 72 + part * 16 + 8);
              const LAS float* wp = wgt + part * 16; const f32x4 w0 = *(const LAS f32x4*)wp, w1 = *(const LAS f32x4*)(wp + 4), w2 = *(const LAS f32x4*)(wp + 8), w3 = *(const LAS f32x4*)(wp + 12);
              float a = bflo(k0.x) * w0[0] + bfhi(k0.x) * w0[1] + bflo(k0.y) * w0[2] + bfhi(k0.y) * w0[3] + bflo(k0.z) * w1[0] + bfhi(k0.z) * w1[1] + bflo(k0.w) * w1[2] + bfhi(k0.w) * w1[3]
                      + bflo(k1.x) * w2[0] + bfhi(k1.x) * w2[1] + bflo(k1.y) * w2[2] + bfhi(k1.y) * w2[3] + bflo(k1.z) * w3[0] + bfhi(k1.z) * w3[1] + bflo(k1.w) * w3[2] + bfhi(k1.w) * w3[3];
              a = dpp_add<0xB1>(a); a = dpp_add<0x4E>(a);
              if (part == 0) nnew[d0 + dd] = gtot * nold[d0 + dd] + a; }
        }
        qnacc = dpp_add<0xB1>(qnacc); qnacc = dpp_add<0x4E>(qnacc); qnacc = dpp_add<0x141>(qnacc);
        if ((tidv & 7) == 0) qn[tidv >> 3] = qnacc;
#pragma unroll
        for (int x = 0; x < 2; ++x) { const int ti = c.wv * 2 + x, tm = ti >> 2, tn = ti & 3; const int s = tn * 16 + l15; const float bs = bcum[s] - ipr[s];
#pragma unroll
            for (int jj = 0; jj < 4; ++jj) { const int t = tm * 16 + quad * 4 + jj; const float v = (s <= t) ? Sa[x][jj] * __expf(bcum[t] - bs) : 0.f; Sp[t * 72 + s] = f2bf(v); } }
        lds_barrier();
        { const int t = tidv >> 3, part = tidv & 7; const u32x4 sr = *(const LAS u32x4*)(Sp + t * 72 + part * 8);
          float ds = bflo(sr.x) + bfhi(sr.x) + bflo(sr.y) + bfhi(sr.y) + bflo(sr.z) + bfhi(sr.z) + bflo(sr.w) + bfhi(sr.w);
          ds = dpp_add<0xB1>(ds); ds = dpp_add<0x4E>(ds); ds = dpp_add<0x141>(ds);
          if (part == 0) { const float den = ds + gin[t] * qn[t]; rden[t] = 1.0f / fmaxf(fabsf(den), 1.0f); } }
#pragma unroll
        for (int x = 0; x < 2; ++x) { const int ti = c.wv * 2 + x, tm = ti >> 2, tn = ti & 3;
#pragma unroll
            for (int jj = 0; jj < 4; ++jj) Ia[x][jj] *= gin[tm * 16 + quad * 4 + jj];
#pragma unroll
            for (int kk = 0; kk < 2; ++kk) { const bf16x8 a = *(const LAS bf16x8*)(Sp + (tm * 16 + l15) * 72 + kk * 32 + quad * 8);
                const bf16x8 bb = *(const LAS bf16x8*)(VTs + (tn * 16 + l15) * 72 + kk * 32 + quad * 8); Ia[x] = mfma16(a, bb, Ia[x]); } }
        lds_barrier();
#pragma unroll
        for (int x = 0; x < 2; ++x) { const int ti = c.wv * 2 + x, tm = ti >> 2, tn = ti & 3;
#pragma unroll
            for (int jj = 0; jj < 4; ++jj) { const int t = tm * 16 + quad * 4 + jj; HR[(row0 + t) * DMIX + h * 384 + sl * 64 + tn * 16 + l15] = Ia[x][jj] * rden[t]; } }
        if (c.tid < 384) nold[c.tid] = nnew[c.tid];
    }
    lds_barrier();
    if (!save) return;
#pragma unroll
    for (int j = 0; j < 12; ++j)
#pragma unroll
        for (int jj = 0; jj < 4; ++jj) CST[(size_t)(e16 * 16 + quadc * 4 + jj) * 384 + (2 * j + par) * 16 + l15c] = C[j][jj];
    if (c.tid < 384) NST[c.tid] = nold[c.tid];
}

__device__ __forceinline__ void phase_a3(const P& p, const Ctx& c, int seg) {
    const bf16_t* P0 = (const bf16_t*)(c.seg + S0_P0); const float* HR = (const float*)(c.seg + S0_HRAW); const bf16_t* XC = (const bf16_t*)(c.seg + S0_XC);
    const bf16_t* YM = (const bf16_t*)(c.seg + S0_YMEM); bf16_t* Y = (bf16_t*)(c.seg + S0_Y); bf16_t* UT = (bf16_t*)(p.ws + OFF_UTAIL);
#pragma unroll 1
    for (int r = c.bid * 8 + c.wv; r < MS; r += c.G * 8) {
        const int b = r >> 9, tl = r & 511;
        float v[3][8]; float mean[3], rstd[3];
#pragma unroll
        for (int ps = 0; ps < 3; ++ps) { const int ch = ps * 512 + c.lane * 8;
            const f32x4 a0 = *(const f32x4*)(HR + (size_t)r * DMIX + ch), a1 = *(const f32x4*)(HR + (size_t)r * DMIX + ch + 4);
            v[ps][0] = a0[0]; v[ps][1] = a0[1]; v[ps][2] = a0[2]; v[ps][3] = a0[3]; v[ps][4] = a1[0]; v[ps][5] = a1[1]; v[ps][6] = a1[2]; v[ps][7] = a1[3]; }
        float hs[4], hq[4];
#pragma unroll
        for (int hd = 0; hd < 4; ++hd) { float s = 0.f, q = 0.f;
#pragma unroll
            for (int ps = 0; ps < 3; ++ps) { if (ps * 512 + 511 < hd * 384 || ps * 512 >= (hd + 1) * 384) continue;
                const bool mine = ((ps * 512 + c.lane * 8) / 384) == hd;
                float ls = 0.f, lq = 0.f;
#pragma unroll
                for (int j = 0; j < 8; ++j) { ls += v[ps][j]; lq += v[ps][j] * v[ps][j]; }
                s += mine ? ls : 0.f; q += mine ? lq : 0.f; }
            hs[hd] = wsum(s); hq[hd] = wsum(q); }
#pragma unroll
        for (int ps = 0; ps < 3; ++ps) { const int hd = (ps * 512 + c.lane * 8) / 384;
            const float s = hd == 0 ? hs[0] : (hd == 1 ? hs[1] : (hd == 2 ? hs[2] : hs[3])), q = hd == 0 ? hq[0] : (hd == 1 ? hq[1] : (hd == 2 ? hq[2] : hq[3]));
            const float m = s * (1.0f / 384.0f); mean[ps] = m; rstd[ps] = rsqrtf(fmaxf(q * (1.0f / 384.0f) - m * m, 0.f) + 1e-5f); }
#pragma unroll
        for (int ps = 0; ps < 3; ++ps) { const int ch = ps * 512 + c.lane * 8;
            const u32x4 xr = *(const u32x4*)(XC + (size_t)r * DMIX + ch), zr = *(const u32x4*)(P0 + (size_t)r * ML_W + 2048 + ch);
            const f32x4 g0 = *(const f32x4*)(p.ml_mhn_g + ch), g1 = *(const f32x4*)(p.ml_mhn_g + ch + 4), k0 = *(const f32x4*)(p.ml_skip + ch), k1 = *(const f32x4*)(p.ml_skip + ch + 4);
            const float xx[8] = {bflo(xr.x), bfhi(xr.x), bflo(xr.y), bfhi(xr.y), bflo(xr.z), bfhi(xr.z), bflo(xr.w), bfhi(xr.w)};
            const float zz[8] = {bflo(zr.x), bfhi(zr.x), bflo(zr.y), bfhi(zr.y), bflo(zr.z), bfhi(zr.z), bflo(zr.w), bfhi(zr.w)};
            const float gg[8] = {g0[0], g0[1], g0[2], g0[3], g1[0], g1[1], g1[2], g1[3]}, kk[8] = {k0[0], k0[1], k0[2], k0[3], k1[0], k1[1], k1[2], k1[3]};
            float y[8];
#pragma unroll
            for (int j = 0; j < 8; ++j) y[j] = ((v[ps][j] - mean[ps]) * rstd[ps] * gg[j] + kk[j] * xx[j]) * siluf_(zz[j]);
            *(u32x4*)(Y + (size_t)r * DIN + ch) = (u32x4){pk2(y[0], y[1]), pk2(y[2], y[3]), pk2(y[4], y[5]), pk2(y[6], y[7])}; }
        { const int cm = c.lane * 8; const u32x4 mr = *(const u32x4*)(YM + (size_t)r * DX + cm), zr = *(const u32x4*)(P0 + (size_t)r * ML_W + 2048 + DMIX + cm);
          const float mm[8] = {bflo(mr.x), bfhi(mr.x), bflo(mr.y), bfhi(mr.y), bflo(mr.z), bfhi(mr.z), bflo(mr.w), bfhi(mr.w)};
          const float zz[8] = {bflo(zr.x), bfhi(zr.x), bflo(zr.y), bfhi(zr.y), bflo(zr.z), bfhi(zr.z), bflo(zr.w), bfhi(zr.w)};
          float y[8];
#pragma unroll
          for (int j = 0; j < 8; ++j) y[j] = mm[j] * siluf_(zz[j]);
          *(u32x4*)(Y + (size_t)r * DIN + DMIX + cm) = (u32x4){pk2(y[0], y[1]), pk2(y[2], y[3]), pk2(y[4], y[5]), pk2(y[6], y[7])}; }
        if (tl >= 509) {
#pragma unroll
            for (int ps = 0; ps < 3; ++ps) { const int ch = ps * 512 + c.lane * 8; *(u32x4*)(UT + (size_t)(b * 3 + tl - 509) * DMIX + ch) = *(const u32x4*)(P0 + (size_t)r * ML_W + ch); } }
    }
}

__device__ __forceinline__ void phase_b1(const P& p, const Ctx& c, int seg) {
    const bf16_t* P1 = (const bf16_t*)(c.seg + S1_P1);
    float* GTB = (float*)(c.seg + S1_W); bf16_t* SA = (bf16_t*)(c.seg + S1_A); bf16_t* SB = (bf16_t*)(c.seg + S1_B); bf16_t* SK = (bf16_t*)(c.seg + S1_K);
    bf16_t* SQ = (bf16_t*)(c.seg + S1_Q); bf16_t* SV = (bf16_t*)(c.seg + S1_V); bf16_t* SG = (bf16_t*)(c.seg + S1_G); float* BRKR = (float*)(c.seg + S1_BRKR);
    const bf16_t* VF = (const bf16_t*)(p.ws + OFF_VF); const bf16_t* LT = (const bf16_t*)(p.ws + OFF_LORAT);
    const bf16_t* PTr = (const bf16_t*)(p.ws + OFF_PTAIL) + (size_t)(seg & 1) * NB * RW_SHIFT; bf16_t* PTw = (bf16_t*)(p.ws + OFF_PTAIL) + (size_t)((seg + 1) & 1) * NB * RW_SHIFT;
    LAS bf16_t* XA = (LAS bf16_t*)c.lds;
    const int l15 = c.lane & 15, quad = c.lane >> 4;
    for (int it = c.bid; it < MS / 16; it += c.G) {
        const int r0 = it * 16, b = r0 >> 9, tl0 = r0 & 511;
        __syncthreads();
        for (int e = c.tid; e < 16 * 288; e += 512) { const int row = e / 288, cc = e % 288, col = 4608 + cc;
            const float cur = bf2f(P1[(size_t)(r0 + row) * P1W + col]);
            float prev = 0.f; if (tl0 + row > 0) prev = bf2f(P1[(size_t)(r0 + row - 1) * P1W + col]); else if (seg > 0) prev = bf2f(PTr[(size_t)b * RW_SHIFT + col]);
            const float pv = cur + p.rw_mu[col] * (prev - cur);
            const float f = cc < 64 ? tanhf(pv) : (cc < 160 ? pv : sigmoidf_(pv));
            XA[row * 296 + cc] = f2bf(f); }
        __syncthreads();
        bf16x8 xf[9];
#pragma unroll
        for (int k = 0; k < 9; ++k) xf[k] = *(const LAS bf16x8*)(XA + l15 * 296 + k * 32 + quad * 8);
        const size_t row = (size_t)r0 + l15; const int tl = tl0 + l15;
        const bf16_t* curp = P1 + row * P1W; const bf16_t* prevp = (tl > 0) ? (P1 + (row - 1) * P1W) : (PTr + (size_t)b * RW_SHIFT); const bool hasprev = (tl > 0) || (seg > 0);
        struct TileIn { u32x2 cr, ck, cv, pr, pk, pv, vf; };
        struct TilePar { f32x4 m0, m1, m2, w0, a0, v0, kkw, kaw, rk; };
#pragma unroll 1
        for (int x = 0; x < 3; ++x) {
            int hh = c.wv * 3 + x; asm volatile("" : "+s"(hh));
            auto load_tile = [&](int ct, TileIn& T) { const int cc = hh * 64 + ct * 16 + quad * 4;
                T.cr = *(const u32x2*)(curp + cc); T.ck = *(const u32x2*)(curp + DMIX + cc); T.cv = *(const u32x2*)(curp + 2 * DMIX + cc);
                T.pr = (u32x2){0u, 0u}; T.pk = T.pr; T.pv = T.pr;
                if (hasprev) { T.pr = *(const u32x2*)(prevp + cc); T.pk = *(const u32x2*)(prevp + DMIX + cc); T.pv = *(const u32x2*)(prevp + 2 * DMIX + cc); }
                T.vf = *(const u32x2*)(VF + row * DMIX + cc); };
            TileIn TA, TB2;
            load_tile(0, TA);
            float inv;
            { u32x2 kcur[4], kprv[4]; f32x4 km[4], kw[4];
#pragma unroll
              for (int ct = 0; ct < 4; ++ct) { const int cc = hh * 64 + ct * 16 + quad * 4;
                  kcur[ct] = *(const u32x2*)(curp + DMIX + cc); kprv[ct] = (u32x2){0u, 0u}; if (hasprev) kprv[ct] = *(const u32x2*)(prevp + DMIX + cc);
                  km[ct] = *(const f32x4*)(p.rw_mu + DMIX + cc); kw[ct] = *(const f32x4*)(p.rw_k_k + cc); }
              float ss = 0.f;
#pragma unroll
              for (int ct = 0; ct < 4; ++ct) {
                  const float cb[4] = {bflo(kcur[ct].x), bfhi(kcur[ct].x), bflo(kcur[ct].y), bfhi(kcur[ct].y)}, qb[4] = {bflo(kprv[ct].x), bfhi(kprv[ct].x), bflo(kprv[ct].y), bfhi(kprv[ct].y)};
#pragma unroll
                  for (int j = 0; j < 4; ++j) { const float kr = (cb[j] + km[ct][j] * (qb[j] - cb[j])) * kw[ct][j]; ss += kr * kr; } }
              ss += __shfl_xor(ss, 16); ss += __shfl_xor(ss, 32);
              inv = 1.0f / fmaxf(sqrtf(ss), 1e-12f); }
            float br = 0.f, kr = 0.f, rkr = 0.f;
            auto do_tile = [&](int ct, const TileIn& TI) { const int cc = hh * 64 + ct * 16 + quad * 4;
                TilePar T; T.m0 = *(const f32x4*)(p.rw_mu + cc); T.m1 = *(const f32x4*)(p.rw_mu + DMIX + cc); T.m2 = *(const f32x4*)(p.rw_mu + 2 * DMIX + cc);
                T.w0 = *(const f32x4*)(p.rw_w0 + cc); T.a0 = *(const f32x4*)(p.rw_a0 + cc); T.v0 = *(const f32x4*)(p.rw_v0 + cc); T.kkw = *(const f32x4*)(p.rw_k_k + cc); T.kaw = *(const f32x4*)(p.rw_k_a + cc);
                T.rk = *(const f32x4*)(p.rw_r_k + cc);
                bf16x8 lt[9]; { const bf16_t* lrow = LT + (size_t)(hh * 64 + ct * 16 + l15) * 288 + quad * 8;
#pragma unroll
                    for (int k = 0; k < 9; ++k) lt[k] = *(const bf16x8*)(lrow + k * 32); }
                f32x4 dw = (f32x4){0.f, 0.f, 0.f, 0.f}, da = dw, dv = dw, dg = dw;
#pragma unroll
                for (int k = 0; k < 2; ++k) dw = mfma16(lt[k], xf[k], dw);
#pragma unroll
                for (int k = 0; k < 2; ++k) da = mfma16(lt[2 + k], xf[2 + k], da);
                dv = mfma16(lt[4], xf[4], dv);
#pragma unroll
                for (int k = 0; k < 4; ++k) dg = mfma16(lt[5 + k], xf[5 + k], dg);
                const float ca[4] = {bflo(TI.cr.x), bfhi(TI.cr.x), bflo(TI.cr.y), bfhi(TI.cr.y)}, cb[4] = {bflo(TI.ck.x), bfhi(TI.ck.x), bflo(TI.ck.y), bfhi(TI.ck.y)}, cd[4] = {bflo(TI.cv.x), bfhi(TI.cv.x), bflo(TI.cv.y), bfhi(TI.cv.y)};
                const float qa[4] = {bflo(TI.pr.x), bfhi(TI.pr.x), bflo(TI.pr.y), bfhi(TI.pr.y)}, qb[4] = {bflo(TI.pk.x), bfhi(TI.pk.x), bflo(TI.pk.y), bfhi(TI.pk.y)}, qd[4] = {bflo(TI.pv.x), bfhi(TI.pv.x), bflo(TI.pv.y), bfhi(TI.pv.y)};
                const float vf[4] = {bflo(TI.vf.x), bfhi(TI.vf.x), bflo(TI.vf.y), bfhi(TI.vf.y)};
                u32x2 gw; gw.x = pk2(dg[0], dg[1]); gw.y = pk2(dg[2], dg[3]); *(u32x2*)(SG + row * DMIX + cc) = gw;
                float wv4[4], av[4], bv[4], ktv[4], qv[4], vv[4];
#pragma unroll
                for (int j = 0; j < 4; ++j) {
                    const float rc = ca[j] + T.m0[j] * (qa[j] - ca[j]), kc = cb[j] + T.m1[j] * (qb[j] - cb[j]), vc = cd[j] + T.m2[j] * (qd[j] - cd[j]);
                    const float zz = -(T.w0[j] + dw[j]); const float sp = fmaxf(zz, 0.f) + __logf(1.0f + __expf(-fabsf(zz)));
                    wv4[j] = __expf(-__expf(-sp - 0.5f));
                    const float a = sigmoidf_(T.a0[j] + da[j]);
                    vv[j] = vc + (vf[j] - vc) * sigmoidf_(T.v0[j] + dv[j]);
                    const float kk = kc * T.kkw[j] * inv; av[j] = -kk; bv[j] = kk * a;
                    ktv[j] = kc * (1.0f + (a - 1.0f) * T.kaw[j]); qv[j] = rc;
                    br += bv[j] * rc; kr += ktv[j] * rc; rkr += rc * ktv[j] * T.rk[j]; }
                float gfin[4];
#pragma unroll
                for (int j = 0; j < 4; ++j) { float g = wv4[j];
                    g *= dpp_shr_or1<1>(g); g *= dpp_shr_or1<2>(g); g *= dpp_shr_or1<4>(g); g *= dpp_shr_or1<8>(g);
                    const float gp = dpp_shr_or1<1>(g), ig = 1.0f / g;
                    av[j] *= gp; qv[j] *= g; bv[j] *= ig; ktv[j] *= ig; gfin[j] = g; }
                if (l15 == 15) *(f32x4*)(GTB + ((size_t)it * 24 + hh) * 64 + ct * 16 + quad * 4) = (f32x4){gfin[0], gfin[1], gfin[2], gfin[3]};
                u32x2 t; t.x = pk2(av[0], av[1]); t.y = pk2(av[2], av[3]); *(u32x2*)(SA + row * DMIX + cc) = t;
                t.x = pk2(bv[0], bv[1]); t.y = pk2(bv[2], bv[3]); *(u32x2*)(SB + row * DMIX + cc) = t;
                t.x = pk2(ktv[0], ktv[1]); t.y = pk2(ktv[2], ktv[3]); *(u32x2*)(SK + row * DMIX + cc) = t;
                t.x = pk2(qv[0], qv[1]); t.y = pk2(qv[2], qv[3]); *(u32x2*)(SQ + row * DMIX + cc) = t;
                t.x = pk2(vv[0], vv[1]); t.y = pk2(vv[2], vv[3]); *(u32x2*)(SV + row * DMIX + cc) = t; };
            load_tile(1, TB2); do_tile(0, TA); __builtin_amdgcn_sched_barrier(0);
            load_tile(2, TA); do_tile(1, TB2); __builtin_amdgcn_sched_barrier(0);
            load_tile(3, TB2); do_tile(2, TA); __builtin_amdgcn_sched_barrier(0);
            do_tile(3, TB2);
            br += __shfl_xor(br, 16); br += __shfl_xor(br, 32); kr += __shfl_xor(kr, 16); kr += __shfl_xor(kr, 32); rkr += __shfl_xor(rkr, 16); rkr += __shfl_xor(rkr, 32);
            if (quad == 0) *(f32x4*)(BRKR + (row * 24 + hh) * 4) = (f32x4){br, kr, rkr, 0.f};
        }
        if (tl0 == 496) { for (int e = c.tid; e < RW_SHIFT; e += 512) PTw[(size_t)b * RW_SHIFT + e] = P1[(size_t)(r0 + 15) * P1W + e]; }
    }
}

__device__ __forceinline__ void rwkv_item(const P& p, const Ctx& c, int seg, int w, bool save) {
    const int b = w / 24, hh = w % 24;
    const float* SW = (const float*)(c.seg + S1_W); const bf16_t* SA = (const bf16_t*)(c.seg + S1_A); const bf16_t* SB = (const bf16_t*)(c.seg + S1_B); const bf16_t* SK = (const bf16_t*)(c.seg + S1_K);
    const bf16_t* SQ = (const bf16_t*)(c.seg + S1_Q); const bf16_t* SV = (const bf16_t*)(c.seg + S1_V); const float* BRKR = (const float*)(c.seg + S1_BRKR);
    float* O = (float*)(c.seg + S1_O); float* RST = (float*)(p.ws + OFF_RST) + (size_t)w * 4096;
    constexpr int TB = 32, REC = 388;
    LAS float* L0 = (LAS float*)c.lds;
    const int rp = c.wv * 4 + (c.lane >> 4), cq = c.lane & 15;
    f32x2 S0a, S0b, S1a, S1b;
    if (seg > 0) { const f32x4 s0 = *(const f32x4*)(RST + (2 * rp) * 64 + cq * 4), s1 = *(const f32x4*)(RST + (2 * rp + 1) * 64 + cq * 4);
        S0a = (f32x2){s0[0], s0[1]}; S0b = (f32x2){s0[2], s0[3]}; S1a = (f32x2){s1[0], s1[1]}; S1b = (f32x2){s1[2], s1[3]}; }
    else { S0a = S0b = S1a = S1b = (f32x2){0.f, 0.f}; }
    const int e4 = c.tid * 4, stt = e4 >> 6, scc = e4 & 63;
    f32x4 gw; u32x2 ga, gb, gk, gq, gv; f32x4 gbr;
    auto gload = [&](int blk) { const size_t go = ((size_t)b * SEGT + blk * TB + stt) * DMIX + hh * 64 + scc;
        gw = *(const f32x4*)(SW + go); ga = *(const u32x2*)(SA + go); gb = *(const u32x2*)(SB + go); gk = *(const u32x2*)(SK + go); gq = *(const u32x2*)(SQ + go); gv = *(const u32x2*)(SV + go);
        if (c.tid < TB) gbr = *(const f32x4*)(BRKR + (((size_t)b * SEGT + blk * TB + c.tid) * 24 + hh) * 4); };
    auto lstore = [&](int buf) { LAS float* r = L0 + buf * (TB * REC) + stt * REC + scc;
        *(LAS f32x4*)(r) = gw; *(LAS f32x4*)(r + 64) = (f32x4){bflo(ga.x), bfhi(ga.x), bflo(ga.y), bfhi(ga.y)}; *(LAS f32x4*)(r + 128) = (f32x4){bflo(gb.x), bfhi(gb.x), bflo(gb.y), bfhi(gb.y)};
        *(LAS f32x4*)(r + 192) = (f32x4){bflo(gk.x), bfhi(gk.x), bflo(gk.y), bfhi(gk.y)}; *(LAS f32x4*)(r + 256) = (f32x4){bflo(gq.x), bfhi(gq.x), bflo(gq.y), bfhi(gq.y)};
        *(LAS f32x4*)(r + 320) = (f32x4){bflo(gv.x), bfhi(gv.x), bflo(gv.y), bfhi(gv.y)};
        if (c.tid < TB) { LAS float* q = L0 + buf * (TB * REC) + c.tid * REC + 384; *(LAS f32x2*)q = (f32x2){gbr[0], gbr[1]}; } };
    __syncthreads();
    gload(0); lstore(0);
    __syncthreads();
#pragma unroll 1
    for (int blk = 0; blk < SEGT / TB; ++blk) {
        const int buf = blk & 1;
        if (blk + 1 < SEGT / TB) gload(blk + 1);
        const LAS float* base = L0 + buf * (TB * REC);
        const size_t rowb = (size_t)b * SEGT + blk * TB;
        f32x4 nw4 = *(const LAS f32x4*)(base + cq * 4), na4 = *(const LAS f32x4*)(base + 64 + cq * 4), nb4 = *(const LAS f32x4*)(base + 128 + cq * 4), nk4 = *(const LAS f32x4*)(base + 192 + cq * 4), nq4 = *(const LAS f32x4*)(base + 256 + cq * 4);
        f32x2 nv2 = *(const LAS f32x2*)(base + 320 + 2 * rp), nbk = *(const LAS f32x2*)(base + 384);
#pragma unroll 2
        for (int tt = 0; tt < TB; ++tt) {
            const f32x4 w4 = nw4, a4 = na4, b4 = nb4, k4 = nk4, q4 = nq4; const f32x2 v2 = nv2, bk = nbk;
            { const LAS float* r = base + (tt + 1 < TB ? tt + 1 : tt) * REC;
              nw4 = *(const LAS f32x4*)(r + cq * 4); na4 = *(const LAS f32x4*)(r + 64 + cq * 4); nb4 = *(const LAS f32x4*)(r + 128 + cq * 4); nk4 = *(const LAS f32x4*)(r + 192 + cq * 4); nq4 = *(const LAS f32x4*)(r + 256 + cq * 4);
              nv2 = *(const LAS f32x2*)(r + 320 + 2 * rp); nbk = *(const LAS f32x2*)(r + 384); }
            const f32x2 wa = (f32x2){w4[0], w4[1]}, wb = (f32x2){w4[2], w4[3]}, aa = (f32x2){a4[0], a4[1]}, ab = (f32x2){a4[2], a4[3]}, ba = (f32x2){b4[0], b4[1]}, bb = (f32x2){b4[2], b4[3]};
            const f32x2 ka = (f32x2){k4[0], k4[1]}, kb = (f32x2){k4[2], k4[3]}, qa = (f32x2){q4[0], q4[1]}, qb = (f32x2){q4[2], q4[3]};
            f32x2 t0 = S0a * aa + S0b * ab, t1 = S0a * qa + S0b * qb, t2 = S1a * aa + S1b * ab, t3 = S1a * qa + S1b * qb;
            float pa0 = t0.x + t0.y, pt0 = t1.x + t1.y, pa1 = t2.x + t2.y, pt1 = t3.x + t3.y;
            row16_allsum4(pa0, pa1, pt0, pt1);
            const f32x2 pa0v = (f32x2){pa0, pa0}, pa1v = (f32x2){pa1, pa1}, v0v = (f32x2){v2.x, v2.x}, v1v = (f32x2){v2.y, v2.y};
            S0a = S0a * wa + pa0v * ba + v0v * ka; S0b = S0b * wb + pa0v * bb + v0v * kb;
            S1a = S1a * wa + pa1v * ba + v1v * ka; S1b = S1b * wb + pa1v * bb + v1v * kb;
            if (cq == 0) { const f32x2 y = (f32x2){pt0 + pa0 * bk.x + v2.x * bk.y, pt1 + pa1 * bk.x + v2.y * bk.y};
                *(f32x2*)(O + (rowb + tt) * DMIX + hh * 64 + 2 * rp) = y; }
        }
        if (blk + 1 < SEGT / TB) lstore(buf ^ 1);
        __syncthreads();
    }
    if (!save) return;
    *(f32x4*)(RST + (2 * rp) * 64 + cq * 4) = (f32x4){S0a.x, S0a.y, S0b.x, S0b.y}; *(f32x4*)(RST + (2 * rp + 1) * 64 + cq * 4) = (f32x4){S1a.x, S1a.y, S1b.x, S1b.y};
}

__device__ __forceinline__ void rwkv_chunk_item(const P& p, const Ctx& c, int seg, int w, bool save) {
    const int b = w / 24, hh = w % 24;
    const bf16_t* SA = (const bf16_t*)(c.seg + S1_A); const bf16_t* SB = (const bf16_t*)(c.seg + S1_B); const bf16_t* SK = (const bf16_t*)(c.seg + S1_K);
    const bf16_t* SR = (const bf16_t*)(c.seg + S1_Q); const bf16_t* SV = (const bf16_t*)(c.seg + S1_V); const float* GTB = (const float*)(c.seg + S1_W);
    float* O = (float*)(c.seg + S1_O); float* RST = (float*)(p.ws + OFF_RST) + (size_t)w * 4096;
    constexpr int O_EA = 0  , O_EB = 4608  , O_EBT = 9216  , O_UV = 14336  ,
                  O_MT1 = 19456  , O_NT = 20736  , O_MABT = 22016  ,
                  O_GT = 23296  , OPB = 23552;
    LAS unsigned char* OB = c.lds;
    LAS bf16_t* S0I = (LAS bf16_t*)(c.lds + 2 * OPB);
    LAS float* XF = (LAS float*)(c.lds + 2 * OPB + 9216);
    const int l15c = c.lane & 15, quadc = c.lane >> 4;
    f32x4 S[2];
#pragma unroll
    for (int x = 0; x < 2; ++x) { const int ti = c.wv * 2 + x, mt = ti >> 2, nt = ti & 3;
#pragma unroll
        for (int jj = 0; jj < 4; ++jj) S[x][jj] = (seg > 0) ? RST[(mt * 16 + quadc * 4 + jj) * 64 + nt * 16 + l15c] : 0.f; }
    unsigned ga = 0, gb = 0, gk = 0, gr = 0, gv = 0; float gg = 1.f;
    auto gload = [&](int ch, int tidv) { const int t = tidv >> 5, j0 = (tidv & 31) * 2; const size_t go = ((size_t)b * SEGT + ch * 16 + t) * DMIX + hh * 64 + j0;
        ga = *(const unsigned*)(SA + go); gb = *(const unsigned*)(SB + go); gk = *(const unsigned*)(SK + go); gr = *(const unsigned*)(SR + go); gv = *(const unsigned*)(SV + go);
        if (tidv < 64) gg = GTB[((size_t)(b * 32 + ch) * 24 + hh) * 64 + tidv]; };
    auto lstore = [&](int pb, int tidv) { const int t = tidv >> 5, j0 = (tidv & 31) * 2;
        LAS bf16_t* EA = (LAS bf16_t*)(OB + pb * OPB + O_EA); LAS bf16_t* EB = (LAS bf16_t*)(OB + pb * OPB + O_EB); LAS bf16_t* EBT = (LAS bf16_t*)(OB + pb * OPB + O_EBT);
        LAS bf16_t* UV = (LAS bf16_t*)(OB + pb * OPB + O_UV); LAS float* GT = (LAS float*)(OB + pb * OPB + O_GT);
        *(LAS unsigned*)(EA + t * 72 + j0) = ga; *(LAS unsigned*)(EA + (16 + t) * 72 + j0) = gr;
        *(LAS unsigned*)(EB + t * 72 + j0) = gb; *(LAS unsigned*)(EB + (16 + t) * 72 + j0) = gk;
        EBT[j0 * 40 + t] = (bf16_t)(gb & 0xFFFFu); EBT[(j0 + 1) * 40 + t] = (bf16_t)(gb >> 16); EBT[j0 * 40 + 16 + t] = (bf16_t)(gk & 0xFFFFu); EBT[(j0 + 1) * 40 + 16 + t] = (bf16_t)(gk >> 16);
        UV[j0 * 40 + 16 + t] = (bf16_t)(gv & 0xFFFFu); UV[(j0 + 1) * 40 + 16 + t] = (bf16_t)(gv >> 16); UV[j0 * 40 + t] = 0; UV[(j0 + 1) * 40 + t] = 0;
        if (tidv < 64) GT[tidv] = gg; };
    auto gtile = [&](int pb, int l15, int quad) {
        LAS bf16_t* EA = (LAS bf16_t*)(OB + pb * OPB + O_EA); LAS bf16_t* EB = (LAS bf16_t*)(OB + pb * OPB + O_EB);
        LAS bf16_t* MT1 = (LAS bf16_t*)(OB + pb * OPB + O_MT1); LAS bf16_t* NT = (LAS bf16_t*)(OB + pb * OPB + O_NT); LAS float* MABT = (LAS float*)(OB + pb * OPB + O_MABT);
        const int sb = c.wv >> 1, tb = c.wv & 1; f32x4 g = (f32x4){0.f, 0.f, 0.f, 0.f};
#pragma unroll
        for (int kk = 0; kk < 2; ++kk) g = mfma16(*(const LAS bf16x8*)(EB + (sb * 16 + l15) * 72 + kk * 32 + quad * 8), *(const LAS bf16x8*)(EA + (tb * 16 + l15) * 72 + kk * 32 + quad * 8), g);
#pragma unroll
        for (int jj = 0; jj < 4; ++jj) { const int s2 = quad * 4 + jj, tt = l15; const float v = g[jj];
            if (tb == 0) { const float m = (s2 < tt) ? v : 0.f; if (sb == 0) { MABT[tt * 20 + s2] = m; MT1[tt * 40 + s2] = 0; } else MT1[tt * 40 + 16 + s2] = f2bf(m); }
            else { const float m = (s2 <= tt) ? v : 0.f; NT[tt * 40 + sb * 16 + s2] = f2bf(m); } } };
    auto simg = [&](int l15, int quad) {
#pragma unroll
        for (int x = 0; x < 2; ++x) { const int ti = c.wv * 2 + x, mt = ti >> 2, nt = ti & 3;
#pragma unroll
            for (int jj = 0; jj < 4; ++jj) S0I[(mt * 16 + quad * 4 + jj) * 72 + nt * 16 + l15] = f2bf(S[x][jj]); } };
    __syncthreads();
    { int t0 = c.tid; asm volatile("" : "+v"(t0)); gload(0, t0); lstore(0, t0); simg(l15c, quadc); }
    lds_barrier();
    if (c.wv < 4) gtile(0, l15c, quadc);
    { int t1 = c.tid; asm volatile("" : "+v"(t1)); gload(1, t1); }
    const int mtq = c.wv & 3;
#pragma unroll 1
    for (int ch = 0; ch < SEGT / 16; ++ch) {
        const int pb = ch & 1;
        int tidv = c.tid, l15 = l15c, quad = quadc; asm volatile("" : "+v"(tidv), "+v"(l15), "+v"(quad));
        LAS bf16_t* EA = (LAS bf16_t*)(OB + pb * OPB + O_EA); LAS bf16_t* EBT = (LAS bf16_t*)(OB + pb * OPB + O_EBT); LAS bf16_t* UV = (LAS bf16_t*)(OB + pb * OPB + O_UV);
        LAS bf16_t* MT1 = (LAS bf16_t*)(OB + pb * OPB + O_MT1); LAS bf16_t* NT = (LAS bf16_t*)(OB + pb * OPB + O_NT); LAS float* MABT = (LAS float*)(OB + pb * OPB + O_MABT); LAS float* GT = (LAS float*)(OB + pb * OPB + O_GT);
        lds_barrier();
        f32x4 Zt = (f32x4){0.f, 0.f, 0.f, 0.f};
        if (c.wv >= 4) {
            f32x4 Xt = (f32x4){0.f, 0.f, 0.f, 0.f};
#pragma unroll
            for (int kk = 0; kk < 2; ++kk) { const bf16x8 a = *(const LAS bf16x8*)(S0I + (mtq * 16 + l15) * 72 + kk * 32 + quad * 8);
                Xt = mfma16(a, *(const LAS bf16x8*)(EA + l15 * 72 + kk * 32 + quad * 8), Xt); Zt = mfma16(a, *(const LAS bf16x8*)(EA + (16 + l15) * 72 + kk * 32 + quad * 8), Zt); }
            Xt = mfma16(*(const LAS bf16x8*)(UV + (mtq * 16 + l15) * 40 + quad * 8), *(const LAS bf16x8*)(MT1 + l15 * 40 + quad * 8), Xt);
#pragma unroll
            for (int jj = 0; jj < 4; ++jj) XF[(mtq * 16 + quad * 4 + jj) * 17 + l15] = Xt[jj];
        }
        lds_barrier();
        if (ch + 1 < SEGT / 16) lstore(pb ^ 1, tidv);
        if (ch + 2 < SEGT / 16) gload(ch + 2, tidv);
        if (c.wv == 0) {
            float u[16];
#pragma unroll
            for (int tt = 0; tt < 16; ++tt) { float acc = XF[c.lane * 17 + tt];
#pragma unroll
                for (int s4 = 0; s4 < (tt + 3) / 4; ++s4) { const f32x4 m = *(const LAS f32x4*)(MABT + tt * 20 + s4 * 4);
#pragma unroll
                    for (int e = 0; e < 4; ++e) if (s4 * 4 + e < tt) acc += u[s4 * 4 + e] * m[e]; }
                u[tt] = acc; }
            *(LAS u32x4*)(UV + c.lane * 40) = (u32x4){pk2(u[0], u[1]), pk2(u[2], u[3]), pk2(u[4], u[5]), pk2(u[6], u[7])};
            *(LAS u32x4*)(UV + c.lane * 40 + 8) = (u32x4){pk2(u[8], u[9]), pk2(u[10], u[11]), pk2(u[12], u[13]), pk2(u[14], u[15])};
        }
        lds_barrier();
        if (c.wv >= 4) {
            Zt = mfma16(*(const LAS bf16x8*)(UV + (mtq * 16 + l15) * 40 + quad * 8), *(const LAS bf16x8*)(NT + l15 * 40 + quad * 8), Zt);
            *(f32x4*)(O + ((size_t)b * SEGT + ch * 16 + l15) * DMIX + hh * 64 + mtq * 16 + quad * 4) = Zt;
        }
#pragma unroll
        for (int x = 0; x < 2; ++x) { const int ti = c.wv * 2 + x, mt = ti >> 2, nt = ti & 3;
            S[x] = mfma16(*(const LAS bf16x8*)(UV + (mt * 16 + l15) * 40 + quad * 8), *(const LAS bf16x8*)(EBT + (nt * 16 + l15) * 40 + quad * 8), S[x]);
            const float gt = GT[nt * 16 + l15];
#pragma unroll
            for (int jj = 0; jj < 4; ++jj) S[x][jj] *= gt; }
        simg(l15, quad);
        if (c.wv < 4 && ch + 1 < SEGT / 16) gtile(pb ^ 1, l15, quad);
    }
    if (!save) return;
#pragma unroll
    for (int x = 0; x < 2; ++x) { const int ti = c.wv * 2 + x, mt = ti >> 2, nt = ti & 3;
#pragma unroll
        for (int jj = 0; jj < 4; ++jj) RST[(mt * 16 + quadc * 4 + jj) * 64 + nt * 16 + l15c] = S[x][jj]; }
}

__device__ __forceinline__ void phase_b3(const P& p, const Ctx& c) {
    const float* O = (const float*)(c.seg + S1_O); const bf16_t* P2 = (const bf16_t*)(c.seg + S1_P2); const bf16_t* SV = (const bf16_t*)(c.seg + S1_V); const bf16_t* SG = (const bf16_t*)(c.seg + S1_G);
    const float* BRKR = (const float*)(c.seg + S1_BRKR); const bf16_t* YM = (const bf16_t*)(c.seg + S1_YMEM); bf16_t* Y = (bf16_t*)(c.seg + S1_Y);
    for (int r = c.bid * 8 + c.wv; r < MS; r += c.G * 8) {
#pragma unroll
        for (int ps = 0; ps < 3; ++ps) {
            const int hh = ps * 8 + (c.lane >> 3), ch = hh * 64 + (c.lane & 7) * 8;
            const f32x4 o0 = *(const f32x4*)(O + (size_t)r * DMIX + ch), o1 = *(const f32x4*)(O + (size_t)r * DMIX + ch + 4);
            float v[8] = {o0[0], o0[1], o0[2], o0[3], o1[0], o1[1], o1[2], o1[3]}; float s = 0.f, s2 = 0.f;
#pragma unroll
            for (int j = 0; j < 8; ++j) { s += v[j]; s2 += v[j] * v[j]; }
            s += __shfl_xor(s, 1); s2 += __shfl_xor(s2, 1); s += __shfl_xor(s, 2); s2 += __shfl_xor(s2, 2); s += __shfl_xor(s, 4); s2 += __shfl_xor(s2, 4);
            const float mean = s * (1.0f / 64.0f), var = fmaxf(s2 * (1.0f / 64.0f) - mean * mean, 0.f), rs = rsqrtf(var + 64e-5f);
            const float rkr = BRKR[((size_t)r * 24 + hh) * 4 + 2];
            const u32x4 vr = *(const u32x4*)(SV + (size_t)r * DMIX + ch), gr = *(const u32x4*)(SG + (size_t)r * DMIX + ch), zr = *(const u32x4*)(P2 + (size_t)r * P2W + 512 + ch);
            const float vv[8] = {bflo(vr.x), bfhi(vr.x), bflo(vr.y), bfhi(vr.y), bflo(vr.z), bfhi(vr.z), bflo(vr.w), bfhi(vr.w)};
            const float gg[8] = {bflo(gr.x), bfhi(gr.x), bflo(gr.y), bfhi(gr.y), bflo(gr.z), bfhi(gr.z), bflo(gr.w), bfhi(gr.w)};
            const float zz[8] = {bflo(zr.x), bfhi(zr.x), bflo(zr.y), bfhi(zr.y), bflo(zr.z), bfhi(zr.z), bflo(zr.w), bfhi(zr.w)};
            float y[8];
#pragma unroll
            for (int j = 0; j < 8; ++j) { const float t = ((v[j] - mean) * rs * p.rw_lnx_g[ch + j] + p.rw_lnx_b[ch + j] + rkr * vv[j]) * gg[j]; y[j] = t * siluf_(zz[j]); }
            *(u32x4*)(Y + (size_t)r * DIN + ch) = (u32x4){pk2(y[0], y[1]), pk2(y[2], y[3]), pk2(y[4], y[5]), pk2(y[6], y[7])};
        }
        { const int cm = c.lane * 8; const u32x4 mr = *(const u32x4*)(YM + (size_t)r * DX + cm), zr = *(const u32x4*)(P2 + (size_t)r * P2W + 512 + DMIX + cm);
          const float mm[8] = {bflo(mr.x), bfhi(mr.x), bflo(mr.y), bfhi(mr.y), bflo(mr.z), bfhi(mr.z), bflo(mr.w), bfhi(mr.w)};
          const float zz[8] = {bflo(zr.x), bfhi(zr.x), bflo(zr.y), bfhi(zr.y), bflo(zr.z), bfhi(zr.z), bflo(zr.w), bfhi(zr.w)};
          float y[8];
#pragma unroll
          for (int j = 0; j < 8; ++j) y[j] = mm[j] * siluf_(zz[j]);
          *(u32x4*)(Y + (size_t)r * DIN + DMIX + cm) = (u32x4){pk2(y[0], y[1]), pk2(y[2], y[3]), pk2(y[4], y[5]), pk2(y[6], y[7])}; }
    }
}

__device__ __forceinline__ bool fresh_ctx(Ctx& c, P& p, unsigned char* ws0) { int t = threadIdx.x; asm volatile("" : "+v"(t)); c.tid = t; c.wv = __builtin_amdgcn_readfirstlane(t >> 6); c.lane = t & 63;
    int bb = (int)blockIdx.x, gg = (int)gridDim.x; asm volatile("" : "+s"(bb), "+s"(gg)); c.bid = bb; c.G = gg;
    size_t z = 0; asm volatile("" : "+s"(z)); p.ws = ws0 + z; c.seg = ws0 + z + OFF_SEG;
    return true; }
__global__ __launch_bounds__(512) void fwd_megakernel(P p_arg) {
    P p = p_arg;
    extern __shared__ __attribute__((aligned(16))) unsigned char shm[];
    LAS unsigned char* lds = (LAS unsigned char*)shm;
    Ctx c; c.tid = threadIdx.x; c.wv = threadIdx.x >> 6; c.lane = threadIdx.x & 63; c.G = gridDim.x; c.bid = blockIdx.x; c.lds = lds; c.seg = p.ws + OFF_SEG;
    volatile LAS unsigned* st = (volatile LAS unsigned*)(lds + LDS_BYTES - 16);
    if (c.tid == 0) { st[0] = 0u; st[1] = 0u; }
    __syncthreads();
    const XcdBarrier xb = xcd_barrier_post((unsigned*)(p.ws + OFF_BAR), st);
#define GSYNC() do { XcdBarrier _xl = xb; size_t _zz = 0; asm volatile("" : "+s"(_zz)); _xl.bar = xb.bar + _zz; _xl.x = xb_xcc_id();     \
        xcd_barrier(_xl); if (RK == 20) { for (int _q = 1; _q < RN; ++_q) xcd_barrier(_xl); } } while (0)
#ifndef RK
#define RK -1
#endif
#ifndef RN
#define RN 1
#endif
#define NREP(k) ((k) == RK ? RN : 1)
#define PH(k) for (int _r = 0; _r < NREP(k); ++_r) if (fresh_ctx(c, p, p_arg.ws))
#define LASTREP(k) (_r + 1 == NREP(k))
    PH(0) phase0(p, c);
    PH(1) phase_apre(p, c, 0);
    GSYNC();
    for (int seg = 0; seg < NSEG; ++seg) {
        PH(2) { SchedA0 S; S.ws = p.ws; S.seg = c.seg; S.G = c.G; S.c = c.bid; S.nextra = (seg == 0) ? 64 : 0;
          pg8::gemm_phase<pg8::EpiBf, SchedA0>(lds, c.tid, 1024, 1024, S, pg8::EpiBf{}); }
        GSYNC();
        PH(3) phase_a1(p, c, seg);
        GSYNC();
        for (int it = c.bid; it < 256; it += c.G) {
            if (it < 192) { PH(4) mlstm_item(p, c, seg, it, LASTREP(4)); }
            else { PH(5) attn_item(p, c, 0, it - 192, (const bf16_t*)(c.seg + S0_P0) + DMIX, ML_W, (bf16_t*)(c.seg + S0_YMEM)); }
        }
        GSYNC();
        PH(6) phase_a3(p, c, seg);
        GSYNC();
        PH(7) { SchedOut S; S.Y = (const char*)(c.seg + S0_Y); S.W = (const char*)(p.ws + OFF_WO0T); S.slab = (char*)(c.seg + S0_SLAB); S.G = c.G; S.c = c.bid;
          pg8::gemm_phase<pg8::EpiBf, SchedOut>(lds, c.tid, DIN, 512, S, pg8::EpiBf{}); }
        GSYNC();
        PH(8) phase_a5(p, c, seg);
        GSYNC();
        PH(9) { SchedB0 S; S.ws = p.ws; S.seg = c.seg; S.G = c.G; S.c = c.bid;
          pg8::gemm_phase<pg8::EpiBf, SchedB0>(lds, c.tid, 1024, 1024, S, pg8::EpiBf{}); }
        GSYNC();
        PH(10) phase_b1(p, c, seg);
        GSYNC();
        for (int it = c.bid; it < 256; it += c.G) {
            if (it < 192) { PH(11) rwkv_chunk_item(p, c, seg, it, LASTREP(11)); }
            else { PH(5) attn_item(p, c, 1, it - 192, (const bf16_t*)(c.seg + S1_P2), P2W, (bf16_t*)(c.seg + S1_YMEM)); }
        }
        GSYNC();
        PH(12) phase_b3(p, c);
        GSYNC();
        PH(13) { SchedOut S; S.Y = (const char*)(c.seg + S1_Y); S.W = (const char*)(p.ws + OFF_WO1T); S.slab = (char*)(c.seg + S1_SLAB); S.G = c.G; S.c = c.bid;
          pg8::gemm_phase<pg8::EpiBf, SchedOut>(lds, c.tid, DIN, 512, S, pg8::EpiBf{}); }
        GSYNC();
        PH(14) phase_b5(p, c, seg);
        PH(1) if (seg + 1 < NSEG) phase_apre(p, c, seg + 1);
        GSYNC();
    }
}

extern "C" void kernel_launch(void* const* d_in, const int* in_sizes, int n_in, void* d_out, int out_size, void* d_ws, size_t ws_size, hipStream_t stream) {
    static int grid = 0;
    if (grid == 0) {
        int dev = 0, cus = 0, per_cu = 0;
        if (hipGetDevice(&dev) != hipSuccess || hipDeviceGetAttribute(&cus, hipDeviceAttributeMultiprocessorCount, dev) != hipSuccess) { grid = -1; return; }
        if (hipFuncSetAttribute((const void*)fwd_megakernel, hipFuncAttributeMaxDynamicSharedMemorySize, LDS_BYTES) != hipSuccess) { fprintf(stderr, "hipFuncSetAttribute failed\n"); grid = -1; return; }
        if (hipOccupancyMaxActiveBlocksPerMultiprocessor(&per_cu, (const void*)fwd_megakernel, 512, LDS_BYTES) != hipSuccess || per_cu < 1) { fprintf(stderr, "occupancy query: %d\n", per_cu); }
        (void)hipGetLastError();
        grid = cus;
        if (n_in != 31 || ws_size < 256 * MiB) { fprintf(stderr, "unexpected n_in %d / ws %zu\n", n_in, ws_size); grid = -1; return; }
    }
    if (grid < 0) return;
    (void)hipMemsetAsync((char*)d_ws + OFF_BAR, 0, XCD_BAR_WORDS * 4, stream);
    P p{};
    const float** f = (const float**)&p;
    for (int i = 0; i < 31; ++i) f[i] = (const float*)d_in[i];
    p.out = (float*)d_out; p.ws = (unsigned char*)d_ws;
    fwd_megakernel<<<dim3(grid), dim3(512), LDS_BYTES, stream>>>(p);
}
```

```cpp
#include <hip/hip_runtime.h>
#include <cstdio>
#include <cstdint>

#define LAS __attribute__((address_space(3)))
typedef unsigned short bf16_t;
typedef short bf16x8 __attribute__((ext_vector_type(8)));
typedef short bf16x4 __attribute__((ext_vector_type(4)));
typedef float f32x4 __attribute__((ext_vector_type(4)));
typedef float f32x2 __attribute__((ext_vector_type(2)));
typedef unsigned u32x4 __attribute__((ext_vector_type(4)));
typedef unsigned u32x2 __attribute__((ext_vector_type(2)));

constexpr int NB = 8, SEQ = 2048, DM = 1024, NSEG = 4, SEGT = 512, MS = NB * SEGT;
constexpr int DMIX = 1536, DX = 512, DIN = 2048;
constexpr int ML_W = 4096, RW_SHIFT = 4896, RW_W = 7456;
constexpr int P1W = 5120, P2W = 2560;
constexpr size_t MiB = 1u << 20;
constexpr size_t OFF_WT0 = 0, OFF_WT1 = 8 * MiB, OFF_WO0T = 23 * MiB, OFF_WO1T = 27 * MiB, OFF_WKVT = 31 * MiB  ,
                 OFF_KMEM = 35 * MiB  , OFF_LORAT = 43 * MiB, OFF_MISC = 45 * MiB,
                 OFF_CST = 46 * MiB, OFF_NST = 65 * MiB, OFF_RST = 65 * MiB + 512 * 1024, OFF_H = 69 * MiB, OFF_VF = 77 * MiB,
                 OFF_SEG = 89 * MiB, OFF_MEMN = 248 * MiB;
constexpr size_t OFF_BAR = OFF_MISC, OFF_UTAIL = OFF_MISC + 64 * 1024, OFF_PTAIL = OFF_MISC + 256 * 1024;
constexpr size_t S0_P0 = 0, S0_Q = 32 * MiB, S0_K = 44 * MiB, S0_KT = 56 * MiB, S0_VT = 68 * MiB, S0_XC = 80 * MiB, S0_HRAW = 92 * MiB,
                 S0_YMEM = 116 * MiB, S0_Y = 120 * MiB, S0_GATE = 136 * MiB;
constexpr size_t S1_P1 = 0, S1_O = 0, S1_Y = 24 * MiB, S1_P2 = 40 * MiB, S1_W = 60 * MiB, S1_A = 84 * MiB, S1_B = 96 * MiB, S1_K = 108 * MiB,
                 S1_Q = 120 * MiB, S1_V = 132 * MiB, S1_G = 144 * MiB, S1_YMEM = 156 * MiB, S1_BRKR = 160 * MiB;
constexpr size_t S0_SLAB = 0  , S1_SLAB = 84 * MiB  ;
constexpr int LDS_BYTES = 150 * 1024;

struct P {
    const float *x, *mem, *norm_g, *mem_norm_g, *mem_kv_w, *w_out, *ml_w_in, *ml_conv_w, *ml_conv_b, *ml_wq, *ml_wk, *ml_wv, *ml_w_gate, *ml_b_gate,
        *ml_mhn_g, *ml_skip, *rw_w_in, *rw_mu, *rw_w_lora2, *rw_w0, *rw_a_lora2, *rw_a0, *rw_v_lora2, *rw_v0, *rw_g_lora2, *rw_k_k, *rw_k_a, *rw_r_k,
        *rw_lnx_g, *rw_lnx_b, *final_g;
    float* out; unsigned char* ws;
};

__device__ __forceinline__ bf16_t f2bf(float f) { unsigned u = __float_as_uint(f); u += 0x7FFFu + ((u >> 16) & 1u); return (bf16_t)(u >> 16); }
__device__ __forceinline__ float bf2f(bf16_t b) { return __uint_as_float(((unsigned)b) << 16); }
__device__ __forceinline__ unsigned pk2(float lo, float hi) { return (unsigned)f2bf(lo) | ((unsigned)f2bf(hi) << 16); }
__device__ __forceinline__ float bflo(unsigned u) { return __uint_as_float(u << 16); }
__device__ __forceinline__ float bfhi(unsigned u) { return __uint_as_float(u & 0xFFFF0000u); }
__device__ __forceinline__ float wsum(float v) {
#pragma unroll
    for (int o = 32; o >= 1; o >>= 1) v += __shfl_xor(v, o);
    return v;
}
__device__ __forceinline__ float sigmoidf_(float x) { return 1.0f / (1.0f + __expf(-x)); }
__device__ __forceinline__ float siluf_(float x) { return x / (1.0f + __expf(-x)); }
__device__ __forceinline__ float softplusf_(float z) { return fmaxf(z, 0.f) + log1pf(__expf(-fabsf(z))); }
template <int CTRL> __device__ __forceinline__ float dpp_add(float v) {
    return v + __int_as_float(__builtin_amdgcn_update_dpp(0, __float_as_int(v), CTRL, 0xF, 0xF, true));
}
__device__ __forceinline__ float row16_allsum(float v) {
    v = dpp_add<0xB1>(v);
    v = dpp_add<0x4E>(v);
    v = dpp_add<0x141>(v);
    v = dpp_add<0x140>(v);
    return v;
}
__device__ __forceinline__ void row16_allsum4(float& a, float& b, float& c, float& d) {
    asm volatile("s_nop 1\n\t"
        "v_add_f32_dpp %0, %0, %0 quad_perm:[1,0,3,2] row_mask:0xf bank_mask:0xf\n\t" "v_add_f32_dpp %1, %1, %1 quad_perm:[1,0,3,2] row_mask:0xf bank_mask:0xf\n\t"
        "v_add_f32_dpp %2, %2, %2 quad_perm:[1,0,3,2] row_mask:0xf bank_mask:0xf\n\t" "v_add_f32_dpp %3, %3, %3 quad_perm:[1,0,3,2] row_mask:0xf bank_mask:0xf\n\t"
        "v_add_f32_dpp %0, %0, %0 quad_perm:[2,3,0,1] row_mask:0xf bank_mask:0xf\n\t" "v_add_f32_dpp %1, %1, %1 quad_perm:[2,3,0,1] row_mask:0xf bank_mask:0xf\n\t"
        "v_add_f32_dpp %2, %2, %2 quad_perm:[2,3,0,1] row_mask:0xf bank_mask:0xf\n\t" "v_add_f32_dpp %3, %3, %3 quad_perm:[2,3,0,1] row_mask:0xf bank_mask:0xf\n\t"
        "v_add_f32_dpp %0, %0, %0 row_half_mirror row_mask:0xf bank_mask:0xf\n\t" "v_add_f32_dpp %1, %1, %1 row_half_mirror row_mask:0xf bank_mask:0xf\n\t"
        "v_add_f32_dpp %2, %2, %2 row_half_mirror row_mask:0xf bank_mask:0xf\n\t" "v_add_f32_dpp %3, %3, %3 row_half_mirror row_mask:0xf bank_mask:0xf\n\t"
        "v_add_f32_dpp %0, %0, %0 row_mirror row_mask:0xf bank_mask:0xf\n\t" "v_add_f32_dpp %1, %1, %1 row_mirror row_mask:0xf bank_mask:0xf\n\t"
        "v_add_f32_dpp %2, %2, %2 row_mirror row_mask:0xf bank_mask:0xf\n\t" "v_add_f32_dpp %3, %3, %3 row_mirror row_mask:0xf bank_mask:0xf\n\t"
        "s_nop 1"
        : "+v"(a), "+v"(b), "+v"(c), "+v"(d));
}
template <int N> __device__ __forceinline__ float dpp_shr_or1(float v) {
    return __int_as_float(__builtin_amdgcn_update_dpp(0x3f800000, __float_as_int(v), 0x110 + N, 0xF, 0xF, false));
}
__device__ __forceinline__ f32x4 mfma16(bf16x8 a, bf16x8 b, f32x4 c) { return __builtin_amdgcn_mfma_f32_16x16x32_bf16(a, b, c, 0, 0, 0); }

namespace pg8 {
constexpr int BM = 256, BK = 64, HALF = 128, HTB = HALF * BK * 2, STAGE_BYTES = 8 * HTB, NXCD = 8, WGM = 8;
__host__ __device__ __forceinline__ int lds_byte(int r, int c) { const int st = (r >> 4) * 2 + (c >> 5), rr = r & 15, cc = c & 31, ob = rr * 64 + cc * 2; return st * 1024 + (ob ^ (((ob >> 9) & 1) << 5)); }
__host__ __device__ __forceinline__ void stage_rc(int b, int& R, int& C) { const int st = b / 1024, sb = b % 1024, swz = sb ^ (((sb >> 9) & 1) << 5); R = (st >> 1) * 16 + swz / 64; C = (st & 1) * 32 + (swz % 64) / 2; }
__host__ __device__ __forceinline__ int perm32(int rho) { const int n = rho >> 4, i = rho & 15; return 8 * (i >> 2) + 4 * n + (i & 3); }

struct Unit { const char* A; const char* B; char* O; int ldc; int pad; };

__device__ __forceinline__ void remap(int wgid, int nM, int nN, int& pm, int& pn) {
    const int nwg = nM * nN;
    { const int q = nwg / NXCD, r = nwg % NXCD, xcd = wgid % NXCD, off = wgid / NXCD; wgid = (xcd < r ? xcd * (q + 1) : r * (q + 1) + (xcd - r) * q) + off; }
    const int nig = WGM * nN, gid = wgid / nig, fm = gid * WGM, gsz = (nM - fm) < WGM ? (nM - fm) : WGM;
    pm = fm + ((wgid % nig) % gsz); pn = (wgid % nig) / gsz;
}

struct EpiBf {
    static constexpr bool PERM = true;
    __device__ __forceinline__ void operator()(const f32x4 (&acc)[2][2][4][2], const Unit& u, int wr, int wc, int fr, int fq) const {
        asm volatile("" : "+v"(fr), "+v"(fq));
        bf16_t* base = (bf16_t*)u.O;
#pragma unroll
        for (int ai = 0; ai < 2; ++ai)
#pragma unroll
            for (int m = 0; m < 4; ++m) { bf16_t* rowp = base + (size_t)(ai * HALF + wr * 64 + m * 16 + fr) * u.ldc + wc * 32 + 8 * fq;
#pragma unroll
                for (int bj = 0; bj < 2; ++bj) { const f32x4 v0 = acc[ai][bj][m][0], v1 = acc[ai][bj][m][1];
                    u32x4 w; w.x = pk2(v0[0], v0[1]); w.y = pk2(v0[2], v0[3]); w.z = pk2(v1[0], v1[1]); w.w = pk2(v1[2], v1[3]);
                    *(u32x4*)(rowp + bj * HALF) = w; } }
    }
};
struct EpiAtomic {
    static constexpr bool PERM = false;
    __device__ __forceinline__ void operator()(const f32x4 (&acc)[2][2][4][2], const Unit& u, int wr, int wc, int fr, int fq) const {
        asm volatile("" : "+v"(fr), "+v"(fq));
        float* base = (float*)u.O;
#pragma unroll
        for (int ai = 0; ai < 2; ++ai)
#pragma unroll
            for (int m = 0; m < 4; ++m) { float* rowp = base + (size_t)(ai * HALF + wr * 64 + m * 16 + fr) * u.ldc + wc * 32 + 4 * fq;
#pragma unroll
                for (int bj = 0; bj < 2; ++bj)
#pragma unroll
                    for (int n = 0; n < 2; ++n) { const f32x4 v = acc[ai][bj][m][n]; float* q = rowp + bj * HALF + n * 16;
#pragma unroll
                        for (int e = 0; e < 4; ++e) (void)__hip_atomic_fetch_add(q + e, v[e], __ATOMIC_RELAXED, __HIP_MEMORY_SCOPE_AGENT); }
                __builtin_amdgcn_sched_barrier(0); }
    }
};

template <class Epi, class Sched>
__device__ __forceinline__ void gemm_phase(LAS unsigned char* lds, const int tid, const int ldk, const int Kloop, const Sched& S, const Epi& E) {
    const int wid = __builtin_amdgcn_readfirstlane(tid >> 6), lane = tid & 63, wr = wid >> 2, wc = wid & 3, fr = lane & 15, fq = lane >> 4;
    const int nt = Kloop / BK;
    unsigned voffA[2], voffB[2];
#pragma unroll
    for (int i = 0; i < 2; ++i) { int R, C; stage_rc(tid * 16 + i * 8192, R, C); const int Rb = Epi::PERM ? ((R & ~31) + perm32(R & 31)) : R;
        voffA[i] = (unsigned)(R * ldk + C) * 2u; voffB[i] = (unsigned)(Rb * ldk + C) * 2u; }
    const size_t kstep = (size_t)(BK * 2);
    const size_t hstep = (size_t)HALF * ldk * 2;
    const unsigned ldsw = (unsigned)wid * 1024u;
    const int aoff = lds_byte(wr * 64 + fr, fq * 8), boff = lds_byte(wc * 32 + fr, fq * 8);
#define PG8_SA(b, h) (((b) * 2 + (h)) * HTB)
#define PG8_SB(b, h) ((4 + (b) * 2 + (h)) * HTB)
#define PG8_STAGE(bufoff, gbase, voff) do { _Pragma("unroll") for (int _i = 0; _i < 2; ++_i) \
        __builtin_amdgcn_global_load_lds((const unsigned*)((const char*)(gbase) + (voff)[_i]), (LAS unsigned*)(lds + (bufoff) + ldsw + _i * 8192), 16, 0, 0); } while (0)
#define PG8_LDA(dst, b, h) do { _Pragma("unroll") for (int m = 0; m < 4; ++m) _Pragma("unroll") for (int k = 0; k < 2; ++k) dst[m][k] = *(const LAS bf16x8*)(lds + PG8_SA(b, h) + aoff + m * 2048 + k * 1024); } while (0)
#define PG8_LDB(dst, b, h) do { _Pragma("unroll") for (int n = 0; n < 2; ++n) _Pragma("unroll") for (int k = 0; k < 2; ++k) dst[n][k] = *(const LAS bf16x8*)(lds + PG8_SB(b, h) + boff + n * 2048 + k * 1024); } while (0)
#define PG8_MMA(ai, bj, At, Bt) do { __builtin_amdgcn_s_setprio(1); _Pragma("unroll") for (int m = 0; m < 4; ++m) _Pragma("unroll") for (int n = 0; n < 2; ++n) _Pragma("unroll") for (int k = 0; k < 2; ++k) \
        acc[ai][bj][m][n] = __builtin_amdgcn_mfma_f32_16x16x32_bf16(Bt[n][k], At[m][k], acc[ai][bj][m][n], 0, 0, 0); __builtin_amdgcn_s_setprio(0); } while (0)
#define PG8_WAIT_V(n) asm volatile("s_waitcnt vmcnt(" #n ")" ::: "memory")
#define PG8_WAIT_L(n) asm volatile("s_waitcnt lgkmcnt(" #n ")" ::: "memory")
#define PG8_BAR __builtin_amdgcn_s_barrier()
#define PG8_SCHED __builtin_amdgcn_sched_barrier(0)
    Unit cur, nxt; int ui = 0;
    if (!S.next(0, cur)) return;
    f32x4 acc[2][2][4][2];
#pragma unroll
    for (int a = 0; a < 2; ++a)
#pragma unroll
        for (int b = 0; b < 2; ++b)
#pragma unroll
            for (int m = 0; m < 4; ++m)
#pragma unroll
                for (int n = 0; n < 2; ++n) acc[a][b][m][n] = (f32x4){0.f, 0.f, 0.f, 0.f};
    bf16x8 At[4][2], B0[2][2], B1[2][2];
    const char* cA = cur.A; const char* cB = cur.B;
    PG8_STAGE(PG8_SB(0, 0), cB, voffB); PG8_STAGE(PG8_SA(0, 0), cA, voffA); PG8_STAGE(PG8_SB(0, 1), cB + hstep, voffB); PG8_STAGE(PG8_SA(0, 1), cA + hstep, voffA);
    if (wr == 1) PG8_BAR;
    PG8_WAIT_V(4); PG8_BAR;
    PG8_STAGE(PG8_SB(1, 0), cB + kstep, voffB); PG8_STAGE(PG8_SA(1, 0), cA + kstep, voffA); PG8_STAGE(PG8_SB(1, 1), cB + hstep + kstep, voffB);
    PG8_WAIT_V(6); PG8_BAR;
    for (;;) {
        const bool has_next = S.next(ui + 1, nxt);
        const char* nA = has_next ? nxt.A : cA; const char* nB = has_next ? nxt.B : cB;
        for (int t = 0; t < nt; t += 2) {
            const bool last = (t == nt - 2);
            const char* a1 = cA + (size_t)(t + 1) * kstep;
            const char* a2 = last ? nA : cA + (size_t)(t + 2) * kstep; const char* b2 = last ? nB : cB + (size_t)(t + 2) * kstep;
            const char* a3 = a2 + kstep; const char* b3 = b2 + kstep;
            PG8_LDB(B0, 0, 0); PG8_SCHED; PG8_LDA(At, 0, 0); PG8_STAGE(PG8_SA(1, 1), a1 + hstep, voffA);
            PG8_WAIT_L(8); PG8_BAR; PG8_WAIT_L(0); PG8_MMA(0, 0, At, B0); PG8_BAR; PG8_SCHED;
            PG8_LDB(B1, 0, 1); PG8_STAGE(PG8_SB(0, 0), b2, voffB);
            PG8_BAR; PG8_WAIT_L(0); PG8_MMA(0, 1, At, B1); PG8_BAR;
            PG8_LDA(At, 0, 1); PG8_STAGE(PG8_SA(0, 0), a2, voffA);
            PG8_BAR; PG8_WAIT_L(0); PG8_MMA(1, 0, At, B0); PG8_BAR; PG8_SCHED;
            PG8_STAGE(PG8_SB(0, 1), b2 + hstep, voffB);
            PG8_WAIT_V(6); PG8_BAR; PG8_MMA(1, 1, At, B1); PG8_BAR;
            PG8_LDB(B0, 1, 0); PG8_SCHED; PG8_LDA(At, 1, 0); PG8_STAGE(PG8_SA(0, 1), a2 + hstep, voffA);
            PG8_WAIT_L(8); PG8_BAR; PG8_WAIT_L(0); PG8_MMA(0, 0, At, B0); PG8_BAR; PG8_SCHED;
            PG8_LDB(B1, 1, 1); PG8_STAGE(PG8_SB(1, 0), b3, voffB);
            PG8_BAR; PG8_WAIT_L(0); PG8_MMA(0, 1, At, B1); PG8_BAR;
            PG8_LDA(At, 1, 1); PG8_STAGE(PG8_SA(1, 0), a3, voffA);
            PG8_BAR; PG8_WAIT_L(0); PG8_MMA(1, 0, At, B0); PG8_BAR; PG8_SCHED;
            PG8_STAGE(PG8_SB(1, 1), b3 + hstep, voffB);
            PG8_WAIT_V(6); PG8_BAR; PG8_MMA(1, 1, At, B1); PG8_BAR;
        }
        E(acc, cur, wr, wc, fr, fq);
        if (!has_next) break;
#pragma unroll
        for (int a = 0; a < 2; ++a)
#pragma unroll
            for (int b = 0; b < 2; ++b)
#pragma unroll
                for (int m = 0; m < 4; ++m)
#pragma unroll
                    for (int n = 0; n < 2; ++n) acc[a][b][m][n] = (f32x4){0.f, 0.f, 0.f, 0.f};
        cur = nxt; cA = nA; cB = nB; ++ui;
    }
    PG8_WAIT_V(0);
    if (wr == 0) PG8_BAR;
    PG8_BAR;
#undef PG8_SA
#undef PG8_SB
#undef PG8_STAGE
#undef PG8_LDA
#undef PG8_LDB
#undef PG8_MMA
#undef PG8_WAIT_V
#undef PG8_WAIT_L
#undef PG8_BAR
#undef PG8_SCHED
}
}

#define XB_TMO      128
#define XB_XCNT(j)  (256  + 64 * (j))
#define XB_XSUB(j)  (1280 + 64 * (j))
#define XB_XGEN(j)  (2304 + 64 * (j))
#define XB_TOP      3328
#define XB_TOPGEN   3392
#define XCD_BAR_WORDS 3456
#define XB_SPIN_CAP (1u << 18)
__device__ __forceinline__ unsigned xb_ld(unsigned* p)              { return __hip_atomic_load(p, __ATOMIC_RELAXED, __HIP_MEMORY_SCOPE_AGENT); }
__device__ __forceinline__ unsigned xb_add(unsigned* p, unsigned v) { return __hip_atomic_fetch_add(p, v, __ATOMIC_RELAXED, __HIP_MEMORY_SCOPE_AGENT); }
__device__ __forceinline__ unsigned xb_xcc_id() { return (unsigned)__builtin_amdgcn_s_getreg((3 << 11) | 20) & 0xFu; }
#define XB_SPIN(cond, bar) do { unsigned _sp = 0; while (cond) { __builtin_amdgcn_s_sleep(1); \
    if ((++_sp & 255u) == 0u) { if (xb_ld(&(bar)[XB_TMO])) break; if (_sp > XB_SPIN_CAP) { atomicAdd(&(bar)[XB_TMO], 1u); break; } } } } while (0)
struct XcdBarrier { unsigned* bar; unsigned x; volatile LAS unsigned* st; };
__device__ __forceinline__ XcdBarrier xcd_barrier_post(unsigned* bar, volatile LAS unsigned* st) {
    XcdBarrier b; b.bar = bar; b.x = xb_xcc_id(); b.st = st;
    if (threadIdx.x == 0) (void)xb_add(&bar[XB_XCNT(b.x)], 1u);
    return b;
}
__device__ __forceinline__ void xcd_barrier_complete(unsigned* bar, unsigned x, unsigned& nloc, unsigned& nx) {
    const unsigned G = gridDim.x * gridDim.y * gridDim.z;
    unsigned sum, cnt, mine, sp = 0u;
    for (;;) {
        sum = 0u; cnt = 0u; mine = 0u;
#pragma unroll
        for (unsigned j = 0; j < 16; ++j) { const unsigned c = xb_ld(&bar[XB_XCNT(j)]); sum += c; cnt += (c > 0u) ? 1u : 0u; mine = (j == x) ? c : mine; }
        if (sum == G) break;
        __builtin_amdgcn_s_sleep(1);
        if ((++sp & 255u) == 0u) { if (xb_ld(&bar[XB_TMO])) break; if (sp > XB_SPIN_CAP) { atomicAdd(&bar[XB_TMO], 1u); break; } }
    }
    nloc = mine > 0u ? mine : 1u; nx = cnt > 0u ? cnt : 1u;
}
__device__ __forceinline__ void xcd_barrier(const XcdBarrier& b) {
    asm volatile("s_waitcnt vmcnt(0)" ::: "memory");
    __syncthreads();
    int tid0 = threadIdx.x; asm volatile("" : "+v"(tid0));
    if (tid0 == 0) {
        unsigned* bar = b.bar;
        __builtin_amdgcn_s_waitcnt(0);
        unsigned nloc = b.st[0], nx = b.st[1];
        if (nloc == 0u) { xcd_barrier_complete(bar, b.x, nloc, nx); b.st[0] = nloc; b.st[1] = nx; }
        const unsigned old = xb_add(&bar[XB_XSUB(b.x)], 1u);
        const unsigned gen = old / nloc;
        if (old + 1u == (gen + 1u) * nloc) {
            __builtin_amdgcn_fence(__ATOMIC_RELEASE, "agent");
            asm volatile("s_waitcnt vmcnt(0)" ::: "memory");
            const unsigned og = xb_add(&bar[XB_TOP], 1u);
            const unsigned tg = og / nx;
            if (og + 1u == (tg + 1u) * nx) xb_add(&bar[XB_TOPGEN], 1u);
            else XB_SPIN(xb_ld(&bar[XB_TOPGEN]) == tg, bar);
            __builtin_amdgcn_fence(__ATOMIC_ACQUIRE, "agent");
            xb_add(&bar[XB_XGEN(b.x)], 1u);
            asm volatile("s_waitcnt vmcnt(0)" ::: "memory");
        } else {
            XB_SPIN(xb_ld(&bar[XB_XGEN(b.x)]) == gen, bar);
            __builtin_amdgcn_fence(__ATOMIC_ACQUIRE, "agent");
            asm volatile("s_waitcnt vmcnt(0)" ::: "memory");
        }
    }
    __syncthreads();
}

__device__ __forceinline__ void lds_barrier() { asm volatile("s_waitcnt lgkmcnt(0)" ::: "memory"); __builtin_amdgcn_s_barrier(); asm volatile("" ::: "memory"); }
struct Ctx { int tid, wv, lane, G, bid; LAS unsigned char* lds; unsigned char* seg; };

template <int MODE>
__device__ __forceinline__ void convT_tile(const Ctx& c, const float* src, int ldsrc, int Ksrc, int k0, int n0, bf16_t* dst, int ldd, int koff) {
    LAS float* tile = (LAS float*)c.lds;
    __syncthreads();
#pragma unroll
    for (int rep = 0; rep < 2; ++rep) {
        const int i = (c.tid >> 4) + 32 * rep, j4 = (c.tid & 15) * 4; const int n = n0 + j4; int sc = n;
        if (MODE == 1) sc = (n < RW_SHIFT) ? n : (n < P1W ? -1 : n - (P1W - RW_SHIFT));
        f32x4 v = (f32x4){0.f, 0.f, 0.f, 0.f};
        if (sc >= 0 && (k0 + i) < Ksrc) v = *(const f32x4*)(src + (size_t)(k0 + i) * ldsrc + sc);
        tile[i * 65 + j4 + 0] = v[0]; tile[i * 65 + j4 + 1] = v[1]; tile[i * 65 + j4 + 2] = v[2]; tile[i * 65 + j4 + 3] = v[3];
    }
    __syncthreads();
    { const int j = c.tid >> 3, i8 = (c.tid & 7) * 8;
      if (k0 + i8 < Ksrc) {
        u32x4 w; w.x = pk2(tile[(i8 + 0) * 65 + j], tile[(i8 + 1) * 65 + j]); w.y = pk2(tile[(i8 + 2) * 65 + j], tile[(i8 + 3) * 65 + j]);
        w.z = pk2(tile[(i8 + 4) * 65 + j], tile[(i8 + 5) * 65 + j]); w.w = pk2(tile[(i8 + 6) * 65 + j], tile[(i8 + 7) * 65 + j]);
        *(u32x4*)(dst + (size_t)(n0 + j) * ldd + koff + k0 + i8) = w; } }
}

__device__ __forceinline__ void rms_row_bf16(const float* src, const float* g, bf16_t* dst, int lane) {
    f32x4 v[4]; float ss = 0.f;
#pragma unroll
    for (int i = 0; i < 4; ++i) { v[i] = *(const f32x4*)(src + i * 256 + lane * 4); ss += v[i][0] * v[i][0] + v[i][1] * v[i][1] + v[i][2] * v[i][2] + v[i][3] * v[i][3]; }
    ss = wsum(ss); const float rs = rsqrtf(ss * (1.0f / 1024.0f) + 1e-6f);
#pragma unroll
    for (int i = 0; i < 4; ++i) { const f32x4 gg = *(const f32x4*)(g + i * 256 + lane * 4);
        u32x2 w; w.x = pk2(v[i][0] * rs * gg[0], v[i][1] * rs * gg[1]); w.y = pk2(v[i][2] * rs * gg[2], v[i][3] * rs * gg[3]);
        *(u32x2*)(dst + i * 256 + lane * 4) = w; }
}
__device__ __forceinline__ float add_slabs(const float* src, const bf16_t* slab, int r, int lane, f32x4 (&v)[4]) {
    float ss = 0.f;
#pragma unroll
    for (int i = 0; i < 4; ++i) { v[i] = *(const f32x4*)(src + i * 256 + lane * 4);
#pragma unroll
        for (int ks = 0; ks < 4; ++ks) { const u32x2 t = *(const u32x2*)(slab + ((size_t)ks * MS + r) * DM + i * 256 + lane * 4);
            v[i][0] += bflo(t.x); v[i][1] += bfhi(t.x); v[i][2] += bflo(t.y); v[i][3] += bfhi(t.y); }
        ss += v[i][0] * v[i][0] + v[i][1] * v[i][1] + v[i][2] * v[i][2] + v[i][3] * v[i][3]; }
    return wsum(ss);
}

__device__ __forceinline__ void phase_apre(const P& p, const Ctx& c, int seg, int wg, int nwg) {
    bf16_t* H = (bf16_t*)(p.ws + OFF_H);
    for (int r = wg * 8 + c.wv; r < MS; r += nwg * 8) { const int b = r >> 9, tl = r & 511; const size_t grow = (size_t)b * SEQ + seg * SEGT + tl;
        rms_row_bf16(p.x + grow * DM, p.norm_g, H + (size_t)r * DM, c.lane); }
}
__device__ __forceinline__ void phase_a5(const P& p, const Ctx& c, int seg) {
    bf16_t* H = (bf16_t*)(p.ws + OFF_H); const bf16_t* slab = (const bf16_t*)(c.seg + S0_SLAB);
    for (int r = c.bid * 8 + c.wv; r < MS; r += c.G * 8) { const int b = r >> 9, tl = r & 511; const size_t grow = (size_t)b * SEQ + seg * SEGT + tl;
        f32x4 v[4]; const float ss = add_slabs(p.x + grow * DM, slab, r, c.lane, v); const float rs = rsqrtf(ss * (1.0f / 1024.0f) + 1e-6f);
#pragma unroll
        for (int i = 0; i < 4; ++i) { const f32x4 gg = *(const f32x4*)(p.norm_g + DM + i * 256 + c.lane * 4);
            *(f32x4*)(p.out + grow * DM + i * 256 + c.lane * 4) = v[i];
            u32x2 w; w.x = pk2(v[i][0] * rs * gg[0], v[i][1] * rs * gg[1]); w.y = pk2(v[i][2] * rs * gg[2], v[i][3] * rs * gg[3]);
            *(u32x2*)(H + (size_t)r * DM + i * 256 + c.lane * 4) = w; } }
}
__device__ __forceinline__ void phase_b5(const P& p, const Ctx& c, int seg) {
    const bf16_t* slab = (const bf16_t*)(c.seg + S1_SLAB);
    for (int r = c.bid * 8 + c.wv; r < MS; r += c.G * 8) { const int b = r >> 9, tl = r & 511; float* row = p.out + ((size_t)b * SEQ + seg * SEGT + tl) * DM;
        f32x4 v[4]; const float ss = add_slabs(row, slab, r, c.lane, v); const float rs = rsqrtf(ss * (1.0f / 1024.0f) + 1e-6f);
#pragma unroll
        for (int i = 0; i < 4; ++i) { const f32x4 gg = *(const f32x4*)(p.final_g + i * 256 + c.lane * 4); f32x4 o;
            o[0] = v[i][0] * rs * gg[0]; o[1] = v[i][1] * rs * gg[1]; o[2] = v[i][2] * rs * gg[2]; o[3] = v[i][3] * rs * gg[3]; *(f32x4*)(row + i * 256 + c.lane * 4) = o; } }
}

__device__ __forceinline__ void phase0(const P& p, const Ctx& c) {
    const int T0 = 16 * 64, T1 = 16 * 120, T2 = 32 * 16, T3 = 32 * 16, T4 = 16 * 16, T5 = 16 * 16, T6 = 24 * 5;
    const int TT = T0 + T1 + T2 + T3 + T4 + T5 + T6;
    for (int t = c.bid; t < TT; t += c.G) {
        int u = t;
        if (u < T0) { convT_tile<0>(c, p.ml_w_in, ML_W, 1024, (u & 15) * 64, (u >> 4) * 64, (bf16_t*)(p.ws + OFF_WT0), 1024, 0); continue; } u -= T0;
        if (u < T1) { convT_tile<1>(c, p.rw_w_in, RW_W, 1024, (u & 15) * 64, (u >> 4) * 64, (bf16_t*)(p.ws + OFF_WT1), 1024, 0); continue; } u -= T1;
        if (u < T2) { convT_tile<0>(c, p.w_out, DM, 2048, (u & 31) * 64, (u >> 5) * 64, (bf16_t*)(p.ws + OFF_WO0T), 2048, 0); continue; } u -= T2;
        if (u < T3) { convT_tile<0>(c, p.w_out + (size_t)DIN * DM, DM, 2048, (u & 31) * 64, (u >> 5) * 64, (bf16_t*)(p.ws + OFF_WO1T), 2048, 0); continue; } u -= T3;
        if (u < T4) { convT_tile<0>(c, p.mem_kv_w, DM, 1024, (u & 15) * 64, (u >> 4) * 64, (bf16_t*)(p.ws + OFF_WKVT), 1024, 0); continue; } u -= T4;
        if (u < T5) { convT_tile<0>(c, p.mem_kv_w + (size_t)DM * DM, DM, 1024, (u & 15) * 64, (u >> 4) * 64, (bf16_t*)(p.ws + OFF_WKVT + 2 * MiB), 1024, 0); continue; } u -= T5;
        { const int nt = u / 5, j = u % 5; bf16_t* L = (bf16_t*)(p.ws + OFF_LORAT);
          if (j == 0) convT_tile<0>(c, p.rw_w_lora2, DMIX, 64, 0, nt * 64, L, 288, 0);
          else if (j == 1) convT_tile<0>(c, p.rw_a_lora2, DMIX, 64, 0, nt * 64, L, 288, 64);
          else if (j == 2) convT_tile<0>(c, p.rw_v_lora2, DMIX, 32, 0, nt * 64, L, 288, 128);
          else convT_tile<0>(c, p.rw_g_lora2, DMIX, 128, (j - 3) * 64, nt * 64, L, 288, 160); }
    }
    for (int r = c.bid * 8 + c.wv; r < 2 * 2048; r += c.G * 8) { const int l = r >> 11, rr = r & 2047;
        rms_row_bf16(p.mem + (size_t)rr * DM, p.mem_norm_g + l * DM, (bf16_t*)(p.ws + OFF_MEMN) + (size_t)r * DM, c.lane); }
}

struct SchedA0 {
    const unsigned char* ws; unsigned char* seg; int G, c, nextra;
    __device__ __forceinline__ bool next(int i, pg8::Unit& u) const {
        const int L = i * G + c; if (L >= 256 + nextra) return false;
        if (L < 256) { int pm, pn; pg8::remap(L, 16, 16, pm, pn);
            u.A = (const char*)(ws + OFF_H) + (size_t)pm * 256 * 1024 * 2; u.B = (const char*)(ws + OFF_WT0) + (size_t)pn * 256 * 1024 * 2;
            u.O = (char*)(seg + S0_P0) + ((size_t)pm * 256 * ML_W + pn * 256) * 2; u.ldc = ML_W; return true; }
        const int e = L - 256, l = e >> 5, j = e & 31;
        const char* memn = (const char*)(ws + OFF_MEMN) + (size_t)l * 2048 * 1024 * 2; const char* wkv = (const char*)(ws + OFF_WKVT) + (size_t)l * 2 * MiB;
        char* kout = (char*)(ws + OFF_KMEM) + (size_t)l * 4 * MiB;
        if (j < 16) { const int pm = j >> 1, pn = j & 1;
            u.A = memn + (size_t)pm * 256 * 1024 * 2; u.B = wkv + (size_t)pn * 256 * 1024 * 2; u.O = kout + ((size_t)pm * 256 * 512 + pn * 256) * 2; u.ldc = 512; }
        else { const int jj = j - 16, pm = jj >> 3, pn = jj & 7;
            u.A = wkv + (size_t)(512 + pm * 256) * 1024 * 2; u.B = memn + (size_t)pn * 256 * 1024 * 2; u.O = kout + 2 * MiB + ((size_t)pm * 256 * 2048 + pn * 256) * 2; u.ldc = 2048; }
        return true;
    }
};
struct SchedB0 {
    const unsigned char* ws; unsigned char* seg; int G, c;
    __device__ __forceinline__ bool next(int i, pg8::Unit& u) const {
        const int L = i * G + c; if (L >= 480) return false;
        int pm, pn; pg8::remap(L, 16, 30, pm, pn);
        u.A = (const char*)(ws + OFF_H) + (size_t)pm * 256 * 1024 * 2; u.B = (const char*)(ws + OFF_WT1) + (size_t)pn * 256 * 1024 * 2;
        if (pn < 20) { u.O = (char*)(seg + S1_P1) + ((size_t)pm * 256 * P1W + pn * 256) * 2; u.ldc = P1W; }
        else { u.O = (char*)(seg + S1_P2) + ((size_t)pm * 256 * P2W + (pn - 20) * 256) * 2; u.ldc = P2W; }
        return true;
    }
};
struct SchedOut {
    const char* Y; const char* W; char* slab; int G, c;
    __device__ __forceinline__ bool next(int i, pg8::Unit& u) const {
        const int L = i * G + c; if (L >= 256) return false;
        const int ks = L >> 6; int pm, pn; pg8::remap(L & 63, 16, 4, pm, pn);
        u.A = Y + ((size_t)pm * 256 * DIN + ks * 512) * 2; u.B = W + ((size_t)pn * 256 * DIN + ks * 512) * 2;
        u.O = slab + (((size_t)ks * MS + pm * 256) * DM + pn * 256) * 2; u.ldc = DM; return true;
    }
};

__device__ __forceinline__ void phase_a1(const P& p, const Ctx& c, int seg) {
    const bf16_t* P0 = (const bf16_t*)(c.seg + S0_P0);
    bf16_t* Qb = (bf16_t*)(c.seg + S0_Q); bf16_t* Kb = (bf16_t*)(c.seg + S0_K); bf16_t* KT = (bf16_t*)(c.seg + S0_KT); bf16_t* VT = (bf16_t*)(c.seg + S0_VT);
    bf16_t* XC = (bf16_t*)(c.seg + S0_XC); bf16_t* VF = (bf16_t*)(p.ws + OFF_VF);
    float* IPRE = (float*)(c.seg + S0_GATE); float* LOGF = IPRE + 32 * SEGT;
    const bf16_t* UT = (const bf16_t*)(p.ws + OFF_UTAIL);
    LAS float* red = (LAS float*)c.lds;
    LAS bf16_t* kst = (LAS bf16_t*)(c.lds + 98304);
    LAS bf16_t* vst = kst + 1536 * 8;
    const int n = c.tid;
    float wq[4][4], wk[4][4], wv[4][4], G12[4][8], G3[4][8];
    if (n < 384) {
#pragma unroll
        for (int i = 0; i < 4; ++i) { const f32x4 a = *(const f32x4*)(p.ml_wq + n * 16 + i * 4), bb = *(const f32x4*)(p.ml_wk + n * 16 + i * 4), cc = *(const f32x4*)(p.ml_wv + n * 16 + i * 4);
#pragma unroll
            for (int o = 0; o < 4; ++o) { wq[i][o] = a[o]; wk[i][o] = bb[o]; wv[i][o] = cc[o]; } }
#pragma unroll
        for (int i = 0; i < 4; ++i)
#pragma unroll
            for (int g = 0; g < 8; ++g) { G12[i][g] = 0.f; G3[i][g] = 0.f; }
#pragma unroll
        for (int o = 0; o < 4; ++o) {
            const float* gq = p.ml_w_gate + (size_t)(n * 4 + o) * 8; const float* gk = p.ml_w_gate + (size_t)(DMIX + n * 4 + o) * 8; const float* gv = p.ml_w_gate + (size_t)(2 * DMIX + n * 4 + o) * 8;
            const f32x4 q0 = *(const f32x4*)gq, q1 = *(const f32x4*)(gq + 4), k0 = *(const f32x4*)gk, k1 = *(const f32x4*)(gk + 4), v0 = *(const f32x4*)gv, v1 = *(const f32x4*)(gv + 4);
#pragma unroll
            for (int i = 0; i < 4; ++i)
#pragma unroll
                for (int g = 0; g < 4; ++g) { G12[i][g] += wq[i][o] * q0[g] + wk[i][o] * k0[g]; G12[i][g + 4] += wq[i][o] * q1[g] + wk[i][o] * k1[g];
                    G3[i][g] += wv[i][o] * v0[g]; G3[i][g + 4] += wv[i][o] * v1[g]; }
        }
    }
#pragma unroll 1
    for (int it = c.bid; it < MS / 8; it += c.G) {
        const int row0 = it * 8, b = row0 >> 9, tl0 = row0 & 511;
        __syncthreads();
        if (n < 384) {
            float um[3][4];
#pragma unroll
            for (int j = 1; j <= 3; ++j) { u32x2 raw = (u32x2){0u, 0u};
                if (tl0 - j >= 0) raw = *(const u32x2*)(P0 + (unsigned)((row0 - j) * ML_W + n * 4));
                else if (seg > 0) raw = *(const u32x2*)(UT + (unsigned)((b * 3 + (3 - j)) * DMIX + n * 4));
                um[3 - j][0] = bflo(raw.x); um[3 - j][1] = bfhi(raw.x); um[3 - j][2] = bflo(raw.y); um[3 - j][3] = bfhi(raw.y); }
            u32x2 nraw = *(const u32x2*)(P0 + (unsigned)(row0 * ML_W + n * 4));
#pragma unroll 1
            for (int tt = 0; tt < 8; ++tt) {
                const unsigned row = (unsigned)(row0 + tt);
                const u32x2 raw = nraw;
                if (tt + 1 < 8) nraw = *(const u32x2*)(P0 + (unsigned)((row + 1) * ML_W + n * 4));
                float u[4] = {bflo(raw.x), bfhi(raw.x), bflo(raw.y), bfhi(raw.y)}, xc[4], q[4], k[4], v[4];
                { int nn = n; asm volatile("" : "+v"(nn));
                  const f32x4 cb = *(const f32x4*)(p.ml_conv_b + nn * 4), c0 = *(const f32x4*)(p.ml_conv_w + nn * 4), c1 = *(const f32x4*)(p.ml_conv_w + DMIX + nn * 4),
                              c2 = *(const f32x4*)(p.ml_conv_w + 2 * DMIX + nn * 4), c3 = *(const f32x4*)(p.ml_conv_w + 3 * DMIX + nn * 4);
#pragma unroll
                  for (int i = 0; i < 4; ++i) { const float y = cb[i] + c0[i] * um[0][i] + c1[i] * um[1][i] + c2[i] * um[2][i] + c3[i] * u[i]; xc[i] = siluf_(y); } }
                const float ks = 0.05103103630798288f;
#pragma unroll
                for (int o = 0; o < 4; ++o) { q[o] = xc[0] * wq[0][o] + xc[1] * wq[1][o] + xc[2] * wq[2][o] + xc[3] * wq[3][o];
                    k[o] = (xc[0] * wk[0][o] + xc[1] * wk[1][o] + xc[2] * wk[2][o] + xc[3] * wk[3][o]) * ks;
                    v[o] = u[0] * wv[0][o] + u[1] * wv[1][o] + u[2] * wv[2][o] + u[3] * wv[3][o]; }
#pragma unroll
                for (int g = 0; g < 8; ++g) red[(tt * 8 + g) * 384 + n] = xc[0] * G12[0][g] + xc[1] * G12[1][g] + xc[2] * G12[2][g] + xc[3] * G12[3][g] + u[0] * G3[0][g] + u[1] * G3[1][g] + u[2] * G3[2][g] + u[3] * G3[3][g];
                u32x2 w; w.x = pk2(q[0], q[1]); w.y = pk2(q[2], q[3]); *(u32x2*)(Qb + (unsigned)(row * DMIX + n * 4)) = w;
                w.x = pk2(k[0], k[1]); w.y = pk2(k[2], k[3]); *(u32x2*)(Kb + (unsigned)(row * DMIX + n * 4)) = w;
                w.x = pk2(xc[0], xc[1]); w.y = pk2(xc[2], xc[3]); *(u32x2*)(XC + (unsigned)(row * DMIX + n * 4)) = w;
                w.x = pk2(v[0], v[1]); w.y = pk2(v[2], v[3]); *(u32x2*)(VF + (unsigned)(row * DMIX + n * 4)) = w;
#pragma unroll
                for (int o = 0; o < 4; ++o) { kst[(n * 4 + o) * 8 + tt] = f2bf(k[o]); vst[(n * 4 + o) * 8 + tt] = f2bf(v[o]); }
#pragma unroll
                for (int i = 0; i < 4; ++i) { um[0][i] = um[1][i]; um[1][i] = um[2][i]; um[2][i] = u[i]; }
            }
            const int hd = n / 96, dch = (n % 96) * 4;
#pragma unroll
            for (int o = 0; o < 4; ++o) { const unsigned off = (unsigned)(((b * 4 + hd) * 384 + dch + o) * SEGT + tl0);
                *(u32x4*)(KT + off) = *(const LAS u32x4*)(kst + (n * 4 + o) * 8); *(u32x4*)(VT + off) = *(const LAS u32x4*)(vst + (n * 4 + o) * 8); }
        }
        __syncthreads();
        { const int v = c.tid >> 3, part = c.tid & 7; float s = 0.f;
#pragma unroll 8
          for (int i = 0; i < 48; ++i) s += red[v * 384 + part * 48 + i];
          s += __shfl_xor(s, 1); s += __shfl_xor(s, 2); s += __shfl_xor(s, 4);
          if (part == 0) { const int tt = v >> 3, g = v & 7; const float gate = s + p.ml_b_gate[g];
              if (g < 4) IPRE[(b * 4 + g) * SEGT + tl0 + tt] = gate; else LOGF[(b * 4 + g - 4) * SEGT + tl0 + tt] = -softplusf_(-gate); } }
    }
}

__device__ __forceinline__ void attn_item(const P& p, const Ctx& c, int layer, int it, const bf16_t* Qp, int ldq, bf16_t* YM) {
    const int b = it >> 3, head = (it >> 1) & 3, qb = it & 1;
    const bf16_t* Kg = (const bf16_t*)(p.ws + OFF_KMEM + (size_t)layer * 4 * MiB) + (size_t)(b * 256) * 512 + head * 128;
    const bf16_t* Vg = (const bf16_t*)(p.ws + OFF_KMEM + (size_t)layer * 4 * MiB + 2 * MiB) + (size_t)(head * 128) * 2048 + b * 256;
    LAS bf16_t* Ks = (LAS bf16_t*)c.lds;
    LAS bf16_t* Vs = Ks + 256 * 136;
    const int l15 = c.lane & 15, quad = c.lane >> 4;
    __syncthreads();
#pragma unroll
    for (int r = 0; r < 8; ++r) { const int id = c.tid + 512 * r; { const int i = id >> 4, c8 = (id & 15) * 8; *(LAS u32x4*)(Ks + i * 136 + c8) = *(const u32x4*)(Kg + (size_t)i * 512 + c8); }
        { const int i = id >> 5, c8 = (id & 31) * 8; *(LAS u32x4*)(Vs + i * 264 + c8) = *(const u32x4*)(Vg + (size_t)i * 2048 + c8); } }
    __syncthreads();
#pragma unroll 1
    for (int pass = 0; pass < 2; ++pass) {
        const int row0 = b * SEGT + qb * 256 + c.wv * 32 + pass * 16;
        bf16x8 qf[4];
#pragma unroll
        for (int kk = 0; kk < 4; ++kk) qf[kk] = *(const bf16x8*)(Qp + (size_t)(row0 + l15) * ldq + head * 128 + kk * 32 + quad * 8);
        f32x4 acc[16];
#pragma unroll
        for (int mt = 0; mt < 16; ++mt) { acc[mt] = (f32x4){0.f, 0.f, 0.f, 0.f};
#pragma unroll
            for (int kk = 0; kk < 4; ++kk) { const bf16x8 a = *(const LAS bf16x8*)(Ks + (mt * 16 + l15) * 136 + kk * 32 + quad * 8); acc[mt] = mfma16(a, qf[kk], acc[mt]); }
            if ((mt & 3) == 3) __builtin_amdgcn_sched_barrier(0); }
        float mx = -1e30f;
#pragma unroll
        for (int mt = 0; mt < 16; ++mt)
#pragma unroll
            for (int j = 0; j < 4; ++j) mx = fmaxf(mx, acc[mt][j]);
        mx = fmaxf(mx, __shfl_xor(mx, 16)); mx = fmaxf(mx, __shfl_xor(mx, 32));
        const float sc = 0.08838834764831845f * 1.4426950408889634f; float sm = 0.f;
#pragma unroll
        for (int mt = 0; mt < 16; ++mt)
#pragma unroll
            for (int j = 0; j < 4; ++j) { const float e = exp2f((acc[mt][j] - mx) * sc); acc[mt][j] = e; sm += e; }
        sm += __shfl_xor(sm, 16); sm += __shfl_xor(sm, 32);
        const float inv = 1.0f / sm;
        bf16x8 pa[8];
#pragma unroll
        for (int kp = 0; kp < 8; ++kp) {
            u32x4 aw; aw.x = pk2(acc[2 * kp][0] * inv, acc[2 * kp][1] * inv); aw.y = pk2(acc[2 * kp][2] * inv, acc[2 * kp][3] * inv);
            aw.z = pk2(acc[2 * kp + 1][0] * inv, acc[2 * kp + 1][1] * inv); aw.w = pk2(acc[2 * kp + 1][2] * inv, acc[2 * kp + 1][3] * inv);
            __builtin_memcpy(&pa[kp], &aw, 16); }
        __builtin_amdgcn_sched_barrier(0);
        f32x4 o[8];
#pragma unroll
        for (int nt = 0; nt < 8; ++nt) o[nt] = (f32x4){0.f, 0.f, 0.f, 0.f};
#pragma unroll
        for (int kp = 0; kp < 8; ++kp) {
            const bf16x8 a = pa[kp];
#pragma unroll
            for (int nt = 0; nt < 8; ++nt) { const LAS bf16_t* vp = Vs + (nt * 16 + l15) * 264 + 2 * kp * 16 + quad * 4;
                const u32x2 lo = *(const LAS u32x2*)vp, hi = *(const LAS u32x2*)(vp + 16); u32x4 bw = (u32x4){lo.x, lo.y, hi.x, hi.y}; bf16x8 bfr; __builtin_memcpy(&bfr, &bw, 16);
                o[nt] = mfma16(a, bfr, o[nt]); }
            __builtin_amdgcn_sched_barrier(0);
        }
#pragma unroll
        for (int nt = 0; nt < 8; ++nt)
#pragma unroll
            for (int j = 0; j < 4; ++j) YM[(size_t)(row0 + quad * 4 + j) * DX + head * 128 + nt * 16 + l15] = f2bf(o[nt][j]);
    }
}

__device__ __forceinline__ void mlstm_item(const P& p, const Ctx& c, int seg, int w, bool save) {
    const int b = w / 24, h = (w / 6) & 3, sl = w % 6;
    const bf16_t* Qb = (const bf16_t*)(c.seg + S0_Q); const bf16_t* Kb = (const bf16_t*)(c.seg + S0_K); const bf16_t* KT = (const bf16_t*)(c.seg + S0_KT); const bf16_t* VT = (const bf16_t*)(c.seg + S0_VT);
    const float* IPRE = (const float*)(c.seg + S0_GATE); const float* LOGF = IPRE + 32 * SEGT;
    float* HR = (float*)(c.seg + S0_HRAW);
    float* CST = (float*)(p.ws + OFF_CST) + (size_t)w * 64 * 384; float* NST = (float*)(p.ws + OFF_NST) + (size_t)w * 384;
    LAS bf16_t* Cimg = (LAS bf16_t*)c.lds;
    LAS bf16_t* Qs = Cimg + 64 * 392;
    LAS bf16_t* Ks = Qs + 64 * 136;
    LAS bf16_t* KTs = Ks + 64 * 136;
    LAS bf16_t* VTs = KTs + 128 * 72;
    LAS bf16_t* VWs = VTs + 64 * 72;
    LAS bf16_t* Sp = VWs + 64 * 72;
    LAS float* fl = (LAS float*)(Sp + 64 * 72);
    LAS float* bcum = fl; LAS float* ipr = fl + 64; LAS float* wgt = fl + 128; LAS float* gin = fl + 192; LAS float* qn = fl + 256; LAS float* rden = fl + 320;
    LAS float* gtotp = fl + 384; LAS float* nold = fl + 400; LAS float* nnew = fl + 800;
    const int l15c = c.lane & 15, quadc = c.lane >> 4, e16 = c.wv & 3, par = c.wv >> 2;
    f32x4 C[12];
    __syncthreads();
    if (seg > 0) {
#pragma unroll
        for (int j = 0; j < 12; ++j)
#pragma unroll
            for (int jj = 0; jj < 4; ++jj) C[j][jj] = CST[(size_t)(e16 * 16 + quadc * 4 + jj) * 384 + (2 * j + par) * 16 + l15c];
        if (c.tid < 384) nold[c.tid] = NST[c.tid];
    } else {
#pragma unroll
        for (int j = 0; j < 12; ++j) C[j] = (f32x4){0.f, 0.f, 0.f, 0.f};
        if (c.tid < 384) nold[c.tid] = 0.f;
    }
    u32x4 pq[2], pk[2], pt[2], pvt; float plf = 0.f, pip = 0.f;
    auto gl_piece = [&](int ch, int pp, int tidv) {
#pragma unroll
        for (int r = 0; r < 2; ++r) { const int id = tidv + 512 * r;
            { const int i = id >> 4, c8 = (id & 15) * 8; const size_t go = ((size_t)b * SEGT + ch * 64 + i) * DMIX + h * 384 + pp * 128 + c8; pq[r] = *(const u32x4*)(Qb + go); pk[r] = *(const u32x4*)(Kb + go); }
            { const int dd = id >> 3, c8 = (id & 7) * 8; pt[r] = *(const u32x4*)(KT + ((size_t)(b * 4 + h) * 384 + pp * 128 + dd) * SEGT + ch * 64 + c8); } } };
    auto gl_chunk = [&](int ch, int tidv) { const int i = tidv >> 3, c8 = (tidv & 7) * 8;
        pvt = *(const u32x4*)(VT + ((size_t)(b * 4 + h) * 384 + sl * 64 + i) * SEGT + ch * 64 + c8);
        if (c.wv == 0) { plf = LOGF[(b * 4 + h) * SEGT + ch * 64 + c.lane]; pip = IPRE[(b * 4 + h) * SEGT + ch * 64 + c.lane]; } };
    { int t0 = c.tid; asm volatile("" : "+v"(t0)); gl_chunk(0, t0); gl_piece(0, 0, t0); }
#pragma unroll 1
    for (int ch = 0; ch < 8; ++ch) {
        const int tl0 = ch * 64; const size_t row0 = (size_t)b * SEGT + tl0;
        int tidv = c.tid, l15 = l15c, quad = quadc;
        asm volatile("" : "+v"(tidv), "+v"(l15), "+v"(quad));
        lds_barrier();
        if (c.wv == 0) {
            float bc = plf;
#pragma unroll
            for (int o = 1; o < 64; o <<= 1) { const float t = __shfl_up(bc, o); if (c.lane >= o) bc += t; }
            const float bl = __shfl(bc, 63);
            bcum[c.lane] = bc; ipr[c.lane] = pip; wgt[c.lane] = __expf(bl - bc + pip); gin[c.lane] = __expf(bc);
            if (c.lane == 0) gtotp[0] = __expf(bl);
        }
#pragma unroll
        for (int j = 0; j < 12; ++j)
#pragma unroll
            for (int jj = 0; jj < 4; ++jj) Cimg[(e16 * 16 + quad * 4 + jj) * 392 + (2 * j + par) * 16 + l15] = f2bf(C[j][jj]);
        lds_barrier();
        { const int i = tidv >> 3, c8 = (tidv & 7) * 8;
          const u32x4 raw = pvt;
          *(LAS u32x4*)(VTs + i * 72 + c8) = raw;
          const f32x4 w0 = *(const LAS f32x4*)(wgt + c8), w1 = *(const LAS f32x4*)(wgt + c8 + 4);
          u32x4 sw; sw.x = pk2(bflo(raw.x) * w0[0], bfhi(raw.x) * w0[1]); sw.y = pk2(bflo(raw.y) * w0[2], bfhi(raw.y) * w0[3]);
          sw.z = pk2(bflo(raw.z) * w1[0], bfhi(raw.z) * w1[1]); sw.w = pk2(bflo(raw.w) * w1[2], bfhi(raw.w) * w1[3]);
          *(LAS u32x4*)(VWs + i * 72 + c8) = sw; }
        if (ch + 1 < 8) gl_chunk(ch + 1, tidv);
        const float gtot = gtotp[0];
#pragma unroll
        for (int j = 0; j < 12; ++j) C[j] *= gtot;
        f32x4 Sa[2], Ia[2]; Sa[0] = Sa[1] = Ia[0] = Ia[1] = (f32x4){0.f, 0.f, 0.f, 0.f};
        float qnacc = 0.f;
#pragma unroll
        for (int pp = 0; pp < 3; ++pp) {
            const int d0 = pp * 128;
            __builtin_amdgcn_sched_barrier(0);
            asm volatile("" : "+v"(tidv));
            lds_barrier();
#pragma unroll
            for (int r = 0; r < 2; ++r) { const int id = tidv + 512 * r;
                { const int i = id >> 4, c8 = (id & 15) * 8; *(LAS u32x4*)(Qs + i * 136 + c8) = pq[r]; *(LAS u32x4*)(Ks + i * 136 + c8) = pk[r]; }
                { const int dd = id >> 3, c8 = (id & 7) * 8; *(LAS u32x4*)(KTs + dd * 72 + c8) = pt[r]; } }
            lds_barrier();
            if (pp < 2) gl_piece(ch, pp + 1, tidv); else if (ch + 1 < 8) gl_piece(ch + 1, 0, tidv);
            { const int tm = c.wv >> 1, tn0 = (c.wv & 1) * 2;
#pragma unroll
              for (int kk = 0; kk < 4; ++kk) { const bf16x8 a = *(const LAS bf16x8*)(Qs + (tm * 16 + l15) * 136 + kk * 32 + quad * 8);
#pragma unroll
                  for (int x = 0; x < 2; ++x) { const int tn = tn0 + x;
                      const bf16x8 bk = *(const LAS bf16x8*)(Ks + (tn * 16 + l15) * 136 + kk * 32 + quad * 8);
                      const bf16x8 bc = *(const LAS bf16x8*)(Cimg + (tn * 16 + l15) * 392 + d0 + kk * 32 + quad * 8);
                      Sa[x] = mfma16(a, bk, Sa[x]); Ia[x] = mfma16(a, bc, Ia[x]); } } }
            { const bf16x8 va0 = *(const LAS bf16x8*)(VWs + (e16 * 16 + l15) * 72 + quad * 8), va1 = *(const LAS bf16x8*)(VWs + (e16 * 16 + l15) * 72 + 32 + quad * 8);
#pragma unroll
              for (int jl = 0; jl < 4; ++jl) { const int ntl = 2 * jl + par, j = pp * 4 + jl;
                  C[j] = mfma16(va0, *(const LAS bf16x8*)(KTs + (ntl * 16 + l15) * 72 + quad * 8), C[j]);
                  C[j] = mfma16(va1, *(const LAS bf16x8*)(KTs + (ntl * 16 + l15) * 72 + 32 + quad * 8), C[j]); } }
            { const int t = tidv >> 3, part = tidv & 7;
              const u32x4 q0 = *(const LAS u32x4*)(Qs + t * 136 + part * 16), q1 = *(const LAS u32x4*)(Qs + t * 136 + part * 16 + 8);
              const LAS float* np = nold + d0 + part * 16; const f32x4 n0 = *(const LAS f32x4*)np, n1 = *(const LAS f32x4*)(np + 4), n2 = *(const LAS f32x4*)(np + 8), n3 = *(const LAS f32x4*)(np + 12);
              qnacc += bflo(q0.x) * n0[0] + bfhi(q0.x) * n0[1] + bflo(q0.y) * n0[2] + bfhi(q0.y) * n0[3] + bflo(q0.z) * n1[0] + bfhi(q0.z) * n1[1] + bflo(q0.w) * n1[2] + bfhi(q0.w) * n1[3]
                     + bflo(q1.x) * n2[0] + bfhi(q1.x) * n2[1] + bflo(q1.y) * n2[2] + bfhi(q1.y) * n2[3] + bflo(q1.z) * n3[0] + bfhi(q1.z) * n3[1] + bflo(q1.w) * n3[2] + bfhi(q1.w) * n3[3]; }
            { const int dd = tidv >> 2, part = tidv & 3;
              const u32x4 k0 = *(const LAS u32x4*)(KTs + dd * 72 + part * 16), k1 = *(const LAS u32x4*)(KTs + dd * 72 + part * 16 + 8);
              const LAS float* wp = wgt + part * 16; const f32x4 w0 = *(const LAS f32x4*)wp, w1 = *(const LAS f32x4*)(wp + 4), w2 = *(const LAS f32x4*)(wp + 8), w3 = *(const LAS f32x4*)(wp + 12);
              float a = bflo(k0.x) * w0[0] + bfhi(k0.x) * w0[1] + bflo(k0.y) * w0[2] + bfhi(k0.y) * w0[3] + bflo(k0.z) * w1[0] + bfhi(k0.z) * w1[1] + bflo(k0.w) * w1[2] + bfhi(k0.w) * w1[3]
                      + bflo(k1.x) * w2[0] + bfhi(k1.x) * w2[1] + bflo(k1.y) * w2[2] + bfhi(k1.y) * w2[3] + bflo(k1.z) * w3[0] + bfhi(k1.z) * w3[1] + bflo(k1.w) * w3[2] + bfhi(k1.w) * w3[3];
              a = dpp_add<0xB1>(a); a = dpp_add<0x4E>(a);
              if (part == 0) nnew[d0 + dd] = gtot * nold[d0 + dd] + a; }
        }
        qnacc = dpp_add<0xB1>(qnacc); qnacc = dpp_add<0x4E>(qnacc); qnacc = dpp_add<0x141>(qnacc);
        if ((tidv & 7) == 0) qn[tidv >> 3] = qnacc;
#pragma unroll
        for (int x = 0; x < 2; ++x) { const int ti = c.wv * 2 + x, tm = ti >> 2, tn = ti & 3; const int s = tn * 16 + l15; const float bs = bcum[s] - ipr[s];
#pragma unroll
            for (int jj = 0; jj < 4; ++jj) { const int t = tm * 16 + quad * 4 + jj; const float v = (s <= t) ? Sa[x][jj] * __expf(bcum[t] - bs) : 0.f; Sp[t * 72 + s] = f2bf(v); } }
        lds_barrier();
        { const int t = tidv >> 3, part = tidv & 7; const u32x4 sr = *(const LAS u32x4*)(Sp + t * 72 + part * 8);
          float ds = bflo(sr.x) + bfhi(sr.x) + bflo(sr.y) + bfhi(sr.y) + bflo(sr.z) + bfhi(sr.z) + bflo(sr.w) + bfhi(sr.w);
          ds = dpp_add<0xB1>(ds); ds = dpp_add<0x4E>(ds); ds = dpp_add<0x141>(ds);
          if (part == 0) { const float den = ds + gin[t] * qn[t]; rden[t] = 1.0f / fmaxf(fabsf(den), 1.0f); } }
#pragma unroll
        for (int x = 0; x < 2; ++x) { const int ti = c.wv * 2 + x, tm = ti >> 2, tn = ti & 3;
#pragma unroll
            for (int jj = 0; jj < 4; ++jj) Ia[x][jj] *= gin[tm * 16 + quad * 4 + jj];
#pragma unroll
            for (int kk = 0; kk < 2; ++kk) { const bf16x8 a = *(const LAS bf16x8*)(Sp + (tm * 16 + l15) * 72 + kk * 32 + quad * 8);
                const bf16x8 bb = *(const LAS bf16x8*)(VTs + (tn * 16 + l15) * 72 + kk * 32 + quad * 8); Ia[x] = mfma16(a, bb, Ia[x]); } }
        lds_barrier();
#pragma unroll
        for (int x = 0; x < 2; ++x) { const int ti = c.wv * 2 + x, tm = ti >> 2, tn = ti & 3;
#pragma unroll
            for (int jj = 0; jj < 4; ++jj) { const int t = tm * 16 + quad * 4 + jj; HR[(row0 + t) * DMIX + h * 384 + sl * 64 + tn * 16 + l15] = Ia[x][jj] * rden[t]; } }
        if (c.tid < 384) nold[c.tid] = nnew[c.tid];
    }
    lds_barrier();
    if (!save) return;
#pragma unroll
    for (int j = 0; j < 12; ++j)
#pragma unroll
        for (int jj = 0; jj < 4; ++jj) CST[(size_t)(e16 * 16 + quadc * 4 + jj) * 384 + (2 * j + par) * 16 + l15c] = C[j][jj];
    if (c.tid < 384) NST[c.tid] = nold[c.tid];
}

__device__ __forceinline__ void phase_a3(const P& p, const Ctx& c, int seg) {
    const bf16_t* P0 = (const bf16_t*)(c.seg + S0_P0); const float* HR = (const float*)(c.seg + S0_HRAW); const bf16_t* XC = (const bf16_t*)(c.seg + S0_XC);
    const bf16_t* YM = (const bf16_t*)(c.seg + S0_YMEM); bf16_t* Y = (bf16_t*)(c.seg + S0_Y); bf16_t* UT = (bf16_t*)(p.ws + OFF_UTAIL);
#pragma unroll 1
    for (int r = c.bid * 8 + c.wv; r < MS; r += c.G * 8) {
        const int b = r >> 9, tl = r & 511;
        float v[3][8]; float mean[3], rstd[3];
#pragma unroll
        for (int ps = 0; ps < 3; ++ps) { const int ch = ps * 512 + c.lane * 8;
            const f32x4 a0 = *(const f32x4*)(HR + (size_t)r * DMIX + ch), a1 = *(const f32x4*)(HR + (size_t)r * DMIX + ch + 4);
            v[ps][0] = a0[0]; v[ps][1] = a0[1]; v[ps][2] = a0[2]; v[ps][3] = a0[3]; v[ps][4] = a1[0]; v[ps][5] = a1[1]; v[ps][6] = a1[2]; v[ps][7] = a1[3]; }
        float hs[4], hq[4];
#pragma unroll
        for (int hd = 0; hd < 4; ++hd) { float s = 0.f, q = 0.f;
#pragma unroll
            for (int ps = 0; ps < 3; ++ps) { if (ps * 512 + 511 < hd * 384 || ps * 512 >= (hd + 1) * 384) continue;
                const bool mine = ((ps * 512 + c.lane * 8) / 384) == hd;
                float ls = 0.f, lq = 0.f;
#pragma unroll
                for (int j = 0; j < 8; ++j) { ls += v[ps][j]; lq += v[ps][j] * v[ps][j]; }
                s += mine ? ls : 0.f; q += mine ? lq : 0.f; }
            hs[hd] = wsum(s); hq[hd] = wsum(q); }
#pragma unroll
        for (int ps = 0; ps < 3; ++ps) { const int hd = (ps * 512 + c.lane * 8) / 384;
            const float s = hd == 0 ? hs[0] : (hd == 1 ? hs[1] : (hd == 2 ? hs[2] : hs[3])), q = hd == 0 ? hq[0] : (hd == 1 ? hq[1] : (hd == 2 ? hq[2] : hq[3]));
            const float m = s * (1.0f / 384.0f); mean[ps] = m; rstd[ps] = rsqrtf(fmaxf(q * (1.0f / 384.0f) - m * m, 0.f) + 1e-5f); }
#pragma unroll
        for (int ps = 0; ps < 3; ++ps) { const int ch = ps * 512 + c.lane * 8;
            const u32x4 xr = *(const u32x4*)(XC + (size_t)r * DMIX + ch), zr = *(const u32x4*)(P0 + (size_t)r * ML_W + 2048 + ch);
            const f32x4 g0 = *(const f32x4*)(p.ml_mhn_g + ch), g1 = *(const f32x4*)(p.ml_mhn_g + ch + 4), k0 = *(const f32x4*)(p.ml_skip + ch), k1 = *(const f32x4*)(p.ml_skip + ch + 4);
            const float xx[8] = {bflo(xr.x), bfhi(xr.x), bflo(xr.y), bfhi(xr.y), bflo(xr.z), bfhi(xr.z), bflo(xr.w), bfhi(xr.w)};
            const float zz[8] = {bflo(zr.x), bfhi(zr.x), bflo(zr.y), bfhi(zr.y), bflo(zr.z), bfhi(zr.z), bflo(zr.w), bfhi(zr.w)};
            const float gg[8] = {g0[0], g0[1], g0[2], g0[3], g1[0], g1[1], g1[2], g1[3]}, kk[8] = {k0[0], k0[1], k0[2], k0[3], k1[0], k1[1], k1[2], k1[3]};
            float y[8];
#pragma unroll
            for (int j = 0; j < 8; ++j) y[j] = ((v[ps][j] - mean[ps]) * rstd[ps] * gg[j] + kk[j] * xx[j]) * siluf_(zz[j]);
            *(u32x4*)(Y + (size_t)r * DIN + ch) = (u32x4){pk2(y[0], y[1]), pk2(y[2], y[3]), pk2(y[4], y[5]), pk2(y[6], y[7])}; }
        { const int cm = c.lane * 8; const u32x4 mr = *(const u32x4*)(YM + (size_t)r * DX + cm), zr = *(const u32x4*)(P0 + (size_t)r * ML_W + 2048 + DMIX + cm);
          const float mm[8] = {bflo(mr.x), bfhi(mr.x), bflo(mr.y), bfhi(mr.y), bflo(mr.z), bfhi(mr.z), bflo(mr.w), bfhi(mr.w)};
          const float zz[8] = {bflo(zr.x), bfhi(zr.x), bflo(zr.y), bfhi(zr.y), bflo(zr.z), bfhi(zr.z), bflo(zr.w), bfhi(zr.w)};
          float y[8];
#pragma unroll
          for (int j = 0; j < 8; ++j) y[j] = mm[j] * siluf_(zz[j]);
          *(u32x4*)(Y + (size_t)r * DIN + DMIX + cm) = (u32x4){pk2(y[0], y[1]), pk2(y[2], y[3]), pk2(y[4], y[5]), pk2(y[6], y[7])}; }
        if (tl >= 509) {
#pragma unroll
            for (int ps = 0; ps < 3; ++ps) { const int ch = ps * 512 + c.lane * 8; *(u32x4*)(UT + (size_t)(b * 3 + tl - 509) * DMIX + ch) = *(const u32x4*)(P0 + (size_t)r * ML_W + ch); } }
    }
}

__device__ __forceinline__ void phase_b1(const P& p, const Ctx& c, int seg) {
    const bf16_t* P1 = (const bf16_t*)(c.seg + S1_P1);
    float* GTB = (float*)(c.seg + S1_W); bf16_t* SA = (bf16_t*)(c.seg + S1_A); bf16_t* SB = (bf16_t*)(c.seg + S1_B); bf16_t* SK = (bf16_t*)(c.seg + S1_K);
    bf16_t* SQ = (bf16_t*)(c.seg + S1_Q); bf16_t* SV = (bf16_t*)(c.seg + S1_V); bf16_t* SG = (bf16_t*)(c.seg + S1_G); float* BRKR = (float*)(c.seg + S1_BRKR);
    const bf16_t* VF = (const bf16_t*)(p.ws + OFF_VF); const bf16_t* LT = (const bf16_t*)(p.ws + OFF_LORAT);
    const bf16_t* PTr = (const bf16_t*)(p.ws + OFF_PTAIL) + (size_t)(seg & 1) * NB * RW_SHIFT; bf16_t* PTw = (bf16_t*)(p.ws + OFF_PTAIL) + (size_t)((seg + 1) & 1) * NB * RW_SHIFT;
    LAS bf16_t* XA = (LAS bf16_t*)c.lds;
    const int l15 = c.lane & 15, quad = c.lane >> 4;
    for (int it = c.bid; it < MS / 16; it += c.G) {
        const int r0 = it * 16, b = r0 >> 9, tl0 = r0 & 511;
        __syncthreads();
        for (int e = c.tid; e < 16 * 288; e += 512) { const int row = e / 288, cc = e % 288, col = 4608 + cc;
            const float cur = bf2f(P1[(size_t)(r0 + row) * P1W + col]);
            float prev = 0.f; if (tl0 + row > 0) prev = bf2f(P1[(size_t)(r0 + row - 1) * P1W + col]); else if (seg > 0) prev = bf2f(PTr[(size_t)b * RW_SHIFT + col]);
            const float pv = cur + p.rw_mu[col] * (prev - cur);
            const float f = cc < 64 ? tanhf(pv) : (cc < 160 ? pv : sigmoidf_(pv));
            XA[row * 296 + cc] = f2bf(f); }
        __syncthreads();
        bf16x8 xf[9];
#pragma unroll
        for (int k = 0; k < 9; ++k) xf[k] = *(const LAS bf16x8*)(XA + l15 * 296 + k * 32 + quad * 8);
        const size_t row = (size_t)r0 + l15; const int tl = tl0 + l15;
        const bf16_t* curp = P1 + row * P1W; const bf16_t* prevp = (tl > 0) ? (P1 + (row - 1) * P1W) : (PTr + (size_t)b * RW_SHIFT); const bool hasprev = (tl > 0) || (seg > 0);
        struct TileIn { u32x2 cr, ck, cv, pr, pk, pv, vf; };
        struct TilePar { f32x4 m0, m1, m2, w0, a0, v0, kkw, kaw, rk; };
#pragma unroll 1
        for (int x = 0; x < 3; ++x) {
            int hh = c.wv * 3 + x; asm volatile("" : "+s"(hh));
            auto load_tile = [&](int ct, TileIn& T) { const int cc = hh * 64 + ct * 16 + quad * 4;
                T.cr = *(const u32x2*)(curp + cc); T.ck = *(const u32x2*)(curp + DMIX + cc); T.cv = *(const u32x2*)(curp + 2 * DMIX + cc);
                T.pr = (u32x2){0u, 0u}; T.pk = T.pr; T.pv = T.pr;
                if (hasprev) { T.pr = *(const u32x2*)(prevp + cc); T.pk = *(const u32x2*)(prevp + DMIX + cc); T.pv = *(const u32x2*)(prevp + 2 * DMIX + cc); }
                T.vf = *(const u32x2*)(VF + row * DMIX + cc); };
            TileIn TA, TB2;
            load_tile(0, TA);
            float inv;
            { u32x2 kcur[4], kprv[4]; f32x4 km[4], kw[4];
#pragma unroll
              for (int ct = 0; ct < 4; ++ct) { const int cc = hh * 64 + ct * 16 + quad * 4;
                  kcur[ct] = *(const u32x2*)(curp + DMIX + cc); kprv[ct] = (u32x2){0u, 0u}; if (hasprev) kprv[ct] = *(const u32x2*)(prevp + DMIX + cc);
                  km[ct] = *(const f32x4*)(p.rw_mu + DMIX + cc); kw[ct] = *(const f32x4*)(p.rw_k_k + cc); }
              float ss = 0.f;
#pragma unroll
              for (int ct = 0; ct < 4; ++ct) {
                  const float cb[4] = {bflo(kcur[ct].x), bfhi(kcur[ct].x), bflo(kcur[ct].y), bfhi(kcur[ct].y)}, qb[4] = {bflo(kprv[ct].x), bfhi(kprv[ct].x), bflo(kprv[ct].y), bfhi(kprv[ct].y)};
#pragma unroll
                  for (int j = 0; j < 4; ++j) { const float kr = (cb[j] + km[ct][j] * (qb[j] - cb[j])) * kw[ct][j]; ss += kr * kr; } }
              ss += __shfl_xor(ss, 16); ss += __shfl_xor(ss, 32);
              inv = 1.0f / fmaxf(sqrtf(ss), 1e-12f); }
            float br = 0.f, kr = 0.f, rkr = 0.f;
            auto do_tile = [&](int ct, const TileIn& TI) { const int cc = hh * 64 + ct * 16 + quad * 4;
                TilePar T; T.m0 = *(const f32x4*)(p.rw_mu + cc); T.m1 = *(const f32x4*)(p.rw_mu + DMIX + cc); T.m2 = *(const f32x4*)(p.rw_mu + 2 * DMIX + cc);
                T.w0 = *(const f32x4*)(p.rw_w0 + cc); T.a0 = *(const f32x4*)(p.rw_a0 + cc); T.v0 = *(const f32x4*)(p.rw_v0 + cc); T.kkw = *(const f32x4*)(p.rw_k_k + cc); T.kaw = *(const f32x4*)(p.rw_k_a + cc);
                T.rk = *(const f32x4*)(p.rw_r_k + cc);
                bf16x8 lt[9]; { const bf16_t* lrow = LT + (size_t)(hh * 64 + ct * 16 + l15) * 288 + quad * 8;
#pragma unroll
                    for (int k = 0; k < 9; ++k) lt[k] = *(const bf16x8*)(lrow + k * 32); }
                f32x4 dw = (f32x4){0.f, 0.f, 0.f, 0.f}, da = dw, dv = dw, dg = dw;
#pragma unroll
                for (int k = 0; k < 2; ++k) dw = mfma16(lt[k], xf[k], dw);
#pragma unroll
                for (int k = 0; k < 2; ++k) da = mfma16(lt[2 + k], xf[2 + k], da);
                dv = mfma16(lt[4], xf[4], dv);
#pragma unroll
                for (int k = 0; k < 4; ++k) dg = mfma16(lt[5 + k], xf[5 + k], dg);
                const float ca[4] = {bflo(TI.cr.x), bfhi(TI.cr.x), bflo(TI.cr.y), bfhi(TI.cr.y)}, cb[4] = {bflo(TI.ck.x), bfhi(TI.ck.x), bflo(TI.ck.y), bfhi(TI.ck.y)}, cd[4] = {bflo(TI.cv.x), bfhi(TI.cv.x), bflo(TI.cv.y), bfhi(TI.cv.y)};
                const float qa[4] = {bflo(TI.pr.x), bfhi(TI.pr.x), bflo(TI.pr.y), bfhi(TI.pr.y)}, qb[4] = {bflo(TI.pk.x), bfhi(TI.pk.x), bflo(TI.pk.y), bfhi(TI.pk.y)}, qd[4] = {bflo(TI.pv.x), bfhi(TI.pv.x), bflo(TI.pv.y), bfhi(TI.pv.y)};
                const float vf[4] = {bflo(TI.vf.x), bfhi(TI.vf.x), bflo(TI.vf.y), bfhi(TI.vf.y)};
                u32x2 gw; gw.x = pk2(dg[0], dg[1]); gw.y = pk2(dg[2], dg[3]); *(u32x2*)(SG + row * DMIX + cc) = gw;
                float wv4[4], av[4], bv[4], ktv[4], qv[4], vv[4];
#pragma unroll
                for (int j = 0; j < 4; ++j) {
                    const float rc = ca[j] + T.m0[j] * (qa[j] - ca[j]), kc = cb[j] + T.m1[j] * (qb[j] - cb[j]), vc = cd[j] + T.m2[j] * (qd[j] - cd[j]);
                    const float zz = -(T.w0[j] + dw[j]); const float sp = fmaxf(zz, 0.f) + __logf(1.0f + __expf(-fabsf(zz)));
                    wv4[j] = __expf(-__expf(-sp - 0.5f));
                    const float a = sigmoidf_(T.a0[j] + da[j]);
                    vv[j] = vc + (vf[j] - vc) * sigmoidf_(T.v0[j] + dv[j]);
                    const float kk = kc * T.kkw[j] * inv; av[j] = -kk; bv[j] = kk * a;
                    ktv[j] = kc * (1.0f + (a - 1.0f) * T.kaw[j]); qv[j] = rc;
                    br += bv[j] * rc; kr += ktv[j] * rc; rkr += rc * ktv[j] * T.rk[j]; }
                float gfin[4];
#pragma unroll
                for (int j = 0; j < 4; ++j) { float g = wv4[j];
                    g *= dpp_shr_or1<1>(g); g *= dpp_shr_or1<2>(g); g *= dpp_shr_or1<4>(g); g *= dpp_shr_or1<8>(g);
                    const float gp = dpp_shr_or1<1>(g), ig = 1.0f / g;
                    av[j] *= gp; qv[j] *= g; bv[j] *= ig; ktv[j] *= ig; gfin[j] = g; }
                if (l15 == 15) *(f32x4*)(GTB + ((size_t)it * 24 + hh) * 64 + ct * 16 + quad * 4) = (f32x4){gfin[0], gfin[1], gfin[2], gfin[3]};
                u32x2 t; t.x = pk2(av[0], av[1]); t.y = pk2(av[2], av[3]); *(u32x2*)(SA + row * DMIX + cc) = t;
                t.x = pk2(bv[0], bv[1]); t.y = pk2(bv[2], bv[3]); *(u32x2*)(SB + row * DMIX + cc) = t;
                t.x = pk2(ktv[0], ktv[1]); t.y = pk2(ktv[2], ktv[3]); *(u32x2*)(SK + row * DMIX + cc) = t;
                t.x = pk2(qv[0], qv[1]); t.y = pk2(qv[2], qv[3]); *(u32x2*)(SQ + row * DMIX + cc) = t;
                t.x = pk2(vv[0], vv[1]); t.y = pk2(vv[2], vv[3]); *(u32x2*)(SV + row * DMIX + cc) = t; };
            load_tile(1, TB2); do_tile(0, TA); __builtin_amdgcn_sched_barrier(0);
            load_tile(2, TA); do_tile(1, TB2); __builtin_amdgcn_sched_barrier(0);
            load_tile(3, TB2); do_tile(2, TA); __builtin_amdgcn_sched_barrier(0);
            do_tile(3, TB2);
            br += __shfl_xor(br, 16); br += __shfl_xor(br, 32); kr += __shfl_xor(kr, 16); kr += __shfl_xor(kr, 32); rkr += __shfl_xor(rkr, 16); rkr += __shfl_xor(rkr, 32);
            if (quad == 0) *(f32x4*)(BRKR + (row * 24 + hh) * 4) = (f32x4){br, kr, rkr, 0.f};
        }
        if (tl0 == 496) { for (int e = c.tid; e < RW_SHIFT; e += 512) PTw[(size_t)b * RW_SHIFT + e] = P1[(size_t)(r0 + 15) * P1W + e]; }
    }
}

__device__ __forceinline__ void rwkv_item(const P& p, const Ctx& c, int seg, int w, bool save) {
    const int b = w / 24, hh = w % 24;
    const float* SW = (const float*)(c.seg + S1_W); const bf16_t* SA = (const bf16_t*)(c.seg + S1_A); const bf16_t* SB = (const bf16_t*)(c.seg + S1_B); const bf16_t* SK = (const bf16_t*)(c.seg + S1_K);
    const bf16_t* SQ = (const bf16_t*)(c.seg + S1_Q); const bf16_t* SV = (const bf16_t*)(c.seg + S1_V); const float* BRKR = (const float*)(c.seg + S1_BRKR);
    float* O = (float*)(c.seg + S1_O); float* RST = (float*)(p.ws + OFF_RST) + (size_t)w * 4096;
    constexpr int TB = 32, REC = 388;
    LAS float* L0 = (LAS float*)c.lds;
    const int rp = c.wv * 4 + (c.lane >> 4), cq = c.lane & 15;
    f32x2 S0a, S0b, S1a, S1b;
    if (seg > 0) { const f32x4 s0 = *(const f32x4*)(RST + (2 * rp) * 64 + cq * 4), s1 = *(const f32x4*)(RST + (2 * rp + 1) * 64 + cq * 4);
        S0a = (f32x2){s0[0], s0[1]}; S0b = (f32x2){s0[2], s0[3]}; S1a = (f32x2){s1[0], s1[1]}; S1b = (f32x2){s1[2], s1[3]}; }
    else { S0a = S0b = S1a = S1b = (f32x2){0.f, 0.f}; }
    const int e4 = c.tid * 4, stt = e4 >> 6, scc = e4 & 63;
    f32x4 gw; u32x2 ga, gb, gk, gq, gv; f32x4 gbr;
    auto gload = [&](int blk) { const size_t go = ((size_t)b * SEGT + blk * TB + stt) * DMIX + hh * 64 + scc;
        gw = *(const f32x4*)(SW + go); ga = *(const u32x2*)(SA + go); gb = *(const u32x2*)(SB + go); gk = *(const u32x2*)(SK + go); gq = *(const u32x2*)(SQ + go); gv = *(const u32x2*)(SV + go);
        if (c.tid < TB) gbr = *(const f32x4*)(BRKR + (((size_t)b * SEGT + blk * TB + c.tid) * 24 + hh) * 4); };
    auto lstore = [&](int buf) { LAS float* r = L0 + buf * (TB * REC) + stt * REC + scc;
        *(LAS f32x4*)(r) = gw; *(LAS f32x4*)(r + 64) = (f32x4){bflo(ga.x), bfhi(ga.x), bflo(ga.y), bfhi(ga.y)}; *(LAS f32x4*)(r + 128) = (f32x4){bflo(gb.x), bfhi(gb.x), bflo(gb.y), bfhi(gb.y)};
        *(LAS f32x4*)(r + 192) = (f32x4){bflo(gk.x), bfhi(gk.x), bflo(gk.y), bfhi(gk.y)}; *(LAS f32x4*)(r + 256) = (f32x4){bflo(gq.x), bfhi(gq.x), bflo(gq.y), bfhi(gq.y)};
        *(LAS f32x4*)(r + 320) = (f32x4){bflo(gv.x), bfhi(gv.x), bflo(gv.y), bfhi(gv.y)};
        if (c.tid < TB) { LAS float* q = L0 + buf * (TB * REC) + c.tid * REC + 384; *(LAS f32x2*)q = (f32x2){gbr[0], gbr[1]}; } };
    __syncthreads();
    gload(0); lstore(0);
    __syncthreads();
#pragma unroll 1
    for (int blk = 0; blk < SEGT / TB; ++blk) {
        const int buf = blk & 1;
        if (blk + 1 < SEGT / TB) gload(blk + 1);
        const LAS float* base = L0 + buf * (TB * REC);
        const size_t rowb = (size_t)b * SEGT + blk * TB;
        f32x4 nw4 = *(const LAS f32x4*)(base + cq * 4), na4 = *(const LAS f32x4*)(base + 64 + cq * 4), nb4 = *(const LAS f32x4*)(base + 128 + cq * 4), nk4 = *(const LAS f32x4*)(base + 192 + cq * 4), nq4 = *(const LAS f32x4*)(base + 256 + cq * 4);
        f32x2 nv2 = *(const LAS f32x2*)(base + 320 + 2 * rp), nbk = *(const LAS f32x2*)(base + 384);
#pragma unroll 2
        for (int tt = 0; tt < TB; ++tt) {
            const f32x4 w4 = nw4, a4 = na4, b4 = nb4, k4 = nk4, q4 = nq4; const f32x2 v2 = nv2, bk = nbk;
            { const LAS float* r = base + (tt + 1 < TB ? tt + 1 : tt) * REC;
              nw4 = *(const LAS f32x4*)(r + cq * 4); na4 = *(const LAS f32x4*)(r + 64 + cq * 4); nb4 = *(const LAS f32x4*)(r + 128 + cq * 4); nk4 = *(const LAS f32x4*)(r + 192 + cq * 4); nq4 = *(const LAS f32x4*)(r + 256 + cq * 4);
              nv2 = *(const LAS f32x2*)(r + 320 + 2 * rp); nbk = *(const LAS f32x2*)(r + 384); }
            const f32x2 wa = (f32x2){w4[0], w4[1]}, wb = (f32x2){w4[2], w4[3]}, aa = (f32x2){a4[0], a4[1]}, ab = (f32x2){a4[2], a4[3]}, ba = (f32x2){b4[0], b4[1]}, bb = (f32x2){b4[2], b4[3]};
            const f32x2 ka = (f32x2){k4[0], k4[1]}, kb = (f32x2){k4[2], k4[3]}, qa = (f32x2){q4[0], q4[1]}, qb = (f32x2){q4[2], q4[3]};
            f32x2 t0 = S0a * aa + S0b * ab, t1 = S0a * qa + S0b * qb, t2 = S1a * aa + S1b * ab, t3 = S1a * qa + S1b * qb;
            float pa0 = t0.x + t0.y, pt0 = t1.x + t1.y, pa1 = t2.x + t2.y, pt1 = t3.x + t3.y;
            row16_allsum4(pa0, pa1, pt0, pt1);
            const f32x2 pa0v = (f32x2){pa0, pa0}, pa1v = (f32x2){pa1, pa1}, v0v = (f32x2){v2.x, v2.x}, v1v = (f32x2){v2.y, v2.y};
            S0a = S0a * wa + pa0v * ba + v0v * ka; S0b = S0b * wb + pa0v * bb + v0v * kb;
            S1a = S1a * wa + pa1v * ba + v1v * ka; S1b = S1b * wb + pa1v * bb + v1v * kb;
            if (cq == 0) { const f32x2 y = (f32x2){pt0 + pa0 * bk.x + v2.x * bk.y, pt1 + pa1 * bk.x + v2.y * bk.y};
                *(f32x2*)(O + (rowb + tt) * DMIX + hh * 64 + 2 * rp) = y; }
        }
        if (blk + 1 < SEGT / TB) lstore(buf ^ 1);
        __syncthreads();
    }
    if (!save) return;
    *(f32x4*)(RST + (2 * rp) * 64 + cq * 4) = (f32x4){S0a.x, S0a.y, S0b.x, S0b.y}; *(f32x4*)(RST + (2 * rp + 1) * 64 + cq * 4) = (f32x4){S1a.x, S1a.y, S1b.x, S1b.y};
}

__device__ __forceinline__ void rwkv_chunk_item(const P& p, const Ctx& c, int seg, int w, bool save) {
    const int b = w / 24, hh = w % 24;
    const bf16_t* SA = (const bf16_t*)(c.seg + S1_A); const bf16_t* SB = (const bf16_t*)(c.seg + S1_B); const bf16_t* SK = (const bf16_t*)(c.seg + S1_K);
    const bf16_t* SR = (const bf16_t*)(c.seg + S1_Q); const bf16_t* SV = (const bf16_t*)(c.seg + S1_V); const float* GTB = (const float*)(c.seg + S1_W);
    float* O = (float*)(c.seg + S1_O); float* RST = (float*)(p.ws + OFF_RST) + (size_t)w * 4096;
    constexpr int O_EA = 0  , O_EB = 4608  , O_EBT = 9216  , O_UV = 14336  ,
                  O_MT1 = 19456  , O_NT = 20736  , O_MABT = 22016  ,
                  O_GT = 23296  , OPB = 23552;
    LAS unsigned char* OB = c.lds;
    LAS bf16_t* S0I = (LAS bf16_t*)(c.lds + 2 * OPB);
    LAS float* XF = (LAS float*)(c.lds + 2 * OPB + 9216);
    const int l15c = c.lane & 15, quadc = c.lane >> 4;
    f32x4 S[2];
#pragma unroll
    for (int x = 0; x < 2; ++x) { const int ti = c.wv * 2 + x, mt = ti >> 2, nt = ti & 3;
#pragma unroll
        for (int jj = 0; jj < 4; ++jj) S[x][jj] = (seg > 0) ? RST[(mt * 16 + quadc * 4 + jj) * 64 + nt * 16 + l15c] : 0.f; }
    unsigned ga = 0, gb = 0, gk = 0, gr = 0, gv = 0; float gg = 1.f;
    auto gload = [&](int ch, int tidv) { const int t = tidv >> 5, j0 = (tidv & 31) * 2; const size_t go = ((size_t)b * SEGT + ch * 16 + t) * DMIX + hh * 64 + j0;
        ga = *(const unsigned*)(SA + go); gb = *(const unsigned*)(SB + go); gk = *(const unsigned*)(SK + go); gr = *(const unsigned*)(SR + go); gv = *(const unsigned*)(SV + go);
        if (tidv < 64) gg = GTB[((size_t)(b * 32 + ch) * 24 + hh) * 64 + tidv]; };
    auto lstore = [&](int pb, int tidv) { const int t = tidv >> 5, j0 = (tidv & 31) * 2;
        LAS bf16_t* EA = (LAS bf16_t*)(OB + pb * OPB + O_EA); LAS bf16_t* EB = (LAS bf16_t*)(OB + pb * OPB + O_EB); LAS bf16_t* EBT = (LAS bf16_t*)(OB + pb * OPB + O_EBT);
        LAS bf16_t* UV = (LAS bf16_t*)(OB + pb * OPB + O_UV); LAS float* GT = (LAS float*)(OB + pb * OPB + O_GT);
        *(LAS unsigned*)(EA + t * 72 + j0) = ga; *(LAS unsigned*)(EA + (16 + t) * 72 + j0) = gr;
        *(LAS unsigned*)(EB + t * 72 + j0) = gb; *(LAS unsigned*)(EB + (16 + t) * 72 + j0) = gk;
        EBT[j0 * 40 + t] = (bf16_t)(gb & 0xFFFFu); EBT[(j0 + 1) * 40 + t] = (bf16_t)(gb >> 16); EBT[j0 * 40 + 16 + t] = (bf16_t)(gk & 0xFFFFu); EBT[(j0 + 1) * 40 + 16 + t] = (bf16_t)(gk >> 16);
        UV[j0 * 40 + 16 + t] = (bf16_t)(gv & 0xFFFFu); UV[(j0 + 1) * 40 + 16 + t] = (bf16_t)(gv >> 16); UV[j0 * 40 + t] = 0; UV[(j0 + 1) * 40 + t] = 0;
        if (tidv < 64) GT[tidv] = gg; };
    auto gtile = [&](int pb, int l15, int quad) {
        LAS bf16_t* EA = (LAS bf16_t*)(OB + pb * OPB + O_EA); LAS bf16_t* EB = (LAS bf16_t*)(OB + pb * OPB + O_EB);
        LAS bf16_t* MT1 = (LAS bf16_t*)(OB + pb * OPB + O_MT1); LAS bf16_t* NT = (LAS bf16_t*)(OB + pb * OPB + O_NT); LAS float* MABT = (LAS float*)(OB + pb * OPB + O_MABT);
        const int sb = c.wv >> 1, tb = c.wv & 1; f32x4 g = (f32x4){0.f, 0.f, 0.f, 0.f};
#pragma unroll
        for (int kk = 0; kk < 2; ++kk) g = mfma16(*(const LAS bf16x8*)(EB + (sb * 16 + l15) * 72 + kk * 32 + quad * 8), *(const LAS bf16x8*)(EA + (tb * 16 + l15) * 72 + kk * 32 + quad * 8), g);
#pragma unroll
        for (int jj = 0; jj < 4; ++jj) { const int s2 = quad * 4 + jj, tt = l15; const float v = g[jj];
            if (tb == 0) { const float m = (s2 < tt) ? v : 0.f; if (sb == 0) { MABT[tt * 20 + s2] = m; MT1[tt * 40 + s2] = 0; } else MT1[tt * 40 + 16 + s2] = f2bf(m); }
            else { const float m = (s2 <= tt) ? v : 0.f; NT[tt * 40 + sb * 16 + s2] = f2bf(m); } } };
    auto simg = [&](int l15, int quad) {
#pragma unroll
        for (int x = 0; x < 2; ++x) { const int ti = c.wv * 2 + x, mt = ti >> 2, nt = ti & 3;
#pragma unroll
            for (int jj = 0; jj < 4; ++jj) S0I[(mt * 16 + quad * 4 + jj) * 72 + nt * 16 + l15] = f2bf(S[x][jj]); } };
    __syncthreads();
    { int t0 = c.tid; asm volatile("" : "+v"(t0)); gload(0, t0); lstore(0, t0); simg(l15c, quadc); }
    lds_barrier();
    if (c.wv < 4) gtile(0, l15c, quadc);
    { int t1 = c.tid; asm volatile("" : "+v"(t1)); gload(1, t1); }
    const int mtq = c.wv & 3;
#pragma unroll 1
    for (int ch = 0; ch < SEGT / 16; ++ch) {
        const int pb = ch & 1;
        int tidv = c.tid, l15 = l15c, quad = quadc; asm volatile("" : "+v"(tidv), "+v"(l15), "+v"(quad));
        LAS bf16_t* EA = (LAS bf16_t*)(OB + pb * OPB + O_EA); LAS bf16_t* EBT = (LAS bf16_t*)(OB + pb * OPB + O_EBT); LAS bf16_t* UV = (LAS bf16_t*)(OB + pb * OPB + O_UV);
        LAS bf16_t* MT1 = (LAS bf16_t*)(OB + pb * OPB + O_MT1); LAS bf16_t* NT = (LAS bf16_t*)(OB + pb * OPB + O_NT); LAS float* MABT = (LAS float*)(OB + pb * OPB + O_MABT); LAS float* GT = (LAS float*)(OB + pb * OPB + O_GT);
        lds_barrier();
        f32x4 Zt = (f32x4){0.f, 0.f, 0.f, 0.f};
        if (c.wv >= 4) {
            f32x4 Xt = (f32x4){0.f, 0.f, 0.f, 0.f};
#pragma unroll
            for (int kk = 0; kk < 2; ++kk) { const bf16x8 a = *(const LAS bf16x8*)(S0I + (mtq * 16 + l15) * 72 + kk * 32 + quad * 8);
                Xt = mfma16(a, *(const LAS bf16x8*)(EA + l15 * 72 + kk * 32 + quad * 8), Xt); Zt = mfma16(a, *(const LAS bf16x8*)(EA + (16 + l15) * 72 + kk * 32 + quad * 8), Zt); }
            Xt = mfma16(*(const LAS bf16x8*)(UV + (mtq * 16 + l15) * 40 + quad * 8), *(const LAS bf16x8*)(MT1 + l15 * 40 + quad * 8), Xt);
#pragma unroll
            for (int jj = 0; jj < 4; ++jj) XF[(mtq * 16 + quad * 4 + jj) * 17 + l15] = Xt[jj];
        }
        lds_barrier();
        if (ch + 1 < SEGT / 16) lstore(pb ^ 1, tidv);
        if (ch + 2 < SEGT / 16) gload(ch + 2, tidv);
        if (c.wv == 0) {
            float u[16];
#pragma unroll
            for (int tt = 0; tt < 16; ++tt) { float acc = XF[c.lane * 17 + tt];
#pragma unroll
                for (int s4 = 0; s4 < (tt + 3) / 4; ++s4) { const f32x4 m = *(const LAS f32x4*)(MABT + tt * 20 + s4 * 4);
#pragma unroll
                    for (int e = 0; e < 4; ++e) if (s4 * 4 + e < tt) acc += u[s4 * 4 + e] * m[e]; }
                u[tt] = acc; }
            *(LAS u32x4*)(UV + c.lane * 40) = (u32x4){pk2(u[0], u[1]), pk2(u[2], u[3]), pk2(u[4], u[5]), pk2(u[6], u[7])};
            *(LAS u32x4*)(UV + c.lane * 40 + 8) = (u32x4){pk2(u[8], u[9]), pk2(u[10], u[11]), pk2(u[12], u[13]), pk2(u[14], u[15])};
        }
        lds_barrier();
        if (c.wv >= 4) {
            Zt = mfma16(*(const LAS bf16x8*)(UV + (mtq * 16 + l15) * 40 + quad * 8), *(const LAS bf16x8*)(NT + l15 * 40 + quad * 8), Zt);
            *(f32x4*)(O + ((size_t)b * SEGT + ch * 16 + l15) * DMIX + hh * 64 + mtq * 16 + quad * 4) = Zt;
        }
#pragma unroll
        for (int x = 0; x < 2; ++x) { const int ti = c.wv * 2 + x, mt = ti >> 2, nt = ti & 3;
            S[x] = mfma16(*(const LAS bf16x8*)(UV + (mt * 16 + l15) * 40 + quad * 8), *(const LAS bf16x8*)(EBT + (nt * 16 + l15) * 40 + quad * 8), S[x]);
            const float gt = GT[nt * 16 + l15];
#pragma unroll
            for (int jj = 0; jj < 4; ++jj) S[x][jj] *= gt; }
        simg(l15, quad);
        if (c.wv < 4 && ch + 1 < SEGT / 16) gtile(pb ^ 1, l15, quad);
    }
    if (!save) return;
#pragma unroll
    for (int x = 0; x < 2; ++x) { const int ti = c.wv * 2 + x, mt = ti >> 2, nt = ti & 3;
#pragma unroll
        for (int jj = 0; jj < 4; ++jj) RST[(mt * 16 + quadc * 4 + jj) * 64 + nt * 16 + l15c] = S[x][jj]; }
}

__device__ __forceinline__ void phase_b3(const P& p, const Ctx& c) {
    const float* O = (const float*)(c.seg + S1_O); const bf16_t* P2 = (const bf16_t*)(c.seg + S1_P2); const bf16_t* SV = (const bf16_t*)(c.seg + S1_V); const bf16_t* SG = (const bf16_t*)(c.seg + S1_G);
    const float* BRKR = (const float*)(c.seg + S1_BRKR); const bf16_t* YM = (const bf16_t*)(c.seg + S1_YMEM); bf16_t* Y = (bf16_t*)(c.seg + S1_Y);
    for (int r = c.bid * 8 + c.wv; r < MS; r += c.G * 8) {
#pragma unroll
        for (int ps = 0; ps < 3; ++ps) {
            const int hh = ps * 8 + (c.lane >> 3), ch = hh * 64 + (c.lane & 7) * 8;
            const f32x4 o0 = *(const f32x4*)(O + (size_t)r * DMIX + ch), o1 = *(const f32x4*)(O + (size_t)r * DMIX + ch + 4);
            float v[8] = {o0[0], o0[1], o0[2], o0[3], o1[0], o1[1], o1[2], o1[3]}; float s = 0.f, s2 = 0.f;
#pragma unroll
            for (int j = 0; j < 8; ++j) { s += v[j]; s2 += v[j] * v[j]; }
            s += __shfl_xor(s, 1); s2 += __shfl_xor(s2, 1); s += __shfl_xor(s, 2); s2 += __shfl_xor(s2, 2); s += __shfl_xor(s, 4); s2 += __shfl_xor(s2, 4);
            const float mean = s * (1.0f / 64.0f), var = fmaxf(s2 * (1.0f / 64.0f) - mean * mean, 0.f), rs = rsqrtf(var + 64e-5f);
            const float rkr = BRKR[((size_t)r * 24 + hh) * 4 + 2];
            const u32x4 vr = *(const u32x4*)(SV + (size_t)r * DMIX + ch), gr = *(const u32x4*)(SG + (size_t)r * DMIX + ch), zr = *(const u32x4*)(P2 + (size_t)r * P2W + 512 + ch);
            const float vv[8] = {bflo(vr.x), bfhi(vr.x), bflo(vr.y), bfhi(vr.y), bflo(vr.z), bfhi(vr.z), bflo(vr.w), bfhi(vr.w)};
            const float gg[8] = {bflo(gr.x), bfhi(gr.x), bflo(gr.y), bfhi(gr.y), bflo(gr.z), bfhi(gr.z), bflo(gr.w), bfhi(gr.w)};
            const float zz[8] = {bflo(zr.x), bfhi(zr.x), bflo(zr.y), bfhi(zr.y), bflo(zr.z), bfhi(zr.z), bflo(zr.w), bfhi(zr.w)};
            float y[8];
#pragma unroll
            for (int j = 0; j < 8; ++j) { const float t = ((v[j] - mean) * rs * p.rw_lnx_g[ch + j] + p.rw_lnx_b[ch + j] + rkr * vv[j]) * gg[j]; y[j] = t * siluf_(zz[j]); }
            *(u32x4*)(Y + (size_t)r * DIN + ch) = (u32x4){pk2(y[0], y[1]), pk2(y[2], y[3]), pk2(y[4], y[5]), pk2(y[6], y[7])};
        }
        { const int cm = c.lane * 8; const u32x4 mr = *(const u32x4*)(YM + (size_t)r * DX + cm), zr = *(const u32x4*)(P2 + (size_t)r * P2W + 512 + DMIX + cm);
          const float mm[8] = {bflo(mr.x), bfhi(mr.x), bflo(mr.y), bfhi(mr.y), bflo(mr.z), bfhi(mr.z), bflo(mr.w), bfhi(mr.w)};
          const float zz[8] = {bflo(zr.x), bfhi(zr.x), bflo(zr.y), bfhi(zr.y), bflo(zr.z), bfhi(zr.z), bflo(zr.w), bfhi(zr.w)};
          float y[8];
#pragma unroll
          for (int j = 0; j < 8; ++j) y[j] = mm[j] * siluf_(zz[j]);
          *(u32x4*)(Y + (size_t)r * DIN + DMIX + cm) = (u32x4){pk2(y[0], y[1]), pk2(y[2], y[3]), pk2(y[4], y[5]), pk2(y[6], y[7])}; }
    }
}

__device__ __forceinline__ bool fresh_ctx(Ctx& c, P& p, unsigned char* ws0) { int t = threadIdx.x; asm volatile("" : "+v"(t)); c.tid = t; c.wv = __builtin_amdgcn_readfirstlane(t >> 6); c.lane = t & 63;
    int bb = (int)blockIdx.x, gg = (int)gridDim.x; asm volatile("" : "+s"(bb), "+s"(gg)); c.bid = bb; c.G = gg;
    size_t z = 0; asm volatile("" : "+s"(z)); p.ws = ws0 + z; c.seg = ws0 + z + OFF_SEG;
    return true; }
__global__ __launch_bounds__(512) void fwd_megakernel(P p_arg) {
    P p = p_arg;
    extern __shared__ __attribute__((aligned(16))) unsigned char shm[];
    LAS unsigned char* lds = (LAS unsigned char*)shm;
    Ctx c; c.tid = threadIdx.x; c.wv = threadIdx.x >> 6; c.lane = threadIdx.x & 63; c.G = gridDim.x; c.bid = blockIdx.x; c.lds = lds; c.seg = p.ws + OFF_SEG;
    volatile LAS unsigned* st = (volatile LAS unsigned*)(lds + LDS_BYTES - 16);
    if (c.tid == 0) { st[0] = 0u; st[1] = 0u; }
    __syncthreads();
    const XcdBarrier xb = xcd_barrier_post((unsigned*)(p.ws + OFF_BAR), st);
#define GSYNC() do { XcdBarrier _xl = xb; size_t _zz = 0; asm volatile("" : "+s"(_zz)); _xl.bar = xb.bar + _zz; _xl.x = xb_xcc_id();     \
        xcd_barrier(_xl); if (RK == 20) { for (int _q = 1; _q < RN; ++_q) xcd_barrier(_xl); } } while (0)
#ifndef RK
#define RK -1
#endif
#ifndef RN
#define RN 1
#endif
#define NREP(k) ((k) == RK ? RN : 1)
#define PH(k) for (int _r = 0; _r < NREP(k); ++_r) if (fresh_ctx(c, p, p_arg.ws))
#define LASTREP(k) (_r + 1 == NREP(k))
    PH(0) phase0(p, c);
    PH(1) phase_apre(p, c, 0, c.bid, c.G);
    GSYNC();
    for (int seg = 0; seg < NSEG; ++seg) {
        PH(2) { SchedA0 S; S.ws = p.ws; S.seg = c.seg; S.G = c.G; S.c = c.bid; S.nextra = (seg == 0) ? 64 : 0;
          pg8::gemm_phase<pg8::EpiBf, SchedA0>(lds, c.tid, 1024, 1024, S, pg8::EpiBf{}); }
        GSYNC();
        PH(3) phase_a1(p, c, seg);
        GSYNC();
        for (int it0 = c.bid; it0 < 256; it0 += c.G) {
            const int xq = it0 & 7, yq = it0 >> 3; const int it = (yq < 24) ? ((xq * 4 + yq / 6) * 6 + yq % 6) : (192 + (yq - 24) * 8 + xq);
            if (it < 192) { PH(4) mlstm_item(p, c, seg, it, LASTREP(4)); }
            else { PH(5) attn_item(p, c, 0, it - 192, (const bf16_t*)(c.seg + S0_P0) + DMIX, ML_W, (bf16_t*)(c.seg + S0_YMEM)); }
        }
        GSYNC();
        PH(6) phase_a3(p, c, seg);
        GSYNC();
        PH(7) { SchedOut S; S.Y = (const char*)(c.seg + S0_Y); S.W = (const char*)(p.ws + OFF_WO0T); S.slab = (char*)(c.seg + S0_SLAB); S.G = c.G; S.c = c.bid;
          pg8::gemm_phase<pg8::EpiBf, SchedOut>(lds, c.tid, DIN, 512, S, pg8::EpiBf{}); }
        GSYNC();
        PH(8) phase_a5(p, c, seg);
        GSYNC();
        PH(9) { SchedB0 S; S.ws = p.ws; S.seg = c.seg; S.G = c.G; S.c = c.bid;
          pg8::gemm_phase<pg8::EpiBf, SchedB0>(lds, c.tid, 1024, 1024, S, pg8::EpiBf{}); }
        GSYNC();
        PH(10) phase_b1(p, c, seg);
        GSYNC();
        for (int it = c.bid; it < 256; it += c.G) {
            if (it < 192) { PH(11) rwkv_chunk_item(p, c, seg, it, LASTREP(11)); }
            else { PH(5) attn_item(p, c, 1, it - 192, (const bf16_t*)(c.seg + S1_P2), P2W, (bf16_t*)(c.seg + S1_YMEM));
                   if (c.G == 256) { PH(1) if (seg + 1 < NSEG) phase_apre(p, c, seg + 1, it - 192, 64); } }
        }
        GSYNC();
        PH(12) phase_b3(p, c);
        GSYNC();
        PH(13) { SchedOut S; S.Y = (const char*)(c.seg + S1_Y); S.W = (const char*)(p.ws + OFF_WO1T); S.slab = (char*)(c.seg + S1_SLAB); S.G = c.G; S.c = c.bid;
          pg8::gemm_phase<pg8::EpiBf, SchedOut>(lds, c.tid, DIN, 512, S, pg8::EpiBf{}); }
        GSYNC();
        PH(14) phase_b5(p, c, seg);
        if (c.G != 256) { PH(1) if (seg + 1 < NSEG) phase_apre(p, c, seg + 1, c.bid, c.G); GSYNC(); }
    }
}

extern "C" void kernel_launch(void* const* d_in, const int* in_sizes, int n_in, void* d_out, int out_size, void* d_ws, size_t ws_size, hipStream_t stream) {
    static int grid = 0;
    if (grid == 0) {
        int dev = 0, cus = 0, per_cu = 0;
        if (hipGetDevice(&dev) != hipSuccess || hipDeviceGetAttribute(&cus, hipDeviceAttributeMultiprocessorCount, dev) != hipSuccess) { grid = -1; return; }
        if (hipFuncSetAttribute((const void*)fwd_megakernel, hipFuncAttributeMaxDynamicSharedMemorySize, LDS_BYTES) != hipSuccess) { fprintf(stderr, "hipFuncSetAttribute failed\n"); grid = -1; return; }
        if (hipOccupancyMaxActiveBlocksPerMultiprocessor(&per_cu, (const void*)fwd_megakernel, 512, LDS_BYTES) != hipSuccess || per_cu < 1) { fprintf(stderr, "occupancy query: %d\n", per_cu); }
        (void)hipGetLastError();
        grid = cus;
        if (n_in != 31 || ws_size < 256 * MiB) { fprintf(stderr, "unexpected n_in %d / ws %zu\n", n_in, ws_size); grid = -1; return; }
    }
    if (grid < 0) return;
    (void)hipMemsetAsync((char*)d_ws + OFF_BAR, 0, XCD_BAR_WORDS * 4, stream);
    P p{};
    const float** f = (const float**)&p;
    for (int i = 0; i < 31; ++i) f[i] = (const float*)d_in[i];
    p.out = (float*)d_out; p.ws = (unsigned char*)d_ws;
    fwd_megakernel<<<dim3(grid), dim3(512), LDS_BYTES, stream>>>(p);
}
```

```cpp
#include <hip/hip_runtime.h>
#include <cstdio>
#include <cstdint>

#define LAS __attribute__((address_space(3)))
typedef unsigned short bf16_t;
typedef short bf16x8 __attribute__((ext_vector_type(8)));
typedef short bf16x4 __attribute__((ext_vector_type(4)));
typedef float f32x4 __attribute__((ext_vector_type(4)));
typedef float f32x2 __attribute__((ext_vector_type(2)));
typedef unsigned u32x4 __attribute__((ext_vector_type(4)));
typedef unsigned u32x2 __attribute__((ext_vector_type(2)));

constexpr int NB = 8, SEQ = 2048, DM = 1024, NSEG = 4, SEGT = 512, MS = NB * SEGT;
constexpr int DMIX = 1536, DX = 512, DIN = 2048;
constexpr int ML_W = 4096, RW_SHIFT = 4896, RW_W = 7456;
constexpr int P1W = 5120, P2W = 2560;
constexpr size_t MiB = 1u << 20;
constexpr size_t OFF_WT0 = 0, OFF_WT1 = 8 * MiB, OFF_WO0T = 23 * MiB, OFF_WO1T = 27 * MiB, OFF_WKVT = 31 * MiB  ,
                 OFF_KMEM = 35 * MiB  , OFF_LORAT = 43 * MiB, OFF_MISC = 45 * MiB,
                 OFF_CST = 46 * MiB, OFF_NST = 65 * MiB, OFF_RST = 65 * MiB + 512 * 1024, OFF_H = 69 * MiB, OFF_VF = 77 * MiB,
                 OFF_SEG = 89 * MiB, OFF_MEMN = 248 * MiB;
constexpr size_t OFF_BAR = OFF_MISC, OFF_UTAIL = OFF_MISC + 64 * 1024, OFF_PTAIL = OFF_MISC + 256 * 1024;
constexpr size_t S0_P0 = 0, S0_Q = 32 * MiB, S0_K = 44 * MiB, S0_KT = 56 * MiB, S0_VT = 68 * MiB, S0_XC = 80 * MiB, S0_HRAW = 92 * MiB,
                 S0_YMEM = 116 * MiB, S0_Y = 120 * MiB, S0_GATE = 136 * MiB;
constexpr size_t S1_P1 = 0, S1_O = 0, S1_Y = 24 * MiB, S1_P2 = 40 * MiB, S1_W = 60 * MiB, S1_A = 84 * MiB, S1_B = 96 * MiB, S1_K = 108 * MiB,
                 S1_Q = 120 * MiB, S1_V = 132 * MiB, S1_G = 144 * MiB, S1_YMEM = 156 * MiB, S1_BRKR = 160 * MiB;
constexpr size_t S0_SLAB = 0  , S1_SLAB = 84 * MiB  ;
constexpr int LDS_BYTES = 150 * 1024;

struct P {
    const float *x, *mem, *norm_g, *mem_norm_g, *mem_kv_w, *w_out, *ml_w_in, *ml_conv_w, *ml_conv_b, *ml_wq, *ml_wk, *ml_wv, *ml_w_gate, *ml_b_gate,
        *ml_mhn_g, *ml_skip, *rw_w_in, *rw_mu, *rw_w_lora2, *rw_w0, *rw_a_lora2, *rw_a0, *rw_v_lora2, *rw_v0, *rw_g_lora2, *rw_k_k, *rw_k_a, *rw_r_k,
        *rw_lnx_g, *rw_lnx_b, *final_g;
    float* out; unsigned char* ws;
};

__device__ __forceinline__ bf16_t f2bf(float f) { unsigned u = __float_as_uint(f); u += 0x7FFFu + ((u >> 16) & 1u); return (bf16_t)(u >> 16); }
__device__ __forceinline__ float bf2f(bf16_t b) { return __uint_as_float(((unsigned)b) << 16); }
__device__ __forceinline__ unsigned pk2(float lo, float hi) { return (unsigned)f2bf(lo) | ((unsigned)f2bf(hi) << 16); }
__device__ __forceinline__ float bflo(unsigned u) { return __uint_as_float(u << 16); }
__device__ __forceinline__ float bfhi(unsigned u) { return __uint_as_float(u & 0xFFFF0000u); }
__device__ __forceinline__ float wsum(float v) {
#pragma unroll
    for (int o = 32; o >= 1; o >>= 1) v += __shfl_xor(v, o);
    return v;
}
__device__ __forceinline__ float sigmoidf_(float x) { return 1.0f / (1.0f + __expf(-x)); }
__device__ __forceinline__ float siluf_(float x) { return x / (1.0f + __expf(-x)); }
__device__ __forceinline__ float softplusf_(float z) { return fmaxf(z, 0.f) + log1pf(__expf(-fabsf(z))); }
template <int CTRL> __device__ __forceinline__ float dpp_add(float v) {
    return v + __int_as_float(__builtin_amdgcn_update_dpp(0, __float_as_int(v), CTRL, 0xF, 0xF, true));
}
__device__ __forceinline__ float row16_allsum(float v) {
    v = dpp_add<0xB1>(v);
    v = dpp_add<0x4E>(v);
    v = dpp_add<0x141>(v);
    v = dpp_add<0x140>(v);
    return v;
}
__device__ __forceinline__ void row16_allsum4(float& a, float& b, float& c, float& d) {
    asm volatile("s_nop 1\n\t"
        "v_add_f32_dpp %0, %0, %0 quad_perm:[1,0,3,2] row_mask:0xf bank_mask:0xf\n\t" "v_add_f32_dpp %1, %1, %1 quad_perm:[1,0,3,2] row_mask:0xf bank_mask:0xf\n\t"
        "v_add_f32_dpp %2, %2, %2 quad_perm:[1,0,3,2] row_mask:0xf bank_mask:0xf\n\t" "v_add_f32_dpp %3, %3, %3 quad_perm:[1,0,3,2] row_mask:0xf bank_mask:0xf\n\t"
        "v_add_f32_dpp %0, %0, %0 quad_perm:[2,3,0,1] row_mask:0xf bank_mask:0xf\n\t" "v_add_f32_dpp %1, %1, %1 quad_perm:[2,3,0,1] row_mask:0xf bank_mask:0xf\n\t"
        "v_add_f32_dpp %2, %2, %2 quad_perm:[2,3,0,1] row_mask:0xf bank_mask:0xf\n\t" "v_add_f32_dpp %3, %3, %3 quad_perm:[2,3,0,1] row_mask:0xf bank_mask:0xf\n\t"
        "v_add_f32_dpp %0, %0, %0 row_half_mirror row_mask:0xf bank_mask:0xf\n\t" "v_add_f32_dpp %1, %1, %1 row_half_mirror row_mask:0xf bank_mask:0xf\n\t"
        "v_add_f32_dpp %2, %2, %2 row_half_mirror row_mask:0xf bank_mask:0xf\n\t" "v_add_f32_dpp %3, %3, %3 row_half_mirror row_mask:0xf bank_mask:0xf\n\t"
        "v_add_f32_dpp %0, %0, %0 row_mirror row_mask:0xf bank_mask:0xf\n\t" "v_add_f32_dpp %1, %1, %1 row_mirror row_mask:0xf bank_mask:0xf\n\t"
        "v_add_f32_dpp %2, %2, %2 row_mirror row_mask:0xf bank_mask:0xf\n\t" "v_add_f32_dpp %3, %3, %3 row_mirror row_mask:0xf bank_mask:0xf\n\t"
        "s_nop 1"
        : "+v"(a), "+v"(b), "+v"(c), "+v"(d));
}
template <int N> __device__ __forceinline__ float dpp_shr_or1(float v) {
    return __int_as_float(__builtin_amdgcn_update_dpp(0x3f800000, __float_as_int(v), 0x110 + N, 0xF, 0xF, false));
}
__device__ __forceinline__ f32x4 mfma16(bf16x8 a, bf16x8 b, f32x4 c) { return __builtin_amdgcn_mfma_f32_16x16x32_bf16(a, b, c, 0, 0, 0); }

namespace pg8 {
constexpr int BM = 256, BK = 64, HALF = 128, HTB = HALF * BK * 2, STAGE_BYTES = 8 * HTB, NXCD = 8, WGM = 8;
__host__ __device__ __forceinline__ int lds_byte(int r, int c) { const int st = (r >> 4) * 2 + (c >> 5), rr = r & 15, cc = c & 31, ob = rr * 64 + cc * 2; return st * 1024 + (ob ^ (((ob >> 9) & 1) << 5)); }
__host__ __device__ __forceinline__ void stage_rc(int b, int& R, int& C) { const int st = b / 1024, sb = b % 1024, swz = sb ^ (((sb >> 9) & 1) << 5); R = (st >> 1) * 16 + swz / 64; C = (st & 1) * 32 + (swz % 64) / 2; }
__host__ __device__ __forceinline__ int perm32(int rho) { const int n = rho >> 4, i = rho & 15; return 8 * (i >> 2) + 4 * n + (i & 3); }

struct Unit { const char* A; const char* B; char* O; int ldc; int pad; };

__device__ __forceinline__ void remap(int wgid, int nM, int nN, int& pm, int& pn) {
    const int nwg = nM * nN;
    { const int q = nwg / NXCD, r = nwg % NXCD, xcd = wgid % NXCD, off = wgid / NXCD; wgid = (xcd < r ? xcd * (q + 1) : r * (q + 1) + (xcd - r) * q) + off; }
    const int nig = WGM * nN, gid = wgid / nig, fm = gid * WGM, gsz = (nM - fm) < WGM ? (nM - fm) : WGM;
    pm = fm + ((wgid % nig) % gsz); pn = (wgid % nig) / gsz;
}

struct EpiBf {
    static constexpr bool PERM = true;
    __device__ __forceinline__ void operator()(const f32x4 (&acc)[2][2][4][2], const Unit& u, int wr, int wc, int fr, int fq) const {
        asm volatile("" : "+v"(fr), "+v"(fq));
        bf16_t* base = (bf16_t*)u.O;
#pragma unroll
        for (int ai = 0; ai < 2; ++ai)
#pragma unroll
            for (int m = 0; m < 4; ++m) { bf16_t* rowp = base + (size_t)(ai * HALF + wr * 64 + m * 16 + fr) * u.ldc + wc * 32 + 8 * fq;
#pragma unroll
                for (int bj = 0; bj < 2; ++bj) { const f32x4 v0 = acc[ai][bj][m][0], v1 = acc[ai][bj][m][1];
                    u32x4 w; w.x = pk2(v0[0], v0[1]); w.y = pk2(v0[2], v0[3]); w.z = pk2(v1[0], v1[1]); w.w = pk2(v1[2], v1[3]);
                    *(u32x4*)(rowp + bj * HALF) = w; } }
    }
};
struct EpiAtomic {
    static constexpr bool PERM = false;
    __device__ __forceinline__ void operator()(const f32x4 (&acc)[2][2][4][2], const Unit& u, int wr, int wc, int fr, int fq) const {
        asm volatile("" : "+v"(fr), "+v"(fq));
        float* base = (float*)u.O;
#pragma unroll
        for (int ai = 0; ai < 2; ++ai)
#pragma unroll
            for (int m = 0; m < 4; ++m) { float* rowp = base + (size_t)(ai * HALF + wr * 64 + m * 16 + fr) * u.ldc + wc * 32 + 4 * fq;
#pragma unroll
                for (int bj = 0; bj < 2; ++bj)
#pragma unroll
                    for (int n = 0; n < 2; ++n) { const f32x4 v = acc[ai][bj][m][n]; float* q = rowp + bj * HALF + n * 16;
#pragma unroll
                        for (int e = 0; e < 4; ++e) (void)__hip_atomic_fetch_add(q + e, v[e], __ATOMIC_RELAXED, __HIP_MEMORY_SCOPE_AGENT); }
                __builtin_amdgcn_sched_barrier(0); }
    }
};

template <class Epi, class Sched>
__device__ __forceinline__ void gemm_phase(LAS unsigned char* lds, const int tid, const int ldk, const int Kloop, const Sched& S, const Epi& E) {
    const int wid = __builtin_amdgcn_readfirstlane(tid >> 6), lane = tid & 63, wr = wid >> 2, wc = wid & 3, fr = lane & 15, fq = lane >> 4;
    const int nt = Kloop / BK;
    unsigned voffA[2], voffB[2];
#pragma unroll
    for (int i = 0; i < 2; ++i) { int R, C; stage_rc(tid * 16 + i * 8192, R, C); const int Rb = Epi::PERM ? ((R & ~31) + perm32(R & 31)) : R;
        voffA[i] = (unsigned)(R * ldk + C) * 2u; voffB[i] = (unsigned)(Rb * ldk + C) * 2u; }
    const size_t kstep = (size_t)(BK * 2);
    const size_t hstep = (size_t)HALF * ldk * 2;
    const unsigned ldsw = (unsigned)wid * 1024u;
    const int aoff = lds_byte(wr * 64 + fr, fq * 8), boff = lds_byte(wc * 32 + fr, fq * 8);
#define PG8_SA(b, h) (((b) * 2 + (h)) * HTB)
#define PG8_SB(b, h) ((4 + (b) * 2 + (h)) * HTB)
#define PG8_STAGE(bufoff, gbase, voff) do { _Pragma("unroll") for (int _i = 0; _i < 2; ++_i) \
        __builtin_amdgcn_global_load_lds((const unsigned*)((const char*)(gbase) + (voff)[_i]), (LAS unsigned*)(lds + (bufoff) + ldsw + _i * 8192), 16, 0, 0); } while (0)
#define PG8_LDA(dst, b, h) do { _Pragma("unroll") for (int m = 0; m < 4; ++m) _Pragma("unroll") for (int k = 0; k < 2; ++k) dst[m][k] = *(const LAS bf16x8*)(lds + PG8_SA(b, h) + aoff + m * 2048 + k * 1024); } while (0)
#define PG8_LDB(dst, b, h) do { _Pragma("unroll") for (int n = 0; n < 2; ++n) _Pragma("unroll") for (int k = 0; k < 2; ++k) dst[n][k] = *(const LAS bf16x8*)(lds + PG8_SB(b, h) + boff + n * 2048 + k * 1024); } while (0)
#define PG8_MMA(ai, bj, At, Bt) do { __builtin_amdgcn_s_setprio(1); _Pragma("unroll") for (int m = 0; m < 4; ++m) _Pragma("unroll") for (int n = 0; n < 2; ++n) _Pragma("unroll") for (int k = 0; k < 2; ++k) \
        acc[ai][bj][m][n] = __builtin_amdgcn_mfma_f32_16x16x32_bf16(Bt[n][k], At[m][k], acc[ai][bj][m][n], 0, 0, 0); __builtin_amdgcn_s_setprio(0); } while (0)
#define PG8_WAIT_V(n) asm volatile("s_waitcnt vmcnt(" #n ")" ::: "memory")
#define PG8_WAIT_L(n) asm volatile("s_waitcnt lgkmcnt(" #n ")" ::: "memory")
#define PG8_BAR __builtin_amdgcn_s_barrier()
#define PG8_SCHED __builtin_amdgcn_sched_barrier(0)
    Unit cur, nxt; int ui = 0;
    if (!S.next(0, cur)) return;
    f32x4 acc[2][2][4][2];
#pragma unroll
    for (int a = 0; a < 2; ++a)
#pragma unroll
        for (int b = 0; b < 2; ++b)
#pragma unroll
            for (int m = 0; m < 4; ++m)
#pragma unroll
                for (int n = 0; n < 2; ++n) acc[a][b][m][n] = (f32x4){0.f, 0.f, 0.f, 0.f};
    bf16x8 At[4][2], B0[2][2], B1[2][2];
    const char* cA = cur.A; const char* cB = cur.B;
    PG8_STAGE(PG8_SB(0, 0), cB, voffB); PG8_STAGE(PG8_SA(0, 0), cA, voffA); PG8_STAGE(PG8_SB(0, 1), cB + hstep, voffB); PG8_STAGE(PG8_SA(0, 1), cA + hstep, voffA);
    if (wr == 1) PG8_BAR;
    PG8_WAIT_V(4); PG8_BAR;
    PG8_STAGE(PG8_SB(1, 0), cB + kstep, voffB); PG8_STAGE(PG8_SA(1, 0), cA + kstep, voffA); PG8_STAGE(PG8_SB(1, 1), cB + hstep + kstep, voffB);
    PG8_WAIT_V(6); PG8_BAR;
    for (;;) {
        const bool has_next = S.next(ui + 1, nxt);
        const char* nA = has_next ? nxt.A : cA; const char* nB = has_next ? nxt.B : cB;
        for (int t = 0; t < nt; t += 2) {
            const bool last = (t == nt - 2);
            const char* a1 = cA + (size_t)(t + 1) * kstep;
            const char* a2 = last ? nA : cA + (size_t)(t + 2) * kstep; const char* b2 = last ? nB : cB + (size_t)(t + 2) * kstep;
            const char* a3 = a2 + kstep; const char* b3 = b2 + kstep;
            PG8_LDB(B0, 0, 0); PG8_SCHED; PG8_LDA(At, 0, 0); PG8_STAGE(PG8_SA(1, 1), a1 + hstep, voffA);
            PG8_WAIT_L(8); PG8_BAR; PG8_WAIT_L(0); PG8_MMA(0, 0, At, B0); PG8_BAR; PG8_SCHED;
            PG8_LDB(B1, 0, 1); PG8_STAGE(PG8_SB(0, 0), b2, voffB);
            PG8_BAR; PG8_WAIT_L(0); PG8_MMA(0, 1, At, B1); PG8_BAR;
            PG8_LDA(At, 0, 1); PG8_STAGE(PG8_SA(0, 0), a2, voffA);
            PG8_BAR; PG8_WAIT_L(0); PG8_MMA(1, 0, At, B0); PG8_BAR; PG8_SCHED;
            PG8_STAGE(PG8_SB(0, 1), b2 + hstep, voffB);
            PG8_WAIT_V(6); PG8_BAR; PG8_MMA(1, 1, At, B1); PG8_BAR;
            PG8_LDB(B0, 1, 0); PG8_SCHED; PG8_LDA(At, 1, 0); PG8_STAGE(PG8_SA(0, 1), a2 + hstep, voffA);
            PG8_WAIT_L(8); PG8_BAR; PG8_WAIT_L(0); PG8_MMA(0, 0, At, B0); PG8_BAR; PG8_SCHED;
            PG8_LDB(B1, 1, 1); PG8_STAGE(PG8_SB(1, 0), b3, voffB);
            PG8_BAR; PG8_WAIT_L(0); PG8_MMA(0, 1, At, B1); PG8_BAR;
            PG8_LDA(At, 1, 1); PG8_STAGE(PG8_SA(1, 0), a3, voffA);
            PG8_BAR; PG8_WAIT_L(0); PG8_MMA(1, 0, At, B0); PG8_BAR; PG8_SCHED;
            PG8_STAGE(PG8_SB(1, 1), b3 + hstep, voffB);
            PG8_WAIT_V(6); PG8_BAR; PG8_MMA(1, 1, At, B1); PG8_BAR;
        }
        E(acc, cur, wr, wc, fr, fq);
        if (!has_next) break;
#pragma unroll
        for (int a = 0; a < 2; ++a)
#pragma unroll
            for (int b = 0; b < 2; ++b)
#pragma unroll
                for (int m = 0; m < 4; ++m)
#pragma unroll
                    for (int n = 0; n < 2; ++n) acc[a][b][m][n] = (f32x4){0.f, 0.f, 0.f, 0.f};
        cur = nxt; cA = nA; cB = nB; ++ui;
    }
    PG8_WAIT_V(0);
    if (wr == 0) PG8_BAR;
    PG8_BAR;
#undef PG8_SA
#undef PG8_SB
#undef PG8_STAGE
#undef PG8_LDA
#undef PG8_LDB
#undef PG8_MMA
#undef PG8_WAIT_V
#undef PG8_WAIT_L
#undef PG8_BAR
#undef PG8_SCHED
}
}

#define XB_TMO      128
#define XB_XCNT(j)  (256  + 64 * (j))
#define XB_XSUB(j)  (1280 + 64 * (j))
#define XB_XGEN(j)  (2304 + 64 * (j))
#define XB_TOP      3328
#define XB_TOPGEN   3392
#define XCD_BAR_WORDS 3456
#define XB_SPIN_CAP (1u << 18)
__device__ __forceinline__ unsigned xb_ld(unsigned* p)              { return __hip_atomic_load(p, __ATOMIC_RELAXED, __HIP_MEMORY_SCOPE_AGENT); }
__device__ __forceinline__ unsigned xb_add(unsigned* p, unsigned v) { return __hip_atomic_fetch_add(p, v, __ATOMIC_RELAXED, __HIP_MEMORY_SCOPE_AGENT); }
__device__ __forceinline__ unsigned xb_xcc_id() { return (unsigned)__builtin_amdgcn_s_getreg((3 << 11) | 20) & 0xFu; }
#define XB_SPIN(cond, bar) do { unsigned _sp = 0; while (cond) { __builtin_amdgcn_s_sleep(1); \
    if ((++_sp & 255u) == 0u) { if (xb_ld(&(bar)[XB_TMO])) break; if (_sp > XB_SPIN_CAP) { atomicAdd(&(bar)[XB_TMO], 1u); break; } } } } while (0)
struct XcdBarrier { unsigned* bar; unsigned x; volatile LAS unsigned* st; };
__device__ __forceinline__ XcdBarrier xcd_barrier_post(unsigned* bar, volatile LAS unsigned* st) {
    XcdBarrier b; b.bar = bar; b.x = xb_xcc_id(); b.st = st;
    if (threadIdx.x == 0) (void)xb_add(&bar[XB_XCNT(b.x)], 1u);
    return b;
}
__device__ __forceinline__ void xcd_barrier_complete(unsigned* bar, unsigned x, unsigned& nloc, unsigned& nx) {
    const unsigned G = gridDim.x * gridDim.y * gridDim.z;
    unsigned sum, cnt, mine, sp = 0u;
    for (;;) {
        sum = 0u; cnt = 0u; mine = 0u;
#pragma unroll
        for (unsigned j = 0; j < 16; ++j) { const unsigned c = xb_ld(&bar[XB_XCNT(j)]); sum += c; cnt += (c > 0u) ? 1u : 0u; mine = (j == x) ? c : mine; }
        if (sum == G) break;
        __builtin_amdgcn_s_sleep(1);
        if ((++sp & 255u) == 0u) { if (xb_ld(&bar[XB_TMO])) break; if (sp > XB_SPIN_CAP) { atomicAdd(&bar[XB_TMO], 1u); break; } }
    }
    nloc = mine > 0u ? mine : 1u; nx = cnt > 0u ? cnt : 1u;
}
__device__ __forceinline__ void xcd_barrier(const XcdBarrier& b) {
    asm volatile("s_waitcnt vmcnt(0)" ::: "memory");
    __syncthreads();
    int tid0 = threadIdx.x; asm volatile("" : "+v"(tid0));
    if (tid0 == 0) {
        unsigned* bar = b.bar;
        __builtin_amdgcn_s_waitcnt(0);
        unsigned nloc = b.st[0], nx = b.st[1];
        if (nloc == 0u) { xcd_barrier_complete(bar, b.x, nloc, nx); b.st[0] = nloc; b.st[1] = nx; }
        const unsigned old = xb_add(&bar[XB_XSUB(b.x)], 1u);
        const unsigned gen = old / nloc;
        if (old + 1u == (gen + 1u) * nloc) {
            __builtin_amdgcn_fence(__ATOMIC_RELEASE, "agent");
            asm volatile("s_waitcnt vmcnt(0)" ::: "memory");
            const unsigned og = xb_add(&bar[XB_TOP], 1u);
            const unsigned tg = og / nx;
            if (og + 1u == (tg + 1u) * nx) xb_add(&bar[XB_TOPGEN], 1u);
            else XB_SPIN(xb_ld(&bar[XB_TOPGEN]) == tg, bar);
            __builtin_amdgcn_fence(__ATOMIC_ACQUIRE, "agent");
            xb_add(&bar[XB_XGEN(b.x)], 1u);
            asm volatile("s_waitcnt vmcnt(0)" ::: "memory");
        } else {
            XB_SPIN(xb_ld(&bar[XB_XGEN(b.x)]) == gen, bar);
            __builtin_amdgcn_fence(__ATOMIC_ACQUIRE, "agent");
            asm volatile("s_waitcnt vmcnt(0)" ::: "memory");
        }
    }
    __syncthreads();
}

__device__ __forceinline__ void lds_barrier() { asm volatile("s_waitcnt lgkmcnt(0)" ::: "memory"); __builtin_amdgcn_s_barrier(); asm volatile("" ::: "memory"); }
struct Ctx { int tid, wv, lane, G, bid; LAS unsigned char* lds; unsigned char* seg; };

template <int MODE>
__device__ __forceinline__ void convT_tile(const Ctx& c, const float* src, int ldsrc, int Ksrc, int k0, int n0, bf16_t* dst, int ldd, int koff) {
    LAS float* tile = (LAS float*)c.lds;
    __syncthreads();
#pragma unroll
    for (int rep = 0; rep < 2; ++rep) {
        const int i = (c.tid >> 4) + 32 * rep, j4 = (c.tid & 15) * 4; const int n = n0 + j4; int sc = n;
        if (MODE == 1) sc = (n < RW_SHIFT) ? n : (n < P1W ? -1 : n - (P1W - RW_SHIFT));
        f32x4 v = (f32x4){0.f, 0.f, 0.f, 0.f};
        if (sc >= 0 && (k0 + i) < Ksrc) v = *(const f32x4*)(src + (size_t)(k0 + i) * ldsrc + sc);
        tile[i * 65 + j4 + 0] = v[0]; tile[i * 65 + j4 + 1] = v[1]; tile[i * 65 + j4 + 2] = v[2]; tile[i * 65 + j4 + 3] = v[3];
    }
    __syncthreads();
    { const int j = c.tid >> 3, i8 = (c.tid & 7) * 8;
      if (k0 + i8 < Ksrc) {
        u32x4 w; w.x = pk2(tile[(i8 + 0) * 65 + j], tile[(i8 + 1) * 65 + j]); w.y = pk2(tile[(i8 + 2) * 65 + j], tile[(i8 + 3) * 65 + j]);
        w.z = pk2(tile[(i8 + 4) * 65 + j], tile[(i8 + 5) * 65 + j]); w.w = pk2(tile[(i8 + 6) * 65 + j], tile[(i8 + 7) * 65 + j]);
        *(u32x4*)(dst + (size_t)(n0 + j) * ldd + koff + k0 + i8) = w; } }
}

__device__ __forceinline__ void rms_row_bf16(const float* src, const float* g, bf16_t* dst, int lane) {
    f32x4 v[4]; float ss = 0.f;
#pragma unroll
    for (int i = 0; i < 4; ++i) { v[i] = *(const f32x4*)(src + i * 256 + lane * 4); ss += v[i][0] * v[i][0] + v[i][1] * v[i][1] + v[i][2] * v[i][2] + v[i][3] * v[i][3]; }
    ss = wsum(ss); const float rs = rsqrtf(ss * (1.0f / 1024.0f) + 1e-6f);
#pragma unroll
    for (int i = 0; i < 4; ++i) { const f32x4 gg = *(const f32x4*)(g + i * 256 + lane * 4);
        u32x2 w; w.x = pk2(v[i][0] * rs * gg[0], v[i][1] * rs * gg[1]); w.y = pk2(v[i][2] * rs * gg[2], v[i][3] * rs * gg[3]);
        *(u32x2*)(dst + i * 256 + lane * 4) = w; }
}
__device__ __forceinline__ float add_slabs(const float* src, const bf16_t* slab, int r, int lane, f32x4 (&v)[4]) {
    float ss = 0.f;
#pragma unroll
    for (int i = 0; i < 4; ++i) { v[i] = *(const f32x4*)(src + i * 256 + lane * 4);
#pragma unroll
        for (int ks = 0; ks < 4; ++ks) { const u32x2 t = *(const u32x2*)(slab + ((size_t)ks * MS + r) * DM + i * 256 + lane * 4);
            v[i][0] += bflo(t.x); v[i][1] += bfhi(t.x); v[i][2] += bflo(t.y); v[i][3] += bfhi(t.y); }
        ss += v[i][0] * v[i][0] + v[i][1] * v[i][1] + v[i][2] * v[i][2] + v[i][3] * v[i][3]; }
    return wsum(ss);
}

__device__ __forceinline__ void phase_apre(const P& p, const Ctx& c, int seg, int wg, int nwg) {
    bf16_t* H = (bf16_t*)(p.ws + OFF_H);
    for (int r = wg * 8 + c.wv; r < MS; r += nwg * 8) { const int b = r >> 9, tl = r & 511; const size_t grow = (size_t)b * SEQ + seg * SEGT + tl;
        rms_row_bf16(p.x + grow * DM, p.norm_g, H + (size_t)r * DM, c.lane); }
}
__device__ __forceinline__ void phase_a5(const P& p, const Ctx& c, int seg) {
    bf16_t* H = (bf16_t*)(p.ws + OFF_H); const bf16_t* slab = (const bf16_t*)(c.seg + S0_SLAB);
    for (int r = c.bid * 8 + c.wv; r < MS / 2; r += c.G * 8) {
        const int ra = r, rb = r + MS / 2;
        const size_t ga = (size_t)(ra >> 9) * SEQ + seg * SEGT + (ra & 511), gb = (size_t)(rb >> 9) * SEQ + seg * SEGT + (rb & 511);
        f32x4 va[4], vb[4]; const float sa = add_slabs(p.x + ga * DM, slab, ra, c.lane, va); const float sb = add_slabs(p.x + gb * DM, slab, rb, c.lane, vb);
        const float rsa = rsqrtf(sa * (1.0f / 1024.0f) + 1e-6f), rsb = rsqrtf(sb * (1.0f / 1024.0f) + 1e-6f);
#pragma unroll
        for (int i = 0; i < 4; ++i) { const f32x4 gg = *(const f32x4*)(p.norm_g + DM + i * 256 + c.lane * 4);
            *(f32x4*)(p.out + ga * DM + i * 256 + c.lane * 4) = va[i]; *(f32x4*)(p.out + gb * DM + i * 256 + c.lane * 4) = vb[i];
            u32x2 w; w.x = pk2(va[i][0] * rsa * gg[0], va[i][1] * rsa * gg[1]); w.y = pk2(va[i][2] * rsa * gg[2], va[i][3] * rsa * gg[3]);
            *(u32x2*)(H + (size_t)ra * DM + i * 256 + c.lane * 4) = w;
            w.x = pk2(vb[i][0] * rsb * gg[0], vb[i][1] * rsb * gg[1]); w.y = pk2(vb[i][2] * rsb * gg[2], vb[i][3] * rsb * gg[3]);
            *(u32x2*)(H + (size_t)rb * DM + i * 256 + c.lane * 4) = w; } }
}
__device__ __forceinline__ void phase_b5(const P& p, const Ctx& c, int seg) {
    const bf16_t* slab = (const bf16_t*)(c.seg + S1_SLAB);
    for (int r = c.bid * 8 + c.wv; r < MS / 2; r += c.G * 8) {
        const int ra = r, rb = r + MS / 2;
        float* rowa = p.out + ((size_t)(ra >> 9) * SEQ + seg * SEGT + (ra & 511)) * DM; float* rowb = p.out + ((size_t)(rb >> 9) * SEQ + seg * SEGT + (rb & 511)) * DM;
        f32x4 va[4], vb[4]; const float sa = add_slabs(rowa, slab, ra, c.lane, va); const float sb = add_slabs(rowb, slab, rb, c.lane, vb);
        const float rsa = rsqrtf(sa * (1.0f / 1024.0f) + 1e-6f), rsb = rsqrtf(sb * (1.0f / 1024.0f) + 1e-6f);
#pragma unroll
        for (int i = 0; i < 4; ++i) { const f32x4 gg = *(const f32x4*)(p.final_g + i * 256 + c.lane * 4); f32x4 o;
            o[0] = va[i][0] * rsa * gg[0]; o[1] = va[i][1] * rsa * gg[1]; o[2] = va[i][2] * rsa * gg[2]; o[3] = va[i][3] * rsa * gg[3]; *(f32x4*)(rowa + i * 256 + c.lane * 4) = o;
            o[0] = vb[i][0] * rsb * gg[0]; o[1] = vb[i][1] * rsb * gg[1]; o[2] = vb[i][2] * rsb * gg[2]; o[3] = vb[i][3] * rsb * gg[3]; *(f32x4*)(rowb + i * 256 + c.lane * 4) = o; } }
}

__device__ __forceinline__ void phase0(const P& p, const Ctx& c) {
    const int T0 = 16 * 64, T1 = 16 * 120, T2 = 32 * 16, T3 = 32 * 16, T4 = 16 * 16, T5 = 16 * 16, T6 = 24 * 5;
    const int TT = T0 + T1 + T2 + T3 + T4 + T5 + T6;
    for (int t = c.bid; t < TT; t += c.G) {
        int u = t;
        if (u < T0) { convT_tile<0>(c, p.ml_w_in, ML_W, 1024, (u & 15) * 64, (u >> 4) * 64, (bf16_t*)(p.ws + OFF_WT0), 1024, 0); continue; } u -= T0;
        if (u < T1) { convT_tile<1>(c, p.rw_w_in, RW_W, 1024, (u & 15) * 64, (u >> 4) * 64, (bf16_t*)(p.ws + OFF_WT1), 1024, 0); continue; } u -= T1;
        if (u < T2) { convT_tile<0>(c, p.w_out, DM, 2048, (u & 31) * 64, (u >> 5) * 64, (bf16_t*)(p.ws + OFF_WO0T), 2048, 0); continue; } u -= T2;
        if (u < T3) { convT_tile<0>(c, p.w_out + (size_t)DIN * DM, DM, 2048, (u & 31) * 64, (u >> 5) * 64, (bf16_t*)(p.ws + OFF_WO1T), 2048, 0); continue; } u -= T3;
        if (u < T4) { convT_tile<0>(c, p.mem_kv_w, DM, 1024, (u & 15) * 64, (u >> 4) * 64, (bf16_t*)(p.ws + OFF_WKVT), 1024, 0); continue; } u -= T4;
        if (u < T5) { convT_tile<0>(c, p.mem_kv_w + (size_t)DM * DM, DM, 1024, (u & 15) * 64, (u >> 4) * 64, (bf16_t*)(p.ws + OFF_WKVT + 2 * MiB), 1024, 0); continue; } u -= T5;
        { const int nt = u / 5, j = u % 5; bf16_t* L = (bf16_t*)(p.ws + OFF_LORAT);
          if (j == 0) convT_tile<0>(c, p.rw_w_lora2, DMIX, 64, 0, nt * 64, L, 288, 0);
          else if (j == 1) convT_tile<0>(c, p.rw_a_lora2, DMIX, 64, 0, nt * 64, L, 288, 64);
          else if (j == 2) convT_tile<0>(c, p.rw_v_lora2, DMIX, 32, 0, nt * 64, L, 288, 128);
          else convT_tile<0>(c, p.rw_g_lora2, DMIX, 128, (j - 3) * 64, nt * 64, L, 288, 160); }
    }
    for (int r = c.bid * 8 + c.wv; r < 2 * 2048; r += c.G * 8) { const int l = r >> 11, rr = r & 2047;
        rms_row_bf16(p.mem + (size_t)rr * DM, p.mem_norm_g + l * DM, (bf16_t*)(p.ws + OFF_MEMN) + (size_t)r * DM, c.lane); }
}

struct SchedA0 {
    const unsigned char* ws; unsigned char* seg; int G, c, nextra;
    __device__ __forceinline__ bool next(int i, pg8::Unit& u) const {
        const int L = i * G + c; if (L >= 256 + nextra) return false;
        if (L < 256) { int pm, pn; pg8::remap(L, 16, 16, pm, pn);
            u.A = (const char*)(ws + OFF_H) + (size_t)pm * 256 * 1024 * 2; u.B = (const char*)(ws + OFF_WT0) + (size_t)pn * 256 * 1024 * 2;
            u.O = (char*)(seg + S0_P0) + ((size_t)pm * 256 * ML_W + pn * 256) * 2; u.ldc = ML_W; return true; }
        const int e = L - 256, l = e >> 5, j = e & 31;
        const char* memn = (const char*)(ws + OFF_MEMN) + (size_t)l * 2048 * 1024 * 2; const char* wkv = (const char*)(ws + OFF_WKVT) + (size_t)l * 2 * MiB;
        char* kout = (char*)(ws + OFF_KMEM) + (size_t)l * 4 * MiB;
        if (j < 16) { const int pm = j >> 1, pn = j & 1;
            u.A = memn + (size_t)pm * 256 * 1024 * 2; u.B = wkv + (size_t)pn * 256 * 1024 * 2; u.O = kout + ((size_t)pm * 256 * 512 + pn * 256) * 2; u.ldc = 512; }
        else { const int jj = j - 16, pm = jj >> 3, pn = jj & 7;
            u.A = wkv + (size_t)(512 + pm * 256) * 1024 * 2; u.B = memn + (size_t)pn * 256 * 1024 * 2; u.O = kout + 2 * MiB + ((size_t)pm * 256 * 2048 + pn * 256) * 2; u.ldc = 2048; }
        return true;
    }
};
struct SchedB0 {
    const unsigned char* ws; unsigned char* seg; int G, c;
    __device__ __forceinline__ bool next(int i, pg8::Unit& u) const {
        const int L = i * G + c; if (L >= 480) return false;
        int pm, pn; pg8::remap(L, 16, 30, pm, pn);
        u.A = (const char*)(ws + OFF_H) + (size_t)pm * 256 * 1024 * 2; u.B = (const char*)(ws + OFF_WT1) + (size_t)pn * 256 * 1024 * 2;
        if (pn < 20) { u.O = (char*)(seg + S1_P1) + ((size_t)pm * 256 * P1W + pn * 256) * 2; u.ldc = P1W; }
        else { u.O = (char*)(seg + S1_P2) + ((size_t)pm * 256 * P2W + (pn - 20) * 256) * 2; u.ldc = P2W; }
        return true;
    }
};
struct SchedOut {
    const char* Y; const char* W; char* slab; int G, c;
    __device__ __forceinline__ bool next(int i, pg8::Unit& u) const {
        const int L = i * G + c; if (L >= 256) return false;
        const int ks = L >> 6; int pm, pn; pg8::remap(L & 63, 16, 4, pm, pn);
        u.A = Y + ((size_t)pm * 256 * DIN + ks * 512) * 2; u.B = W + ((size_t)pn * 256 * DIN + ks * 512) * 2;
        u.O = slab + (((size_t)ks * MS + pm * 256) * DM + pn * 256) * 2; u.ldc = DM; return true;
    }
};

__device__ __forceinline__ void phase_a1(const P& p, const Ctx& c, int seg) {
    const bf16_t* P0 = (const bf16_t*)(c.seg + S0_P0);
    bf16_t* Qb = (bf16_t*)(c.seg + S0_Q); bf16_t* Kb = (bf16_t*)(c.seg + S0_K); bf16_t* KT = (bf16_t*)(c.seg + S0_KT); bf16_t* VT = (bf16_t*)(c.seg + S0_VT);
    bf16_t* XC = (bf16_t*)(c.seg + S0_XC); bf16_t* VF = (bf16_t*)(p.ws + OFF_VF);
    float* IPRE = (float*)(c.seg + S0_GATE); float* LOGF = IPRE + 32 * SEGT;
    const bf16_t* UT = (const bf16_t*)(p.ws + OFF_UTAIL);
    LAS float* red = (LAS float*)c.lds;
    LAS bf16_t* kst = (LAS bf16_t*)(c.lds + 98304);
    LAS bf16_t* vst = kst + 1536 * 8;
    const int n = c.tid;
    float wq[4][4], wk[4][4], wv[4][4], G12[4][8], G3[4][8];
    if (n < 384) {
#pragma unroll
        for (int i = 0; i < 4; ++i) { const f32x4 a = *(const f32x4*)(p.ml_wq + n * 16 + i * 4), bb = *(const f32x4*)(p.ml_wk + n * 16 + i * 4), cc = *(const f32x4*)(p.ml_wv + n * 16 + i * 4);
#pragma unroll
            for (int o = 0; o < 4; ++o) { wq[i][o] = a[o]; wk[i][o] = bb[o]; wv[i][o] = cc[o]; } }
#pragma unroll
        for (int i = 0; i < 4; ++i)
#pragma unroll
            for (int g = 0; g < 8; ++g) { G12[i][g] = 0.f; G3[i][g] = 0.f; }
#pragma unroll
        for (int o = 0; o < 4; ++o) {
            const float* gq = p.ml_w_gate + (size_t)(n * 4 + o) * 8; const float* gk = p.ml_w_gate + (size_t)(DMIX + n * 4 + o) * 8; const float* gv = p.ml_w_gate + (size_t)(2 * DMIX + n * 4 + o) * 8;
            const f32x4 q0 = *(const f32x4*)gq, q1 = *(const f32x4*)(gq + 4), k0 = *(const f32x4*)gk, k1 = *(const f32x4*)(gk + 4), v0 = *(const f32x4*)gv, v1 = *(const f32x4*)(gv + 4);
#pragma unroll
            for (int i = 0; i < 4; ++i)
#pragma unroll
                for (int g = 0; g < 4; ++g) { G12[i][g] += wq[i][o] * q0[g] + wk[i][o] * k0[g]; G12[i][g + 4] += wq[i][o] * q1[g] + wk[i][o] * k1[g];
                    G3[i][g] += wv[i][o] * v0[g]; G3[i][g + 4] += wv[i][o] * v1[g]; }
        }
    }
#pragma unroll 1
    for (int it = c.bid; it < MS / 8; it += c.G) {
        const int row0 = it * 8, b = row0 >> 9, tl0 = row0 & 511;
        __syncthreads();
        if (n < 384) {
            float um[3][4];
#pragma unroll
            for (int j = 1; j <= 3; ++j) { u32x2 raw = (u32x2){0u, 0u};
                if (tl0 - j >= 0) raw = *(const u32x2*)(P0 + (unsigned)((row0 - j) * ML_W + n * 4));
                else if (seg > 0) raw = *(const u32x2*)(UT + (unsigned)((b * 3 + (3 - j)) * DMIX + n * 4));
                um[3 - j][0] = bflo(raw.x); um[3 - j][1] = bfhi(raw.x); um[3 - j][2] = bflo(raw.y); um[3 - j][3] = bfhi(raw.y); }
            u32x2 nraw = *(const u32x2*)(P0 + (unsigned)(row0 * ML_W + n * 4));
#pragma unroll 1
            for (int tt = 0; tt < 8; ++tt) {
                const unsigned row = (unsigned)(row0 + tt);
                const u32x2 raw = nraw;
                if (tt + 1 < 8) nraw = *(const u32x2*)(P0 + (unsigned)((row + 1) * ML_W + n * 4));
                float u[4] = {bflo(raw.x), bfhi(raw.x), bflo(raw.y), bfhi(raw.y)}, xc[4], q[4], k[4], v[4];
                { int nn = n; asm volatile("" : "+v"(nn));
                  const f32x4 cb = *(const f32x4*)(p.ml_conv_b + nn * 4), c0 = *(const f32x4*)(p.ml_conv_w + nn * 4), c1 = *(const f32x4*)(p.ml_conv_w + DMIX + nn * 4),
                              c2 = *(const f32x4*)(p.ml_conv_w + 2 * DMIX + nn * 4), c3 = *(const f32x4*)(p.ml_conv_w + 3 * DMIX + nn * 4);
#pragma unroll
                  for (int i = 0; i < 4; ++i) { const float y = cb[i] + c0[i] * um[0][i] + c1[i] * um[1][i] + c2[i] * um[2][i] + c3[i] * u[i]; xc[i] = siluf_(y); } }
                const float ks = 0.05103103630798288f;
#pragma unroll
                for (int o = 0; o < 4; ++o) { q[o] = xc[0] * wq[0][o] + xc[1] * wq[1][o] + xc[2] * wq[2][o] + xc[3] * wq[3][o];
                    k[o] = (xc[0] * wk[0][o] + xc[1] * wk[1][o] + xc[2] * wk[2][o] + xc[3] * wk[3][o]) * ks;
                    v[o] = u[0] * wv[0][o] + u[1] * wv[1][o] + u[2] * wv[2][o] + u[3] * wv[3][o]; }
#pragma unroll
                for (int g = 0; g < 8; ++g) red[(tt * 8 + g) * 384 + n] = xc[0] * G12[0][g] + xc[1] * G12[1][g] + xc[2] * G12[2][g] + xc[3] * G12[3][g] + u[0] * G3[0][g] + u[1] * G3[1][g] + u[2] * G3[2][g] + u[3] * G3[3][g];
                u32x2 w; w.x = pk2(q[0], q[1]); w.y = pk2(q[2], q[3]); *(u32x2*)(Qb + (unsigned)(row * DMIX + n * 4)) = w;
                w.x = pk2(k[0], k[1]); w.y = pk2(k[2], k[3]); *(u32x2*)(Kb + (unsigned)(row * DMIX + n * 4)) = w;
                w.x = pk2(xc[0], xc[1]); w.y = pk2(xc[2], xc[3]); *(u32x2*)(XC + (unsigned)(row * DMIX + n * 4)) = w;
                w.x = pk2(v[0], v[1]); w.y = pk2(v[2], v[3]); *(u32x2*)(VF + (unsigned)(row * DMIX + n * 4)) = w;
#pragma unroll
                for (int o = 0; o < 4; ++o) { kst[(n * 4 + o) * 8 + tt] = f2bf(k[o]); vst[(n * 4 + o) * 8 + tt] = f2bf(v[o]); }
#pragma unroll
                for (int i = 0; i < 4; ++i) { um[0][i] = um[1][i]; um[1][i] = um[2][i]; um[2][i] = u[i]; }
            }
            const int hd = n / 96, dch = (n % 96) * 4;
#pragma unroll
            for (int o = 0; o < 4; ++o) { const unsigned off = (unsigned)(((b * 4 + hd) * 384 + dch + o) * SEGT + tl0);
                *(u32x4*)(KT + off) = *(const LAS u32x4*)(kst + (n * 4 + o) * 8); *(u32x4*)(VT + off) = *(const LAS u32x4*)(vst + (n * 4 + o) * 8); }
        }
        __syncthreads();
        { const int v = c.tid >> 3, part = c.tid & 7; float s = 0.f;
#pragma unroll 8
          for (int i = 0; i < 48; ++i) s += red[v * 384 + part * 48 + i];
          s += __shfl_xor(s, 1); s += __shfl_xor(s, 2); s += __shfl_xor(s, 4);
          if (part == 0) { const int tt = v >> 3, g = v & 7; const float gate = s + p.ml_b_gate[g];
              if (g < 4) IPRE[(b * 4 + g) * SEGT + tl0 + tt] = gate; else LOGF[(b * 4 + g - 4) * SEGT + tl0 + tt] = -softplusf_(-gate); } }
    }
}

__device__ __forceinline__ void attn_item(const P& p, const Ctx& c, int layer, int it, const bf16_t* Qp, int ldq, bf16_t* YM) {
    const int b = it >> 3, head = (it >> 1) & 3, qb = it & 1;
    const bf16_t* Kg = (const bf16_t*)(p.ws + OFF_KMEM + (size_t)layer * 4 * MiB) + (size_t)(b * 256) * 512 + head * 128;
    const bf16_t* Vg = (const bf16_t*)(p.ws + OFF_KMEM + (size_t)layer * 4 * MiB + 2 * MiB) + (size_t)(head * 128) * 2048 + b * 256;
    LAS bf16_t* Ks = (LAS bf16_t*)c.lds;
    LAS bf16_t* Vs = Ks + 256 * 136;
    const int l15 = c.lane & 15, quad = c.lane >> 4;
    __syncthreads();
#pragma unroll
    for (int r = 0; r < 8; ++r) { const int id = c.tid + 512 * r; { const int i = id >> 4, c8 = (id & 15) * 8; *(LAS u32x4*)(Ks + i * 136 + c8) = *(const u32x4*)(Kg + (size_t)i * 512 + c8); }
        { const int i = id >> 5, c8 = (id & 31) * 8; *(LAS u32x4*)(Vs + i * 264 + c8) = *(const u32x4*)(Vg + (size_t)i * 2048 + c8); } }
    __syncthreads();
#pragma unroll 1
    for (int pass = 0; pass < 2; ++pass) {
        const int row0 = b * SEGT + qb * 256 + c.wv * 32 + pass * 16;
        bf16x8 qf[4];
#pragma unroll
        for (int kk = 0; kk < 4; ++kk) qf[kk] = *(const bf16x8*)(Qp + (size_t)(row0 + l15) * ldq + head * 128 + kk * 32 + quad * 8);
        f32x4 acc[16];
#pragma unroll
        for (int mt = 0; mt < 16; ++mt) { acc[mt] = (f32x4){0.f, 0.f, 0.f, 0.f};
#pragma unroll
            for (int kk = 0; kk < 4; ++kk) { const bf16x8 a = *(const LAS bf16x8*)(Ks + (mt * 16 + l15) * 136 + kk * 32 + quad * 8); acc[mt] = mfma16(a, qf[kk], acc[mt]); }
            if ((mt & 3) == 3) __builtin_amdgcn_sched_barrier(0); }
        float mx = -1e30f;
#pragma unroll
        for (int mt = 0; mt < 16; ++mt)
#pragma unroll
            for (int j = 0; j < 4; ++j) mx = fmaxf(mx, acc[mt][j]);
        mx = fmaxf(mx, __shfl_xor(mx, 16)); mx = fmaxf(mx, __shfl_xor(mx, 32));
        const float sc = 0.08838834764831845f * 1.4426950408889634f; float sm = 0.f;
#pragma unroll
        for (int mt = 0; mt < 16; ++mt)
#pragma unroll
            for (int j = 0; j < 4; ++j) { const float e = exp2f((acc[mt][j] - mx) * sc); acc[mt][j] = e; sm += e; }
        sm += __shfl_xor(sm, 16); sm += __shfl_xor(sm, 32);
        const float inv = 1.0f / sm;
        bf16x8 pa[8];
#pragma unroll
        for (int kp = 0; kp < 8; ++kp) {
            u32x4 aw; aw.x = pk2(acc[2 * kp][0] * inv, acc[2 * kp][1] * inv); aw.y = pk2(acc[2 * kp][2] * inv, acc[2 * kp][3] * inv);
            aw.z = pk2(acc[2 * kp + 1][0] * inv, acc[2 * kp + 1][1] * inv); aw.w = pk2(acc[2 * kp + 1][2] * inv, acc[2 * kp + 1][3] * inv);
            __builtin_memcpy(&pa[kp], &aw, 16); }
        __builtin_amdgcn_sched_barrier(0);
        f32x4 o[8];
#pragma unroll
        for (int nt = 0; nt < 8; ++nt) o[nt] = (f32x4){0.f, 0.f, 0.f, 0.f};
#pragma unroll
        for (int kp = 0; kp < 8; ++kp) {
            const bf16x8 a = pa[kp];
#pragma unroll
            for (int nt = 0; nt < 8; ++nt) { const LAS bf16_t* vp = Vs + (nt * 16 + l15) * 264 + 2 * kp * 16 + quad * 4;
                const u32x2 lo = *(const LAS u32x2*)vp, hi = *(const LAS u32x2*)(vp + 16); u32x4 bw = (u32x4){lo.x, lo.y, hi.x, hi.y}; bf16x8 bfr; __builtin_memcpy(&bfr, &bw, 16);
                o[nt] = mfma16(a, bfr, o[nt]); }
            __builtin_amdgcn_sched_barrier(0);
        }
#pragma unroll
        for (int nt = 0; nt < 8; ++nt)
#pragma unroll
            for (int j = 0; j < 4; ++j) YM[(size_t)(row0 + quad * 4 + j) * DX + head * 128 + nt * 16 + l15] = f2bf(o[nt][j]);
    }
}

__device__ __forceinline__ void mlstm_item(const P& p, const Ctx& c, int seg, int w, bool save) {
    const int b = w / 24, h = (w / 6) & 3, sl = w % 6;
    const bf16_t* Qb = (const bf16_t*)(c.seg + S0_Q); const bf16_t* Kb = (const bf16_t*)(c.seg + S0_K); const bf16_t* KT = (const bf16_t*)(c.seg + S0_KT); const bf16_t* VT = (const bf16_t*)(c.seg + S0_VT);
    const float* IPRE = (const float*)(c.seg + S0_GATE); const float* LOGF = IPRE + 32 * SEGT;
    float* HR = (float*)(c.seg + S0_HRAW);
    float* CST = (float*)(p.ws + OFF_CST) + (size_t)w * 64 * 384; float* NST = (float*)(p.ws + OFF_NST) + (size_t)w * 384;
    LAS bf16_t* Cimg = (LAS bf16_t*)c.lds;
    LAS bf16_t* Qs = Cimg + 64 * 392;
    LAS bf16_t* Ks = Qs + 64 * 136;
    LAS bf16_t* KTs = Ks + 64 * 136;
    LAS bf16_t* VTs = KTs + 128 * 72;
    LAS bf16_t* VWs = VTs + 64 * 72;
    LAS bf16_t* Sp = VWs + 64 * 72;
    LAS float* fl = (LAS float*)(Sp + 64 * 72);
    LAS float* bcum = fl; LAS float* ipr = fl + 64; LAS float* wgt = fl + 128; LAS float* gin = fl + 192; LAS float* qn = fl + 256; LAS float* rden = fl + 320;
    LAS float* gtotp = fl + 384; LAS float* nold = fl + 400; LAS float* nnew = fl + 800;
    const int l15c = c.lane & 15, quadc = c.lane >> 4, e16 = c.wv & 3, par = c.wv >> 2;
    f32x4 C[12];
    __syncthreads();
    if (seg > 0) {
#pragma unroll
        for (int j = 0; j < 12; ++j)
#pragma unroll
            for (int jj = 0; jj < 4; ++jj) C[j][jj] = CST[(size_t)(e16 * 16 + quadc * 4 + jj) * 384 + (2 * j + par) * 16 + l15c];
        if (c.tid < 384) nold[c.tid] = NST[c.tid];
    } else {
#pragma unroll
        for (int j = 0; j < 12; ++j) C[j] = (f32x4){0.f, 0.f, 0.f, 0.f};
        if (c.tid < 384) nold[c.tid] = 0.f;
    }
    u32x4 pq[2], pk[2], pt[2], pvt; float plf = 0.f, pip = 0.f;
    auto gl_piece = [&](int ch, int pp, int tidv) {
#pragma unroll
        for (int r = 0; r < 2; ++r) { const int id = tidv + 512 * r;
            { const int i = id >> 4, c8 = (id & 15) * 8; const size_t go = ((size_t)b * SEGT + ch * 64 + i) * DMIX + h * 384 + pp * 128 + c8; pq[r] = *(const u32x4*)(Qb + go); pk[r] = *(const u32x4*)(Kb + go); }
            { const int dd = id >> 3, c8 = (id & 7) * 8; pt[r] = *(const u32x4*)(KT + ((size_t)(b * 4 + h) * 384 + pp * 128 + dd) * SEGT + ch * 64 + c8); } } };
    auto gl_chunk = [&](int ch, int tidv) { const int i = tidv >> 3, c8 = (tidv & 7) * 8;
        pvt = *(const u32x4*)(VT + ((size_t)(b * 4 + h) * 384 + sl * 64 + i) * SEGT + ch * 64 + c8);
        if (c.wv == 0) { plf = LOGF[(b * 4 + h) * SEGT + ch * 64 + c.lane]; pip = IPRE[(b * 4 + h) * SEGT + ch * 64 + c.lane]; } };
    { int t0 = c.tid; asm volatile("" : "+v"(t0)); gl_chunk(0, t0); gl_piece(0, 0, t0); }
#pragma unroll 1
    for (int ch = 0; ch < 8; ++ch) {
        const int tl0 = ch * 64; const size_t row0 = (size_t)b * SEGT + tl0;
        int tidv = c.tid, l15 = l15c, quad = quadc;
        asm volatile("" : "+v"(tidv), "+v"(l15), "+v"(quad));
        lds_barrier();
        if (c.wv == 0) {
            float bc = plf;
#pragma unroll
            for (int o = 1; o < 64; o <<= 1) { const float t = __shfl_up(bc, o); if (c.lane >= o) bc += t; }
            const float bl = __shfl(bc, 63);
            bcum[c.lane] = bc; ipr[c.lane] = pip; wgt[c.lane] = __expf(bl - bc + pip); gin[c.lane] = __expf(bc);
            if (c.lane == 0) gtotp[0] = __expf(bl);
        }
#pragma unroll
        for (int j = 0; j < 12; ++j)
#pragma unroll
            for (int jj = 0; jj < 4; ++jj) Cimg[(e16 * 16 + quad * 4 + jj) * 392 + (2 * j + par) * 16 + l15] = f2bf(C[j][jj]);
        lds_barrier();
        { const int i = tidv >> 3, c8 = (tidv & 7) * 8;
          const u32x4 raw = pvt;
          *(LAS u32x4*)(VTs + i * 72 + c8) = raw;
          const f32x4 w0 = *(const LAS f32x4*)(wgt + c8), w1 = *(const LAS f32x4*)(wgt + c8 + 4);
          u32x4 sw; sw.x = pk2(bflo(raw.x) * w0[0], bfhi(raw.x) * w0[1]); sw.y = pk2(bflo(raw.y) * w0[2], bfhi(raw.y) * w0[3]);
          sw.z = pk2(bflo(raw.z) * w1[0], bfhi(raw.z) * w1[1]); sw.w = pk2(bflo(raw.w) * w1[2], bfhi(raw.w) * w1[3]);
          *(LAS u32x4*)(VWs + i * 72 + c8) = sw; }
        if (ch + 1 < 8) gl_chunk(ch + 1, tidv);
        const float gtot = gtotp[0];
#pragma unroll
        for (int j = 0; j < 12; ++j) C[j] *= gtot;
        f32x4 Sa[2], Ia[2]; Sa[0] = Sa[1] = Ia[0] = Ia[1] = (f32x4){0.f, 0.f, 0.f, 0.f};
        float qnacc = 0.f;
#pragma unroll
        for (int pp = 0; pp < 3; ++pp) {
            const int d0 = pp * 128;
            __builtin_amdgcn_sched_barrier(0);
            asm volatile("" : "+v"(tidv));
            lds_barrier();
#pragma unroll
            for (int r = 0; r < 2; ++r) { const int id = tidv + 512 * r;
                { const int i = id >> 4, c8 = (id & 15) * 8; *(LAS u32x4*)(Qs + i * 136 + c8) = pq[r]; *(LAS u32x4*)(Ks + i * 136 + c8) = pk[r]; }
                { const int dd = id >> 3, c8 = (id & 7) * 8; *(LAS u32x4*)(KTs + dd * 72 + c8) = pt[r]; } }
            lds_barrier();
            if (pp < 2) gl_piece(ch, pp + 1, tidv); else if (ch + 1 < 8) gl_piece(ch + 1, 0, tidv);
            { const int tm = c.wv >> 1, tn0 = (c.wv & 1) * 2;
#pragma unroll
              for (int kk = 0; kk < 4; ++kk) { const bf16x8 a = *(const LAS bf16x8*)(Qs + (tm * 16 + l15) * 136 + kk * 32 + quad * 8);
#pragma unroll
                  for (int x = 0; x < 2; ++x) { const int tn = tn0 + x;
                      const bf16x8 bk = *(const LAS bf16x8*)(Ks + (tn * 16 + l15) * 136 + kk * 32 + quad * 8);
                      const bf16x8 bc = *(const LAS bf16x8*)(Cimg + (tn * 16 + l15) * 392 + d0 + kk * 32 + quad * 8);
                      Sa[x] = mfma16(a, bk, Sa[x]); Ia[x] = mfma16(a, bc, Ia[x]); } } }
            { const bf16x8 va0 = *(const LAS bf16x8*)(VWs + (e16 * 16 + l15) * 72 + quad * 8), va1 = *(const LAS bf16x8*)(VWs + (e16 * 16 + l15) * 72 + 32 + quad * 8);
#pragma unroll
              for (int jl = 0; jl < 4; ++jl) { const int ntl = 2 * jl + par, j = pp * 4 + jl;
                  C[j] = mfma16(va0, *(const LAS bf16x8*)(KTs + (ntl * 16 + l15) * 72 + quad * 8), C[j]);
                  C[j] = mfma16(va1, *(const LAS bf16x8*)(KTs + (ntl * 16 + l15) * 72 + 32 + quad * 8), C[j]); } }
            { const int t = tidv >> 3, part = tidv & 7;
              const u32x4 q0 = *(const LAS u32x4*)(Qs + t * 136 + part * 16), q1 = *(const LAS u32x4*)(Qs + t * 136 + part * 16 + 8);
              const LAS float* np = nold + d0 + part * 16; const f32x4 n0 = *(const LAS f32x4*)np, n1 = *(const LAS f32x4*)(np + 4), n2 = *(const LAS f32x4*)(np + 8), n3 = *(const LAS f32x4*)(np + 12);
              qnacc += bflo(q0.x) * n0[0] + bfhi(q0.x) * n0[1] + bflo(q0.y) * n0[2] + bfhi(q0.y) * n0[3] + bflo(q0.z) * n1[0] + bfhi(q0.z) * n1[1] + bflo(q0.w) * n1[2] + bfhi(q0.w) * n1[3]
                     + bflo(q1.x) * n2[0] + bfhi(q1.x) * n2[1] + bflo(q1.y) * n2[2] + bfhi(q1.y) * n2[3] + bflo(q1.z) * n3[0] + bfhi(q1.z) * n3[1] + bflo(q1.w) * n3[2] + bfhi(q1.w) * n3[3]; }
            { const int dd = tidv >> 2, part = tidv & 3;
              const u32x4 k0 = *(const LAS u32x4*)(KTs + dd * 72 + part * 16), k1 = *(const LAS u32x4*)(KTs + dd * 72 + part * 16 + 8);
              const LAS float* wp = wgt + part * 16; const f32x4 w0 = *(const LAS f32x4*)wp, w1 = *(const LAS f32x4*)(wp + 4), w2 = *(const LAS f32x4*)(wp + 8), w3 = *(const LAS f32x4*)(wp + 12);
              float a = bflo(k0.x) * w0[0] + bfhi(k0.x) * w0[1] + bflo(k0.y) * w0[2] + bfhi(k0.y) * w0[3] + bflo(k0.z) * w1[0] + bfhi(k0.z) * w1[1] + bflo(k0.w) * w1[2] + bfhi(k0.w) * w1[3]
                      + bflo(k1.x) * w2[0] + bfhi(k1.x) * w2[1] + bflo(k1.y) * w2[2] + bfhi(k1.y) * w2[3] + bflo(k1.z) * w3[0] + bfhi(k1.z) * w3[1] + bflo(k1.w) * w3[2] + bfhi(k1.w) * w3[3];
              a = dpp_add<0xB1>(a); a = dpp_add<0x4E>(a);
              if (part == 0) nnew[d0 + dd] = gtot * nold[d0 + dd] + a; }
        }
        qnacc = dpp_add<0xB1>(qnacc); qnacc = dpp_add<0x4E>(qnacc); qnacc = dpp_add<0x141>(qnacc);
        if ((tidv & 7) == 0) qn[tidv >> 3] = qnacc;
#pragma unroll
        for (int x = 0; x < 2; ++x) { const int ti = c.wv * 2 + x, tm = ti >> 2, tn = ti & 3; const int s = tn * 16 + l15; const float bs = bcum[s] - ipr[s];
#pragma unroll
            for (int jj = 0; jj < 4; ++jj) { const int t = tm * 16 + quad * 4 + jj; const float v = (s <= t) ? Sa[x][jj] * __expf(bcum[t] - bs) : 0.f; Sp[t * 72 + s] = f2bf(v); } }
        lds_barrier();
        { const int t = tidv >> 3, part = tidv & 7; const u32x4 sr = *(const LAS u32x4*)(Sp + t * 72 + part * 8);
          float ds = bflo(sr.x) + bfhi(sr.x) + bflo(sr.y) + bfhi(sr.y) + bflo(sr.z) + bfhi(sr.z) + bflo(sr.w) + bfhi(sr.w);
          ds = dpp_add<0xB1>(ds); ds = dpp_add<0x4E>(ds); ds = dpp_add<0x141>(ds);
          if (part == 0) { const float den = ds + gin[t] * qn[t]; rden[t] = 1.0f / fmaxf(fabsf(den), 1.0f); } }
#pragma unroll
        for (int x = 0; x < 2; ++x) { const int ti = c.wv * 2 + x, tm = ti >> 2, tn = ti & 3;
#pragma unroll
            for (int jj = 0; jj < 4; ++jj) Ia[x][jj] *= gin[tm * 16 + quad * 4 + jj];
#pragma unroll
            for (int kk = 0; kk < 2; ++kk) { const bf16x8 a = *(const LAS bf16x8*)(Sp + (tm * 16 + l15) * 72 + kk * 32 + quad * 8);
                const bf16x8 bb = *(const LAS bf16x8*)(VTs + (tn * 16 + l15) * 72 + kk * 32 + quad * 8); Ia[x] = mfma16(a, bb, Ia[x]); } }
        lds_barrier();
#pragma unroll
        for (int x = 0; x < 2; ++x) { const int ti = c.wv * 2 + x, tm = ti >> 2, tn = ti & 3;
#pragma unroll
            for (int jj = 0; jj < 4; ++jj) { const int t = tm * 16 + quad * 4 + jj; HR[(row0 + t) * DMIX + h * 384 + sl * 64 + tn * 16 + l15] = Ia[x][jj] * rden[t]; } }
        if (c.tid < 384) nold[c.tid] = nnew[c.tid];
    }
    lds_barrier();
    if (!save) return;
#pragma unroll
    for (int j = 0; j < 12; ++j)
#pragma unroll
        for (int jj = 0; jj < 4; ++jj) CST[(size_t)(e16 * 16 + quadc * 4 + jj) * 384 + (2 * j + par) * 16 + l15c] = C[j][jj];
    if (c.tid < 384) NST[c.tid] = nold[c.tid];
}

__device__ __forceinline__ void phase_a3(const P& p, const Ctx& c, int seg) {
    const bf16_t* P0 = (const bf16_t*)(c.seg + S0_P0); const float* HR = (const float*)(c.seg + S0_HRAW); const bf16_t* XC = (const bf16_t*)(c.seg + S0_XC);
    const bf16_t* YM = (const bf16_t*)(c.seg + S0_YMEM); bf16_t* Y = (bf16_t*)(c.seg + S0_Y); bf16_t* UT = (bf16_t*)(p.ws + OFF_UTAIL);
#pragma unroll 1
    for (int r = c.bid * 8 + c.wv; r < MS; r += c.G * 8) {
        const int b = r >> 9, tl = r & 511;
        float v[3][8]; float mean[3], rstd[3];
#pragma unroll
        for (int ps = 0; ps < 3; ++ps) { const int ch = ps * 512 + c.lane * 8;
            const f32x4 a0 = *(const f32x4*)(HR + (size_t)r * DMIX + ch), a1 = *(const f32x4*)(HR + (size_t)r * DMIX + ch + 4);
            v[ps][0] = a0[0]; v[ps][1] = a0[1]; v[ps][2] = a0[2]; v[ps][3] = a0[3]; v[ps][4] = a1[0]; v[ps][5] = a1[1]; v[ps][6] = a1[2]; v[ps][7] = a1[3]; }
        float hs[4], hq[4];
#pragma unroll
        for (int hd = 0; hd < 4; ++hd) { float s = 0.f, q = 0.f;
#pragma unroll
            for (int ps = 0; ps < 3; ++ps) { if (ps * 512 + 511 < hd * 384 || ps * 512 >= (hd + 1) * 384) continue;
                const bool mine = ((ps * 512 + c.lane * 8) / 384) == hd;
                float ls = 0.f, lq = 0.f;
#pragma unroll
                for (int j = 0; j < 8; ++j) { ls += v[ps][j]; lq += v[ps][j] * v[ps][j]; }
                s += mine ? ls : 0.f; q += mine ? lq : 0.f; }
            hs[hd] = wsum(s); hq[hd] = wsum(q); }
#pragma unroll
        for (int ps = 0; ps < 3; ++ps) { const int hd = (ps * 512 + c.lane * 8) / 384;
            const float s = hd == 0 ? hs[0] : (hd == 1 ? hs[1] : (hd == 2 ? hs[2] : hs[3])), q = hd == 0 ? hq[0] : (hd == 1 ? hq[1] : (hd == 2 ? hq[2] : hq[3]));
            const float m = s * (1.0f / 384.0f); mean[ps] = m; rstd[ps] = rsqrtf(fmaxf(q * (1.0f / 384.0f) - m * m, 0.f) + 1e-5f); }
#pragma unroll
        for (int ps = 0; ps < 3; ++ps) { const int ch = ps * 512 + c.lane * 8;
            const u32x4 xr = *(const u32x4*)(XC + (size_t)r * DMIX + ch), zr = *(const u32x4*)(P0 + (size_t)r * ML_W + 2048 + ch);
            const f32x4 g0 = *(const f32x4*)(p.ml_mhn_g + ch), g1 = *(const f32x4*)(p.ml_mhn_g + ch + 4), k0 = *(const f32x4*)(p.ml_skip + ch), k1 = *(const f32x4*)(p.ml_skip + ch + 4);
            const float xx[8] = {bflo(xr.x), bfhi(xr.x), bflo(xr.y), bfhi(xr.y), bflo(xr.z), bfhi(xr.z), bflo(xr.w), bfhi(xr.w)};
            const float zz[8] = {bflo(zr.x), bfhi(zr.x), bflo(zr.y), bfhi(zr.y), bflo(zr.z), bfhi(zr.z), bflo(zr.w), bfhi(zr.w)};
            const float gg[8] = {g0[0], g0[1], g0[2], g0[3], g1[0], g1[1], g1[2], g1[3]}, kk[8] = {k0[0], k0[1], k0[2], k0[3], k1[0], k1[1], k1[2], k1[3]};
            float y[8];
#pragma unroll
            for (int j = 0; j < 8; ++j) y[j] = ((v[ps][j] - mean[ps]) * rstd[ps] * gg[j] + kk[j] * xx[j]) * siluf_(zz[j]);
            *(u32x4*)(Y + (size_t)r * DIN + ch) = (u32x4){pk2(y[0], y[1]), pk2(y[2], y[3]), pk2(y[4], y[5]), pk2(y[6], y[7])}; }
        { const int cm = c.lane * 8; const u32x4 mr = *(const u32x4*)(YM + (size_t)r * DX + cm), zr = *(const u32x4*)(P0 + (size_t)r * ML_W + 2048 + DMIX + cm);
          const float mm[8] = {bflo(mr.x), bfhi(mr.x), bflo(mr.y), bfhi(mr.y), bflo(mr.z), bfhi(mr.z), bflo(mr.w), bfhi(mr.w)};
          const float zz[8] = {bflo(zr.x), bfhi(zr.x), bflo(zr.y), bfhi(zr.y), bflo(zr.z), bfhi(zr.z), bflo(zr.w), bfhi(zr.w)};
          float y[8];
#pragma unroll
          for (int j = 0; j < 8; ++j) y[j] = mm[j] * siluf_(zz[j]);
          *(u32x4*)(Y + (size_t)r * DIN + DMIX + cm) = (u32x4){pk2(y[0], y[1]), pk2(y[2], y[3]), pk2(y[4], y[5]), pk2(y[6], y[7])}; }
        if (tl >= 509) {
#pragma unroll
            for (int ps = 0; ps < 3; ++ps) { const int ch = ps * 512 + c.lane * 8; *(u32x4*)(UT + (size_t)(b * 3 + tl - 509) * DMIX + ch) = *(const u32x4*)(P0 + (size_t)r * ML_W + ch); } }
    }
}

__device__ __forceinline__ void phase_b1(const P& p, const Ctx& c, int seg) {
    const bf16_t* P1 = (const bf16_t*)(c.seg + S1_P1);
    float* GTB = (float*)(c.seg + S1_W); bf16_t* SA = (bf16_t*)(c.seg + S1_A); bf16_t* SB = (bf16_t*)(c.seg + S1_B); bf16_t* SK = (bf16_t*)(c.seg + S1_K);
    bf16_t* SQ = (bf16_t*)(c.seg + S1_Q); bf16_t* SV = (bf16_t*)(c.seg + S1_V); bf16_t* SG = (bf16_t*)(c.seg + S1_G); float* BRKR = (float*)(c.seg + S1_BRKR);
    const bf16_t* VF = (const bf16_t*)(p.ws + OFF_VF); const bf16_t* LT = (const bf16_t*)(p.ws + OFF_LORAT);
    const bf16_t* PTr = (const bf16_t*)(p.ws + OFF_PTAIL) + (size_t)(seg & 1) * NB * RW_SHIFT; bf16_t* PTw = (bf16_t*)(p.ws + OFF_PTAIL) + (size_t)((seg + 1) & 1) * NB * RW_SHIFT;
    LAS bf16_t* XA = (LAS bf16_t*)c.lds;
    const int l15 = c.lane & 15, quad = c.lane >> 4;
    for (int it = c.bid; it < MS / 16; it += c.G) {
        const int r0 = it * 16, b = r0 >> 9, tl0 = r0 & 511;
        __syncthreads();
        for (int e = c.tid; e < 16 * 288; e += 512) { const int row = e / 288, cc = e % 288, col = 4608 + cc;
            const float cur = bf2f(P1[(size_t)(r0 + row) * P1W + col]);
            float prev = 0.f; if (tl0 + row > 0) prev = bf2f(P1[(size_t)(r0 + row - 1) * P1W + col]); else if (seg > 0) prev = bf2f(PTr[(size_t)b * RW_SHIFT + col]);
            const float pv = cur + p.rw_mu[col] * (prev - cur);
            const float f = cc < 64 ? tanhf(pv) : (cc < 160 ? pv : sigmoidf_(pv));
            XA[row * 296 + cc] = f2bf(f); }
        __syncthreads();
        bf16x8 xf[9];
#pragma unroll
        for (int k = 0; k < 9; ++k) xf[k] = *(const LAS bf16x8*)(XA + l15 * 296 + k * 32 + quad * 8);
        const size_t row = (size_t)r0 + l15; const int tl = tl0 + l15;
        const bf16_t* curp = P1 + row * P1W; const bf16_t* prevp = (tl > 0) ? (P1 + (row - 1) * P1W) : (PTr + (size_t)b * RW_SHIFT); const bool hasprev = (tl > 0) || (seg > 0);
        struct TileIn { u32x2 cr, ck, cv, pr, pk, pv, vf; };
        struct TilePar { f32x4 m0, m1, m2, w0, a0, v0, kkw, kaw, rk; };
#pragma unroll 1
        for (int x = 0; x < 3; ++x) {
            int hh = c.wv * 3 + x; asm volatile("" : "+s"(hh));
            auto load_tile = [&](int ct, TileIn& T) { const int cc = hh * 64 + ct * 16 + quad * 4;
                T.cr = *(const u32x2*)(curp + cc); T.ck = *(const u32x2*)(curp + DMIX + cc); T.cv = *(const u32x2*)(curp + 2 * DMIX + cc);
                T.pr = (u32x2){0u, 0u}; T.pk = T.pr; T.pv = T.pr;
                if (hasprev) { T.pr = *(const u32x2*)(prevp + cc); T.pk = *(const u32x2*)(prevp + DMIX + cc); T.pv = *(const u32x2*)(prevp + 2 * DMIX + cc); }
                T.vf = *(const u32x2*)(VF + row * DMIX + cc); };
            TileIn TA, TB2;
            load_tile(0, TA);
            float inv;
            { u32x2 kcur[4], kprv[4]; f32x4 km[4], kw[4];
#pragma unroll
              for (int ct = 0; ct < 4; ++ct) { const int cc = hh * 64 + ct * 16 + quad * 4;
                  kcur[ct] = *(const u32x2*)(curp + DMIX + cc); kprv[ct] = (u32x2){0u, 0u}; if (hasprev) kprv[ct] = *(const u32x2*)(prevp + DMIX + cc);
                  km[ct] = *(const f32x4*)(p.rw_mu + DMIX + cc); kw[ct] = *(const f32x4*)(p.rw_k_k + cc); }
              float ss = 0.f;
#pragma unroll
              for (int ct = 0; ct < 4; ++ct) {
                  const float cb[4] = {bflo(kcur[ct].x), bfhi(kcur[ct].x), bflo(kcur[ct].y), bfhi(kcur[ct].y)}, qb[4] = {bflo(kprv[ct].x), bfhi(kprv[ct].x), bflo(kprv[ct].y), bfhi(kprv[ct].y)};
#pragma unroll
                  for (int j = 0; j < 4; ++j) { const float kr = (cb[j] + km[ct][j] * (qb[j] - cb[j])) * kw[ct][j]; ss += kr * kr; } }
              ss += __shfl_xor(ss, 16); ss += __shfl_xor(ss, 32);
              inv = 1.0f / fmaxf(sqrtf(ss), 1e-12f); }
            float br = 0.f, kr = 0.f, rkr = 0.f;
            auto do_tile = [&](int ct, const TileIn& TI) { const int cc = hh * 64 + ct * 16 + quad * 4;
                TilePar T; T.m0 = *(const f32x4*)(p.rw_mu + cc); T.m1 = *(const f32x4*)(p.rw_mu + DMIX + cc); T.m2 = *(const f32x4*)(p.rw_mu + 2 * DMIX + cc);
                T.w0 = *(const f32x4*)(p.rw_w0 + cc); T.a0 = *(const f32x4*)(p.rw_a0 + cc); T.v0 = *(const f32x4*)(p.rw_v0 + cc); T.kkw = *(const f32x4*)(p.rw_k_k + cc); T.kaw = *(const f32x4*)(p.rw_k_a + cc);
                T.rk = *(const f32x4*)(p.rw_r_k + cc);
                bf16x8 lt[9]; { const bf16_t* lrow = LT + (size_t)(hh * 64 + ct * 16 + l15) * 288 + quad * 8;
#pragma unroll
                    for (int k = 0; k < 9; ++k) lt[k] = *(const bf16x8*)(lrow + k * 32); }
                f32x4 dw = (f32x4){0.f, 0.f, 0.f, 0.f}, da = dw, dv = dw, dg = dw;
#pragma unroll
                for (int k = 0; k < 2; ++k) dw = mfma16(lt[k], xf[k], dw);
#pragma unroll
                for (int k = 0; k < 2; ++k) da = mfma16(lt[2 + k], xf[2 + k], da);
                dv = mfma16(lt[4], xf[4], dv);
#pragma unroll
                for (int k = 0; k < 4; ++k) dg = mfma16(lt[5 + k], xf[5 + k], dg);
                const float ca[4] = {bflo(TI.cr.x), bfhi(TI.cr.x), bflo(TI.cr.y), bfhi(TI.cr.y)}, cb[4] = {bflo(TI.ck.x), bfhi(TI.ck.x), bflo(TI.ck.y), bfhi(TI.ck.y)}, cd[4] = {bflo(TI.cv.x), bfhi(TI.cv.x), bflo(TI.cv.y), bfhi(TI.cv.y)};
                const float qa[4] = {bflo(TI.pr.x), bfhi(TI.pr.x), bflo(TI.pr.y), bfhi(TI.pr.y)}, qb[4] = {bflo(TI.pk.x), bfhi(TI.pk.x), bflo(TI.pk.y), bfhi(TI.pk.y)}, qd[4] = {bflo(TI.pv.x), bfhi(TI.pv.x), bflo(TI.pv.y), bfhi(TI.pv.y)};
                const float vf[4] = {bflo(TI.vf.x), bfhi(TI.vf.x), bflo(TI.vf.y), bfhi(TI.vf.y)};
                u32x2 gw; gw.x = pk2(dg[0], dg[1]); gw.y = pk2(dg[2], dg[3]); *(u32x2*)(SG + row * DMIX + cc) = gw;
                float wv4[4], av[4], bv[4], ktv[4], qv[4], vv[4];
#pragma unroll
                for (int j = 0; j < 4; ++j) {
                    const float rc = ca[j] + T.m0[j] * (qa[j] - ca[j]), kc = cb[j] + T.m1[j] * (qb[j] - cb[j]), vc = cd[j] + T.m2[j] * (qd[j] - cd[j]);
                    const float zz = -(T.w0[j] + dw[j]); const float sp = fmaxf(zz, 0.f) + __logf(1.0f + __expf(-fabsf(zz)));
                    wv4[j] = __expf(-__expf(-sp - 0.5f));
                    const float a = sigmoidf_(T.a0[j] + da[j]);
                    vv[j] = vc + (vf[j] - vc) * sigmoidf_(T.v0[j] + dv[j]);
                    const float kk = kc * T.kkw[j] * inv; av[j] = -kk; bv[j] = kk * a;
                    ktv[j] = kc * (1.0f + (a - 1.0f) * T.kaw[j]); qv[j] = rc;
                    br += bv[j] * rc; kr += ktv[j] * rc; rkr += rc * ktv[j] * T.rk[j]; }
                float gfin[4];
#pragma unroll
                for (int j = 0; j < 4; ++j) { float g = wv4[j];
                    g *= dpp_shr_or1<1>(g); g *= dpp_shr_or1<2>(g); g *= dpp_shr_or1<4>(g); g *= dpp_shr_or1<8>(g);
                    const float gp = dpp_shr_or1<1>(g), ig = 1.0f / g;
                    av[j] *= gp; qv[j] *= g; bv[j] *= ig; ktv[j] *= ig; gfin[j] = g; }
                if (l15 == 15) *(f32x4*)(GTB + ((size_t)it * 24 + hh) * 64 + ct * 16 + quad * 4) = (f32x4){gfin[0], gfin[1], gfin[2], gfin[3]};
                u32x2 t; t.x = pk2(av[0], av[1]); t.y = pk2(av[2], av[3]); *(u32x2*)(SA + row * DMIX + cc) = t;
                t.x = pk2(bv[0], bv[1]); t.y = pk2(bv[2], bv[3]); *(u32x2*)(SB + row * DMIX + cc) = t;
                t.x = pk2(ktv[0], ktv[1]); t.y = pk2(ktv[2], ktv[3]); *(u32x2*)(SK + row * DMIX + cc) = t;
                t.x = pk2(qv[0], qv[1]); t.y = pk2(qv[2], qv[3]); *(u32x2*)(SQ + row * DMIX + cc) = t;
                t.x = pk2(vv[0], vv[1]); t.y = pk2(vv[2], vv[3]); *(u32x2*)(SV + row * DMIX + cc) = t; };
            load_tile(1, TB2); do_tile(0, TA); __builtin_amdgcn_sched_barrier(0);
            load_tile(2, TA); do_tile(1, TB2); __builtin_amdgcn_sched_barrier(0);
            load_tile(3, TB2); do_tile(2, TA); __builtin_amdgcn_sched_barrier(0);
            do_tile(3, TB2);
            br += __shfl_xor(br, 16); br += __shfl_xor(br, 32); kr += __shfl_xor(kr, 16); kr += __shfl_xor(kr, 32); rkr += __shfl_xor(rkr, 16); rkr += __shfl_xor(rkr, 32);
            if (quad == 0) *(f32x4*)(BRKR + (row * 24 + hh) * 4) = (f32x4){br, kr, rkr, 0.f};
        }
        if (tl0 == 496) { for (int e = c.tid; e < RW_SHIFT; e += 512) PTw[(size_t)b * RW_SHIFT + e] = P1[(size_t)(r0 + 15) * P1W + e]; }
    }
}

__device__ __forceinline__ void rwkv_item(const P& p, const Ctx& c, int seg, int w, bool save) {
    const int b = w / 24, hh = w % 24;
    const float* SW = (const float*)(c.seg + S1_W); const bf16_t* SA = (const bf16_t*)(c.seg + S1_A); const bf16_t* SB = (const bf16_t*)(c.seg + S1_B); const bf16_t* SK = (const bf16_t*)(c.seg + S1_K);
    const bf16_t* SQ = (const bf16_t*)(c.seg + S1_Q); const bf16_t* SV = (const bf16_t*)(c.seg + S1_V); const float* BRKR = (const float*)(c.seg + S1_BRKR);
    float* O = (float*)(c.seg + S1_O); float* RST = (float*)(p.ws + OFF_RST) + (size_t)w * 4096;
    constexpr int TB = 32, REC = 388;
    LAS float* L0 = (LAS float*)c.lds;
    const int rp = c.wv * 4 + (c.lane >> 4), cq = c.lane & 15;
    f32x2 S0a, S0b, S1a, S1b;
    if (seg > 0) { const f32x4 s0 = *(const f32x4*)(RST + (2 * rp) * 64 + cq * 4), s1 = *(const f32x4*)(RST + (2 * rp + 1) * 64 + cq * 4);
        S0a = (f32x2){s0[0], s0[1]}; S0b = (f32x2){s0[2], s0[3]}; S1a = (f32x2){s1[0], s1[1]}; S1b = (f32x2){s1[2], s1[3]}; }
    else { S0a = S0b = S1a = S1b = (f32x2){0.f, 0.f}; }
    const int e4 = c.tid * 4, stt = e4 >> 6, scc = e4 & 63;
    f32x4 gw; u32x2 ga, gb, gk, gq, gv; f32x4 gbr;
    auto gload = [&](int blk) { const size_t go = ((size_t)b * SEGT + blk * TB + stt) * DMIX + hh * 64 + scc;
        gw = *(const f32x4*)(SW + go); ga = *(const u32x2*)(SA + go); gb = *(const u32x2*)(SB + go); gk = *(const u32x2*)(SK + go); gq = *(const u32x2*)(SQ + go); gv = *(const u32x2*)(SV + go);
        if (c.tid < TB) gbr = *(const f32x4*)(BRKR + (((size_t)b * SEGT + blk * TB + c.tid) * 24 + hh) * 4); };
    auto lstore = [&](int buf) { LAS float* r = L0 + buf * (TB * REC) + stt * REC + scc;
        *(LAS f32x4*)(r) = gw; *(LAS f32x4*)(r + 64) = (f32x4){bflo(ga.x), bfhi(ga.x), bflo(ga.y), bfhi(ga.y)}; *(LAS f32x4*)(r + 128) = (f32x4){bflo(gb.x), bfhi(gb.x), bflo(gb.y), bfhi(gb.y)};
        *(LAS f32x4*)(r + 192) = (f32x4){bflo(gk.x), bfhi(gk.x), bflo(gk.y), bfhi(gk.y)}; *(LAS f32x4*)(r + 256) = (f32x4){bflo(gq.x), bfhi(gq.x), bflo(gq.y), bfhi(gq.y)};
        *(LAS f32x4*)(r + 320) = (f32x4){bflo(gv.x), bfhi(gv.x), bflo(gv.y), bfhi(gv.y)};
        if (c.tid < TB) { LAS float* q = L0 + buf * (TB * REC) + c.tid * REC + 384; *(LAS f32x2*)q = (f32x2){gbr[0], gbr[1]}; } };
    __syncthreads();
    gload(0); lstore(0);
    __syncthreads();
#pragma unroll 1
    for (int blk = 0; blk < SEGT / TB; ++blk) {
        const int buf = blk & 1;
        if (blk + 1 < SEGT / TB) gload(blk + 1);
        const LAS float* base = L0 + buf * (TB * REC);
        const size_t rowb = (size_t)b * SEGT + blk * TB;
        f32x4 nw4 = *(const LAS f32x4*)(base + cq * 4), na4 = *(const LAS f32x4*)(base + 64 + cq * 4), nb4 = *(const LAS f32x4*)(base + 128 + cq * 4), nk4 = *(const LAS f32x4*)(base + 192 + cq * 4), nq4 = *(const LAS f32x4*)(base + 256 + cq * 4);
        f32x2 nv2 = *(const LAS f32x2*)(base + 320 + 2 * rp), nbk = *(const LAS f32x2*)(base + 384);
#pragma unroll 2
        for (int tt = 0; tt < TB; ++tt) {
            const f32x4 w4 = nw4, a4 = na4, b4 = nb4, k4 = nk4, q4 = nq4; const f32x2 v2 = nv2, bk = nbk;
            { const LAS float* r = base + (tt + 1 < TB ? tt + 1 : tt) * REC;
              nw4 = *(const LAS f32x4*)(r + cq * 4); na4 = *(const LAS f32x4*)(r + 64 + cq * 4); nb4 = *(const LAS f32x4*)(r + 128 + cq * 4); nk4 = *(const LAS f32x4*)(r + 192 + cq * 4); nq4 = *(const LAS f32x4*)(r + 256 + cq * 4);
              nv2 = *(const LAS f32x2*)(r + 320 + 2 * rp); nbk = *(const LAS f32x2*)(r + 384); }
            const f32x2 wa = (f32x2){w4[0], w4[1]}, wb = (f32x2){w4[2], w4[3]}, aa = (f32x2){a4[0], a4[1]}, ab = (f32x2){a4[2], a4[3]}, ba = (f32x2){b4[0], b4[1]}, bb = (f32x2){b4[2], b4[3]};
            const f32x2 ka = (f32x2){k4[0], k4[1]}, kb = (f32x2){k4[2], k4[3]}, qa = (f32x2){q4[0], q4[1]}, qb = (f32x2){q4[2], q4[3]};
            f32x2 t0 = S0a * aa + S0b * ab, t1 = S0a * qa + S0b * qb, t2 = S1a * aa + S1b * ab, t3 = S1a * qa + S1b * qb;
            float pa0 = t0.x + t0.y, pt0 = t1.x + t1.y, pa1 = t2.x + t2.y, pt1 = t3.x + t3.y;
            row16_allsum4(pa0, pa1, pt0, pt1);
            const f32x2 pa0v = (f32x2){pa0, pa0}, pa1v = (f32x2){pa1, pa1}, v0v = (f32x2){v2.x, v2.x}, v1v = (f32x2){v2.y, v2.y};
            S0a = S0a * wa + pa0v * ba + v0v * ka; S0b = S0b * wb + pa0v * bb + v0v * kb;
            S1a = S1a * wa + pa1v * ba + v1v * ka; S1b = S1b * wb + pa1v * bb + v1v * kb;
            if (cq == 0) { const f32x2 y = (f32x2){pt0 + pa0 * bk.x + v2.x * bk.y, pt1 + pa1 * bk.x + v2.y * bk.y};
                *(f32x2*)(O + (rowb + tt) * DMIX + hh * 64 + 2 * rp) = y; }
        }
        if (blk + 1 < SEGT / TB) lstore(buf ^ 1);
        __syncthreads();
    }
    if (!save) return;
    *(f32x4*)(RST + (2 * rp) * 64 + cq * 4) = (f32x4){S0a.x, S0a.y, S0b.x, S0b.y}; *(f32x4*)(RST + (2 * rp + 1) * 64 + cq * 4) = (f32x4){S1a.x, S1a.y, S1b.x, S1b.y};
}

__device__ __forceinline__ void rwkv_chunk_item(const P& p, const Ctx& c, int seg, int w, bool save) {
    const int b = w / 24, hh = w % 24;
    const bf16_t* SA = (const bf16_t*)(c.seg + S1_A); const bf16_t* SB = (const bf16_t*)(c.seg + S1_B); const bf16_t* SK = (const bf16_t*)(c.seg + S1_K);
    const bf16_t* SR = (const bf16_t*)(c.seg + S1_Q); const bf16_t* SV = (const bf16_t*)(c.seg + S1_V); const float* GTB = (const float*)(c.seg + S1_W);
    float* O = (float*)(c.seg + S1_O); float* RST = (float*)(p.ws + OFF_RST) + (size_t)w * 4096;
    constexpr int O_EA = 0  , O_EB = 4608  , O_EBT = 9216  , O_UV = 14336  ,
                  O_MT1 = 19456  , O_NT = 20736  , O_MABT = 22016  ,
                  O_GT = 23296  , OPB = 23552;
    LAS unsigned char* OB = c.lds;
    LAS bf16_t* S0I = (LAS bf16_t*)(c.lds + 2 * OPB);
    LAS float* XF = (LAS float*)(c.lds + 2 * OPB + 9216);
    const int l15c = c.lane & 15, quadc = c.lane >> 4;
    f32x4 S[2];
#pragma unroll
    for (int x = 0; x < 2; ++x) { const int ti = c.wv * 2 + x, mt = ti >> 2, nt = ti & 3;
#pragma unroll
        for (int jj = 0; jj < 4; ++jj) S[x][jj] = (seg > 0) ? RST[(mt * 16 + quadc * 4 + jj) * 64 + nt * 16 + l15c] : 0.f; }
    unsigned ga = 0, gb = 0, gk = 0, gr = 0, gv = 0; float gg = 1.f;
    auto gload = [&](int ch, int tidv) { const int t = tidv >> 5, j0 = (tidv & 31) * 2; const size_t go = ((size_t)b * SEGT + ch * 16 + t) * DMIX + hh * 64 + j0;
        ga = *(const unsigned*)(SA + go); gb = *(const unsigned*)(SB + go); gk = *(const unsigned*)(SK + go); gr = *(const unsigned*)(SR + go); gv = *(const unsigned*)(SV + go);
        if (tidv < 64) gg = GTB[((size_t)(b * 32 + ch) * 24 + hh) * 64 + tidv]; };
    auto lstore = [&](int pb, int tidv) { const int t = tidv >> 5, j0 = (tidv & 31) * 2;
        LAS bf16_t* EA = (LAS bf16_t*)(OB + pb * OPB + O_EA); LAS bf16_t* EB = (LAS bf16_t*)(OB + pb * OPB + O_EB); LAS bf16_t* EBT = (LAS bf16_t*)(OB + pb * OPB + O_EBT);
        LAS bf16_t* UV = (LAS bf16_t*)(OB + pb * OPB + O_UV); LAS float* GT = (LAS float*)(OB + pb * OPB + O_GT);
        *(LAS unsigned*)(EA + t * 72 + j0) = ga; *(LAS unsigned*)(EA + (16 + t) * 72 + j0) = gr;
        *(LAS unsigned*)(EB + t * 72 + j0) = gb; *(LAS unsigned*)(EB + (16 + t) * 72 + j0) = gk;
        EBT[j0 * 40 + t] = (bf16_t)(gb & 0xFFFFu); EBT[(j0 + 1) * 40 + t] = (bf16_t)(gb >> 16); EBT[j0 * 40 + 16 + t] = (bf16_t)(gk & 0xFFFFu); EBT[(j0 + 1) * 40 + 16 + t] = (bf16_t)(gk >> 16);
        UV[j0 * 40 + 16 + t] = (bf16_t)(gv & 0xFFFFu); UV[(j0 + 1) * 40 + 16 + t] = (bf16_t)(gv >> 16); UV[j0 * 40 + t] = 0; UV[(j0 + 1) * 40 + t] = 0;
        if (tidv < 64) GT[tidv] = gg; };
    auto gtile = [&](int pb, int l15, int quad) {
        LAS bf16_t* EA = (LAS bf16_t*)(OB + pb * OPB + O_EA); LAS bf16_t* EB = (LAS bf16_t*)(OB + pb * OPB + O_EB);
        LAS bf16_t* MT1 = (LAS bf16_t*)(OB + pb * OPB + O_MT1); LAS bf16_t* NT = (LAS bf16_t*)(OB + pb * OPB + O_NT); LAS float* MABT = (LAS float*)(OB + pb * OPB + O_MABT);
        const int sb = c.wv >> 1, tb = c.wv & 1; f32x4 g = (f32x4){0.f, 0.f, 0.f, 0.f};
#pragma unroll
        for (int kk = 0; kk < 2; ++kk) g = mfma16(*(const LAS bf16x8*)(EB + (sb * 16 + l15) * 72 + kk * 32 + quad * 8), *(const LAS bf16x8*)(EA + (tb * 16 + l15) * 72 + kk * 32 + quad * 8), g);
#pragma unroll
        for (int jj = 0; jj < 4; ++jj) { const int s2 = quad * 4 + jj, tt = l15; const float v = g[jj];
            if (tb == 0) { const float m = (s2 < tt) ? v : 0.f; if (sb == 0) { MABT[tt * 20 + s2] = m; MT1[tt * 40 + s2] = 0; } else MT1[tt * 40 + 16 + s2] = f2bf(m); }
            else { const float m = (s2 <= tt) ? v : 0.f; NT[tt * 40 + sb * 16 + s2] = f2bf(m); } } };
    auto simg = [&](int l15, int quad) {
#pragma unroll
        for (int x = 0; x < 2; ++x) { const int ti = c.wv * 2 + x, mt = ti >> 2, nt = ti & 3;
#pragma unroll
            for (int jj = 0; jj < 4; ++jj) S0I[(mt * 16 + quad * 4 + jj) * 72 + nt * 16 + l15] = f2bf(S[x][jj]); } };
    __syncthreads();
    { int t0 = c.tid; asm volatile("" : "+v"(t0)); gload(0, t0); lstore(0, t0); simg(l15c, quadc); }
    lds_barrier();
    if (c.wv < 4) gtile(0, l15c, quadc);
    { int t1 = c.tid; asm volatile("" : "+v"(t1)); gload(1, t1); }
    const int mtq = c.wv & 3;
#pragma unroll 1
    for (int ch = 0; ch < SEGT / 16; ++ch) {
        const int pb = ch & 1;
        int tidv = c.tid, l15 = l15c, quad = quadc; asm volatile("" : "+v"(tidv), "+v"(l15), "+v"(quad));
        LAS bf16_t* EA = (LAS bf16_t*)(OB + pb * OPB + O_EA); LAS bf16_t* EBT = (LAS bf16_t*)(OB + pb * OPB + O_EBT); LAS bf16_t* UV = (LAS bf16_t*)(OB + pb * OPB + O_UV);
        LAS bf16_t* MT1 = (LAS bf16_t*)(OB + pb * OPB + O_MT1); LAS bf16_t* NT = (LAS bf16_t*)(OB + pb * OPB + O_NT); LAS float* MABT = (LAS float*)(OB + pb * OPB + O_MABT); LAS float* GT = (LAS float*)(OB + pb * OPB + O_GT);
        lds_barrier();
        f32x4 Zt = (f32x4){0.f, 0.f, 0.f, 0.f};
        if (c.wv >= 4) {
            f32x4 Xt = (f32x4){0.f, 0.f, 0.f, 0.f};
#pragma unroll
            for (int kk = 0; kk < 2; ++kk) { const bf16x8 a = *(const LAS bf16x8*)(S0I + (mtq * 16 + l15) * 72 + kk * 32 + quad * 8);
                Xt = mfma16(a, *(const LAS bf16x8*)(EA + l15 * 72 + kk * 32 + quad * 8), Xt); Zt = mfma16(a, *(const LAS bf16x8*)(EA + (16 + l15) * 72 + kk * 32 + quad * 8), Zt); }
            Xt = mfma16(*(const LAS bf16x8*)(UV + (mtq * 16 + l15) * 40 + quad * 8), *(const LAS bf16x8*)(MT1 + l15 * 40 + quad * 8), Xt);
#pragma unroll
            for (int jj = 0; jj < 4; ++jj) XF[(mtq * 16 + quad * 4 + jj) * 17 + l15] = Xt[jj];
        }
        lds_barrier();
        if (ch + 1 < SEGT / 16) lstore(pb ^ 1, tidv);
        if (ch + 2 < SEGT / 16) gload(ch + 2, tidv);
        if (c.wv == 0) {
            float u[16];
#pragma unroll
            for (int tt = 0; tt < 16; ++tt) { float acc = XF[c.lane * 17 + tt];
#pragma unroll
                for (int s4 = 0; s4 < (tt + 3) / 4; ++s4) { const f32x4 m = *(const LAS f32x4*)(MABT + tt * 20 + s4 * 4);
#pragma unroll
                    for (int e = 0; e < 4; ++e) if (s4 * 4 + e < tt) acc += u[s4 * 4 + e] * m[e]; }
                u[tt] = acc; }
            *(LAS u32x4*)(UV + c.lane * 40) = (u32x4){pk2(u[0], u[1]), pk2(u[2], u[3]), pk2(u[4], u[5]), pk2(u[6], u[7])};
            *(LAS u32x4*)(UV + c.lane * 40 + 8) = (u32x4){pk2(u[8], u[9]), pk2(u[10], u[11]), pk2(u[12], u[13]), pk2(u[14], u[15])};
        }
        lds_barrier();
        if (c.wv >= 4) {
            Zt = mfma16(*(const LAS bf16x8*)(UV + (mtq * 16 + l15) * 40 + quad * 8), *(const LAS bf16x8*)(NT + l15 * 40 + quad * 8), Zt);
            *(f32x4*)(O + ((size_t)b * SEGT + ch * 16 + l15) * DMIX + hh * 64 + mtq * 16 + quad * 4) = Zt;
        }
#pragma unroll
        for (int x = 0; x < 2; ++x) { const int ti = c.wv * 2 + x, mt = ti >> 2, nt = ti & 3;
            S[x] = mfma16(*(const LAS bf16x8*)(UV + (mt * 16 + l15) * 40 + quad * 8), *(const LAS bf16x8*)(EBT + (nt * 16 + l15) * 40 + quad * 8), S[x]);
            const float gt = GT[nt * 16 + l15];
#pragma unroll
            for (int jj = 0; jj < 4; ++jj) S[x][jj] *= gt; }
        simg(l15, quad);
        if (c.wv < 4 && ch + 1 < SEGT / 16) gtile(pb ^ 1, l15, quad);
    }
    if (!save) return;
#pragma unroll
    for (int x = 0; x < 2; ++x) { const int ti = c.wv * 2 + x, mt = ti >> 2, nt = ti & 3;
#pragma unroll
        for (int jj = 0; jj < 4; ++jj) RST[(mt * 16 + quadc * 4 + jj) * 64 + nt * 16 + l15c] = S[x][jj]; }
}

__device__ __forceinline__ void phase_b3(const P& p, const Ctx& c) {
    const float* O = (const float*)(c.seg + S1_O); const bf16_t* P2 = (const bf16_t*)(c.seg + S1_P2); const bf16_t* SV = (const bf16_t*)(c.seg + S1_V); const bf16_t* SG = (const bf16_t*)(c.seg + S1_G);
    const float* BRKR = (const float*)(c.seg + S1_BRKR); const bf16_t* YM = (const bf16_t*)(c.seg + S1_YMEM); bf16_t* Y = (bf16_t*)(c.seg + S1_Y);
    for (int r = c.bid * 8 + c.wv; r < MS; r += c.G * 8) {
#pragma unroll
        for (int ps = 0; ps < 3; ++ps) {
            const int hh = ps * 8 + (c.lane >> 3), ch = hh * 64 + (c.lane & 7) * 8;
            const f32x4 o0 = *(const f32x4*)(O + (size_t)r * DMIX + ch), o1 = *(const f32x4*)(O + (size_t)r * DMIX + ch + 4);
            float v[8] = {o0[0], o0[1], o0[2], o0[3], o1[0], o1[1], o1[2], o1[3]}; float s = 0.f, s2 = 0.f;
#pragma unroll
            for (int j = 0; j < 8; ++j) { s += v[j]; s2 += v[j] * v[j]; }
            s += __shfl_xor(s, 1); s2 += __shfl_xor(s2, 1); s += __shfl_xor(s, 2); s2 += __shfl_xor(s2, 2); s += __shfl_xor(s, 4); s2 += __shfl_xor(s2, 4);
            const float mean = s * (1.0f / 64.0f), var = fmaxf(s2 * (1.0f / 64.0f) - mean * mean, 0.f), rs = rsqrtf(var + 64e-5f);
            const float rkr = BRKR[((size_t)r * 24 + hh) * 4 + 2];
            const u32x4 vr = *(const u32x4*)(SV + (size_t)r * DMIX + ch), gr = *(const u32x4*)(SG + (size_t)r * DMIX + ch), zr = *(const u32x4*)(P2 + (size_t)r * P2W + 512 + ch);
            const float vv[8] = {bflo(vr.x), bfhi(vr.x), bflo(vr.y), bfhi(vr.y), bflo(vr.z), bfhi(vr.z), bflo(vr.w), bfhi(vr.w)};
            const float gg[8] = {bflo(gr.x), bfhi(gr.x), bflo(gr.y), bfhi(gr.y), bflo(gr.z), bfhi(gr.z), bflo(gr.w), bfhi(gr.w)};
            const float zz[8] = {bflo(zr.x), bfhi(zr.x), bflo(zr.y), bfhi(zr.y), bflo(zr.z), bfhi(zr.z), bflo(zr.w), bfhi(zr.w)};
            float y[8];
#pragma unroll
            for (int j = 0; j < 8; ++j) { const float t = ((v[j] - mean) * rs * p.rw_lnx_g[ch + j] + p.rw_lnx_b[ch + j] + rkr * vv[j]) * gg[j]; y[j] = t * siluf_(zz[j]); }
            *(u32x4*)(Y + (size_t)r * DIN + ch) = (u32x4){pk2(y[0], y[1]), pk2(y[2], y[3]), pk2(y[4], y[5]), pk2(y[6], y[7])};
        }
        { const int cm = c.lane * 8; const u32x4 mr = *(const u32x4*)(YM + (size_t)r * DX + cm), zr = *(const u32x4*)(P2 + (size_t)r * P2W + 512 + DMIX + cm);
          const float mm[8] = {bflo(mr.x), bfhi(mr.x), bflo(mr.y), bfhi(mr.y), bflo(mr.z), bfhi(mr.z), bflo(mr.w), bfhi(mr.w)};
          const float zz[8] = {bflo(zr.x), bfhi(zr.x), bflo(zr.y), bfhi(zr.y), bflo(zr.z), bfhi(zr.z), bflo(zr.w), bfhi(zr.w)};
          float y[8];
#pragma unroll
          for (int j = 0; j < 8; ++j) y[j] = mm[j] * siluf_(zz[j]);
          *(u32x4*)(Y + (size_t)r * DIN + DMIX + cm) = (u32x4){pk2(y[0], y[1]), pk2(y[2], y[3]), pk2(y[4], y[5]), pk2(y[6], y[7])}; }
    }
}

__device__ __forceinline__ bool fresh_ctx(Ctx& c, P& p, unsigned char* ws0) { int t = threadIdx.x; asm volatile("" : "+v"(t)); c.tid = t; c.wv = __builtin_amdgcn_readfirstlane(t >> 6); c.lane = t & 63;
    int bb = (int)blockIdx.x, gg = (int)gridDim.x; asm volatile("" : "+s"(bb), "+s"(gg)); c.bid = bb; c.G = gg;
#if defined(__HIP_DEVICE_COMPILE__)
    { typedef const __attribute__((address_space(4))) unsigned long long* KP; KP kp = (KP)__builtin_amdgcn_kernarg_segment_ptr(); asm volatile("" : "+s"(kp));
      typedef __attribute__((address_space(1))) char* GP; char** dst = (char**)&p;
#pragma unroll
      for (int i = 0; i < (int)(sizeof(P) / 8); ++i) dst[i] = (char*)(GP)(kp[i]); }
#endif
    size_t z = 0; asm volatile("" : "+s"(z)); p.ws = ws0 + z; c.seg = ws0 + z + OFF_SEG;
    return true; }
__global__ __launch_bounds__(512) void fwd_megakernel(P p_arg) {
    P p = p_arg;
    extern __shared__ __attribute__((aligned(16))) unsigned char shm[];
    LAS unsigned char* lds = (LAS unsigned char*)shm;
    Ctx c; c.tid = threadIdx.x; c.wv = threadIdx.x >> 6; c.lane = threadIdx.x & 63; c.G = gridDim.x; c.bid = blockIdx.x; c.lds = lds; c.seg = p.ws + OFF_SEG;
    volatile LAS unsigned* st = (volatile LAS unsigned*)(lds + LDS_BYTES - 16);
    if (c.tid == 0) { st[0] = 0u; st[1] = 0u; }
    __syncthreads();
    const XcdBarrier xb = xcd_barrier_post((unsigned*)(p.ws + OFF_BAR), st);
#define GSYNC() do { XcdBarrier _xl = xb; size_t _zz = 0; asm volatile("" : "+s"(_zz)); _xl.bar = xb.bar + _zz; _xl.x = xb_xcc_id();     \
        xcd_barrier(_xl); if (RK == 20) { for (int _q = 1; _q < RN; ++_q) xcd_barrier(_xl); } } while (0)
#ifndef RK
#define RK -1
#endif
#ifndef RN
#define RN 1
#endif
#define NREP(k) ((k) == RK ? RN : 1)
#define PH(k) for (int _r = 0; _r < NREP(k); ++_r) if (fresh_ctx(c, p, p_arg.ws))
#define LASTREP(k) (_r + 1 == NREP(k))
    PH(0) phase0(p, c);
    PH(1) phase_apre(p, c, 0, c.bid, c.G);
    GSYNC();
    for (int seg = 0; seg < NSEG; ++seg) {
        PH(2) { SchedA0 S; S.ws = p.ws; S.seg = c.seg; S.G = c.G; S.c = c.bid; S.nextra = (seg == 0) ? 64 : 0;
          pg8::gemm_phase<pg8::EpiBf, SchedA0>(lds, c.tid, 1024, 1024, S, pg8::EpiBf{}); }
        GSYNC();
        PH(3) phase_a1(p, c, seg);
        GSYNC();
        for (int it0 = c.bid; it0 < 256; it0 += c.G) {
            const int xq = it0 & 7, yq = it0 >> 3; const int it = (yq < 24) ? ((xq * 4 + yq / 6) * 6 + yq % 6) : (192 + (yq - 24) * 8 + xq);
            if (it < 192) { PH(4) mlstm_item(p, c, seg, it, LASTREP(4)); }
            else { PH(5) attn_item(p, c, 0, it - 192, (const bf16_t*)(c.seg + S0_P0) + DMIX, ML_W, (bf16_t*)(c.seg + S0_YMEM)); }
        }
        GSYNC();
        PH(6) phase_a3(p, c, seg);
        GSYNC();
        PH(7) { SchedOut S; S.Y = (const char*)(c.seg + S0_Y); S.W = (const char*)(p.ws + OFF_WO0T); S.slab = (char*)(c.seg + S0_SLAB); S.G = c.G; S.c = c.bid;
          pg8::gemm_phase<pg8::EpiBf, SchedOut>(lds, c.tid, DIN, 512, S, pg8::EpiBf{}); }
        GSYNC();
        PH(8) phase_a5(p, c, seg);
        GSYNC();
        PH(9) { SchedB0 S; S.ws = p.ws; S.seg = c.seg; S.G = c.G; S.c = c.bid;
          pg8::gemm_phase<pg8::EpiBf, SchedB0>(lds, c.tid, 1024, 1024, S, pg8::EpiBf{}); }
        GSYNC();
        PH(10) phase_b1(p, c, seg);
        GSYNC();
        for (int it = c.bid; it < 256; it += c.G) {
            if (it < 192) { PH(11) rwkv_chunk_item(p, c, seg, it, LASTREP(11)); }
            else { PH(5) attn_item(p, c, 1, it - 192, (const bf16_t*)(c.seg + S1_P2), P2W, (bf16_t*)(c.seg + S1_YMEM));
                   if (c.G == 256) { PH(1) if (seg + 1 < NSEG) phase_apre(p, c, seg + 1, it - 192, 64); } }
        }
        GSYNC();
        PH(12) phase_b3(p, c);
        GSYNC();
        PH(13) { SchedOut S; S.Y = (const char*)(c.seg + S1_Y); S.W = (const char*)(p.ws + OFF_WO1T); S.slab = (char*)(c.seg + S1_SLAB); S.G = c.G; S.c = c.bid;
          pg8::gemm_phase<pg8::EpiBf, SchedOut>(lds, c.tid, DIN, 512, S, pg8::EpiBf{}); }
        GSYNC();
        PH(14) phase_b5(p, c, seg);
        if (c.G != 256) { PH(1) if (seg + 1 < NSEG) phase_apre(p, c, seg + 1, c.bid, c.G); GSYNC(); }
    }
}

extern "C" void kernel_launch(void* const* d_in, const int* in_sizes, int n_in, void* d_out, int out_size, void* d_ws, size_t ws_size, hipStream_t stream) {
    static int grid = 0;
    if (grid == 0) {
        int dev = 0, cus = 0, per_cu = 0;
        if (hipGetDevice(&dev) != hipSuccess || hipDeviceGetAttribute(&cus, hipDeviceAttributeMultiprocessorCount, dev) != hipSuccess) { grid = -1; return; }
        if (hipFuncSetAttribute((const void*)fwd_megakernel, hipFuncAttributeMaxDynamicSharedMemorySize, LDS_BYTES) != hipSuccess) { fprintf(stderr, "hipFuncSetAttribute failed\n"); grid = -1; return; }
        if (hipOccupancyMaxActiveBlocksPerMultiprocessor(&per_cu, (const void*)fwd_megakernel, 512, LDS_BYTES) != hipSuccess || per_cu < 1) { fprintf(stderr, "occupancy query: %d\n", per_cu); }
        (void)hipGetLastError();
        grid = cus;
        if (n_in != 31 || ws_size < 256 * MiB) { fprintf(stderr, "unexpected n_in %d / ws %zu\n", n_in, ws_size); grid = -1; return; }
    }
    if (grid < 0) return;
    (void)hipMemsetAsync((char*)d_ws + OFF_BAR, 0, XCD_BAR_WORDS * 4, stream);
    P p{};
    const float** f = (const float**)&p;
    for (int i = 0; i < 31; ++i) f[i] = (const float*)d_in[i];
    p.out = (float*)d_out; p.ws = (unsigned char*)d_ws;
    fwd_megakernel<<<dim3(grid), dim3(512), LDS_BYTES, stream>>>(p);
}
```

```cpp
#include <hip/hip_runtime.h>
#include <cstdio>
#include <cstdint>

#define LAS __attribute__((address_space(3)))
typedef unsigned short bf16_t;
typedef short bf16x8 __attribute__((ext_vector_type(8)));
typedef short bf16x4 __attribute__((ext_vector_type(4)));
typedef float f32x4 __attribute__((ext_vector_type(4)));
typedef float f32x2 __attribute__((ext_vector_type(2)));
typedef unsigned u32x4 __attribute__((ext_vector_type(4)));
typedef unsigned u32x2 __attribute__((ext_vector_type(2)));

constexpr int NB = 8, SEQ = 2048, DM = 1024, NSEG = 4, SEGT = 512, MS = NB * SEGT;
constexpr int DMIX = 1536, DX = 512, DIN = 2048;
constexpr int ML_W = 4096, RW_SHIFT = 4896, RW_W = 7456;
constexpr int P1W = 5120, P2W = 2560;
constexpr size_t MiB = 1u << 20;
constexpr size_t OFF_WT0 = 0, OFF_WT1 = 8 * MiB, OFF_WO0T = 23 * MiB, OFF_WO1T = 27 * MiB, OFF_WKVT = 31 * MiB  ,
                 OFF_KMEM = 35 * MiB  , OFF_LORAT = 43 * MiB, OFF_MISC = 45 * MiB,
                 OFF_CST = 46 * MiB, OFF_NST = 65 * MiB, OFF_RST = 65 * MiB + 512 * 1024, OFF_H = 69 * MiB, OFF_VF = 77 * MiB,
                 OFF_SEG = 89 * MiB, OFF_MEMN = 248 * MiB;
constexpr size_t OFF_BAR = OFF_MISC, OFF_UTAIL = OFF_MISC + 64 * 1024, OFF_PTAIL = OFF_MISC + 256 * 1024;
constexpr size_t S0_P0 = 0, S0_Q = 32 * MiB, S0_K = 44 * MiB, S0_KT = 56 * MiB, S0_VT = 68 * MiB, S0_XC = 80 * MiB, S0_HRAW = 92 * MiB,
                 S0_YMEM = 116 * MiB, S0_Y = 120 * MiB, S0_GATE = 136 * MiB;
constexpr size_t S1_P1 = 0, S1_O = 0, S1_Y = 24 * MiB, S1_P2 = 40 * MiB, S1_W = 60 * MiB, S1_A = 84 * MiB, S1_B = 96 * MiB, S1_K = 108 * MiB,
                 S1_Q = 120 * MiB, S1_V = 132 * MiB, S1_G = 144 * MiB, S1_YMEM = 156 * MiB, S1_BRKR = 160 * MiB;
constexpr size_t S0_SLAB = 0  , S1_SLAB = 84 * MiB  ;
constexpr int LDS_BYTES = 150 * 1024;

struct P {
    const float *x, *mem, *norm_g, *mem_norm_g, *mem_kv_w, *w_out, *ml_w_in, *ml_conv_w, *ml_conv_b, *ml_wq, *ml_wk, *ml_wv, *ml_w_gate, *ml_b_gate,
        *ml_mhn_g, *ml_skip, *rw_w_in, *rw_mu, *rw_w_lora2, *rw_w0, *rw_a_lora2, *rw_a0, *rw_v_lora2, *rw_v0, *rw_g_lora2, *rw_k_k, *rw_k_a, *rw_r_k,
        *rw_lnx_g, *rw_lnx_b, *final_g;
    float* out; unsigned char* ws;
};

__device__ __forceinline__ bf16_t f2bf(float f) { unsigned u = __float_as_uint(f); u += 0x7FFFu + ((u >> 16) & 1u); return (bf16_t)(u >> 16); }
__device__ __forceinline__ float bf2f(bf16_t b) { return __uint_as_float(((unsigned)b) << 16); }
__device__ __forceinline__ unsigned pk2(float lo, float hi) { return (unsigned)f2bf(lo) | ((unsigned)f2bf(hi) << 16); }
__device__ __forceinline__ float bflo(unsigned u) { return __uint_as_float(u << 16); }
__device__ __forceinline__ float bfhi(unsigned u) { return __uint_as_float(u & 0xFFFF0000u); }
__device__ __forceinline__ float wsum(float v) {
#pragma unroll
    for (int o = 32; o >= 1; o >>= 1) v += __shfl_xor(v, o);
    return v;
}
__device__ __forceinline__ float sigmoidf_(float x) { return 1.0f / (1.0f + __expf(-x)); }
__device__ __forceinline__ float siluf_(float x) { return x / (1.0f + __expf(-x)); }
__device__ __forceinline__ float softplusf_(float z) { return fmaxf(z, 0.f) + log1pf(__expf(-fabsf(z))); }
template <int CTRL> __device__ __forceinline__ float dpp_add(float v) {
    return v + __int_as_float(__builtin_amdgcn_update_dpp(0, __float_as_int(v), CTRL, 0xF, 0xF, true));
}
__device__ __forceinline__ float row16_allsum(float v) {
    v = dpp_add<0xB1>(v);
    v = dpp_add<0x4E>(v);
    v = dpp_add<0x141>(v);
    v = dpp_add<0x140>(v);
    return v;
}
__device__ __forceinline__ void row16_allsum4(float& a, float& b, float& c, float& d) {
    asm volatile("s_nop 1\n\t"
        "v_add_f32_dpp %0, %0, %0 quad_perm:[1,0,3,2] row_mask:0xf bank_mask:0xf\n\t" "v_add_f32_dpp %1, %1, %1 quad_perm:[1,0,3,2] row_mask:0xf bank_mask:0xf\n\t"
        "v_add_f32_dpp %2, %2, %2 quad_perm:[1,0,3,2] row_mask:0xf bank_mask:0xf\n\t" "v_add_f32_dpp %3, %3, %3 quad_perm:[1,0,3,2] row_mask:0xf bank_mask:0xf\n\t"
        "v_add_f32_dpp %0, %0, %0 quad_perm:[2,3,0,1] row_mask:0xf bank_mask:0xf\n\t" "v_add_f32_dpp %1, %1, %1 quad_perm:[2,3,0,1] row_mask:0xf bank_mask:0xf\n\t"
        "v_add_f32_dpp %2, %2, %2 quad_perm:[2,3,0,1] row_mask:0xf bank_mask:0xf\n\t" "v_add_f32_dpp %3, %3, %3 quad_perm:[2,3,0,1] row_mask:0xf bank_mask:0xf\n\t"
        "v_add_f32_dpp %0, %0, %0 row_half_mirror row_mask:0xf bank_mask:0xf\n\t" "v_add_f32_dpp %1, %1, %1 row_half_mirror row_mask:0xf bank_mask:0xf\n\t"
        "v_add_f32_dpp %2, %2, %2 row_half_mirror row_mask:0xf bank_mask:0xf\n\t" "v_add_f32_dpp %3, %3, %3 row_half_mirror row_mask:0xf bank_mask:0xf\n\t"
        "v_add_f32_dpp %0, %0, %0 row_mirror row_mask:0xf bank_mask:0xf\n\t" "v_add_f32_dpp %1, %1, %1 row_mirror row_mask:0xf bank_mask:0xf\n\t"
        "v_add_f32_dpp %2, %2, %2 row_mirror row_mask:0xf bank_mask:0xf\n\t" "v_add_f32_dpp %3, %3, %3 row_mirror row_mask:0xf bank_mask:0xf\n\t"
        "s_nop 1"
        : "+v"(a), "+v"(b), "+v"(c), "+v"(d));
}
template <int N> __device__ __forceinline__ float dpp_shr_or1(float v) {
    return __int_as_float(__builtin_amdgcn_update_dpp(0x3f800000, __float_as_int(v), 0x110 + N, 0xF, 0xF, false));
}
__device__ __forceinline__ f32x4 mfma16(bf16x8 a, bf16x8 b, f32x4 c) { return __builtin_amdgcn_mfma_f32_16x16x32_bf16(a, b, c, 0, 0, 0); }

namespace pg8 {
constexpr int BM = 256, BK = 64, HALF = 128, HTB = HALF * BK * 2, STAGE_BYTES = 8 * HTB, NXCD = 8, WGM = 8;
__host__ __device__ __forceinline__ int lds_byte(int r, int c) { const int st = (r >> 4) * 2 + (c >> 5), rr = r & 15, cc = c & 31, ob = rr * 64 + cc * 2; return st * 1024 + (ob ^ (((ob >> 9) & 1) << 5)); }
__host__ __device__ __forceinline__ void stage_rc(int b, int& R, int& C) { const int st = b / 1024, sb = b % 1024, swz = sb ^ (((sb >> 9) & 1) << 5); R = (st >> 1) * 16 + swz / 64; C = (st & 1) * 32 + (swz % 64) / 2; }
__host__ __device__ __forceinline__ int perm32(int rho) { const int n = rho >> 4, i = rho & 15; return 8 * (i >> 2) + 4 * n + (i & 3); }

struct Unit { const char* A; const char* B; char* O; int ldc; int pad; };

__device__ __forceinline__ void remap(int wgid, int nM, int nN, int& pm, int& pn) {
    const int nwg = nM * nN;
    { const int q = nwg / NXCD, r = nwg % NXCD, xcd = wgid % NXCD, off = wgid / NXCD; wgid = (xcd < r ? xcd * (q + 1) : r * (q + 1) + (xcd - r) * q) + off; }
    const int nig = WGM * nN, gid = wgid / nig, fm = gid * WGM, gsz = (nM - fm) < WGM ? (nM - fm) : WGM;
    pm = fm + ((wgid % nig) % gsz); pn = (wgid % nig) / gsz;
}

struct EpiBf {
    static constexpr bool PERM = true;
    __device__ __forceinline__ void operator()(const f32x4 (&acc)[2][2][4][2], const Unit& u, int wr, int wc, int fr, int fq) const {
        asm volatile("" : "+v"(fr), "+v"(fq));
        bf16_t* base = (bf16_t*)u.O;
#pragma unroll
        for (int ai = 0; ai < 2; ++ai)
#pragma unroll
            for (int m = 0; m < 4; ++m) { bf16_t* rowp = base + (size_t)(ai * HALF + wr * 64 + m * 16 + fr) * u.ldc + wc * 32 + 8 * fq;
#pragma unroll
                for (int bj = 0; bj < 2; ++bj) { const f32x4 v0 = acc[ai][bj][m][0], v1 = acc[ai][bj][m][1];
                    u32x4 w; w.x = pk2(v0[0], v0[1]); w.y = pk2(v0[2], v0[3]); w.z = pk2(v1[0], v1[1]); w.w = pk2(v1[2], v1[3]);
                    *(u32x4*)(rowp + bj * HALF) = w; } }
    }
};
struct EpiAtomic {
    static constexpr bool PERM = false;
    __device__ __forceinline__ void operator()(const f32x4 (&acc)[2][2][4][2], const Unit& u, int wr, int wc, int fr, int fq) const {
        asm volatile("" : "+v"(fr), "+v"(fq));
        float* base = (float*)u.O;
#pragma unroll
        for (int ai = 0; ai < 2; ++ai)
#pragma unroll
            for (int m = 0; m < 4; ++m) { float* rowp = base + (size_t)(ai * HALF + wr * 64 + m * 16 + fr) * u.ldc + wc * 32 + 4 * fq;
#pragma unroll
                for (int bj = 0; bj < 2; ++bj)
#pragma unroll
                    for (int n = 0; n < 2; ++n) { const f32x4 v = acc[ai][bj][m][n]; float* q = rowp + bj * HALF + n * 16;
#pragma unroll
                        for (int e = 0; e < 4; ++e) (void)__hip_atomic_fetch_add(q + e, v[e], __ATOMIC_RELAXED, __HIP_MEMORY_SCOPE_AGENT); }
                __builtin_amdgcn_sched_barrier(0); }
    }
};

template <class Epi, class Sched>
__device__ __forceinline__ void gemm_phase(LAS unsigned char* lds, const int tid, const int ldk, const int Kloop, const Sched& S, const Epi& E) {
    const int wid = __builtin_amdgcn_readfirstlane(tid >> 6), lane = tid & 63, wr = wid >> 2, wc = wid & 3, fr = lane & 15, fq = lane >> 4;
    const int nt = Kloop / BK;
    unsigned voffA[2], voffB[2];
#pragma unroll
    for (int i = 0; i < 2; ++i) { int R, C; stage_rc(tid * 16 + i * 8192, R, C); const int Rb = Epi::PERM ? ((R & ~31) + perm32(R & 31)) : R;
        voffA[i] = (unsigned)(R * ldk + C) * 2u; voffB[i] = (unsigned)(Rb * ldk + C) * 2u; }
    const size_t kstep = (size_t)(BK * 2);
    const size_t hstep = (size_t)HALF * ldk * 2;
    const unsigned ldsw = (unsigned)wid * 1024u;
    const int aoff = lds_byte(wr * 64 + fr, fq * 8), boff = lds_byte(wc * 32 + fr, fq * 8);
#define PG8_SA(b, h) (((b) * 2 + (h)) * HTB)
#define PG8_SB(b, h) ((4 + (b) * 2 + (h)) * HTB)
#define PG8_STAGE(bufoff, gbase, voff) do { _Pragma("unroll") for (int _i = 0; _i < 2; ++_i) \
        __builtin_amdgcn_global_load_lds((const unsigned*)((const char*)(gbase) + (voff)[_i]), (LAS unsigned*)(lds + (bufoff) + ldsw + _i * 8192), 16, 0, 0); } while (0)
#define PG8_LDA(dst, b, h) do { _Pragma("unroll") for (int m = 0; m < 4; ++m) _Pragma("unroll") for (int k = 0; k < 2; ++k) dst[m][k] = *(const LAS bf16x8*)(lds + PG8_SA(b, h) + aoff + m * 2048 + k * 1024); } while (0)
#define PG8_LDB(dst, b, h) do { _Pragma("unroll") for (int n = 0; n < 2; ++n) _Pragma("unroll") for (int k = 0; k < 2; ++k) dst[n][k] = *(const LAS bf16x8*)(lds + PG8_SB(b, h) + boff + n * 2048 + k * 1024); } while (0)
#define PG8_MMA(ai, bj, At, Bt) do { __builtin_amdgcn_s_setprio(1); _Pragma("unroll") for (int m = 0; m < 4; ++m) _Pragma("unroll") for (int n = 0; n < 2; ++n) _Pragma("unroll") for (int k = 0; k < 2; ++k) \
        acc[ai][bj][m][n] = __builtin_amdgcn_mfma_f32_16x16x32_bf16(Bt[n][k], At[m][k], acc[ai][bj][m][n], 0, 0, 0); __builtin_amdgcn_s_setprio(0); } while (0)
#define PG8_WAIT_V(n) asm volatile("s_waitcnt vmcnt(" #n ")" ::: "memory")
#define PG8_WAIT_L(n) asm volatile("s_waitcnt lgkmcnt(" #n ")" ::: "memory")
#define PG8_BAR __builtin_amdgcn_s_barrier()
#define PG8_SCHED __builtin_amdgcn_sched_barrier(0)
    Unit cur, nxt; int ui = 0;
    if (!S.next(0, cur)) return;
    f32x4 acc[2][2][4][2];
#pragma unroll
    for (int a = 0; a < 2; ++a)
#pragma unroll
        for (int b = 0; b < 2; ++b)
#pragma unroll
            for (int m = 0; m < 4; ++m)
#pragma unroll
                for (int n = 0; n < 2; ++n) acc[a][b][m][n] = (f32x4){0.f, 0.f, 0.f, 0.f};
    bf16x8 At[4][2], B0[2][2], B1[2][2];
    const char* cA = cur.A; const char* cB = cur.B;
    PG8_STAGE(PG8_SB(0, 0), cB, voffB); PG8_STAGE(PG8_SA(0, 0), cA, voffA); PG8_STAGE(PG8_SB(0, 1), cB + hstep, voffB); PG8_STAGE(PG8_SA(0, 1), cA + hstep, voffA);
    if (wr == 1) PG8_BAR;
    PG8_WAIT_V(4); PG8_BAR;
    PG8_STAGE(PG8_SB(1, 0), cB + kstep, voffB); PG8_STAGE(PG8_SA(1, 0), cA + kstep, voffA); PG8_STAGE(PG8_SB(1, 1), cB + hstep + kstep, voffB);
    PG8_WAIT_V(6); PG8_BAR;
    for (;;) {
        const bool has_next = S.next(ui + 1, nxt);
        const char* nA = has_next ? nxt.A : cA; const char* nB = has_next ? nxt.B : cB;
        for (int t = 0; t < nt; t += 2) {
            const bool last = (t == nt - 2);
            const char* a1 = cA + (size_t)(t + 1) * kstep;
            const char* a2 = last ? nA : cA + (size_t)(t + 2) * kstep; const char* b2 = last ? nB : cB + (size_t)(t + 2) * kstep;
            const char* a3 = a2 + kstep; const char* b3 = b2 + kstep;
            PG8_LDB(B0, 0, 0); PG8_SCHED; PG8_LDA(At, 0, 0); PG8_STAGE(PG8_SA(1, 1), a1 + hstep, voffA);
            PG8_WAIT_L(8); PG8_BAR; PG8_WAIT_L(0); PG8_MMA(0, 0, At, B0); PG8_BAR; PG8_SCHED;
            PG8_LDB(B1, 0, 1); PG8_STAGE(PG8_SB(0, 0), b2, voffB);
            PG8_BAR; PG8_WAIT_L(0); PG8_MMA(0, 1, At, B1); PG8_BAR;
            PG8_LDA(At, 0, 1); PG8_STAGE(PG8_SA(0, 0), a2, voffA);
            PG8_BAR; PG8_WAIT_L(0); PG8_MMA(1, 0, At, B0); PG8_BAR; PG8_SCHED;
            PG8_STAGE(PG8_SB(0, 1), b2 + hstep, voffB);
            PG8_WAIT_V(6); PG8_BAR; PG8_MMA(1, 1, At, B1); PG8_BAR;
            PG8_LDB(B0, 1, 0); PG8_SCHED; PG8_LDA(At, 1, 0); PG8_STAGE(PG8_SA(0, 1), a2 + hstep, voffA);
            PG8_WAIT_L(8); PG8_BAR; PG8_WAIT_L(0); PG8_MMA(0, 0, At, B0); PG8_BAR; PG8_SCHED;
            PG8_LDB(B1, 1, 1); PG8_STAGE(PG8_SB(1, 0), b3, voffB);
            PG8_BAR; PG8_WAIT_L(0); PG8_MMA(0, 1, At, B1); PG8_BAR;
            PG8_LDA(At, 1, 1); PG8_STAGE(PG8_SA(1, 0), a3, voffA);
            PG8_BAR; PG8_WAIT_L(0); PG8_MMA(1, 0, At, B0); PG8_BAR; PG8_SCHED;
            PG8_STAGE(PG8_SB(1, 1), b3 + hstep, voffB);
            PG8_WAIT_V(6); PG8_BAR; PG8_MMA(1, 1, At, B1); PG8_BAR;
        }
        E(acc, cur, wr, wc, fr, fq);
        if (!has_next) break;
#pragma unroll
        for (int a = 0; a < 2; ++a)
#pragma unroll
            for (int b = 0; b < 2; ++b)
#pragma unroll
                for (int m = 0; m < 4; ++m)
#pragma unroll
                    for (int n = 0; n < 2; ++n) acc[a][b][m][n] = (f32x4){0.f, 0.f, 0.f, 0.f};
        cur = nxt; cA = nA; cB = nB; ++ui;
    }
    PG8_WAIT_V(0);
    if (wr == 0) PG8_BAR;
    PG8_BAR;
#undef PG8_SA
#undef PG8_SB
#undef PG8_STAGE
#undef PG8_LDA
#undef PG8_LDB
#undef PG8_MMA
#undef PG8_WAIT_V
#undef PG8_WAIT_L
#undef PG8_BAR
#undef PG8_SCHED
}
}

#define XB_TMO      128
#define XB_XCNT(j)  (256  + 64 * (j))
#define XB_XSUB(j)  (1280 + 64 * (j))
#define XB_XGEN(j)  (2304 + 64 * (j))
#define XB_TOP      3328
#define XB_TOPGEN   3392
#define XCD_BAR_WORDS 3456
#define XB_SPIN_CAP (1u << 18)
__device__ __forceinline__ unsigned xb_ld(unsigned* p)              { return __hip_atomic_load(p, __ATOMIC_RELAXED, __HIP_MEMORY_SCOPE_AGENT); }
__device__ __forceinline__ unsigned xb_add(unsigned* p, unsigned v) { return __hip_atomic_fetch_add(p, v, __ATOMIC_RELAXED, __HIP_MEMORY_SCOPE_AGENT); }
__device__ __forceinline__ unsigned xb_xcc_id() { return (unsigned)__builtin_amdgcn_s_getreg((3 << 11) | 20) & 0xFu; }
#define XB_SPIN(cond, bar) do { unsigned _sp = 0; while (cond) { __builtin_amdgcn_s_sleep(1); \
    if ((++_sp & 255u) == 0u) { if (xb_ld(&(bar)[XB_TMO])) break; if (_sp > XB_SPIN_CAP) { atomicAdd(&(bar)[XB_TMO], 1u); break; } } } } while (0)
struct XcdBarrier { unsigned* bar; unsigned x; volatile LAS unsigned* st; };
__device__ __forceinline__ XcdBarrier xcd_barrier_post(unsigned* bar, volatile LAS unsigned* st) {
    XcdBarrier b; b.bar = bar; b.x = xb_xcc_id(); b.st = st;
    if (threadIdx.x == 0) (void)xb_add(&bar[XB_XCNT(b.x)], 1u);
    return b;
}
__device__ __forceinline__ void xcd_barrier_complete(unsigned* bar, unsigned x, unsigned& nloc, unsigned& nx) {
    const unsigned G = gridDim.x * gridDim.y * gridDim.z;
    unsigned sum, cnt, mine, sp = 0u;
    for (;;) {
        sum = 0u; cnt = 0u; mine = 0u;
#pragma unroll
        for (unsigned j = 0; j < 16; ++j) { const unsigned c = xb_ld(&bar[XB_XCNT(j)]); sum += c; cnt += (c > 0u) ? 1u : 0u; mine = (j == x) ? c : mine; }
        if (sum == G) break;
        __builtin_amdgcn_s_sleep(1);
        if ((++sp & 255u) == 0u) { if (xb_ld(&bar[XB_TMO])) break; if (sp > XB_SPIN_CAP) { atomicAdd(&bar[XB_TMO], 1u); break; } }
    }
    nloc = mine > 0u ? mine : 1u; nx = cnt > 0u ? cnt : 1u;
}
__device__ __forceinline__ void xcd_barrier(const XcdBarrier& b) {
    asm volatile("s_waitcnt vmcnt(0)" ::: "memory");
    __syncthreads();
    int tid0 = threadIdx.x; asm volatile("" : "+v"(tid0));
    if (tid0 == 0) {
        unsigned* bar = b.bar;
        __builtin_amdgcn_s_waitcnt(0);
        unsigned nloc = b.st[0], nx = b.st[1];
        if (nloc == 0u) { xcd_barrier_complete(bar, b.x, nloc, nx); b.st[0] = nloc; b.st[1] = nx; }
        const unsigned old = xb_add(&bar[XB_XSUB(b.x)], 1u);
        const unsigned gen = old / nloc;
        if (old + 1u == (gen + 1u) * nloc) {
            __builtin_amdgcn_fence(__ATOMIC_RELEASE, "agent");
            asm volatile("s_waitcnt vmcnt(0)" ::: "memory");
            const unsigned og = xb_add(&bar[XB_TOP], 1u);
            const unsigned tg = og / nx;
            if (og + 1u == (tg + 1u) * nx) xb_add(&bar[XB_TOPGEN], 1u);
            else XB_SPIN(xb_ld(&bar[XB_TOPGEN]) == tg, bar);
            __builtin_amdgcn_fence(__ATOMIC_ACQUIRE, "agent");
            xb_add(&bar[XB_XGEN(b.x)], 1u);
            asm volatile("s_waitcnt vmcnt(0)" ::: "memory");
        } else {
            XB_SPIN(xb_ld(&bar[XB_XGEN(b.x)]) == gen, bar);
            __builtin_amdgcn_fence(__ATOMIC_ACQUIRE, "agent");
            asm volatile("s_waitcnt vmcnt(0)" ::: "memory");
        }
    }
    __syncthreads();
}

__device__ __forceinline__ void lds_barrier() { asm volatile("s_waitcnt lgkmcnt(0)" ::: "memory"); __builtin_amdgcn_s_barrier(); asm volatile("" ::: "memory"); }
struct Ctx { int tid, wv, lane, G, bid; LAS unsigned char* lds; unsigned char* seg; };

template <int MODE>
__device__ __forceinline__ void convT_tile(const Ctx& c, const float* src, int ldsrc, int Ksrc, int k0, int n0, bf16_t* dst, int ldd, int koff) {
    LAS float* tile = (LAS float*)c.lds;
    __syncthreads();
#pragma unroll
    for (int rep = 0; rep < 2; ++rep) {
        const int i = (c.tid >> 4) + 32 * rep, j4 = (c.tid & 15) * 4; const int n = n0 + j4; int sc = n;
        if (MODE == 1) sc = (n < RW_SHIFT) ? n : (n < P1W ? -1 : n - (P1W - RW_SHIFT));
        f32x4 v = (f32x4){0.f, 0.f, 0.f, 0.f};
        if (sc >= 0 && (k0 + i) < Ksrc) v = *(const f32x4*)(src + (size_t)(k0 + i) * ldsrc + sc);
        tile[i * 65 + j4 + 0] = v[0]; tile[i * 65 + j4 + 1] = v[1]; tile[i * 65 + j4 + 2] = v[2]; tile[i * 65 + j4 + 3] = v[3];
    }
    __syncthreads();
    { const int j = c.tid >> 3, i8 = (c.tid & 7) * 8;
      if (k0 + i8 < Ksrc) {
        u32x4 w; w.x = pk2(tile[(i8 + 0) * 65 + j], tile[(i8 + 1) * 65 + j]); w.y = pk2(tile[(i8 + 2) * 65 + j], tile[(i8 + 3) * 65 + j]);
        w.z = pk2(tile[(i8 + 4) * 65 + j], tile[(i8 + 5) * 65 + j]); w.w = pk2(tile[(i8 + 6) * 65 + j], tile[(i8 + 7) * 65 + j]);
        *(u32x4*)(dst + (size_t)(n0 + j) * ldd + koff + k0 + i8) = w; } }
}

__device__ __forceinline__ void rms_row_bf16(const float* src, const float* g, bf16_t* dst, int lane) {
    f32x4 v[4]; float ss = 0.f;
#pragma unroll
    for (int i = 0; i < 4; ++i) { v[i] = *(const f32x4*)(src + i * 256 + lane * 4); ss += v[i][0] * v[i][0] + v[i][1] * v[i][1] + v[i][2] * v[i][2] + v[i][3] * v[i][3]; }
    ss = wsum(ss); const float rs = rsqrtf(ss * (1.0f / 1024.0f) + 1e-6f);
#pragma unroll
    for (int i = 0; i < 4; ++i) { const f32x4 gg = *(const f32x4*)(g + i * 256 + lane * 4);
        u32x2 w; w.x = pk2(v[i][0] * rs * gg[0], v[i][1] * rs * gg[1]); w.y = pk2(v[i][2] * rs * gg[2], v[i][3] * rs * gg[3]);
        *(u32x2*)(dst + i * 256 + lane * 4) = w; }
}
__device__ __forceinline__ float add_slabs(const float* src, const bf16_t* slab, int r, int lane, f32x4 (&v)[4]) {
    float ss = 0.f;
#pragma unroll
    for (int i = 0; i < 4; ++i) { v[i] = *(const f32x4*)(src + i * 256 + lane * 4);
#pragma unroll
        for (int ks = 0; ks < 4; ++ks) { const u32x2 t = *(const u32x2*)(slab + ((size_t)ks * MS + r) * DM + i * 256 + lane * 4);
            v[i][0] += bflo(t.x); v[i][1] += bfhi(t.x); v[i][2] += bflo(t.y); v[i][3] += bfhi(t.y); }
        ss += v[i][0] * v[i][0] + v[i][1] * v[i][1] + v[i][2] * v[i][2] + v[i][3] * v[i][3]; }
    return wsum(ss);
}

__device__ __forceinline__ void phase_apre(const P& p, const Ctx& c, int seg, int wg, int nwg) {
    bf16_t* H = (bf16_t*)(p.ws + OFF_H);
    for (int r = wg * 8 + c.wv; r < MS; r += nwg * 8) { const int b = r >> 9, tl = r & 511; const size_t grow = (size_t)b * SEQ + seg * SEGT + tl;
        rms_row_bf16(p.x + grow * DM, p.norm_g, H + (size_t)r * DM, c.lane); }
}
__device__ __forceinline__ void phase_a5(const P& p, const Ctx& c, int seg) {
    bf16_t* H = (bf16_t*)(p.ws + OFF_H); const bf16_t* slab = (const bf16_t*)(c.seg + S0_SLAB);
    for (int r = c.bid * 8 + c.wv; r < MS / 2; r += c.G * 8) {
        const int ra = r, rb = r + MS / 2;
        const size_t ga = (size_t)(ra >> 9) * SEQ + seg * SEGT + (ra & 511), gb = (size_t)(rb >> 9) * SEQ + seg * SEGT + (rb & 511);
        f32x4 va[4], vb[4]; const float sa = add_slabs(p.x + ga * DM, slab, ra, c.lane, va); const float sb = add_slabs(p.x + gb * DM, slab, rb, c.lane, vb);
        const float rsa = rsqrtf(sa * (1.0f / 1024.0f) + 1e-6f), rsb = rsqrtf(sb * (1.0f / 1024.0f) + 1e-6f);
#pragma unroll
        for (int i = 0; i < 4; ++i) { const f32x4 gg = *(const f32x4*)(p.norm_g + DM + i * 256 + c.lane * 4);
            *(f32x4*)(p.out + ga * DM + i * 256 + c.lane * 4) = va[i]; *(f32x4*)(p.out + gb * DM + i * 256 + c.lane * 4) = vb[i];
            u32x2 w; w.x = pk2(va[i][0] * rsa * gg[0], va[i][1] * rsa * gg[1]); w.y = pk2(va[i][2] * rsa * gg[2], va[i][3] * rsa * gg[3]);
            *(u32x2*)(H + (size_t)ra * DM + i * 256 + c.lane * 4) = w;
            w.x = pk2(vb[i][0] * rsb * gg[0], vb[i][1] * rsb * gg[1]); w.y = pk2(vb[i][2] * rsb * gg[2], vb[i][3] * rsb * gg[3]);
            *(u32x2*)(H + (size_t)rb * DM + i * 256 + c.lane * 4) = w; } }
}
__device__ __forceinline__ void phase_b5(const P& p, const Ctx& c, int seg) {
    const bf16_t* slab = (const bf16_t*)(c.seg + S1_SLAB);
    for (int r = c.bid * 8 + c.wv; r < MS / 2; r += c.G * 8) {
        const int ra = r, rb = r + MS / 2;
        float* rowa = p.out + ((size_t)(ra >> 9) * SEQ + seg * SEGT + (ra & 511)) * DM; float* rowb = p.out + ((size_t)(rb >> 9) * SEQ + seg * SEGT + (rb & 511)) * DM;
        f32x4 va[4], vb[4]; const float sa = add_slabs(rowa, slab, ra, c.lane, va); const float sb = add_slabs(rowb, slab, rb, c.lane, vb);
        const float rsa = rsqrtf(sa * (1.0f / 1024.0f) + 1e-6f), rsb = rsqrtf(sb * (1.0f / 1024.0f) + 1e-6f);
#pragma unroll
        for (int i = 0; i < 4; ++i) { const f32x4 gg = *(const f32x4*)(p.final_g + i * 256 + c.lane * 4); f32x4 o;
            o[0] = va[i][0] * rsa * gg[0]; o[1] = va[i][1] * rsa * gg[1]; o[2] = va[i][2] * rsa * gg[2]; o[3] = va[i][3] * rsa * gg[3]; *(f32x4*)(rowa + i * 256 + c.lane * 4) = o;
            o[0] = vb[i][0] * rsb * gg[0]; o[1] = vb[i][1] * rsb * gg[1]; o[2] = vb[i][2] * rsb * gg[2]; o[3] = vb[i][3] * rsb * gg[3]; *(f32x4*)(rowb + i * 256 + c.lane * 4) = o; } }
}

__device__ __forceinline__ void phase0(const P& p, const Ctx& c) {
    const int T0 = 16 * 64, T1 = 16 * 120, T2 = 32 * 16, T3 = 32 * 16, T4 = 16 * 16, T5 = 16 * 16, T6 = 24 * 5;
    const int TT = T0 + T1 + T2 + T3 + T4 + T5 + T6;
    for (int t = c.bid; t < TT; t += c.G) {
        int u = t;
        if (u < T0) { convT_tile<0>(c, p.ml_w_in, ML_W, 1024, (u & 15) * 64, (u >> 4) * 64, (bf16_t*)(p.ws + OFF_WT0), 1024, 0); continue; } u -= T0;
        if (u < T1) { convT_tile<1>(c, p.rw_w_in, RW_W, 1024, (u & 15) * 64, (u >> 4) * 64, (bf16_t*)(p.ws + OFF_WT1), 1024, 0); continue; } u -= T1;
        if (u < T2) { convT_tile<0>(c, p.w_out, DM, 2048, (u & 31) * 64, (u >> 5) * 64, (bf16_t*)(p.ws + OFF_WO0T), 2048, 0); continue; } u -= T2;
        if (u < T3) { convT_tile<0>(c, p.w_out + (size_t)DIN * DM, DM, 2048, (u & 31) * 64, (u >> 5) * 64, (bf16_t*)(p.ws + OFF_WO1T), 2048, 0); continue; } u -= T3;
        if (u < T4) { convT_tile<0>(c, p.mem_kv_w, DM, 1024, (u & 15) * 64, (u >> 4) * 64, (bf16_t*)(p.ws + OFF_WKVT), 1024, 0); continue; } u -= T4;
        if (u < T5) { convT_tile<0>(c, p.mem_kv_w + (size_t)DM * DM, DM, 1024, (u & 15) * 64, (u >> 4) * 64, (bf16_t*)(p.ws + OFF_WKVT + 2 * MiB), 1024, 0); continue; } u -= T5;
        { const int nt = u / 5, j = u % 5; bf16_t* L = (bf16_t*)(p.ws + OFF_LORAT);
          if (j == 0) convT_tile<0>(c, p.rw_w_lora2, DMIX, 64, 0, nt * 64, L, 288, 0);
          else if (j == 1) convT_tile<0>(c, p.rw_a_lora2, DMIX, 64, 0, nt * 64, L, 288, 64);
          else if (j == 2) convT_tile<0>(c, p.rw_v_lora2, DMIX, 32, 0, nt * 64, L, 288, 128);
          else convT_tile<0>(c, p.rw_g_lora2, DMIX, 128, (j - 3) * 64, nt * 64, L, 288, 160); }
    }
    for (int r = c.bid * 8 + c.wv; r < 2 * 2048; r += c.G * 8) { const int l = r >> 11, rr = r & 2047;
        rms_row_bf16(p.mem + (size_t)rr * DM, p.mem_norm_g + l * DM, (bf16_t*)(p.ws + OFF_MEMN) + (size_t)r * DM, c.lane); }
}

struct SchedA0 {
    const unsigned char* ws; unsigned char* seg; int G, c, nextra;
    __device__ __forceinline__ bool next(int i, pg8::Unit& u) const {
        const int L = i * G + c; if (L >= 256 + nextra) return false;
        if (L < 256) { int pm, pn; pg8::remap(L, 16, 16, pm, pn);
            u.A = (const char*)(ws + OFF_H) + (size_t)pm * 256 * 1024 * 2; u.B = (const char*)(ws + OFF_WT0) + (size_t)pn * 256 * 1024 * 2;
            u.O = (char*)(seg + S0_P0) + ((size_t)pm * 256 * ML_W + pn * 256) * 2; u.ldc = ML_W; return true; }
        const int e = L - 256, l = e >> 5, j = e & 31;
        const char* memn = (const char*)(ws + OFF_MEMN) + (size_t)l * 2048 * 1024 * 2; const char* wkv = (const char*)(ws + OFF_WKVT) + (size_t)l * 2 * MiB;
        char* kout = (char*)(ws + OFF_KMEM) + (size_t)l * 4 * MiB;
        if (j < 16) { const int pm = j >> 1, pn = j & 1;
            u.A = memn + (size_t)pm * 256 * 1024 * 2; u.B = wkv + (size_t)pn * 256 * 1024 * 2; u.O = kout + ((size_t)pm * 256 * 512 + pn * 256) * 2; u.ldc = 512; }
        else { const int jj = j - 16, pm = jj >> 3, pn = jj & 7;
            u.A = wkv + (size_t)(512 + pm * 256) * 1024 * 2; u.B = memn + (size_t)pn * 256 * 1024 * 2; u.O = kout + 2 * MiB + ((size_t)pm * 256 * 2048 + pn * 256) * 2; u.ldc = 2048; }
        return true;
    }
};
struct SchedB0 {
    const unsigned char* ws; unsigned char* seg; int G, c;
    __device__ __forceinline__ bool next(int i, pg8::Unit& u) const {
        const int L = i * G + c; if (L >= 480) return false;
        int pm, pn; pg8::remap(L, 16, 30, pm, pn);
        u.A = (const char*)(ws + OFF_H) + (size_t)pm * 256 * 1024 * 2; u.B = (const char*)(ws + OFF_WT1) + (size_t)pn * 256 * 1024 * 2;
        if (pn < 20) { u.O = (char*)(seg + S1_P1) + ((size_t)pm * 256 * P1W + pn * 256) * 2; u.ldc = P1W; }
        else { u.O = (char*)(seg + S1_P2) + ((size_t)pm * 256 * P2W + (pn - 20) * 256) * 2; u.ldc = P2W; }
        return true;
    }
};
struct SchedOut {
    const char* Y; const char* W; char* slab; int G, c;
    __device__ __forceinline__ bool next(int i, pg8::Unit& u) const {
        const int L = i * G + c; if (L >= 256) return false;
        const int ks = L >> 6; int pm, pn; pg8::remap(L & 63, 16, 4, pm, pn);
        u.A = Y + ((size_t)pm * 256 * DIN + ks * 512) * 2; u.B = W + ((size_t)pn * 256 * DIN + ks * 512) * 2;
        u.O = slab + (((size_t)ks * MS + pm * 256) * DM + pn * 256) * 2; u.ldc = DM; return true;
    }
};

__device__ __forceinline__ void phase_a1(const P& p, const Ctx& c, int seg) {
    const bf16_t* P0 = (const bf16_t*)(c.seg + S0_P0);
    bf16_t* Qb = (bf16_t*)(c.seg + S0_Q); bf16_t* Kb = (bf16_t*)(c.seg + S0_K); bf16_t* KT = (bf16_t*)(c.seg + S0_KT); bf16_t* VT = (bf16_t*)(c.seg + S0_VT);
    bf16_t* XC = (bf16_t*)(c.seg + S0_XC); bf16_t* VF = (bf16_t*)(p.ws + OFF_VF);
    float* IPRE = (float*)(c.seg + S0_GATE); float* LOGF = IPRE + 32 * SEGT;
    const bf16_t* UT = (const bf16_t*)(p.ws + OFF_UTAIL);
    LAS float* red = (LAS float*)c.lds;
    LAS bf16_t* kst = (LAS bf16_t*)(c.lds + 98304);
    LAS bf16_t* vst = kst + 1536 * 8;
    const int n = c.tid;
    float wq[4][4], wk[4][4], wv[4][4], G12[4][8], G3[4][8];
    if (n < 384) {
#pragma unroll
        for (int i = 0; i < 4; ++i) { const f32x4 a = *(const f32x4*)(p.ml_wq + n * 16 + i * 4), bb = *(const f32x4*)(p.ml_wk + n * 16 + i * 4), cc = *(const f32x4*)(p.ml_wv + n * 16 + i * 4);
#pragma unroll
            for (int o = 0; o < 4; ++o) { wq[i][o] = a[o]; wk[i][o] = bb[o]; wv[i][o] = cc[o]; } }
#pragma unroll
        for (int i = 0; i < 4; ++i)
#pragma unroll
            for (int g = 0; g < 8; ++g) { G12[i][g] = 0.f; G3[i][g] = 0.f; }
#pragma unroll
        for (int o = 0; o < 4; ++o) {
            const float* gq = p.ml_w_gate + (size_t)(n * 4 + o) * 8; const float* gk = p.ml_w_gate + (size_t)(DMIX + n * 4 + o) * 8; const float* gv = p.ml_w_gate + (size_t)(2 * DMIX + n * 4 + o) * 8;
            const f32x4 q0 = *(const f32x4*)gq, q1 = *(const f32x4*)(gq + 4), k0 = *(const f32x4*)gk, k1 = *(const f32x4*)(gk + 4), v0 = *(const f32x4*)gv, v1 = *(const f32x4*)(gv + 4);
#pragma unroll
            for (int i = 0; i < 4; ++i)
#pragma unroll
                for (int g = 0; g < 4; ++g) { G12[i][g] += wq[i][o] * q0[g] + wk[i][o] * k0[g]; G12[i][g + 4] += wq[i][o] * q1[g] + wk[i][o] * k1[g];
                    G3[i][g] += wv[i][o] * v0[g]; G3[i][g + 4] += wv[i][o] * v1[g]; }
        }
    }
#pragma unroll 1
    for (int it = c.bid; it < MS / 8; it += c.G) {
        const int row0 = it * 8, b = row0 >> 9, tl0 = row0 & 511;
        __syncthreads();
        if (n < 384) {
            float um[3][4];
#pragma unroll
            for (int j = 1; j <= 3; ++j) { u32x2 raw = (u32x2){0u, 0u};
                if (tl0 - j >= 0) raw = *(const u32x2*)(P0 + (unsigned)((row0 - j) * ML_W + n * 4));
                else if (seg > 0) raw = *(const u32x2*)(UT + (unsigned)((b * 3 + (3 - j)) * DMIX + n * 4));
                um[3 - j][0] = bflo(raw.x); um[3 - j][1] = bfhi(raw.x); um[3 - j][2] = bflo(raw.y); um[3 - j][3] = bfhi(raw.y); }
            u32x2 nraw = *(const u32x2*)(P0 + (unsigned)(row0 * ML_W + n * 4));
#pragma unroll 1
            for (int tt = 0; tt < 8; ++tt) {
                const unsigned row = (unsigned)(row0 + tt);
                const u32x2 raw = nraw;
                if (tt + 1 < 8) nraw = *(const u32x2*)(P0 + (unsigned)((row + 1) * ML_W + n * 4));
                float u[4] = {bflo(raw.x), bfhi(raw.x), bflo(raw.y), bfhi(raw.y)}, xc[4], q[4], k[4], v[4];
                { int nn = n; asm volatile("" : "+v"(nn));
                  const f32x4 cb = *(const f32x4*)(p.ml_conv_b + nn * 4), c0 = *(const f32x4*)(p.ml_conv_w + nn * 4), c1 = *(const f32x4*)(p.ml_conv_w + DMIX + nn * 4),
                              c2 = *(const f32x4*)(p.ml_conv_w + 2 * DMIX + nn * 4), c3 = *(const f32x4*)(p.ml_conv_w + 3 * DMIX + nn * 4);
#pragma unroll
                  for (int i = 0; i < 4; ++i) { const float y = cb[i] + c0[i] * um[0][i] + c1[i] * um[1][i] + c2[i] * um[2][i] + c3[i] * u[i]; xc[i] = siluf_(y); } }
                const float ks = 0.05103103630798288f;
#pragma unroll
                for (int o = 0; o < 4; ++o) { q[o] = xc[0] * wq[0][o] + xc[1] * wq[1][o] + xc[2] * wq[2][o] + xc[3] * wq[3][o];
                    k[o] = (xc[0] * wk[0][o] + xc[1] * wk[1][o] + xc[2] * wk[2][o] + xc[3] * wk[3][o]) * ks;
                    v[o] = u[0] * wv[0][o] + u[1] * wv[1][o] + u[2] * wv[2][o] + u[3] * wv[3][o]; }
#pragma unroll
                for (int g = 0; g < 8; ++g) red[(tt * 8 + g) * 384 + n] = xc[0] * G12[0][g] + xc[1] * G12[1][g] + xc[2] * G12[2][g] + xc[3] * G12[3][g] + u[0] * G3[0][g] + u[1] * G3[1][g] + u[2] * G3[2][g] + u[3] * G3[3][g];
                u32x2 w; w.x = pk2(q[0], q[1]); w.y = pk2(q[2], q[3]); *(u32x2*)(Qb + (unsigned)(row * DMIX + n * 4)) = w;
                w.x = pk2(k[0], k[1]); w.y = pk2(k[2], k[3]); *(u32x2*)(Kb + (unsigned)(row * DMIX + n * 4)) = w;
                w.x = pk2(xc[0], xc[1]); w.y = pk2(xc[2], xc[3]); *(u32x2*)(XC + (unsigned)(row * DMIX + n * 4)) = w;
                w.x = pk2(v[0], v[1]); w.y = pk2(v[2], v[3]); *(u32x2*)(VF + (unsigned)(row * DMIX + n * 4)) = w;
#pragma unroll
                for (int o = 0; o < 4; ++o) { kst[(n * 4 + o) * 8 + tt] = f2bf(k[o]); vst[(n * 4 + o) * 8 + tt] = f2bf(v[o]); }
#pragma unroll
                for (int i = 0; i < 4; ++i) { um[0][i] = um[1][i]; um[1][i] = um[2][i]; um[2][i] = u[i]; }
            }
            const int hd = n / 96, dch = (n % 96) * 4;
#pragma unroll
            for (int o = 0; o < 4; ++o) { const unsigned off = (unsigned)(((b * 4 + hd) * 384 + dch + o) * SEGT + tl0);
                *(u32x4*)(KT + off) = *(const LAS u32x4*)(kst + (n * 4 + o) * 8); *(u32x4*)(VT + off) = *(const LAS u32x4*)(vst + (n * 4 + o) * 8); }
        }
        __syncthreads();
        { const int v = c.tid >> 3, part = c.tid & 7; float s = 0.f;
#pragma unroll 8
          for (int i = 0; i < 48; ++i) s += red[v * 384 + part * 48 + i];
          s += __shfl_xor(s, 1); s += __shfl_xor(s, 2); s += __shfl_xor(s, 4);
          if (part == 0) { const int tt = v >> 3, g = v & 7; const float gate = s + p.ml_b_gate[g];
              if (g < 4) IPRE[(b * 4 + g) * SEGT + tl0 + tt] = gate; else LOGF[(b * 4 + g - 4) * SEGT + tl0 + tt] = -softplusf_(-gate); } }
    }
}

__device__ __forceinline__ void attn_item(const P& p, const Ctx& c, int layer, int it, const bf16_t* Qp, int ldq, bf16_t* YM) {
    const int b = it >> 3, head = (it >> 1) & 3, qb = it & 1;
    const bf16_t* Kg = (const bf16_t*)(p.ws + OFF_KMEM + (size_t)layer * 4 * MiB) + (size_t)(b * 256) * 512 + head * 128;
    const bf16_t* Vg = (const bf16_t*)(p.ws + OFF_KMEM + (size_t)layer * 4 * MiB + 2 * MiB) + (size_t)(head * 128) * 2048 + b * 256;
    LAS bf16_t* Ks = (LAS bf16_t*)c.lds;
    LAS bf16_t* Vs = Ks + 256 * 136;
    const int l15 = c.lane & 15, quad = c.lane >> 4;
    __syncthreads();
#pragma unroll
    for (int r = 0; r < 8; ++r) { const int id = c.tid + 512 * r; { const int i = id >> 4, c8 = (id & 15) * 8; *(LAS u32x4*)(Ks + i * 136 + c8) = *(const u32x4*)(Kg + (size_t)i * 512 + c8); }
        { const int i = id >> 5, c8 = (id & 31) * 8; *(LAS u32x4*)(Vs + i * 264 + c8) = *(const u32x4*)(Vg + (size_t)i * 2048 + c8); } }
    __syncthreads();
#pragma unroll 1
    for (int pass = 0; pass < 2; ++pass) {
        const int row0 = b * SEGT + qb * 256 + c.wv * 32 + pass * 16;
        bf16x8 qf[4];
#pragma unroll
        for (int kk = 0; kk < 4; ++kk) qf[kk] = *(const bf16x8*)(Qp + (size_t)(row0 + l15) * ldq + head * 128 + kk * 32 + quad * 8);
        f32x4 acc[16];
#pragma unroll
        for (int mt = 0; mt < 16; ++mt) { acc[mt] = (f32x4){0.f, 0.f, 0.f, 0.f};
#pragma unroll
            for (int kk = 0; kk < 4; ++kk) { const bf16x8 a = *(const LAS bf16x8*)(Ks + (mt * 16 + l15) * 136 + kk * 32 + quad * 8); acc[mt] = mfma16(a, qf[kk], acc[mt]); }
            if ((mt & 3) == 3) __builtin_amdgcn_sched_barrier(0); }
        float mx = -1e30f;
#pragma unroll
        for (int mt = 0; mt < 16; ++mt)
#pragma unroll
            for (int j = 0; j < 4; ++j) mx = fmaxf(mx, acc[mt][j]);
        mx = fmaxf(mx, __shfl_xor(mx, 16)); mx = fmaxf(mx, __shfl_xor(mx, 32));
        const float sc = 0.08838834764831845f * 1.4426950408889634f; float sm = 0.f;
#pragma unroll
        for (int mt = 0; mt < 16; ++mt)
#pragma unroll
            for (int j = 0; j < 4; ++j) { const float e = exp2f((acc[mt][j] - mx) * sc); acc[mt][j] = e; sm += e; }
        sm += __shfl_xor(sm, 16); sm += __shfl_xor(sm, 32);
        const float inv = 1.0f / sm;
        bf16x8 pa[8];
#pragma unroll
        for (int kp = 0; kp < 8; ++kp) {
            u32x4 aw; aw.x = pk2(acc[2 * kp][0] * inv, acc[2 * kp][1] * inv); aw.y = pk2(acc[2 * kp][2] * inv, acc[2 * kp][3] * inv);
            aw.z = pk2(acc[2 * kp + 1][0] * inv, acc[2 * kp + 1][1] * inv); aw.w = pk2(acc[2 * kp + 1][2] * inv, acc[2 * kp + 1][3] * inv);
            __builtin_memcpy(&pa[kp], &aw, 16); }
        __builtin_amdgcn_sched_barrier(0);
        f32x4 o[8];
#pragma unroll
        for (int nt = 0; nt < 8; ++nt) o[nt] = (f32x4){0.f, 0.f, 0.f, 0.f};
#pragma unroll
        for (int kp = 0; kp < 8; ++kp) {
            const bf16x8 a = pa[kp];
#pragma unroll
            for (int nt = 0; nt < 8; ++nt) { const LAS bf16_t* vp = Vs + (nt * 16 + l15) * 264 + 2 * kp * 16 + quad * 4;
                const u32x2 lo = *(const LAS u32x2*)vp, hi = *(const LAS u32x2*)(vp + 16); u32x4 bw = (u32x4){lo.x, lo.y, hi.x, hi.y}; bf16x8 bfr; __builtin_memcpy(&bfr, &bw, 16);
                o[nt] = mfma16(a, bfr, o[nt]); }
            __builtin_amdgcn_sched_barrier(0);
        }
#pragma unroll
        for (int nt = 0; nt < 8; ++nt)
#pragma unroll
            for (int j = 0; j < 4; ++j) YM[(size_t)(row0 + quad * 4 + j) * DX + head * 128 + nt * 16 + l15] = f2bf(o[nt][j]);
    }
}

__device__ __forceinline__ void mlstm_item(const P& p, const Ctx& c, int seg, int w, bool save) {
    const int b = w / 24, h = (w / 6) & 3, sl = w % 6;
    const bf16_t* Qb = (const bf16_t*)(c.seg + S0_Q); const bf16_t* Kb = (const bf16_t*)(c.seg + S0_K); const bf16_t* KT = (const bf16_t*)(c.seg + S0_KT); const bf16_t* VT = (const bf16_t*)(c.seg + S0_VT);
    const float* IPRE = (const float*)(c.seg + S0_GATE); const float* LOGF = IPRE + 32 * SEGT;
    bf16_t* HR = (bf16_t*)(c.seg + S0_HRAW);
    float* CST = (float*)(p.ws + OFF_CST) + (size_t)w * 64 * 384; float* NST = (float*)(p.ws + OFF_NST) + (size_t)w * 384;
    LAS bf16_t* Cimg = (LAS bf16_t*)c.lds;
    LAS bf16_t* Qs = Cimg + 64 * 392;
    LAS bf16_t* Ks = Qs + 64 * 136;
    LAS bf16_t* KTs = Ks + 64 * 136;
    LAS bf16_t* VTs = KTs + 128 * 72;
    LAS bf16_t* VWs = VTs + 64 * 72;
    LAS bf16_t* Sp = VWs + 64 * 72;
    LAS float* fl = (LAS float*)(Sp + 64 * 72);
    LAS float* bcum = fl; LAS float* ipr = fl + 64; LAS float* wgt = fl + 128; LAS float* gin = fl + 192; LAS float* qn = fl + 256; LAS float* rden = fl + 320;
    LAS float* gtotp = fl + 384; LAS float* nold = fl + 400; LAS float* nnew = fl + 800;
    const int l15c = c.lane & 15, quadc = c.lane >> 4, e16 = c.wv & 3, par = c.wv >> 2;
    f32x4 C[12];
    __syncthreads();
    if (seg > 0) {
#pragma unroll
        for (int j = 0; j < 12; ++j)
#pragma unroll
            for (int jj = 0; jj < 4; ++jj) C[j][jj] = CST[(size_t)(e16 * 16 + quadc * 4 + jj) * 384 + (2 * j + par) * 16 + l15c];
        if (c.tid < 384) nold[c.tid] = NST[c.tid];
    } else {
#pragma unroll
        for (int j = 0; j < 12; ++j) C[j] = (f32x4){0.f, 0.f, 0.f, 0.f};
        if (c.tid < 384) nold[c.tid] = 0.f;
    }
    u32x4 pq[2], pk[2], pt[2], pvt; float plf = 0.f, pip = 0.f;
    auto gl_piece = [&](int ch, int pp, int tidv) {
#pragma unroll
        for (int r = 0; r < 2; ++r) { const int id = tidv + 512 * r;
            { const int i = id >> 4, c8 = (id & 15) * 8; const size_t go = ((size_t)b * SEGT + ch * 64 + i) * DMIX + h * 384 + pp * 128 + c8; pq[r] = *(const u32x4*)(Qb + go); pk[r] = *(const u32x4*)(Kb + go); }
            { const int dd = id >> 3, c8 = (id & 7) * 8; pt[r] = *(const u32x4*)(KT + ((size_t)(b * 4 + h) * 384 + pp * 128 + dd) * SEGT + ch * 64 + c8); } } };
    auto gl_chunk = [&](int ch, int tidv) { const int i = tidv >> 3, c8 = (tidv & 7) * 8;
        pvt = *(const u32x4*)(VT + ((size_t)(b * 4 + h) * 384 + sl * 64 + i) * SEGT + ch * 64 + c8);
        if (c.wv == 0) { plf = LOGF[(b * 4 + h) * SEGT + ch * 64 + c.lane]; pip = IPRE[(b * 4 + h) * SEGT + ch * 64 + c.lane]; } };
    { int t0 = c.tid; asm volatile("" : "+v"(t0)); gl_chunk(0, t0); gl_piece(0, 0, t0); }
#pragma unroll 1
    for (int ch = 0; ch < 8; ++ch) {
        const int tl0 = ch * 64; const size_t row0 = (size_t)b * SEGT + tl0;
        int tidv = c.tid, l15 = l15c, quad = quadc;
        asm volatile("" : "+v"(tidv), "+v"(l15), "+v"(quad));
        lds_barrier();
        if (c.wv == 0) {
            float bc = plf;
#pragma unroll
            for (int o = 1; o < 64; o <<= 1) { const float t = __shfl_up(bc, o); if (c.lane >= o) bc += t; }
            const float bl = __shfl(bc, 63);
            bcum[c.lane] = bc; ipr[c.lane] = pip; wgt[c.lane] = __expf(bl - bc + pip); gin[c.lane] = __expf(bc);
            if (c.lane == 0) gtotp[0] = __expf(bl);
        }
#pragma unroll
        for (int j = 0; j < 12; ++j)
#pragma unroll
            for (int jj = 0; jj < 4; ++jj) Cimg[(e16 * 16 + quad * 4 + jj) * 392 + (2 * j + par) * 16 + l15] = f2bf(C[j][jj]);
        lds_barrier();
        { const int i = tidv >> 3, c8 = (tidv & 7) * 8;
          const u32x4 raw = pvt;
          *(LAS u32x4*)(VTs + i * 72 + c8) = raw;
          const f32x4 w0 = *(const LAS f32x4*)(wgt + c8), w1 = *(const LAS f32x4*)(wgt + c8 + 4);
          u32x4 sw; sw.x = pk2(bflo(raw.x) * w0[0], bfhi(raw.x) * w0[1]); sw.y = pk2(bflo(raw.y) * w0[2], bfhi(raw.y) * w0[3]);
          sw.z = pk2(bflo(raw.z) * w1[0], bfhi(raw.z) * w1[1]); sw.w = pk2(bflo(raw.w) * w1[2], bfhi(raw.w) * w1[3]);
          *(LAS u32x4*)(VWs + i * 72 + c8) = sw; }
        if (ch + 1 < 8) gl_chunk(ch + 1, tidv);
        const float gtot = gtotp[0];
#pragma unroll
        for (int j = 0; j < 12; ++j) C[j] *= gtot;
        f32x4 Sa[2], Ia[2]; Sa[0] = Sa[1] = Ia[0] = Ia[1] = (f32x4){0.f, 0.f, 0.f, 0.f};
        float qnacc = 0.f;
#pragma unroll
        for (int pp = 0; pp < 3; ++pp) {
            const int d0 = pp * 128;
            __builtin_amdgcn_sched_barrier(0);
            asm volatile("" : "+v"(tidv));
            lds_barrier();
#pragma unroll
            for (int r = 0; r < 2; ++r) { const int id = tidv + 512 * r;
                { const int i = id >> 4, c8 = (id & 15) * 8; *(LAS u32x4*)(Qs + i * 136 + c8) = pq[r]; *(LAS u32x4*)(Ks + i * 136 + c8) = pk[r]; }
                { const int dd = id >> 3, c8 = (id & 7) * 8; *(LAS u32x4*)(KTs + dd * 72 + c8) = pt[r]; } }
            lds_barrier();
            if (pp < 2) gl_piece(ch, pp + 1, tidv); else if (ch + 1 < 8) gl_piece(ch + 1, 0, tidv);
            { const int tm = c.wv >> 1, tn0 = (c.wv & 1) * 2;
#pragma unroll
              for (int kk = 0; kk < 4; ++kk) { const bf16x8 a = *(const LAS bf16x8*)(Qs + (tm * 16 + l15) * 136 + kk * 32 + quad * 8);
#pragma unroll
                  for (int x = 0; x < 2; ++x) { const int tn = tn0 + x;
                      const bf16x8 bk = *(const LAS bf16x8*)(Ks + (tn * 16 + l15) * 136 + kk * 32 + quad * 8);
                      const bf16x8 bc = *(const LAS bf16x8*)(Cimg + (tn * 16 + l15) * 392 + d0 + kk * 32 + quad * 8);
                      Sa[x] = mfma16(a, bk, Sa[x]); Ia[x] = mfma16(a, bc, Ia[x]); } } }
            { const bf16x8 va0 = *(const LAS bf16x8*)(VWs + (e16 * 16 + l15) * 72 + quad * 8), va1 = *(const LAS bf16x8*)(VWs + (e16 * 16 + l15) * 72 + 32 + quad * 8);
#pragma unroll
              for (int jl = 0; jl < 4; ++jl) { const int ntl = 2 * jl + par, j = pp * 4 + jl;
                  C[j] = mfma16(va0, *(const LAS bf16x8*)(KTs + (ntl * 16 + l15) * 72 + quad * 8), C[j]);
                  C[j] = mfma16(va1, *(const LAS bf16x8*)(KTs + (ntl * 16 + l15) * 72 + 32 + quad * 8), C[j]); } }
            { const int t = tidv >> 3, part = tidv & 7;
              const u32x4 q0 = *(const LAS u32x4*)(Qs + t * 136 + part * 16), q1 = *(const LAS u32x4*)(Qs + t * 136 + part * 16 + 8);
              const LAS float* np = nold + d0 + part * 16; const f32x4 n0 = *(const LAS f32x4*)np, n1 = *(const LAS f32x4*)(np + 4), n2 = *(const LAS f32x4*)(np + 8), n3 = *(const LAS f32x4*)(np + 12);
              qnacc += bflo(q0.x) * n0[0] + bfhi(q0.x) * n0[1] + bflo(q0.y) * n0[2] + bfhi(q0.y) * n0[3] + bflo(q0.z) * n1[0] + bfhi(q0.z) * n1[1] + bflo(q0.w) * n1[2] + bfhi(q0.w) * n1[3]
                     + bflo(q1.x) * n2[0] + bfhi(q1.x) * n2[1] + bflo(q1.y) * n2[2] + bfhi(q1.y) * n2[3] + bflo(q1.z) * n3[0] + bfhi(q1.z) * n3[1] + bflo(q1.w) * n3[2] + bfhi(q1.w) * n3[3]; }
            { const int dd = tidv >> 2, part = tidv & 3;
              const u32x4 k0 = *(const LAS u32x4*)(KTs + dd * 72 + part * 16), k1 = *(const LAS u32x4*)(KTs + dd * 72 + part * 16 + 8);
              const LAS float* wp = wgt + part * 16; const f32x4 w0 = *(const LAS f32x4*)wp, w1 = *(const LAS f32x4*)(wp + 4), w2 = *(const LAS f32x4*)(wp + 8), w3 = *(const LAS f32x4*)(wp + 12);
              float a = bflo(k0.x) * w0[0] + bfhi(k0.x) * w0[1] + bflo(k0.y) * w0[2] + bfhi(k0.y) * w0[3] + bflo(k0.z) * w1[0] + bfhi(k0.z) * w1[1] + bflo(k0.w) * w1[2] + bfhi(k0.w) * w1[3]
                      + bflo(k1.x) * w2[0] + bfhi(k1.x) * w2[1] + bflo(k1.y) * w2[2] + bfhi(k1.y) * w2[3] + bflo(k1.z) * w3[0] + bfhi(k1.z) * w3[1] + bflo(k1.w) * w3[2] + bfhi(k1.w) * w3[3];
              a = dpp_add<0xB1>(a); a = dpp_add<0x4E>(a);
              if (part == 0) nnew[d0 + dd] = gtot * nold[d0 + dd] + a; }
        }
        qnacc = dpp_add<0xB1>(qnacc); qnacc = dpp_add<0x4E>(qnacc); qnacc = dpp_add<0x141>(qnacc);
        if ((tidv & 7) == 0) qn[tidv >> 3] = qnacc;
#pragma unroll
        for (int x = 0; x < 2; ++x) { const int ti = c.wv * 2 + x, tm = ti >> 2, tn = ti & 3; const int s = tn * 16 + l15; const float bs = bcum[s] - ipr[s];
#pragma unroll
            for (int jj = 0; jj < 4; ++jj) { const int t = tm * 16 + quad * 4 + jj; const float v = (s <= t) ? Sa[x][jj] * __expf(bcum[t] - bs) : 0.f; Sp[t * 72 + s] = f2bf(v); } }
        lds_barrier();
        { const int t = tidv >> 3, part = tidv & 7; const u32x4 sr = *(const LAS u32x4*)(Sp + t * 72 + part * 8);
          float ds = bflo(sr.x) + bfhi(sr.x) + bflo(sr.y) + bfhi(sr.y) + bflo(sr.z) + bfhi(sr.z) + bflo(sr.w) + bfhi(sr.w);
          ds = dpp_add<0xB1>(ds); ds = dpp_add<0x4E>(ds); ds = dpp_add<0x141>(ds);
          if (part == 0) { const float den = ds + gin[t] * qn[t]; rden[t] = 1.0f / fmaxf(fabsf(den), 1.0f); } }
#pragma unroll
        for (int x = 0; x < 2; ++x) { const int ti = c.wv * 2 + x, tm = ti >> 2, tn = ti & 3;
#pragma unroll
            for (int jj = 0; jj < 4; ++jj) Ia[x][jj] *= gin[tm * 16 + quad * 4 + jj];
#pragma unroll
            for (int kk = 0; kk < 2; ++kk) { const bf16x8 a = *(const LAS bf16x8*)(Sp + (tm * 16 + l15) * 72 + kk * 32 + quad * 8);
                const bf16x8 bb = *(const LAS bf16x8*)(VTs + (tn * 16 + l15) * 72 + kk * 32 + quad * 8); Ia[x] = mfma16(a, bb, Ia[x]); } }
        lds_barrier();
#pragma unroll
        for (int x = 0; x < 2; ++x) { const int ti = c.wv * 2 + x, tm = ti >> 2, tn = ti & 3;
#pragma unroll
            for (int jj = 0; jj < 4; ++jj) { const int t = tm * 16 + quad * 4 + jj; HR[(row0 + t) * DMIX + h * 384 + sl * 64 + tn * 16 + l15] = f2bf(Ia[x][jj] * rden[t]); } }
        if (c.tid < 384) nold[c.tid] = nnew[c.tid];
    }
    lds_barrier();
    if (!save) return;
#pragma unroll
    for (int j = 0; j < 12; ++j)
#pragma unroll
        for (int jj = 0; jj < 4; ++jj) CST[(size_t)(e16 * 16 + quadc * 4 + jj) * 384 + (2 * j + par) * 16 + l15c] = C[j][jj];
    if (c.tid < 384) NST[c.tid] = nold[c.tid];
}

__device__ __forceinline__ void phase_a3(const P& p, const Ctx& c, int seg) {
    const bf16_t* P0 = (const bf16_t*)(c.seg + S0_P0); const bf16_t* HR = (const bf16_t*)(c.seg + S0_HRAW); const bf16_t* XC = (const bf16_t*)(c.seg + S0_XC);
    const bf16_t* YM = (const bf16_t*)(c.seg + S0_YMEM); bf16_t* Y = (bf16_t*)(c.seg + S0_Y); bf16_t* UT = (bf16_t*)(p.ws + OFF_UTAIL);
#pragma unroll 1
    for (int r = c.bid * 8 + c.wv; r < MS; r += c.G * 8) {
        const int b = r >> 9, tl = r & 511;
        float v[3][8]; float mean[3], rstd[3];
#pragma unroll
        for (int ps = 0; ps < 3; ++ps) { const int ch = ps * 512 + c.lane * 8;
            const u32x4 hr = *(const u32x4*)(HR + (size_t)r * DMIX + ch);
            v[ps][0] = bflo(hr.x); v[ps][1] = bfhi(hr.x); v[ps][2] = bflo(hr.y); v[ps][3] = bfhi(hr.y); v[ps][4] = bflo(hr.z); v[ps][5] = bfhi(hr.z); v[ps][6] = bflo(hr.w); v[ps][7] = bfhi(hr.w); }
        float hs[4], hq[4];
#pragma unroll
        for (int hd = 0; hd < 4; ++hd) { float s = 0.f, q = 0.f;
#pragma unroll
            for (int ps = 0; ps < 3; ++ps) { if (ps * 512 + 511 < hd * 384 || ps * 512 >= (hd + 1) * 384) continue;
                const bool mine = ((ps * 512 + c.lane * 8) / 384) == hd;
                float ls = 0.f, lq = 0.f;
#pragma unroll
                for (int j = 0; j < 8; ++j) { ls += v[ps][j]; lq += v[ps][j] * v[ps][j]; }
                s += mine ? ls : 0.f; q += mine ? lq : 0.f; }
            hs[hd] = wsum(s); hq[hd] = wsum(q); }
#pragma unroll
        for (int ps = 0; ps < 3; ++ps) { const int hd = (ps * 512 + c.lane * 8) / 384;
            const float s = hd == 0 ? hs[0] : (hd == 1 ? hs[1] : (hd == 2 ? hs[2] : hs[3])), q = hd == 0 ? hq[0] : (hd == 1 ? hq[1] : (hd == 2 ? hq[2] : hq[3]));
            const float m = s * (1.0f / 384.0f); mean[ps] = m; rstd[ps] = rsqrtf(fmaxf(q * (1.0f / 384.0f) - m * m, 0.f) + 1e-5f); }
#pragma unroll
        for (int ps = 0; ps < 3; ++ps) { const int ch = ps * 512 + c.lane * 8;
            const u32x4 xr = *(const u32x4*)(XC + (size_t)r * DMIX + ch), zr = *(const u32x4*)(P0 + (size_t)r * ML_W + 2048 + ch);
            const f32x4 g0 = *(const f32x4*)(p.ml_mhn_g + ch), g1 = *(const f32x4*)(p.ml_mhn_g + ch + 4), k0 = *(const f32x4*)(p.ml_skip + ch), k1 = *(const f32x4*)(p.ml_skip + ch + 4);
            const float xx[8] = {bflo(xr.x), bfhi(xr.x), bflo(xr.y), bfhi(xr.y), bflo(xr.z), bfhi(xr.z), bflo(xr.w), bfhi(xr.w)};
            const float zz[8] = {bflo(zr.x), bfhi(zr.x), bflo(zr.y), bfhi(zr.y), bflo(zr.z), bfhi(zr.z), bflo(zr.w), bfhi(zr.w)};
            const float gg[8] = {g0[0], g0[1], g0[2], g0[3], g1[0], g1[1], g1[2], g1[3]}, kk[8] = {k0[0], k0[1], k0[2], k0[3], k1[0], k1[1], k1[2], k1[3]};
            float y[8];
#pragma unroll
            for (int j = 0; j < 8; ++j) y[j] = ((v[ps][j] - mean[ps]) * rstd[ps] * gg[j] + kk[j] * xx[j]) * siluf_(zz[j]);
            *(u32x4*)(Y + (size_t)r * DIN + ch) = (u32x4){pk2(y[0], y[1]), pk2(y[2], y[3]), pk2(y[4], y[5]), pk2(y[6], y[7])}; }
        { const int cm = c.lane * 8; const u32x4 mr = *(const u32x4*)(YM + (size_t)r * DX + cm), zr = *(const u32x4*)(P0 + (size_t)r * ML_W + 2048 + DMIX + cm);
          const float mm[8] = {bflo(mr.x), bfhi(mr.x), bflo(mr.y), bfhi(mr.y), bflo(mr.z), bfhi(mr.z), bflo(mr.w), bfhi(mr.w)};
          const float zz[8] = {bflo(zr.x), bfhi(zr.x), bflo(zr.y), bfhi(zr.y), bflo(zr.z), bfhi(zr.z), bflo(zr.w), bfhi(zr.w)};
          float y[8];
#pragma unroll
          for (int j = 0; j < 8; ++j) y[j] = mm[j] * siluf_(zz[j]);
          *(u32x4*)(Y + (size_t)r * DIN + DMIX + cm) = (u32x4){pk2(y[0], y[1]), pk2(y[2], y[3]), pk2(y[4], y[5]), pk2(y[6], y[7])}; }
        if (tl >= 509) {
#pragma unroll
            for (int ps = 0; ps < 3; ++ps) { const int ch = ps * 512 + c.lane * 8; *(u32x4*)(UT + (size_t)(b * 3 + tl - 509) * DMIX + ch) = *(const u32x4*)(P0 + (size_t)r * ML_W + ch); } }
    }
}

__device__ __forceinline__ void phase_b1(const P& p, const Ctx& c, int seg) {
    const bf16_t* P1 = (const bf16_t*)(c.seg + S1_P1);
    float* GTB = (float*)(c.seg + S1_W); bf16_t* SA = (bf16_t*)(c.seg + S1_A); bf16_t* SB = (bf16_t*)(c.seg + S1_B); bf16_t* SK = (bf16_t*)(c.seg + S1_K);
    bf16_t* SQ = (bf16_t*)(c.seg + S1_Q); bf16_t* SV = (bf16_t*)(c.seg + S1_V); bf16_t* SG = (bf16_t*)(c.seg + S1_G); float* BRKR = (float*)(c.seg + S1_BRKR);
    const bf16_t* VF = (const bf16_t*)(p.ws + OFF_VF); const bf16_t* LT = (const bf16_t*)(p.ws + OFF_LORAT);
    const bf16_t* PTr = (const bf16_t*)(p.ws + OFF_PTAIL) + (size_t)(seg & 1) * NB * RW_SHIFT; bf16_t* PTw = (bf16_t*)(p.ws + OFF_PTAIL) + (size_t)((seg + 1) & 1) * NB * RW_SHIFT;
    LAS bf16_t* XA = (LAS bf16_t*)c.lds;
    const int l15 = c.lane & 15, quad = c.lane >> 4;
    for (int it = c.bid; it < MS / 16; it += c.G) {
        const int r0 = it * 16, b = r0 >> 9, tl0 = r0 & 511;
        __syncthreads();
        for (int e = c.tid; e < 16 * 288; e += 512) { const int row = e / 288, cc = e % 288, col = 4608 + cc;
            const float cur = bf2f(P1[(size_t)(r0 + row) * P1W + col]);
            float prev = 0.f; if (tl0 + row > 0) prev = bf2f(P1[(size_t)(r0 + row - 1) * P1W + col]); else if (seg > 0) prev = bf2f(PTr[(size_t)b * RW_SHIFT + col]);
            const float pv = cur + p.rw_mu[col] * (prev - cur);
            const float f = cc < 64 ? tanhf(pv) : (cc < 160 ? pv : sigmoidf_(pv));
            XA[row * 296 + cc] = f2bf(f); }
        __syncthreads();
        bf16x8 xf[9];
#pragma unroll
        for (int k = 0; k < 9; ++k) xf[k] = *(const LAS bf16x8*)(XA + l15 * 296 + k * 32 + quad * 8);
        const size_t row = (size_t)r0 + l15; const int tl = tl0 + l15;
        const bf16_t* curp = P1 + row * P1W; const bf16_t* prevp = (tl > 0) ? (P1 + (row - 1) * P1W) : (PTr + (size_t)b * RW_SHIFT); const bool hasprev = (tl > 0) || (seg > 0);
        struct TileIn { u32x2 cr, ck, cv, pr, pk, pv, vf; };
        struct TilePar { f32x4 m0, m1, m2, w0, a0, v0, kkw, kaw, rk; };
#pragma unroll 1
        for (int x = 0; x < 3; ++x) {
            int hh = c.wv * 3 + x; asm volatile("" : "+s"(hh));
            auto load_tile = [&](int ct, TileIn& T) { const int cc = hh * 64 + ct * 16 + quad * 4;
                T.cr = *(const u32x2*)(curp + cc); T.ck = *(const u32x2*)(curp + DMIX + cc); T.cv = *(const u32x2*)(curp + 2 * DMIX + cc);
                T.pr = (u32x2){0u, 0u}; T.pk = T.pr; T.pv = T.pr;
                if (hasprev) { T.pr = *(const u32x2*)(prevp + cc); T.pk = *(const u32x2*)(prevp + DMIX + cc); T.pv = *(const u32x2*)(prevp + 2 * DMIX + cc); }
                T.vf = *(const u32x2*)(VF + row * DMIX + cc); };
            TileIn TA, TB2;
            load_tile(0, TA);
            float inv;
            { u32x2 kcur[4], kprv[4]; f32x4 km[4], kw[4];
#pragma unroll
              for (int ct = 0; ct < 4; ++ct) { const int cc = hh * 64 + ct * 16 + quad * 4;
                  kcur[ct] = *(const u32x2*)(curp + DMIX + cc); kprv[ct] = (u32x2){0u, 0u}; if (hasprev) kprv[ct] = *(const u32x2*)(prevp + DMIX + cc);
                  km[ct] = *(const f32x4*)(p.rw_mu + DMIX + cc); kw[ct] = *(const f32x4*)(p.rw_k_k + cc); }
              float ss = 0.f;
#pragma unroll
              for (int ct = 0; ct < 4; ++ct) {
                  const float cb[4] = {bflo(kcur[ct].x), bfhi(kcur[ct].x), bflo(kcur[ct].y), bfhi(kcur[ct].y)}, qb[4] = {bflo(kprv[ct].x), bfhi(kprv[ct].x), bflo(kprv[ct].y), bfhi(kprv[ct].y)};
#pragma unroll
                  for (int j = 0; j < 4; ++j) { const float kr = (cb[j] + km[ct][j] * (qb[j] - cb[j])) * kw[ct][j]; ss += kr * kr; } }
              ss += __shfl_xor(ss, 16); ss += __shfl_xor(ss, 32);
              inv = 1.0f / fmaxf(sqrtf(ss), 1e-12f); }
            float br = 0.f, kr = 0.f, rkr = 0.f;
            auto do_tile = [&](int ct, const TileIn& TI) { const int cc = hh * 64 + ct * 16 + quad * 4;
                TilePar T; T.m0 = *(const f32x4*)(p.rw_mu + cc); T.m1 = *(const f32x4*)(p.rw_mu + DMIX + cc); T.m2 = *(const f32x4*)(p.rw_mu + 2 * DMIX + cc);
                T.w0 = *(const f32x4*)(p.rw_w0 + cc); T.a0 = *(const f32x4*)(p.rw_a0 + cc); T.v0 = *(const f32x4*)(p.rw_v0 + cc); T.kkw = *(const f32x4*)(p.rw_k_k + cc); T.kaw = *(const f32x4*)(p.rw_k_a + cc);
                T.rk = *(const f32x4*)(p.rw_r_k + cc);
                bf16x8 lt[9]; { const bf16_t* lrow = LT + (size_t)(hh * 64 + ct * 16 + l15) * 288 + quad * 8;
#pragma unroll
                    for (int k = 0; k < 9; ++k) lt[k] = *(const bf16x8*)(lrow + k * 32); }
                f32x4 dw = (f32x4){0.f, 0.f, 0.f, 0.f}, da = dw, dv = dw, dg = dw;
#pragma unroll
                for (int k = 0; k < 2; ++k) dw = mfma16(lt[k], xf[k], dw);
#pragma unroll
                for (int k = 0; k < 2; ++k) da = mfma16(lt[2 + k], xf[2 + k], da);
                dv = mfma16(lt[4], xf[4], dv);
#pragma unroll
                for (int k = 0; k < 4; ++k) dg = mfma16(lt[5 + k], xf[5 + k], dg);
                const float ca[4] = {bflo(TI.cr.x), bfhi(TI.cr.x), bflo(TI.cr.y), bfhi(TI.cr.y)}, cb[4] = {bflo(TI.ck.x), bfhi(TI.ck.x), bflo(TI.ck.y), bfhi(TI.ck.y)}, cd[4] = {bflo(TI.cv.x), bfhi(TI.cv.x), bflo(TI.cv.y), bfhi(TI.cv.y)};
                const float qa[4] = {bflo(TI.pr.x), bfhi(TI.pr.x), bflo(TI.pr.y), bfhi(TI.pr.y)}, qb[4] = {bflo(TI.pk.x), bfhi(TI.pk.x), bflo(TI.pk.y), bfhi(TI.pk.y)}, qd[4] = {bflo(TI.pv.x), bfhi(TI.pv.x), bflo(TI.pv.y), bfhi(TI.pv.y)};
                const float vf[4] = {bflo(TI.vf.x), bfhi(TI.vf.x), bflo(TI.vf.y), bfhi(TI.vf.y)};
                u32x2 gw; gw.x = pk2(dg[0], dg[1]); gw.y = pk2(dg[2], dg[3]); *(u32x2*)(SG + row * DMIX + cc) = gw;
                float wv4[4], av[4], bv[4], ktv[4], qv[4], vv[4];
#pragma unroll
                for (int j = 0; j < 4; ++j) {
                    const float rc = ca[j] + T.m0[j] * (qa[j] - ca[j]), kc = cb[j] + T.m1[j] * (qb[j] - cb[j]), vc = cd[j] + T.m2[j] * (qd[j] - cd[j]);
                    const float zz = -(T.w0[j] + dw[j]); const float sp = fmaxf(zz, 0.f) + __logf(1.0f + __expf(-fabsf(zz)));
                    wv4[j] = __expf(-__expf(-sp - 0.5f));
                    const float a = sigmoidf_(T.a0[j] + da[j]);
                    vv[j] = vc + (vf[j] - vc) * sigmoidf_(T.v0[j] + dv[j]);
                    const float kk = kc * T.kkw[j] * inv; av[j] = -kk; bv[j] = kk * a;
                    ktv[j] = kc * (1.0f + (a - 1.0f) * T.kaw[j]); qv[j] = rc;
                    br += bv[j] * rc; kr += ktv[j] * rc; rkr += rc * ktv[j] * T.rk[j]; }
                float gfin[4];
#pragma unroll
                for (int j = 0; j < 4; ++j) { float g = wv4[j];
                    g *= dpp_shr_or1<1>(g); g *= dpp_shr_or1<2>(g); g *= dpp_shr_or1<4>(g); g *= dpp_shr_or1<8>(g);
                    const float gp = dpp_shr_or1<1>(g), ig = 1.0f / g;
                    av[j] *= gp; qv[j] *= g; bv[j] *= ig; ktv[j] *= ig; gfin[j] = g; }
                if (l15 == 15) *(f32x4*)(GTB + ((size_t)it * 24 + hh) * 64 + ct * 16 + quad * 4) = (f32x4){gfin[0], gfin[1], gfin[2], gfin[3]};
                u32x2 t; t.x = pk2(av[0], av[1]); t.y = pk2(av[2], av[3]); *(u32x2*)(SA + row * DMIX + cc) = t;
                t.x = pk2(bv[0], bv[1]); t.y = pk2(bv[2], bv[3]); *(u32x2*)(SB + row * DMIX + cc) = t;
                t.x = pk2(ktv[0], ktv[1]); t.y = pk2(ktv[2], ktv[3]); *(u32x2*)(SK + row * DMIX + cc) = t;
                t.x = pk2(qv[0], qv[1]); t.y = pk2(qv[2], qv[3]); *(u32x2*)(SQ + row * DMIX + cc) = t;
                t.x = pk2(vv[0], vv[1]); t.y = pk2(vv[2], vv[3]); *(u32x2*)(SV + row * DMIX + cc) = t; };
            load_tile(1, TB2); do_tile(0, TA); __builtin_amdgcn_sched_barrier(0);
            load_tile(2, TA); do_tile(1, TB2); __builtin_amdgcn_sched_barrier(0);
            load_tile(3, TB2); do_tile(2, TA); __builtin_amdgcn_sched_barrier(0);
            do_tile(3, TB2);
            br += __shfl_xor(br, 16); br += __shfl_xor(br, 32); kr += __shfl_xor(kr, 16); kr += __shfl_xor(kr, 32); rkr += __shfl_xor(rkr, 16); rkr += __shfl_xor(rkr, 32);
            if (quad == 0) *(f32x4*)(BRKR + (row * 24 + hh) * 4) = (f32x4){br, kr, rkr, 0.f};
        }
        if (tl0 == 496) { for (int e = c.tid; e < RW_SHIFT; e += 512) PTw[(size_t)b * RW_SHIFT + e] = P1[(size_t)(r0 + 15) * P1W + e]; }
    }
}

__device__ __forceinline__ void rwkv_item(const P& p, const Ctx& c, int seg, int w, bool save) {
    const int b = w / 24, hh = w % 24;
    const float* SW = (const float*)(c.seg + S1_W); const bf16_t* SA = (const bf16_t*)(c.seg + S1_A); const bf16_t* SB = (const bf16_t*)(c.seg + S1_B); const bf16_t* SK = (const bf16_t*)(c.seg + S1_K);
    const bf16_t* SQ = (const bf16_t*)(c.seg + S1_Q); const bf16_t* SV = (const bf16_t*)(c.seg + S1_V); const float* BRKR = (const float*)(c.seg + S1_BRKR);
    float* O = (float*)(c.seg + S1_O); float* RST = (float*)(p.ws + OFF_RST) + (size_t)w * 4096;
    constexpr int TB = 32, REC = 388;
    LAS float* L0 = (LAS float*)c.lds;
    const int rp = c.wv * 4 + (c.lane >> 4), cq = c.lane & 15;
    f32x2 S0a, S0b, S1a, S1b;
    if (seg > 0) { const f32x4 s0 = *(const f32x4*)(RST + (2 * rp) * 64 + cq * 4), s1 = *(const f32x4*)(RST + (2 * rp + 1) * 64 + cq * 4);
        S0a = (f32x2){s0[0], s0[1]}; S0b = (f32x2){s0[2], s0[3]}; S1a = (f32x2){s1[0], s1[1]}; S1b = (f32x2){s1[2], s1[3]}; }
    else { S0a = S0b = S1a = S1b = (f32x2){0.f, 0.f}; }
    const int e4 = c.tid * 4, stt = e4 >> 6, scc = e4 & 63;
    f32x4 gw; u32x2 ga, gb, gk, gq, gv; f32x4 gbr;
    auto gload = [&](int blk) { const size_t go = ((size_t)b * SEGT + blk * TB + stt) * DMIX + hh * 64 + scc;
        gw = *(const f32x4*)(SW + go); ga = *(const u32x2*)(SA + go); gb = *(const u32x2*)(SB + go); gk = *(const u32x2*)(SK + go); gq = *(const u32x2*)(SQ + go); gv = *(const u32x2*)(SV + go);
        if (c.tid < TB) gbr = *(const f32x4*)(BRKR + (((size_t)b * SEGT + blk * TB + c.tid) * 24 + hh) * 4); };
    auto lstore = [&](int buf) { LAS float* r = L0 + buf * (TB * REC) + stt * REC + scc;
        *(LAS f32x4*)(r) = gw; *(LAS f32x4*)(r + 64) = (f32x4){bflo(ga.x), bfhi(ga.x), bflo(ga.y), bfhi(ga.y)}; *(LAS f32x4*)(r + 128) = (f32x4){bflo(gb.x), bfhi(gb.x), bflo(gb.y), bfhi(gb.y)};
        *(LAS f32x4*)(r + 192) = (f32x4){bflo(gk.x), bfhi(gk.x), bflo(gk.y), bfhi(gk.y)}; *(LAS f32x4*)(r + 256) = (f32x4){bflo(gq.x), bfhi(gq.x), bflo(gq.y), bfhi(gq.y)};
        *(LAS f32x4*)(r + 320) = (f32x4){bflo(gv.x), bfhi(gv.x), bflo(gv.y), bfhi(gv.y)};
        if (c.tid < TB) { LAS float* q = L0 + buf * (TB * REC) + c.tid * REC + 384; *(LAS f32x2*)q = (f32x2){gbr[0], gbr[1]}; } };
    __syncthreads();
    gload(0); lstore(0);
    __syncthreads();
#pragma unroll 1
    for (int blk = 0; blk < SEGT / TB; ++blk) {
        const int buf = blk & 1;
        if (blk + 1 < SEGT / TB) gload(blk + 1);
        const LAS float* base = L0 + buf * (TB * REC);
        const size_t rowb = (size_t)b * SEGT + blk * TB;
        f32x4 nw4 = *(const LAS f32x4*)(base + cq * 4), na4 = *(const LAS f32x4*)(base + 64 + cq * 4), nb4 = *(const LAS f32x4*)(base + 128 + cq * 4), nk4 = *(const LAS f32x4*)(base + 192 + cq * 4), nq4 = *(const LAS f32x4*)(base + 256 + cq * 4);
        f32x2 nv2 = *(const LAS f32x2*)(base + 320 + 2 * rp), nbk = *(const LAS f32x2*)(base + 384);
#pragma unroll 2
        for (int tt = 0; tt < TB; ++tt) {
            const f32x4 w4 = nw4, a4 = na4, b4 = nb4, k4 = nk4, q4 = nq4; const f32x2 v2 = nv2, bk = nbk;
            { const LAS float* r = base + (tt + 1 < TB ? tt + 1 : tt) * REC;
              nw4 = *(const LAS f32x4*)(r + cq * 4); na4 = *(const LAS f32x4*)(r + 64 + cq * 4); nb4 = *(const LAS f32x4*)(r + 128 + cq * 4); nk4 = *(const LAS f32x4*)(r + 192 + cq * 4); nq4 = *(const LAS f32x4*)(r + 256 + cq * 4);
              nv2 = *(const LAS f32x2*)(r + 320 + 2 * rp); nbk = *(const LAS f32x2*)(r + 384); }
            const f32x2 wa = (f32x2){w4[0], w4[1]}, wb = (f32x2){w4[2], w4[3]}, aa = (f32x2){a4[0], a4[1]}, ab = (f32x2){a4[2], a4[3]}, ba = (f32x2){b4[0], b4[1]}, bb = (f32x2){b4[2], b4[3]};
            const f32x2 ka = (f32x2){k4[0], k4[1]}, kb = (f32x2){k4[2], k4[3]}, qa = (f32x2){q4[0], q4[1]}, qb = (f32x2){q4[2], q4[3]};
            f32x2 t0 = S0a * aa + S0b * ab, t1 = S0a * qa + S0b * qb, t2 = S1a * aa + S1b * ab, t3 = S1a * qa + S1b * qb;
            float pa0 = t0.x + t0.y, pt0 = t1.x + t1.y, pa1 = t2.x + t2.y, pt1 = t3.x + t3.y;
            row16_allsum4(pa0, pa1, pt0, pt1);
            const f32x2 pa0v = (f32x2){pa0, pa0}, pa1v = (f32x2){pa1, pa1}, v0v = (f32x2){v2.x, v2.x}, v1v = (f32x2){v2.y, v2.y};
            S0a = S0a * wa + pa0v * ba + v0v * ka; S0b = S0b * wb + pa0v * bb + v0v * kb;
            S1a = S1a * wa + pa1v * ba + v1v * ka; S1b = S1b * wb + pa1v * bb + v1v * kb;
            if (cq == 0) { const f32x2 y = (f32x2){pt0 + pa0 * bk.x + v2.x * bk.y, pt1 + pa1 * bk.x + v2.y * bk.y};
                *(f32x2*)(O + (rowb + tt) * DMIX + hh * 64 + 2 * rp) = y; }
        }
        if (blk + 1 < SEGT / TB) lstore(buf ^ 1);
        __syncthreads();
    }
    if (!save) return;
    *(f32x4*)(RST + (2 * rp) * 64 + cq * 4) = (f32x4){S0a.x, S0a.y, S0b.x, S0b.y}; *(f32x4*)(RST + (2 * rp + 1) * 64 + cq * 4) = (f32x4){S1a.x, S1a.y, S1b.x, S1b.y};
}

__device__ __forceinline__ void rwkv_chunk_item(const P& p, const Ctx& c, int seg, int w, bool save) {
    const int b = w / 24, hh = w % 24;
    const bf16_t* SA = (const bf16_t*)(c.seg + S1_A); const bf16_t* SB = (const bf16_t*)(c.seg + S1_B); const bf16_t* SK = (const bf16_t*)(c.seg + S1_K);
    const bf16_t* SR = (const bf16_t*)(c.seg + S1_Q); const bf16_t* SV = (const bf16_t*)(c.seg + S1_V); const float* GTB = (const float*)(c.seg + S1_W);
    bf16_t* O = (bf16_t*)(c.seg + S1_O); float* RST = (float*)(p.ws + OFF_RST) + (size_t)w * 4096;
    constexpr int O_EA = 0  , O_EB = 4608  , O_EBT = 9216  , O_UV = 14336  ,
                  O_MT1 = 19456  , O_NT = 20736  , O_MABT = 22016  ,
                  O_GT = 23296  , OPB = 23552;
    LAS unsigned char* OB = c.lds;
    LAS bf16_t* S0I = (LAS bf16_t*)(c.lds + 2 * OPB);
    LAS float* XF = (LAS float*)(c.lds + 2 * OPB + 9216);
    const int l15c = c.lane & 15, quadc = c.lane >> 4;
    f32x4 S[2];
#pragma unroll
    for (int x = 0; x < 2; ++x) { const int ti = c.wv * 2 + x, mt = ti >> 2, nt = ti & 3;
#pragma unroll
        for (int jj = 0; jj < 4; ++jj) S[x][jj] = (seg > 0) ? RST[(mt * 16 + quadc * 4 + jj) * 64 + nt * 16 + l15c] : 0.f; }
    unsigned ga = 0, gb = 0, gk = 0, gr = 0, gv = 0; float gg = 1.f;
    auto gload = [&](int ch, int tidv) { const int t = tidv >> 5, j0 = (tidv & 31) * 2; const size_t go = ((size_t)b * SEGT + ch * 16 + t) * DMIX + hh * 64 + j0;
        ga = *(const unsigned*)(SA + go); gb = *(const unsigned*)(SB + go); gk = *(const unsigned*)(SK + go); gr = *(const unsigned*)(SR + go); gv = *(const unsigned*)(SV + go);
        if (tidv < 64) gg = GTB[((size_t)(b * 32 + ch) * 24 + hh) * 64 + tidv]; };
    auto lstore = [&](int pb, int tidv) { const int t = tidv >> 5, j0 = (tidv & 31) * 2;
        LAS bf16_t* EA = (LAS bf16_t*)(OB + pb * OPB + O_EA); LAS bf16_t* EB = (LAS bf16_t*)(OB + pb * OPB + O_EB); LAS bf16_t* EBT = (LAS bf16_t*)(OB + pb * OPB + O_EBT);
        LAS bf16_t* UV = (LAS bf16_t*)(OB + pb * OPB + O_UV); LAS float* GT = (LAS float*)(OB + pb * OPB + O_GT);
        *(LAS unsigned*)(EA + t * 72 + j0) = ga; *(LAS unsigned*)(EA + (16 + t) * 72 + j0) = gr;
        *(LAS unsigned*)(EB + t * 72 + j0) = gb; *(LAS unsigned*)(EB + (16 + t) * 72 + j0) = gk;
        EBT[j0 * 40 + t] = (bf16_t)(gb & 0xFFFFu); EBT[(j0 + 1) * 40 + t] = (bf16_t)(gb >> 16); EBT[j0 * 40 + 16 + t] = (bf16_t)(gk & 0xFFFFu); EBT[(j0 + 1) * 40 + 16 + t] = (bf16_t)(gk >> 16);
        UV[j0 * 40 + 16 + t] = (bf16_t)(gv & 0xFFFFu); UV[(j0 + 1) * 40 + 16 + t] = (bf16_t)(gv >> 16); UV[j0 * 40 + t] = 0; UV[(j0 + 1) * 40 + t] = 0;
        if (tidv < 64) GT[tidv] = gg; };
    auto gtile = [&](int pb, int l15, int quad) {
        LAS bf16_t* EA = (LAS bf16_t*)(OB + pb * OPB + O_EA); LAS bf16_t* EB = (LAS bf16_t*)(OB + pb * OPB + O_EB);
        LAS bf16_t* MT1 = (LAS bf16_t*)(OB + pb * OPB + O_MT1); LAS bf16_t* NT = (LAS bf16_t*)(OB + pb * OPB + O_NT); LAS float* MABT = (LAS float*)(OB + pb * OPB + O_MABT);
        const int sb = c.wv >> 1, tb = c.wv & 1; f32x4 g = (f32x4){0.f, 0.f, 0.f, 0.f};
#pragma unroll
        for (int kk = 0; kk < 2; ++kk) g = mfma16(*(const LAS bf16x8*)(EB + (sb * 16 + l15) * 72 + kk * 32 + quad * 8), *(const LAS bf16x8*)(EA + (tb * 16 + l15) * 72 + kk * 32 + quad * 8), g);
#pragma unroll
        for (int jj = 0; jj < 4; ++jj) { const int s2 = quad * 4 + jj, tt = l15; const float v = g[jj];
            if (tb == 0) { const float m = (s2 < tt) ? v : 0.f; if (sb == 0) { MABT[tt * 20 + s2] = m; MT1[tt * 40 + s2] = 0; } else MT1[tt * 40 + 16 + s2] = f2bf(m); }
            else { const float m = (s2 <= tt) ? v : 0.f; NT[tt * 40 + sb * 16 + s2] = f2bf(m); } } };
    auto simg = [&](int l15, int quad) {
#pragma unroll
        for (int x = 0; x < 2; ++x) { const int ti = c.wv * 2 + x, mt = ti >> 2, nt = ti & 3;
#pragma unroll
            for (int jj = 0; jj < 4; ++jj) S0I[(mt * 16 + quad * 4 + jj) * 72 + nt * 16 + l15] = f2bf(S[x][jj]); } };
    __syncthreads();
    { int t0 = c.tid; asm volatile("" : "+v"(t0)); gload(0, t0); lstore(0, t0); simg(l15c, quadc); }
    lds_barrier();
    if (c.wv < 4) gtile(0, l15c, quadc);
    { int t1 = c.tid; asm volatile("" : "+v"(t1)); gload(1, t1); }
    const int mtq = c.wv & 3;
#pragma unroll 1
    for (int ch = 0; ch < SEGT / 16; ++ch) {
        const int pb = ch & 1;
        int tidv = c.tid, l15 = l15c, quad = quadc; asm volatile("" : "+v"(tidv), "+v"(l15), "+v"(quad));
        LAS bf16_t* EA = (LAS bf16_t*)(OB + pb * OPB + O_EA); LAS bf16_t* EBT = (LAS bf16_t*)(OB + pb * OPB + O_EBT); LAS bf16_t* UV = (LAS bf16_t*)(OB + pb * OPB + O_UV);
        LAS bf16_t* MT1 = (LAS bf16_t*)(OB + pb * OPB + O_MT1); LAS bf16_t* NT = (LAS bf16_t*)(OB + pb * OPB + O_NT); LAS float* MABT = (LAS float*)(OB + pb * OPB + O_MABT); LAS float* GT = (LAS float*)(OB + pb * OPB + O_GT);
        lds_barrier();
        f32x4 Zt = (f32x4){0.f, 0.f, 0.f, 0.f};
        if (c.wv >= 4) {
            f32x4 Xt = (f32x4){0.f, 0.f, 0.f, 0.f};
#pragma unroll
            for (int kk = 0; kk < 2; ++kk) { const bf16x8 a = *(const LAS bf16x8*)(S0I + (mtq * 16 + l15) * 72 + kk * 32 + quad * 8);
                Xt = mfma16(a, *(const LAS bf16x8*)(EA + l15 * 72 + kk * 32 + quad * 8), Xt); Zt = mfma16(a, *(const LAS bf16x8*)(EA + (16 + l15) * 72 + kk * 32 + quad * 8), Zt); }
            Xt = mfma16(*(const LAS bf16x8*)(UV + (mtq * 16 + l15) * 40 + quad * 8), *(const LAS bf16x8*)(MT1 + l15 * 40 + quad * 8), Xt);
#pragma unroll
            for (int jj = 0; jj < 4; ++jj) XF[(mtq * 16 + quad * 4 + jj) * 17 + l15] = Xt[jj];
        }
        lds_barrier();
        if (ch + 1 < SEGT / 16) lstore(pb ^ 1, tidv);
        if (ch + 2 < SEGT / 16) gload(ch + 2, tidv);
        if (c.wv == 0) {
            float u[16];
#pragma unroll
            for (int tt = 0; tt < 16; ++tt) { float acc = XF[c.lane * 17 + tt];
#pragma unroll
                for (int s4 = 0; s4 < (tt + 3) / 4; ++s4) { const f32x4 m = *(const LAS f32x4*)(MABT + tt * 20 + s4 * 4);
#pragma unroll
                    for (int e = 0; e < 4; ++e) if (s4 * 4 + e < tt) acc += u[s4 * 4 + e] * m[e]; }
                u[tt] = acc; }
            *(LAS u32x4*)(UV + c.lane * 40) = (u32x4){pk2(u[0], u[1]), pk2(u[2], u[3]), pk2(u[4], u[5]), pk2(u[6], u[7])};
            *(LAS u32x4*)(UV + c.lane * 40 + 8) = (u32x4){pk2(u[8], u[9]), pk2(u[10], u[11]), pk2(u[12], u[13]), pk2(u[14], u[15])};
        }
        lds_barrier();
        if (c.wv >= 4) {
            Zt = mfma16(*(const LAS bf16x8*)(UV + (mtq * 16 + l15) * 40 + quad * 8), *(const LAS bf16x8*)(NT + l15 * 40 + quad * 8), Zt);
            *(u32x2*)(O + ((size_t)b * SEGT + ch * 16 + l15) * DMIX + hh * 64 + mtq * 16 + quad * 4) = (u32x2){pk2(Zt[0], Zt[1]), pk2(Zt[2], Zt[3])};
        }
#pragma unroll
        for (int x = 0; x < 2; ++x) { const int ti = c.wv * 2 + x, mt = ti >> 2, nt = ti & 3;
            S[x] = mfma16(*(const LAS bf16x8*)(UV + (mt * 16 + l15) * 40 + quad * 8), *(const LAS bf16x8*)(EBT + (nt * 16 + l15) * 40 + quad * 8), S[x]);
            const float gt = GT[nt * 16 + l15];
#pragma unroll
            for (int jj = 0; jj < 4; ++jj) S[x][jj] *= gt; }
        simg(l15, quad);
        if (c.wv < 4 && ch + 1 < SEGT / 16) gtile(pb ^ 1, l15, quad);
    }
    if (!save) return;
#pragma unroll
    for (int x = 0; x < 2; ++x) { const int ti = c.wv * 2 + x, mt = ti >> 2, nt = ti & 3;
#pragma unroll
        for (int jj = 0; jj < 4; ++jj) RST[(mt * 16 + quadc * 4 + jj) * 64 + nt * 16 + l15c] = S[x][jj]; }
}

__device__ __forceinline__ void phase_b3(const P& p, const Ctx& c) {
    const bf16_t* O = (const bf16_t*)(c.seg + S1_O); const bf16_t* P2 = (const bf16_t*)(c.seg + S1_P2); const bf16_t* SV = (const bf16_t*)(c.seg + S1_V); const bf16_t* SG = (const bf16_t*)(c.seg + S1_G);
    const float* BRKR = (const float*)(c.seg + S1_BRKR); const bf16_t* YM = (const bf16_t*)(c.seg + S1_YMEM); bf16_t* Y = (bf16_t*)(c.seg + S1_Y);
    for (int r = c.bid * 8 + c.wv; r < MS; r += c.G * 8) {
#pragma unroll
        for (int ps = 0; ps < 3; ++ps) {
            const int hh = ps * 8 + (c.lane >> 3), ch = hh * 64 + (c.lane & 7) * 8;
            const u32x4 orr = *(const u32x4*)(O + (size_t)r * DMIX + ch);
            float v[8] = {bflo(orr.x), bfhi(orr.x), bflo(orr.y), bfhi(orr.y), bflo(orr.z), bfhi(orr.z), bflo(orr.w), bfhi(orr.w)}; float s = 0.f, s2 = 0.f;
#pragma unroll
            for (int j = 0; j < 8; ++j) { s += v[j]; s2 += v[j] * v[j]; }
            s += __shfl_xor(s, 1); s2 += __shfl_xor(s2, 1); s += __shfl_xor(s, 2); s2 += __shfl_xor(s2, 2); s += __shfl_xor(s, 4); s2 += __shfl_xor(s2, 4);
            const float mean = s * (1.0f / 64.0f), var = fmaxf(s2 * (1.0f / 64.0f) - mean * mean, 0.f), rs = rsqrtf(var + 64e-5f);
            const float rkr = BRKR[((size_t)r * 24 + hh) * 4 + 2];
            const u32x4 vr = *(const u32x4*)(SV + (size_t)r * DMIX + ch), gr = *(const u32x4*)(SG + (size_t)r * DMIX + ch), zr = *(const u32x4*)(P2 + (size_t)r * P2W + 512 + ch);
            const float vv[8] = {bflo(vr.x), bfhi(vr.x), bflo(vr.y), bfhi(vr.y), bflo(vr.z), bfhi(vr.z), bflo(vr.w), bfhi(vr.w)};
            const float gg[8] = {bflo(gr.x), bfhi(gr.x), bflo(gr.y), bfhi(gr.y), bflo(gr.z), bfhi(gr.z), bflo(gr.w), bfhi(gr.w)};
            const float zz[8] = {bflo(zr.x), bfhi(zr.x), bflo(zr.y), bfhi(zr.y), bflo(zr.z), bfhi(zr.z), bflo(zr.w), bfhi(zr.w)};
            float y[8];
#pragma unroll
            for (int j = 0; j < 8; ++j) { const float t = ((v[j] - mean) * rs * p.rw_lnx_g[ch + j] + p.rw_lnx_b[ch + j] + rkr * vv[j]) * gg[j]; y[j] = t * siluf_(zz[j]); }
            *(u32x4*)(Y + (size_t)r * DIN + ch) = (u32x4){pk2(y[0], y[1]), pk2(y[2], y[3]), pk2(y[4], y[5]), pk2(y[6], y[7])};
        }
        { const int cm = c.lane * 8; const u32x4 mr = *(const u32x4*)(YM + (size_t)r * DX + cm), zr = *(const u32x4*)(P2 + (size_t)r * P2W + 512 + DMIX + cm);
          const float mm[8] = {bflo(mr.x), bfhi(mr.x), bflo(mr.y), bfhi(mr.y), bflo(mr.z), bfhi(mr.z), bflo(mr.w), bfhi(mr.w)};
          const float zz[8] = {bflo(zr.x), bfhi(zr.x), bflo(zr.y), bfhi(zr.y), bflo(zr.z), bfhi(zr.z), bflo(zr.w), bfhi(zr.w)};
          float y[8];
#pragma unroll
          for (int j = 0; j < 8; ++j) y[j] = mm[j] * siluf_(zz[j]);
          *(u32x4*)(Y + (size_t)r * DIN + DMIX + cm) = (u32x4){pk2(y[0], y[1]), pk2(y[2], y[3]), pk2(y[4], y[5]), pk2(y[6], y[7])}; }
    }
}

__device__ __forceinline__ bool fresh_ctx(Ctx& c, P& p, unsigned char* ws0) { int t = threadIdx.x; asm volatile("" : "+v"(t)); c.tid = t; c.wv = __builtin_amdgcn_readfirstlane(t >> 6); c.lane = t & 63;
    int bb = (int)blockIdx.x, gg = (int)gridDim.x; asm volatile("" : "+s"(bb), "+s"(gg)); c.bid = bb; c.G = gg;
#if defined(__HIP_DEVICE_COMPILE__)
    { typedef const __attribute__((address_space(4))) unsigned long long* KP; KP kp = (KP)__builtin_amdgcn_kernarg_segment_ptr(); asm volatile("" : "+s"(kp));
      typedef __attribute__((address_space(1))) char* GP; char** dst = (char**)&p;
#pragma unroll
      for (int i = 0; i < (int)(sizeof(P) / 8); ++i) dst[i] = (char*)(GP)(kp[i]); }
#endif
    size_t z = 0; asm volatile("" : "+s"(z)); p.ws = ws0 + z; c.seg = ws0 + z + OFF_SEG;
    return true; }
__global__ __launch_bounds__(512) void fwd_megakernel(P p_arg) {
    P p = p_arg;
    extern __shared__ __attribute__((aligned(16))) unsigned char shm[];
    LAS unsigned char* lds = (LAS unsigned char*)shm;
    Ctx c; c.tid = threadIdx.x; c.wv = threadIdx.x >> 6; c.lane = threadIdx.x & 63; c.G = gridDim.x; c.bid = blockIdx.x; c.lds = lds; c.seg = p.ws + OFF_SEG;
    volatile LAS unsigned* st = (volatile LAS unsigned*)(lds + LDS_BYTES - 16);
    if (c.tid == 0) { st[0] = 0u; st[1] = 0u; }
    __syncthreads();
    const XcdBarrier xb = xcd_barrier_post((unsigned*)(p.ws + OFF_BAR), st);
#define GSYNC() do { XcdBarrier _xl = xb; size_t _zz = 0; asm volatile("" : "+s"(_zz)); _xl.bar = xb.bar + _zz; _xl.x = xb_xcc_id();     \
        xcd_barrier(_xl); if (RK == 20) { for (int _q = 1; _q < RN; ++_q) xcd_barrier(_xl); } } while (0)
#ifndef RK
#define RK -1
#endif
#ifndef RN
#define RN 1
#endif
#define NREP(k) ((k) == RK ? RN : 1)
#define PH(k) for (int _r = 0; _r < NREP(k); ++_r) if (fresh_ctx(c, p, p_arg.ws))
#define LASTREP(k) (_r + 1 == NREP(k))
    PH(0) phase0(p, c);
    PH(1) phase_apre(p, c, 0, c.bid, c.G);
    GSYNC();
    for (int seg = 0; seg < NSEG; ++seg) {
        PH(2) { SchedA0 S; S.ws = p.ws; S.seg = c.seg; S.G = c.G; S.c = c.bid; S.nextra = (seg == 0) ? 64 : 0;
          pg8::gemm_phase<pg8::EpiBf, SchedA0>(lds, c.tid, 1024, 1024, S, pg8::EpiBf{}); }
        GSYNC();
        PH(3) phase_a1(p, c, seg);
        GSYNC();
        for (int it0 = c.bid; it0 < 256; it0 += c.G) {
            const int xq = it0 & 7, yq = it0 >> 3; const int it = (yq < 24) ? ((xq * 4 + yq / 6) * 6 + yq % 6) : (192 + (yq - 24) * 8 + xq);
            if (it < 192) { PH(4) mlstm_item(p, c, seg, it, LASTREP(4)); }
            else { PH(5) attn_item(p, c, 0, it - 192, (const bf16_t*)(c.seg + S0_P0) + DMIX, ML_W, (bf16_t*)(c.seg + S0_YMEM)); }
        }
        GSYNC();
        PH(6) phase_a3(p, c, seg);
        GSYNC();
        PH(7) { SchedOut S; S.Y = (const char*)(c.seg + S0_Y); S.W = (const char*)(p.ws + OFF_WO0T); S.slab = (char*)(c.seg + S0_SLAB); S.G = c.G; S.c = c.bid;
          pg8::gemm_phase<pg8::EpiBf, SchedOut>(lds, c.tid, DIN, 512, S, pg8::EpiBf{}); }
        GSYNC();
        PH(8) phase_a5(p, c, seg);
        GSYNC();
        PH(9) { SchedB0 S; S.ws = p.ws; S.seg = c.seg; S.G = c.G; S.c = c.bid;
          pg8::gemm_phase<pg8::EpiBf, SchedB0>(lds, c.tid, 1024, 1024, S, pg8::EpiBf{}); }
        GSYNC();
        PH(10) phase_b1(p, c, seg);
        GSYNC();
        for (int it = c.bid; it < 256; it += c.G) {
            if (it < 192) { PH(11) rwkv_chunk_item(p, c, seg, it, LASTREP(11)); }
            else { PH(5) attn_item(p, c, 1, it - 192, (const bf16_t*)(c.seg + S1_P2), P2W, (bf16_t*)(c.seg + S1_YMEM));
                   if (c.G == 256) { PH(1) if (seg + 1 < NSEG) phase_apre(p, c, seg + 1, it - 192, 64); } }
        }
        GSYNC();
        PH(12) phase_b3(p, c);
        GSYNC();
        PH(13) { SchedOut S; S.Y = (const char*)(c.seg + S1_Y); S.W = (const char*)(p.ws + OFF_WO1T); S.slab = (char*)(c.seg + S1_SLAB); S.G = c.G; S.c = c.bid;
          pg8::gemm_phase<pg8::EpiBf, SchedOut>(lds, c.tid, DIN, 512, S, pg8::EpiBf{}); }
        GSYNC();
        PH(14) phase_b5(p, c, seg);
        if (c.G != 256) { PH(1) if (seg + 1 < NSEG) phase_apre(p, c, seg + 1, c.bid, c.G); GSYNC(); }
    }
}

extern "C" void kernel_launch(void* const* d_in, const int* in_sizes, int n_in, void* d_out, int out_size, void* d_ws, size_t ws_size, hipStream_t stream) {
    static int grid = 0;
    if (grid == 0) {
        int dev = 0, cus = 0, per_cu = 0;
        if (hipGetDevice(&dev) != hipSuccess || hipDeviceGetAttribute(&cus, hipDeviceAttributeMultiprocessorCount, dev) != hipSuccess) { grid = -1; return; }
        if (hipFuncSetAttribute((const void*)fwd_megakernel, hipFuncAttributeMaxDynamicSharedMemorySize, LDS_BYTES) != hipSuccess) { fprintf(stderr, "hipFuncSetAttribute failed\n"); grid = -1; return; }
        if (hipOccupancyMaxActiveBlocksPerMultiprocessor(&per_cu, (const void*)fwd_megakernel, 512, LDS_BYTES) != hipSuccess || per_cu < 1) { fprintf(stderr, "occupancy query: %d\n", per_cu); }
        (void)hipGetLastError();
        grid = cus;
        if (n_in != 31 || ws_size < 256 * MiB) { fprintf(stderr, "unexpected n_in %d / ws %zu\n", n_in, ws_size); grid = -1; return; }
    }
    if (grid < 0) return;
    (void)hipMemsetAsync((char*)d_ws + OFF_BAR, 0, XCD_BAR_WORDS * 4, stream);
    P p{};
    const float** f = (const float**)&p;
    for (int i = 0; i < 31; ++i) f[i] = (const float*)d_in[i];
    p.out = (float*)d_out; p.ws = (unsigned char*)d_ws;
    fwd_megakernel<<<dim3(grid), dim3(512), LDS_BYTES, stream>>>(p);
}
```

```cpp
#include <hip/hip_runtime.h>
#include <cstdio>
#include <cstdint>

#define LAS __attribute__((address_space(3)))
typedef unsigned short bf16_t;
typedef short bf16x8 __attribute__((ext_vector_type(8)));
typedef short bf16x4 __attribute__((ext_vector_type(4)));
typedef float f32x4 __attribute__((ext_vector_type(4)));
typedef float f32x2 __attribute__((ext_vector_type(2)));
typedef unsigned u32x4 __attribute__((ext_vector_type(4)));
typedef unsigned u32x2 __attribute__((ext_vector_type(2)));

constexpr int NB = 8, SEQ = 2048, DM = 1024, NSEG = 4, SEGT = 512, MS = NB * SEGT;
constexpr int DMIX = 1536, DX = 512, DIN = 2048;
constexpr int ML_W = 4096, RW_SHIFT = 4896, RW_W = 7456;
constexpr int P1W = 5120, P2W = 2560;
constexpr size_t MiB = 1u << 20;
constexpr size_t OFF_WT0 = 0, OFF_WT1 = 8 * MiB, OFF_WO0T = 23 * MiB, OFF_WO1T = 27 * MiB, OFF_WKVT = 31 * MiB  ,
                 OFF_KMEM = 35 * MiB  , OFF_LORAT = 43 * MiB, OFF_MISC = 45 * MiB,
                 OFF_CST = 46 * MiB, OFF_NST = 65 * MiB, OFF_RST = 65 * MiB + 512 * 1024, OFF_H = 69 * MiB, OFF_VF = 77 * MiB,
                 OFF_SEG = 89 * MiB, OFF_MEMN = 248 * MiB;
constexpr size_t OFF_BAR = OFF_MISC, OFF_UTAIL = OFF_MISC + 64 * 1024, OFF_PTAIL = OFF_MISC + 256 * 1024;
constexpr size_t S0_P0 = 0, S0_Q = 32 * MiB, S0_K = 44 * MiB, S0_KT = 56 * MiB, S0_VT = 68 * MiB, S0_XC = 80 * MiB, S0_HRAW = 92 * MiB,
                 S0_YMEM = 116 * MiB, S0_Y = 120 * MiB, S0_GATE = 136 * MiB;
constexpr size_t S1_P1 = 0, S1_O = 0, S1_Y = 24 * MiB, S1_P2 = 40 * MiB, S1_W = 60 * MiB, S1_A = 84 * MiB, S1_B = 96 * MiB, S1_K = 108 * MiB,
                 S1_Q = 120 * MiB, S1_V = 132 * MiB, S1_G = 144 * MiB, S1_YMEM = 156 * MiB, S1_BRKR = 160 * MiB;
constexpr size_t S0_SLAB = 0  , S1_SLAB = 84 * MiB  ;
constexpr int LDS_BYTES = 150 * 1024;

struct P {
    const float *x, *mem, *norm_g, *mem_norm_g, *mem_kv_w, *w_out, *ml_w_in, *ml_conv_w, *ml_conv_b, *ml_wq, *ml_wk, *ml_wv, *ml_w_gate, *ml_b_gate,
        *ml_mhn_g, *ml_skip, *rw_w_in, *rw_mu, *rw_w_lora2, *rw_w0, *rw_a_lora2, *rw_a0, *rw_v_lora2, *rw_v0, *rw_g_lora2, *rw_k_k, *rw_k_a, *rw_r_k,
        *rw_lnx_g, *rw_lnx_b, *final_g;
    float* out; unsigned char* ws;
};

__device__ __forceinline__ bf16_t f2bf(float f) { unsigned u = __float_as_uint(f); u += 0x7FFFu + ((u >> 16) & 1u); return (bf16_t)(u >> 16); }
__device__ __forceinline__ float bf2f(bf16_t b) { return __uint_as_float(((unsigned)b) << 16); }
__device__ __forceinline__ unsigned pk2(float lo, float hi) { return (unsigned)f2bf(lo) | ((unsigned)f2bf(hi) << 16); }
__device__ __forceinline__ float bflo(unsigned u) { return __uint_as_float(u << 16); }
__device__ __forceinline__ float bfhi(unsigned u) { return __uint_as_float(u & 0xFFFF0000u); }
__device__ __forceinline__ float wsum(float v) {
#pragma unroll
    for (int o = 32; o >= 1; o >>= 1) v += __shfl_xor(v, o);
    return v;
}
__device__ __forceinline__ float sigmoidf_(float x) { return 1.0f / (1.0f + __expf(-x)); }
__device__ __forceinline__ float siluf_(float x) { return x / (1.0f + __expf(-x)); }
__device__ __forceinline__ float softplusf_(float z) { return fmaxf(z, 0.f) + __logf(1.0f + __expf(-fabsf(z))); }
template <int CTRL> __device__ __forceinline__ float dpp_add(float v) {
    return v + __int_as_float(__builtin_amdgcn_update_dpp(0, __float_as_int(v), CTRL, 0xF, 0xF, true));
}
__device__ __forceinline__ float row16_allsum(float v) {
    v = dpp_add<0xB1>(v);
    v = dpp_add<0x4E>(v);
    v = dpp_add<0x141>(v);
    v = dpp_add<0x140>(v);
    return v;
}
__device__ __forceinline__ void row16_allsum4(float& a, float& b, float& c, float& d) {
    asm volatile("s_nop 1\n\t"
        "v_add_f32_dpp %0, %0, %0 quad_perm:[1,0,3,2] row_mask:0xf bank_mask:0xf\n\t" "v_add_f32_dpp %1, %1, %1 quad_perm:[1,0,3,2] row_mask:0xf bank_mask:0xf\n\t"
        "v_add_f32_dpp %2, %2, %2 quad_perm:[1,0,3,2] row_mask:0xf bank_mask:0xf\n\t" "v_add_f32_dpp %3, %3, %3 quad_perm:[1,0,3,2] row_mask:0xf bank_mask:0xf\n\t"
        "v_add_f32_dpp %0, %0, %0 quad_perm:[2,3,0,1] row_mask:0xf bank_mask:0xf\n\t" "v_add_f32_dpp %1, %1, %1 quad_perm:[2,3,0,1] row_mask:0xf bank_mask:0xf\n\t"
        "v_add_f32_dpp %2, %2, %2 quad_perm:[2,3,0,1] row_mask:0xf bank_mask:0xf\n\t" "v_add_f32_dpp %3, %3, %3 quad_perm:[2,3,0,1] row_mask:0xf bank_mask:0xf\n\t"
        "v_add_f32_dpp %0, %0, %0 row_half_mirror row_mask:0xf bank_mask:0xf\n\t" "v_add_f32_dpp %1, %1, %1 row_half_mirror row_mask:0xf bank_mask:0xf\n\t"
        "v_add_f32_dpp %2, %2, %2 row_half_mirror row_mask:0xf bank_mask:0xf\n\t" "v_add_f32_dpp %3, %3, %3 row_half_mirror row_mask:0xf bank_mask:0xf\n\t"
        "v_add_f32_dpp %0, %0, %0 row_mirror row_mask:0xf bank_mask:0xf\n\t" "v_add_f32_dpp %1, %1, %1 row_mirror row_mask:0xf bank_mask:0xf\n\t"
        "v_add_f32_dpp %2, %2, %2 row_mirror row_mask:0xf bank_mask:0xf\n\t" "v_add_f32_dpp %3, %3, %3 row_mirror row_mask:0xf bank_mask:0xf\n\t"
        "s_nop 1"
        : "+v"(a), "+v"(b), "+v"(c), "+v"(d));
}
template <int N> __device__ __forceinline__ float dpp_shr_or1(float v) {
    return __int_as_float(__builtin_amdgcn_update_dpp(0x3f800000, __float_as_int(v), 0x110 + N, 0xF, 0xF, false));
}
__device__ __forceinline__ f32x4 mfma16(bf16x8 a, bf16x8 b, f32x4 c) { return __builtin_amdgcn_mfma_f32_16x16x32_bf16(a, b, c, 0, 0, 0); }

namespace pg8 {
constexpr int BM = 256, BK = 64, HALF = 128, HTB = HALF * BK * 2, STAGE_BYTES = 8 * HTB, NXCD = 8, WGM = 8;
__host__ __device__ __forceinline__ int lds_byte(int r, int c) { const int st = (r >> 4) * 2 + (c >> 5), rr = r & 15, cc = c & 31, ob = rr * 64 + cc * 2; return st * 1024 + (ob ^ (((ob >> 9) & 1) << 5)); }
__host__ __device__ __forceinline__ void stage_rc(int b, int& R, int& C) { const int st = b / 1024, sb = b % 1024, swz = sb ^ (((sb >> 9) & 1) << 5); R = (st >> 1) * 16 + swz / 64; C = (st & 1) * 32 + (swz % 64) / 2; }
__host__ __device__ __forceinline__ int perm32(int rho) { const int n = rho >> 4, i = rho & 15; return 8 * (i >> 2) + 4 * n + (i & 3); }

struct Unit { const char* A; const char* B; char* O; int ldc; int pad; };

__device__ __forceinline__ void remap(int wgid, int nM, int nN, int& pm, int& pn) {
    const int nwg = nM * nN;
    { const int q = nwg / NXCD, r = nwg % NXCD, xcd = wgid % NXCD, off = wgid / NXCD; wgid = (xcd < r ? xcd * (q + 1) : r * (q + 1) + (xcd - r) * q) + off; }
    const int nig = WGM * nN, gid = wgid / nig, fm = gid * WGM, gsz = (nM - fm) < WGM ? (nM - fm) : WGM;
    pm = fm + ((wgid % nig) % gsz); pn = (wgid % nig) / gsz;
}

struct EpiBf {
    static constexpr bool PERM = true;
    __device__ __forceinline__ void operator()(const f32x4 (&acc)[2][2][4][2], const Unit& u, int wr, int wc, int fr, int fq) const {
        asm volatile("" : "+v"(fr), "+v"(fq));
        bf16_t* base = (bf16_t*)u.O;
#pragma unroll
        for (int ai = 0; ai < 2; ++ai)
#pragma unroll
            for (int m = 0; m < 4; ++m) { bf16_t* rowp = base + (size_t)(ai * HALF + wr * 64 + m * 16 + fr) * u.ldc + wc * 32 + 8 * fq;
#pragma unroll
                for (int bj = 0; bj < 2; ++bj) { const f32x4 v0 = acc[ai][bj][m][0], v1 = acc[ai][bj][m][1];
                    u32x4 w; w.x = pk2(v0[0], v0[1]); w.y = pk2(v0[2], v0[3]); w.z = pk2(v1[0], v1[1]); w.w = pk2(v1[2], v1[3]);
                    *(u32x4*)(rowp + bj * HALF) = w; } }
    }
};
struct EpiAtomic {
    static constexpr bool PERM = false;
    __device__ __forceinline__ void operator()(const f32x4 (&acc)[2][2][4][2], const Unit& u, int wr, int wc, int fr, int fq) const {
        asm volatile("" : "+v"(fr), "+v"(fq));
        float* base = (float*)u.O;
#pragma unroll
        for (int ai = 0; ai < 2; ++ai)
#pragma unroll
            for (int m = 0; m < 4; ++m) { float* rowp = base + (size_t)(ai * HALF + wr * 64 + m * 16 + fr) * u.ldc + wc * 32 + 4 * fq;
#pragma unroll
                for (int bj = 0; bj < 2; ++bj)
#pragma unroll
                    for (int n = 0; n < 2; ++n) { const f32x4 v = acc[ai][bj][m][n]; float* q = rowp + bj * HALF + n * 16;
#pragma unroll
                        for (int e = 0; e < 4; ++e) (void)__hip_atomic_fetch_add(q + e, v[e], __ATOMIC_RELAXED, __HIP_MEMORY_SCOPE_AGENT); }
                __builtin_amdgcn_sched_barrier(0); }
    }
};

template <class Epi, class Sched>
__device__ __forceinline__ void gemm_phase(LAS unsigned char* lds, const int tid, const int ldk, const int Kloop, const Sched& S, const Epi& E) {
    const int wid = __builtin_amdgcn_readfirstlane(tid >> 6), lane = tid & 63, wr = wid >> 2, wc = wid & 3, fr = lane & 15, fq = lane >> 4;
    const int nt = Kloop / BK;
    unsigned voffA[2], voffB[2];
#pragma unroll
    for (int i = 0; i < 2; ++i) { int R, C; stage_rc(tid * 16 + i * 8192, R, C); const int Rb = Epi::PERM ? ((R & ~31) + perm32(R & 31)) : R;
        voffA[i] = (unsigned)(R * ldk + C) * 2u; voffB[i] = (unsigned)(Rb * ldk + C) * 2u; }
    const size_t kstep = (size_t)(BK * 2);
    const size_t hstep = (size_t)HALF * ldk * 2;
    const unsigned ldsw = (unsigned)wid * 1024u;
    const int aoff = lds_byte(wr * 64 + fr, fq * 8), boff = lds_byte(wc * 32 + fr, fq * 8);
#define PG8_SA(b, h) (((b) * 2 + (h)) * HTB)
#define PG8_SB(b, h) ((4 + (b) * 2 + (h)) * HTB)
#define PG8_STAGE(bufoff, gbase, voff) do { _Pragma("unroll") for (int _i = 0; _i < 2; ++_i) \
        __builtin_amdgcn_global_load_lds((const unsigned*)((const char*)(gbase) + (voff)[_i]), (LAS unsigned*)(lds + (bufoff) + ldsw + _i * 8192), 16, 0, 0); } while (0)
#define PG8_LDA(dst, b, h) do { _Pragma("unroll") for (int m = 0; m < 4; ++m) _Pragma("unroll") for (int k = 0; k < 2; ++k) dst[m][k] = *(const LAS bf16x8*)(lds + PG8_SA(b, h) + aoff + m * 2048 + k * 1024); } while (0)
#define PG8_LDB(dst, b, h) do { _Pragma("unroll") for (int n = 0; n < 2; ++n) _Pragma("unroll") for (int k = 0; k < 2; ++k) dst[n][k] = *(const LAS bf16x8*)(lds + PG8_SB(b, h) + boff + n * 2048 + k * 1024); } while (0)
#define PG8_MMA(ai, bj, At, Bt) do { __builtin_amdgcn_s_setprio(1); _Pragma("unroll") for (int m = 0; m < 4; ++m) _Pragma("unroll") for (int n = 0; n < 2; ++n) _Pragma("unroll") for (int k = 0; k < 2; ++k) \
        acc[ai][bj][m][n] = __builtin_amdgcn_mfma_f32_16x16x32_bf16(Bt[n][k], At[m][k], acc[ai][bj][m][n], 0, 0, 0); __builtin_amdgcn_s_setprio(0); } while (0)
#define PG8_WAIT_V(n) asm volatile("s_waitcnt vmcnt(" #n ")" ::: "memory")
#define PG8_WAIT_L(n) asm volatile("s_waitcnt lgkmcnt(" #n ")" ::: "memory")
#define PG8_BAR __builtin_amdgcn_s_barrier()
#define PG8_SCHED __builtin_amdgcn_sched_barrier(0)
    Unit cur, nxt; int ui = 0;
    if (!S.next(0, cur)) return;
    f32x4 acc[2][2][4][2];
#pragma unroll
    for (int a = 0; a < 2; ++a)
#pragma unroll
        for (int b = 0; b < 2; ++b)
#pragma unroll
            for (int m = 0; m < 4; ++m)
#pragma unroll
                for (int n = 0; n < 2; ++n) acc[a][b][m][n] = (f32x4){0.f, 0.f, 0.f, 0.f};
    bf16x8 At[4][2], B0[2][2], B1[2][2];
    const char* cA = cur.A; const char* cB = cur.B;
    PG8_STAGE(PG8_SB(0, 0), cB, voffB); PG8_STAGE(PG8_SA(0, 0), cA, voffA); PG8_STAGE(PG8_SB(0, 1), cB + hstep, voffB); PG8_STAGE(PG8_SA(0, 1), cA + hstep, voffA);
    if (wr == 1) PG8_BAR;
    PG8_WAIT_V(4); PG8_BAR;
    PG8_STAGE(PG8_SB(1, 0), cB + kstep, voffB); PG8_STAGE(PG8_SA(1, 0), cA + kstep, voffA); PG8_STAGE(PG8_SB(1, 1), cB + hstep + kstep, voffB);
    PG8_WAIT_V(6); PG8_BAR;
    for (;;) {
        const bool has_next = S.next(ui + 1, nxt);
        const char* nA = has_next ? nxt.A : cA; const char* nB = has_next ? nxt.B : cB;
        for (int t = 0; t < nt; t += 2) {
            const bool last = (t == nt - 2);
            const char* a1 = cA + (size_t)(t + 1) * kstep;
            const char* a2 = last ? nA : cA + (size_t)(t + 2) * kstep; const char* b2 = last ? nB : cB + (size_t)(t + 2) * kstep;
            const char* a3 = a2 + kstep; const char* b3 = b2 + kstep;
            PG8_LDB(B0, 0, 0); PG8_SCHED; PG8_LDA(At, 0, 0); PG8_STAGE(PG8_SA(1, 1), a1 + hstep, voffA);
            PG8_WAIT_L(8); PG8_BAR; PG8_WAIT_L(0); PG8_MMA(0, 0, At, B0); PG8_BAR; PG8_SCHED;
            PG8_LDB(B1, 0, 1); PG8_STAGE(PG8_SB(0, 0), b2, voffB);
            PG8_BAR; PG8_WAIT_L(0); PG8_MMA(0, 1, At, B1); PG8_BAR;
            PG8_LDA(At, 0, 1); PG8_STAGE(PG8_SA(0, 0), a2, voffA);
            PG8_BAR; PG8_WAIT_L(0); PG8_MMA(1, 0, At, B0); PG8_BAR; PG8_SCHED;
            PG8_STAGE(PG8_SB(0, 1), b2 + hstep, voffB);
            PG8_WAIT_V(6); PG8_BAR; PG8_MMA(1, 1, At, B1); PG8_BAR;
            PG8_LDB(B0, 1, 0); PG8_SCHED; PG8_LDA(At, 1, 0); PG8_STAGE(PG8_SA(0, 1), a2 + hstep, voffA);
            PG8_WAIT_L(8); PG8_BAR; PG8_WAIT_L(0); PG8_MMA(0, 0, At, B0); PG8_BAR; PG8_SCHED;
            PG8_LDB(B1, 1, 1); PG8_STAGE(PG8_SB(1, 0), b3, voffB);
            PG8_BAR; PG8_WAIT_L(0); PG8_MMA(0, 1, At, B1); PG8_BAR;
            PG8_LDA(At, 1, 1); PG8_STAGE(PG8_SA(1, 0), a3, voffA);
            PG8_BAR; PG8_WAIT_L(0); PG8_MMA(1, 0, At, B0); PG8_BAR; PG8_SCHED;
            PG8_STAGE(PG8_SB(1, 1), b3 + hstep, voffB);
            PG8_WAIT_V(6); PG8_BAR; PG8_MMA(1, 1, At, B1); PG8_BAR;
        }
        E(acc, cur, wr, wc, fr, fq);
        if (!has_next) break;
#pragma unroll
        for (int a = 0; a < 2; ++a)
#pragma unroll
            for (int b = 0; b < 2; ++b)
#pragma unroll
                for (int m = 0; m < 4; ++m)
#pragma unroll
                    for (int n = 0; n < 2; ++n) acc[a][b][m][n] = (f32x4){0.f, 0.f, 0.f, 0.f};
        cur = nxt; cA = nA; cB = nB; ++ui;
    }
    PG8_WAIT_V(0);
    if (wr == 0) PG8_BAR;
    PG8_BAR;
#undef PG8_SA
#undef PG8_SB
#undef PG8_STAGE
#undef PG8_LDA
#undef PG8_LDB
#undef PG8_MMA
#undef PG8_WAIT_V
#undef PG8_WAIT_L
#undef PG8_BAR
#undef PG8_SCHED
}
}

#define XB_TMO      128
#define XB_XCNT(j)  (256  + 64 * (j))
#define XB_XSUB(j)  (1280 + 64 * (j))
#define XB_XGEN(j)  (2304 + 64 * (j))
#define XB_TOP      3328
#define XB_TOPGEN   3392
#define XCD_BAR_WORDS 3456
#define XB_SPIN_CAP (1u << 18)
__device__ __forceinline__ unsigned xb_ld(unsigned* p)              { return __hip_atomic_load(p, __ATOMIC_RELAXED, __HIP_MEMORY_SCOPE_AGENT); }
__device__ __forceinline__ unsigned xb_add(unsigned* p, unsigned v) { return __hip_atomic_fetch_add(p, v, __ATOMIC_RELAXED, __HIP_MEMORY_SCOPE_AGENT); }
__device__ __forceinline__ unsigned xb_xcc_id() { return (unsigned)__builtin_amdgcn_s_getreg((3 << 11) | 20) & 0xFu; }
#define XB_SPIN(cond, bar) do { unsigned _sp = 0; while (cond) { __builtin_amdgcn_s_sleep(1); \
    if ((++_sp & 255u) == 0u) { if (xb_ld(&(bar)[XB_TMO])) break; if (_sp > XB_SPIN_CAP) { atomicAdd(&(bar)[XB_TMO], 1u); break; } } } } while (0)
struct XcdBarrier { unsigned* bar; unsigned x; volatile LAS unsigned* st; };
__device__ __forceinline__ XcdBarrier xcd_barrier_post(unsigned* bar, volatile LAS unsigned* st) {
    XcdBarrier b; b.bar = bar; b.x = xb_xcc_id(); b.st = st;
    if (threadIdx.x == 0) (void)xb_add(&bar[XB_XCNT(b.x)], 1u);
    return b;
}
__device__ __forceinline__ void xcd_barrier_complete(unsigned* bar, unsigned x, unsigned& nloc, unsigned& nx) {
    const unsigned G = gridDim.x * gridDim.y * gridDim.z;
    unsigned sum, cnt, mine, sp = 0u;
    for (;;) {
        sum = 0u; cnt = 0u; mine = 0u;
#pragma unroll
        for (unsigned j = 0; j < 16; ++j) { const unsigned c = xb_ld(&bar[XB_XCNT(j)]); sum += c; cnt += (c > 0u) ? 1u : 0u; mine = (j == x) ? c : mine; }
        if (sum == G) break;
        __builtin_amdgcn_s_sleep(1);
        if ((++sp & 255u) == 0u) { if (xb_ld(&bar[XB_TMO])) break; if (sp > XB_SPIN_CAP) { atomicAdd(&bar[XB_TMO], 1u); break; } }
    }
    nloc = mine > 0u ? mine : 1u; nx = cnt > 0u ? cnt : 1u;
}
__device__ __forceinline__ void xcd_barrier(const XcdBarrier& b) {
    asm volatile("s_waitcnt vmcnt(0)" ::: "memory");
    __syncthreads();
    int tid0 = threadIdx.x; asm volatile("" : "+v"(tid0));
    if (tid0 == 0) {
        unsigned* bar = b.bar;
        __builtin_amdgcn_s_waitcnt(0);
        unsigned nloc = b.st[0], nx = b.st[1];
        if (nloc == 0u) { xcd_barrier_complete(bar, b.x, nloc, nx); b.st[0] = nloc; b.st[1] = nx; }
        const unsigned old = xb_add(&bar[XB_XSUB(b.x)], 1u);
        const unsigned gen = old / nloc;
        if (old + 1u == (gen + 1u) * nloc) {
            __builtin_amdgcn_fence(__ATOMIC_RELEASE, "agent");
            asm volatile("s_waitcnt vmcnt(0)" ::: "memory");
            const unsigned og = xb_add(&bar[XB_TOP], 1u);
            const unsigned tg = og / nx;
            if (og + 1u == (tg + 1u) * nx) xb_add(&bar[XB_TOPGEN], 1u);
            else XB_SPIN(xb_ld(&bar[XB_TOPGEN]) == tg, bar);
            __builtin_amdgcn_fence(__ATOMIC_ACQUIRE, "agent");
            xb_add(&bar[XB_XGEN(b.x)], 1u);
            asm volatile("s_waitcnt vmcnt(0)" ::: "memory");
        } else {
            XB_SPIN(xb_ld(&bar[XB_XGEN(b.x)]) == gen, bar);
            __builtin_amdgcn_fence(__ATOMIC_ACQUIRE, "agent");
            asm volatile("s_waitcnt vmcnt(0)" ::: "memory");
        }
    }
    __syncthreads();
}

__device__ __forceinline__ void lds_barrier() { asm volatile("s_waitcnt lgkmcnt(0)" ::: "memory"); __builtin_amdgcn_s_barrier(); asm volatile("" ::: "memory"); }
struct Ctx { int tid, wv, lane, G, bid; LAS unsigned char* lds; unsigned char* seg; };

template <int MODE>
__device__ __forceinline__ void convT_tile(const Ctx& c, const float* src, int ldsrc, int Ksrc, int k0, int n0, bf16_t* dst, int ldd, int koff) {
    LAS float* tile = (LAS float*)c.lds;
    __syncthreads();
#pragma unroll
    for (int rep = 0; rep < 2; ++rep) {
        const int i = (c.tid >> 4) + 32 * rep, j4 = (c.tid & 15) * 4; const int n = n0 + j4; int sc = n;
        if (MODE == 1) sc = (n < RW_SHIFT) ? n : (n < P1W ? -1 : n - (P1W - RW_SHIFT));
        f32x4 v = (f32x4){0.f, 0.f, 0.f, 0.f};
        if (sc >= 0 && (k0 + i) < Ksrc) v = *(const f32x4*)(src + (size_t)(k0 + i) * ldsrc + sc);
        tile[i * 65 + j4 + 0] = v[0]; tile[i * 65 + j4 + 1] = v[1]; tile[i * 65 + j4 + 2] = v[2]; tile[i * 65 + j4 + 3] = v[3];
    }
    __syncthreads();
    { const int j = c.tid >> 3, i8 = (c.tid & 7) * 8;
      if (k0 + i8 < Ksrc) {
        u32x4 w; w.x = pk2(tile[(i8 + 0) * 65 + j], tile[(i8 + 1) * 65 + j]); w.y = pk2(tile[(i8 + 2) * 65 + j], tile[(i8 + 3) * 65 + j]);
        w.z = pk2(tile[(i8 + 4) * 65 + j], tile[(i8 + 5) * 65 + j]); w.w = pk2(tile[(i8 + 6) * 65 + j], tile[(i8 + 7) * 65 + j]);
        *(u32x4*)(dst + (size_t)(n0 + j) * ldd + koff + k0 + i8) = w; } }
}

__device__ __forceinline__ void rms_row_bf16(const float* src, const float* g, bf16_t* dst, int lane) {
    f32x4 v[4]; float ss = 0.f;
#pragma unroll
    for (int i = 0; i < 4; ++i) { v[i] = *(const f32x4*)(src + i * 256 + lane * 4); ss += v[i][0] * v[i][0] + v[i][1] * v[i][1] + v[i][2] * v[i][2] + v[i][3] * v[i][3]; }
    ss = wsum(ss); const float rs = rsqrtf(ss * (1.0f / 1024.0f) + 1e-6f);
#pragma unroll
    for (int i = 0; i < 4; ++i) { const f32x4 gg = *(const f32x4*)(g + i * 256 + lane * 4);
        u32x2 w; w.x = pk2(v[i][0] * rs * gg[0], v[i][1] * rs * gg[1]); w.y = pk2(v[i][2] * rs * gg[2], v[i][3] * rs * gg[3]);
        *(u32x2*)(dst + i * 256 + lane * 4) = w; }
}
__device__ __forceinline__ float add_slabs(const float* src, const bf16_t* slab, int r, int lane, f32x4 (&v)[4]) {
    float ss = 0.f;
#pragma unroll
    for (int i = 0; i < 4; ++i) { v[i] = *(const f32x4*)(src + i * 256 + lane * 4);
#pragma unroll
        for (int ks = 0; ks < 4; ++ks) { const u32x2 t = *(const u32x2*)(slab + ((size_t)ks * MS + r) * DM + i * 256 + lane * 4);
            v[i][0] += bflo(t.x); v[i][1] += bfhi(t.x); v[i][2] += bflo(t.y); v[i][3] += bfhi(t.y); }
        ss += v[i][0] * v[i][0] + v[i][1] * v[i][1] + v[i][2] * v[i][2] + v[i][3] * v[i][3]; }
    return wsum(ss);
}

__device__ __forceinline__ void phase_apre(const P& p, const Ctx& c, int seg, int wg, int nwg) {
    bf16_t* H = (bf16_t*)(p.ws + OFF_H);
    for (int r = wg * 8 + c.wv; r < MS; r += nwg * 8) { const int b = r >> 9, tl = r & 511; const size_t grow = (size_t)b * SEQ + seg * SEGT + tl;
        rms_row_bf16(p.x + grow * DM, p.norm_g, H + (size_t)r * DM, c.lane); }
}
__device__ __forceinline__ void phase_a5(const P& p, const Ctx& c, int seg) {
    bf16_t* H = (bf16_t*)(p.ws + OFF_H); const bf16_t* slab = (const bf16_t*)(c.seg + S0_SLAB);
    for (int r = c.bid * 8 + c.wv; r < MS / 2; r += c.G * 8) {
        const int ra = r, rb = r + MS / 2;
        const size_t ga = (size_t)(ra >> 9) * SEQ + seg * SEGT + (ra & 511), gb = (size_t)(rb >> 9) * SEQ + seg * SEGT + (rb & 511);
        f32x4 va[4], vb[4]; const float sa = add_slabs(p.x + ga * DM, slab, ra, c.lane, va); const float sb = add_slabs(p.x + gb * DM, slab, rb, c.lane, vb);
        const float rsa = rsqrtf(sa * (1.0f / 1024.0f) + 1e-6f), rsb = rsqrtf(sb * (1.0f / 1024.0f) + 1e-6f);
#pragma unroll
        for (int i = 0; i < 4; ++i) { const f32x4 gg = *(const f32x4*)(p.norm_g + DM + i * 256 + c.lane * 4);
            *(f32x4*)(p.out + ga * DM + i * 256 + c.lane * 4) = va[i]; *(f32x4*)(p.out + gb * DM + i * 256 + c.lane * 4) = vb[i];
            u32x2 w; w.x = pk2(va[i][0] * rsa * gg[0], va[i][1] * rsa * gg[1]); w.y = pk2(va[i][2] * rsa * gg[2], va[i][3] * rsa * gg[3]);
            *(u32x2*)(H + (size_t)ra * DM + i * 256 + c.lane * 4) = w;
            w.x = pk2(vb[i][0] * rsb * gg[0], vb[i][1] * rsb * gg[1]); w.y = pk2(vb[i][2] * rsb * gg[2], vb[i][3] * rsb * gg[3]);
            *(u32x2*)(H + (size_t)rb * DM + i * 256 + c.lane * 4) = w; } }
}
__device__ __forceinline__ void phase_b5(const P& p, const Ctx& c, int seg) {
    const bf16_t* slab = (const bf16_t*)(c.seg + S1_SLAB);
    for (int r = c.bid * 8 + c.wv; r < MS / 2; r += c.G * 8) {
        const int ra = r, rb = r + MS / 2;
        float* rowa = p.out + ((size_t)(ra >> 9) * SEQ + seg * SEGT + (ra & 511)) * DM; float* rowb = p.out + ((size_t)(rb >> 9) * SEQ + seg * SEGT + (rb & 511)) * DM;
        f32x4 va[4], vb[4]; const float sa = add_slabs(rowa, slab, ra, c.lane, va); const float sb = add_slabs(rowb, slab, rb, c.lane, vb);
        const float rsa = rsqrtf(sa * (1.0f / 1024.0f) + 1e-6f), rsb = rsqrtf(sb * (1.0f / 1024.0f) + 1e-6f);
#pragma unroll
        for (int i = 0; i < 4; ++i) { const f32x4 gg = *(const f32x4*)(p.final_g + i * 256 + c.lane * 4); f32x4 o;
            o[0] = va[i][0] * rsa * gg[0]; o[1] = va[i][1] * rsa * gg[1]; o[2] = va[i][2] * rsa * gg[2]; o[3] = va[i][3] * rsa * gg[3]; *(f32x4*)(rowa + i * 256 + c.lane * 4) = o;
            o[0] = vb[i][0] * rsb * gg[0]; o[1] = vb[i][1] * rsb * gg[1]; o[2] = vb[i][2] * rsb * gg[2]; o[3] = vb[i][3] * rsb * gg[3]; *(f32x4*)(rowb + i * 256 + c.lane * 4) = o; } }
}

__device__ __forceinline__ void phase0(const P& p, const Ctx& c) {
    const int T0 = 16 * 64, T1 = 16 * 120, T2 = 32 * 16, T3 = 32 * 16, T4 = 16 * 16, T5 = 16 * 16, T6 = 24 * 5;
    const int TT = T0 + T1 + T2 + T3 + T4 + T5 + T6;
    for (int t = c.bid; t < TT; t += c.G) {
        int u = t;
        if (u < T0) { convT_tile<0>(c, p.ml_w_in, ML_W, 1024, (u & 15) * 64, (u >> 4) * 64, (bf16_t*)(p.ws + OFF_WT0), 1024, 0); continue; } u -= T0;
        if (u < T1) { convT_tile<1>(c, p.rw_w_in, RW_W, 1024, (u & 15) * 64, (u >> 4) * 64, (bf16_t*)(p.ws + OFF_WT1), 1024, 0); continue; } u -= T1;
        if (u < T2) { convT_tile<0>(c, p.w_out, DM, 2048, (u & 31) * 64, (u >> 5) * 64, (bf16_t*)(p.ws + OFF_WO0T), 2048, 0); continue; } u -= T2;
        if (u < T3) { convT_tile<0>(c, p.w_out + (size_t)DIN * DM, DM, 2048, (u & 31) * 64, (u >> 5) * 64, (bf16_t*)(p.ws + OFF_WO1T), 2048, 0); continue; } u -= T3;
        if (u < T4) { convT_tile<0>(c, p.mem_kv_w, DM, 1024, (u & 15) * 64, (u >> 4) * 64, (bf16_t*)(p.ws + OFF_WKVT), 1024, 0); continue; } u -= T4;
        if (u < T5) { convT_tile<0>(c, p.mem_kv_w + (size_t)DM * DM, DM, 1024, (u & 15) * 64, (u >> 4) * 64, (bf16_t*)(p.ws + OFF_WKVT + 2 * MiB), 1024, 0); continue; } u -= T5;
        { const int nt = u / 5, j = u % 5; bf16_t* L = (bf16_t*)(p.ws + OFF_LORAT);
          if (j == 0) convT_tile<0>(c, p.rw_w_lora2, DMIX, 64, 0, nt * 64, L, 288, 0);
          else if (j == 1) convT_tile<0>(c, p.rw_a_lora2, DMIX, 64, 0, nt * 64, L, 288, 64);
          else if (j == 2) convT_tile<0>(c, p.rw_v_lora2, DMIX, 32, 0, nt * 64, L, 288, 128);
          else convT_tile<0>(c, p.rw_g_lora2, DMIX, 128, (j - 3) * 64, nt * 64, L, 288, 160); }
    }
    for (int r = c.bid * 8 + c.wv; r < 2 * 2048; r += c.G * 8) { const int l = r >> 11, rr = r & 2047;
        rms_row_bf16(p.mem + (size_t)rr * DM, p.mem_norm_g + l * DM, (bf16_t*)(p.ws + OFF_MEMN) + (size_t)r * DM, c.lane); }
}

struct SchedA0 {
    const unsigned char* ws; unsigned char* seg; int G, c, nextra;
    __device__ __forceinline__ bool next(int i, pg8::Unit& u) const {
        const int L = i * G + c; if (L >= 256 + nextra) return false;
        if (L < 256) { int pm, pn; pg8::remap(L, 16, 16, pm, pn);
            u.A = (const char*)(ws + OFF_H) + (size_t)pm * 256 * 1024 * 2; u.B = (const char*)(ws + OFF_WT0) + (size_t)pn * 256 * 1024 * 2;
            u.O = (char*)(seg + S0_P0) + ((size_t)pm * 256 * ML_W + pn * 256) * 2; u.ldc = ML_W; return true; }
        const int e = L - 256, l = e >> 5, j = e & 31;
        const char* memn = (const char*)(ws + OFF_MEMN) + (size_t)l * 2048 * 1024 * 2; const char* wkv = (const char*)(ws + OFF_WKVT) + (size_t)l * 2 * MiB;
        char* kout = (char*)(ws + OFF_KMEM) + (size_t)l * 4 * MiB;
        if (j < 16) { const int pm = j >> 1, pn = j & 1;
            u.A = memn + (size_t)pm * 256 * 1024 * 2; u.B = wkv + (size_t)pn * 256 * 1024 * 2; u.O = kout + ((size_t)pm * 256 * 512 + pn * 256) * 2; u.ldc = 512; }
        else { const int jj = j - 16, pm = jj >> 3, pn = jj & 7;
            u.A = wkv + (size_t)(512 + pm * 256) * 1024 * 2; u.B = memn + (size_t)pn * 256 * 1024 * 2; u.O = kout + 2 * MiB + ((size_t)pm * 256 * 2048 + pn * 256) * 2; u.ldc = 2048; }
        return true;
    }
};
struct SchedB0 {
    const unsigned char* ws; unsigned char* seg; int G, c;
    __device__ __forceinline__ bool next(int i, pg8::Unit& u) const {
        const int L = i * G + c; if (L >= 480) return false;
        int pm, pn; pg8::remap(L, 16, 30, pm, pn);
        u.A = (const char*)(ws + OFF_H) + (size_t)pm * 256 * 1024 * 2; u.B = (const char*)(ws + OFF_WT1) + (size_t)pn * 256 * 1024 * 2;
        if (pn < 20) { u.O = (char*)(seg + S1_P1) + ((size_t)pm * 256 * P1W + pn * 256) * 2; u.ldc = P1W; }
        else { u.O = (char*)(seg + S1_P2) + ((size_t)pm * 256 * P2W + (pn - 20) * 256) * 2; u.ldc = P2W; }
        return true;
    }
};
struct SchedOut {
    const char* Y; const char* W; char* slab; int G, c;
    __device__ __forceinline__ bool next(int i, pg8::Unit& u) const {
        const int L = i * G + c; if (L >= 256) return false;
        const int ks = L >> 6; int pm, pn; pg8::remap(L & 63, 16, 4, pm, pn);
        u.A = Y + ((size_t)pm * 256 * DIN + ks * 512) * 2; u.B = W + ((size_t)pn * 256 * DIN + ks * 512) * 2;
        u.O = slab + (((size_t)ks * MS + pm * 256) * DM + pn * 256) * 2; u.ldc = DM; return true;
    }
};

__device__ __forceinline__ void phase_a1(const P& p, const Ctx& c, int seg) {
    const bf16_t* P0 = (const bf16_t*)(c.seg + S0_P0);
    bf16_t* Qb = (bf16_t*)(c.seg + S0_Q); bf16_t* Kb = (bf16_t*)(c.seg + S0_K); bf16_t* KT = (bf16_t*)(c.seg + S0_KT); bf16_t* VT = (bf16_t*)(c.seg + S0_VT);
    bf16_t* XC = (bf16_t*)(c.seg + S0_XC); bf16_t* VF = (bf16_t*)(p.ws + OFF_VF);
    float* IPRE = (float*)(c.seg + S0_GATE); float* LOGF = IPRE + 32 * SEGT;
    const bf16_t* UT = (const bf16_t*)(p.ws + OFF_UTAIL);
    LAS float* red = (LAS float*)c.lds;
    LAS bf16_t* kst = (LAS bf16_t*)(c.lds + 98304);
    LAS bf16_t* vst = kst + 1536 * 8;
    const int n = c.tid;
    float wq[4][4], wk[4][4], wv[4][4], G12[4][8], G3[4][8];
    if (n < 384) {
#pragma unroll
        for (int i = 0; i < 4; ++i) { const f32x4 a = *(const f32x4*)(p.ml_wq + n * 16 + i * 4), bb = *(const f32x4*)(p.ml_wk + n * 16 + i * 4), cc = *(const f32x4*)(p.ml_wv + n * 16 + i * 4);
#pragma unroll
            for (int o = 0; o < 4; ++o) { wq[i][o] = a[o]; wk[i][o] = bb[o]; wv[i][o] = cc[o]; } }
#pragma unroll
        for (int i = 0; i < 4; ++i)
#pragma unroll
            for (int g = 0; g < 8; ++g) { G12[i][g] = 0.f; G3[i][g] = 0.f; }
#pragma unroll
        for (int o = 0; o < 4; ++o) {
            const float* gq = p.ml_w_gate + (size_t)(n * 4 + o) * 8; const float* gk = p.ml_w_gate + (size_t)(DMIX + n * 4 + o) * 8; const float* gv = p.ml_w_gate + (size_t)(2 * DMIX + n * 4 + o) * 8;
            const f32x4 q0 = *(const f32x4*)gq, q1 = *(const f32x4*)(gq + 4), k0 = *(const f32x4*)gk, k1 = *(const f32x4*)(gk + 4), v0 = *(const f32x4*)gv, v1 = *(const f32x4*)(gv + 4);
#pragma unroll
            for (int i = 0; i < 4; ++i)
#pragma unroll
                for (int g = 0; g < 4; ++g) { G12[i][g] += wq[i][o] * q0[g] + wk[i][o] * k0[g]; G12[i][g + 4] += wq[i][o] * q1[g] + wk[i][o] * k1[g];
                    G3[i][g] += wv[i][o] * v0[g]; G3[i][g + 4] += wv[i][o] * v1[g]; }
        }
    }
#pragma unroll 1
    for (int it = c.bid; it < MS / 8; it += c.G) {
        const int row0 = it * 8, b = row0 >> 9, tl0 = row0 & 511;
        __syncthreads();
        if (n < 384) {
            float um[3][4];
#pragma unroll
            for (int j = 1; j <= 3; ++j) { u32x2 raw = (u32x2){0u, 0u};
                if (tl0 - j >= 0) raw = *(const u32x2*)(P0 + (unsigned)((row0 - j) * ML_W + n * 4));
                else if (seg > 0) raw = *(const u32x2*)(UT + (unsigned)((b * 3 + (3 - j)) * DMIX + n * 4));
                um[3 - j][0] = bflo(raw.x); um[3 - j][1] = bfhi(raw.x); um[3 - j][2] = bflo(raw.y); um[3 - j][3] = bfhi(raw.y); }
            u32x2 nraw = *(const u32x2*)(P0 + (unsigned)(row0 * ML_W + n * 4));
#pragma unroll 1
            for (int tt = 0; tt < 8; ++tt) {
                const unsigned row = (unsigned)(row0 + tt);
                const u32x2 raw = nraw;
                if (tt + 1 < 8) nraw = *(const u32x2*)(P0 + (unsigned)((row + 1) * ML_W + n * 4));
                float u[4] = {bflo(raw.x), bfhi(raw.x), bflo(raw.y), bfhi(raw.y)}, xc[4], q[4], k[4], v[4];
                { int nn = n; asm volatile("" : "+v"(nn));
                  const f32x4 cb = *(const f32x4*)(p.ml_conv_b + nn * 4), c0 = *(const f32x4*)(p.ml_conv_w + nn * 4), c1 = *(const f32x4*)(p.ml_conv_w + DMIX + nn * 4),
                              c2 = *(const f32x4*)(p.ml_conv_w + 2 * DMIX + nn * 4), c3 = *(const f32x4*)(p.ml_conv_w + 3 * DMIX + nn * 4);
#pragma unroll
                  for (int i = 0; i < 4; ++i) { const float y = cb[i] + c0[i] * um[0][i] + c1[i] * um[1][i] + c2[i] * um[2][i] + c3[i] * u[i]; xc[i] = siluf_(y); } }
                const float ks = 0.05103103630798288f;
#pragma unroll
                for (int o = 0; o < 4; ++o) { q[o] = xc[0] * wq[0][o] + xc[1] * wq[1][o] + xc[2] * wq[2][o] + xc[3] * wq[3][o];
                    k[o] = (xc[0] * wk[0][o] + xc[1] * wk[1][o] + xc[2] * wk[2][o] + xc[3] * wk[3][o]) * ks;
                    v[o] = u[0] * wv[0][o] + u[1] * wv[1][o] + u[2] * wv[2][o] + u[3] * wv[3][o]; }
#pragma unroll
                for (int g = 0; g < 8; ++g) red[(tt * 8 + g) * 384 + n] = xc[0] * G12[0][g] + xc[1] * G12[1][g] + xc[2] * G12[2][g] + xc[3] * G12[3][g] + u[0] * G3[0][g] + u[1] * G3[1][g] + u[2] * G3[2][g] + u[3] * G3[3][g];
                u32x2 w; w.x = pk2(q[0], q[1]); w.y = pk2(q[2], q[3]); *(u32x2*)(Qb + (unsigned)(row * DMIX + n * 4)) = w;
                w.x = pk2(k[0], k[1]); w.y = pk2(k[2], k[3]); *(u32x2*)(Kb + (unsigned)(row * DMIX + n * 4)) = w;
                w.x = pk2(xc[0], xc[1]); w.y = pk2(xc[2], xc[3]); *(u32x2*)(XC + (unsigned)(row * DMIX + n * 4)) = w;
                w.x = pk2(v[0], v[1]); w.y = pk2(v[2], v[3]); *(u32x2*)(VF + (unsigned)(row * DMIX + n * 4)) = w;
#pragma unroll
                for (int o = 0; o < 4; ++o) { kst[(n * 4 + o) * 8 + tt] = f2bf(k[o]); vst[(n * 4 + o) * 8 + tt] = f2bf(v[o]); }
#pragma unroll
                for (int i = 0; i < 4; ++i) { um[0][i] = um[1][i]; um[1][i] = um[2][i]; um[2][i] = u[i]; }
            }
            const int hd = n / 96, dch = (n % 96) * 4;
#pragma unroll
            for (int o = 0; o < 4; ++o) { const unsigned off = (unsigned)(((b * 4 + hd) * 384 + dch + o) * SEGT + tl0);
                *(u32x4*)(KT + off) = *(const LAS u32x4*)(kst + (n * 4 + o) * 8); *(u32x4*)(VT + off) = *(const LAS u32x4*)(vst + (n * 4 + o) * 8); }
        }
        __syncthreads();
        { const int v = c.tid >> 3, part = c.tid & 7; float s = 0.f;
#pragma unroll 8
          for (int i = 0; i < 48; ++i) s += red[v * 384 + part * 48 + i];
          s += __shfl_xor(s, 1); s += __shfl_xor(s, 2); s += __shfl_xor(s, 4);
          if (part == 0) { const int tt = v >> 3, g = v & 7; const float gate = s + p.ml_b_gate[g];
              if (g < 4) IPRE[(b * 4 + g) * SEGT + tl0 + tt] = gate; else LOGF[(b * 4 + g - 4) * SEGT + tl0 + tt] = -softplusf_(-gate); } }
    }
}

__device__ __forceinline__ void attn_item(const P& p, const Ctx& c, int layer, int it, const bf16_t* Qp, int ldq, bf16_t* YM) {
    const int b = it >> 3, head = (it >> 1) & 3, qb = it & 1;
    const bf16_t* Kg = (const bf16_t*)(p.ws + OFF_KMEM + (size_t)layer * 4 * MiB) + (size_t)(b * 256) * 512 + head * 128;
    const bf16_t* Vg = (const bf16_t*)(p.ws + OFF_KMEM + (size_t)layer * 4 * MiB + 2 * MiB) + (size_t)(head * 128) * 2048 + b * 256;
    LAS bf16_t* Ks = (LAS bf16_t*)c.lds;
    LAS bf16_t* Vs = Ks + 256 * 136;
    const int l15 = c.lane & 15, quad = c.lane >> 4;
    __syncthreads();
#pragma unroll
    for (int r = 0; r < 8; ++r) { const int id = c.tid + 512 * r; { const int i = id >> 4, c8 = (id & 15) * 8; *(LAS u32x4*)(Ks + i * 136 + c8) = *(const u32x4*)(Kg + (size_t)i * 512 + c8); }
        { const int i = id >> 5, c8 = (id & 31) * 8; *(LAS u32x4*)(Vs + i * 264 + c8) = *(const u32x4*)(Vg + (size_t)i * 2048 + c8); } }
    __syncthreads();
#pragma unroll 1
    for (int pass = 0; pass < 2; ++pass) {
        const int row0 = b * SEGT + qb * 256 + c.wv * 32 + pass * 16;
        bf16x8 qf[4];
#pragma unroll
        for (int kk = 0; kk < 4; ++kk) qf[kk] = *(const bf16x8*)(Qp + (size_t)(row0 + l15) * ldq + head * 128 + kk * 32 + quad * 8);
        f32x4 acc[16];
#pragma unroll
        for (int mt = 0; mt < 16; ++mt) { acc[mt] = (f32x4){0.f, 0.f, 0.f, 0.f};
#pragma unroll
            for (int kk = 0; kk < 4; ++kk) { const bf16x8 a = *(const LAS bf16x8*)(Ks + (mt * 16 + l15) * 136 + kk * 32 + quad * 8); acc[mt] = mfma16(a, qf[kk], acc[mt]); }
            if ((mt & 3) == 3) __builtin_amdgcn_sched_barrier(0); }
        float mx = -1e30f;
#pragma unroll
        for (int mt = 0; mt < 16; ++mt)
#pragma unroll
            for (int j = 0; j < 4; ++j) mx = fmaxf(mx, acc[mt][j]);
        mx = fmaxf(mx, __shfl_xor(mx, 16)); mx = fmaxf(mx, __shfl_xor(mx, 32));
        const float sc = 0.08838834764831845f * 1.4426950408889634f; float sm = 0.f;
#pragma unroll
        for (int mt = 0; mt < 16; ++mt)
#pragma unroll
            for (int j = 0; j < 4; ++j) { const float e = exp2f((acc[mt][j] - mx) * sc); acc[mt][j] = e; sm += e; }
        sm += __shfl_xor(sm, 16); sm += __shfl_xor(sm, 32);
        const float inv = 1.0f / sm;
        bf16x8 pa[8];
#pragma unroll
        for (int kp = 0; kp < 8; ++kp) {
            u32x4 aw; aw.x = pk2(acc[2 * kp][0] * inv, acc[2 * kp][1] * inv); aw.y = pk2(acc[2 * kp][2] * inv, acc[2 * kp][3] * inv);
            aw.z = pk2(acc[2 * kp + 1][0] * inv, acc[2 * kp + 1][1] * inv); aw.w = pk2(acc[2 * kp + 1][2] * inv, acc[2 * kp + 1][3] * inv);
            __builtin_memcpy(&pa[kp], &aw, 16); }
        __builtin_amdgcn_sched_barrier(0);
        f32x4 o[8];
#pragma unroll
        for (int nt = 0; nt < 8; ++nt) o[nt] = (f32x4){0.f, 0.f, 0.f, 0.f};
#pragma unroll
        for (int kp = 0; kp < 8; ++kp) {
            const bf16x8 a = pa[kp];
#pragma unroll
            for (int nt = 0; nt < 8; ++nt) { const LAS bf16_t* vp = Vs + (nt * 16 + l15) * 264 + 2 * kp * 16 + quad * 4;
                const u32x2 lo = *(const LAS u32x2*)vp, hi = *(const LAS u32x2*)(vp + 16); u32x4 bw = (u32x4){lo.x, lo.y, hi.x, hi.y}; bf16x8 bfr; __builtin_memcpy(&bfr, &bw, 16);
                o[nt] = mfma16(a, bfr, o[nt]); }
            __builtin_amdgcn_sched_barrier(0);
        }
#pragma unroll
        for (int nt = 0; nt < 8; ++nt)
#pragma unroll
            for (int j = 0; j < 4; ++j) YM[(size_t)(row0 + quad * 4 + j) * DX + head * 128 + nt * 16 + l15] = f2bf(o[nt][j]);
    }
}

__device__ __forceinline__ void mlstm_item(const P& p, const Ctx& c, int seg, int w, bool save) {
    const int b = w / 24, h = (w / 6) & 3, sl = w % 6;
    const bf16_t* Qb = (const bf16_t*)(c.seg + S0_Q); const bf16_t* Kb = (const bf16_t*)(c.seg + S0_K); const bf16_t* KT = (const bf16_t*)(c.seg + S0_KT); const bf16_t* VT = (const bf16_t*)(c.seg + S0_VT);
    const float* IPRE = (const float*)(c.seg + S0_GATE); const float* LOGF = IPRE + 32 * SEGT;
    bf16_t* HR = (bf16_t*)(c.seg + S0_HRAW);
    float* CST = (float*)(p.ws + OFF_CST) + (size_t)w * 64 * 384; float* NST = (float*)(p.ws + OFF_NST) + (size_t)w * 384;
    LAS bf16_t* Cimg = (LAS bf16_t*)c.lds;
    LAS bf16_t* Qs = Cimg + 64 * 392;
    LAS bf16_t* Ks = Qs + 64 * 136;
    LAS bf16_t* KTs = Ks + 64 * 136;
    LAS bf16_t* VTs = KTs + 128 * 72;
    LAS bf16_t* VWs = VTs + 64 * 72;
    LAS bf16_t* Sp = VWs + 64 * 72;
    LAS float* fl = (LAS float*)(Sp + 64 * 72);
    LAS float* bcum = fl; LAS float* ipr = fl + 64; LAS float* wgt = fl + 128; LAS float* gin = fl + 192; LAS float* qn = fl + 256; LAS float* rden = fl + 320;
    LAS float* gtotp = fl + 384; LAS float* nold = fl + 400; LAS float* nnew = fl + 800;
    const int l15c = c.lane & 15, quadc = c.lane >> 4, e16 = c.wv & 3, par = c.wv >> 2;
    f32x4 C[12];
    __syncthreads();
    if (seg > 0) {
#pragma unroll
        for (int j = 0; j < 12; ++j)
#pragma unroll
            for (int jj = 0; jj < 4; ++jj) C[j][jj] = CST[(size_t)(e16 * 16 + quadc * 4 + jj) * 384 + (2 * j + par) * 16 + l15c];
        if (c.tid < 384) nold[c.tid] = NST[c.tid];
    } else {
#pragma unroll
        for (int j = 0; j < 12; ++j) C[j] = (f32x4){0.f, 0.f, 0.f, 0.f};
        if (c.tid < 384) nold[c.tid] = 0.f;
    }
    u32x4 pq[2], pk[2], pt[2], pvt; float plf = 0.f, pip = 0.f;
    auto gl_piece = [&](int ch, int pp, int tidv) {
#pragma unroll
        for (int r = 0; r < 2; ++r) { const int id = tidv + 512 * r;
            { const int i = id >> 4, c8 = (id & 15) * 8; const size_t go = ((size_t)b * SEGT + ch * 64 + i) * DMIX + h * 384 + pp * 128 + c8; pq[r] = *(const u32x4*)(Qb + go); pk[r] = *(const u32x4*)(Kb + go); }
            { const int dd = id >> 3, c8 = (id & 7) * 8; pt[r] = *(const u32x4*)(KT + ((size_t)(b * 4 + h) * 384 + pp * 128 + dd) * SEGT + ch * 64 + c8); } } };
    auto gl_chunk = [&](int ch, int tidv) { const int i = tidv >> 3, c8 = (tidv & 7) * 8;
        pvt = *(const u32x4*)(VT + ((size_t)(b * 4 + h) * 384 + sl * 64 + i) * SEGT + ch * 64 + c8);
        if (c.wv == 0) { plf = LOGF[(b * 4 + h) * SEGT + ch * 64 + c.lane]; pip = IPRE[(b * 4 + h) * SEGT + ch * 64 + c.lane]; } };
    { int t0 = c.tid; asm volatile("" : "+v"(t0)); gl_chunk(0, t0); gl_piece(0, 0, t0); }
#pragma unroll 1
    for (int ch = 0; ch < 8; ++ch) {
        const int tl0 = ch * 64; const size_t row0 = (size_t)b * SEGT + tl0;
        int tidv = c.tid, l15 = l15c, quad = quadc;
        asm volatile("" : "+v"(tidv), "+v"(l15), "+v"(quad));
        lds_barrier();
        if (c.wv == 0) {
            float bc = plf;
#pragma unroll
            for (int o = 1; o < 64; o <<= 1) { const float t = __shfl_up(bc, o); if (c.lane >= o) bc += t; }
            const float bl = __shfl(bc, 63);
            bcum[c.lane] = bc; ipr[c.lane] = pip; wgt[c.lane] = __expf(bl - bc + pip); gin[c.lane] = __expf(bc);
            if (c.lane == 0) gtotp[0] = __expf(bl);
        }
#pragma unroll
        for (int j = 0; j < 12; ++j)
#pragma unroll
            for (int jj = 0; jj < 4; ++jj) Cimg[(e16 * 16 + quad * 4 + jj) * 392 + (2 * j + par) * 16 + l15] = f2bf(C[j][jj]);
        lds_barrier();
        { const int i = tidv >> 3, c8 = (tidv & 7) * 8;
          const u32x4 raw = pvt;
          *(LAS u32x4*)(VTs + i * 72 + c8) = raw;
          const f32x4 w0 = *(const LAS f32x4*)(wgt + c8), w1 = *(const LAS f32x4*)(wgt + c8 + 4);
          u32x4 sw; sw.x = pk2(bflo(raw.x) * w0[0], bfhi(raw.x) * w0[1]); sw.y = pk2(bflo(raw.y) * w0[2], bfhi(raw.y) * w0[3]);
          sw.z = pk2(bflo(raw.z) * w1[0], bfhi(raw.z) * w1[1]); sw.w = pk2(bflo(raw.w) * w1[2], bfhi(raw.w) * w1[3]);
          *(LAS u32x4*)(VWs + i * 72 + c8) = sw; }
        if (ch + 1 < 8) gl_chunk(ch + 1, tidv);
        const float gtot = gtotp[0];
#pragma unroll
        for (int j = 0; j < 12; ++j) C[j] *= gtot;
        f32x4 Sa[2], Ia[2]; Sa[0] = Sa[1] = Ia[0] = Ia[1] = (f32x4){0.f, 0.f, 0.f, 0.f};
        float qnacc = 0.f;
#pragma unroll
        for (int pp = 0; pp < 3; ++pp) {
            const int d0 = pp * 128;
            __builtin_amdgcn_sched_barrier(0);
            asm volatile("" : "+v"(tidv));
            lds_barrier();
#pragma unroll
            for (int r = 0; r < 2; ++r) { const int id = tidv + 512 * r;
                { const int i = id >> 4, c8 = (id & 15) * 8; *(LAS u32x4*)(Qs + i * 136 + c8) = pq[r]; *(LAS u32x4*)(Ks + i * 136 + c8) = pk[r]; }
                { const int dd = id >> 3, c8 = (id & 7) * 8; *(LAS u32x4*)(KTs + dd * 72 + c8) = pt[r]; } }
            lds_barrier();
            if (pp < 2) gl_piece(ch, pp + 1, tidv); else if (ch + 1 < 8) gl_piece(ch + 1, 0, tidv);
            { const int tm = c.wv >> 1, tn0 = (c.wv & 1) * 2;
#pragma unroll
              for (int kk = 0; kk < 4; ++kk) { const bf16x8 a = *(const LAS bf16x8*)(Qs + (tm * 16 + l15) * 136 + kk * 32 + quad * 8);
#pragma unroll
                  for (int x = 0; x < 2; ++x) { const int tn = tn0 + x;
                      const bf16x8 bk = *(const LAS bf16x8*)(Ks + (tn * 16 + l15) * 136 + kk * 32 + quad * 8);
                      const bf16x8 bc = *(const LAS bf16x8*)(Cimg + (tn * 16 + l15) * 392 + d0 + kk * 32 + quad * 8);
                      Sa[x] = mfma16(a, bk, Sa[x]); Ia[x] = mfma16(a, bc, Ia[x]); } } }
            { const bf16x8 va0 = *(const LAS bf16x8*)(VWs + (e16 * 16 + l15) * 72 + quad * 8), va1 = *(const LAS bf16x8*)(VWs + (e16 * 16 + l15) * 72 + 32 + quad * 8);
#pragma unroll
              for (int jl = 0; jl < 4; ++jl) { const int ntl = 2 * jl + par, j = pp * 4 + jl;
                  C[j] = mfma16(va0, *(const LAS bf16x8*)(KTs + (ntl * 16 + l15) * 72 + quad * 8), C[j]);
                  C[j] = mfma16(va1, *(const LAS bf16x8*)(KTs + (ntl * 16 + l15) * 72 + 32 + quad * 8), C[j]); } }
            { const int t = tidv >> 3, part = tidv & 7;
              const u32x4 q0 = *(const LAS u32x4*)(Qs + t * 136 + part * 16), q1 = *(const LAS u32x4*)(Qs + t * 136 + part * 16 + 8);
              const LAS float* np = nold + d0 + part * 16; const f32x4 n0 = *(const LAS f32x4*)np, n1 = *(const LAS f32x4*)(np + 4), n2 = *(const LAS f32x4*)(np + 8), n3 = *(const LAS f32x4*)(np + 12);
              qnacc += bflo(q0.x) * n0[0] + bfhi(q0.x) * n0[1] + bflo(q0.y) * n0[2] + bfhi(q0.y) * n0[3] + bflo(q0.z) * n1[0] + bfhi(q0.z) * n1[1] + bflo(q0.w) * n1[2] + bfhi(q0.w) * n1[3]
                     + bflo(q1.x) * n2[0] + bfhi(q1.x) * n2[1] + bflo(q1.y) * n2[2] + bfhi(q1.y) * n2[3] + bflo(q1.z) * n3[0] + bfhi(q1.z) * n3[1] + bflo(q1.w) * n3[2] + bfhi(q1.w) * n3[3]; }
            { const int dd = tidv >> 2, part = tidv & 3;
              const u32x4 k0 = *(const LAS u32x4*)(KTs + dd * 72 + part * 16), k1 = *(const LAS u32x4*)(KTs + dd * 72 + part * 16 + 8);
              const LAS float* wp = wgt + part * 16; const f32x4 w0 = *(const LAS f32x4*)wp, w1 = *(const LAS f32x4*)(wp + 4), w2 = *(const LAS f32x4*)(wp + 8), w3 = *(const LAS f32x4*)(wp + 12);
              float a = bflo(k0.x) * w0[0] + bfhi(k0.x) * w0[1] + bflo(k0.y) * w0[2] + bfhi(k0.y) * w0[3] + bflo(k0.z) * w1[0] + bfhi(k0.z) * w1[1] + bflo(k0.w) * w1[2] + bfhi(k0.w) * w1[3]
                      + bflo(k1.x) * w2[0] + bfhi(k1.x) * w2[1] + bflo(k1.y) * w2[2] + bfhi(k1.y) * w2[3] + bflo(k1.z) * w3[0] + bfhi(k1.z) * w3[1] + bflo(k1.w) * w3[2] + bfhi(k1.w) * w3[3];
              a = dpp_add<0xB1>(a); a = dpp_add<0x4E>(a);
              if (part == 0) nnew[d0 + dd] = gtot * nold[d0 + dd] + a; }
        }
        qnacc = dpp_add<0xB1>(qnacc); qnacc = dpp_add<0x4E>(qnacc); qnacc = dpp_add<0x141>(qnacc);
        if ((tidv & 7) == 0) qn[tidv >> 3] = qnacc;
#pragma unroll
        for (int x = 0; x < 2; ++x) { const int ti = c.wv * 2 + x, tm = ti >> 2, tn = ti & 3; const int s = tn * 16 + l15; const float bs = bcum[s] - ipr[s];
#pragma unroll
            for (int jj = 0; jj < 4; ++jj) { const int t = tm * 16 + quad * 4 + jj; const float v = (s <= t) ? Sa[x][jj] * __expf(bcum[t] - bs) : 0.f; Sp[t * 72 + s] = f2bf(v); } }
        lds_barrier();
        { const int t = tidv >> 3, part = tidv & 7; const u32x4 sr = *(const LAS u32x4*)(Sp + t * 72 + part * 8);
          float ds = bflo(sr.x) + bfhi(sr.x) + bflo(sr.y) + bfhi(sr.y) + bflo(sr.z) + bfhi(sr.z) + bflo(sr.w) + bfhi(sr.w);
          ds = dpp_add<0xB1>(ds); ds = dpp_add<0x4E>(ds); ds = dpp_add<0x141>(ds);
          if (part == 0) { const float den = ds + gin[t] * qn[t]; rden[t] = 1.0f / fmaxf(fabsf(den), 1.0f); } }
#pragma unroll
        for (int x = 0; x < 2; ++x) { const int ti = c.wv * 2 + x, tm = ti >> 2, tn = ti & 3;
#pragma unroll
            for (int jj = 0; jj < 4; ++jj) Ia[x][jj] *= gin[tm * 16 + quad * 4 + jj];
#pragma unroll
            for (int kk = 0; kk < 2; ++kk) { const bf16x8 a = *(const LAS bf16x8*)(Sp + (tm * 16 + l15) * 72 + kk * 32 + quad * 8);
                const bf16x8 bb = *(const LAS bf16x8*)(VTs + (tn * 16 + l15) * 72 + kk * 32 + quad * 8); Ia[x] = mfma16(a, bb, Ia[x]); } }
        lds_barrier();
#pragma unroll
        for (int x = 0; x < 2; ++x) { const int ti = c.wv * 2 + x, tm = ti >> 2, tn = ti & 3;
#pragma unroll
            for (int jj = 0; jj < 4; ++jj) { const int t = tm * 16 + quad * 4 + jj; HR[(row0 + t) * DMIX + h * 384 + sl * 64 + tn * 16 + l15] = f2bf(Ia[x][jj] * rden[t]); } }
        if (c.tid < 384) nold[c.tid] = nnew[c.tid];
    }
    lds_barrier();
    if (!save) return;
#pragma unroll
    for (int j = 0; j < 12; ++j)
#pragma unroll
        for (int jj = 0; jj < 4; ++jj) CST[(size_t)(e16 * 16 + quadc * 4 + jj) * 384 + (2 * j + par) * 16 + l15c] = C[j][jj];
    if (c.tid < 384) NST[c.tid] = nold[c.tid];
}

__device__ __forceinline__ void phase_a3(const P& p, const Ctx& c, int seg) {
    const bf16_t* P0 = (const bf16_t*)(c.seg + S0_P0); const bf16_t* HR = (const bf16_t*)(c.seg + S0_HRAW); const bf16_t* XC = (const bf16_t*)(c.seg + S0_XC);
    const bf16_t* YM = (const bf16_t*)(c.seg + S0_YMEM); bf16_t* Y = (bf16_t*)(c.seg + S0_Y); bf16_t* UT = (bf16_t*)(p.ws + OFF_UTAIL);
#pragma unroll 1
    for (int r = c.bid * 8 + c.wv; r < MS; r += c.G * 8) {
        const int b = r >> 9, tl = r & 511;
        float v[3][8]; float mean[3], rstd[3];
#pragma unroll
        for (int ps = 0; ps < 3; ++ps) { const int ch = ps * 512 + c.lane * 8;
            const u32x4 hr = *(const u32x4*)(HR + (size_t)r * DMIX + ch);
            v[ps][0] = bflo(hr.x); v[ps][1] = bfhi(hr.x); v[ps][2] = bflo(hr.y); v[ps][3] = bfhi(hr.y); v[ps][4] = bflo(hr.z); v[ps][5] = bfhi(hr.z); v[ps][6] = bflo(hr.w); v[ps][7] = bfhi(hr.w); }
        float hs[4], hq[4];
#pragma unroll
        for (int hd = 0; hd < 4; ++hd) { float s = 0.f, q = 0.f;
#pragma unroll
            for (int ps = 0; ps < 3; ++ps) { if (ps * 512 + 511 < hd * 384 || ps * 512 >= (hd + 1) * 384) continue;
                const bool mine = ((ps * 512 + c.lane * 8) / 384) == hd;
                float ls = 0.f, lq = 0.f;
#pragma unroll
                for (int j = 0; j < 8; ++j) { ls += v[ps][j]; lq += v[ps][j] * v[ps][j]; }
                s += mine ? ls : 0.f; q += mine ? lq : 0.f; }
            hs[hd] = wsum(s); hq[hd] = wsum(q); }
#pragma unroll
        for (int ps = 0; ps < 3; ++ps) { const int hd = (ps * 512 + c.lane * 8) / 384;
            const float s = hd == 0 ? hs[0] : (hd == 1 ? hs[1] : (hd == 2 ? hs[2] : hs[3])), q = hd == 0 ? hq[0] : (hd == 1 ? hq[1] : (hd == 2 ? hq[2] : hq[3]));
            const float m = s * (1.0f / 384.0f); mean[ps] = m; rstd[ps] = rsqrtf(fmaxf(q * (1.0f / 384.0f) - m * m, 0.f) + 1e-5f); }
#pragma unroll
        for (int ps = 0; ps < 3; ++ps) { const int ch = ps * 512 + c.lane * 8;
            const u32x4 xr = *(const u32x4*)(XC + (size_t)r * DMIX + ch), zr = *(const u32x4*)(P0 + (size_t)r * ML_W + 2048 + ch);
            const f32x4 g0 = *(const f32x4*)(p.ml_mhn_g + ch), g1 = *(const f32x4*)(p.ml_mhn_g + ch + 4), k0 = *(const f32x4*)(p.ml_skip + ch), k1 = *(const f32x4*)(p.ml_skip + ch + 4);
            const float xx[8] = {bflo(xr.x), bfhi(xr.x), bflo(xr.y), bfhi(xr.y), bflo(xr.z), bfhi(xr.z), bflo(xr.w), bfhi(xr.w)};
            const float zz[8] = {bflo(zr.x), bfhi(zr.x), bflo(zr.y), bfhi(zr.y), bflo(zr.z), bfhi(zr.z), bflo(zr.w), bfhi(zr.w)};
            const float gg[8] = {g0[0], g0[1], g0[2], g0[3], g1[0], g1[1], g1[2], g1[3]}, kk[8] = {k0[0], k0[1], k0[2], k0[3], k1[0], k1[1], k1[2], k1[3]};
            float y[8];
#pragma unroll
            for (int j = 0; j < 8; ++j) y[j] = ((v[ps][j] - mean[ps]) * rstd[ps] * gg[j] + kk[j] * xx[j]) * siluf_(zz[j]);
            *(u32x4*)(Y + (size_t)r * DIN + ch) = (u32x4){pk2(y[0], y[1]), pk2(y[2], y[3]), pk2(y[4], y[5]), pk2(y[6], y[7])}; }
        { const int cm = c.lane * 8; const u32x4 mr = *(const u32x4*)(YM + (size_t)r * DX + cm), zr = *(const u32x4*)(P0 + (size_t)r * ML_W + 2048 + DMIX + cm);
          const float mm[8] = {bflo(mr.x), bfhi(mr.x), bflo(mr.y), bfhi(mr.y), bflo(mr.z), bfhi(mr.z), bflo(mr.w), bfhi(mr.w)};
          const float zz[8] = {bflo(zr.x), bfhi(zr.x), bflo(zr.y), bfhi(zr.y), bflo(zr.z), bfhi(zr.z), bflo(zr.w), bfhi(zr.w)};
          float y[8];
#pragma unroll
          for (int j = 0; j < 8; ++j) y[j] = mm[j] * siluf_(zz[j]);
          *(u32x4*)(Y + (size_t)r * DIN + DMIX + cm) = (u32x4){pk2(y[0], y[1]), pk2(y[2], y[3]), pk2(y[4], y[5]), pk2(y[6], y[7])}; }
        if (tl >= 509) {
#pragma unroll
            for (int ps = 0; ps < 3; ++ps) { const int ch = ps * 512 + c.lane * 8; *(u32x4*)(UT + (size_t)(b * 3 + tl - 509) * DMIX + ch) = *(const u32x4*)(P0 + (size_t)r * ML_W + ch); } }
    }
}

__device__ __forceinline__ void phase_b1(const P& p, const Ctx& c, int seg) {
    const bf16_t* P1 = (const bf16_t*)(c.seg + S1_P1);
    float* GTB = (float*)(c.seg + S1_W); bf16_t* SA = (bf16_t*)(c.seg + S1_A); bf16_t* SB = (bf16_t*)(c.seg + S1_B); bf16_t* SK = (bf16_t*)(c.seg + S1_K);
    bf16_t* SQ = (bf16_t*)(c.seg + S1_Q); bf16_t* SV = (bf16_t*)(c.seg + S1_V); bf16_t* SG = (bf16_t*)(c.seg + S1_G); float* BRKR = (float*)(c.seg + S1_BRKR);
    const bf16_t* VF = (const bf16_t*)(p.ws + OFF_VF); const bf16_t* LT = (const bf16_t*)(p.ws + OFF_LORAT);
    const bf16_t* PTr = (const bf16_t*)(p.ws + OFF_PTAIL) + (size_t)(seg & 1) * NB * RW_SHIFT; bf16_t* PTw = (bf16_t*)(p.ws + OFF_PTAIL) + (size_t)((seg + 1) & 1) * NB * RW_SHIFT;
    LAS bf16_t* XA = (LAS bf16_t*)c.lds;
    const int l15 = c.lane & 15, quad = c.lane >> 4;
    for (int it = c.bid; it < MS / 16; it += c.G) {
        const int r0 = it * 16, b = r0 >> 9, tl0 = r0 & 511;
        __syncthreads();
        for (int e = c.tid; e < 16 * 288; e += 512) { const int row = e / 288, cc = e % 288, col = 4608 + cc;
            const float cur = bf2f(P1[(size_t)(r0 + row) * P1W + col]);
            float prev = 0.f; if (tl0 + row > 0) prev = bf2f(P1[(size_t)(r0 + row - 1) * P1W + col]); else if (seg > 0) prev = bf2f(PTr[(size_t)b * RW_SHIFT + col]);
            const float pv = cur + p.rw_mu[col] * (prev - cur);
            const float f = cc < 64 ? (1.0f - 2.0f / (1.0f + __expf(2.0f * pv)))   : (cc < 160 ? pv : sigmoidf_(pv));
            XA[row * 296 + cc] = f2bf(f); }
        __syncthreads();
        const size_t row = (size_t)r0 + l15; const int tl = tl0 + l15;
        const bf16_t* curp = P1 + row * P1W; const bf16_t* prevp = (tl > 0) ? (P1 + (row - 1) * P1W) : (PTr + (size_t)b * RW_SHIFT); const bool hasprev = (tl > 0) || (seg > 0);
        struct TileIn { u32x2 cr, ck, cv, pr, pk, pv, vf; };
        struct TilePar { f32x4 m0, m1, m2, w0, a0, v0, kkw, kaw, rk; };
#pragma unroll 1
        for (int x = 0; x < 3; ++x) {
            int hh = c.wv * 3 + x; asm volatile("" : "+s"(hh));
            auto load_tile = [&](int ct, TileIn& T) { const int cc = hh * 64 + (ct >> 1) * 32 + quad * 8 + 4 * (ct & 1);
                T.cr = *(const u32x2*)(curp + cc); T.ck = *(const u32x2*)(curp + DMIX + cc); T.cv = *(const u32x2*)(curp + 2 * DMIX + cc);
                T.pr = (u32x2){0u, 0u}; T.pk = T.pr; T.pv = T.pr;
                if (hasprev) { T.pr = *(const u32x2*)(prevp + cc); T.pk = *(const u32x2*)(prevp + DMIX + cc); T.pv = *(const u32x2*)(prevp + 2 * DMIX + cc); }
                T.vf = *(const u32x2*)(VF + row * DMIX + cc); };
            TileIn TA;
            load_tile(0, TA);
            float inv;
            { u32x2 kcur[4], kprv[4]; f32x4 km[4], kw[4];
#pragma unroll
              for (int ct = 0; ct < 4; ++ct) { const int cc = hh * 64 + (ct >> 1) * 32 + quad * 8 + 4 * (ct & 1);
                  kcur[ct] = *(const u32x2*)(curp + DMIX + cc); kprv[ct] = (u32x2){0u, 0u}; if (hasprev) kprv[ct] = *(const u32x2*)(prevp + DMIX + cc);
                  km[ct] = *(const f32x4*)(p.rw_mu + DMIX + cc); kw[ct] = *(const f32x4*)(p.rw_k_k + cc); }
              float ss = 0.f;
#pragma unroll
              for (int ct = 0; ct < 4; ++ct) {
                  const float cb[4] = {bflo(kcur[ct].x), bfhi(kcur[ct].x), bflo(kcur[ct].y), bfhi(kcur[ct].y)}, qb[4] = {bflo(kprv[ct].x), bfhi(kprv[ct].x), bflo(kprv[ct].y), bfhi(kprv[ct].y)};
#pragma unroll
                  for (int j = 0; j < 4; ++j) { const float kr = (cb[j] + km[ct][j] * (qb[j] - cb[j])) * kw[ct][j]; ss += kr * kr; } }
              ss += __shfl_xor(ss, 16); ss += __shfl_xor(ss, 32);
              inv = 1.0f / fmaxf(sqrtf(ss), 1e-12f); }
            float br = 0.f, kr = 0.f, rkr = 0.f;
            u32x2 st_g, st_a, st_b, st_k, st_q, st_v;
            auto do_tile = [&](int ct, const TileIn& TI) { const int cc = hh * 64 + (ct >> 1) * 32 + quad * 8 + 4 * (ct & 1);
                TilePar T; T.m0 = *(const f32x4*)(p.rw_mu + cc); T.m1 = *(const f32x4*)(p.rw_mu + DMIX + cc); T.m2 = *(const f32x4*)(p.rw_mu + 2 * DMIX + cc);
                T.w0 = *(const f32x4*)(p.rw_w0 + cc); T.a0 = *(const f32x4*)(p.rw_a0 + cc); T.v0 = *(const f32x4*)(p.rw_v0 + cc); T.kkw = *(const f32x4*)(p.rw_k_k + cc); T.kaw = *(const f32x4*)(p.rw_k_a + cc);
                T.rk = *(const f32x4*)(p.rw_r_k + cc);
                bf16x8 lt[9]; { const bf16_t* lrow = LT + (size_t)(hh * 64 + (ct >> 1) * 32 + 8 * (l15 >> 2) + 4 * (ct & 1) + (l15 & 3)) * 288 + quad * 8;
#pragma unroll
                    for (int k = 0; k < 9; ++k) lt[k] = *(const bf16x8*)(lrow + k * 32); }
                bf16x8 xf[9];
#pragma unroll
                for (int k = 0; k < 9; ++k) xf[k] = *(const LAS bf16x8*)(XA + l15 * 296 + k * 32 + quad * 8);
                f32x4 dw = (f32x4){0.f, 0.f, 0.f, 0.f}, da = dw, dv = dw, dg = dw;
#pragma unroll
                for (int k = 0; k < 2; ++k) dw = mfma16(lt[k], xf[k], dw);
#pragma unroll
                for (int k = 0; k < 2; ++k) da = mfma16(lt[2 + k], xf[2 + k], da);
                dv = mfma16(lt[4], xf[4], dv);
#pragma unroll
                for (int k = 0; k < 4; ++k) dg = mfma16(lt[5 + k], xf[5 + k], dg);
                const float ca[4] = {bflo(TI.cr.x), bfhi(TI.cr.x), bflo(TI.cr.y), bfhi(TI.cr.y)}, cb[4] = {bflo(TI.ck.x), bfhi(TI.ck.x), bflo(TI.ck.y), bfhi(TI.ck.y)}, cd[4] = {bflo(TI.cv.x), bfhi(TI.cv.x), bflo(TI.cv.y), bfhi(TI.cv.y)};
                const float qa[4] = {bflo(TI.pr.x), bfhi(TI.pr.x), bflo(TI.pr.y), bfhi(TI.pr.y)}, qb[4] = {bflo(TI.pk.x), bfhi(TI.pk.x), bflo(TI.pk.y), bfhi(TI.pk.y)}, qd[4] = {bflo(TI.pv.x), bfhi(TI.pv.x), bflo(TI.pv.y), bfhi(TI.pv.y)};
                const float vf[4] = {bflo(TI.vf.x), bfhi(TI.vf.x), bflo(TI.vf.y), bfhi(TI.vf.y)};
                u32x2 gw; gw.x = pk2(dg[0], dg[1]); gw.y = pk2(dg[2], dg[3]);
                float wv4[4], av[4], bv[4], ktv[4], qv[4], vv[4];
#pragma unroll
                for (int j = 0; j < 4; ++j) {
                    const float rc = ca[j] + T.m0[j] * (qa[j] - ca[j]), kc = cb[j] + T.m1[j] * (qb[j] - cb[j]), vc = cd[j] + T.m2[j] * (qd[j] - cd[j]);
                    const float zz = -(T.w0[j] + dw[j]); const float sp = fmaxf(zz, 0.f) + __logf(1.0f + __expf(-fabsf(zz)));
                    wv4[j] = __expf(-__expf(-sp - 0.5f));
                    const float a = sigmoidf_(T.a0[j] + da[j]);
                    vv[j] = vc + (vf[j] - vc) * sigmoidf_(T.v0[j] + dv[j]);
                    const float kk = kc * T.kkw[j] * inv; av[j] = -kk; bv[j] = kk * a;
                    ktv[j] = kc * (1.0f + (a - 1.0f) * T.kaw[j]); qv[j] = rc;
                    br += bv[j] * rc; kr += ktv[j] * rc; rkr += rc * ktv[j] * T.rk[j]; }
                float gfin[4];
#pragma unroll
                for (int j = 0; j < 4; ++j) { float g = wv4[j];
                    g *= dpp_shr_or1<1>(g); g *= dpp_shr_or1<2>(g); g *= dpp_shr_or1<4>(g); g *= dpp_shr_or1<8>(g);
                    const float gp = dpp_shr_or1<1>(g), ig = 1.0f / g;
                    av[j] *= gp; qv[j] *= g; bv[j] *= ig; ktv[j] *= ig; gfin[j] = g; }
                if (l15 == 15) *(f32x4*)(GTB + ((size_t)it * 24 + hh) * 64 + (cc - hh * 64)) = (f32x4){gfin[0], gfin[1], gfin[2], gfin[3]};
                const u32x2 ta = (u32x2){pk2(av[0], av[1]), pk2(av[2], av[3])}, tb = (u32x2){pk2(bv[0], bv[1]), pk2(bv[2], bv[3])}, tk = (u32x2){pk2(ktv[0], ktv[1]), pk2(ktv[2], ktv[3])};
                const u32x2 tq = (u32x2){pk2(qv[0], qv[1]), pk2(qv[2], qv[3])}, tv = (u32x2){pk2(vv[0], vv[1]), pk2(vv[2], vv[3])};
                if ((ct & 1) == 0) { st_g = gw; st_a = ta; st_b = tb; st_k = tk; st_q = tq; st_v = tv; }
                else { const size_t o8 = row * DMIX + cc - 4;
                    *(u32x4*)(SG + o8) = (u32x4){st_g.x, st_g.y, gw.x, gw.y}; *(u32x4*)(SA + o8) = (u32x4){st_a.x, st_a.y, ta.x, ta.y}; *(u32x4*)(SB + o8) = (u32x4){st_b.x, st_b.y, tb.x, tb.y};
                    *(u32x4*)(SK + o8) = (u32x4){st_k.x, st_k.y, tk.x, tk.y}; *(u32x4*)(SQ + o8) = (u32x4){st_q.x, st_q.y, tq.x, tq.y}; *(u32x4*)(SV + o8) = (u32x4){st_v.x, st_v.y, tv.x, tv.y}; } };
            do_tile(0, TA); __builtin_amdgcn_sched_barrier(0);
            load_tile(1, TA); do_tile(1, TA); __builtin_amdgcn_sched_barrier(0);
            load_tile(2, TA); do_tile(2, TA); __builtin_amdgcn_sched_barrier(0);
            load_tile(3, TA); do_tile(3, TA);
            br += __shfl_xor(br, 16); br += __shfl_xor(br, 32); kr += __shfl_xor(kr, 16); kr += __shfl_xor(kr, 32); rkr += __shfl_xor(rkr, 16); rkr += __shfl_xor(rkr, 32);
            if (quad == 0) *(f32x4*)(BRKR + (row * 24 + hh) * 4) = (f32x4){br, kr, rkr, 0.f};
        }
        if (tl0 == 496) { for (int e = c.tid; e < RW_SHIFT; e += 512) PTw[(size_t)b * RW_SHIFT + e] = P1[(size_t)(r0 + 15) * P1W + e]; }
    }
}

__device__ __forceinline__ void rwkv_item(const P& p, const Ctx& c, int seg, int w, bool save) {
    const int b = w / 24, hh = w % 24;
    const float* SW = (const float*)(c.seg + S1_W); const bf16_t* SA = (const bf16_t*)(c.seg + S1_A); const bf16_t* SB = (const bf16_t*)(c.seg + S1_B); const bf16_t* SK = (const bf16_t*)(c.seg + S1_K);
    const bf16_t* SQ = (const bf16_t*)(c.seg + S1_Q); const bf16_t* SV = (const bf16_t*)(c.seg + S1_V); const float* BRKR = (const float*)(c.seg + S1_BRKR);
    float* O = (float*)(c.seg + S1_O); float* RST = (float*)(p.ws + OFF_RST) + (size_t)w * 4096;
    constexpr int TB = 32, REC = 388;
    LAS float* L0 = (LAS float*)c.lds;
    const int rp = c.wv * 4 + (c.lane >> 4), cq = c.lane & 15;
    f32x2 S0a, S0b, S1a, S1b;
    if (seg > 0) { const f32x4 s0 = *(const f32x4*)(RST + (2 * rp) * 64 + cq * 4), s1 = *(const f32x4*)(RST + (2 * rp + 1) * 64 + cq * 4);
        S0a = (f32x2){s0[0], s0[1]}; S0b = (f32x2){s0[2], s0[3]}; S1a = (f32x2){s1[0], s1[1]}; S1b = (f32x2){s1[2], s1[3]}; }
    else { S0a = S0b = S1a = S1b = (f32x2){0.f, 0.f}; }
    const int e4 = c.tid * 4, stt = e4 >> 6, scc = e4 & 63;
    f32x4 gw; u32x2 ga, gb, gk, gq, gv; f32x4 gbr;
    auto gload = [&](int blk) { const size_t go = ((size_t)b * SEGT + blk * TB + stt) * DMIX + hh * 64 + scc;
        gw = *(const f32x4*)(SW + go); ga = *(const u32x2*)(SA + go); gb = *(const u32x2*)(SB + go); gk = *(const u32x2*)(SK + go); gq = *(const u32x2*)(SQ + go); gv = *(const u32x2*)(SV + go);
        if (c.tid < TB) gbr = *(const f32x4*)(BRKR + (((size_t)b * SEGT + blk * TB + c.tid) * 24 + hh) * 4); };
    auto lstore = [&](int buf) { LAS float* r = L0 + buf * (TB * REC) + stt * REC + scc;
        *(LAS f32x4*)(r) = gw; *(LAS f32x4*)(r + 64) = (f32x4){bflo(ga.x), bfhi(ga.x), bflo(ga.y), bfhi(ga.y)}; *(LAS f32x4*)(r + 128) = (f32x4){bflo(gb.x), bfhi(gb.x), bflo(gb.y), bfhi(gb.y)};
        *(LAS f32x4*)(r + 192) = (f32x4){bflo(gk.x), bfhi(gk.x), bflo(gk.y), bfhi(gk.y)}; *(LAS f32x4*)(r + 256) = (f32x4){bflo(gq.x), bfhi(gq.x), bflo(gq.y), bfhi(gq.y)};
        *(LAS f32x4*)(r + 320) = (f32x4){bflo(gv.x), bfhi(gv.x), bflo(gv.y), bfhi(gv.y)};
        if (c.tid < TB) { LAS float* q = L0 + buf * (TB * REC) + c.tid * REC + 384; *(LAS f32x2*)q = (f32x2){gbr[0], gbr[1]}; } };
    __syncthreads();
    gload(0); lstore(0);
    __syncthreads();
#pragma unroll 1
    for (int blk = 0; blk < SEGT / TB; ++blk) {
        const int buf = blk & 1;
        if (blk + 1 < SEGT / TB) gload(blk + 1);
        const LAS float* base = L0 + buf * (TB * REC);
        const size_t rowb = (size_t)b * SEGT + blk * TB;
        f32x4 nw4 = *(const LAS f32x4*)(base + cq * 4), na4 = *(const LAS f32x4*)(base + 64 + cq * 4), nb4 = *(const LAS f32x4*)(base + 128 + cq * 4), nk4 = *(const LAS f32x4*)(base + 192 + cq * 4), nq4 = *(const LAS f32x4*)(base + 256 + cq * 4);
        f32x2 nv2 = *(const LAS f32x2*)(base + 320 + 2 * rp), nbk = *(const LAS f32x2*)(base + 384);
#pragma unroll 2
        for (int tt = 0; tt < TB; ++tt) {
            const f32x4 w4 = nw4, a4 = na4, b4 = nb4, k4 = nk4, q4 = nq4; const f32x2 v2 = nv2, bk = nbk;
            { const LAS float* r = base + (tt + 1 < TB ? tt + 1 : tt) * REC;
              nw4 = *(const LAS f32x4*)(r + cq * 4); na4 = *(const LAS f32x4*)(r + 64 + cq * 4); nb4 = *(const LAS f32x4*)(r + 128 + cq * 4); nk4 = *(const LAS f32x4*)(r + 192 + cq * 4); nq4 = *(const LAS f32x4*)(r + 256 + cq * 4);
              nv2 = *(const LAS f32x2*)(r + 320 + 2 * rp); nbk = *(const LAS f32x2*)(r + 384); }
            const f32x2 wa = (f32x2){w4[0], w4[1]}, wb = (f32x2){w4[2], w4[3]}, aa = (f32x2){a4[0], a4[1]}, ab = (f32x2){a4[2], a4[3]}, ba = (f32x2){b4[0], b4[1]}, bb = (f32x2){b4[2], b4[3]};
            const f32x2 ka = (f32x2){k4[0], k4[1]}, kb = (f32x2){k4[2], k4[3]}, qa = (f32x2){q4[0], q4[1]}, qb = (f32x2){q4[2], q4[3]};
            f32x2 t0 = S0a * aa + S0b * ab, t1 = S0a * qa + S0b * qb, t2 = S1a * aa + S1b * ab, t3 = S1a * qa + S1b * qb;
            float pa0 = t0.x + t0.y, pt0 = t1.x + t1.y, pa1 = t2.x + t2.y, pt1 = t3.x + t3.y;
            row16_allsum4(pa0, pa1, pt0, pt1);
            const f32x2 pa0v = (f32x2){pa0, pa0}, pa1v = (f32x2){pa1, pa1}, v0v = (f32x2){v2.x, v2.x}, v1v = (f32x2){v2.y, v2.y};
            S0a = S0a * wa + pa0v * ba + v0v * ka; S0b = S0b * wb + pa0v * bb + v0v * kb;
            S1a = S1a * wa + pa1v * ba + v1v * ka; S1b = S1b * wb + pa1v * bb + v1v * kb;
            if (cq == 0) { const f32x2 y = (f32x2){pt0 + pa0 * bk.x + v2.x * bk.y, pt1 + pa1 * bk.x + v2.y * bk.y};
                *(f32x2*)(O + (rowb + tt) * DMIX + hh * 64 + 2 * rp) = y; }
        }
        if (blk + 1 < SEGT / TB) lstore(buf ^ 1);
        __syncthreads();
    }
    if (!save) return;
    *(f32x4*)(RST + (2 * rp) * 64 + cq * 4) = (f32x4){S0a.x, S0a.y, S0b.x, S0b.y}; *(f32x4*)(RST + (2 * rp + 1) * 64 + cq * 4) = (f32x4){S1a.x, S1a.y, S1b.x, S1b.y};
}

__device__ __forceinline__ void rwkv_chunk_item(const P& p, const Ctx& c, int seg, int w, bool save) {
    const int b = w / 24, hh = w % 24;
    const bf16_t* SA = (const bf16_t*)(c.seg + S1_A); const bf16_t* SB = (const bf16_t*)(c.seg + S1_B); const bf16_t* SK = (const bf16_t*)(c.seg + S1_K);
    const bf16_t* SR = (const bf16_t*)(c.seg + S1_Q); const bf16_t* SV = (const bf16_t*)(c.seg + S1_V); const float* GTB = (const float*)(c.seg + S1_W);
    bf16_t* O = (bf16_t*)(c.seg + S1_O); float* RST = (float*)(p.ws + OFF_RST) + (size_t)w * 4096;
    constexpr int O_EA = 0  , O_EB = 4608  , O_EBT = 9216  , O_UV = 14336  ,
                  O_MT1 = 19456  , O_NT = 20736  , O_MABT = 22016  ,
                  O_GT = 23296  , OPB = 23552;
    LAS unsigned char* OB = c.lds;
    LAS bf16_t* S0I = (LAS bf16_t*)(c.lds + 2 * OPB);
    LAS float* XF = (LAS float*)(c.lds + 2 * OPB + 9216);
    const int l15c = c.lane & 15, quadc = c.lane >> 4;
    f32x4 S[2];
#pragma unroll
    for (int x = 0; x < 2; ++x) { const int ti = c.wv * 2 + x, mt = ti >> 2, nt = ti & 3;
#pragma unroll
        for (int jj = 0; jj < 4; ++jj) S[x][jj] = (seg > 0) ? RST[(mt * 16 + quadc * 4 + jj) * 64 + nt * 16 + l15c] : 0.f; }
    unsigned ga = 0, gb = 0, gk = 0, gr = 0, gv = 0; float gg = 1.f;
    auto gload = [&](int ch, int tidv) { const int t = tidv >> 5, j0 = (tidv & 31) * 2; const size_t go = ((size_t)b * SEGT + ch * 16 + t) * DMIX + hh * 64 + j0;
        ga = *(const unsigned*)(SA + go); gb = *(const unsigned*)(SB + go); gk = *(const unsigned*)(SK + go); gr = *(const unsigned*)(SR + go); gv = *(const unsigned*)(SV + go);
        if (tidv < 64) gg = GTB[((size_t)(b * 32 + ch) * 24 + hh) * 64 + tidv]; };
    auto lstore = [&](int pb, int tidv) { const int t = tidv >> 5, j0 = (tidv & 31) * 2;
        LAS bf16_t* EA = (LAS bf16_t*)(OB + pb * OPB + O_EA); LAS bf16_t* EB = (LAS bf16_t*)(OB + pb * OPB + O_EB); LAS bf16_t* EBT = (LAS bf16_t*)(OB + pb * OPB + O_EBT);
        LAS bf16_t* UV = (LAS bf16_t*)(OB + pb * OPB + O_UV); LAS float* GT = (LAS float*)(OB + pb * OPB + O_GT);
        *(LAS unsigned*)(EA + t * 72 + j0) = ga; *(LAS unsigned*)(EA + (16 + t) * 72 + j0) = gr;
        *(LAS unsigned*)(EB + t * 72 + j0) = gb; *(LAS unsigned*)(EB + (16 + t) * 72 + j0) = gk;
        EBT[j0 * 40 + t] = (bf16_t)(gb & 0xFFFFu); EBT[(j0 + 1) * 40 + t] = (bf16_t)(gb >> 16); EBT[j0 * 40 + 16 + t] = (bf16_t)(gk & 0xFFFFu); EBT[(j0 + 1) * 40 + 16 + t] = (bf16_t)(gk >> 16);
        UV[j0 * 40 + 16 + t] = (bf16_t)(gv & 0xFFFFu); UV[(j0 + 1) * 40 + 16 + t] = (bf16_t)(gv >> 16); UV[j0 * 40 + t] = 0; UV[(j0 + 1) * 40 + t] = 0;
        if (tidv < 64) GT[tidv] = gg; };
    auto gtile = [&](int pb, int l15, int quad) {
        LAS bf16_t* EA = (LAS bf16_t*)(OB + pb * OPB + O_EA); LAS bf16_t* EB = (LAS bf16_t*)(OB + pb * OPB + O_EB);
        LAS bf16_t* MT1 = (LAS bf16_t*)(OB + pb * OPB + O_MT1); LAS bf16_t* NT = (LAS bf16_t*)(OB + pb * OPB + O_NT); LAS float* MABT = (LAS float*)(OB + pb * OPB + O_MABT);
        const int sb = c.wv >> 1, tb = c.wv & 1; f32x4 g = (f32x4){0.f, 0.f, 0.f, 0.f};
#pragma unroll
        for (int kk = 0; kk < 2; ++kk) g = mfma16(*(const LAS bf16x8*)(EB + (sb * 16 + l15) * 72 + kk * 32 + quad * 8), *(const LAS bf16x8*)(EA + (tb * 16 + l15) * 72 + kk * 32 + quad * 8), g);
#pragma unroll
        for (int jj = 0; jj < 4; ++jj) { const int s2 = quad * 4 + jj, tt = l15; const float v = g[jj];
            if (tb == 0) { const float m = (s2 < tt) ? v : 0.f; if (sb == 0) { MABT[tt * 20 + s2] = m; MT1[tt * 40 + s2] = 0; } else MT1[tt * 40 + 16 + s2] = f2bf(m); }
            else { const float m = (s2 <= tt) ? v : 0.f; NT[tt * 40 + sb * 16 + s2] = f2bf(m); } } };
    auto simg = [&](int l15, int quad) {
#pragma unroll
        for (int x = 0; x < 2; ++x) { const int ti = c.wv * 2 + x, mt = ti >> 2, nt = ti & 3;
#pragma unroll
            for (int jj = 0; jj < 4; ++jj) S0I[(mt * 16 + quad * 4 + jj) * 72 + nt * 16 + l15] = f2bf(S[x][jj]); } };
    __syncthreads();
    { int t0 = c.tid; asm volatile("" : "+v"(t0)); gload(0, t0); lstore(0, t0); simg(l15c, quadc); }
    lds_barrier();
    if (c.wv < 4) gtile(0, l15c, quadc);
    { int t1 = c.tid; asm volatile("" : "+v"(t1)); gload(1, t1); }
    const int mtq = c.wv & 3;
#pragma unroll 1
    for (int ch = 0; ch < SEGT / 16; ++ch) {
        const int pb = ch & 1;
        int tidv = c.tid, l15 = l15c, quad = quadc; asm volatile("" : "+v"(tidv), "+v"(l15), "+v"(quad));
        LAS bf16_t* EA = (LAS bf16_t*)(OB + pb * OPB + O_EA); LAS bf16_t* EBT = (LAS bf16_t*)(OB + pb * OPB + O_EBT); LAS bf16_t* UV = (LAS bf16_t*)(OB + pb * OPB + O_UV);
        LAS bf16_t* MT1 = (LAS bf16_t*)(OB + pb * OPB + O_MT1); LAS bf16_t* NT = (LAS bf16_t*)(OB + pb * OPB + O_NT); LAS float* MABT = (LAS float*)(OB + pb * OPB + O_MABT); LAS float* GT = (LAS float*)(OB + pb * OPB + O_GT);
        lds_barrier();
        f32x4 Zt = (f32x4){0.f, 0.f, 0.f, 0.f};
        if (c.wv >= 4) {
            f32x4 Xt = (f32x4){0.f, 0.f, 0.f, 0.f};
#pragma unroll
            for (int kk = 0; kk < 2; ++kk) { const bf16x8 a = *(const LAS bf16x8*)(S0I + (mtq * 16 + l15) * 72 + kk * 32 + quad * 8);
                Xt = mfma16(a, *(const LAS bf16x8*)(EA + l15 * 72 + kk * 32 + quad * 8), Xt); Zt = mfma16(a, *(const LAS bf16x8*)(EA + (16 + l15) * 72 + kk * 32 + quad * 8), Zt); }
            Xt = mfma16(*(const LAS bf16x8*)(UV + (mtq * 16 + l15) * 40 + quad * 8), *(const LAS bf16x8*)(MT1 + l15 * 40 + quad * 8), Xt);
#pragma unroll
            for (int jj = 0; jj < 4; ++jj) XF[(mtq * 16 + quad * 4 + jj) * 17 + l15] = Xt[jj];
        }
        lds_barrier();
        if (ch + 1 < SEGT / 16) lstore(pb ^ 1, tidv);
        if (ch + 2 < SEGT / 16) gload(ch + 2, tidv);
        if (c.wv == 0) {
            float u[16];
#pragma unroll
            for (int tt = 0; tt < 16; ++tt) { float acc = XF[c.lane * 17 + tt];
#pragma unroll
                for (int s4 = 0; s4 < (tt + 3) / 4; ++s4) { const f32x4 m = *(const LAS f32x4*)(MABT + tt * 20 + s4 * 4);
#pragma unroll
                    for (int e = 0; e < 4; ++e) if (s4 * 4 + e < tt) acc += u[s4 * 4 + e] * m[e]; }
                u[tt] = acc; }
            *(LAS u32x4*)(UV + c.lane * 40) = (u32x4){pk2(u[0], u[1]), pk2(u[2], u[3]), pk2(u[4], u[5]), pk2(u[6], u[7])};
            *(LAS u32x4*)(UV + c.lane * 40 + 8) = (u32x4){pk2(u[8], u[9]), pk2(u[10], u[11]), pk2(u[12], u[13]), pk2(u[14], u[15])};
        }
        lds_barrier();
        if (c.wv >= 4) {
            Zt = mfma16(*(const LAS bf16x8*)(UV + (mtq * 16 + l15) * 40 + quad * 8), *(const LAS bf16x8*)(NT + l15 * 40 + quad * 8), Zt);
            *(u32x2*)(O + ((size_t)b * SEGT + ch * 16 + l15) * DMIX + hh * 64 + mtq * 16 + quad * 4) = (u32x2){pk2(Zt[0], Zt[1]), pk2(Zt[2], Zt[3])};
        }
#pragma unroll
        for (int x = 0; x < 2; ++x) { const int ti = c.wv * 2 + x, mt = ti >> 2, nt = ti & 3;
            S[x] = mfma16(*(const LAS bf16x8*)(UV + (mt * 16 + l15) * 40 + quad * 8), *(const LAS bf16x8*)(EBT + (nt * 16 + l15) * 40 + quad * 8), S[x]);
            const float gt = GT[nt * 16 + l15];
#pragma unroll
            for (int jj = 0; jj < 4; ++jj) S[x][jj] *= gt; }
        simg(l15, quad);
        if (c.wv < 4 && ch + 1 < SEGT / 16) gtile(pb ^ 1, l15, quad);
    }
    if (!save) return;
#pragma unroll
    for (int x = 0; x < 2; ++x) { const int ti = c.wv * 2 + x, mt = ti >> 2, nt = ti & 3;
#pragma unroll
        for (int jj = 0; jj < 4; ++jj) RST[(mt * 16 + quadc * 4 + jj) * 64 + nt * 16 + l15c] = S[x][jj]; }
}

__device__ __forceinline__ void phase_b3(const P& p, const Ctx& c) {
    const bf16_t* O = (const bf16_t*)(c.seg + S1_O); const bf16_t* P2 = (const bf16_t*)(c.seg + S1_P2); const bf16_t* SV = (const bf16_t*)(c.seg + S1_V); const bf16_t* SG = (const bf16_t*)(c.seg + S1_G);
    const float* BRKR = (const float*)(c.seg + S1_BRKR); const bf16_t* YM = (const bf16_t*)(c.seg + S1_YMEM); bf16_t* Y = (bf16_t*)(c.seg + S1_Y);
    for (int r = c.bid * 8 + c.wv; r < MS; r += c.G * 8) {
#pragma unroll
        for (int ps = 0; ps < 3; ++ps) {
            const int hh = ps * 8 + (c.lane >> 3), ch = hh * 64 + (c.lane & 7) * 8;
            const u32x4 orr = *(const u32x4*)(O + (size_t)r * DMIX + ch);
            float v[8] = {bflo(orr.x), bfhi(orr.x), bflo(orr.y), bfhi(orr.y), bflo(orr.z), bfhi(orr.z), bflo(orr.w), bfhi(orr.w)}; float s = 0.f, s2 = 0.f;
#pragma unroll
            for (int j = 0; j < 8; ++j) { s += v[j]; s2 += v[j] * v[j]; }
            s += __shfl_xor(s, 1); s2 += __shfl_xor(s2, 1); s += __shfl_xor(s, 2); s2 += __shfl_xor(s2, 2); s += __shfl_xor(s, 4); s2 += __shfl_xor(s2, 4);
            const float mean = s * (1.0f / 64.0f), var = fmaxf(s2 * (1.0f / 64.0f) - mean * mean, 0.f), rs = rsqrtf(var + 64e-5f);
            const float rkr = BRKR[((size_t)r * 24 + hh) * 4 + 2];
            const u32x4 vr = *(const u32x4*)(SV + (size_t)r * DMIX + ch), gr = *(const u32x4*)(SG + (size_t)r * DMIX + ch), zr = *(const u32x4*)(P2 + (size_t)r * P2W + 512 + ch);
            const float vv[8] = {bflo(vr.x), bfhi(vr.x), bflo(vr.y), bfhi(vr.y), bflo(vr.z), bfhi(vr.z), bflo(vr.w), bfhi(vr.w)};
            const float gg[8] = {bflo(gr.x), bfhi(gr.x), bflo(gr.y), bfhi(gr.y), bflo(gr.z), bfhi(gr.z), bflo(gr.w), bfhi(gr.w)};
            const float zz[8] = {bflo(zr.x), bfhi(zr.x), bflo(zr.y), bfhi(zr.y), bflo(zr.z), bfhi(zr.z), bflo(zr.w), bfhi(zr.w)};
            float y[8];
#pragma unroll
            for (int j = 0; j < 8; ++j) { const float t = ((v[j] - mean) * rs * p.rw_lnx_g[ch + j] + p.rw_lnx_b[ch + j] + rkr * vv[j]) * gg[j]; y[j] = t * siluf_(zz[j]); }
            *(u32x4*)(Y + (size_t)r * DIN + ch) = (u32x4){pk2(y[0], y[1]), pk2(y[2], y[3]), pk2(y[4], y[5]), pk2(y[6], y[7])};
        }
        { const int cm = c.lane * 8; const u32x4 mr = *(const u32x4*)(YM + (size_t)r * DX + cm), zr = *(const u32x4*)(P2 + (size_t)r * P2W + 512 + DMIX + cm);
          const float mm[8] = {bflo(mr.x), bfhi(mr.x), bflo(mr.y), bfhi(mr.y), bflo(mr.z), bfhi(mr.z), bflo(mr.w), bfhi(mr.w)};
          const float zz[8] = {bflo(zr.x), bfhi(zr.x), bflo(zr.y), bfhi(zr.y), bflo(zr.z), bfhi(zr.z), bflo(zr.w), bfhi(zr.w)};
          float y[8];
#pragma unroll
          for (int j = 0; j < 8; ++j) y[j] = mm[j] * siluf_(zz[j]);
          *(u32x4*)(Y + (size_t)r * DIN + DMIX + cm) = (u32x4){pk2(y[0], y[1]), pk2(y[2], y[3]), pk2(y[4], y[5]), pk2(y[6], y[7])}; }
    }
}

__device__ __forceinline__ bool fresh_ctx(Ctx& c, P& p, unsigned char* ws0) { int t = threadIdx.x; asm volatile("" : "+v"(t)); c.tid = t; c.wv = __builtin_amdgcn_readfirstlane(t >> 6); c.lane = t & 63;
    int bb = (int)blockIdx.x, gg = (int)gridDim.x; asm volatile("" : "+s"(bb), "+s"(gg)); c.bid = bb; c.G = gg;
#if defined(__HIP_DEVICE_COMPILE__)
    { typedef const __attribute__((address_space(4))) unsigned long long* KP; KP kp = (KP)__builtin_amdgcn_kernarg_segment_ptr(); asm volatile("" : "+s"(kp));
      typedef __attribute__((address_space(1))) char* GP; char** dst = (char**)&p;
#pragma unroll
      for (int i = 0; i < (int)(sizeof(P) / 8); ++i) dst[i] = (char*)(GP)(kp[i]); }
#endif
    size_t z = 0; asm volatile("" : "+s"(z)); p.ws = ws0 + z; c.seg = ws0 + z + OFF_SEG;
    return true; }
__global__ __launch_bounds__(512) void fwd_megakernel(P p_arg) {
    P p = p_arg;
    extern __shared__ __attribute__((aligned(16))) unsigned char shm[];
    LAS unsigned char* lds = (LAS unsigned char*)shm;
    Ctx c; c.tid = threadIdx.x; c.wv = threadIdx.x >> 6; c.lane = threadIdx.x & 63; c.G = gridDim.x; c.bid = blockIdx.x; c.lds = lds; c.seg = p.ws + OFF_SEG;
    volatile LAS unsigned* st = (volatile LAS unsigned*)(lds + LDS_BYTES - 16);
    if (c.tid == 0) { st[0] = 0u; st[1] = 0u; }
    __syncthreads();
    const XcdBarrier xb = xcd_barrier_post((unsigned*)(p.ws + OFF_BAR), st);
#define GSYNC() do { XcdBarrier _xl = xb; size_t _zz = 0; asm volatile("" : "+s"(_zz)); _xl.bar = xb.bar + _zz; _xl.x = xb_xcc_id();     \
        xcd_barrier(_xl); if (RK == 20) { for (int _q = 1; _q < RN; ++_q) xcd_barrier(_xl); } } while (0)
#ifndef RK
#define RK -1
#endif
#ifndef RN
#define RN 1
#endif
#define NREP(k) ((k) == RK ? RN : 1)
#define PH(k) for (int _r = 0; _r < NREP(k); ++_r) if (fresh_ctx(c, p, p_arg.ws))
#define LASTREP(k) (_r + 1 == NREP(k))
    PH(0) phase0(p, c);
    PH(1) phase_apre(p, c, 0, c.bid, c.G);
    GSYNC();
    for (int seg = 0; seg < NSEG; ++seg) {
        PH(2) { SchedA0 S; S.ws = p.ws; S.seg = c.seg; S.G = c.G; S.c = c.bid; S.nextra = (seg == 0) ? 64 : 0;
          pg8::gemm_phase<pg8::EpiBf, SchedA0>(lds, c.tid, 1024, 1024, S, pg8::EpiBf{}); }
        GSYNC();
        PH(3) phase_a1(p, c, seg);
        GSYNC();
        for (int it0 = c.bid; it0 < 256; it0 += c.G) {
            const int xq = it0 & 7, yq = it0 >> 3; const int it = (yq < 24) ? ((xq * 4 + yq / 6) * 6 + yq % 6) : (192 + (yq - 24) * 8 + xq);
            if (it < 192) { PH(4) mlstm_item(p, c, seg, it, LASTREP(4)); }
            else { PH(5) attn_item(p, c, 0, it - 192, (const bf16_t*)(c.seg + S0_P0) + DMIX, ML_W, (bf16_t*)(c.seg + S0_YMEM)); }
        }
        GSYNC();
        PH(6) phase_a3(p, c, seg);
        GSYNC();
        PH(7) { SchedOut S; S.Y = (const char*)(c.seg + S0_Y); S.W = (const char*)(p.ws + OFF_WO0T); S.slab = (char*)(c.seg + S0_SLAB); S.G = c.G; S.c = c.bid;
          pg8::gemm_phase<pg8::EpiBf, SchedOut>(lds, c.tid, DIN, 512, S, pg8::EpiBf{}); }
        GSYNC();
        PH(8) phase_a5(p, c, seg);
        GSYNC();
        PH(9) { SchedB0 S; S.ws = p.ws; S.seg = c.seg; S.G = c.G; S.c = c.bid;
          pg8::gemm_phase<pg8::EpiBf, SchedB0>(lds, c.tid, 1024, 1024, S, pg8::EpiBf{}); }
        GSYNC();
        PH(10) phase_b1(p, c, seg);
        GSYNC();
        for (int it = c.bid; it < 256; it += c.G) {
            if (it < 192) { PH(11) rwkv_chunk_item(p, c, seg, it, LASTREP(11)); }
            else { PH(5) attn_item(p, c, 1, it - 192, (const bf16_t*)(c.seg + S1_P2), P2W, (bf16_t*)(c.seg + S1_YMEM));
                   if (c.G == 256) { PH(1) if (seg + 1 < NSEG) phase_apre(p, c, seg + 1, it - 192, 64); } }
        }
        GSYNC();
        PH(12) phase_b3(p, c);
        GSYNC();
        PH(13) { SchedOut S; S.Y = (const char*)(c.seg + S1_Y); S.W = (const char*)(p.ws + OFF_WO1T); S.slab = (char*)(c.seg + S1_SLAB); S.G = c.G; S.c = c.bid;
          pg8::gemm_phase<pg8::EpiBf, SchedOut>(lds, c.tid, DIN, 512, S, pg8::EpiBf{}); }
        GSYNC();
        PH(14) phase_b5(p, c, seg);
        if (c.G != 256) { PH(1) if (seg + 1 < NSEG) phase_apre(p, c, seg + 1, c.bid, c.G); GSYNC(); }
    }
}

extern "C" void kernel_launch(void* const* d_in, const int* in_sizes, int n_in, void* d_out, int out_size, void* d_ws, size_t ws_size, hipStream_t stream) {
    static int grid = 0;
    if (grid == 0) {
        int dev = 0, cus = 0, per_cu = 0;
        if (hipGetDevice(&dev) != hipSuccess || hipDeviceGetAttribute(&cus, hipDeviceAttributeMultiprocessorCount, dev) != hipSuccess) { grid = -1; return; }
        if (hipFuncSetAttribute((const void*)fwd_megakernel, hipFuncAttributeMaxDynamicSharedMemorySize, LDS_BYTES) != hipSuccess) { fprintf(stderr, "hipFuncSetAttribute failed\n"); grid = -1; return; }
        if (hipOccupancyMaxActiveBlocksPerMultiprocessor(&per_cu, (const void*)fwd_megakernel, 512, LDS_BYTES) != hipSuccess || per_cu < 1) { fprintf(stderr, "occupancy query: %d\n", per_cu); }
        (void)hipGetLastError();
        grid = cus;
        if (n_in != 31 || ws_size < 256 * MiB) { fprintf(stderr, "unexpected n_in %d / ws %zu\n", n_in, ws_size); grid = -1; return; }
    }
    if (grid < 0) return;
    (void)hipMemsetAsync((char*)d_ws + OFF_BAR, 0, XCD_BAR_WORDS * 4, stream);
    P p{};
    const float** f = (const float**)&p;
    for (int i = 0; i < 31; ++i) f[i] = (const float*)d_in[i];
    p.out = (float*)d_out; p.ws = (unsigned char*)d_ws;
    fwd_megakernel<<<dim3(grid), dim3(512), LDS_BYTES, stream>>>(p);
}
```

```cpp
#include <hip/hip_runtime.h>
#include <cstdio>
#include <cstdint>

#define LAS __attribute__((address_space(3)))
typedef unsigned short bf16_t;
typedef short bf16x8 __attribute__((ext_vector_type(8)));
typedef short bf16x4 __attribute__((ext_vector_type(4)));
typedef float f32x4 __attribute__((ext_vector_type(4)));
typedef float f32x2 __attribute__((ext_vector_type(2)));
typedef unsigned u32x4 __attribute__((ext_vector_type(4)));
typedef unsigned u32x2 __attribute__((ext_vector_type(2)));

constexpr int NB = 8, SEQ = 2048, DM = 1024, NSEG = 4, SEGT = 512, MS = NB * SEGT;
constexpr int DMIX = 1536, DX = 512, DIN = 2048;
constexpr int ML_W = 4096, RW_SHIFT = 4896, RW_W = 7456;
constexpr int P1W = 5120, P2W = 2560;
constexpr size_t MiB = 1u << 20;
constexpr size_t OFF_WT0 = 0, OFF_WT1 = 8 * MiB, OFF_WO0T = 23 * MiB, OFF_WO1T = 27 * MiB, OFF_WKVT = 31 * MiB  ,
                 OFF_KMEM = 35 * MiB  , OFF_LORAT = 43 * MiB, OFF_MISC = 45 * MiB,
                 OFF_CST = 46 * MiB, OFF_NST = 65 * MiB, OFF_RST = 65 * MiB + 512 * 1024, OFF_H = 69 * MiB, OFF_VF = 77 * MiB,
                 OFF_SEG = 89 * MiB, OFF_MEMN = 248 * MiB;
constexpr size_t OFF_BAR = OFF_MISC, OFF_UTAIL = OFF_MISC + 64 * 1024, OFF_PTAIL = OFF_MISC + 256 * 1024;
constexpr size_t S0_P0 = 0, S0_Q = 32 * MiB, S0_K = 44 * MiB, S0_KT = 56 * MiB, S0_VT = 68 * MiB, S0_XC = 80 * MiB, S0_HRAW = 92 * MiB,
                 S0_YMEM = 116 * MiB, S0_Y = 120 * MiB, S0_GATE = 136 * MiB;
constexpr size_t S1_P1 = 0, S1_O = 0, S1_Y = 24 * MiB, S1_P2 = 40 * MiB, S1_W = 60 * MiB, S1_A = 84 * MiB, S1_B = 96 * MiB, S1_K = 108 * MiB,
                 S1_Q = 120 * MiB, S1_V = 132 * MiB, S1_G = 144 * MiB, S1_YMEM = 156 * MiB, S1_BRKR = 160 * MiB;
constexpr size_t S0_SLAB = 0  , S1_SLAB = 84 * MiB  ;
constexpr int LDS_BYTES = 150 * 1024;

struct P {
    const float *x, *mem, *norm_g, *mem_norm_g, *mem_kv_w, *w_out, *ml_w_in, *ml_conv_w, *ml_conv_b, *ml_wq, *ml_wk, *ml_wv, *ml_w_gate, *ml_b_gate,
        *ml_mhn_g, *ml_skip, *rw_w_in, *rw_mu, *rw_w_lora2, *rw_w0, *rw_a_lora2, *rw_a0, *rw_v_lora2, *rw_v0, *rw_g_lora2, *rw_k_k, *rw_k_a, *rw_r_k,
        *rw_lnx_g, *rw_lnx_b, *final_g;
    float* out; unsigned char* ws;
};

__device__ __forceinline__ bf16_t f2bf(float f) { unsigned u = __float_as_uint(f); u += 0x7FFFu + ((u >> 16) & 1u); return (bf16_t)(u >> 16); }
__device__ __forceinline__ float bf2f(bf16_t b) { return __uint_as_float(((unsigned)b) << 16); }
__device__ __forceinline__ unsigned pk2(float lo, float hi) { return (unsigned)f2bf(lo) | ((unsigned)f2bf(hi) << 16); }
__device__ __forceinline__ float bflo(unsigned u) { return __uint_as_float(u << 16); }
__device__ __forceinline__ float bfhi(unsigned u) { return __uint_as_float(u & 0xFFFF0000u); }
__device__ __forceinline__ float wsum(float v) {
#pragma unroll
    for (int o = 32; o >= 1; o >>= 1) v += __shfl_xor(v, o);
    return v;
}
__device__ __forceinline__ float sigmoidf_(float x) { return 1.0f / (1.0f + __expf(-x)); }
__device__ __forceinline__ float siluf_(float x) { return x / (1.0f + __expf(-x)); }
__device__ __forceinline__ float softplusf_(float z) { return fmaxf(z, 0.f) + __logf(1.0f + __expf(-fabsf(z))); }
template <int CTRL> __device__ __forceinline__ float dpp_add(float v) {
    return v + __int_as_float(__builtin_amdgcn_update_dpp(0, __float_as_int(v), CTRL, 0xF, 0xF, true));
}
__device__ __forceinline__ float row16_allsum(float v) {
    v = dpp_add<0xB1>(v);
    v = dpp_add<0x4E>(v);
    v = dpp_add<0x141>(v);
    v = dpp_add<0x140>(v);
    return v;
}
__device__ __forceinline__ void row16_allsum4(float& a, float& b, float& c, float& d) {
    asm volatile("s_nop 1\n\t"
        "v_add_f32_dpp %0, %0, %0 quad_perm:[1,0,3,2] row_mask:0xf bank_mask:0xf\n\t" "v_add_f32_dpp %1, %1, %1 quad_perm:[1,0,3,2] row_mask:0xf bank_mask:0xf\n\t"
        "v_add_f32_dpp %2, %2, %2 quad_perm:[1,0,3,2] row_mask:0xf bank_mask:0xf\n\t" "v_add_f32_dpp %3, %3, %3 quad_perm:[1,0,3,2] row_mask:0xf bank_mask:0xf\n\t"
        "v_add_f32_dpp %0, %0, %0 quad_perm:[2,3,0,1] row_mask:0xf bank_mask:0xf\n\t" "v_add_f32_dpp %1, %1, %1 quad_perm:[2,3,0,1] row_mask:0xf bank_mask:0xf\n\t"
        "v_add_f32_dpp %2, %2, %2 quad_perm:[2,3,0,1] row_mask:0xf bank_mask:0xf\n\t" "v_add_f32_dpp %3, %3, %3 quad_perm:[2,3,0,1] row_mask:0xf bank_mask:0xf\n\t"
        "v_add_f32_dpp %0, %0, %0 row_half_mirror row_mask:0xf bank_mask:0xf\n\t" "v_add_f32_dpp %1, %1, %1 row_half_mirror row_mask:0xf bank_mask:0xf\n\t"
        "v_add_f32_dpp %2, %2, %2 row_half_mirror row_mask:0xf bank_mask:0xf\n\t" "v_add_f32_dpp %3, %3, %3 row_half_mirror row_mask:0xf bank_mask:0xf\n\t"
        "v_add_f32_dpp %0, %0, %0 row_mirror row_mask:0xf bank_mask:0xf\n\t" "v_add_f32_dpp %1, %1, %1 row_mirror row_mask:0xf bank_mask:0xf\n\t"
        "v_add_f32_dpp %2, %2, %2 row_mirror row_mask:0xf bank_mask:0xf\n\t" "v_add_f32_dpp %3, %3, %3 row_mirror row_mask:0xf bank_mask:0xf\n\t"
        "s_nop 1"
        : "+v"(a), "+v"(b), "+v"(c), "+v"(d));
}
template <int N> __device__ __forceinline__ float dpp_shr_or1(float v) {
    return __int_as_float(__builtin_amdgcn_update_dpp(0x3f800000, __float_as_int(v), 0x110 + N, 0xF, 0xF, false));
}
__device__ __forceinline__ f32x4 mfma16(bf16x8 a, bf16x8 b, f32x4 c) { return __builtin_amdgcn_mfma_f32_16x16x32_bf16(a, b, c, 0, 0, 0); }

namespace pg8 {
constexpr int BM = 256, BK = 64, HALF = 128, HTB = HALF * BK * 2, STAGE_BYTES = 8 * HTB, NXCD = 8, WGM = 8;
__host__ __device__ __forceinline__ int lds_byte(int r, int c) { const int st = (r >> 4) * 2 + (c >> 5), rr = r & 15, cc = c & 31, ob = rr * 64 + cc * 2; return st * 1024 + (ob ^ (((ob >> 9) & 1) << 5)); }
__host__ __device__ __forceinline__ void stage_rc(int b, int& R, int& C) { const int st = b / 1024, sb = b % 1024, swz = sb ^ (((sb >> 9) & 1) << 5); R = (st >> 1) * 16 + swz / 64; C = (st & 1) * 32 + (swz % 64) / 2; }
__host__ __device__ __forceinline__ int perm32(int rho) { const int n = rho >> 4, i = rho & 15; return 8 * (i >> 2) + 4 * n + (i & 3); }

struct Unit { const char* A; const char* B; char* O; int ldc; int pad; };

__device__ __forceinline__ void remap(int wgid, int nM, int nN, int& pm, int& pn) {
    const int nwg = nM * nN;
    { const int q = nwg / NXCD, r = nwg % NXCD, xcd = wgid % NXCD, off = wgid / NXCD; wgid = (xcd < r ? xcd * (q + 1) : r * (q + 1) + (xcd - r) * q) + off; }
    const int nig = WGM * nN, gid = wgid / nig, fm = gid * WGM, gsz = (nM - fm) < WGM ? (nM - fm) : WGM;
    pm = fm + ((wgid % nig) % gsz); pn = (wgid % nig) / gsz;
}

struct EpiBf {
    static constexpr bool PERM = true;
    __device__ __forceinline__ void operator()(const f32x4 (&acc)[2][2][4][2], const Unit& u, int wr, int wc, int fr, int fq) const {
        asm volatile("" : "+v"(fr), "+v"(fq));
        bf16_t* base = (bf16_t*)u.O;
#pragma unroll
        for (int ai = 0; ai < 2; ++ai)
#pragma unroll
            for (int m = 0; m < 4; ++m) { bf16_t* rowp = base + (size_t)(ai * HALF + wr * 64 + m * 16 + fr) * u.ldc + wc * 32 + 8 * fq;
#pragma unroll
                for (int bj = 0; bj < 2; ++bj) { const f32x4 v0 = acc[ai][bj][m][0], v1 = acc[ai][bj][m][1];
                    u32x4 w; w.x = pk2(v0[0], v0[1]); w.y = pk2(v0[2], v0[3]); w.z = pk2(v1[0], v1[1]); w.w = pk2(v1[2], v1[3]);
                    *(u32x4*)(rowp + bj * HALF) = w; } }
    }
};
struct EpiAtomic {
    static constexpr bool PERM = false;
    __device__ __forceinline__ void operator()(const f32x4 (&acc)[2][2][4][2], const Unit& u, int wr, int wc, int fr, int fq) const {
        asm volatile("" : "+v"(fr), "+v"(fq));
        float* base = (float*)u.O;
#pragma unroll
        for (int ai = 0; ai < 2; ++ai)
#pragma unroll
            for (int m = 0; m < 4; ++m) { float* rowp = base + (size_t)(ai * HALF + wr * 64 + m * 16 + fr) * u.ldc + wc * 32 + 4 * fq;
#pragma unroll
                for (int bj = 0; bj < 2; ++bj)
#pragma unroll
                    for (int n = 0; n < 2; ++n) { const f32x4 v = acc[ai][bj][m][n]; float* q = rowp + bj * HALF + n * 16;
#pragma unroll
                        for (int e = 0; e < 4; ++e) (void)__hip_atomic_fetch_add(q + e, v[e], __ATOMIC_RELAXED, __HIP_MEMORY_SCOPE_AGENT); }
                __builtin_amdgcn_sched_barrier(0); }
    }
};

template <class Epi, class Sched>
__device__ __forceinline__ void gemm_phase(LAS unsigned char* lds, const int tid, const int ldk, const int Kloop, const Sched& S, const Epi& E) {
    const int wid = __builtin_amdgcn_readfirstlane(tid >> 6), lane = tid & 63, wr = wid >> 2, wc = wid & 3, fr = lane & 15, fq = lane >> 4;
    const int nt = Kloop / BK;
    unsigned voffA[2], voffB[2];
#pragma unroll
    for (int i = 0; i < 2; ++i) { int R, C; stage_rc(tid * 16 + i * 8192, R, C); const int Rb = Epi::PERM ? ((R & ~31) + perm32(R & 31)) : R;
        voffA[i] = (unsigned)(R * ldk + C) * 2u; voffB[i] = (unsigned)(Rb * ldk + C) * 2u; }
    const size_t kstep = (size_t)(BK * 2);
    const size_t hstep = (size_t)HALF * ldk * 2;
    const unsigned ldsw = (unsigned)wid * 1024u;
    const int aoff = lds_byte(wr * 64 + fr, fq * 8), boff = lds_byte(wc * 32 + fr, fq * 8);
#define PG8_SA(b, h) (((b) * 2 + (h)) * HTB)
#define PG8_SB(b, h) ((4 + (b) * 2 + (h)) * HTB)
#define PG8_STAGE(bufoff, gbase, voff) do { _Pragma("unroll") for (int _i = 0; _i < 2; ++_i) \
        __builtin_amdgcn_global_load_lds((const unsigned*)((const char*)(gbase) + (voff)[_i]), (LAS unsigned*)(lds + (bufoff) + ldsw + _i * 8192), 16, 0, 0); } while (0)
#define PG8_LDA(dst, b, h) do { _Pragma("unroll") for (int m = 0; m < 4; ++m) _Pragma("unroll") for (int k = 0; k < 2; ++k) dst[m][k] = *(const LAS bf16x8*)(lds + PG8_SA(b, h) + aoff + m * 2048 + k * 1024); } while (0)
#define PG8_LDB(dst, b, h) do { _Pragma("unroll") for (int n = 0; n < 2; ++n) _Pragma("unroll") for (int k = 0; k < 2; ++k) dst[n][k] = *(const LAS bf16x8*)(lds + PG8_SB(b, h) + boff + n * 2048 + k * 1024); } while (0)
#define PG8_MMA(ai, bj, At, Bt) do { __builtin_amdgcn_s_setprio(1); _Pragma("unroll") for (int m = 0; m < 4; ++m) _Pragma("unroll") for (int n = 0; n < 2; ++n) _Pragma("unroll") for (int k = 0; k < 2; ++k) \
        acc[ai][bj][m][n] = __builtin_amdgcn_mfma_f32_16x16x32_bf16(Bt[n][k], At[m][k], acc[ai][bj][m][n], 0, 0, 0); __builtin_amdgcn_s_setprio(0); } while (0)
#define PG8_WAIT_V(n) asm volatile("s_waitcnt vmcnt(" #n ")" ::: "memory")
#define PG8_WAIT_L(n) asm volatile("s_waitcnt lgkmcnt(" #n ")" ::: "memory")
#define PG8_BAR __builtin_amdgcn_s_barrier()
#define PG8_SCHED __builtin_amdgcn_sched_barrier(0)
    Unit cur, nxt; int ui = 0;
    if (!S.next(0, cur)) return;
    f32x4 acc[2][2][4][2];
#pragma unroll
    for (int a = 0; a < 2; ++a)
#pragma unroll
        for (int b = 0; b < 2; ++b)
#pragma unroll
            for (int m = 0; m < 4; ++m)
#pragma unroll
                for (int n = 0; n < 2; ++n) acc[a][b][m][n] = (f32x4){0.f, 0.f, 0.f, 0.f};
    bf16x8 At[4][2], B0[2][2], B1[2][2];
    const char* cA = cur.A; const char* cB = cur.B;
    PG8_STAGE(PG8_SB(0, 0), cB, voffB); PG8_STAGE(PG8_SA(0, 0), cA, voffA); PG8_STAGE(PG8_SB(0, 1), cB + hstep, voffB); PG8_STAGE(PG8_SA(0, 1), cA + hstep, voffA);
    if (wr == 1) PG8_BAR;
    PG8_WAIT_V(4); PG8_BAR;
    PG8_STAGE(PG8_SB(1, 0), cB + kstep, voffB); PG8_STAGE(PG8_SA(1, 0), cA + kstep, voffA); PG8_STAGE(PG8_SB(1, 1), cB + hstep + kstep, voffB);
    PG8_WAIT_V(6); PG8_BAR;
    for (;;) {
        const bool has_next = S.next(ui + 1, nxt);
        const char* nA = has_next ? nxt.A : cA; const char* nB = has_next ? nxt.B : cB;
        for (int t = 0; t < nt; t += 2) {
            const bool last = (t == nt - 2);
            const char* a1 = cA + (size_t)(t + 1) * kstep;
            const char* a2 = last ? nA : cA + (size_t)(t + 2) * kstep; const char* b2 = last ? nB : cB + (size_t)(t + 2) * kstep;
            const char* a3 = a2 + kstep; const char* b3 = b2 + kstep;
            PG8_LDB(B0, 0, 0); PG8_SCHED; PG8_LDA(At, 0, 0); PG8_STAGE(PG8_SA(1, 1), a1 + hstep, voffA);
            PG8_WAIT_L(8); PG8_BAR; PG8_WAIT_L(0); PG8_MMA(0, 0, At, B0); PG8_BAR; PG8_SCHED;
            PG8_LDB(B1, 0, 1); PG8_STAGE(PG8_SB(0, 0), b2, voffB);
            PG8_BAR; PG8_WAIT_L(0); PG8_MMA(0, 1, At, B1); PG8_BAR;
            PG8_LDA(At, 0, 1); PG8_STAGE(PG8_SA(0, 0), a2, voffA);
            PG8_BAR; PG8_WAIT_L(0); PG8_MMA(1, 0, At, B0); PG8_BAR; PG8_SCHED;
            PG8_STAGE(PG8_SB(0, 1), b2 + hstep, voffB);
            PG8_WAIT_V(6); PG8_BAR; PG8_MMA(1, 1, At, B1); PG8_BAR;
            PG8_LDB(B0, 1, 0); PG8_SCHED; PG8_LDA(At, 1, 0); PG8_STAGE(PG8_SA(0, 1), a2 + hstep, voffA);
            PG8_WAIT_L(8); PG8_BAR; PG8_WAIT_L(0); PG8_MMA(0, 0, At, B0); PG8_BAR; PG8_SCHED;
            PG8_LDB(B1, 1, 1); PG8_STAGE(PG8_SB(1, 0), b3, voffB);
            PG8_BAR; PG8_WAIT_L(0); PG8_MMA(0, 1, At, B1); PG8_BAR;
            PG8_LDA(At, 1, 1); PG8_STAGE(PG8_SA(1, 0), a3, voffA);
            PG8_BAR; PG8_WAIT_L(0); PG8_MMA(1, 0, At, B0); PG8_BAR; PG8_SCHED;
            PG8_STAGE(PG8_SB(1, 1), b3 + hstep, voffB);
            PG8_WAIT_V(6); PG8_BAR; PG8_MMA(1, 1, At, B1); PG8_BAR;
        }
        E(acc, cur, wr, wc, fr, fq);
        if (!has_next) break;
#pragma unroll
        for (int a = 0; a < 2; ++a)
#pragma unroll
            for (int b = 0; b < 2; ++b)
#pragma unroll
                for (int m = 0; m < 4; ++m)
#pragma unroll
                    for (int n = 0; n < 2; ++n) acc[a][b][m][n] = (f32x4){0.f, 0.f, 0.f, 0.f};
        cur = nxt; cA = nA; cB = nB; ++ui;
    }
    PG8_WAIT_V(0);
    if (wr == 0) PG8_BAR;
    PG8_BAR;
#undef PG8_SA
#undef PG8_SB
#undef PG8_STAGE
#undef PG8_LDA
#undef PG8_LDB
#undef PG8_MMA
#undef PG8_WAIT_V
#undef PG8_WAIT_L
#undef PG8_BAR
#undef PG8_SCHED
}
}

#define XB_TMO      128
#define XB_XCNT(j)  (256  + 64 * (j))
#define XB_XSUB(j)  (1280 + 64 * (j))
#define XB_XGEN(j)  (2304 + 64 * (j))
#define XB_TOP      3328
#define XB_TOPGEN   3392
#define XCD_BAR_WORDS 3456
#define XB_SPIN_CAP (1u << 18)
__device__ __forceinline__ unsigned xb_ld(unsigned* p)              { return __hip_atomic_load(p, __ATOMIC_RELAXED, __HIP_MEMORY_SCOPE_AGENT); }
__device__ __forceinline__ unsigned xb_add(unsigned* p, unsigned v) { return __hip_atomic_fetch_add(p, v, __ATOMIC_RELAXED, __HIP_MEMORY_SCOPE_AGENT); }
__device__ __forceinline__ unsigned xb_xcc_id() { return (unsigned)__builtin_amdgcn_s_getreg((3 << 11) | 20) & 0xFu; }
#define XB_SPIN(cond, bar) do { unsigned _sp = 0; while (cond) { __builtin_amdgcn_s_sleep(1); \
    if ((++_sp & 255u) == 0u) { if (xb_ld(&(bar)[XB_TMO])) break; if (_sp > XB_SPIN_CAP) { atomicAdd(&(bar)[XB_TMO], 1u); break; } } } } while (0)
struct XcdBarrier { unsigned* bar; unsigned x; volatile LAS unsigned* st; };
__device__ __forceinline__ XcdBarrier xcd_barrier_post(unsigned* bar, volatile LAS unsigned* st) {
    XcdBarrier b; b.bar = bar; b.x = xb_xcc_id(); b.st = st;
    if (threadIdx.x == 0) (void)xb_add(&bar[XB_XCNT(b.x)], 1u);
    return b;
}
__device__ __forceinline__ void xcd_barrier_complete(unsigned* bar, unsigned x, unsigned& nloc, unsigned& nx) {
    const unsigned G = gridDim.x * gridDim.y * gridDim.z;
    unsigned sum, cnt, mine, sp = 0u;
    for (;;) {
        sum = 0u; cnt = 0u; mine = 0u;
#pragma unroll
        for (unsigned j = 0; j < 16; ++j) { const unsigned c = xb_ld(&bar[XB_XCNT(j)]); sum += c; cnt += (c > 0u) ? 1u : 0u; mine = (j == x) ? c : mine; }
        if (sum == G) break;
        __builtin_amdgcn_s_sleep(1);
        if ((++sp & 255u) == 0u) { if (xb_ld(&bar[XB_TMO])) break; if (sp > XB_SPIN_CAP) { atomicAdd(&bar[XB_TMO], 1u); break; } }
    }
    nloc = mine > 0u ? mine : 1u; nx = cnt > 0u ? cnt : 1u;
}
__device__ __forceinline__ void xcd_barrier(const XcdBarrier& b) {
    asm volatile("s_waitcnt vmcnt(0)" ::: "memory");
    __syncthreads();
    int tid0 = threadIdx.x; asm volatile("" : "+v"(tid0));
    if (tid0 == 0) {
        unsigned* bar = b.bar;
        __builtin_amdgcn_s_waitcnt(0);
        unsigned nloc = b.st[0], nx = b.st[1];
        if (nloc == 0u) { xcd_barrier_complete(bar, b.x, nloc, nx); b.st[0] = nloc; b.st[1] = nx; }
        const unsigned old = xb_add(&bar[XB_XSUB(b.x)], 1u);
        const unsigned gen = old / nloc;
        if (old + 1u == (gen + 1u) * nloc) {
            __builtin_amdgcn_fence(__ATOMIC_RELEASE, "agent");
            asm volatile("s_waitcnt vmcnt(0)" ::: "memory");
            const unsigned og = xb_add(&bar[XB_TOP], 1u);
            const unsigned tg = og / nx;
            if (og + 1u == (tg + 1u) * nx) xb_add(&bar[XB_TOPGEN], 1u);
            else XB_SPIN(xb_ld(&bar[XB_TOPGEN]) == tg, bar);
            __builtin_amdgcn_fence(__ATOMIC_ACQUIRE, "agent");
            xb_add(&bar[XB_XGEN(b.x)], 1u);
            asm volatile("s_waitcnt vmcnt(0)" ::: "memory");
        } else {
            XB_SPIN(xb_ld(&bar[XB_XGEN(b.x)]) == gen, bar);
            __builtin_amdgcn_fence(__ATOMIC_ACQUIRE, "agent");
            asm volatile("s_waitcnt vmcnt(0)" ::: "memory");
        }
    }
    __syncthreads();
}

__device__ __forceinline__ void lds_barrier() { asm volatile("s_waitcnt lgkmcnt(0)" ::: "memory"); __builtin_amdgcn_s_barrier(); asm volatile("" ::: "memory"); }
struct Ctx { int tid, wv, lane, G, bid; LAS unsigned char* lds; unsigned char* seg; };

template <int MODE>
__device__ __forceinline__ void convT_tile(const Ctx& c, const float* src, int ldsrc, int Ksrc, int k0, int n0, bf16_t* dst, int ldd, int koff) {
    LAS float* tile = (LAS float*)c.lds;
    __syncthreads();
#pragma unroll
    for (int rep = 0; rep < 2; ++rep) {
        const int i = (c.tid >> 4) + 32 * rep, j4 = (c.tid & 15) * 4; const int n = n0 + j4; int sc = n;
        if (MODE == 1) sc = (n < RW_SHIFT) ? n : (n < P1W ? -1 : n - (P1W - RW_SHIFT));
        f32x4 v = (f32x4){0.f, 0.f, 0.f, 0.f};
        if (sc >= 0 && (k0 + i) < Ksrc) v = *(const f32x4*)(src + (size_t)(k0 + i) * ldsrc + sc);
        tile[i * 65 + j4 + 0] = v[0]; tile[i * 65 + j4 + 1] = v[1]; tile[i * 65 + j4 + 2] = v[2]; tile[i * 65 + j4 + 3] = v[3];
    }
    __syncthreads();
    { const int j = c.tid >> 3, i8 = (c.tid & 7) * 8;
      if (k0 + i8 < Ksrc) {
        u32x4 w; w.x = pk2(tile[(i8 + 0) * 65 + j], tile[(i8 + 1) * 65 + j]); w.y = pk2(tile[(i8 + 2) * 65 + j], tile[(i8 + 3) * 65 + j]);
        w.z = pk2(tile[(i8 + 4) * 65 + j], tile[(i8 + 5) * 65 + j]); w.w = pk2(tile[(i8 + 6) * 65 + j], tile[(i8 + 7) * 65 + j]);
        *(u32x4*)(dst + (size_t)(n0 + j) * ldd + koff + k0 + i8) = w; } }
}

__device__ __forceinline__ void rms_row_bf16(const float* src, const float* g, bf16_t* dst, int lane) {
    f32x4 v[4]; float ss = 0.f;
#pragma unroll
    for (int i = 0; i < 4; ++i) { v[i] = *(const f32x4*)(src + i * 256 + lane * 4); ss += v[i][0] * v[i][0] + v[i][1] * v[i][1] + v[i][2] * v[i][2] + v[i][3] * v[i][3]; }
    ss = wsum(ss); const float rs = rsqrtf(ss * (1.0f / 1024.0f) + 1e-6f);
#pragma unroll
    for (int i = 0; i < 4; ++i) { const f32x4 gg = *(const f32x4*)(g + i * 256 + lane * 4);
        u32x2 w; w.x = pk2(v[i][0] * rs * gg[0], v[i][1] * rs * gg[1]); w.y = pk2(v[i][2] * rs * gg[2], v[i][3] * rs * gg[3]);
        *(u32x2*)(dst + i * 256 + lane * 4) = w; }
}
__device__ __forceinline__ float add_slabs(const float* src, const bf16_t* slab, int r, int lane, f32x4 (&v)[4]) {
    float ss = 0.f;
#pragma unroll
    for (int i = 0; i < 4; ++i) { v[i] = *(const f32x4*)(src + i * 256 + lane * 4);
#pragma unroll
        for (int ks = 0; ks < 4; ++ks) { const u32x2 t = *(const u32x2*)(slab + ((size_t)ks * MS + r) * DM + i * 256 + lane * 4);
            v[i][0] += bflo(t.x); v[i][1] += bfhi(t.x); v[i][2] += bflo(t.y); v[i][3] += bfhi(t.y); }
        ss += v[i][0] * v[i][0] + v[i][1] * v[i][1] + v[i][2] * v[i][2] + v[i][3] * v[i][3]; }
    return wsum(ss);
}

__device__ __forceinline__ void phase_apre(const P& p, const Ctx& c, int seg, int wg, int nwg) {
    bf16_t* H = (bf16_t*)(p.ws + OFF_H);
    for (int r = wg * 8 + c.wv; r < MS; r += nwg * 8) { const int b = r >> 9, tl = r & 511; const size_t grow = (size_t)b * SEQ + seg * SEGT + tl;
        rms_row_bf16(p.x + grow * DM, p.norm_g, H + (size_t)r * DM, c.lane); }
}
__device__ __forceinline__ void phase_a5(const P& p, const Ctx& c, int seg) {
    bf16_t* H = (bf16_t*)(p.ws + OFF_H); const bf16_t* slab = (const bf16_t*)(c.seg + S0_SLAB);
    for (int r = c.bid * 8 + c.wv; r < MS / 2; r += c.G * 8) {
        const int ra = r, rb = r + MS / 2;
        const size_t ga = (size_t)(ra >> 9) * SEQ + seg * SEGT + (ra & 511), gb = (size_t)(rb >> 9) * SEQ + seg * SEGT + (rb & 511);
        f32x4 va[4], vb[4]; const float sa = add_slabs(p.x + ga * DM, slab, ra, c.lane, va); const float sb = add_slabs(p.x + gb * DM, slab, rb, c.lane, vb);
        const float rsa = rsqrtf(sa * (1.0f / 1024.0f) + 1e-6f), rsb = rsqrtf(sb * (1.0f / 1024.0f) + 1e-6f);
#pragma unroll
        for (int i = 0; i < 4; ++i) { const f32x4 gg = *(const f32x4*)(p.norm_g + DM + i * 256 + c.lane * 4);
            *(f32x4*)(p.out + ga * DM + i * 256 + c.lane * 4) = va[i]; *(f32x4*)(p.out + gb * DM + i * 256 + c.lane * 4) = vb[i];
            u32x2 w; w.x = pk2(va[i][0] * rsa * gg[0], va[i][1] * rsa * gg[1]); w.y = pk2(va[i][2] * rsa * gg[2], va[i][3] * rsa * gg[3]);
            *(u32x2*)(H + (size_t)ra * DM + i * 256 + c.lane * 4) = w;
            w.x = pk2(vb[i][0] * rsb * gg[0], vb[i][1] * rsb * gg[1]); w.y = pk2(vb[i][2] * rsb * gg[2], vb[i][3] * rsb * gg[3]);
            *(u32x2*)(H + (size_t)rb * DM + i * 256 + c.lane * 4) = w; } }
}
__device__ __forceinline__ void phase_b5(const P& p, const Ctx& c, int seg) {
    const bf16_t* slab = (const bf16_t*)(c.seg + S1_SLAB);
    for (int r = c.bid * 8 + c.wv; r < MS / 2; r += c.G * 8) {
        const int ra = r, rb = r + MS / 2;
        float* rowa = p.out + ((size_t)(ra >> 9) * SEQ + seg * SEGT + (ra & 511)) * DM; float* rowb = p.out + ((size_t)(rb >> 9) * SEQ + seg * SEGT + (rb & 511)) * DM;
        f32x4 va[4], vb[4]; const float sa = add_slabs(rowa, slab, ra, c.lane, va); const float sb = add_slabs(rowb, slab, rb, c.lane, vb);
        const float rsa = rsqrtf(sa * (1.0f / 1024.0f) + 1e-6f), rsb = rsqrtf(sb * (1.0f / 1024.0f) + 1e-6f);
#pragma unroll
        for (int i = 0; i < 4; ++i) { const f32x4 gg = *(const f32x4*)(p.final_g + i * 256 + c.lane * 4); f32x4 o;
            o[0] = va[i][0] * rsa * gg[0]; o[1] = va[i][1] * rsa * gg[1]; o[2] = va[i][2] * rsa * gg[2]; o[3] = va[i][3] * rsa * gg[3]; *(f32x4*)(rowa + i * 256 + c.lane * 4) = o;
            o[0] = vb[i][0] * rsb * gg[0]; o[1] = vb[i][1] * rsb * gg[1]; o[2] = vb[i][2] * rsb * gg[2]; o[3] = vb[i][3] * rsb * gg[3]; *(f32x4*)(rowb + i * 256 + c.lane * 4) = o; } }
}

__device__ __forceinline__ void phase0(const P& p, const Ctx& c) {
    const int T0 = 16 * 64, T1 = 16 * 120, T2 = 32 * 16, T3 = 32 * 16, T4 = 16 * 16, T5 = 16 * 16, T6 = 24 * 5;
    const int TT = T0 + T1 + T2 + T3 + T4 + T5 + T6;
    for (int t = c.bid; t < TT; t += c.G) {
        int u = t;
        if (u < T0) { convT_tile<0>(c, p.ml_w_in, ML_W, 1024, (u & 15) * 64, (u >> 4) * 64, (bf16_t*)(p.ws + OFF_WT0), 1024, 0); continue; } u -= T0;
        if (u < T1) { convT_tile<1>(c, p.rw_w_in, RW_W, 1024, (u & 15) * 64, (u >> 4) * 64, (bf16_t*)(p.ws + OFF_WT1), 1024, 0); continue; } u -= T1;
        if (u < T2) { convT_tile<0>(c, p.w_out, DM, 2048, (u & 31) * 64, (u >> 5) * 64, (bf16_t*)(p.ws + OFF_WO0T), 2048, 0); continue; } u -= T2;
        if (u < T3) { convT_tile<0>(c, p.w_out + (size_t)DIN * DM, DM, 2048, (u & 31) * 64, (u >> 5) * 64, (bf16_t*)(p.ws + OFF_WO1T), 2048, 0); continue; } u -= T3;
        if (u < T4) { convT_tile<0>(c, p.mem_kv_w, DM, 1024, (u & 15) * 64, (u >> 4) * 64, (bf16_t*)(p.ws + OFF_WKVT), 1024, 0); continue; } u -= T4;
        if (u < T5) { convT_tile<0>(c, p.mem_kv_w + (size_t)DM * DM, DM, 1024, (u & 15) * 64, (u >> 4) * 64, (bf16_t*)(p.ws + OFF_WKVT + 2 * MiB), 1024, 0); continue; } u -= T5;
        { const int nt = u / 5, j = u % 5; bf16_t* L = (bf16_t*)(p.ws + OFF_LORAT);
          if (j == 0) convT_tile<0>(c, p.rw_w_lora2, DMIX, 64, 0, nt * 64, L, 288, 0);
          else if (j == 1) convT_tile<0>(c, p.rw_a_lora2, DMIX, 64, 0, nt * 64, L, 288, 64);
          else if (j == 2) convT_tile<0>(c, p.rw_v_lora2, DMIX, 32, 0, nt * 64, L, 288, 128);
          else convT_tile<0>(c, p.rw_g_lora2, DMIX, 128, (j - 3) * 64, nt * 64, L, 288, 160); }
    }
    for (int r = c.bid * 8 + c.wv; r < 2 * 2048; r += c.G * 8) { const int l = r >> 11, rr = r & 2047;
        rms_row_bf16(p.mem + (size_t)rr * DM, p.mem_norm_g + l * DM, (bf16_t*)(p.ws + OFF_MEMN) + (size_t)r * DM, c.lane); }
}

struct SchedA0 {
    const unsigned char* ws; unsigned char* seg; int G, c, nextra;
    __device__ __forceinline__ bool next(int i, pg8::Unit& u) const {
        const int L = i * G + c; if (L >= 256 + nextra) return false;
        if (L < 256) { int pm, pn; pg8::remap(L, 16, 16, pm, pn);
            u.A = (const char*)(ws + OFF_H) + (size_t)pm * 256 * 1024 * 2; u.B = (const char*)(ws + OFF_WT0) + (size_t)pn * 256 * 1024 * 2;
            u.O = (char*)(seg + S0_P0) + ((size_t)pm * 256 * ML_W + pn * 256) * 2; u.ldc = ML_W; return true; }
        const int e = L - 256, l = e >> 5, j = e & 31;
        const char* memn = (const char*)(ws + OFF_MEMN) + (size_t)l * 2048 * 1024 * 2; const char* wkv = (const char*)(ws + OFF_WKVT) + (size_t)l * 2 * MiB;
        char* kout = (char*)(ws + OFF_KMEM) + (size_t)l * 4 * MiB;
        if (j < 16) { const int pm = j >> 1, pn = j & 1;
            u.A = memn + (size_t)pm * 256 * 1024 * 2; u.B = wkv + (size_t)pn * 256 * 1024 * 2; u.O = kout + ((size_t)pm * 256 * 512 + pn * 256) * 2; u.ldc = 512; }
        else { const int jj = j - 16, pm = jj >> 3, pn = jj & 7;
            u.A = wkv + (size_t)(512 + pm * 256) * 1024 * 2; u.B = memn + (size_t)pn * 256 * 1024 * 2; u.O = kout + 2 * MiB + ((size_t)pm * 256 * 2048 + pn * 256) * 2; u.ldc = 2048; }
        return true;
    }
};
struct SchedB0 {
    const unsigned char* ws; unsigned char* seg; int G, c;
    __device__ __forceinline__ bool next(int i, pg8::Unit& u) const {
        const int L = i * G + c; if (L >= 480) return false;
        int pm, pn; pg8::remap(L, 16, 30, pm, pn);
        u.A = (const char*)(ws + OFF_H) + (size_t)pm * 256 * 1024 * 2; u.B = (const char*)(ws + OFF_WT1) + (size_t)pn * 256 * 1024 * 2;
        if (pn < 20) { u.O = (char*)(seg + S1_P1) + ((size_t)pm * 256 * P1W + pn * 256) * 2; u.ldc = P1W; }
        else { u.O = (char*)(seg + S1_P2) + ((size_t)pm * 256 * P2W + (pn - 20) * 256) * 2; u.ldc = P2W; }
        return true;
    }
};
struct SchedOut {
    const char* Y; const char* W; char* slab; int G, c;
    __device__ __forceinline__ bool next(int i, pg8::Unit& u) const {
        const int L = i * G + c; if (L >= 256) return false;
        const int ks = L >> 6; int pm, pn; pg8::remap(L & 63, 16, 4, pm, pn);
        u.A = Y + ((size_t)pm * 256 * DIN + ks * 512) * 2; u.B = W + ((size_t)pn * 256 * DIN + ks * 512) * 2;
        u.O = slab + (((size_t)ks * MS + pm * 256) * DM + pn * 256) * 2; u.ldc = DM; return true;
    }
};

__device__ __forceinline__ void phase_a1(const P& p, const Ctx& c, int seg) {
    const bf16_t* P0 = (const bf16_t*)(c.seg + S0_P0);
    bf16_t* Qb = (bf16_t*)(c.seg + S0_Q); bf16_t* Kb = (bf16_t*)(c.seg + S0_K); bf16_t* KT = (bf16_t*)(c.seg + S0_KT); bf16_t* VT = (bf16_t*)(c.seg + S0_VT);
    bf16_t* XC = (bf16_t*)(c.seg + S0_XC); bf16_t* VF = (bf16_t*)(p.ws + OFF_VF);
    float* IPRE = (float*)(c.seg + S0_GATE); float* LOGF = IPRE + 32 * SEGT;
    const bf16_t* UT = (const bf16_t*)(p.ws + OFF_UTAIL);
    LAS float* red = (LAS float*)c.lds;
    LAS bf16_t* kst = (LAS bf16_t*)(c.lds + 98304);
    LAS bf16_t* vst = kst + 1536 * 8;
    const int n = c.tid;
    float wq[4][4], wk[4][4], wv[4][4], G12[4][8], G3[4][8];
    if (n < 384) {
#pragma unroll
        for (int i = 0; i < 4; ++i) { const f32x4 a = *(const f32x4*)(p.ml_wq + n * 16 + i * 4), bb = *(const f32x4*)(p.ml_wk + n * 16 + i * 4), cc = *(const f32x4*)(p.ml_wv + n * 16 + i * 4);
#pragma unroll
            for (int o = 0; o < 4; ++o) { wq[i][o] = a[o]; wk[i][o] = bb[o]; wv[i][o] = cc[o]; } }
#pragma unroll
        for (int i = 0; i < 4; ++i)
#pragma unroll
            for (int g = 0; g < 8; ++g) { G12[i][g] = 0.f; G3[i][g] = 0.f; }
#pragma unroll
        for (int o = 0; o < 4; ++o) {
            const float* gq = p.ml_w_gate + (size_t)(n * 4 + o) * 8; const float* gk = p.ml_w_gate + (size_t)(DMIX + n * 4 + o) * 8; const float* gv = p.ml_w_gate + (size_t)(2 * DMIX + n * 4 + o) * 8;
            const f32x4 q0 = *(const f32x4*)gq, q1 = *(const f32x4*)(gq + 4), k0 = *(const f32x4*)gk, k1 = *(const f32x4*)(gk + 4), v0 = *(const f32x4*)gv, v1 = *(const f32x4*)(gv + 4);
#pragma unroll
            for (int i = 0; i < 4; ++i)
#pragma unroll
                for (int g = 0; g < 4; ++g) { G12[i][g] += wq[i][o] * q0[g] + wk[i][o] * k0[g]; G12[i][g + 4] += wq[i][o] * q1[g] + wk[i][o] * k1[g];
                    G3[i][g] += wv[i][o] * v0[g]; G3[i][g + 4] += wv[i][o] * v1[g]; }
        }
    }
#pragma unroll 1
    for (int it = c.bid; it < MS / 8; it += c.G) {
        const int row0 = it * 8, b = row0 >> 9, tl0 = row0 & 511;
        __syncthreads();
        if (n < 384) {
            float um[3][4];
#pragma unroll
            for (int j = 1; j <= 3; ++j) { u32x2 raw = (u32x2){0u, 0u};
                if (tl0 - j >= 0) raw = *(const u32x2*)(P0 + (unsigned)((row0 - j) * ML_W + n * 4));
                else if (seg > 0) raw = *(const u32x2*)(UT + (unsigned)((b * 3 + (3 - j)) * DMIX + n * 4));
                um[3 - j][0] = bflo(raw.x); um[3 - j][1] = bfhi(raw.x); um[3 - j][2] = bflo(raw.y); um[3 - j][3] = bfhi(raw.y); }
            u32x2 nraw = *(const u32x2*)(P0 + (unsigned)(row0 * ML_W + n * 4));
#pragma unroll 1
            for (int tt = 0; tt < 8; ++tt) {
                const unsigned row = (unsigned)(row0 + tt);
                const u32x2 raw = nraw;
                if (tt + 1 < 8) nraw = *(const u32x2*)(P0 + (unsigned)((row + 1) * ML_W + n * 4));
                float u[4] = {bflo(raw.x), bfhi(raw.x), bflo(raw.y), bfhi(raw.y)}, xc[4], q[4], k[4], v[4];
                { int nn = n; asm volatile("" : "+v"(nn));
                  const f32x4 cb = *(const f32x4*)(p.ml_conv_b + nn * 4), c0 = *(const f32x4*)(p.ml_conv_w + nn * 4), c1 = *(const f32x4*)(p.ml_conv_w + DMIX + nn * 4),
                              c2 = *(const f32x4*)(p.ml_conv_w + 2 * DMIX + nn * 4), c3 = *(const f32x4*)(p.ml_conv_w + 3 * DMIX + nn * 4);
#pragma unroll
                  for (int i = 0; i < 4; ++i) { const float y = cb[i] + c0[i] * um[0][i] + c1[i] * um[1][i] + c2[i] * um[2][i] + c3[i] * u[i]; xc[i] = siluf_(y); } }
                const float ks = 0.05103103630798288f;
#pragma unroll
                for (int o = 0; o < 4; ++o) { q[o] = xc[0] * wq[0][o] + xc[1] * wq[1][o] + xc[2] * wq[2][o] + xc[3] * wq[3][o];
                    k[o] = (xc[0] * wk[0][o] + xc[1] * wk[1][o] + xc[2] * wk[2][o] + xc[3] * wk[3][o]) * ks;
                    v[o] = u[0] * wv[0][o] + u[1] * wv[1][o] + u[2] * wv[2][o] + u[3] * wv[3][o]; }
#pragma unroll
                for (int g = 0; g < 8; ++g) red[(tt * 8 + g) * 384 + n] = xc[0] * G12[0][g] + xc[1] * G12[1][g] + xc[2] * G12[2][g] + xc[3] * G12[3][g] + u[0] * G3[0][g] + u[1] * G3[1][g] + u[2] * G3[2][g] + u[3] * G3[3][g];
                u32x2 w; w.x = pk2(q[0], q[1]); w.y = pk2(q[2], q[3]); *(u32x2*)(Qb + (unsigned)(row * DMIX + n * 4)) = w;
                w.x = pk2(k[0], k[1]); w.y = pk2(k[2], k[3]); *(u32x2*)(Kb + (unsigned)(row * DMIX + n * 4)) = w;
                w.x = pk2(xc[0], xc[1]); w.y = pk2(xc[2], xc[3]); *(u32x2*)(XC + (unsigned)(row * DMIX + n * 4)) = w;
                w.x = pk2(v[0], v[1]); w.y = pk2(v[2], v[3]); *(u32x2*)(VF + (unsigned)(row * DMIX + n * 4)) = w;
#pragma unroll
                for (int o = 0; o < 4; ++o) { kst[(n * 4 + o) * 8 + tt] = f2bf(k[o]); vst[(n * 4 + o) * 8 + tt] = f2bf(v[o]); }
#pragma unroll
                for (int i = 0; i < 4; ++i) { um[0][i] = um[1][i]; um[1][i] = um[2][i]; um[2][i] = u[i]; }
            }
            const int hd = n / 96, dch = (n % 96) * 4;
#pragma unroll
            for (int o = 0; o < 4; ++o) { const unsigned off = (unsigned)(((b * 4 + hd) * 384 + dch + o) * SEGT + tl0);
                *(u32x4*)(KT + off) = *(const LAS u32x4*)(kst + (n * 4 + o) * 8); *(u32x4*)(VT + off) = *(const LAS u32x4*)(vst + (n * 4 + o) * 8); }
        }
        __syncthreads();
        { const int v = c.tid >> 3, part = c.tid & 7; float s = 0.f;
#pragma unroll 8
          for (int i = 0; i < 48; ++i) s += red[v * 384 + part * 48 + i];
          s += __shfl_xor(s, 1); s += __shfl_xor(s, 2); s += __shfl_xor(s, 4);
          if (part == 0) { const int tt = v >> 3, g = v & 7; const float gate = s + p.ml_b_gate[g];
              if (g < 4) IPRE[(b * 4 + g) * SEGT + tl0 + tt] = gate; else LOGF[(b * 4 + g - 4) * SEGT + tl0 + tt] = -softplusf_(-gate); } }
    }
}

__device__ __forceinline__ void attn_item(const P& p, const Ctx& c, int layer, int it, const bf16_t* Qp, int ldq, bf16_t* YM) {
    const int b = it >> 3, head = (it >> 1) & 3, qb = it & 1;
    const bf16_t* Kg = (const bf16_t*)(p.ws + OFF_KMEM + (size_t)layer * 4 * MiB) + (size_t)(b * 256) * 512 + head * 128;
    const bf16_t* Vg = (const bf16_t*)(p.ws + OFF_KMEM + (size_t)layer * 4 * MiB + 2 * MiB) + (size_t)(head * 128) * 2048 + b * 256;
    LAS bf16_t* Ks = (LAS bf16_t*)c.lds;
    LAS bf16_t* Vs = Ks + 256 * 136;
    const int l15 = c.lane & 15, quad = c.lane >> 4;
    __syncthreads();
#pragma unroll
    for (int r = 0; r < 8; ++r) { const int id = c.tid + 512 * r; { const int i = id >> 4, c8 = (id & 15) * 8; *(LAS u32x4*)(Ks + i * 136 + c8) = *(const u32x4*)(Kg + (size_t)i * 512 + c8); }
        { const int i = id >> 5, c8 = (id & 31) * 8; *(LAS u32x4*)(Vs + i * 264 + c8) = *(const u32x4*)(Vg + (size_t)i * 2048 + c8); } }
    __syncthreads();
#pragma unroll 1
    for (int pass = 0; pass < 2; ++pass) {
        const int row0 = b * SEGT + qb * 256 + c.wv * 32 + pass * 16;
        bf16x8 qf[4];
#pragma unroll
        for (int kk = 0; kk < 4; ++kk) qf[kk] = *(const bf16x8*)(Qp + (size_t)(row0 + l15) * ldq + head * 128 + kk * 32 + quad * 8);
        f32x4 acc[16];
#pragma unroll
        for (int mt = 0; mt < 16; ++mt) { acc[mt] = (f32x4){0.f, 0.f, 0.f, 0.f};
#pragma unroll
            for (int kk = 0; kk < 4; ++kk) { const bf16x8 a = *(const LAS bf16x8*)(Ks + (mt * 16 + l15) * 136 + kk * 32 + quad * 8); acc[mt] = mfma16(a, qf[kk], acc[mt]); }
            if ((mt & 3) == 3) __builtin_amdgcn_sched_barrier(0); }
        float mx = -1e30f;
#pragma unroll
        for (int mt = 0; mt < 16; ++mt)
#pragma unroll
            for (int j = 0; j < 4; ++j) mx = fmaxf(mx, acc[mt][j]);
        mx = fmaxf(mx, __shfl_xor(mx, 16)); mx = fmaxf(mx, __shfl_xor(mx, 32));
        const float sc = 0.08838834764831845f * 1.4426950408889634f; float sm = 0.f;
#pragma unroll
        for (int mt = 0; mt < 16; ++mt)
#pragma unroll
            for (int j = 0; j < 4; ++j) { const float e = exp2f((acc[mt][j] - mx) * sc); acc[mt][j] = e; sm += e; }
        sm += __shfl_xor(sm, 16); sm += __shfl_xor(sm, 32);
        const float inv = 1.0f / sm;
        bf16x8 pa[8];
#pragma unroll
        for (int kp = 0; kp < 8; ++kp) {
            u32x4 aw; aw.x = pk2(acc[2 * kp][0] * inv, acc[2 * kp][1] * inv); aw.y = pk2(acc[2 * kp][2] * inv, acc[2 * kp][3] * inv);
            aw.z = pk2(acc[2 * kp + 1][0] * inv, acc[2 * kp + 1][1] * inv); aw.w = pk2(acc[2 * kp + 1][2] * inv, acc[2 * kp + 1][3] * inv);
            __builtin_memcpy(&pa[kp], &aw, 16); }
        __builtin_amdgcn_sched_barrier(0);
        f32x4 o[8];
#pragma unroll
        for (int nt = 0; nt < 8; ++nt) o[nt] = (f32x4){0.f, 0.f, 0.f, 0.f};
#pragma unroll
        for (int kp = 0; kp < 8; ++kp) {
            const bf16x8 a = pa[kp];
#pragma unroll
            for (int nt = 0; nt < 8; ++nt) { const LAS bf16_t* vp = Vs + (nt * 16 + l15) * 264 + 2 * kp * 16 + quad * 4;
                const u32x2 lo = *(const LAS u32x2*)vp, hi = *(const LAS u32x2*)(vp + 16); u32x4 bw = (u32x4){lo.x, lo.y, hi.x, hi.y}; bf16x8 bfr; __builtin_memcpy(&bfr, &bw, 16);
                o[nt] = mfma16(a, bfr, o[nt]); }
            __builtin_amdgcn_sched_barrier(0);
        }
#pragma unroll
        for (int nt = 0; nt < 8; ++nt)
#pragma unroll
            for (int j = 0; j < 4; ++j) YM[(size_t)(row0 + quad * 4 + j) * DX + head * 128 + nt * 16 + l15] = f2bf(o[nt][j]);
    }
}

__device__ __forceinline__ void mlstm_item(const P& p, const Ctx& c, int seg, int w, bool save) {
    const int b = w / 24, h = (w / 6) & 3, sl = w % 6;
    const bf16_t* Qb = (const bf16_t*)(c.seg + S0_Q); const bf16_t* Kb = (const bf16_t*)(c.seg + S0_K); const bf16_t* KT = (const bf16_t*)(c.seg + S0_KT); const bf16_t* VT = (const bf16_t*)(c.seg + S0_VT);
    const float* IPRE = (const float*)(c.seg + S0_GATE); const float* LOGF = IPRE + 32 * SEGT;
    bf16_t* HR = (bf16_t*)(c.seg + S0_HRAW);
    float* CST = (float*)(p.ws + OFF_CST) + (size_t)w * 64 * 384; float* NST = (float*)(p.ws + OFF_NST) + (size_t)w * 384;
    LAS bf16_t* Cimg = (LAS bf16_t*)c.lds;
    LAS bf16_t* Qs = Cimg + 64 * 392;
    LAS bf16_t* Ks = Qs + 64 * 136;
    LAS bf16_t* KTs = Ks + 64 * 136;
    LAS bf16_t* VTs = KTs + 128 * 72;
    LAS bf16_t* VWs = VTs + 64 * 72;
    LAS bf16_t* Sp = VWs + 64 * 72;
    LAS float* fl = (LAS float*)(Sp + 64 * 72);
    LAS float* bcum = fl; LAS float* ipr = fl + 64; LAS float* wgt = fl + 128; LAS float* gin = fl + 192; LAS float* qn = fl + 256; LAS float* rden = fl + 320;
    LAS float* gtotp = fl + 384; LAS float* nold = fl + 400; LAS float* nnew = fl + 800;
    const int l15c = c.lane & 15, quadc = c.lane >> 4, e16 = c.wv & 3, par = c.wv >> 2;
    f32x4 C[12];
    __syncthreads();
    if (seg > 0) {
#pragma unroll
        for (int j = 0; j < 12; ++j)
#pragma unroll
            for (int jj = 0; jj < 4; ++jj) C[j][jj] = CST[(size_t)(e16 * 16 + quadc * 4 + jj) * 384 + (2 * j + par) * 16 + l15c];
        if (c.tid < 384) nold[c.tid] = NST[c.tid];
    } else {
#pragma unroll
        for (int j = 0; j < 12; ++j) C[j] = (f32x4){0.f, 0.f, 0.f, 0.f};
        if (c.tid < 384) nold[c.tid] = 0.f;
    }
    u32x4 pq[2], pk[2], pt[2], pvt; float plf = 0.f, pip = 0.f;
    auto gl_piece = [&](int ch, int pp, int tidv) {
#pragma unroll
        for (int r = 0; r < 2; ++r) { const int id = tidv + 512 * r;
            { const int i = id >> 4, c8 = (id & 15) * 8; const size_t go = ((size_t)b * SEGT + ch * 64 + i) * DMIX + h * 384 + pp * 128 + c8; pq[r] = *(const u32x4*)(Qb + go); pk[r] = *(const u32x4*)(Kb + go); }
            { const int dd = id >> 3, c8 = (id & 7) * 8; pt[r] = *(const u32x4*)(KT + ((size_t)(b * 4 + h) * 384 + pp * 128 + dd) * SEGT + ch * 64 + c8); } } };
    auto gl_chunk = [&](int ch, int tidv) { const int i = tidv >> 3, c8 = (tidv & 7) * 8;
        pvt = *(const u32x4*)(VT + ((size_t)(b * 4 + h) * 384 + sl * 64 + i) * SEGT + ch * 64 + c8);
        if (c.wv == 0) { plf = LOGF[(b * 4 + h) * SEGT + ch * 64 + c.lane]; pip = IPRE[(b * 4 + h) * SEGT + ch * 64 + c.lane]; } };
    { int t0 = c.tid; asm volatile("" : "+v"(t0)); gl_chunk(0, t0); gl_piece(0, 0, t0); }
#pragma unroll 1
    for (int ch = 0; ch < 8; ++ch) {
        const int tl0 = ch * 64; const size_t row0 = (size_t)b * SEGT + tl0;
        int tidv = c.tid, l15 = l15c, quad = quadc;
        asm volatile("" : "+v"(tidv), "+v"(l15), "+v"(quad));
        lds_barrier();
        if (c.wv == 0) {
            float bc = plf;
#pragma unroll
            for (int o = 1; o < 64; o <<= 1) { const float t = __shfl_up(bc, o); if (c.lane >= o) bc += t; }
            const float bl = __shfl(bc, 63);
            bcum[c.lane] = bc; ipr[c.lane] = pip; wgt[c.lane] = __expf(bl - bc + pip); gin[c.lane] = __expf(bc);
            if (c.lane == 0) gtotp[0] = __expf(bl);
        }
#pragma unroll
        for (int j = 0; j < 12; ++j)
#pragma unroll
            for (int jj = 0; jj < 4; ++jj) Cimg[(e16 * 16 + quad * 4 + jj) * 392 + (2 * j + par) * 16 + l15] = f2bf(C[j][jj]);
        lds_barrier();
        { const int i = tidv >> 3, c8 = (tidv & 7) * 8;
          const u32x4 raw = pvt;
          *(LAS u32x4*)(VTs + i * 72 + c8) = raw;
          const f32x4 w0 = *(const LAS f32x4*)(wgt + c8), w1 = *(const LAS f32x4*)(wgt + c8 + 4);
          u32x4 sw; sw.x = pk2(bflo(raw.x) * w0[0], bfhi(raw.x) * w0[1]); sw.y = pk2(bflo(raw.y) * w0[2], bfhi(raw.y) * w0[3]);
          sw.z = pk2(bflo(raw.z) * w1[0], bfhi(raw.z) * w1[1]); sw.w = pk2(bflo(raw.w) * w1[2], bfhi(raw.w) * w1[3]);
          *(LAS u32x4*)(VWs + i * 72 + c8) = sw; }
        if (ch + 1 < 8) gl_chunk(ch + 1, tidv);
        const float gtot = gtotp[0];
#pragma unroll
        for (int j = 0; j < 12; ++j) C[j] *= gtot;
        f32x4 Sa[2], Ia[2]; Sa[0] = Sa[1] = Ia[0] = Ia[1] = (f32x4){0.f, 0.f, 0.f, 0.f};
        float qnacc = 0.f;
#pragma unroll
        for (int pp = 0; pp < 3; ++pp) {
            const int d0 = pp * 128;
            __builtin_amdgcn_sched_barrier(0);
            asm volatile("" : "+v"(tidv));
            lds_barrier();
#pragma unroll
            for (int r = 0; r < 2; ++r) { const int id = tidv + 512 * r;
                { const int i = id >> 4, c8 = (id & 15) * 8; *(LAS u32x4*)(Qs + i * 136 + c8) = pq[r]; *(LAS u32x4*)(Ks + i * 136 + c8) = pk[r]; }
                { const int dd = id >> 3, c8 = (id & 7) * 8; *(LAS u32x4*)(KTs + dd * 72 + c8) = pt[r]; } }
            lds_barrier();
            if (pp < 2) gl_piece(ch, pp + 1, tidv); else if (ch + 1 < 8) gl_piece(ch + 1, 0, tidv);
            { const int tm = c.wv >> 1, tn0 = (c.wv & 1) * 2;
#pragma unroll
              for (int kk = 0; kk < 4; ++kk) { const bf16x8 a = *(const LAS bf16x8*)(Qs + (tm * 16 + l15) * 136 + kk * 32 + quad * 8);
#pragma unroll
                  for (int x = 0; x < 2; ++x) { const int tn = tn0 + x;
                      const bf16x8 bk = *(const LAS bf16x8*)(Ks + (tn * 16 + l15) * 136 + kk * 32 + quad * 8);
                      const bf16x8 bc = *(const LAS bf16x8*)(Cimg + (tn * 16 + l15) * 392 + d0 + kk * 32 + quad * 8);
                      Sa[x] = mfma16(a, bk, Sa[x]); Ia[x] = mfma16(a, bc, Ia[x]); } } }
            { const bf16x8 va0 = *(const LAS bf16x8*)(VWs + (e16 * 16 + l15) * 72 + quad * 8), va1 = *(const LAS bf16x8*)(VWs + (e16 * 16 + l15) * 72 + 32 + quad * 8);
#pragma unroll
              for (int jl = 0; jl < 4; ++jl) { const int ntl = 2 * jl + par, j = pp * 4 + jl;
                  C[j] = mfma16(va0, *(const LAS bf16x8*)(KTs + (ntl * 16 + l15) * 72 + quad * 8), C[j]);
                  C[j] = mfma16(va1, *(const LAS bf16x8*)(KTs + (ntl * 16 + l15) * 72 + 32 + quad * 8), C[j]); } }
            { const int t = tidv >> 3, part = tidv & 7;
              const u32x4 q0 = *(const LAS u32x4*)(Qs + t * 136 + part * 16), q1 = *(const LAS u32x4*)(Qs + t * 136 + part * 16 + 8);
              const LAS float* np = nold + d0 + part * 16; const f32x4 n0 = *(const LAS f32x4*)np, n1 = *(const LAS f32x4*)(np + 4), n2 = *(const LAS f32x4*)(np + 8), n3 = *(const LAS f32x4*)(np + 12);
              qnacc += bflo(q0.x) * n0[0] + bfhi(q0.x) * n0[1] + bflo(q0.y) * n0[2] + bfhi(q0.y) * n0[3] + bflo(q0.z) * n1[0] + bfhi(q0.z) * n1[1] + bflo(q0.w) * n1[2] + bfhi(q0.w) * n1[3]
                     + bflo(q1.x) * n2[0] + bfhi(q1.x) * n2[1] + bflo(q1.y) * n2[2] + bfhi(q1.y) * n2[3] + bflo(q1.z) * n3[0] + bfhi(q1.z) * n3[1] + bflo(q1.w) * n3[2] + bfhi(q1.w) * n3[3]; }
            { const int dd = tidv >> 2, part = tidv & 3;
              const u32x4 k0 = *(const LAS u32x4*)(KTs + dd * 72 + part * 16), k1 = *(const LAS u32x4*)(KTs + dd * 72 + part * 16 + 8);
              const LAS float* wp = wgt + part * 16; const f32x4 w0 = *(const LAS f32x4*)wp, w1 = *(const LAS f32x4*)(wp + 4), w2 = *(const LAS f32x4*)(wp + 8), w3 = *(const LAS f32x4*)(wp + 12);
              float a = bflo(k0.x) * w0[0] + bfhi(k0.x) * w0[1] + bflo(k0.y) * w0[2] + bfhi(k0.y) * w0[3] + bflo(k0.z) * w1[0] + bfhi(k0.z) * w1[1] + bflo(k0.w) * w1[2] + bfhi(k0.w) * w1[3]
                      + bflo(k1.x) * w2[0] + bfhi(k1.x) * w2[1] + bflo(k1.y) * w2[2] + bfhi(k1.y) * w2[3] + bflo(k1.z) * w3[0] + bfhi(k1.z) * w3[1] + bflo(k1.w) * w3[2] + bfhi(k1.w) * w3[3];
              a = dpp_add<0xB1>(a); a = dpp_add<0x4E>(a);
              if (part == 0) nnew[d0 + dd] = gtot * nold[d0 + dd] + a; }
        }
        qnacc = dpp_add<0xB1>(qnacc); qnacc = dpp_add<0x4E>(qnacc); qnacc = dpp_add<0x141>(qnacc);
        if ((tidv & 7) == 0) qn[tidv >> 3] = qnacc;
#pragma unroll
        for (int x = 0; x < 2; ++x) { const int ti = c.wv * 2 + x, tm = ti >> 2, tn = ti & 3; const int s = tn * 16 + l15; const float bs = bcum[s] - ipr[s];
#pragma unroll
            for (int jj = 0; jj < 4; ++jj) { const int t = tm * 16 + quad * 4 + jj; const float v = (s <= t) ? Sa[x][jj] * __expf(bcum[t] - bs) : 0.f; Sp[t * 72 + s] = f2bf(v); } }
        lds_barrier();
        { const int t = tidv >> 3, part = tidv & 7; const u32x4 sr = *(const LAS u32x4*)(Sp + t * 72 + part * 8);
          float ds = bflo(sr.x) + bfhi(sr.x) + bflo(sr.y) + bfhi(sr.y) + bflo(sr.z) + bfhi(sr.z) + bflo(sr.w) + bfhi(sr.w);
          ds = dpp_add<0xB1>(ds); ds = dpp_add<0x4E>(ds); ds = dpp_add<0x141>(ds);
          if (part == 0) { const float den = ds + gin[t] * qn[t]; rden[t] = 1.0f / fmaxf(fabsf(den), 1.0f); } }
#pragma unroll
        for (int x = 0; x < 2; ++x) { const int ti = c.wv * 2 + x, tm = ti >> 2, tn = ti & 3;
#pragma unroll
            for (int jj = 0; jj < 4; ++jj) Ia[x][jj] *= gin[tm * 16 + quad * 4 + jj];
#pragma unroll
            for (int kk = 0; kk < 2; ++kk) { const bf16x8 a = *(const LAS bf16x8*)(Sp + (tm * 16 + l15) * 72 + kk * 32 + quad * 8);
                const bf16x8 bb = *(const LAS bf16x8*)(VTs + (tn * 16 + l15) * 72 + kk * 32 + quad * 8); Ia[x] = mfma16(a, bb, Ia[x]); } }
        lds_barrier();
#pragma unroll
        for (int x = 0; x < 2; ++x) { const int ti = c.wv * 2 + x, tm = ti >> 2, tn = ti & 3;
#pragma unroll
            for (int jj = 0; jj < 4; ++jj) { const int t = tm * 16 + quad * 4 + jj; HR[(row0 + t) * DMIX + h * 384 + sl * 64 + tn * 16 + l15] = f2bf(Ia[x][jj] * rden[t]); } }
        if (c.tid < 384) nold[c.tid] = nnew[c.tid];
    }
    lds_barrier();
    if (!save) return;
#pragma unroll
    for (int j = 0; j < 12; ++j)
#pragma unroll
        for (int jj = 0; jj < 4; ++jj) CST[(size_t)(e16 * 16 + quadc * 4 + jj) * 384 + (2 * j + par) * 16 + l15c] = C[j][jj];
    if (c.tid < 384) NST[c.tid] = nold[c.tid];
}

__device__ __forceinline__ void phase_a3(const P& p, const Ctx& c, int seg) {
    const bf16_t* P0 = (const bf16_t*)(c.seg + S0_P0); const bf16_t* HR = (const bf16_t*)(c.seg + S0_HRAW); const bf16_t* XC = (const bf16_t*)(c.seg + S0_XC);
    const bf16_t* YM = (const bf16_t*)(c.seg + S0_YMEM); bf16_t* Y = (bf16_t*)(c.seg + S0_Y); bf16_t* UT = (bf16_t*)(p.ws + OFF_UTAIL);
#pragma unroll 1
    for (int r = c.bid * 8 + c.wv; r < MS; r += c.G * 8) {
        const int b = r >> 9, tl = r & 511;
        float v[3][8]; float mean[3], rstd[3];
#pragma unroll
        for (int ps = 0; ps < 3; ++ps) { const int ch = ps * 512 + c.lane * 8;
            const u32x4 hr = *(const u32x4*)(HR + (size_t)r * DMIX + ch);
            v[ps][0] = bflo(hr.x); v[ps][1] = bfhi(hr.x); v[ps][2] = bflo(hr.y); v[ps][3] = bfhi(hr.y); v[ps][4] = bflo(hr.z); v[ps][5] = bfhi(hr.z); v[ps][6] = bflo(hr.w); v[ps][7] = bfhi(hr.w); }
        float hs[4], hq[4];
#pragma unroll
        for (int hd = 0; hd < 4; ++hd) { float s = 0.f, q = 0.f;
#pragma unroll
            for (int ps = 0; ps < 3; ++ps) { if (ps * 512 + 511 < hd * 384 || ps * 512 >= (hd + 1) * 384) continue;
                const bool mine = ((ps * 512 + c.lane * 8) / 384) == hd;
                float ls = 0.f, lq = 0.f;
#pragma unroll
                for (int j = 0; j < 8; ++j) { ls += v[ps][j]; lq += v[ps][j] * v[ps][j]; }
                s += mine ? ls : 0.f; q += mine ? lq : 0.f; }
            hs[hd] = wsum(s); hq[hd] = wsum(q); }
#pragma unroll
        for (int ps = 0; ps < 3; ++ps) { const int hd = (ps * 512 + c.lane * 8) / 384;
            const float s = hd == 0 ? hs[0] : (hd == 1 ? hs[1] : (hd == 2 ? hs[2] : hs[3])), q = hd == 0 ? hq[0] : (hd == 1 ? hq[1] : (hd == 2 ? hq[2] : hq[3]));
            const float m = s * (1.0f / 384.0f); mean[ps] = m; rstd[ps] = rsqrtf(fmaxf(q * (1.0f / 384.0f) - m * m, 0.f) + 1e-5f); }
#pragma unroll
        for (int ps = 0; ps < 3; ++ps) { const int ch = ps * 512 + c.lane * 8;
            const u32x4 xr = *(const u32x4*)(XC + (size_t)r * DMIX + ch), zr = *(const u32x4*)(P0 + (size_t)r * ML_W + 2048 + ch);
            const f32x4 g0 = *(const f32x4*)(p.ml_mhn_g + ch), g1 = *(const f32x4*)(p.ml_mhn_g + ch + 4), k0 = *(const f32x4*)(p.ml_skip + ch), k1 = *(const f32x4*)(p.ml_skip + ch + 4);
            const float xx[8] = {bflo(xr.x), bfhi(xr.x), bflo(xr.y), bfhi(xr.y), bflo(xr.z), bfhi(xr.z), bflo(xr.w), bfhi(xr.w)};
            const float zz[8] = {bflo(zr.x), bfhi(zr.x), bflo(zr.y), bfhi(zr.y), bflo(zr.z), bfhi(zr.z), bflo(zr.w), bfhi(zr.w)};
            const float gg[8] = {g0[0], g0[1], g0[2], g0[3], g1[0], g1[1], g1[2], g1[3]}, kk[8] = {k0[0], k0[1], k0[2], k0[3], k1[0], k1[1], k1[2], k1[3]};
            float y[8];
#pragma unroll
            for (int j = 0; j < 8; ++j) y[j] = ((v[ps][j] - mean[ps]) * rstd[ps] * gg[j] + kk[j] * xx[j]) * siluf_(zz[j]);
            *(u32x4*)(Y + (size_t)r * DIN + ch) = (u32x4){pk2(y[0], y[1]), pk2(y[2], y[3]), pk2(y[4], y[5]), pk2(y[6], y[7])}; }
        { const int cm = c.lane * 8; const u32x4 mr = *(const u32x4*)(YM + (size_t)r * DX + cm), zr = *(const u32x4*)(P0 + (size_t)r * ML_W + 2048 + DMIX + cm);
          const float mm[8] = {bflo(mr.x), bfhi(mr.x), bflo(mr.y), bfhi(mr.y), bflo(mr.z), bfhi(mr.z), bflo(mr.w), bfhi(mr.w)};
          const float zz[8] = {bflo(zr.x), bfhi(zr.x), bflo(zr.y), bfhi(zr.y), bflo(zr.z), bfhi(zr.z), bflo(zr.w), bfhi(zr.w)};
          float y[8];
#pragma unroll
          for (int j = 0; j < 8; ++j) y[j] = mm[j] * siluf_(zz[j]);
          *(u32x4*)(Y + (size_t)r * DIN + DMIX + cm) = (u32x4){pk2(y[0], y[1]), pk2(y[2], y[3]), pk2(y[4], y[5]), pk2(y[6], y[7])}; }
        if (tl >= 509) {
#pragma unroll
            for (int ps = 0; ps < 3; ++ps) { const int ch = ps * 512 + c.lane * 8; *(u32x4*)(UT + (size_t)(b * 3 + tl - 509) * DMIX + ch) = *(const u32x4*)(P0 + (size_t)r * ML_W + ch); } }
    }
}

__device__ __forceinline__ void phase_b1(const P& p, const Ctx& c, int seg) {
    const bf16_t* P1 = (const bf16_t*)(c.seg + S1_P1);
    float* GTB = (float*)(c.seg + S1_W); bf16_t* SA = (bf16_t*)(c.seg + S1_A); bf16_t* SB = (bf16_t*)(c.seg + S1_B); bf16_t* SK = (bf16_t*)(c.seg + S1_K);
    bf16_t* SQ = (bf16_t*)(c.seg + S1_Q); bf16_t* SV = (bf16_t*)(c.seg + S1_V); bf16_t* SG = (bf16_t*)(c.seg + S1_G); float* BRKR = (float*)(c.seg + S1_BRKR);
    const bf16_t* VF = (const bf16_t*)(p.ws + OFF_VF); const bf16_t* LT = (const bf16_t*)(p.ws + OFF_LORAT);
    const bf16_t* PTr = (const bf16_t*)(p.ws + OFF_PTAIL) + (size_t)(seg & 1) * NB * RW_SHIFT; bf16_t* PTw = (bf16_t*)(p.ws + OFF_PTAIL) + (size_t)((seg + 1) & 1) * NB * RW_SHIFT;
    LAS bf16_t* XA = (LAS bf16_t*)c.lds;
    const int l15 = c.lane & 15, quad = c.lane >> 4;
    for (int it = c.bid; it < MS / 16; it += c.G) {
        const int r0 = it * 16, b = r0 >> 9, tl0 = r0 & 511;
        __syncthreads();
        for (int e = c.tid; e < 16 * 288; e += 512) { const int row = e / 288, cc = e % 288, col = 4608 + cc;
            const float cur = bf2f(P1[(size_t)(r0 + row) * P1W + col]);
            float prev = 0.f; if (tl0 + row > 0) prev = bf2f(P1[(size_t)(r0 + row - 1) * P1W + col]); else if (seg > 0) prev = bf2f(PTr[(size_t)b * RW_SHIFT + col]);
            const float pv = cur + p.rw_mu[col] * (prev - cur);
            const float f = cc < 64 ? (1.0f - 2.0f / (1.0f + __expf(2.0f * pv)))   : (cc < 160 ? pv : sigmoidf_(pv));
            XA[row * 296 + cc] = f2bf(f); }
        __syncthreads();
        const size_t row = (size_t)r0 + l15; const int tl = tl0 + l15;
        const bf16_t* curp = P1 + row * P1W; const bf16_t* prevp = (tl > 0) ? (P1 + (row - 1) * P1W) : (PTr + (size_t)b * RW_SHIFT); const bool hasprev = (tl > 0) || (seg > 0);
        struct TileIn { u32x4 cr, ck, cv, pr, pk, pv, vf; };
        struct TilePar { f32x4 m0, m1, m2, w0, a0, v0, kkw, kaw, rk; };
#pragma unroll 1
        for (int x = 0; x < 3; ++x) {
            int hh = c.wv * 3 + x; asm volatile("" : "+s"(hh));
            auto load_tile = [&](int ct, TileIn& T) { const int cc = hh * 64 + (ct >> 1) * 32 + quad * 8;
                T.cr = *(const u32x4*)(curp + cc); T.ck = *(const u32x4*)(curp + DMIX + cc); T.cv = *(const u32x4*)(curp + 2 * DMIX + cc);
                T.pr = (u32x4){0u, 0u, 0u, 0u}; T.pk = T.pr; T.pv = T.pr;
                if (hasprev) { T.pr = *(const u32x4*)(prevp + cc); T.pk = *(const u32x4*)(prevp + DMIX + cc); T.pv = *(const u32x4*)(prevp + 2 * DMIX + cc); }
                T.vf = *(const u32x4*)(VF + row * DMIX + cc); };
            TileIn TA;
            load_tile(0, TA);
            float inv;
            { u32x2 kcur[4], kprv[4]; f32x4 km[4], kw[4];
#pragma unroll
              for (int ct = 0; ct < 4; ++ct) { const int cc = hh * 64 + (ct >> 1) * 32 + quad * 8 + 4 * (ct & 1);
                  kcur[ct] = *(const u32x2*)(curp + DMIX + cc); kprv[ct] = (u32x2){0u, 0u}; if (hasprev) kprv[ct] = *(const u32x2*)(prevp + DMIX + cc);
                  km[ct] = *(const f32x4*)(p.rw_mu + DMIX + cc); kw[ct] = *(const f32x4*)(p.rw_k_k + cc); }
              float ss = 0.f;
#pragma unroll
              for (int ct = 0; ct < 4; ++ct) {
                  const float cb[4] = {bflo(kcur[ct].x), bfhi(kcur[ct].x), bflo(kcur[ct].y), bfhi(kcur[ct].y)}, qb[4] = {bflo(kprv[ct].x), bfhi(kprv[ct].x), bflo(kprv[ct].y), bfhi(kprv[ct].y)};
#pragma unroll
                  for (int j = 0; j < 4; ++j) { const float kr = (cb[j] + km[ct][j] * (qb[j] - cb[j])) * kw[ct][j]; ss += kr * kr; } }
              ss += __shfl_xor(ss, 16); ss += __shfl_xor(ss, 32);
              inv = 1.0f / fmaxf(sqrtf(ss), 1e-12f); }
            float br = 0.f, kr = 0.f, rkr = 0.f;
            u32x2 st_g, st_a, st_b, st_k, st_q, st_v;
            auto do_tile = [&](int ct, const TileIn& TI) { const int cc = hh * 64 + (ct >> 1) * 32 + quad * 8 + 4 * (ct & 1);
                TilePar T; T.m0 = *(const f32x4*)(p.rw_mu + cc); T.m1 = *(const f32x4*)(p.rw_mu + DMIX + cc); T.m2 = *(const f32x4*)(p.rw_mu + 2 * DMIX + cc);
                T.w0 = *(const f32x4*)(p.rw_w0 + cc); T.a0 = *(const f32x4*)(p.rw_a0 + cc); T.v0 = *(const f32x4*)(p.rw_v0 + cc); T.kkw = *(const f32x4*)(p.rw_k_k + cc); T.kaw = *(const f32x4*)(p.rw_k_a + cc);
                T.rk = *(const f32x4*)(p.rw_r_k + cc);
                bf16x8 lt[9]; { const bf16_t* lrow = LT + (size_t)(hh * 64 + (ct >> 1) * 32 + 8 * (l15 >> 2) + 4 * (ct & 1) + (l15 & 3)) * 288 + quad * 8;
#pragma unroll
                    for (int k = 0; k < 9; ++k) lt[k] = *(const bf16x8*)(lrow + k * 32); }
                bf16x8 xf[9];
#pragma unroll
                for (int k = 0; k < 9; ++k) xf[k] = *(const LAS bf16x8*)(XA + l15 * 296 + k * 32 + quad * 8);
                f32x4 dw = (f32x4){0.f, 0.f, 0.f, 0.f}, da = dw, dv = dw, dg = dw;
#pragma unroll
                for (int k = 0; k < 2; ++k) dw = mfma16(lt[k], xf[k], dw);
#pragma unroll
                for (int k = 0; k < 2; ++k) da = mfma16(lt[2 + k], xf[2 + k], da);
                dv = mfma16(lt[4], xf[4], dv);
#pragma unroll
                for (int k = 0; k < 4; ++k) dg = mfma16(lt[5 + k], xf[5 + k], dg);
                const bool od = (ct & 1) != 0;
                const unsigned r0 = od ? TI.cr.z : TI.cr.x, r1 = od ? TI.cr.w : TI.cr.y, k0 = od ? TI.ck.z : TI.ck.x, k1 = od ? TI.ck.w : TI.ck.y, c0 = od ? TI.cv.z : TI.cv.x, c1 = od ? TI.cv.w : TI.cv.y;
                const unsigned p0 = od ? TI.pr.z : TI.pr.x, p1 = od ? TI.pr.w : TI.pr.y, q0 = od ? TI.pk.z : TI.pk.x, q1 = od ? TI.pk.w : TI.pk.y, d0 = od ? TI.pv.z : TI.pv.x, d1 = od ? TI.pv.w : TI.pv.y;
                const unsigned f0 = od ? TI.vf.z : TI.vf.x, f1 = od ? TI.vf.w : TI.vf.y;
                const float ca[4] = {bflo(r0), bfhi(r0), bflo(r1), bfhi(r1)}, cb[4] = {bflo(k0), bfhi(k0), bflo(k1), bfhi(k1)}, cd[4] = {bflo(c0), bfhi(c0), bflo(c1), bfhi(c1)};
                const float qa[4] = {bflo(p0), bfhi(p0), bflo(p1), bfhi(p1)}, qb[4] = {bflo(q0), bfhi(q0), bflo(q1), bfhi(q1)}, qd[4] = {bflo(d0), bfhi(d0), bflo(d1), bfhi(d1)};
                const float vf[4] = {bflo(f0), bfhi(f0), bflo(f1), bfhi(f1)};
                u32x2 gw; gw.x = pk2(dg[0], dg[1]); gw.y = pk2(dg[2], dg[3]);
                float wv4[4], av[4], bv[4], ktv[4], qv[4], vv[4];
#pragma unroll
                for (int j = 0; j < 4; ++j) {
                    const float rc = ca[j] + T.m0[j] * (qa[j] - ca[j]), kc = cb[j] + T.m1[j] * (qb[j] - cb[j]), vc = cd[j] + T.m2[j] * (qd[j] - cd[j]);
                    const float zz = -(T.w0[j] + dw[j]); const float sp = fmaxf(zz, 0.f) + __logf(1.0f + __expf(-fabsf(zz)));
                    wv4[j] = __expf(-__expf(-sp - 0.5f));
                    const float a = sigmoidf_(T.a0[j] + da[j]);
                    vv[j] = vc + (vf[j] - vc) * sigmoidf_(T.v0[j] + dv[j]);
                    const float kk = kc * T.kkw[j] * inv; av[j] = -kk; bv[j] = kk * a;
                    ktv[j] = kc * (1.0f + (a - 1.0f) * T.kaw[j]); qv[j] = rc;
                    br += bv[j] * rc; kr += ktv[j] * rc; rkr += rc * ktv[j] * T.rk[j]; }
                float gfin[4];
#pragma unroll
                for (int j = 0; j < 4; ++j) { float g = wv4[j];
                    g *= dpp_shr_or1<1>(g); g *= dpp_shr_or1<2>(g); g *= dpp_shr_or1<4>(g); g *= dpp_shr_or1<8>(g);
                    const float gp = dpp_shr_or1<1>(g), ig = 1.0f / g;
                    av[j] *= gp; qv[j] *= g; bv[j] *= ig; ktv[j] *= ig; gfin[j] = g; }
                if (l15 == 15) *(f32x4*)(GTB + ((size_t)it * 24 + hh) * 64 + (cc - hh * 64)) = (f32x4){gfin[0], gfin[1], gfin[2], gfin[3]};
                const u32x2 ta = (u32x2){pk2(av[0], av[1]), pk2(av[2], av[3])}, tb = (u32x2){pk2(bv[0], bv[1]), pk2(bv[2], bv[3])}, tk = (u32x2){pk2(ktv[0], ktv[1]), pk2(ktv[2], ktv[3])};
                const u32x2 tq = (u32x2){pk2(qv[0], qv[1]), pk2(qv[2], qv[3])}, tv = (u32x2){pk2(vv[0], vv[1]), pk2(vv[2], vv[3])};
                if ((ct & 1) == 0) { st_g = gw; st_a = ta; st_b = tb; st_k = tk; st_q = tq; st_v = tv; }
                else { const size_t o8 = row * DMIX + cc - 4;
                    *(u32x4*)(SG + o8) = (u32x4){st_g.x, st_g.y, gw.x, gw.y}; *(u32x4*)(SA + o8) = (u32x4){st_a.x, st_a.y, ta.x, ta.y}; *(u32x4*)(SB + o8) = (u32x4){st_b.x, st_b.y, tb.x, tb.y};
                    *(u32x4*)(SK + o8) = (u32x4){st_k.x, st_k.y, tk.x, tk.y}; *(u32x4*)(SQ + o8) = (u32x4){st_q.x, st_q.y, tq.x, tq.y}; *(u32x4*)(SV + o8) = (u32x4){st_v.x, st_v.y, tv.x, tv.y}; } };
            do_tile(0, TA); __builtin_amdgcn_sched_barrier(0);
            do_tile(1, TA); __builtin_amdgcn_sched_barrier(0);
            load_tile(2, TA); do_tile(2, TA); __builtin_amdgcn_sched_barrier(0);
            do_tile(3, TA);
            br += __shfl_xor(br, 16); br += __shfl_xor(br, 32); kr += __shfl_xor(kr, 16); kr += __shfl_xor(kr, 32); rkr += __shfl_xor(rkr, 16); rkr += __shfl_xor(rkr, 32);
            if (quad == 0) *(f32x4*)(BRKR + (row * 24 + hh) * 4) = (f32x4){br, kr, rkr, 0.f};
        }
        if (tl0 == 496) { for (int e = c.tid; e < RW_SHIFT; e += 512) PTw[(size_t)b * RW_SHIFT + e] = P1[(size_t)(r0 + 15) * P1W + e]; }
    }
}

__device__ __forceinline__ void rwkv_item(const P& p, const Ctx& c, int seg, int w, bool save) {
    const int b = w / 24, hh = w % 24;
    const float* SW = (const float*)(c.seg + S1_W); const bf16_t* SA = (const bf16_t*)(c.seg + S1_A); const bf16_t* SB = (const bf16_t*)(c.seg + S1_B); const bf16_t* SK = (const bf16_t*)(c.seg + S1_K);
    const bf16_t* SQ = (const bf16_t*)(c.seg + S1_Q); const bf16_t* SV = (const bf16_t*)(c.seg + S1_V); const float* BRKR = (const float*)(c.seg + S1_BRKR);
    float* O = (float*)(c.seg + S1_O); float* RST = (float*)(p.ws + OFF_RST) + (size_t)w * 4096;
    constexpr int TB = 32, REC = 388;
    LAS float* L0 = (LAS float*)c.lds;
    const int rp = c.wv * 4 + (c.lane >> 4), cq = c.lane & 15;
    f32x2 S0a, S0b, S1a, S1b;
    if (seg > 0) { const f32x4 s0 = *(const f32x4*)(RST + (2 * rp) * 64 + cq * 4), s1 = *(const f32x4*)(RST + (2 * rp + 1) * 64 + cq * 4);
        S0a = (f32x2){s0[0], s0[1]}; S0b = (f32x2){s0[2], s0[3]}; S1a = (f32x2){s1[0], s1[1]}; S1b = (f32x2){s1[2], s1[3]}; }
    else { S0a = S0b = S1a = S1b = (f32x2){0.f, 0.f}; }
    const int e4 = c.tid * 4, stt = e4 >> 6, scc = e4 & 63;
    f32x4 gw; u32x2 ga, gb, gk, gq, gv; f32x4 gbr;
    auto gload = [&](int blk) { const size_t go = ((size_t)b * SEGT + blk * TB + stt) * DMIX + hh * 64 + scc;
        gw = *(const f32x4*)(SW + go); ga = *(const u32x2*)(SA + go); gb = *(const u32x2*)(SB + go); gk = *(const u32x2*)(SK + go); gq = *(const u32x2*)(SQ + go); gv = *(const u32x2*)(SV + go);
        if (c.tid < TB) gbr = *(const f32x4*)(BRKR + (((size_t)b * SEGT + blk * TB + c.tid) * 24 + hh) * 4); };
    auto lstore = [&](int buf) { LAS float* r = L0 + buf * (TB * REC) + stt * REC + scc;
        *(LAS f32x4*)(r) = gw; *(LAS f32x4*)(r + 64) = (f32x4){bflo(ga.x), bfhi(ga.x), bflo(ga.y), bfhi(ga.y)}; *(LAS f32x4*)(r + 128) = (f32x4){bflo(gb.x), bfhi(gb.x), bflo(gb.y), bfhi(gb.y)};
        *(LAS f32x4*)(r + 192) = (f32x4){bflo(gk.x), bfhi(gk.x), bflo(gk.y), bfhi(gk.y)}; *(LAS f32x4*)(r + 256) = (f32x4){bflo(gq.x), bfhi(gq.x), bflo(gq.y), bfhi(gq.y)};
        *(LAS f32x4*)(r + 320) = (f32x4){bflo(gv.x), bfhi(gv.x), bflo(gv.y), bfhi(gv.y)};
        if (c.tid < TB) { LAS float* q = L0 + buf * (TB * REC) + c.tid * REC + 384; *(LAS f32x2*)q = (f32x2){gbr[0], gbr[1]}; } };
    __syncthreads();
    gload(0); lstore(0);
    __syncthreads();
#pragma unroll 1
    for (int blk = 0; blk < SEGT / TB; ++blk) {
        const int buf = blk & 1;
        if (blk + 1 < SEGT / TB) gload(blk + 1);
        const LAS float* base = L0 + buf * (TB * REC);
        const size_t rowb = (size_t)b * SEGT + blk * TB;
        f32x4 nw4 = *(const LAS f32x4*)(base + cq * 4), na4 = *(const LAS f32x4*)(base + 64 + cq * 4), nb4 = *(const LAS f32x4*)(base + 128 + cq * 4), nk4 = *(const LAS f32x4*)(base + 192 + cq * 4), nq4 = *(const LAS f32x4*)(base + 256 + cq * 4);
        f32x2 nv2 = *(const LAS f32x2*)(base + 320 + 2 * rp), nbk = *(const LAS f32x2*)(base + 384);
#pragma unroll 2
        for (int tt = 0; tt < TB; ++tt) {
            const f32x4 w4 = nw4, a4 = na4, b4 = nb4, k4 = nk4, q4 = nq4; const f32x2 v2 = nv2, bk = nbk;
            { const LAS float* r = base + (tt + 1 < TB ? tt + 1 : tt) * REC;
              nw4 = *(const LAS f32x4*)(r + cq * 4); na4 = *(const LAS f32x4*)(r + 64 + cq * 4); nb4 = *(const LAS f32x4*)(r + 128 + cq * 4); nk4 = *(const LAS f32x4*)(r + 192 + cq * 4); nq4 = *(const LAS f32x4*)(r + 256 + cq * 4);
              nv2 = *(const LAS f32x2*)(r + 320 + 2 * rp); nbk = *(const LAS f32x2*)(r + 384); }
            const f32x2 wa = (f32x2){w4[0], w4[1]}, wb = (f32x2){w4[2], w4[3]}, aa = (f32x2){a4[0], a4[1]}, ab = (f32x2){a4[2], a4[3]}, ba = (f32x2){b4[0], b4[1]}, bb = (f32x2){b4[2], b4[3]};
            const f32x2 ka = (f32x2){k4[0], k4[1]}, kb = (f32x2){k4[2], k4[3]}, qa = (f32x2){q4[0], q4[1]}, qb = (f32x2){q4[2], q4[3]};
            f32x2 t0 = S0a * aa + S0b * ab, t1 = S0a * qa + S0b * qb, t2 = S1a * aa + S1b * ab, t3 = S1a * qa + S1b * qb;
            float pa0 = t0.x + t0.y, pt0 = t1.x + t1.y, pa1 = t2.x + t2.y, pt1 = t3.x + t3.y;
            row16_allsum4(pa0, pa1, pt0, pt1);
            const f32x2 pa0v = (f32x2){pa0, pa0}, pa1v = (f32x2){pa1, pa1}, v0v = (f32x2){v2.x, v2.x}, v1v = (f32x2){v2.y, v2.y};
            S0a = S0a * wa + pa0v * ba + v0v * ka; S0b = S0b * wb + pa0v * bb + v0v * kb;
            S1a = S1a * wa + pa1v * ba + v1v * ka; S1b = S1b * wb + pa1v * bb + v1v * kb;
            if (cq == 0) { const f32x2 y = (f32x2){pt0 + pa0 * bk.x + v2.x * bk.y, pt1 + pa1 * bk.x + v2.y * bk.y};
                *(f32x2*)(O + (rowb + tt) * DMIX + hh * 64 + 2 * rp) = y; }
        }
        if (blk + 1 < SEGT / TB) lstore(buf ^ 1);
        __syncthreads();
    }
    if (!save) return;
    *(f32x4*)(RST + (2 * rp) * 64 + cq * 4) = (f32x4){S0a.x, S0a.y, S0b.x, S0b.y}; *(f32x4*)(RST + (2 * rp + 1) * 64 + cq * 4) = (f32x4){S1a.x, S1a.y, S1b.x, S1b.y};
}

__device__ __forceinline__ void rwkv_chunk_item(const P& p, const Ctx& c, int seg, int w, bool save) {
    const int b = w / 24, hh = w % 24;
    const bf16_t* SA = (const bf16_t*)(c.seg + S1_A); const bf16_t* SB = (const bf16_t*)(c.seg + S1_B); const bf16_t* SK = (const bf16_t*)(c.seg + S1_K);
    const bf16_t* SR = (const bf16_t*)(c.seg + S1_Q); const bf16_t* SV = (const bf16_t*)(c.seg + S1_V); const float* GTB = (const float*)(c.seg + S1_W);
    bf16_t* O = (bf16_t*)(c.seg + S1_O); float* RST = (float*)(p.ws + OFF_RST) + (size_t)w * 4096;
    constexpr int O_EA = 0  , O_EB = 4608  , O_EBT = 9216  , O_UV = 14336  ,
                  O_MT1 = 19456  , O_NT = 20736  , O_MABT = 22016  ,
                  O_GT = 23296  , OPB = 23552;
    LAS unsigned char* OB = c.lds;
    LAS bf16_t* S0I = (LAS bf16_t*)(c.lds + 2 * OPB);
    LAS float* XF = (LAS float*)(c.lds + 2 * OPB + 9216);
    const int l15c = c.lane & 15, quadc = c.lane >> 4;
    f32x4 S[2];
#pragma unroll
    for (int x = 0; x < 2; ++x) { const int ti = c.wv * 2 + x, mt = ti >> 2, nt = ti & 3;
#pragma unroll
        for (int jj = 0; jj < 4; ++jj) S[x][jj] = (seg > 0) ? RST[(mt * 16 + quadc * 4 + jj) * 64 + nt * 16 + l15c] : 0.f; }
    unsigned ga = 0, gb = 0, gk = 0, gr = 0, gv = 0; float gg = 1.f;
    auto gload = [&](int ch, int tidv) { const int t = tidv >> 5, j0 = (tidv & 31) * 2; const size_t go = ((size_t)b * SEGT + ch * 16 + t) * DMIX + hh * 64 + j0;
        ga = *(const unsigned*)(SA + go); gb = *(const unsigned*)(SB + go); gk = *(const unsigned*)(SK + go); gr = *(const unsigned*)(SR + go); gv = *(const unsigned*)(SV + go);
        if (tidv < 64) gg = GTB[((size_t)(b * 32 + ch) * 24 + hh) * 64 + tidv]; };
    auto lstore = [&](int pb, int tidv) { const int t = tidv >> 5, j0 = (tidv & 31) * 2;
        LAS bf16_t* EA = (LAS bf16_t*)(OB + pb * OPB + O_EA); LAS bf16_t* EB = (LAS bf16_t*)(OB + pb * OPB + O_EB); LAS bf16_t* EBT = (LAS bf16_t*)(OB + pb * OPB + O_EBT);
        LAS bf16_t* UV = (LAS bf16_t*)(OB + pb * OPB + O_UV); LAS float* GT = (LAS float*)(OB + pb * OPB + O_GT);
        *(LAS unsigned*)(EA + t * 72 + j0) = ga; *(LAS unsigned*)(EA + (16 + t) * 72 + j0) = gr;
        *(LAS unsigned*)(EB + t * 72 + j0) = gb; *(LAS unsigned*)(EB + (16 + t) * 72 + j0) = gk;
        EBT[j0 * 40 + t] = (bf16_t)(gb & 0xFFFFu); EBT[(j0 + 1) * 40 + t] = (bf16_t)(gb >> 16); EBT[j0 * 40 + 16 + t] = (bf16_t)(gk & 0xFFFFu); EBT[(j0 + 1) * 40 + 16 + t] = (bf16_t)(gk >> 16);
        UV[j0 * 40 + 16 + t] = (bf16_t)(gv & 0xFFFFu); UV[(j0 + 1) * 40 + 16 + t] = (bf16_t)(gv >> 16); UV[j0 * 40 + t] = 0; UV[(j0 + 1) * 40 + t] = 0;
        if (tidv < 64) GT[tidv] = gg; };
    auto gtile = [&](int pb, int l15, int quad) {
        LAS bf16_t* EA = (LAS bf16_t*)(OB + pb * OPB + O_EA); LAS bf16_t* EB = (LAS bf16_t*)(OB + pb * OPB + O_EB);
        LAS bf16_t* MT1 = (LAS bf16_t*)(OB + pb * OPB + O_MT1); LAS bf16_t* NT = (LAS bf16_t*)(OB + pb * OPB + O_NT); LAS float* MABT = (LAS float*)(OB + pb * OPB + O_MABT);
        const int sb = c.wv >> 1, tb = c.wv & 1; f32x4 g = (f32x4){0.f, 0.f, 0.f, 0.f};
#pragma unroll
        for (int kk = 0; kk < 2; ++kk) g = mfma16(*(const LAS bf16x8*)(EB + (sb * 16 + l15) * 72 + kk * 32 + quad * 8), *(const LAS bf16x8*)(EA + (tb * 16 + l15) * 72 + kk * 32 + quad * 8), g);
#pragma unroll
        for (int jj = 0; jj < 4; ++jj) { const int s2 = quad * 4 + jj, tt = l15; const float v = g[jj];
            if (tb == 0) { const float m = (s2 < tt) ? v : 0.f; if (sb == 0) { MABT[tt * 20 + s2] = m; MT1[tt * 40 + s2] = 0; } else MT1[tt * 40 + 16 + s2] = f2bf(m); }
            else { const float m = (s2 <= tt) ? v : 0.f; NT[tt * 40 + sb * 16 + s2] = f2bf(m); } } };
    auto simg = [&](int l15, int quad) {
#pragma unroll
        for (int x = 0; x < 2; ++x) { const int ti = c.wv * 2 + x, mt = ti >> 2, nt = ti & 3;
#pragma unroll
            for (int jj = 0; jj < 4; ++jj) S0I[(mt * 16 + quad * 4 + jj) * 72 + nt * 16 + l15] = f2bf(S[x][jj]); } };
    __syncthreads();
    { int t0 = c.tid; asm volatile("" : "+v"(t0)); gload(0, t0); lstore(0, t0); simg(l15c, quadc); }
    lds_barrier();
    if (c.wv < 4) gtile(0, l15c, quadc);
    { int t1 = c.tid; asm volatile("" : "+v"(t1)); gload(1, t1); }
    const int mtq = c.wv & 3;
#pragma unroll 1
    for (int ch = 0; ch < SEGT / 16; ++ch) {
        const int pb = ch & 1;
        int tidv = c.tid, l15 = l15c, quad = quadc; asm volatile("" : "+v"(tidv), "+v"(l15), "+v"(quad));
        LAS bf16_t* EA = (LAS bf16_t*)(OB + pb * OPB + O_EA); LAS bf16_t* EBT = (LAS bf16_t*)(OB + pb * OPB + O_EBT); LAS bf16_t* UV = (LAS bf16_t*)(OB + pb * OPB + O_UV);
        LAS bf16_t* MT1 = (LAS bf16_t*)(OB + pb * OPB + O_MT1); LAS bf16_t* NT = (LAS bf16_t*)(OB + pb * OPB + O_NT); LAS float* MABT = (LAS float*)(OB + pb * OPB + O_MABT); LAS float* GT = (LAS float*)(OB + pb * OPB + O_GT);
        lds_barrier();
        f32x4 Zt = (f32x4){0.f, 0.f, 0.f, 0.f};
        if (c.wv >= 4) {
            f32x4 Xt = (f32x4){0.f, 0.f, 0.f, 0.f};
#pragma unroll
            for (int kk = 0; kk < 2; ++kk) { const bf16x8 a = *(const LAS bf16x8*)(S0I + (mtq * 16 + l15) * 72 + kk * 32 + quad * 8);
                Xt = mfma16(a, *(const LAS bf16x8*)(EA + l15 * 72 + kk * 32 + quad * 8), Xt); Zt = mfma16(a, *(const LAS bf16x8*)(EA + (16 + l15) * 72 + kk * 32 + quad * 8), Zt); }
            Xt = mfma16(*(const LAS bf16x8*)(UV + (mtq * 16 + l15) * 40 + quad * 8), *(const LAS bf16x8*)(MT1 + l15 * 40 + quad * 8), Xt);
#pragma unroll
            for (int jj = 0; jj < 4; ++jj) XF[(mtq * 16 + quad * 4 + jj) * 17 + l15] = Xt[jj];
        }
        lds_barrier();
        if (ch + 1 < SEGT / 16) lstore(pb ^ 1, tidv);
        if (ch + 2 < SEGT / 16) gload(ch + 2, tidv);
        if (c.wv == 0) {
            float u[16];
#pragma unroll
            for (int tt = 0; tt < 16; ++tt) { float acc = XF[c.lane * 17 + tt];
#pragma unroll
                for (int s4 = 0; s4 < (tt + 3) / 4; ++s4) { const f32x4 m = *(const LAS f32x4*)(MABT + tt * 20 + s4 * 4);
#pragma unroll
                    for (int e = 0; e < 4; ++e) if (s4 * 4 + e < tt) acc += u[s4 * 4 + e] * m[e]; }
                u[tt] = acc; }
            *(LAS u32x4*)(UV + c.lane * 40) = (u32x4){pk2(u[0], u[1]), pk2(u[2], u[3]), pk2(u[4], u[5]), pk2(u[6], u[7])};
            *(LAS u32x4*)(UV + c.lane * 40 + 8) = (u32x4){pk2(u[8], u[9]), pk2(u[10], u[11]), pk2(u[12], u[13]), pk2(u[14], u[15])};
        }
        lds_barrier();
        if (c.wv >= 4) {
            Zt = mfma16(*(const LAS bf16x8*)(UV + (mtq * 16 + l15) * 40 + quad * 8), *(const LAS bf16x8*)(NT + l15 * 40 + quad * 8), Zt);
            *(u32x2*)(O + ((size_t)b * SEGT + ch * 16 + l15) * DMIX + hh * 64 + mtq * 16 + quad * 4) = (u32x2){pk2(Zt[0], Zt[1]), pk2(Zt[2], Zt[3])};
        }
#pragma unroll
        for (int x = 0; x < 2; ++x) { const int ti = c.wv * 2 + x, mt = ti >> 2, nt = ti & 3;
            S[x] = mfma16(*(const LAS bf16x8*)(UV + (mt * 16 + l15) * 40 + quad * 8), *(const LAS bf16x8*)(EBT + (nt * 16 + l15) * 40 + quad * 8), S[x]);
            const float gt = GT[nt * 16 + l15];
#pragma unroll
            for (int jj = 0; jj < 4; ++jj) S[x][jj] *= gt; }
        simg(l15, quad);
        if (c.wv < 4 && ch + 1 < SEGT / 16) gtile(pb ^ 1, l15, quad);
    }
    if (!save) return;
#pragma unroll
    for (int x = 0; x < 2; ++x) { const int ti = c.wv * 2 + x, mt = ti >> 2, nt = ti & 3;
#pragma unroll
        for (int jj = 0; jj < 4; ++jj) RST[(mt * 16 + quadc * 4 + jj) * 64 + nt * 16 + l15c] = S[x][jj]; }
}

__device__ __forceinline__ void phase_b3(const P& p, const Ctx& c) {
    const bf16_t* O = (const bf16_t*)(c.seg + S1_O); const bf16_t* P2 = (const bf16_t*)(c.seg + S1_P2); const bf16_t* SV = (const bf16_t*)(c.seg + S1_V); const bf16_t* SG = (const bf16_t*)(c.seg + S1_G);
    const float* BRKR = (const float*)(c.seg + S1_BRKR); const bf16_t* YM = (const bf16_t*)(c.seg + S1_YMEM); bf16_t* Y = (bf16_t*)(c.seg + S1_Y);
    for (int r = c.bid * 8 + c.wv; r < MS; r += c.G * 8) {
#pragma unroll
        for (int ps = 0; ps < 3; ++ps) {
            const int hh = ps * 8 + (c.lane >> 3), ch = hh * 64 + (c.lane & 7) * 8;
            const u32x4 orr = *(const u32x4*)(O + (size_t)r * DMIX + ch);
            float v[8] = {bflo(orr.x), bfhi(orr.x), bflo(orr.y), bfhi(orr.y), bflo(orr.z), bfhi(orr.z), bflo(orr.w), bfhi(orr.w)}; float s = 0.f, s2 = 0.f;
#pragma unroll
            for (int j = 0; j < 8; ++j) { s += v[j]; s2 += v[j] * v[j]; }
            s += __shfl_xor(s, 1); s2 += __shfl_xor(s2, 1); s += __shfl_xor(s, 2); s2 += __shfl_xor(s2, 2); s += __shfl_xor(s, 4); s2 += __shfl_xor(s2, 4);
            const float mean = s * (1.0f / 64.0f), var = fmaxf(s2 * (1.0f / 64.0f) - mean * mean, 0.f), rs = rsqrtf(var + 64e-5f);
            const float rkr = BRKR[((size_t)r * 24 + hh) * 4 + 2];
            const u32x4 vr = *(const u32x4*)(SV + (size_t)r * DMIX + ch), gr = *(const u32x4*)(SG + (size_t)r * DMIX + ch), zr = *(const u32x4*)(P2 + (size_t)r * P2W + 512 + ch);
            const float vv[8] = {bflo(vr.x), bfhi(vr.x), bflo(vr.y), bfhi(vr.y), bflo(vr.z), bfhi(vr.z), bflo(vr.w), bfhi(vr.w)};
            const float gg[8] = {bflo(gr.x), bfhi(gr.x), bflo(gr.y), bfhi(gr.y), bflo(gr.z), bfhi(gr.z), bflo(gr.w), bfhi(gr.w)};
            const float zz[8] = {bflo(zr.x), bfhi(zr.x), bflo(zr.y), bfhi(zr.y), bflo(zr.z), bfhi(zr.z), bflo(zr.w), bfhi(zr.w)};
            float y[8];
#pragma unroll
            for (int j = 0; j < 8; ++j) { const float t = ((v[j] - mean) * rs * p.rw_lnx_g[ch + j] + p.rw_lnx_b[ch + j] + rkr * vv[j]) * gg[j]; y[j] = t * siluf_(zz[j]); }
            *(u32x4*)(Y + (size_t)r * DIN + ch) = (u32x4){pk2(y[0], y[1]), pk2(y[2], y[3]), pk2(y[4], y[5]), pk2(y[6], y[7])};
        }
        { const int cm = c.lane * 8; const u32x4 mr = *(const u32x4*)(YM + (size_t)r * DX + cm), zr = *(const u32x4*)(P2 + (size_t)r * P2W + 512 + DMIX + cm);
          const float mm[8] = {bflo(mr.x), bfhi(mr.x), bflo(mr.y), bfhi(mr.y), bflo(mr.z), bfhi(mr.z), bflo(mr.w), bfhi(mr.w)};
          const float zz[8] = {bflo(zr.x), bfhi(zr.x), bflo(zr.y), bfhi(zr.y), bflo(zr.z), bfhi(zr.z), bflo(zr.w), bfhi(zr.w)};
          float y[8];
#pragma unroll
          for (int j = 0; j < 8; ++j) y[j] = mm[j] * siluf_(zz[j]);
          *(u32x4*)(Y + (size_t)r * DIN + DMIX + cm) = (u32x4){pk2(y[0], y[1]), pk2(y[2], y[3]), pk2(y[4], y[5]), pk2(y[6], y[7])}; }
    }
}

__device__ __forceinline__ bool fresh_ctx(Ctx& c, P& p, unsigned char* ws0) { int t = threadIdx.x; asm volatile("" : "+v"(t)); c.tid = t; c.wv = __builtin_amdgcn_readfirstlane(t >> 6); c.lane = t & 63;
    int bb = (int)blockIdx.x, gg = (int)gridDim.x; asm volatile("" : "+s"(bb), "+s"(gg)); c.bid = bb; c.G = gg;
#if defined(__HIP_DEVICE_COMPILE__)
    { typedef const __attribute__((address_space(4))) unsigned long long* KP; KP kp = (KP)__builtin_amdgcn_kernarg_segment_ptr(); asm volatile("" : "+s"(kp));
      typedef __attribute__((address_space(1))) char* GP; char** dst = (char**)&p;
#pragma unroll
      for (int i = 0; i < (int)(sizeof(P) / 8); ++i) dst[i] = (char*)(GP)(kp[i]); }
#endif
    size_t z = 0; asm volatile("" : "+s"(z)); p.ws = ws0 + z; c.seg = ws0 + z + OFF_SEG;
    return true; }
__global__ __launch_bounds__(512) void fwd_megakernel(P p_arg) {
    P p = p_arg;
    extern __shared__ __attribute__((aligned(16))) unsigned char shm[];
    LAS unsigned char* lds = (LAS unsigned char*)shm;
    Ctx c; c.tid = threadIdx.x; c.wv = threadIdx.x >> 6; c.lane = threadIdx.x & 63; c.G = gridDim.x; c.bid = blockIdx.x; c.lds = lds; c.seg = p.ws + OFF_SEG;
    volatile LAS unsigned* st = (volatile LAS unsigned*)(lds + LDS_BYTES - 16);
    if (c.tid == 0) { st[0] = 0u; st[1] = 0u; }
    __syncthreads();
    const XcdBarrier xb = xcd_barrier_post((unsigned*)(p.ws + OFF_BAR), st);
#define GSYNC() do { XcdBarrier _xl = xb; size_t _zz = 0; asm volatile("" : "+s"(_zz)); _xl.bar = xb.bar + _zz; _xl.x = xb_xcc_id();     \
        xcd_barrier(_xl); if (RK == 20) { for (int _q = 1; _q < RN; ++_q) xcd_barrier(_xl); } } while (0)
#ifndef RK
#define RK -1
#endif
#ifndef RN
#define RN 1
#endif
#define NREP(k) ((k) == RK ? RN : 1)
#define PH(k) for (int _r = 0; _r < NREP(k); ++_r) if (fresh_ctx(c, p, p_arg.ws))
#define LASTREP(k) (_r + 1 == NREP(k))
    PH(0) phase0(p, c);
    PH(1) phase_apre(p, c, 0, c.bid, c.G);
    GSYNC();
    for (int seg = 0; seg < NSEG; ++seg) {
        PH(2) { SchedA0 S; S.ws = p.ws; S.seg = c.seg; S.G = c.G; S.c = c.bid; S.nextra = (seg == 0) ? 64 : 0;
          pg8::gemm_phase<pg8::EpiBf, SchedA0>(lds, c.tid, 1024, 1024, S, pg8::EpiBf{}); }
        GSYNC();
        PH(3) phase_a1(p, c, seg);
        GSYNC();
        for (int it0 = c.bid; it0 < 256; it0 += c.G) {
            const int xq = it0 & 7, yq = it0 >> 3; const int it = (yq < 24) ? ((xq * 4 + yq / 6) * 6 + yq % 6) : (192 + (yq - 24) * 8 + xq);
            if (it < 192) { PH(4) mlstm_item(p, c, seg, it, LASTREP(4)); }
            else { PH(5) attn_item(p, c, 0, it - 192, (const bf16_t*)(c.seg + S0_P0) + DMIX, ML_W, (bf16_t*)(c.seg + S0_YMEM)); }
        }
        GSYNC();
        PH(6) phase_a3(p, c, seg);
        GSYNC();
        PH(7) { SchedOut S; S.Y = (const char*)(c.seg + S0_Y); S.W = (const char*)(p.ws + OFF_WO0T); S.slab = (char*)(c.seg + S0_SLAB); S.G = c.G; S.c = c.bid;
          pg8::gemm_phase<pg8::EpiBf, SchedOut>(lds, c.tid, DIN, 512, S, pg8::EpiBf{}); }
        GSYNC();
        PH(8) phase_a5(p, c, seg);
        GSYNC();
        PH(9) { SchedB0 S; S.ws = p.ws; S.seg = c.seg; S.G = c.G; S.c = c.bid;
          pg8::gemm_phase<pg8::EpiBf, SchedB0>(lds, c.tid, 1024, 1024, S, pg8::EpiBf{}); }
        GSYNC();
        PH(10) phase_b1(p, c, seg);
        GSYNC();
        for (int it = c.bid; it < 256; it += c.G) {
            if (it < 192) { PH(11) rwkv_chunk_item(p, c, seg, it, LASTREP(11)); }
            else { PH(5) attn_item(p, c, 1, it - 192, (const bf16_t*)(c.seg + S1_P2), P2W, (bf16_t*)(c.seg + S1_YMEM));
                   if (c.G == 256) { PH(1) if (seg + 1 < NSEG) phase_apre(p, c, seg + 1, it - 192, 64); } }
        }
        GSYNC();
        PH(12) phase_b3(p, c);
        GSYNC();
        PH(13) { SchedOut S; S.Y = (const char*)(c.seg + S1_Y); S.W = (const char*)(p.ws + OFF_WO1T); S.slab = (char*)(c.seg + S1_SLAB); S.G = c.G; S.c = c.bid;
          pg8::gemm_phase<pg8::EpiBf, SchedOut>(lds, c.tid, DIN, 512, S, pg8::EpiBf{}); }
        GSYNC();
        PH(14) phase_b5(p, c, seg);
        if (c.G != 256) { PH(1) if (seg + 1 < NSEG) phase_apre(p, c, seg + 1, c.bid, c.G); GSYNC(); }
    }
}

extern "C" void kernel_launch(void* const* d_in, const int* in_sizes, int n_in, void* d_out, int out_size, void* d_ws, size_t ws_size, hipStream_t stream) {
    static int grid = 0;
    if (grid == 0) {
        int dev = 0, cus = 0, per_cu = 0;
        if (hipGetDevice(&dev) != hipSuccess || hipDeviceGetAttribute(&cus, hipDeviceAttributeMultiprocessorCount, dev) != hipSuccess) { grid = -1; return; }
        if (hipFuncSetAttribute((const void*)fwd_megakernel, hipFuncAttributeMaxDynamicSharedMemorySize, LDS_BYTES) != hipSuccess) { fprintf(stderr, "hipFuncSetAttribute failed\n"); grid = -1; return; }
        if (hipOccupancyMaxActiveBlocksPerMultiprocessor(&per_cu, (const void*)fwd_megakernel, 512, LDS_BYTES) != hipSuccess || per_cu < 1) { fprintf(stderr, "occupancy query: %d\n", per_cu); }
        (void)hipGetLastError();
        grid = cus;
        if (n_in != 31 || ws_size < 256 * MiB) { fprintf(stderr, "unexpected n_in %d / ws %zu\n", n_in, ws_size); grid = -1; return; }
    }
    if (grid < 0) return;
    (void)hipMemsetAsync((char*)d_ws + OFF_BAR, 0, XCD_BAR_WORDS * 4, stream);
    P p{};
    const float** f = (const float**)&p;
    for (int i = 0; i < 31; ++i) f[i] = (const float*)d_in[i];
    p.out = (float*)d_out; p.ws = (unsigned char*)d_ws;
    fwd_megakernel<<<dim3(grid), dim3(512), LDS_BYTES, stream>>>(p);
}
```

```cpp
#include <hip/hip_runtime.h>
#include <cstdio>
#include <cstdint>

#define LAS __attribute__((address_space(3)))
typedef unsigned short bf16_t;
typedef short bf16x8 __attribute__((ext_vector_type(8)));
typedef short bf16x4 __attribute__((ext_vector_type(4)));
typedef float f32x4 __attribute__((ext_vector_type(4)));
typedef float f32x2 __attribute__((ext_vector_type(2)));
typedef unsigned u32x4 __attribute__((ext_vector_type(4)));
typedef unsigned u32x2 __attribute__((ext_vector_type(2)));

constexpr int NB = 8, SEQ = 2048, DM = 1024, NSEG = 4, SEGT = 512, MS = NB * SEGT;
constexpr int DMIX = 1536, DX = 512, DIN = 2048;
constexpr int ML_W = 4096, RW_SHIFT = 4896, RW_W = 7456;
constexpr int P1W = 5120, P2W = 2560;
constexpr size_t MiB = 1u << 20;
constexpr size_t OFF_WT0 = 0, OFF_WT1 = 8 * MiB, OFF_WO0T = 23 * MiB, OFF_WO1T = 27 * MiB, OFF_WKVT = 31 * MiB  ,
                 OFF_KMEM = 35 * MiB  , OFF_LORAT = 43 * MiB, OFF_MISC = 45 * MiB,
                 OFF_CST = 46 * MiB, OFF_NST = 65 * MiB, OFF_RST = 65 * MiB + 512 * 1024, OFF_H = 69 * MiB, OFF_VF = 77 * MiB,
                 OFF_SEG = 89 * MiB, OFF_MEMN = 248 * MiB;
constexpr size_t OFF_BAR = OFF_MISC, OFF_UTAIL = OFF_MISC + 64 * 1024, OFF_PTAIL = OFF_MISC + 256 * 1024;
constexpr size_t S0_P0 = 0, S0_Q = 32 * MiB, S0_K = 44 * MiB, S0_KT = 56 * MiB, S0_VT = 68 * MiB, S0_XC = 80 * MiB, S0_HRAW = 92 * MiB,
                 S0_YMEM = 116 * MiB, S0_Y = 120 * MiB, S0_GATE = 136 * MiB;
constexpr size_t S1_P1 = 0, S1_O = 0, S1_Y = 24 * MiB, S1_P2 = 40 * MiB, S1_W = 60 * MiB, S1_A = 84 * MiB, S1_B = 96 * MiB, S1_K = 108 * MiB,
                 S1_Q = 120 * MiB, S1_V = 132 * MiB, S1_G = 144 * MiB, S1_YMEM = 156 * MiB, S1_BRKR = 160 * MiB;
constexpr size_t S0_SLAB = 0  , S1_SLAB = 84 * MiB  ;
constexpr int LDS_BYTES = 150 * 1024;

struct P {
    const float *x, *mem, *norm_g, *mem_norm_g, *mem_kv_w, *w_out, *ml_w_in, *ml_conv_w, *ml_conv_b, *ml_wq, *ml_wk, *ml_wv, *ml_w_gate, *ml_b_gate,
        *ml_mhn_g, *ml_skip, *rw_w_in, *rw_mu, *rw_w_lora2, *rw_w0, *rw_a_lora2, *rw_a0, *rw_v_lora2, *rw_v0, *rw_g_lora2, *rw_k_k, *rw_k_a, *rw_r_k,
        *rw_lnx_g, *rw_lnx_b, *final_g;
    float* out; unsigned char* ws;
};

__device__ __forceinline__ bf16_t f2bf(float f) { const __bf16 r = (__bf16)f; bf16_t u; __builtin_memcpy(&u, &r, 2); return u; }
__device__ __forceinline__ float bf2f(bf16_t b) { return __uint_as_float(((unsigned)b) << 16); }
typedef __bf16 bf2_t __attribute__((ext_vector_type(2)));
__device__ __forceinline__ unsigned pk2(float lo, float hi) { const bf2_t r = __builtin_convertvector((f32x2){lo, hi}, bf2_t); unsigned u; __builtin_memcpy(&u, &r, 4); return u; }
__device__ __forceinline__ float bflo(unsigned u) { return __uint_as_float(u << 16); }
__device__ __forceinline__ float bfhi(unsigned u) { return __uint_as_float(u & 0xFFFF0000u); }
__device__ __forceinline__ float wsum(float v) {
#pragma unroll
    for (int o = 32; o >= 1; o >>= 1) v += __shfl_xor(v, o);
    return v;
}
__device__ __forceinline__ float sigmoidf_(float x) { return 1.0f / (1.0f + __expf(-x)); }
__device__ __forceinline__ float siluf_(float x) { return x / (1.0f + __expf(-x)); }
__device__ __forceinline__ float softplusf_(float z) { return fmaxf(z, 0.f) + __logf(1.0f + __expf(-fabsf(z))); }
template <int CTRL> __device__ __forceinline__ float dpp_add(float v) {
    return v + __int_as_float(__builtin_amdgcn_update_dpp(0, __float_as_int(v), CTRL, 0xF, 0xF, true));
}
__device__ __forceinline__ float row16_allsum(float v) {
    v = dpp_add<0xB1>(v);
    v = dpp_add<0x4E>(v);
    v = dpp_add<0x141>(v);
    v = dpp_add<0x140>(v);
    return v;
}
__device__ __forceinline__ void row16_allsum4(float& a, float& b, float& c, float& d) {
    asm volatile("s_nop 1\n\t"
        "v_add_f32_dpp %0, %0, %0 quad_perm:[1,0,3,2] row_mask:0xf bank_mask:0xf\n\t" "v_add_f32_dpp %1, %1, %1 quad_perm:[1,0,3,2] row_mask:0xf bank_mask:0xf\n\t"
        "v_add_f32_dpp %2, %2, %2 quad_perm:[1,0,3,2] row_mask:0xf bank_mask:0xf\n\t" "v_add_f32_dpp %3, %3, %3 quad_perm:[1,0,3,2] row_mask:0xf bank_mask:0xf\n\t"
        "v_add_f32_dpp %0, %0, %0 quad_perm:[2,3,0,1] row_mask:0xf bank_mask:0xf\n\t" "v_add_f32_dpp %1, %1, %1 quad_perm:[2,3,0,1] row_mask:0xf bank_mask:0xf\n\t"
        "v_add_f32_dpp %2, %2, %2 quad_perm:[2,3,0,1] row_mask:0xf bank_mask:0xf\n\t" "v_add_f32_dpp %3, %3, %3 quad_perm:[2,3,0,1] row_mask:0xf bank_mask:0xf\n\t"
        "v_add_f32_dpp %0, %0, %0 row_half_mirror row_mask:0xf bank_mask:0xf\n\t" "v_add_f32_dpp %1, %1, %1 row_half_mirror row_mask:0xf bank_mask:0xf\n\t"
        "v_add_f32_dpp %2, %2, %2 row_half_mirror row_mask:0xf bank_mask:0xf\n\t" "v_add_f32_dpp %3, %3, %3 row_half_mirror row_mask:0xf bank_mask:0xf\n\t"
        "v_add_f32_dpp %0, %0, %0 row_mirror row_mask:0xf bank_mask:0xf\n\t" "v_add_f32_dpp %1, %1, %1 row_mirror row_mask:0xf bank_mask:0xf\n\t"
        "v_add_f32_dpp %2, %2, %2 row_mirror row_mask:0xf bank_mask:0xf\n\t" "v_add_f32_dpp %3, %3, %3 row_mirror row_mask:0xf bank_mask:0xf\n\t"
        "s_nop 1"
        : "+v"(a), "+v"(b), "+v"(c), "+v"(d));
}
template <int N> __device__ __forceinline__ float dpp_shr_or1(float v) {
    return __int_as_float(__builtin_amdgcn_update_dpp(0x3f800000, __float_as_int(v), 0x110 + N, 0xF, 0xF, false));
}
__device__ __forceinline__ f32x4 mfma16(bf16x8 a, bf16x8 b, f32x4 c) { return __builtin_amdgcn_mfma_f32_16x16x32_bf16(a, b, c, 0, 0, 0); }

namespace pg8 {
constexpr int BM = 256, BK = 64, HALF = 128, HTB = HALF * BK * 2, STAGE_BYTES = 8 * HTB, NXCD = 8, WGM = 8;
__host__ __device__ __forceinline__ int lds_byte(int r, int c) { const int st = (r >> 4) * 2 + (c >> 5), rr = r & 15, cc = c & 31, ob = rr * 64 + cc * 2; return st * 1024 + (ob ^ (((ob >> 9) & 1) << 5)); }
__host__ __device__ __forceinline__ void stage_rc(int b, int& R, int& C) { const int st = b / 1024, sb = b % 1024, swz = sb ^ (((sb >> 9) & 1) << 5); R = (st >> 1) * 16 + swz / 64; C = (st & 1) * 32 + (swz % 64) / 2; }
__host__ __device__ __forceinline__ int perm32(int rho) { const int n = rho >> 4, i = rho & 15; return 8 * (i >> 2) + 4 * n + (i & 3); }

struct Unit { const char* A; const char* B; char* O; int ldc; int pad; };

__device__ __forceinline__ void remap(int wgid, int nM, int nN, int& pm, int& pn) {
    const int nwg = nM * nN;
    { const int q = nwg / NXCD, r = nwg % NXCD, xcd = wgid % NXCD, off = wgid / NXCD; wgid = (xcd < r ? xcd * (q + 1) : r * (q + 1) + (xcd - r) * q) + off; }
    const int nig = WGM * nN, gid = wgid / nig, fm = gid * WGM, gsz = (nM - fm) < WGM ? (nM - fm) : WGM;
    pm = fm + ((wgid % nig) % gsz); pn = (wgid % nig) / gsz;
}

struct EpiBf {
    static constexpr bool PERM = true;
    __device__ __forceinline__ void operator()(const f32x4 (&acc)[2][2][4][2], const Unit& u, int wr, int wc, int fr, int fq) const {
        asm volatile("" : "+v"(fr), "+v"(fq));
        bf16_t* base = (bf16_t*)u.O;
#pragma unroll
        for (int ai = 0; ai < 2; ++ai)
#pragma unroll
            for (int m = 0; m < 4; ++m) { bf16_t* rowp = base + (size_t)(ai * HALF + wr * 64 + m * 16 + fr) * u.ldc + wc * 32 + 8 * fq;
#pragma unroll
                for (int bj = 0; bj < 2; ++bj) { const f32x4 v0 = acc[ai][bj][m][0], v1 = acc[ai][bj][m][1];
                    u32x4 w; w.x = pk2(v0[0], v0[1]); w.y = pk2(v0[2], v0[3]); w.z = pk2(v1[0], v1[1]); w.w = pk2(v1[2], v1[3]);
                    *(u32x4*)(rowp + bj * HALF) = w; } }
    }
};
struct EpiAtomic {
    static constexpr bool PERM = false;
    __device__ __forceinline__ void operator()(const f32x4 (&acc)[2][2][4][2], const Unit& u, int wr, int wc, int fr, int fq) const {
        asm volatile("" : "+v"(fr), "+v"(fq));
        float* base = (float*)u.O;
#pragma unroll
        for (int ai = 0; ai < 2; ++ai)
#pragma unroll
            for (int m = 0; m < 4; ++m) { float* rowp = base + (size_t)(ai * HALF + wr * 64 + m * 16 + fr) * u.ldc + wc * 32 + 4 * fq;
#pragma unroll
                for (int bj = 0; bj < 2; ++bj)
#pragma unroll
                    for (int n = 0; n < 2; ++n) { const f32x4 v = acc[ai][bj][m][n]; float* q = rowp + bj * HALF + n * 16;
#pragma unroll
                        for (int e = 0; e < 4; ++e) (void)__hip_atomic_fetch_add(q + e, v[e], __ATOMIC_RELAXED, __HIP_MEMORY_SCOPE_AGENT); }
                __builtin_amdgcn_sched_barrier(0); }
    }
};

template <class Epi, class Sched>
__device__ __forceinline__ void gemm_phase(LAS unsigned char* lds, const int tid, const int ldk, const int Kloop, const Sched& S, const Epi& E) {
    const int wid = __builtin_amdgcn_readfirstlane(tid >> 6), lane = tid & 63, wr = wid >> 2, wc = wid & 3, fr = lane & 15, fq = lane >> 4;
    const int nt = Kloop / BK;
    unsigned voffA[2], voffB[2];
#pragma unroll
    for (int i = 0; i < 2; ++i) { int R, C; stage_rc(tid * 16 + i * 8192, R, C); const int Rb = Epi::PERM ? ((R & ~31) + perm32(R & 31)) : R;
        voffA[i] = (unsigned)(R * ldk + C) * 2u; voffB[i] = (unsigned)(Rb * ldk + C) * 2u; }
    const size_t kstep = (size_t)(BK * 2);
    const size_t hstep = (size_t)HALF * ldk * 2;
    const unsigned ldsw = (unsigned)wid * 1024u;
    const int aoff = lds_byte(wr * 64 + fr, fq * 8), boff = lds_byte(wc * 32 + fr, fq * 8);
#define PG8_SA(b, h) (((b) * 2 + (h)) * HTB)
#define PG8_SB(b, h) ((4 + (b) * 2 + (h)) * HTB)
#define PG8_STAGE(bufoff, gbase, voff) do { _Pragma("unroll") for (int _i = 0; _i < 2; ++_i) \
        __builtin_amdgcn_global_load_lds((const unsigned*)((const char*)(gbase) + (voff)[_i]), (LAS unsigned*)(lds + (bufoff) + ldsw + _i * 8192), 16, 0, 0); } while (0)
#define PG8_LDA(dst, b, h) do { _Pragma("unroll") for (int m = 0; m < 4; ++m) _Pragma("unroll") for (int k = 0; k < 2; ++k) dst[m][k] = *(const LAS bf16x8*)(lds + PG8_SA(b, h) + aoff + m * 2048 + k * 1024); } while (0)
#define PG8_LDB(dst, b, h) do { _Pragma("unroll") for (int n = 0; n < 2; ++n) _Pragma("unroll") for (int k = 0; k < 2; ++k) dst[n][k] = *(const LAS bf16x8*)(lds + PG8_SB(b, h) + boff + n * 2048 + k * 1024); } while (0)
#define PG8_MMA(ai, bj, At, Bt) do { __builtin_amdgcn_s_setprio(1); _Pragma("unroll") for (int m = 0; m < 4; ++m) _Pragma("unroll") for (int n = 0; n < 2; ++n) _Pragma("unroll") for (int k = 0; k < 2; ++k) \
        acc[ai][bj][m][n] = __builtin_amdgcn_mfma_f32_16x16x32_bf16(Bt[n][k], At[m][k], acc[ai][bj][m][n], 0, 0, 0); __builtin_amdgcn_s_setprio(0); } while (0)
#define PG8_WAIT_V(n) asm volatile("s_waitcnt vmcnt(" #n ")" ::: "memory")
#define PG8_WAIT_L(n) asm volatile("s_waitcnt lgkmcnt(" #n ")" ::: "memory")
#define PG8_BAR __builtin_amdgcn_s_barrier()
#define PG8_SCHED __builtin_amdgcn_sched_barrier(0)
    Unit cur, nxt; int ui = 0;
    if (!S.next(0, cur)) return;
    f32x4 acc[2][2][4][2];
#pragma unroll
    for (int a = 0; a < 2; ++a)
#pragma unroll
        for (int b = 0; b < 2; ++b)
#pragma unroll
            for (int m = 0; m < 4; ++m)
#pragma unroll
                for (int n = 0; n < 2; ++n) acc[a][b][m][n] = (f32x4){0.f, 0.f, 0.f, 0.f};
    bf16x8 At[4][2], B0[2][2], B1[2][2];
    const char* cA = cur.A; const char* cB = cur.B;
    PG8_STAGE(PG8_SB(0, 0), cB, voffB); PG8_STAGE(PG8_SA(0, 0), cA, voffA); PG8_STAGE(PG8_SB(0, 1), cB + hstep, voffB); PG8_STAGE(PG8_SA(0, 1), cA + hstep, voffA);
    if (wr == 1) PG8_BAR;
    PG8_WAIT_V(4); PG8_BAR;
    PG8_STAGE(PG8_SB(1, 0), cB + kstep, voffB); PG8_STAGE(PG8_SA(1, 0), cA + kstep, voffA); PG8_STAGE(PG8_SB(1, 1), cB + hstep + kstep, voffB);
    PG8_WAIT_V(6); PG8_BAR;
    for (;;) {
        const bool has_next = S.next(ui + 1, nxt);
        const char* nA = has_next ? nxt.A : cA; const char* nB = has_next ? nxt.B : cB;
        for (int t = 0; t < nt; t += 2) {
            const bool last = (t == nt - 2);
            const char* a1 = cA + (size_t)(t + 1) * kstep;
            const char* a2 = last ? nA : cA + (size_t)(t + 2) * kstep; const char* b2 = last ? nB : cB + (size_t)(t + 2) * kstep;
            const char* a3 = a2 + kstep; const char* b3 = b2 + kstep;
            PG8_LDB(B0, 0, 0); PG8_SCHED; PG8_LDA(At, 0, 0); PG8_STAGE(PG8_SA(1, 1), a1 + hstep, voffA);
            PG8_WAIT_L(8); PG8_BAR; PG8_WAIT_L(0); PG8_MMA(0, 0, At, B0); PG8_BAR; PG8_SCHED;
            PG8_LDB(B1, 0, 1); PG8_STAGE(PG8_SB(0, 0), b2, voffB);
            PG8_BAR; PG8_WAIT_L(0); PG8_MMA(0, 1, At, B1); PG8_BAR;
            PG8_LDA(At, 0, 1); PG8_STAGE(PG8_SA(0, 0), a2, voffA);
            PG8_BAR; PG8_WAIT_L(0); PG8_MMA(1, 0, At, B0); PG8_BAR; PG8_SCHED;
            PG8_STAGE(PG8_SB(0, 1), b2 + hstep, voffB);
            PG8_WAIT_V(6); PG8_BAR; PG8_MMA(1, 1, At, B1); PG8_BAR;
            PG8_LDB(B0, 1, 0); PG8_SCHED; PG8_LDA(At, 1, 0); PG8_STAGE(PG8_SA(0, 1), a2 + hstep, voffA);
            PG8_WAIT_L(8); PG8_BAR; PG8_WAIT_L(0); PG8_MMA(0, 0, At, B0); PG8_BAR; PG8_SCHED;
            PG8_LDB(B1, 1, 1); PG8_STAGE(PG8_SB(1, 0), b3, voffB);
            PG8_BAR; PG8_WAIT_L(0); PG8_MMA(0, 1, At, B1); PG8_BAR;
            PG8_LDA(At, 1, 1); PG8_STAGE(PG8_SA(1, 0), a3, voffA);
            PG8_BAR; PG8_WAIT_L(0); PG8_MMA(1, 0, At, B0); PG8_BAR; PG8_SCHED;
            PG8_STAGE(PG8_SB(1, 1), b3 + hstep, voffB);
            PG8_WAIT_V(6); PG8_BAR; PG8_MMA(1, 1, At, B1); PG8_BAR;
        }
        E(acc, cur, wr, wc, fr, fq);
        if (!has_next) break;
#pragma unroll
        for (int a = 0; a < 2; ++a)
#pragma unroll
            for (int b = 0; b < 2; ++b)
#pragma unroll
                for (int m = 0; m < 4; ++m)
#pragma unroll
                    for (int n = 0; n < 2; ++n) acc[a][b][m][n] = (f32x4){0.f, 0.f, 0.f, 0.f};
        cur = nxt; cA = nA; cB = nB; ++ui;
    }
    PG8_WAIT_V(0);
    if (wr == 0) PG8_BAR;
    PG8_BAR;
#undef PG8_SA
#undef PG8_SB
#undef PG8_STAGE
#undef PG8_LDA
#undef PG8_LDB
#undef PG8_MMA
#undef PG8_WAIT_V
#undef PG8_WAIT_L
#undef PG8_BAR
#undef PG8_SCHED
}
}

#define XB_TMO      128
#define XB_XCNT(j)  (256  + 64 * (j))
#define XB_XSUB(j)  (1280 + 64 * (j))
#define XB_XGEN(j)  (2304 + 64 * (j))
#define XB_TOP      3328
#define XB_TOPGEN   3392
#define XCD_BAR_WORDS 3456
#define XB_SPIN_CAP (1u << 18)
__device__ __forceinline__ unsigned xb_ld(unsigned* p)              { return __hip_atomic_load(p, __ATOMIC_RELAXED, __HIP_MEMORY_SCOPE_AGENT); }
__device__ __forceinline__ unsigned xb_add(unsigned* p, unsigned v) { return __hip_atomic_fetch_add(p, v, __ATOMIC_RELAXED, __HIP_MEMORY_SCOPE_AGENT); }
__device__ __forceinline__ unsigned xb_xcc_id() { return (unsigned)__builtin_amdgcn_s_getreg((3 << 11) | 20) & 0xFu; }
#define XB_SPIN(cond, bar) do { unsigned _sp = 0; while (cond) { __builtin_amdgcn_s_sleep(1); \
    if ((++_sp & 255u) == 0u) { if (xb_ld(&(bar)[XB_TMO])) break; if (_sp > XB_SPIN_CAP) { atomicAdd(&(bar)[XB_TMO], 1u); break; } } } } while (0)
struct XcdBarrier { unsigned* bar; unsigned x; volatile LAS unsigned* st; };
__device__ __forceinline__ XcdBarrier xcd_barrier_post(unsigned* bar, volatile LAS unsigned* st) {
    XcdBarrier b; b.bar = bar; b.x = xb_xcc_id(); b.st = st;
    if (threadIdx.x == 0) (void)xb_add(&bar[XB_XCNT(b.x)], 1u);
    return b;
}
__device__ __forceinline__ void xcd_barrier_complete(unsigned* bar, unsigned x, unsigned& nloc, unsigned& nx) {
    const unsigned G = gridDim.x * gridDim.y * gridDim.z;
    unsigned sum, cnt, mine, sp = 0u;
    for (;;) {
        sum = 0u; cnt = 0u; mine = 0u;
#pragma unroll
        for (unsigned j = 0; j < 16; ++j) { const unsigned c = xb_ld(&bar[XB_XCNT(j)]); sum += c; cnt += (c > 0u) ? 1u : 0u; mine = (j == x) ? c : mine; }
        if (sum == G) break;
        __builtin_amdgcn_s_sleep(1);
        if ((++sp & 255u) == 0u) { if (xb_ld(&bar[XB_TMO])) break; if (sp > XB_SPIN_CAP) { atomicAdd(&bar[XB_TMO], 1u); break; } }
    }
    nloc = mine > 0u ? mine : 1u; nx = cnt > 0u ? cnt : 1u;
}
__device__ __forceinline__ void xcd_barrier(const XcdBarrier& b) {
    asm volatile("s_waitcnt vmcnt(0)" ::: "memory");
    __syncthreads();
    int tid0 = threadIdx.x; asm volatile("" : "+v"(tid0));
    if (tid0 == 0) {
        unsigned* bar = b.bar;
        __builtin_amdgcn_s_waitcnt(0);
        unsigned nloc = b.st[0], nx = b.st[1];
        if (nloc == 0u) { xcd_barrier_complete(bar, b.x, nloc, nx); b.st[0] = nloc; b.st[1] = nx; }
        const unsigned old = xb_add(&bar[XB_XSUB(b.x)], 1u);
        const unsigned gen = old / nloc;
        if (old + 1u == (gen + 1u) * nloc) {
            __builtin_amdgcn_fence(__ATOMIC_RELEASE, "agent");
            asm volatile("s_waitcnt vmcnt(0)" ::: "memory");
            const unsigned og = xb_add(&bar[XB_TOP], 1u);
            const unsigned tg = og / nx;
            if (og + 1u == (tg + 1u) * nx) xb_add(&bar[XB_TOPGEN], 1u);
            else XB_SPIN(xb_ld(&bar[XB_TOPGEN]) == tg, bar);
            __builtin_amdgcn_fence(__ATOMIC_ACQUIRE, "agent");
            xb_add(&bar[XB_XGEN(b.x)], 1u);
            asm volatile("s_waitcnt vmcnt(0)" ::: "memory");
        } else {
            XB_SPIN(xb_ld(&bar[XB_XGEN(b.x)]) == gen, bar);
            __builtin_amdgcn_fence(__ATOMIC_ACQUIRE, "agent");
            asm volatile("s_waitcnt vmcnt(0)" ::: "memory");
        }
    }
    __syncthreads();
}

__device__ __forceinline__ void lds_barrier() { asm volatile("s_waitcnt lgkmcnt(0)" ::: "memory"); __builtin_amdgcn_s_barrier(); asm volatile("" ::: "memory"); }
struct Ctx { int tid, wv, lane, G, bid; LAS unsigned char* lds; unsigned char* seg; };

template <int MODE>
__device__ __forceinline__ void convT_tile(const Ctx& c, const float* src, int ldsrc, int Ksrc, int k0, int n0, bf16_t* dst, int ldd, int koff) {
    LAS float* tile = (LAS float*)c.lds;
    __syncthreads();
#pragma unroll
    for (int rep = 0; rep < 2; ++rep) {
        const int i = (c.tid >> 4) + 32 * rep, j4 = (c.tid & 15) * 4; const int n = n0 + j4; int sc = n;
        if (MODE == 1) sc = (n < RW_SHIFT) ? n : (n < P1W ? -1 : n - (P1W - RW_SHIFT));
        f32x4 v = (f32x4){0.f, 0.f, 0.f, 0.f};
        if (sc >= 0 && (k0 + i) < Ksrc) v = *(const f32x4*)(src + (size_t)(k0 + i) * ldsrc + sc);
        tile[i * 65 + j4 + 0] = v[0]; tile[i * 65 + j4 + 1] = v[1]; tile[i * 65 + j4 + 2] = v[2]; tile[i * 65 + j4 + 3] = v[3];
    }
    __syncthreads();
    { const int j = c.tid >> 3, i8 = (c.tid & 7) * 8;
      if (k0 + i8 < Ksrc) {
        u32x4 w; w.x = pk2(tile[(i8 + 0) * 65 + j], tile[(i8 + 1) * 65 + j]); w.y = pk2(tile[(i8 + 2) * 65 + j], tile[(i8 + 3) * 65 + j]);
        w.z = pk2(tile[(i8 + 4) * 65 + j], tile[(i8 + 5) * 65 + j]); w.w = pk2(tile[(i8 + 6) * 65 + j], tile[(i8 + 7) * 65 + j]);
        *(u32x4*)(dst + (size_t)(n0 + j) * ldd + koff + k0 + i8) = w; } }
}

__device__ __forceinline__ void rms_row_bf16(const float* src, const float* g, bf16_t* dst, int lane) {
    f32x4 v[4]; float ss = 0.f;
#pragma unroll
    for (int i = 0; i < 4; ++i) { v[i] = *(const f32x4*)(src + i * 256 + lane * 4); ss += v[i][0] * v[i][0] + v[i][1] * v[i][1] + v[i][2] * v[i][2] + v[i][3] * v[i][3]; }
    ss = wsum(ss); const float rs = rsqrtf(ss * (1.0f / 1024.0f) + 1e-6f);
#pragma unroll
    for (int i = 0; i < 4; ++i) { const f32x4 gg = *(const f32x4*)(g + i * 256 + lane * 4);
        u32x2 w; w.x = pk2(v[i][0] * rs * gg[0], v[i][1] * rs * gg[1]); w.y = pk2(v[i][2] * rs * gg[2], v[i][3] * rs * gg[3]);
        *(u32x2*)(dst + i * 256 + lane * 4) = w; }
}
__device__ __forceinline__ float add_slabs(const float* src, const bf16_t* slab, int r, int lane, f32x4 (&v)[4]) {
    float ss = 0.f;
#pragma unroll
    for (int i = 0; i < 4; ++i) { v[i] = *(const f32x4*)(src + i * 256 + lane * 4);
#pragma unroll
        for (int ks = 0; ks < 4; ++ks) { const u32x2 t = *(const u32x2*)(slab + ((size_t)ks * MS + r) * DM + i * 256 + lane * 4);
            v[i][0] += bflo(t.x); v[i][1] += bfhi(t.x); v[i][2] += bflo(t.y); v[i][3] += bfhi(t.y); }
        ss += v[i][0] * v[i][0] + v[i][1] * v[i][1] + v[i][2] * v[i][2] + v[i][3] * v[i][3]; }
    return wsum(ss);
}

__device__ __forceinline__ void phase_apre(const P& p, const Ctx& c, int seg, int wg, int nwg) {
    bf16_t* H = (bf16_t*)(p.ws + OFF_H);
    for (int r = wg * 8 + c.wv; r < MS; r += nwg * 8) { const int b = r >> 9, tl = r & 511; const size_t grow = (size_t)b * SEQ + seg * SEGT + tl;
        rms_row_bf16(p.x + grow * DM, p.norm_g, H + (size_t)r * DM, c.lane); }
}
__device__ __forceinline__ void phase_a5(const P& p, const Ctx& c, int seg) {
    bf16_t* H = (bf16_t*)(p.ws + OFF_H); const bf16_t* slab = (const bf16_t*)(c.seg + S0_SLAB);
    for (int r = c.bid * 8 + c.wv; r < MS / 2; r += c.G * 8) {
        const int ra = r, rb = r + MS / 2;
        const size_t ga = (size_t)(ra >> 9) * SEQ + seg * SEGT + (ra & 511), gb = (size_t)(rb >> 9) * SEQ + seg * SEGT + (rb & 511);
        f32x4 va[4], vb[4]; const float sa = add_slabs(p.x + ga * DM, slab, ra, c.lane, va); const float sb = add_slabs(p.x + gb * DM, slab, rb, c.lane, vb);
        const float rsa = rsqrtf(sa * (1.0f / 1024.0f) + 1e-6f), rsb = rsqrtf(sb * (1.0f / 1024.0f) + 1e-6f);
#pragma unroll
        for (int i = 0; i < 4; ++i) { const f32x4 gg = *(const f32x4*)(p.norm_g + DM + i * 256 + c.lane * 4);
            *(f32x4*)(p.out + ga * DM + i * 256 + c.lane * 4) = va[i]; *(f32x4*)(p.out + gb * DM + i * 256 + c.lane * 4) = vb[i];
            u32x2 w; w.x = pk2(va[i][0] * rsa * gg[0], va[i][1] * rsa * gg[1]); w.y = pk2(va[i][2] * rsa * gg[2], va[i][3] * rsa * gg[3]);
            *(u32x2*)(H + (size_t)ra * DM + i * 256 + c.lane * 4) = w;
            w.x = pk2(vb[i][0] * rsb * gg[0], vb[i][1] * rsb * gg[1]); w.y = pk2(vb[i][2] * rsb * gg[2], vb[i][3] * rsb * gg[3]);
            *(u32x2*)(H + (size_t)rb * DM + i * 256 + c.lane * 4) = w; } }
}
__device__ __forceinline__ void phase_b5(const P& p, const Ctx& c, int seg) {
    const bf16_t* slab = (const bf16_t*)(c.seg + S1_SLAB);
    for (int r = c.bid * 8 + c.wv; r < MS / 2; r += c.G * 8) {
        const int ra = r, rb = r + MS / 2;
        float* rowa = p.out + ((size_t)(ra >> 9) * SEQ + seg * SEGT + (ra & 511)) * DM; float* rowb = p.out + ((size_t)(rb >> 9) * SEQ + seg * SEGT + (rb & 511)) * DM;
        f32x4 va[4], vb[4]; const float sa = add_slabs(rowa, slab, ra, c.lane, va); const float sb = add_slabs(rowb, slab, rb, c.lane, vb);
        const float rsa = rsqrtf(sa * (1.0f / 1024.0f) + 1e-6f), rsb = rsqrtf(sb * (1.0f / 1024.0f) + 1e-6f);
#pragma unroll
        for (int i = 0; i < 4; ++i) { const f32x4 gg = *(const f32x4*)(p.final_g + i * 256 + c.lane * 4); f32x4 o;
            o[0] = va[i][0] * rsa * gg[0]; o[1] = va[i][1] * rsa * gg[1]; o[2] = va[i][2] * rsa * gg[2]; o[3] = va[i][3] * rsa * gg[3]; *(f32x4*)(rowa + i * 256 + c.lane * 4) = o;
            o[0] = vb[i][0] * rsb * gg[0]; o[1] = vb[i][1] * rsb * gg[1]; o[2] = vb[i][2] * rsb * gg[2]; o[3] = vb[i][3] * rsb * gg[3]; *(f32x4*)(rowb + i * 256 + c.lane * 4) = o; } }
}

__device__ __forceinline__ void phase0(const P& p, const Ctx& c) {
    const int T0 = 16 * 64, T1 = 16 * 120, T2 = 32 * 16, T3 = 32 * 16, T4 = 16 * 16, T5 = 16 * 16, T6 = 24 * 5;
    const int TT = T0 + T1 + T2 + T3 + T4 + T5 + T6;
    for (int t = c.bid; t < TT; t += c.G) {
        int u = t;
        if (u < T0) { convT_tile<0>(c, p.ml_w_in, ML_W, 1024, (u & 15) * 64, (u >> 4) * 64, (bf16_t*)(p.ws + OFF_WT0), 1024, 0); continue; } u -= T0;
        if (u < T1) { convT_tile<1>(c, p.rw_w_in, RW_W, 1024, (u & 15) * 64, (u >> 4) * 64, (bf16_t*)(p.ws + OFF_WT1), 1024, 0); continue; } u -= T1;
        if (u < T2) { convT_tile<0>(c, p.w_out, DM, 2048, (u & 31) * 64, (u >> 5) * 64, (bf16_t*)(p.ws + OFF_WO0T), 2048, 0); continue; } u -= T2;
        if (u < T3) { convT_tile<0>(c, p.w_out + (size_t)DIN * DM, DM, 2048, (u & 31) * 64, (u >> 5) * 64, (bf16_t*)(p.ws + OFF_WO1T), 2048, 0); continue; } u -= T3;
        if (u < T4) { convT_tile<0>(c, p.mem_kv_w, DM, 1024, (u & 15) * 64, (u >> 4) * 64, (bf16_t*)(p.ws + OFF_WKVT), 1024, 0); continue; } u -= T4;
        if (u < T5) { convT_tile<0>(c, p.mem_kv_w + (size_t)DM * DM, DM, 1024, (u & 15) * 64, (u >> 4) * 64, (bf16_t*)(p.ws + OFF_WKVT + 2 * MiB), 1024, 0); continue; } u -= T5;
        { const int nt = u / 5, j = u % 5; bf16_t* L = (bf16_t*)(p.ws + OFF_LORAT);
          if (j == 0) convT_tile<0>(c, p.rw_w_lora2, DMIX, 64, 0, nt * 64, L, 288, 0);
          else if (j == 1) convT_tile<0>(c, p.rw_a_lora2, DMIX, 64, 0, nt * 64, L, 288, 64);
          else if (j == 2) convT_tile<0>(c, p.rw_v_lora2, DMIX, 32, 0, nt * 64, L, 288, 128);
          else convT_tile<0>(c, p.rw_g_lora2, DMIX, 128, (j - 3) * 64, nt * 64, L, 288, 160); }
    }
    for (int r = c.bid * 8 + c.wv; r < 2 * 2048; r += c.G * 8) { const int l = r >> 11, rr = r & 2047;
        rms_row_bf16(p.mem + (size_t)rr * DM, p.mem_norm_g + l * DM, (bf16_t*)(p.ws + OFF_MEMN) + (size_t)r * DM, c.lane); }
}

struct SchedA0 {
    const unsigned char* ws; unsigned char* seg; int G, c, nextra;
    __device__ __forceinline__ bool next(int i, pg8::Unit& u) const {
        const int L = i * G + c; if (L >= 256 + nextra) return false;
        if (L < 256) { int pm, pn; pg8::remap(L, 16, 16, pm, pn);
            u.A = (const char*)(ws + OFF_H) + (size_t)pm * 256 * 1024 * 2; u.B = (const char*)(ws + OFF_WT0) + (size_t)pn * 256 * 1024 * 2;
            u.O = (char*)(seg + S0_P0) + ((size_t)pm * 256 * ML_W + pn * 256) * 2; u.ldc = ML_W; return true; }
        const int e = L - 256, l = e >> 5, j = e & 31;
        const char* memn = (const char*)(ws + OFF_MEMN) + (size_t)l * 2048 * 1024 * 2; const char* wkv = (const char*)(ws + OFF_WKVT) + (size_t)l * 2 * MiB;
        char* kout = (char*)(ws + OFF_KMEM) + (size_t)l * 4 * MiB;
        if (j < 16) { const int pm = j >> 1, pn = j & 1;
            u.A = memn + (size_t)pm * 256 * 1024 * 2; u.B = wkv + (size_t)pn * 256 * 1024 * 2; u.O = kout + ((size_t)pm * 256 * 512 + pn * 256) * 2; u.ldc = 512; }
        else { const int jj = j - 16, pm = jj >> 3, pn = jj & 7;
            u.A = wkv + (size_t)(512 + pm * 256) * 1024 * 2; u.B = memn + (size_t)pn * 256 * 1024 * 2; u.O = kout + 2 * MiB + ((size_t)pm * 256 * 2048 + pn * 256) * 2; u.ldc = 2048; }
        return true;
    }
};
struct SchedB0 {
    const unsigned char* ws; unsigned char* seg; int G, c;
    __device__ __forceinline__ bool next(int i, pg8::Unit& u) const {
        const int L = i * G + c; if (L >= 480) return false;
        int pm, pn; pg8::remap(L, 16, 30, pm, pn);
        u.A = (const char*)(ws + OFF_H) + (size_t)pm * 256 * 1024 * 2; u.B = (const char*)(ws + OFF_WT1) + (size_t)pn * 256 * 1024 * 2;
        if (pn < 20) { u.O = (char*)(seg + S1_P1) + ((size_t)pm * 256 * P1W + pn * 256) * 2; u.ldc = P1W; }
        else { u.O = (char*)(seg + S1_P2) + ((size_t)pm * 256 * P2W + (pn - 20) * 256) * 2; u.ldc = P2W; }
        return true;
    }
};
struct SchedOut {
    const char* Y; const char* W; char* slab; int G, c;
    __device__ __forceinline__ bool next(int i, pg8::Unit& u) const {
        const int L = i * G + c; if (L >= 256) return false;
        const int ks = L >> 6; int pm, pn; pg8::remap(L & 63, 16, 4, pm, pn);
        u.A = Y + ((size_t)pm * 256 * DIN + ks * 512) * 2; u.B = W + ((size_t)pn * 256 * DIN + ks * 512) * 2;
        u.O = slab + (((size_t)ks * MS + pm * 256) * DM + pn * 256) * 2; u.ldc = DM; return true;
    }
};

__device__ __forceinline__ void phase_a1(const P& p, const Ctx& c, int seg) {
    const bf16_t* P0 = (const bf16_t*)(c.seg + S0_P0);
    bf16_t* Qb = (bf16_t*)(c.seg + S0_Q); bf16_t* Kb = (bf16_t*)(c.seg + S0_K); bf16_t* KT = (bf16_t*)(c.seg + S0_KT); bf16_t* VT = (bf16_t*)(c.seg + S0_VT);
    bf16_t* XC = (bf16_t*)(c.seg + S0_XC); bf16_t* VF = (bf16_t*)(p.ws + OFF_VF);
    float* IPRE = (float*)(c.seg + S0_GATE); float* LOGF = IPRE + 32 * SEGT;
    const bf16_t* UT = (const bf16_t*)(p.ws + OFF_UTAIL);
    LAS float* red = (LAS float*)c.lds;
    LAS bf16_t* kst = (LAS bf16_t*)(c.lds + 98304);
    LAS bf16_t* vst = kst + 1536 * 8;
    const int n = c.tid;
    float wq[4][4], wk[4][4], wv[4][4], G12[4][8], G3[4][8];
    if (n < 384) {
#pragma unroll
        for (int i = 0; i < 4; ++i) { const f32x4 a = *(const f32x4*)(p.ml_wq + n * 16 + i * 4), bb = *(const f32x4*)(p.ml_wk + n * 16 + i * 4), cc = *(const f32x4*)(p.ml_wv + n * 16 + i * 4);
#pragma unroll
            for (int o = 0; o < 4; ++o) { wq[i][o] = a[o]; wk[i][o] = bb[o]; wv[i][o] = cc[o]; } }
#pragma unroll
        for (int i = 0; i < 4; ++i)
#pragma unroll
            for (int g = 0; g < 8; ++g) { G12[i][g] = 0.f; G3[i][g] = 0.f; }
#pragma unroll
        for (int o = 0; o < 4; ++o) {
            const float* gq = p.ml_w_gate + (size_t)(n * 4 + o) * 8; const float* gk = p.ml_w_gate + (size_t)(DMIX + n * 4 + o) * 8; const float* gv = p.ml_w_gate + (size_t)(2 * DMIX + n * 4 + o) * 8;
            const f32x4 q0 = *(const f32x4*)gq, q1 = *(const f32x4*)(gq + 4), k0 = *(const f32x4*)gk, k1 = *(const f32x4*)(gk + 4), v0 = *(const f32x4*)gv, v1 = *(const f32x4*)(gv + 4);
#pragma unroll
            for (int i = 0; i < 4; ++i)
#pragma unroll
                for (int g = 0; g < 4; ++g) { G12[i][g] += wq[i][o] * q0[g] + wk[i][o] * k0[g]; G12[i][g + 4] += wq[i][o] * q1[g] + wk[i][o] * k1[g];
                    G3[i][g] += wv[i][o] * v0[g]; G3[i][g + 4] += wv[i][o] * v1[g]; }
        }
    }
#pragma unroll 1
    for (int it = c.bid; it < MS / 8; it += c.G) {
        const int row0 = it * 8, b = row0 >> 9, tl0 = row0 & 511;
        __syncthreads();
        if (n < 384) {
            float um[3][4];
#pragma unroll
            for (int j = 1; j <= 3; ++j) { u32x2 raw = (u32x2){0u, 0u};
                if (tl0 - j >= 0) raw = *(const u32x2*)(P0 + (unsigned)((row0 - j) * ML_W + n * 4));
                else if (seg > 0) raw = *(const u32x2*)(UT + (unsigned)((b * 3 + (3 - j)) * DMIX + n * 4));
                um[3 - j][0] = bflo(raw.x); um[3 - j][1] = bfhi(raw.x); um[3 - j][2] = bflo(raw.y); um[3 - j][3] = bfhi(raw.y); }
            u32x2 nraw = *(const u32x2*)(P0 + (unsigned)(row0 * ML_W + n * 4));
#pragma unroll 1
            for (int tt = 0; tt < 8; ++tt) {
                const unsigned row = (unsigned)(row0 + tt);
                const u32x2 raw = nraw;
                if (tt + 1 < 8) nraw = *(const u32x2*)(P0 + (unsigned)((row + 1) * ML_W + n * 4));
                float u[4] = {bflo(raw.x), bfhi(raw.x), bflo(raw.y), bfhi(raw.y)}, xc[4], q[4], k[4], v[4];
                { int nn = n; asm volatile("" : "+v"(nn));
                  const f32x4 cb = *(const f32x4*)(p.ml_conv_b + nn * 4), c0 = *(const f32x4*)(p.ml_conv_w + nn * 4), c1 = *(const f32x4*)(p.ml_conv_w + DMIX + nn * 4),
                              c2 = *(const f32x4*)(p.ml_conv_w + 2 * DMIX + nn * 4), c3 = *(const f32x4*)(p.ml_conv_w + 3 * DMIX + nn * 4);
#pragma unroll
                  for (int i = 0; i < 4; ++i) { const float y = cb[i] + c0[i] * um[0][i] + c1[i] * um[1][i] + c2[i] * um[2][i] + c3[i] * u[i]; xc[i] = siluf_(y); } }
                const float ks = 0.05103103630798288f;
#pragma unroll
                for (int o = 0; o < 4; ++o) { q[o] = xc[0] * wq[0][o] + xc[1] * wq[1][o] + xc[2] * wq[2][o] + xc[3] * wq[3][o];
                    k[o] = (xc[0] * wk[0][o] + xc[1] * wk[1][o] + xc[2] * wk[2][o] + xc[3] * wk[3][o]) * ks;
                    v[o] = u[0] * wv[0][o] + u[1] * wv[1][o] + u[2] * wv[2][o] + u[3] * wv[3][o]; }
#pragma unroll
                for (int g = 0; g < 8; ++g) red[(tt * 8 + g) * 384 + n] = xc[0] * G12[0][g] + xc[1] * G12[1][g] + xc[2] * G12[2][g] + xc[3] * G12[3][g] + u[0] * G3[0][g] + u[1] * G3[1][g] + u[2] * G3[2][g] + u[3] * G3[3][g];
                u32x2 w; w.x = pk2(q[0], q[1]); w.y = pk2(q[2], q[3]); *(u32x2*)(Qb + (unsigned)(row * DMIX + n * 4)) = w;
                w.x = pk2(k[0], k[1]); w.y = pk2(k[2], k[3]); *(u32x2*)(Kb + (unsigned)(row * DMIX + n * 4)) = w;
                w.x = pk2(xc[0], xc[1]); w.y = pk2(xc[2], xc[3]); *(u32x2*)(XC + (unsigned)(row * DMIX + n * 4)) = w;
                w.x = pk2(v[0], v[1]); w.y = pk2(v[2], v[3]); *(u32x2*)(VF + (unsigned)(row * DMIX + n * 4)) = w;
#pragma unroll
                for (int o = 0; o < 4; ++o) { kst[(n * 4 + o) * 8 + tt] = f2bf(k[o]); vst[(n * 4 + o) * 8 + tt] = f2bf(v[o]); }
#pragma unroll
                for (int i = 0; i < 4; ++i) { um[0][i] = um[1][i]; um[1][i] = um[2][i]; um[2][i] = u[i]; }
            }
            const int hd = n / 96, dch = (n % 96) * 4;
#pragma unroll
            for (int o = 0; o < 4; ++o) { const unsigned off = (unsigned)(((b * 4 + hd) * 384 + dch + o) * SEGT + tl0);
                *(u32x4*)(KT + off) = *(const LAS u32x4*)(kst + (n * 4 + o) * 8); *(u32x4*)(VT + off) = *(const LAS u32x4*)(vst + (n * 4 + o) * 8); }
        }
        __syncthreads();
        { const int v = c.tid >> 3, part = c.tid & 7; float s = 0.f;
#pragma unroll 8
          for (int i = 0; i < 48; ++i) s += red[v * 384 + part * 48 + i];
          s += __shfl_xor(s, 1); s += __shfl_xor(s, 2); s += __shfl_xor(s, 4);
          if (part == 0) { const int tt = v >> 3, g = v & 7; const float gate = s + p.ml_b_gate[g];
              if (g < 4) IPRE[(b * 4 + g) * SEGT + tl0 + tt] = gate; else LOGF[(b * 4 + g - 4) * SEGT + tl0 + tt] = -softplusf_(-gate); } }
    }
}

__device__ __forceinline__ void attn_item(const P& p, const Ctx& c, int layer, int it, const bf16_t* Qp, int ldq, bf16_t* YM) {
    const int b = it >> 3, head = (it >> 1) & 3, qb = it & 1;
    const bf16_t* Kg = (const bf16_t*)(p.ws + OFF_KMEM + (size_t)layer * 4 * MiB) + (size_t)(b * 256) * 512 + head * 128;
    const bf16_t* Vg = (const bf16_t*)(p.ws + OFF_KMEM + (size_t)layer * 4 * MiB + 2 * MiB) + (size_t)(head * 128) * 2048 + b * 256;
    LAS bf16_t* Ks = (LAS bf16_t*)c.lds;
    LAS bf16_t* Vs = Ks + 256 * 136;
    const int l15 = c.lane & 15, quad = c.lane >> 4;
    __syncthreads();
#pragma unroll
    for (int r = 0; r < 8; ++r) { const int id = c.tid + 512 * r; { const int i = id >> 4, c8 = (id & 15) * 8; *(LAS u32x4*)(Ks + i * 136 + c8) = *(const u32x4*)(Kg + (size_t)i * 512 + c8); }
        { const int i = id >> 5, c8 = (id & 31) * 8; *(LAS u32x4*)(Vs + i * 264 + c8) = *(const u32x4*)(Vg + (size_t)i * 2048 + c8); } }
    __syncthreads();
#pragma unroll 1
    for (int pass = 0; pass < 2; ++pass) {
        const int row0 = b * SEGT + qb * 256 + c.wv * 32 + pass * 16;
        bf16x8 qf[4];
#pragma unroll
        for (int kk = 0; kk < 4; ++kk) qf[kk] = *(const bf16x8*)(Qp + (size_t)(row0 + l15) * ldq + head * 128 + kk * 32 + quad * 8);
        f32x4 acc[16];
#pragma unroll
        for (int mt = 0; mt < 16; ++mt) { acc[mt] = (f32x4){0.f, 0.f, 0.f, 0.f};
#pragma unroll
            for (int kk = 0; kk < 4; ++kk) { const bf16x8 a = *(const LAS bf16x8*)(Ks + (mt * 16 + l15) * 136 + kk * 32 + quad * 8); acc[mt] = mfma16(a, qf[kk], acc[mt]); }
            if ((mt & 3) == 3) __builtin_amdgcn_sched_barrier(0); }
        float mx = -1e30f;
#pragma unroll
        for (int mt = 0; mt < 16; ++mt)
#pragma unroll
            for (int j = 0; j < 4; ++j) mx = fmaxf(mx, acc[mt][j]);
        mx = fmaxf(mx, __shfl_xor(mx, 16)); mx = fmaxf(mx, __shfl_xor(mx, 32));
        const float sc = 0.08838834764831845f * 1.4426950408889634f; float sm = 0.f;
#pragma unroll
        for (int mt = 0; mt < 16; ++mt)
#pragma unroll
            for (int j = 0; j < 4; ++j) { const float e = exp2f((acc[mt][j] - mx) * sc); acc[mt][j] = e; sm += e; }
        sm += __shfl_xor(sm, 16); sm += __shfl_xor(sm, 32);
        const float inv = 1.0f / sm;
        bf16x8 pa[8];
#pragma unroll
        for (int kp = 0; kp < 8; ++kp) {
            u32x4 aw; aw.x = pk2(acc[2 * kp][0] * inv, acc[2 * kp][1] * inv); aw.y = pk2(acc[2 * kp][2] * inv, acc[2 * kp][3] * inv);
            aw.z = pk2(acc[2 * kp + 1][0] * inv, acc[2 * kp + 1][1] * inv); aw.w = pk2(acc[2 * kp + 1][2] * inv, acc[2 * kp + 1][3] * inv);
            __builtin_memcpy(&pa[kp], &aw, 16); }
        __builtin_amdgcn_sched_barrier(0);
        f32x4 o[8];
#pragma unroll
        for (int nt = 0; nt < 8; ++nt) o[nt] = (f32x4){0.f, 0.f, 0.f, 0.f};
#pragma unroll
        for (int kp = 0; kp < 8; ++kp) {
            const bf16x8 a = pa[kp];
#pragma unroll
            for (int nt = 0; nt < 8; ++nt) { const LAS bf16_t* vp = Vs + (nt * 16 + l15) * 264 + 2 * kp * 16 + quad * 4;
                const u32x2 lo = *(const LAS u32x2*)vp, hi = *(const LAS u32x2*)(vp + 16); u32x4 bw = (u32x4){lo.x, lo.y, hi.x, hi.y}; bf16x8 bfr; __builtin_memcpy(&bfr, &bw, 16);
                o[nt] = mfma16(a, bfr, o[nt]); }
            __builtin_amdgcn_sched_barrier(0);
        }
#pragma unroll
        for (int nt = 0; nt < 8; ++nt)
#pragma unroll
            for (int j = 0; j < 4; ++j) YM[(size_t)(row0 + quad * 4 + j) * DX + head * 128 + nt * 16 + l15] = f2bf(o[nt][j]);
    }
}

__device__ __forceinline__ void mlstm_item(const P& p, const Ctx& c, int seg, int w, bool save) {
    const int b = w / 24, h = (w / 6) & 3, sl = w % 6;
    const bf16_t* Qb = (const bf16_t*)(c.seg + S0_Q); const bf16_t* Kb = (const bf16_t*)(c.seg + S0_K); const bf16_t* KT = (const bf16_t*)(c.seg + S0_KT); const bf16_t* VT = (const bf16_t*)(c.seg + S0_VT);
    const float* IPRE = (const float*)(c.seg + S0_GATE); const float* LOGF = IPRE + 32 * SEGT;
    bf16_t* HR = (bf16_t*)(c.seg + S0_HRAW);
    float* CST = (float*)(p.ws + OFF_CST) + (size_t)w * 64 * 384; float* NST = (float*)(p.ws + OFF_NST) + (size_t)w * 384;
    LAS bf16_t* Cimg = (LAS bf16_t*)c.lds;
    LAS bf16_t* Qs = Cimg + 64 * 392;
    LAS bf16_t* Ks = Qs + 64 * 136;
    LAS bf16_t* KTs = Ks + 64 * 136;
    LAS bf16_t* VTs = KTs + 128 * 72;
    LAS bf16_t* VWs = VTs + 64 * 72;
    LAS bf16_t* Sp = VWs + 64 * 72;
    LAS float* fl = (LAS float*)(Sp + 64 * 72);
    LAS float* bcum = fl; LAS float* ipr = fl + 64; LAS float* wgt = fl + 128; LAS float* gin = fl + 192; LAS float* qn = fl + 256; LAS float* rden = fl + 320;
    LAS float* gtotp = fl + 384; LAS float* nold = fl + 400; LAS float* nnew = fl + 800;
    const int l15c = c.lane & 15, quadc = c.lane >> 4, e16 = c.wv & 3, par = c.wv >> 2;
    f32x4 C[12];
    __syncthreads();
    if (seg > 0) {
#pragma unroll
        for (int j = 0; j < 12; ++j)
#pragma unroll
            for (int jj = 0; jj < 4; ++jj) C[j][jj] = CST[(size_t)(e16 * 16 + quadc * 4 + jj) * 384 + (2 * j + par) * 16 + l15c];
        if (c.tid < 384) nold[c.tid] = NST[c.tid];
    } else {
#pragma unroll
        for (int j = 0; j < 12; ++j) C[j] = (f32x4){0.f, 0.f, 0.f, 0.f};
        if (c.tid < 384) nold[c.tid] = 0.f;
    }
    u32x4 pq[2], pk[2], pt[2], pvt; float plf = 0.f, pip = 0.f;
    auto gl_piece = [&](int ch, int pp, int tidv) {
#pragma unroll
        for (int r = 0; r < 2; ++r) { const int id = tidv + 512 * r;
            { const int i = id >> 4, c8 = (id & 15) * 8; const size_t go = ((size_t)b * SEGT + ch * 64 + i) * DMIX + h * 384 + pp * 128 + c8; pq[r] = *(const u32x4*)(Qb + go); pk[r] = *(const u32x4*)(Kb + go); }
            { const int dd = id >> 3, c8 = (id & 7) * 8; pt[r] = *(const u32x4*)(KT + ((size_t)(b * 4 + h) * 384 + pp * 128 + dd) * SEGT + ch * 64 + c8); } } };
    auto gl_chunk = [&](int ch, int tidv) { const int i = tidv >> 3, c8 = (tidv & 7) * 8;
        pvt = *(const u32x4*)(VT + ((size_t)(b * 4 + h) * 384 + sl * 64 + i) * SEGT + ch * 64 + c8);
        if (c.wv == 0) { plf = LOGF[(b * 4 + h) * SEGT + ch * 64 + c.lane]; pip = IPRE[(b * 4 + h) * SEGT + ch * 64 + c.lane]; } };
    { int t0 = c.tid; asm volatile("" : "+v"(t0)); gl_chunk(0, t0); gl_piece(0, 0, t0); }
#pragma unroll 1
    for (int ch = 0; ch < 8; ++ch) {
        const int tl0 = ch * 64; const size_t row0 = (size_t)b * SEGT + tl0;
        int tidv = c.tid, l15 = l15c, quad = quadc;
        asm volatile("" : "+v"(tidv), "+v"(l15), "+v"(quad));
        lds_barrier();
        if (c.wv == 0) {
            float bc = plf;
#pragma unroll
            for (int o = 1; o < 64; o <<= 1) { const float t = __shfl_up(bc, o); if (c.lane >= o) bc += t; }
            const float bl = __shfl(bc, 63);
            bcum[c.lane] = bc; ipr[c.lane] = pip; wgt[c.lane] = __expf(bl - bc + pip); gin[c.lane] = __expf(bc);
            if (c.lane == 0) gtotp[0] = __expf(bl);
        }
#pragma unroll
        for (int j = 0; j < 12; ++j)
#pragma unroll
            for (int jj = 0; jj < 4; ++jj) Cimg[(e16 * 16 + quad * 4 + jj) * 392 + (2 * j + par) * 16 + l15] = f2bf(C[j][jj]);
        lds_barrier();
        { const int i = tidv >> 3, c8 = (tidv & 7) * 8;
          const u32x4 raw = pvt;
          *(LAS u32x4*)(VTs + i * 72 + c8) = raw;
          const f32x4 w0 = *(const LAS f32x4*)(wgt + c8), w1 = *(const LAS f32x4*)(wgt + c8 + 4);
          u32x4 sw; sw.x = pk2(bflo(raw.x) * w0[0], bfhi(raw.x) * w0[1]); sw.y = pk2(bflo(raw.y) * w0[2], bfhi(raw.y) * w0[3]);
          sw.z = pk2(bflo(raw.z) * w1[0], bfhi(raw.z) * w1[1]); sw.w = pk2(bflo(raw.w) * w1[2], bfhi(raw.w) * w1[3]);
          *(LAS u32x4*)(VWs + i * 72 + c8) = sw; }
        if (ch + 1 < 8) gl_chunk(ch + 1, tidv);
        const float gtot = gtotp[0];
#pragma unroll
        for (int j = 0; j < 12; ++j) C[j] *= gtot;
        f32x4 Sa[2], Ia[2]; Sa[0] = Sa[1] = Ia[0] = Ia[1] = (f32x4){0.f, 0.f, 0.f, 0.f};
        float qnacc = 0.f;
#pragma unroll
        for (int pp = 0; pp < 3; ++pp) {
            const int d0 = pp * 128;
            __builtin_amdgcn_sched_barrier(0);
            asm volatile("" : "+v"(tidv));
            lds_barrier();
#pragma unroll
            for (int r = 0; r < 2; ++r) { const int id = tidv + 512 * r;
                { const int i = id >> 4, c8 = (id & 15) * 8; *(LAS u32x4*)(Qs + i * 136 + c8) = pq[r]; *(LAS u32x4*)(Ks + i * 136 + c8) = pk[r]; }
                { const int dd = id >> 3, c8 = (id & 7) * 8; *(LAS u32x4*)(KTs + dd * 72 + c8) = pt[r]; } }
            lds_barrier();
            if (pp < 2) gl_piece(ch, pp + 1, tidv); else if (ch + 1 < 8) gl_piece(ch + 1, 0, tidv);
            { const int tm = c.wv >> 1, tn0 = (c.wv & 1) * 2;
#pragma unroll
              for (int kk = 0; kk < 4; ++kk) { const bf16x8 a = *(const LAS bf16x8*)(Qs + (tm * 16 + l15) * 136 + kk * 32 + quad * 8);
#pragma unroll
                  for (int x = 0; x < 2; ++x) { const int tn = tn0 + x;
                      const bf16x8 bk = *(const LAS bf16x8*)(Ks + (tn * 16 + l15) * 136 + kk * 32 + quad * 8);
                      const bf16x8 bc = *(const LAS bf16x8*)(Cimg + (tn * 16 + l15) * 392 + d0 + kk * 32 + quad * 8);
                      Sa[x] = mfma16(a, bk, Sa[x]); Ia[x] = mfma16(a, bc, Ia[x]); } } }
            { const bf16x8 va0 = *(const LAS bf16x8*)(VWs + (e16 * 16 + l15) * 72 + quad * 8), va1 = *(const LAS bf16x8*)(VWs + (e16 * 16 + l15) * 72 + 32 + quad * 8);
#pragma unroll
              for (int jl = 0; jl < 4; ++jl) { const int ntl = 2 * jl + par, j = pp * 4 + jl;
                  C[j] = mfma16(va0, *(const LAS bf16x8*)(KTs + (ntl * 16 + l15) * 72 + quad * 8), C[j]);
                  C[j] = mfma16(va1, *(const LAS bf16x8*)(KTs + (ntl * 16 + l15) * 72 + 32 + quad * 8), C[j]); } }
            { const int t = tidv >> 3, part = tidv & 7;
              const u32x4 q0 = *(const LAS u32x4*)(Qs + t * 136 + part * 16), q1 = *(const LAS u32x4*)(Qs + t * 136 + part * 16 + 8);
              const LAS float* np = nold + d0 + part * 16; const f32x4 n0 = *(const LAS f32x4*)np, n1 = *(const LAS f32x4*)(np + 4), n2 = *(const LAS f32x4*)(np + 8), n3 = *(const LAS f32x4*)(np + 12);
              qnacc += bflo(q0.x) * n0[0] + bfhi(q0.x) * n0[1] + bflo(q0.y) * n0[2] + bfhi(q0.y) * n0[3] + bflo(q0.z) * n1[0] + bfhi(q0.z) * n1[1] + bflo(q0.w) * n1[2] + bfhi(q0.w) * n1[3]
                     + bflo(q1.x) * n2[0] + bfhi(q1.x) * n2[1] + bflo(q1.y) * n2[2] + bfhi(q1.y) * n2[3] + bflo(q1.z) * n3[0] + bfhi(q1.z) * n3[1] + bflo(q1.w) * n3[2] + bfhi(q1.w) * n3[3]; }
            { const int dd = tidv >> 2, part = tidv & 3;
              const u32x4 k0 = *(const LAS u32x4*)(KTs + dd * 72 + part * 16), k1 = *(const LAS u32x4*)(KTs + dd * 72 + part * 16 + 8);
              const LAS float* wp = wgt + part * 16; const f32x4 w0 = *(const LAS f32x4*)wp, w1 = *(const LAS f32x4*)(wp + 4), w2 = *(const LAS f32x4*)(wp + 8), w3 = *(const LAS f32x4*)(wp + 12);
              float a = bflo(k0.x) * w0[0] + bfhi(k0.x) * w0[1] + bflo(k0.y) * w0[2] + bfhi(k0.y) * w0[3] + bflo(k0.z) * w1[0] + bfhi(k0.z) * w1[1] + bflo(k0.w) * w1[2] + bfhi(k0.w) * w1[3]
                      + bflo(k1.x) * w2[0] + bfhi(k1.x) * w2[1] + bflo(k1.y) * w2[2] + bfhi(k1.y) * w2[3] + bflo(k1.z) * w3[0] + bfhi(k1.z) * w3[1] + bflo(k1.w) * w3[2] + bfhi(k1.w) * w3[3];
              a = dpp_add<0xB1>(a); a = dpp_add<0x4E>(a);
              if (part == 0) nnew[d0 + dd] = gtot * nold[d0 + dd] + a; }
        }
        qnacc = dpp_add<0xB1>(qnacc); qnacc = dpp_add<0x4E>(qnacc); qnacc = dpp_add<0x141>(qnacc);
        if ((tidv & 7) == 0) qn[tidv >> 3] = qnacc;
#pragma unroll
        for (int x = 0; x < 2; ++x) { const int ti = c.wv * 2 + x, tm = ti >> 2, tn = ti & 3; const int s = tn * 16 + l15; const float bs = bcum[s] - ipr[s];
#pragma unroll
            for (int jj = 0; jj < 4; ++jj) { const int t = tm * 16 + quad * 4 + jj; const float v = (s <= t) ? Sa[x][jj] * __expf(bcum[t] - bs) : 0.f; Sp[t * 72 + s] = f2bf(v); } }
        lds_barrier();
        { const int t = tidv >> 3, part = tidv & 7; const u32x4 sr = *(const LAS u32x4*)(Sp + t * 72 + part * 8);
          float ds = bflo(sr.x) + bfhi(sr.x) + bflo(sr.y) + bfhi(sr.y) + bflo(sr.z) + bfhi(sr.z) + bflo(sr.w) + bfhi(sr.w);
          ds = dpp_add<0xB1>(ds); ds = dpp_add<0x4E>(ds); ds = dpp_add<0x141>(ds);
          if (part == 0) { const float den = ds + gin[t] * qn[t]; rden[t] = 1.0f / fmaxf(fabsf(den), 1.0f); } }
#pragma unroll
        for (int x = 0; x < 2; ++x) { const int ti = c.wv * 2 + x, tm = ti >> 2, tn = ti & 3;
#pragma unroll
            for (int jj = 0; jj < 4; ++jj) Ia[x][jj] *= gin[tm * 16 + quad * 4 + jj];
#pragma unroll
            for (int kk = 0; kk < 2; ++kk) { const bf16x8 a = *(const LAS bf16x8*)(Sp + (tm * 16 + l15) * 72 + kk * 32 + quad * 8);
                const bf16x8 bb = *(const LAS bf16x8*)(VTs + (tn * 16 + l15) * 72 + kk * 32 + quad * 8); Ia[x] = mfma16(a, bb, Ia[x]); } }
        lds_barrier();
#pragma unroll
        for (int x = 0; x < 2; ++x) { const int ti = c.wv * 2 + x, tm = ti >> 2, tn = ti & 3;
#pragma unroll
            for (int jj = 0; jj < 4; ++jj) { const int t = tm * 16 + quad * 4 + jj; HR[(row0 + t) * DMIX + h * 384 + sl * 64 + tn * 16 + l15] = f2bf(Ia[x][jj] * rden[t]); } }
        if (c.tid < 384) nold[c.tid] = nnew[c.tid];
    }
    lds_barrier();
    if (!save) return;
#pragma unroll
    for (int j = 0; j < 12; ++j)
#pragma unroll
        for (int jj = 0; jj < 4; ++jj) CST[(size_t)(e16 * 16 + quadc * 4 + jj) * 384 + (2 * j + par) * 16 + l15c] = C[j][jj];
    if (c.tid < 384) NST[c.tid] = nold[c.tid];
}

__device__ __forceinline__ void phase_a3(const P& p, const Ctx& c, int seg) {
    const bf16_t* P0 = (const bf16_t*)(c.seg + S0_P0); const bf16_t* HR = (const bf16_t*)(c.seg + S0_HRAW); const bf16_t* XC = (const bf16_t*)(c.seg + S0_XC);
    const bf16_t* YM = (const bf16_t*)(c.seg + S0_YMEM); bf16_t* Y = (bf16_t*)(c.seg + S0_Y); bf16_t* UT = (bf16_t*)(p.ws + OFF_UTAIL);
#pragma unroll 1
    for (int r = c.bid * 8 + c.wv; r < MS; r += c.G * 8) {
        const int b = r >> 9, tl = r & 511;
        float v[3][8]; float mean[3], rstd[3];
#pragma unroll
        for (int ps = 0; ps < 3; ++ps) { const int ch = ps * 512 + c.lane * 8;
            const u32x4 hr = *(const u32x4*)(HR + (size_t)r * DMIX + ch);
            v[ps][0] = bflo(hr.x); v[ps][1] = bfhi(hr.x); v[ps][2] = bflo(hr.y); v[ps][3] = bfhi(hr.y); v[ps][4] = bflo(hr.z); v[ps][5] = bfhi(hr.z); v[ps][6] = bflo(hr.w); v[ps][7] = bfhi(hr.w); }
        float hs[4], hq[4];
#pragma unroll
        for (int hd = 0; hd < 4; ++hd) { float s = 0.f, q = 0.f;
#pragma unroll
            for (int ps = 0; ps < 3; ++ps) { if (ps * 512 + 511 < hd * 384 || ps * 512 >= (hd + 1) * 384) continue;
                const bool mine = ((ps * 512 + c.lane * 8) / 384) == hd;
                float ls = 0.f, lq = 0.f;
#pragma unroll
                for (int j = 0; j < 8; ++j) { ls += v[ps][j]; lq += v[ps][j] * v[ps][j]; }
                s += mine ? ls : 0.f; q += mine ? lq : 0.f; }
            hs[hd] = wsum(s); hq[hd] = wsum(q); }
#pragma unroll
        for (int ps = 0; ps < 3; ++ps) { const int hd = (ps * 512 + c.lane * 8) / 384;
            const float s = hd == 0 ? hs[0] : (hd == 1 ? hs[1] : (hd == 2 ? hs[2] : hs[3])), q = hd == 0 ? hq[0] : (hd == 1 ? hq[1] : (hd == 2 ? hq[2] : hq[3]));
            const float m = s * (1.0f / 384.0f); mean[ps] = m; rstd[ps] = rsqrtf(fmaxf(q * (1.0f / 384.0f) - m * m, 0.f) + 1e-5f); }
#pragma unroll
        for (int ps = 0; ps < 3; ++ps) { const int ch = ps * 512 + c.lane * 8;
            const u32x4 xr = *(const u32x4*)(XC + (size_t)r * DMIX + ch), zr = *(const u32x4*)(P0 + (size_t)r * ML_W + 2048 + ch);
            const f32x4 g0 = *(const f32x4*)(p.ml_mhn_g + ch), g1 = *(const f32x4*)(p.ml_mhn_g + ch + 4), k0 = *(const f32x4*)(p.ml_skip + ch), k1 = *(const f32x4*)(p.ml_skip + ch + 4);
            const float xx[8] = {bflo(xr.x), bfhi(xr.x), bflo(xr.y), bfhi(xr.y), bflo(xr.z), bfhi(xr.z), bflo(xr.w), bfhi(xr.w)};
            const float zz[8] = {bflo(zr.x), bfhi(zr.x), bflo(zr.y), bfhi(zr.y), bflo(zr.z), bfhi(zr.z), bflo(zr.w), bfhi(zr.w)};
            const float gg[8] = {g0[0], g0[1], g0[2], g0[3], g1[0], g1[1], g1[2], g1[3]}, kk[8] = {k0[0], k0[1], k0[2], k0[3], k1[0], k1[1], k1[2], k1[3]};
            float y[8];
#pragma unroll
            for (int j = 0; j < 8; ++j) y[j] = ((v[ps][j] - mean[ps]) * rstd[ps] * gg[j] + kk[j] * xx[j]) * siluf_(zz[j]);
            *(u32x4*)(Y + (size_t)r * DIN + ch) = (u32x4){pk2(y[0], y[1]), pk2(y[2], y[3]), pk2(y[4], y[5]), pk2(y[6], y[7])}; }
        { const int cm = c.lane * 8; const u32x4 mr = *(const u32x4*)(YM + (size_t)r * DX + cm), zr = *(const u32x4*)(P0 + (size_t)r * ML_W + 2048 + DMIX + cm);
          const float mm[8] = {bflo(mr.x), bfhi(mr.x), bflo(mr.y), bfhi(mr.y), bflo(mr.z), bfhi(mr.z), bflo(mr.w), bfhi(mr.w)};
          const float zz[8] = {bflo(zr.x), bfhi(zr.x), bflo(zr.y), bfhi(zr.y), bflo(zr.z), bfhi(zr.z), bflo(zr.w), bfhi(zr.w)};
          float y[8];
#pragma unroll
          for (int j = 0; j < 8; ++j) y[j] = mm[j] * siluf_(zz[j]);
          *(u32x4*)(Y + (size_t)r * DIN + DMIX + cm) = (u32x4){pk2(y[0], y[1]), pk2(y[2], y[3]), pk2(y[4], y[5]), pk2(y[6], y[7])}; }
        if (tl >= 509) {
#pragma unroll
            for (int ps = 0; ps < 3; ++ps) { const int ch = ps * 512 + c.lane * 8; *(u32x4*)(UT + (size_t)(b * 3 + tl - 509) * DMIX + ch) = *(const u32x4*)(P0 + (size_t)r * ML_W + ch); } }
    }
}

__device__ __forceinline__ void phase_b1(const P& p, const Ctx& c, int seg) {
    const bf16_t* P1 = (const bf16_t*)(c.seg + S1_P1);
    float* GTB = (float*)(c.seg + S1_W); bf16_t* SA = (bf16_t*)(c.seg + S1_A); bf16_t* SB = (bf16_t*)(c.seg + S1_B); bf16_t* SK = (bf16_t*)(c.seg + S1_K);
    bf16_t* SQ = (bf16_t*)(c.seg + S1_Q); bf16_t* SV = (bf16_t*)(c.seg + S1_V); bf16_t* SG = (bf16_t*)(c.seg + S1_G); float* BRKR = (float*)(c.seg + S1_BRKR);
    const bf16_t* VF = (const bf16_t*)(p.ws + OFF_VF); const bf16_t* LT = (const bf16_t*)(p.ws + OFF_LORAT);
    const bf16_t* PTr = (const bf16_t*)(p.ws + OFF_PTAIL) + (size_t)(seg & 1) * NB * RW_SHIFT; bf16_t* PTw = (bf16_t*)(p.ws + OFF_PTAIL) + (size_t)((seg + 1) & 1) * NB * RW_SHIFT;
    LAS bf16_t* XA = (LAS bf16_t*)c.lds;
    const int l15 = c.lane & 15, quad = c.lane >> 4;
    for (int it = c.bid; it < MS / 16; it += c.G) {
        const int r0 = it * 16, b = r0 >> 9, tl0 = r0 & 511;
        __syncthreads();
        for (int e = c.tid; e < 16 * 288; e += 512) { const int row = e / 288, cc = e % 288, col = 4608 + cc;
            const float cur = bf2f(P1[(size_t)(r0 + row) * P1W + col]);
            float prev = 0.f; if (tl0 + row > 0) prev = bf2f(P1[(size_t)(r0 + row - 1) * P1W + col]); else if (seg > 0) prev = bf2f(PTr[(size_t)b * RW_SHIFT + col]);
            const float pv = cur + p.rw_mu[col] * (prev - cur);
            const float f = cc < 64 ? (1.0f - 2.0f / (1.0f + __expf(2.0f * pv)))   : (cc < 160 ? pv : sigmoidf_(pv));
            XA[row * 296 + cc] = f2bf(f); }
        __syncthreads();
        const size_t row = (size_t)r0 + l15; const int tl = tl0 + l15;
        const bf16_t* curp = P1 + row * P1W; const bf16_t* prevp = (tl > 0) ? (P1 + (row - 1) * P1W) : (PTr + (size_t)b * RW_SHIFT); const bool hasprev = (tl > 0) || (seg > 0);
        struct TileIn { u32x4 cr, ck, cv, pr, pk, pv, vf; };
        struct TilePar { f32x4 m0, m1, m2, w0, a0, v0, kkw, kaw, rk; };
#pragma unroll 1
        for (int x = 0; x < 3; ++x) {
            int hh = c.wv * 3 + x; asm volatile("" : "+s"(hh));
            auto load_tile = [&](int ct, TileIn& T) { const int cc = hh * 64 + (ct >> 1) * 32 + quad * 8;
                T.cr = *(const u32x4*)(curp + cc); T.ck = *(const u32x4*)(curp + DMIX + cc); T.cv = *(const u32x4*)(curp + 2 * DMIX + cc);
                T.pr = (u32x4){0u, 0u, 0u, 0u}; T.pk = T.pr; T.pv = T.pr;
                if (hasprev) { T.pr = *(const u32x4*)(prevp + cc); T.pk = *(const u32x4*)(prevp + DMIX + cc); T.pv = *(const u32x4*)(prevp + 2 * DMIX + cc); }
                T.vf = *(const u32x4*)(VF + row * DMIX + cc); };
            TileIn TA;
            load_tile(0, TA);
            float inv;
            { u32x2 kcur[4], kprv[4]; f32x4 km[4], kw[4];
#pragma unroll
              for (int ct = 0; ct < 4; ++ct) { const int cc = hh * 64 + (ct >> 1) * 32 + quad * 8 + 4 * (ct & 1);
                  kcur[ct] = *(const u32x2*)(curp + DMIX + cc); kprv[ct] = (u32x2){0u, 0u}; if (hasprev) kprv[ct] = *(const u32x2*)(prevp + DMIX + cc);
                  km[ct] = *(const f32x4*)(p.rw_mu + DMIX + cc); kw[ct] = *(const f32x4*)(p.rw_k_k + cc); }
              float ss = 0.f;
#pragma unroll
              for (int ct = 0; ct < 4; ++ct) {
                  const float cb[4] = {bflo(kcur[ct].x), bfhi(kcur[ct].x), bflo(kcur[ct].y), bfhi(kcur[ct].y)}, qb[4] = {bflo(kprv[ct].x), bfhi(kprv[ct].x), bflo(kprv[ct].y), bfhi(kprv[ct].y)};
#pragma unroll
                  for (int j = 0; j < 4; ++j) { const float kr = (cb[j] + km[ct][j] * (qb[j] - cb[j])) * kw[ct][j]; ss += kr * kr; } }
              ss += __shfl_xor(ss, 16); ss += __shfl_xor(ss, 32);
              inv = 1.0f / fmaxf(sqrtf(ss), 1e-12f); }
            float br = 0.f, kr = 0.f, rkr = 0.f;
            u32x2 st_g, st_a, st_b, st_k, st_q, st_v;
            auto do_tile = [&](int ct, const TileIn& TI) { const int cc = hh * 64 + (ct >> 1) * 32 + quad * 8 + 4 * (ct & 1);
                TilePar T; T.m0 = *(const f32x4*)(p.rw_mu + cc); T.m1 = *(const f32x4*)(p.rw_mu + DMIX + cc); T.m2 = *(const f32x4*)(p.rw_mu + 2 * DMIX + cc);
                T.w0 = *(const f32x4*)(p.rw_w0 + cc); T.a0 = *(const f32x4*)(p.rw_a0 + cc); T.v0 = *(const f32x4*)(p.rw_v0 + cc); T.kkw = *(const f32x4*)(p.rw_k_k + cc); T.kaw = *(const f32x4*)(p.rw_k_a + cc);
                T.rk = *(const f32x4*)(p.rw_r_k + cc);
                bf16x8 lt[9]; { const bf16_t* lrow = LT + (size_t)(hh * 64 + (ct >> 1) * 32 + 8 * (l15 >> 2) + 4 * (ct & 1) + (l15 & 3)) * 288 + quad * 8;
#pragma unroll
                    for (int k = 0; k < 9; ++k) lt[k] = *(const bf16x8*)(lrow + k * 32); }
                bf16x8 xf[9];
#pragma unroll
                for (int k = 0; k < 9; ++k) xf[k] = *(const LAS bf16x8*)(XA + l15 * 296 + k * 32 + quad * 8);
                f32x4 dw = (f32x4){0.f, 0.f, 0.f, 0.f}, da = dw, dv = dw, dg = dw;
#pragma unroll
                for (int k = 0; k < 2; ++k) dw = mfma16(lt[k], xf[k], dw);
#pragma unroll
                for (int k = 0; k < 2; ++k) da = mfma16(lt[2 + k], xf[2 + k], da);
                dv = mfma16(lt[4], xf[4], dv);
#pragma unroll
                for (int k = 0; k < 4; ++k) dg = mfma16(lt[5 + k], xf[5 + k], dg);
                const bool od = (ct & 1) != 0;
                const unsigned r0 = od ? TI.cr.z : TI.cr.x, r1 = od ? TI.cr.w : TI.cr.y, k0 = od ? TI.ck.z : TI.ck.x, k1 = od ? TI.ck.w : TI.ck.y, c0 = od ? TI.cv.z : TI.cv.x, c1 = od ? TI.cv.w : TI.cv.y;
                const unsigned p0 = od ? TI.pr.z : TI.pr.x, p1 = od ? TI.pr.w : TI.pr.y, q0 = od ? TI.pk.z : TI.pk.x, q1 = od ? TI.pk.w : TI.pk.y, d0 = od ? TI.pv.z : TI.pv.x, d1 = od ? TI.pv.w : TI.pv.y;
                const unsigned f0 = od ? TI.vf.z : TI.vf.x, f1 = od ? TI.vf.w : TI.vf.y;
                const float ca[4] = {bflo(r0), bfhi(r0), bflo(r1), bfhi(r1)}, cb[4] = {bflo(k0), bfhi(k0), bflo(k1), bfhi(k1)}, cd[4] = {bflo(c0), bfhi(c0), bflo(c1), bfhi(c1)};
                const float qa[4] = {bflo(p0), bfhi(p0), bflo(p1), bfhi(p1)}, qb[4] = {bflo(q0), bfhi(q0), bflo(q1), bfhi(q1)}, qd[4] = {bflo(d0), bfhi(d0), bflo(d1), bfhi(d1)};
                const float vf[4] = {bflo(f0), bfhi(f0), bflo(f1), bfhi(f1)};
                u32x2 gw; gw.x = pk2(dg[0], dg[1]); gw.y = pk2(dg[2], dg[3]);
                float wv4[4], av[4], bv[4], ktv[4], qv[4], vv[4];
#pragma unroll
                for (int j = 0; j < 4; ++j) {
                    const float rc = ca[j] + T.m0[j] * (qa[j] - ca[j]), kc = cb[j] + T.m1[j] * (qb[j] - cb[j]), vc = cd[j] + T.m2[j] * (qd[j] - cd[j]);
                    const float zz = -(T.w0[j] + dw[j]); const float sp = fmaxf(zz, 0.f) + __logf(1.0f + __expf(-fabsf(zz)));
                    wv4[j] = __expf(-__expf(-sp - 0.5f));
                    const float a = sigmoidf_(T.a0[j] + da[j]);
                    vv[j] = vc + (vf[j] - vc) * sigmoidf_(T.v0[j] + dv[j]);
                    const float kk = kc * T.kkw[j] * inv; av[j] = -kk; bv[j] = kk * a;
                    ktv[j] = kc * (1.0f + (a - 1.0f) * T.kaw[j]); qv[j] = rc;
                    br += bv[j] * rc; kr += ktv[j] * rc; rkr += rc * ktv[j] * T.rk[j]; }
                float gfin[4];
#pragma unroll
                for (int j = 0; j < 4; ++j) { float g = wv4[j];
                    g *= dpp_shr_or1<1>(g); g *= dpp_shr_or1<2>(g); g *= dpp_shr_or1<4>(g); g *= dpp_shr_or1<8>(g);
                    const float gp = dpp_shr_or1<1>(g), ig = 1.0f / g;
                    av[j] *= gp; qv[j] *= g; bv[j] *= ig; ktv[j] *= ig; gfin[j] = g; }
                if (l15 == 15) *(f32x4*)(GTB + ((size_t)it * 24 + hh) * 64 + (cc - hh * 64)) = (f32x4){gfin[0], gfin[1], gfin[2], gfin[3]};
                const u32x2 ta = (u32x2){pk2(av[0], av[1]), pk2(av[2], av[3])}, tb = (u32x2){pk2(bv[0], bv[1]), pk2(bv[2], bv[3])}, tk = (u32x2){pk2(ktv[0], ktv[1]), pk2(ktv[2], ktv[3])};
                const u32x2 tq = (u32x2){pk2(qv[0], qv[1]), pk2(qv[2], qv[3])}, tv = (u32x2){pk2(vv[0], vv[1]), pk2(vv[2], vv[3])};
                if ((ct & 1) == 0) { st_g = gw; st_a = ta; st_b = tb; st_k = tk; st_q = tq; st_v = tv; }
                else { const size_t o8 = row * DMIX + cc - 4;
                    *(u32x4*)(SG + o8) = (u32x4){st_g.x, st_g.y, gw.x, gw.y}; *(u32x4*)(SA + o8) = (u32x4){st_a.x, st_a.y, ta.x, ta.y}; *(u32x4*)(SB + o8) = (u32x4){st_b.x, st_b.y, tb.x, tb.y};
                    *(u32x4*)(SK + o8) = (u32x4){st_k.x, st_k.y, tk.x, tk.y}; *(u32x4*)(SQ + o8) = (u32x4){st_q.x, st_q.y, tq.x, tq.y}; *(u32x4*)(SV + o8) = (u32x4){st_v.x, st_v.y, tv.x, tv.y}; } };
            do_tile(0, TA); __builtin_amdgcn_sched_barrier(0);
            do_tile(1, TA); __builtin_amdgcn_sched_barrier(0);
            load_tile(2, TA); do_tile(2, TA); __builtin_amdgcn_sched_barrier(0);
            do_tile(3, TA);
            br += __shfl_xor(br, 16); br += __shfl_xor(br, 32); kr += __shfl_xor(kr, 16); kr += __shfl_xor(kr, 32); rkr += __shfl_xor(rkr, 16); rkr += __shfl_xor(rkr, 32);
            if (quad == 0) *(f32x4*)(BRKR + (row * 24 + hh) * 4) = (f32x4){br, kr, rkr, 0.f};
        }
        if (tl0 == 496) { for (int e = c.tid; e < RW_SHIFT; e += 512) PTw[(size_t)b * RW_SHIFT + e] = P1[(size_t)(r0 + 15) * P1W + e]; }
    }
}

__device__ __forceinline__ void rwkv_item(const P& p, const Ctx& c, int seg, int w, bool save) {
    const int b = w / 24, hh = w % 24;
    const float* SW = (const float*)(c.seg + S1_W); const bf16_t* SA = (const bf16_t*)(c.seg + S1_A); const bf16_t* SB = (const bf16_t*)(c.seg + S1_B); const bf16_t* SK = (const bf16_t*)(c.seg + S1_K);
    const bf16_t* SQ = (const bf16_t*)(c.seg + S1_Q); const bf16_t* SV = (const bf16_t*)(c.seg + S1_V); const float* BRKR = (const float*)(c.seg + S1_BRKR);
    float* O = (float*)(c.seg + S1_O); float* RST = (float*)(p.ws + OFF_RST) + (size_t)w * 4096;
    constexpr int TB = 32, REC = 388;
    LAS float* L0 = (LAS float*)c.lds;
    const int rp = c.wv * 4 + (c.lane >> 4), cq = c.lane & 15;
    f32x2 S0a, S0b, S1a, S1b;
    if (seg > 0) { const f32x4 s0 = *(const f32x4*)(RST + (2 * rp) * 64 + cq * 4), s1 = *(const f32x4*)(RST + (2 * rp + 1) * 64 + cq * 4);
        S0a = (f32x2){s0[0], s0[1]}; S0b = (f32x2){s0[2], s0[3]}; S1a = (f32x2){s1[0], s1[1]}; S1b = (f32x2){s1[2], s1[3]}; }
    else { S0a = S0b = S1a = S1b = (f32x2){0.f, 0.f}; }
    const int e4 = c.tid * 4, stt = e4 >> 6, scc = e4 & 63;
    f32x4 gw; u32x2 ga, gb, gk, gq, gv; f32x4 gbr;
    auto gload = [&](int blk) { const size_t go = ((size_t)b * SEGT + blk * TB + stt) * DMIX + hh * 64 + scc;
        gw = *(const f32x4*)(SW + go); ga = *(const u32x2*)(SA + go); gb = *(const u32x2*)(SB + go); gk = *(const u32x2*)(SK + go); gq = *(const u32x2*)(SQ + go); gv = *(const u32x2*)(SV + go);
        if (c.tid < TB) gbr = *(const f32x4*)(BRKR + (((size_t)b * SEGT + blk * TB + c.tid) * 24 + hh) * 4); };
    auto lstore = [&](int buf) { LAS float* r = L0 + buf * (TB * REC) + stt * REC + scc;
        *(LAS f32x4*)(r) = gw; *(LAS f32x4*)(r + 64) = (f32x4){bflo(ga.x), bfhi(ga.x), bflo(ga.y), bfhi(ga.y)}; *(LAS f32x4*)(r + 128) = (f32x4){bflo(gb.x), bfhi(gb.x), bflo(gb.y), bfhi(gb.y)};
        *(LAS f32x4*)(r + 192) = (f32x4){bflo(gk.x), bfhi(gk.x), bflo(gk.y), bfhi(gk.y)}; *(LAS f32x4*)(r + 256) = (f32x4){bflo(gq.x), bfhi(gq.x), bflo(gq.y), bfhi(gq.y)};
        *(LAS f32x4*)(r + 320) = (f32x4){bflo(gv.x), bfhi(gv.x), bflo(gv.y), bfhi(gv.y)};
        if (c.tid < TB) { LAS float* q = L0 + buf * (TB * REC) + c.tid * REC + 384; *(LAS f32x2*)q = (f32x2){gbr[0], gbr[1]}; } };
    __syncthreads();
    gload(0); lstore(0);
    __syncthreads();
#pragma unroll 1
    for (int blk = 0; blk < SEGT / TB; ++blk) {
        const int buf = blk & 1;
        if (blk + 1 < SEGT / TB) gload(blk + 1);
        const LAS float* base = L0 + buf * (TB * REC);
        const size_t rowb = (size_t)b * SEGT + blk * TB;
        f32x4 nw4 = *(const LAS f32x4*)(base + cq * 4), na4 = *(const LAS f32x4*)(base + 64 + cq * 4), nb4 = *(const LAS f32x4*)(base + 128 + cq * 4), nk4 = *(const LAS f32x4*)(base + 192 + cq * 4), nq4 = *(const LAS f32x4*)(base + 256 + cq * 4);
        f32x2 nv2 = *(const LAS f32x2*)(base + 320 + 2 * rp), nbk = *(const LAS f32x2*)(base + 384);
#pragma unroll 2
        for (int tt = 0; tt < TB; ++tt) {
            const f32x4 w4 = nw4, a4 = na4, b4 = nb4, k4 = nk4, q4 = nq4; const f32x2 v2 = nv2, bk = nbk;
            { const LAS float* r = base + (tt + 1 < TB ? tt + 1 : tt) * REC;
              nw4 = *(const LAS f32x4*)(r + cq * 4); na4 = *(const LAS f32x4*)(r + 64 + cq * 4); nb4 = *(const LAS f32x4*)(r + 128 + cq * 4); nk4 = *(const LAS f32x4*)(r + 192 + cq * 4); nq4 = *(const LAS f32x4*)(r + 256 + cq * 4);
              nv2 = *(const LAS f32x2*)(r + 320 + 2 * rp); nbk = *(const LAS f32x2*)(r + 384); }
            const f32x2 wa = (f32x2){w4[0], w4[1]}, wb = (f32x2){w4[2], w4[3]}, aa = (f32x2){a4[0], a4[1]}, ab = (f32x2){a4[2], a4[3]}, ba = (f32x2){b4[0], b4[1]}, bb = (f32x2){b4[2], b4[3]};
            const f32x2 ka = (f32x2){k4[0], k4[1]}, kb = (f32x2){k4[2], k4[3]}, qa = (f32x2){q4[0], q4[1]}, qb = (f32x2){q4[2], q4[3]};
            f32x2 t0 = S0a * aa + S0b * ab, t1 = S0a * qa + S0b * qb, t2 = S1a * aa + S1b * ab, t3 = S1a * qa + S1b * qb;
            float pa0 = t0.x + t0.y, pt0 = t1.x + t1.y, pa1 = t2.x + t2.y, pt1 = t3.x + t3.y;
            row16_allsum4(pa0, pa1, pt0, pt1);
            const f32x2 pa0v = (f32x2){pa0, pa0}, pa1v = (f32x2){pa1, pa1}, v0v = (f32x2){v2.x, v2.x}, v1v = (f32x2){v2.y, v2.y};
            S0a = S0a * wa + pa0v * ba + v0v * ka; S0b = S0b * wb + pa0v * bb + v0v * kb;
            S1a = S1a * wa + pa1v * ba + v1v * ka; S1b = S1b * wb + pa1v * bb + v1v * kb;
            if (cq == 0) { const f32x2 y = (f32x2){pt0 + pa0 * bk.x + v2.x * bk.y, pt1 + pa1 * bk.x + v2.y * bk.y};
                *(f32x2*)(O + (rowb + tt) * DMIX + hh * 64 + 2 * rp) = y; }
        }
        if (blk + 1 < SEGT / TB) lstore(buf ^ 1);
        __syncthreads();
    }
    if (!save) return;
    *(f32x4*)(RST + (2 * rp) * 64 + cq * 4) = (f32x4){S0a.x, S0a.y, S0b.x, S0b.y}; *(f32x4*)(RST + (2 * rp + 1) * 64 + cq * 4) = (f32x4){S1a.x, S1a.y, S1b.x, S1b.y};
}

__device__ __forceinline__ void rwkv_chunk_item(const P& p, const Ctx& c, int seg, int w, bool save) {
    const int b = w / 24, hh = w % 24;
    const bf16_t* SA = (const bf16_t*)(c.seg + S1_A); const bf16_t* SB = (const bf16_t*)(c.seg + S1_B); const bf16_t* SK = (const bf16_t*)(c.seg + S1_K);
    const bf16_t* SR = (const bf16_t*)(c.seg + S1_Q); const bf16_t* SV = (const bf16_t*)(c.seg + S1_V); const float* GTB = (const float*)(c.seg + S1_W);
    bf16_t* O = (bf16_t*)(c.seg + S1_O); float* RST = (float*)(p.ws + OFF_RST) + (size_t)w * 4096;
    constexpr int O_EA = 0  , O_EB = 4608  , O_EBT = 9216  , O_UV = 14336  ,
                  O_MT1 = 19456  , O_NT = 20736  , O_MABT = 22016  ,
                  O_GT = 23296  , OPB = 23552;
    LAS unsigned char* OB = c.lds;
    LAS bf16_t* S0I = (LAS bf16_t*)(c.lds + 2 * OPB);
    LAS float* XF = (LAS float*)(c.lds + 2 * OPB + 9216);
    const int l15c = c.lane & 15, quadc = c.lane >> 4;
    f32x4 S[2];
#pragma unroll
    for (int x = 0; x < 2; ++x) { const int ti = c.wv * 2 + x, mt = ti >> 2, nt = ti & 3;
#pragma unroll
        for (int jj = 0; jj < 4; ++jj) S[x][jj] = (seg > 0) ? RST[(mt * 16 + quadc * 4 + jj) * 64 + nt * 16 + l15c] : 0.f; }
    unsigned ga = 0, gb = 0, gk = 0, gr = 0, gv = 0; float gg = 1.f;
    auto gload = [&](int ch, int tidv) { const int t = tidv >> 5, j0 = (tidv & 31) * 2; const size_t go = ((size_t)b * SEGT + ch * 16 + t) * DMIX + hh * 64 + j0;
        ga = *(const unsigned*)(SA + go); gb = *(const unsigned*)(SB + go); gk = *(const unsigned*)(SK + go); gr = *(const unsigned*)(SR + go); gv = *(const unsigned*)(SV + go);
        if (tidv < 64) gg = GTB[((size_t)(b * 32 + ch) * 24 + hh) * 64 + tidv]; };
    auto lstore = [&](int pb, int tidv) { const int t = tidv >> 5, j0 = (tidv & 31) * 2;
        LAS bf16_t* EA = (LAS bf16_t*)(OB + pb * OPB + O_EA); LAS bf16_t* EB = (LAS bf16_t*)(OB + pb * OPB + O_EB); LAS bf16_t* EBT = (LAS bf16_t*)(OB + pb * OPB + O_EBT);
        LAS bf16_t* UV = (LAS bf16_t*)(OB + pb * OPB + O_UV); LAS float* GT = (LAS float*)(OB + pb * OPB + O_GT);
        *(LAS unsigned*)(EA + t * 72 + j0) = ga; *(LAS unsigned*)(EA + (16 + t) * 72 + j0) = gr;
        *(LAS unsigned*)(EB + t * 72 + j0) = gb; *(LAS unsigned*)(EB + (16 + t) * 72 + j0) = gk;
        EBT[j0 * 40 + t] = (bf16_t)(gb & 0xFFFFu); EBT[(j0 + 1) * 40 + t] = (bf16_t)(gb >> 16); EBT[j0 * 40 + 16 + t] = (bf16_t)(gk & 0xFFFFu); EBT[(j0 + 1) * 40 + 16 + t] = (bf16_t)(gk >> 16);
        UV[j0 * 40 + 16 + t] = (bf16_t)(gv & 0xFFFFu); UV[(j0 + 1) * 40 + 16 + t] = (bf16_t)(gv >> 16); UV[j0 * 40 + t] = 0; UV[(j0 + 1) * 40 + t] = 0;
        if (tidv < 64) GT[tidv] = gg; };
    auto gtile = [&](int pb, int l15, int quad) {
        LAS bf16_t* EA = (LAS bf16_t*)(OB + pb * OPB + O_EA); LAS bf16_t* EB = (LAS bf16_t*)(OB + pb * OPB + O_EB);
        LAS bf16_t* MT1 = (LAS bf16_t*)(OB + pb * OPB + O_MT1); LAS bf16_t* NT = (LAS bf16_t*)(OB + pb * OPB + O_NT); LAS float* MABT = (LAS float*)(OB + pb * OPB + O_MABT);
        const int sb = c.wv >> 1, tb = c.wv & 1; f32x4 g = (f32x4){0.f, 0.f, 0.f, 0.f};
#pragma unroll
        for (int kk = 0; kk < 2; ++kk) g = mfma16(*(const LAS bf16x8*)(EB + (sb * 16 + l15) * 72 + kk * 32 + quad * 8), *(const LAS bf16x8*)(EA + (tb * 16 + l15) * 72 + kk * 32 + quad * 8), g);
#pragma unroll
        for (int jj = 0; jj < 4; ++jj) { const int s2 = quad * 4 + jj, tt = l15; const float v = g[jj];
            if (tb == 0) { const float m = (s2 < tt) ? v : 0.f; if (sb == 0) { MABT[tt * 20 + s2] = m; MT1[tt * 40 + s2] = 0; } else MT1[tt * 40 + 16 + s2] = f2bf(m); }
            else { const float m = (s2 <= tt) ? v : 0.f; NT[tt * 40 + sb * 16 + s2] = f2bf(m); } } };
    auto simg = [&](int l15, int quad) {
#pragma unroll
        for (int x = 0; x < 2; ++x) { const int ti = c.wv * 2 + x, mt = ti >> 2, nt = ti & 3;
#pragma unroll
            for (int jj = 0; jj < 4; ++jj) S0I[(mt * 16 + quad * 4 + jj) * 72 + nt * 16 + l15] = f2bf(S[x][jj]); } };
    __syncthreads();
    { int t0 = c.tid; asm volatile("" : "+v"(t0)); gload(0, t0); lstore(0, t0); simg(l15c, quadc); }
    lds_barrier();
    if (c.wv < 4) gtile(0, l15c, quadc);
    { int t1 = c.tid; asm volatile("" : "+v"(t1)); gload(1, t1); }
    const int mtq = c.wv & 3;
#pragma unroll 1
    for (int ch = 0; ch < SEGT / 16; ++ch) {
        const int pb = ch & 1;
        int tidv = c.tid, l15 = l15c, quad = quadc; asm volatile("" : "+v"(tidv), "+v"(l15), "+v"(quad));
        LAS bf16_t* EA = (LAS bf16_t*)(OB + pb * OPB + O_EA); LAS bf16_t* EBT = (LAS bf16_t*)(OB + pb * OPB + O_EBT); LAS bf16_t* UV = (LAS bf16_t*)(OB + pb * OPB + O_UV);
        LAS bf16_t* MT1 = (LAS bf16_t*)(OB + pb * OPB + O_MT1); LAS bf16_t* NT = (LAS bf16_t*)(OB + pb * OPB + O_NT); LAS float* MABT = (LAS float*)(OB + pb * OPB + O_MABT); LAS float* GT = (LAS float*)(OB + pb * OPB + O_GT);
        lds_barrier();
        f32x4 Zt = (f32x4){0.f, 0.f, 0.f, 0.f};
        if (c.wv >= 4) {
            f32x4 Xt = (f32x4){0.f, 0.f, 0.f, 0.f};
#pragma unroll
            for (int kk = 0; kk < 2; ++kk) { const bf16x8 a = *(const LAS bf16x8*)(S0I + (mtq * 16 + l15) * 72 + kk * 32 + quad * 8);
                Xt = mfma16(a, *(const LAS bf16x8*)(EA + l15 * 72 + kk * 32 + quad * 8), Xt); Zt = mfma16(a, *(const LAS bf16x8*)(EA + (16 + l15) * 72 + kk * 32 + quad * 8), Zt); }
            Xt = mfma16(*(const LAS bf16x8*)(UV + (mtq * 16 + l15) * 40 + quad * 8), *(const LAS bf16x8*)(MT1 + l15 * 40 + quad * 8), Xt);
#pragma unroll
            for (int jj = 0; jj < 4; ++jj) XF[(mtq * 16 + quad * 4 + jj) * 17 + l15] = Xt[jj];
        }
        lds_barrier();
        if (ch + 1 < SEGT / 16) lstore(pb ^ 1, tidv);
        if (ch + 2 < SEGT / 16) gload(ch + 2, tidv);
        if (c.wv == 0) {
            float u[16];
#pragma unroll
            for (int tt = 0; tt < 16; ++tt) { float acc = XF[c.lane * 17 + tt];
#pragma unroll
                for (int s4 = 0; s4 < (tt + 3) / 4; ++s4) { const f32x4 m = *(const LAS f32x4*)(MABT + tt * 20 + s4 * 4);
#pragma unroll
                    for (int e = 0; e < 4; ++e) if (s4 * 4 + e < tt) acc += u[s4 * 4 + e] * m[e]; }
                u[tt] = acc; }
            *(LAS u32x4*)(UV + c.lane * 40) = (u32x4){pk2(u[0], u[1]), pk2(u[2], u[3]), pk2(u[4], u[5]), pk2(u[6], u[7])};
            *(LAS u32x4*)(UV + c.lane * 40 + 8) = (u32x4){pk2(u[8], u[9]), pk2(u[10], u[11]), pk2(u[12], u[13]), pk2(u[14], u[15])};
        }
        lds_barrier();
        if (c.wv >= 4) {
            Zt = mfma16(*(const LAS bf16x8*)(UV + (mtq * 16 + l15) * 40 + quad * 8), *(const LAS bf16x8*)(NT + l15 * 40 + quad * 8), Zt);
            *(u32x2*)(O + ((size_t)b * SEGT + ch * 16 + l15) * DMIX + hh * 64 + mtq * 16 + quad * 4) = (u32x2){pk2(Zt[0], Zt[1]), pk2(Zt[2], Zt[3])};
        }
#pragma unroll
        for (int x = 0; x < 2; ++x) { const int ti = c.wv * 2 + x, mt = ti >> 2, nt = ti & 3;
            S[x] = mfma16(*(const LAS bf16x8*)(UV + (mt * 16 + l15) * 40 + quad * 8), *(const LAS bf16x8*)(EBT + (nt * 16 + l15) * 40 + quad * 8), S[x]);
            const float gt = GT[nt * 16 + l15];
#pragma unroll
            for (int jj = 0; jj < 4; ++jj) S[x][jj] *= gt; }
        simg(l15, quad);
        if (c.wv < 4 && ch + 1 < SEGT / 16) gtile(pb ^ 1, l15, quad);
    }
    if (!save) return;
#pragma unroll
    for (int x = 0; x < 2; ++x) { const int ti = c.wv * 2 + x, mt = ti >> 2, nt = ti & 3;
#pragma unroll
        for (int jj = 0; jj < 4; ++jj) RST[(mt * 16 + quadc * 4 + jj) * 64 + nt * 16 + l15c] = S[x][jj]; }
}

__device__ __forceinline__ void phase_b3(const P& p, const Ctx& c) {
    const bf16_t* O = (const bf16_t*)(c.seg + S1_O); const bf16_t* P2 = (const bf16_t*)(c.seg + S1_P2); const bf16_t* SV = (const bf16_t*)(c.seg + S1_V); const bf16_t* SG = (const bf16_t*)(c.seg + S1_G);
    const float* BRKR = (const float*)(c.seg + S1_BRKR); const bf16_t* YM = (const bf16_t*)(c.seg + S1_YMEM); bf16_t* Y = (bf16_t*)(c.seg + S1_Y);
    for (int r = c.bid * 8 + c.wv; r < MS; r += c.G * 8) {
#pragma unroll
        for (int ps = 0; ps < 3; ++ps) {
            const int hh = ps * 8 + (c.lane >> 3), ch = hh * 64 + (c.lane & 7) * 8;
            const u32x4 orr = *(const u32x4*)(O + (size_t)r * DMIX + ch);
            float v[8] = {bflo(orr.x), bfhi(orr.x), bflo(orr.y), bfhi(orr.y), bflo(orr.z), bfhi(orr.z), bflo(orr.w), bfhi(orr.w)}; float s = 0.f, s2 = 0.f;
#pragma unroll
            for (int j = 0; j < 8; ++j) { s += v[j]; s2 += v[j] * v[j]; }
            s += __shfl_xor(s, 1); s2 += __shfl_xor(s2, 1); s += __shfl_xor(s, 2); s2 += __shfl_xor(s2, 2); s += __shfl_xor(s, 4); s2 += __shfl_xor(s2, 4);
            const float mean = s * (1.0f / 64.0f), var = fmaxf(s2 * (1.0f / 64.0f) - mean * mean, 0.f), rs = rsqrtf(var + 64e-5f);
            const float rkr = BRKR[((size_t)r * 24 + hh) * 4 + 2];
            const u32x4 vr = *(const u32x4*)(SV + (size_t)r * DMIX + ch), gr = *(const u32x4*)(SG + (size_t)r * DMIX + ch), zr = *(const u32x4*)(P2 + (size_t)r * P2W + 512 + ch);
            const float vv[8] = {bflo(vr.x), bfhi(vr.x), bflo(vr.y), bfhi(vr.y), bflo(vr.z), bfhi(vr.z), bflo(vr.w), bfhi(vr.w)};
            const float gg[8] = {bflo(gr.x), bfhi(gr.x), bflo(gr.y), bfhi(gr.y), bflo(gr.z), bfhi(gr.z), bflo(gr.w), bfhi(gr.w)};
            const float zz[8] = {bflo(zr.x), bfhi(zr.x), bflo(zr.y), bfhi(zr.y), bflo(zr.z), bfhi(zr.z), bflo(zr.w), bfhi(zr.w)};
            float y[8];
#pragma unroll
            for (int j = 0; j < 8; ++j) { const float t = ((v[j] - mean) * rs * p.rw_lnx_g[ch + j] + p.rw_lnx_b[ch + j] + rkr * vv[j]) * gg[j]; y[j] = t * siluf_(zz[j]); }
            *(u32x4*)(Y + (size_t)r * DIN + ch) = (u32x4){pk2(y[0], y[1]), pk2(y[2], y[3]), pk2(y[4], y[5]), pk2(y[6], y[7])};
        }
        { const int cm = c.lane * 8; const u32x4 mr = *(const u32x4*)(YM + (size_t)r * DX + cm), zr = *(const u32x4*)(P2 + (size_t)r * P2W + 512 + DMIX + cm);
          const float mm[8] = {bflo(mr.x), bfhi(mr.x), bflo(mr.y), bfhi(mr.y), bflo(mr.z), bfhi(mr.z), bflo(mr.w), bfhi(mr.w)};
          const float zz[8] = {bflo(zr.x), bfhi(zr.x), bflo(zr.y), bfhi(zr.y), bflo(zr.z), bfhi(zr.z), bflo(zr.w), bfhi(zr.w)};
          float y[8];
#pragma unroll
          for (int j = 0; j < 8; ++j) y[j] = mm[j] * siluf_(zz[j]);
          *(u32x4*)(Y + (size_t)r * DIN + DMIX + cm) = (u32x4){pk2(y[0], y[1]), pk2(y[2], y[3]), pk2(y[4], y[5]), pk2(y[6], y[7])}; }
    }
}

__device__ __forceinline__ bool fresh_ctx(Ctx& c, P& p, unsigned char* ws0) { int t = threadIdx.x; asm volatile("" : "+v"(t)); c.tid = t; c.wv = __builtin_amdgcn_readfirstlane(t >> 6); c.lane = t & 63;
    int bb = (int)blockIdx.x, gg = (int)gridDim.x; asm volatile("" : "+s"(bb), "+s"(gg)); c.bid = bb; c.G = gg;
#if defined(__HIP_DEVICE_COMPILE__)
    { typedef const __attribute__((address_space(4))) unsigned long long* KP; KP kp = (KP)__builtin_amdgcn_kernarg_segment_ptr(); asm volatile("" : "+s"(kp));
      typedef __attribute__((address_space(1))) char* GP; char** dst = (char**)&p;
#pragma unroll
      for (int i = 0; i < (int)(sizeof(P) / 8); ++i) dst[i] = (char*)(GP)(kp[i]); }
#endif
    size_t z = 0; asm volatile("" : "+s"(z)); p.ws = ws0 + z; c.seg = ws0 + z + OFF_SEG;
    return true; }
__global__ __launch_bounds__(512) void fwd_megakernel(P p_arg) {
    P p = p_arg;
    extern __shared__ __attribute__((aligned(16))) unsigned char shm[];
    LAS unsigned char* lds = (LAS unsigned char*)shm;
    Ctx c; c.tid = threadIdx.x; c.wv = threadIdx.x >> 6; c.lane = threadIdx.x & 63; c.G = gridDim.x; c.bid = blockIdx.x; c.lds = lds; c.seg = p.ws + OFF_SEG;
    volatile LAS unsigned* st = (volatile LAS unsigned*)(lds + LDS_BYTES - 16);
    if (c.tid == 0) { st[0] = 0u; st[1] = 0u; }
    __syncthreads();
    const XcdBarrier xb = xcd_barrier_post((unsigned*)(p.ws + OFF_BAR), st);
#define GSYNC() do { XcdBarrier _xl = xb; size_t _zz = 0; asm volatile("" : "+s"(_zz)); _xl.bar = xb.bar + _zz; _xl.x = xb_xcc_id();     \
        xcd_barrier(_xl); if (RK == 20) { for (int _q = 1; _q < RN; ++_q) xcd_barrier(_xl); } } while (0)
#ifndef RK
#define RK -1
#endif
#ifndef RN
#define RN 1
#endif
#define NREP(k) ((k) == RK ? RN : 1)
#define PH(k) for (int _r = 0; _r < NREP(k); ++_r) if (fresh_ctx(c, p, p_arg.ws))
#define LASTREP(k) (_r + 1 == NREP(k))
    PH(0) phase0(p, c);
    PH(1) phase_apre(p, c, 0, c.bid, c.G);
    GSYNC();
    for (int seg = 0; seg < NSEG; ++seg) {
        PH(2) { SchedA0 S; S.ws = p.ws; S.seg = c.seg; S.G = c.G; S.c = c.bid; S.nextra = (seg == 0) ? 64 : 0;
          pg8::gemm_phase<pg8::EpiBf, SchedA0>(lds, c.tid, 1024, 1024, S, pg8::EpiBf{}); }
        GSYNC();
        PH(3) phase_a1(p, c, seg);
        GSYNC();
        for (int it0 = c.bid; it0 < 256; it0 += c.G) {
            const int xq = it0 & 7, yq = it0 >> 3; const int it = (yq < 24) ? ((xq * 4 + yq / 6) * 6 + yq % 6) : (192 + (yq - 24) * 8 + xq);
            if (it < 192) { PH(4) mlstm_item(p, c, seg, it, LASTREP(4)); }
            else { PH(5) attn_item(p, c, 0, it - 192, (const bf16_t*)(c.seg + S0_P0) + DMIX, ML_W, (bf16_t*)(c.seg + S0_YMEM)); }
        }
        GSYNC();
        PH(6) phase_a3(p, c, seg);
        GSYNC();
        PH(7) { SchedOut S; S.Y = (const char*)(c.seg + S0_Y); S.W = (const char*)(p.ws + OFF_WO0T); S.slab = (char*)(c.seg + S0_SLAB); S.G = c.G; S.c = c.bid;
          pg8::gemm_phase<pg8::EpiBf, SchedOut>(lds, c.tid, DIN, 512, S, pg8::EpiBf{}); }
        GSYNC();
        PH(8) phase_a5(p, c, seg);
        GSYNC();
        PH(9) { SchedB0 S; S.ws = p.ws; S.seg = c.seg; S.G = c.G; S.c = c.bid;
          pg8::gemm_phase<pg8::EpiBf, SchedB0>(lds, c.tid, 1024, 1024, S, pg8::EpiBf{}); }
        GSYNC();
        PH(10) phase_b1(p, c, seg);
        GSYNC();
        for (int it = c.bid; it < 256; it += c.G) {
            if (it < 192) { PH(11) rwkv_chunk_item(p, c, seg, it, LASTREP(11)); }
            else { PH(5) attn_item(p, c, 1, it - 192, (const bf16_t*)(c.seg + S1_P2), P2W, (bf16_t*)(c.seg + S1_YMEM));
                   if (c.G == 256) { PH(1) if (seg + 1 < NSEG) phase_apre(p, c, seg + 1, it - 192, 64); } }
        }
        GSYNC();
        PH(12) phase_b3(p, c);
        GSYNC();
        PH(13) { SchedOut S; S.Y = (const char*)(c.seg + S1_Y); S.W = (const char*)(p.ws + OFF_WO1T); S.slab = (char*)(c.seg + S1_SLAB); S.G = c.G; S.c = c.bid;
          pg8::gemm_phase<pg8::EpiBf, SchedOut>(lds, c.tid, DIN, 512, S, pg8::EpiBf{}); }
        GSYNC();
        PH(14) phase_b5(p, c, seg);
        if (c.G != 256) { PH(1) if (seg + 1 < NSEG) phase_apre(p, c, seg + 1, c.bid, c.G); GSYNC(); }
    }
}

extern "C" void kernel_launch(void* const* d_in, const int* in_sizes, int n_in, void* d_out, int out_size, void* d_ws, size_t ws_size, hipStream_t stream) {
    static int grid = 0;
    if (grid == 0) {
        int dev = 0, cus = 0, per_cu = 0;
        if (hipGetDevice(&dev) != hipSuccess || hipDeviceGetAttribute(&cus, hipDeviceAttributeMultiprocessorCount, dev) != hipSuccess) { grid = -1; return; }
        if (hipFuncSetAttribute((const void*)fwd_megakernel, hipFuncAttributeMaxDynamicSharedMemorySize, LDS_BYTES) != hipSuccess) { fprintf(stderr, "hipFuncSetAttribute failed\n"); grid = -1; return; }
        if (hipOccupancyMaxActiveBlocksPerMultiprocessor(&per_cu, (const void*)fwd_megakernel, 512, LDS_BYTES) != hipSuccess || per_cu < 1) { fprintf(stderr, "occupancy query: %d\n", per_cu); }
        (void)hipGetLastError();
        grid = cus;
        if (n_in != 31 || ws_size < 256 * MiB) { fprintf(stderr, "unexpected n_in %d / ws %zu\n", n_in, ws_size); grid = -1; return; }
    }
    if (grid < 0) return;
    (void)hipMemsetAsync((char*)d_ws + OFF_BAR, 0, XCD_BAR_WORDS * 4, stream);
    P p{};
    const float** f = (const float**)&p;
    for (int i = 0; i < 31; ++i) f[i] = (const float*)d_in[i];
    p.out = (float*)d_out; p.ws = (unsigned char*)d_ws;
    fwd_megakernel<<<dim3(grid), dim3(512), LDS_BYTES, stream>>>(p);
}
```

```cpp
#include <hip/hip_runtime.h>
#include <cstdio>
#include <cstdint>

#define LAS __attribute__((address_space(3)))
typedef unsigned short bf16_t;
typedef short bf16x8 __attribute__((ext_vector_type(8)));
typedef short bf16x4 __attribute__((ext_vector_type(4)));
typedef float f32x4 __attribute__((ext_vector_type(4)));
typedef float f32x2 __attribute__((ext_vector_type(2)));
typedef unsigned u32x4 __attribute__((ext_vector_type(4)));
typedef unsigned u32x2 __attribute__((ext_vector_type(2)));

constexpr int NB = 8, SEQ = 2048, DM = 1024, NSEG = 4, SEGT = 512, MS = NB * SEGT;
constexpr int DMIX = 1536, DX = 512, DIN = 2048;
constexpr int ML_W = 4096, RW_SHIFT = 4896, RW_W = 7456;
constexpr int P1W = 5120, P2W = 2560;
constexpr size_t MiB = 1u << 20;
constexpr size_t OFF_WT0 = 0, OFF_WT1 = 8 * MiB, OFF_WO0T = 23 * MiB, OFF_WO1T = 27 * MiB, OFF_WKVT = 31 * MiB  ,
                 OFF_KMEM = 35 * MiB  , OFF_LORAT = 43 * MiB, OFF_MISC = 45 * MiB,
                 OFF_CST = 46 * MiB, OFF_NST = 65 * MiB, OFF_RST = 65 * MiB + 512 * 1024, OFF_H = 69 * MiB, OFF_VF = 77 * MiB,
                 OFF_SEG = 89 * MiB, OFF_MEMN = 248 * MiB;
constexpr size_t OFF_BAR = OFF_MISC, OFF_UTAIL = OFF_MISC + 64 * 1024, OFF_PTAIL = OFF_MISC + 256 * 1024;
constexpr size_t S0_P0 = 0, S0_Q = 32 * MiB, S0_K = 44 * MiB, S0_KT = 56 * MiB, S0_VT = 68 * MiB, S0_XC = 80 * MiB, S0_HRAW = 92 * MiB,
                 S0_YMEM = 116 * MiB, S0_Y = 120 * MiB, S0_GATE = 136 * MiB;
constexpr size_t S1_P1 = 0, S1_O = 0, S1_Y = 24 * MiB, S1_P2 = 40 * MiB, S1_W = 60 * MiB, S1_A = 84 * MiB, S1_B = 96 * MiB, S1_K = 108 * MiB,
                 S1_Q = 120 * MiB, S1_V = 132 * MiB, S1_G = 144 * MiB, S1_YMEM = 156 * MiB, S1_BRKR = 160 * MiB;
constexpr size_t S0_SLAB = 0  , S1_SLAB = 84 * MiB  ;
constexpr int LDS_BYTES = 150 * 1024;

struct P {
    const float *x, *mem, *norm_g, *mem_norm_g, *mem_kv_w, *w_out, *ml_w_in, *ml_conv_w, *ml_conv_b, *ml_wq, *ml_wk, *ml_wv, *ml_w_gate, *ml_b_gate,
        *ml_mhn_g, *ml_skip, *rw_w_in, *rw_mu, *rw_w_lora2, *rw_w0, *rw_a_lora2, *rw_a0, *rw_v_lora2, *rw_v0, *rw_g_lora2, *rw_k_k, *rw_k_a, *rw_r_k,
        *rw_lnx_g, *rw_lnx_b, *final_g;
    float* out; unsigned char* ws;
};

__device__ __forceinline__ bf16_t f2bf(float f) { const __bf16 r = (__bf16)f; bf16_t u; __builtin_memcpy(&u, &r, 2); return u; }
__device__ __forceinline__ float bf2f(bf16_t b) { return __uint_as_float(((unsigned)b) << 16); }
typedef __bf16 bf2_t __attribute__((ext_vector_type(2)));
__device__ __forceinline__ unsigned pk2(float lo, float hi) { const bf2_t r = __builtin_convertvector((f32x2){lo, hi}, bf2_t); unsigned u; __builtin_memcpy(&u, &r, 4); return u; }
__device__ __forceinline__ float bflo(unsigned u) { return __uint_as_float(u << 16); }
__device__ __forceinline__ float bfhi(unsigned u) { return __uint_as_float(u & 0xFFFF0000u); }
__device__ __forceinline__ float wsum(float v) {
#pragma unroll
    for (int o = 32; o >= 1; o >>= 1) v += __shfl_xor(v, o);
    return v;
}
__device__ __forceinline__ float frcp(float x) { return __builtin_amdgcn_rcpf(x); }
__device__ __forceinline__ float sigmoidf_(float x) { return frcp(1.0f + __expf(-x)); }
__device__ __forceinline__ float siluf_(float x) { return x * frcp(1.0f + __expf(-x)); }
__device__ __forceinline__ float softplusf_(float z) { return fmaxf(z, 0.f) + __logf(1.0f + __expf(-fabsf(z))); }
template <int CTRL> __device__ __forceinline__ float dpp_add(float v) {
    return v + __int_as_float(__builtin_amdgcn_update_dpp(0, __float_as_int(v), CTRL, 0xF, 0xF, true));
}
__device__ __forceinline__ float row16_allsum(float v) {
    v = dpp_add<0xB1>(v);
    v = dpp_add<0x4E>(v);
    v = dpp_add<0x141>(v);
    v = dpp_add<0x140>(v);
    return v;
}
__device__ __forceinline__ void row16_allsum4(float& a, float& b, float& c, float& d) {
    asm volatile("s_nop 1\n\t"
        "v_add_f32_dpp %0, %0, %0 quad_perm:[1,0,3,2] row_mask:0xf bank_mask:0xf\n\t" "v_add_f32_dpp %1, %1, %1 quad_perm:[1,0,3,2] row_mask:0xf bank_mask:0xf\n\t"
        "v_add_f32_dpp %2, %2, %2 quad_perm:[1,0,3,2] row_mask:0xf bank_mask:0xf\n\t" "v_add_f32_dpp %3, %3, %3 quad_perm:[1,0,3,2] row_mask:0xf bank_mask:0xf\n\t"
        "v_add_f32_dpp %0, %0, %0 quad_perm:[2,3,0,1] row_mask:0xf bank_mask:0xf\n\t" "v_add_f32_dpp %1, %1, %1 quad_perm:[2,3,0,1] row_mask:0xf bank_mask:0xf\n\t"
        "v_add_f32_dpp %2, %2, %2 quad_perm:[2,3,0,1] row_mask:0xf bank_mask:0xf\n\t" "v_add_f32_dpp %3, %3, %3 quad_perm:[2,3,0,1] row_mask:0xf bank_mask:0xf\n\t"
        "v_add_f32_dpp %0, %0, %0 row_half_mirror row_mask:0xf bank_mask:0xf\n\t" "v_add_f32_dpp %1, %1, %1 row_half_mirror row_mask:0xf bank_mask:0xf\n\t"
        "v_add_f32_dpp %2, %2, %2 row_half_mirror row_mask:0xf bank_mask:0xf\n\t" "v_add_f32_dpp %3, %3, %3 row_half_mirror row_mask:0xf bank_mask:0xf\n\t"
        "v_add_f32_dpp %0, %0, %0 row_mirror row_mask:0xf bank_mask:0xf\n\t" "v_add_f32_dpp %1, %1, %1 row_mirror row_mask:0xf bank_mask:0xf\n\t"
        "v_add_f32_dpp %2, %2, %2 row_mirror row_mask:0xf bank_mask:0xf\n\t" "v_add_f32_dpp %3, %3, %3 row_mirror row_mask:0xf bank_mask:0xf\n\t"
        "s_nop 1"
        : "+v"(a), "+v"(b), "+v"(c), "+v"(d));
}
template <int N> __device__ __forceinline__ float dpp_shr_or1(float v) {
    return __int_as_float(__builtin_amdgcn_update_dpp(0x3f800000, __float_as_int(v), 0x110 + N, 0xF, 0xF, false));
}
__device__ __forceinline__ f32x4 mfma16(bf16x8 a, bf16x8 b, f32x4 c) { return __builtin_amdgcn_mfma_f32_16x16x32_bf16(a, b, c, 0, 0, 0); }

namespace pg8 {
constexpr int BM = 256, BK = 64, HALF = 128, HTB = HALF * BK * 2, STAGE_BYTES = 8 * HTB, NXCD = 8, WGM = 8;
__host__ __device__ __forceinline__ int lds_byte(int r, int c) { const int st = (r >> 4) * 2 + (c >> 5), rr = r & 15, cc = c & 31, ob = rr * 64 + cc * 2; return st * 1024 + (ob ^ (((ob >> 9) & 1) << 5)); }
__host__ __device__ __forceinline__ void stage_rc(int b, int& R, int& C) { const int st = b / 1024, sb = b % 1024, swz = sb ^ (((sb >> 9) & 1) << 5); R = (st >> 1) * 16 + swz / 64; C = (st & 1) * 32 + (swz % 64) / 2; }
__host__ __device__ __forceinline__ int perm32(int rho) { const int n = rho >> 4, i = rho & 15; return 8 * (i >> 2) + 4 * n + (i & 3); }

struct Unit { const char* A; const char* B; char* O; int ldc; int pad; };

__device__ __forceinline__ void remap(int wgid, int nM, int nN, int& pm, int& pn) {
    const int nwg = nM * nN;
    { const int q = nwg / NXCD, r = nwg % NXCD, xcd = wgid % NXCD, off = wgid / NXCD; wgid = (xcd < r ? xcd * (q + 1) : r * (q + 1) + (xcd - r) * q) + off; }
    const int nig = WGM * nN, gid = wgid / nig, fm = gid * WGM, gsz = (nM - fm) < WGM ? (nM - fm) : WGM;
    pm = fm + ((wgid % nig) % gsz); pn = (wgid % nig) / gsz;
}

struct EpiBf {
    static constexpr bool PERM = true;
    __device__ __forceinline__ void operator()(const f32x4 (&acc)[2][2][4][2], const Unit& u, int wr, int wc, int fr, int fq) const {
        asm volatile("" : "+v"(fr), "+v"(fq));
        bf16_t* base = (bf16_t*)u.O;
#pragma unroll
        for (int ai = 0; ai < 2; ++ai)
#pragma unroll
            for (int m = 0; m < 4; ++m) { bf16_t* rowp = base + (size_t)(ai * HALF + wr * 64 + m * 16 + fr) * u.ldc + wc * 32 + 8 * fq;
#pragma unroll
                for (int bj = 0; bj < 2; ++bj) { const f32x4 v0 = acc[ai][bj][m][0], v1 = acc[ai][bj][m][1];
                    u32x4 w; w.x = pk2(v0[0], v0[1]); w.y = pk2(v0[2], v0[3]); w.z = pk2(v1[0], v1[1]); w.w = pk2(v1[2], v1[3]);
                    *(u32x4*)(rowp + bj * HALF) = w; } }
    }
};
struct EpiAtomic {
    static constexpr bool PERM = false;
    __device__ __forceinline__ void operator()(const f32x4 (&acc)[2][2][4][2], const Unit& u, int wr, int wc, int fr, int fq) const {
        asm volatile("" : "+v"(fr), "+v"(fq));
        float* base = (float*)u.O;
#pragma unroll
        for (int ai = 0; ai < 2; ++ai)
#pragma unroll
            for (int m = 0; m < 4; ++m) { float* rowp = base + (size_t)(ai * HALF + wr * 64 + m * 16 + fr) * u.ldc + wc * 32 + 4 * fq;
#pragma unroll
                for (int bj = 0; bj < 2; ++bj)
#pragma unroll
                    for (int n = 0; n < 2; ++n) { const f32x4 v = acc[ai][bj][m][n]; float* q = rowp + bj * HALF + n * 16;
#pragma unroll
                        for (int e = 0; e < 4; ++e) (void)__hip_atomic_fetch_add(q + e, v[e], __ATOMIC_RELAXED, __HIP_MEMORY_SCOPE_AGENT); }
                __builtin_amdgcn_sched_barrier(0); }
    }
};

template <class Epi, class Sched>
__device__ __forceinline__ void gemm_phase(LAS unsigned char* lds, const int tid, const int ldk, const int Kloop, const Sched& S, const Epi& E) {
    const int wid = __builtin_amdgcn_readfirstlane(tid >> 6), lane = tid & 63, wr = wid >> 2, wc = wid & 3, fr = lane & 15, fq = lane >> 4;
    const int nt = Kloop / BK;
    unsigned voffA[2], voffB[2];
#pragma unroll
    for (int i = 0; i < 2; ++i) { int R, C; stage_rc(tid * 16 + i * 8192, R, C); const int Rb = Epi::PERM ? ((R & ~31) + perm32(R & 31)) : R;
        voffA[i] = (unsigned)(R * ldk + C) * 2u; voffB[i] = (unsigned)(Rb * ldk + C) * 2u; }
    const size_t kstep = (size_t)(BK * 2);
    const size_t hstep = (size_t)HALF * ldk * 2;
    const unsigned ldsw = (unsigned)wid * 1024u;
    const int aoff = lds_byte(wr * 64 + fr, fq * 8), boff = lds_byte(wc * 32 + fr, fq * 8);
#define PG8_SA(b, h) (((b) * 2 + (h)) * HTB)
#define PG8_SB(b, h) ((4 + (b) * 2 + (h)) * HTB)
#define PG8_STAGE(bufoff, gbase, voff) do { _Pragma("unroll") for (int _i = 0; _i < 2; ++_i) \
        __builtin_amdgcn_global_load_lds((const unsigned*)((const char*)(gbase) + (voff)[_i]), (LAS unsigned*)(lds + (bufoff) + ldsw + _i * 8192), 16, 0, 0); } while (0)
#define PG8_LDA(dst, b, h) do { _Pragma("unroll") for (int m = 0; m < 4; ++m) _Pragma("unroll") for (int k = 0; k < 2; ++k) dst[m][k] = *(const LAS bf16x8*)(lds + PG8_SA(b, h) + aoff + m * 2048 + k * 1024); } while (0)
#define PG8_LDB(dst, b, h) do { _Pragma("unroll") for (int n = 0; n < 2; ++n) _Pragma("unroll") for (int k = 0; k < 2; ++k) dst[n][k] = *(const LAS bf16x8*)(lds + PG8_SB(b, h) + boff + n * 2048 + k * 1024); } while (0)
#define PG8_MMA(ai, bj, At, Bt) do { __builtin_amdgcn_s_setprio(1); _Pragma("unroll") for (int m = 0; m < 4; ++m) _Pragma("unroll") for (int n = 0; n < 2; ++n) _Pragma("unroll") for (int k = 0; k < 2; ++k) \
        acc[ai][bj][m][n] = __builtin_amdgcn_mfma_f32_16x16x32_bf16(Bt[n][k], At[m][k], acc[ai][bj][m][n], 0, 0, 0); __builtin_amdgcn_s_setprio(0); } while (0)
#define PG8_WAIT_V(n) asm volatile("s_waitcnt vmcnt(" #n ")" ::: "memory")
#define PG8_WAIT_L(n) asm volatile("s_waitcnt lgkmcnt(" #n ")" ::: "memory")
#define PG8_BAR __builtin_amdgcn_s_barrier()
#define PG8_SCHED __builtin_amdgcn_sched_barrier(0)
    Unit cur, nxt; int ui = 0;
    if (!S.next(0, cur)) return;
    f32x4 acc[2][2][4][2];
#pragma unroll
    for (int a = 0; a < 2; ++a)
#pragma unroll
        for (int b = 0; b < 2; ++b)
#pragma unroll
            for (int m = 0; m < 4; ++m)
#pragma unroll
                for (int n = 0; n < 2; ++n) acc[a][b][m][n] = (f32x4){0.f, 0.f, 0.f, 0.f};
    bf16x8 At[4][2], B0[2][2], B1[2][2];
    const char* cA = cur.A; const char* cB = cur.B;
    PG8_STAGE(PG8_SB(0, 0), cB, voffB); PG8_STAGE(PG8_SA(0, 0), cA, voffA); PG8_STAGE(PG8_SB(0, 1), cB + hstep, voffB); PG8_STAGE(PG8_SA(0, 1), cA + hstep, voffA);
    if (wr == 1) PG8_BAR;
    PG8_WAIT_V(4); PG8_BAR;
    PG8_STAGE(PG8_SB(1, 0), cB + kstep, voffB); PG8_STAGE(PG8_SA(1, 0), cA + kstep, voffA); PG8_STAGE(PG8_SB(1, 1), cB + hstep + kstep, voffB);
    PG8_WAIT_V(6); PG8_BAR;
    for (;;) {
        const bool has_next = S.next(ui + 1, nxt);
        const char* nA = has_next ? nxt.A : cA; const char* nB = has_next ? nxt.B : cB;
        for (int t = 0; t < nt; t += 2) {
            const bool last = (t == nt - 2);
            const char* a1 = cA + (size_t)(t + 1) * kstep;
            const char* a2 = last ? nA : cA + (size_t)(t + 2) * kstep; const char* b2 = last ? nB : cB + (size_t)(t + 2) * kstep;
            const char* a3 = a2 + kstep; const char* b3 = b2 + kstep;
            PG8_LDB(B0, 0, 0); PG8_SCHED; PG8_LDA(At, 0, 0); PG8_STAGE(PG8_SA(1, 1), a1 + hstep, voffA);
            PG8_WAIT_L(8); PG8_BAR; PG8_WAIT_L(0); PG8_MMA(0, 0, At, B0); PG8_BAR; PG8_SCHED;
            PG8_LDB(B1, 0, 1); PG8_STAGE(PG8_SB(0, 0), b2, voffB);
            PG8_BAR; PG8_WAIT_L(0); PG8_MMA(0, 1, At, B1); PG8_BAR;
            PG8_LDA(At, 0, 1); PG8_STAGE(PG8_SA(0, 0), a2, voffA);
            PG8_BAR; PG8_WAIT_L(0); PG8_MMA(1, 0, At, B0); PG8_BAR; PG8_SCHED;
            PG8_STAGE(PG8_SB(0, 1), b2 + hstep, voffB);
            PG8_WAIT_V(6); PG8_BAR; PG8_MMA(1, 1, At, B1); PG8_BAR;
            PG8_LDB(B0, 1, 0); PG8_SCHED; PG8_LDA(At, 1, 0); PG8_STAGE(PG8_SA(0, 1), a2 + hstep, voffA);
            PG8_WAIT_L(8); PG8_BAR; PG8_WAIT_L(0); PG8_MMA(0, 0, At, B0); PG8_BAR; PG8_SCHED;
            PG8_LDB(B1, 1, 1); PG8_STAGE(PG8_SB(1, 0), b3, voffB);
            PG8_BAR; PG8_WAIT_L(0); PG8_MMA(0, 1, At, B1); PG8_BAR;
            PG8_LDA(At, 1, 1); PG8_STAGE(PG8_SA(1, 0), a3, voffA);
            PG8_BAR; PG8_WAIT_L(0); PG8_MMA(1, 0, At, B0); PG8_BAR; PG8_SCHED;
            PG8_STAGE(PG8_SB(1, 1), b3 + hstep, voffB);
            PG8_WAIT_V(6); PG8_BAR; PG8_MMA(1, 1, At, B1); PG8_BAR;
        }
        E(acc, cur, wr, wc, fr, fq);
        if (!has_next) break;
#pragma unroll
        for (int a = 0; a < 2; ++a)
#pragma unroll
            for (int b = 0; b < 2; ++b)
#pragma unroll
                for (int m = 0; m < 4; ++m)
#pragma unroll
                    for (int n = 0; n < 2; ++n) acc[a][b][m][n] = (f32x4){0.f, 0.f, 0.f, 0.f};
        cur = nxt; cA = nA; cB = nB; ++ui;
    }
    PG8_WAIT_V(0);
    if (wr == 0) PG8_BAR;
    PG8_BAR;
#undef PG8_SA
#undef PG8_SB
#undef PG8_STAGE
#undef PG8_LDA
#undef PG8_LDB
#undef PG8_MMA
#undef PG8_WAIT_V
#undef PG8_WAIT_L
#undef PG8_BAR
#undef PG8_SCHED
}
}

#define XB_TMO      128
#define XB_XCNT(j)  (256  + 64 * (j))
#define XB_XSUB(j)  (1280 + 64 * (j))
#define XB_XGEN(j)  (2304 + 64 * (j))
#define XB_TOP      3328
#define XB_TOPGEN   3392
#define XCD_BAR_WORDS 3456
#define XB_SPIN_CAP (1u << 18)
__device__ __forceinline__ unsigned xb_ld(unsigned* p)              { return __hip_atomic_load(p, __ATOMIC_RELAXED, __HIP_MEMORY_SCOPE_AGENT); }
__device__ __forceinline__ unsigned xb_add(unsigned* p, unsigned v) { return __hip_atomic_fetch_add(p, v, __ATOMIC_RELAXED, __HIP_MEMORY_SCOPE_AGENT); }
__device__ __forceinline__ unsigned xb_xcc_id() { return (unsigned)__builtin_amdgcn_s_getreg((3 << 11) | 20) & 0xFu; }
#define XB_SPIN(cond, bar) do { unsigned _sp = 0; while (cond) { __builtin_amdgcn_s_sleep(1); \
    if ((++_sp & 255u) == 0u) { if (xb_ld(&(bar)[XB_TMO])) break; if (_sp > XB_SPIN_CAP) { atomicAdd(&(bar)[XB_TMO], 1u); break; } } } } while (0)
struct XcdBarrier { unsigned* bar; unsigned x; volatile LAS unsigned* st; };
__device__ __forceinline__ XcdBarrier xcd_barrier_post(unsigned* bar, volatile LAS unsigned* st) {
    XcdBarrier b; b.bar = bar; b.x = xb_xcc_id(); b.st = st;
    if (threadIdx.x == 0) (void)xb_add(&bar[XB_XCNT(b.x)], 1u);
    return b;
}
__device__ __forceinline__ void xcd_barrier_complete(unsigned* bar, unsigned x, unsigned& nloc, unsigned& nx) {
    const unsigned G = gridDim.x * gridDim.y * gridDim.z;
    unsigned sum, cnt, mine, sp = 0u;
    for (;;) {
        sum = 0u; cnt = 0u; mine = 0u;
#pragma unroll
        for (unsigned j = 0; j < 16; ++j) { const unsigned c = xb_ld(&bar[XB_XCNT(j)]); sum += c; cnt += (c > 0u) ? 1u : 0u; mine = (j == x) ? c : mine; }
        if (sum == G) break;
        __builtin_amdgcn_s_sleep(1);
        if ((++sp & 255u) == 0u) { if (xb_ld(&bar[XB_TMO])) break; if (sp > XB_SPIN_CAP) { atomicAdd(&bar[XB_TMO], 1u); break; } }
    }
    nloc = mine > 0u ? mine : 1u; nx = cnt > 0u ? cnt : 1u;
}
__device__ __forceinline__ void xcd_barrier(const XcdBarrier& b) {
    asm volatile("s_waitcnt vmcnt(0)" ::: "memory");
    __syncthreads();
    int tid0 = threadIdx.x; asm volatile("" : "+v"(tid0));
    if (tid0 == 0) {
        unsigned* bar = b.bar;
        __builtin_amdgcn_s_waitcnt(0);
        unsigned nloc = b.st[0], nx = b.st[1];
        if (nloc == 0u) { xcd_barrier_complete(bar, b.x, nloc, nx); b.st[0] = nloc; b.st[1] = nx; }
        const unsigned old = xb_add(&bar[XB_XSUB(b.x)], 1u);
        const unsigned gen = old / nloc;
        if (old + 1u == (gen + 1u) * nloc) {
            __builtin_amdgcn_fence(__ATOMIC_RELEASE, "agent");
            asm volatile("s_waitcnt vmcnt(0)" ::: "memory");
            const unsigned og = xb_add(&bar[XB_TOP], 1u);
            const unsigned tg = og / nx;
            if (og + 1u == (tg + 1u) * nx) xb_add(&bar[XB_TOPGEN], 1u);
            else XB_SPIN(xb_ld(&bar[XB_TOPGEN]) == tg, bar);
            __builtin_amdgcn_fence(__ATOMIC_ACQUIRE, "agent");
            xb_add(&bar[XB_XGEN(b.x)], 1u);
            asm volatile("s_waitcnt vmcnt(0)" ::: "memory");
        } else {
            XB_SPIN(xb_ld(&bar[XB_XGEN(b.x)]) == gen, bar);
            __builtin_amdgcn_fence(__ATOMIC_ACQUIRE, "agent");
            asm volatile("s_waitcnt vmcnt(0)" ::: "memory");
        }
    }
    __syncthreads();
}

__device__ __forceinline__ void lds_barrier() { asm volatile("s_waitcnt lgkmcnt(0)" ::: "memory"); __builtin_amdgcn_s_barrier(); asm volatile("" ::: "memory"); }
struct Ctx { int tid, wv, lane, G, bid; LAS unsigned char* lds; unsigned char* seg; };

template <int MODE>
__device__ __forceinline__ void convT_tile(const Ctx& c, const float* src, int ldsrc, int Ksrc, int k0, int n0, bf16_t* dst, int ldd, int koff) {
    LAS float* tile = (LAS float*)c.lds;
    __syncthreads();
#pragma unroll
    for (int rep = 0; rep < 2; ++rep) {
        const int i = (c.tid >> 4) + 32 * rep, j4 = (c.tid & 15) * 4; const int n = n0 + j4; int sc = n;
        if (MODE == 1) sc = (n < RW_SHIFT) ? n : (n < P1W ? -1 : n - (P1W - RW_SHIFT));
        f32x4 v = (f32x4){0.f, 0.f, 0.f, 0.f};
        if (sc >= 0 && (k0 + i) < Ksrc) v = *(const f32x4*)(src + (size_t)(k0 + i) * ldsrc + sc);
        tile[i * 65 + j4 + 0] = v[0]; tile[i * 65 + j4 + 1] = v[1]; tile[i * 65 + j4 + 2] = v[2]; tile[i * 65 + j4 + 3] = v[3];
    }
    __syncthreads();
    { const int j = c.tid >> 3, i8 = (c.tid & 7) * 8;
      if (k0 + i8 < Ksrc) {
        u32x4 w; w.x = pk2(tile[(i8 + 0) * 65 + j], tile[(i8 + 1) * 65 + j]); w.y = pk2(tile[(i8 + 2) * 65 + j], tile[(i8 + 3) * 65 + j]);
        w.z = pk2(tile[(i8 + 4) * 65 + j], tile[(i8 + 5) * 65 + j]); w.w = pk2(tile[(i8 + 6) * 65 + j], tile[(i8 + 7) * 65 + j]);
        *(u32x4*)(dst + (size_t)(n0 + j) * ldd + koff + k0 + i8) = w; } }
}

__device__ __forceinline__ void rms_row_bf16(const float* src, const float* g, bf16_t* dst, int lane) {
    f32x4 v[4]; float ss = 0.f;
#pragma unroll
    for (int i = 0; i < 4; ++i) { v[i] = *(const f32x4*)(src + i * 256 + lane * 4); ss += v[i][0] * v[i][0] + v[i][1] * v[i][1] + v[i][2] * v[i][2] + v[i][3] * v[i][3]; }
    ss = wsum(ss); const float rs = rsqrtf(ss * (1.0f / 1024.0f) + 1e-6f);
#pragma unroll
    for (int i = 0; i < 4; ++i) { const f32x4 gg = *(const f32x4*)(g + i * 256 + lane * 4);
        u32x2 w; w.x = pk2(v[i][0] * rs * gg[0], v[i][1] * rs * gg[1]); w.y = pk2(v[i][2] * rs * gg[2], v[i][3] * rs * gg[3]);
        *(u32x2*)(dst + i * 256 + lane * 4) = w; }
}
__device__ __forceinline__ float add_slabs(const float* src, const bf16_t* slab, int r, int lane, f32x4 (&v)[4]) {
    float ss = 0.f;
#pragma unroll
    for (int i = 0; i < 4; ++i) { v[i] = *(const f32x4*)(src + i * 256 + lane * 4);
#pragma unroll
        for (int ks = 0; ks < 4; ++ks) { const u32x2 t = *(const u32x2*)(slab + ((size_t)ks * MS + r) * DM + i * 256 + lane * 4);
            v[i][0] += bflo(t.x); v[i][1] += bfhi(t.x); v[i][2] += bflo(t.y); v[i][3] += bfhi(t.y); }
        ss += v[i][0] * v[i][0] + v[i][1] * v[i][1] + v[i][2] * v[i][2] + v[i][3] * v[i][3]; }
    return wsum(ss);
}

__device__ __forceinline__ void phase_apre(const P& p, const Ctx& c, int seg, int wg, int nwg) {
    bf16_t* H = (bf16_t*)(p.ws + OFF_H);
    for (int r = wg * 8 + c.wv; r < MS; r += nwg * 8) { const int b = r >> 9, tl = r & 511; const size_t grow = (size_t)b * SEQ + seg * SEGT + tl;
        rms_row_bf16(p.x + grow * DM, p.norm_g, H + (size_t)r * DM, c.lane); }
}
__device__ __forceinline__ void phase_a5(const P& p, const Ctx& c, int seg) {
    bf16_t* H = (bf16_t*)(p.ws + OFF_H); const bf16_t* slab = (const bf16_t*)(c.seg + S0_SLAB);
    for (int r = c.bid * 8 + c.wv; r < MS / 2; r += c.G * 8) {
        const int ra = r, rb = r + MS / 2;
        const size_t ga = (size_t)(ra >> 9) * SEQ + seg * SEGT + (ra & 511), gb = (size_t)(rb >> 9) * SEQ + seg * SEGT + (rb & 511);
        f32x4 va[4], vb[4]; const float sa = add_slabs(p.x + ga * DM, slab, ra, c.lane, va); const float sb = add_slabs(p.x + gb * DM, slab, rb, c.lane, vb);
        const float rsa = rsqrtf(sa * (1.0f / 1024.0f) + 1e-6f), rsb = rsqrtf(sb * (1.0f / 1024.0f) + 1e-6f);
#pragma unroll
        for (int i = 0; i < 4; ++i) { const f32x4 gg = *(const f32x4*)(p.norm_g + DM + i * 256 + c.lane * 4);
            *(f32x4*)(p.out + ga * DM + i * 256 + c.lane * 4) = va[i]; *(f32x4*)(p.out + gb * DM + i * 256 + c.lane * 4) = vb[i];
            u32x2 w; w.x = pk2(va[i][0] * rsa * gg[0], va[i][1] * rsa * gg[1]); w.y = pk2(va[i][2] * rsa * gg[2], va[i][3] * rsa * gg[3]);
            *(u32x2*)(H + (size_t)ra * DM + i * 256 + c.lane * 4) = w;
            w.x = pk2(vb[i][0] * rsb * gg[0], vb[i][1] * rsb * gg[1]); w.y = pk2(vb[i][2] * rsb * gg[2], vb[i][3] * rsb * gg[3]);
            *(u32x2*)(H + (size_t)rb * DM + i * 256 + c.lane * 4) = w; } }
}
__device__ __forceinline__ void phase_b5(const P& p, const Ctx& c, int seg) {
    const bf16_t* slab = (const bf16_t*)(c.seg + S1_SLAB);
    for (int r = c.bid * 8 + c.wv; r < MS / 2; r += c.G * 8) {
        const int ra = r, rb = r + MS / 2;
        float* rowa = p.out + ((size_t)(ra >> 9) * SEQ + seg * SEGT + (ra & 511)) * DM; float* rowb = p.out + ((size_t)(rb >> 9) * SEQ + seg * SEGT + (rb & 511)) * DM;
        f32x4 va[4], vb[4]; const float sa = add_slabs(rowa, slab, ra, c.lane, va); const float sb = add_slabs(rowb, slab, rb, c.lane, vb);
        const float rsa = rsqrtf(sa * (1.0f / 1024.0f) + 1e-6f), rsb = rsqrtf(sb * (1.0f / 1024.0f) + 1e-6f);
#pragma unroll
        for (int i = 0; i < 4; ++i) { const f32x4 gg = *(const f32x4*)(p.final_g + i * 256 + c.lane * 4); f32x4 o;
            o[0] = va[i][0] * rsa * gg[0]; o[1] = va[i][1] * rsa * gg[1]; o[2] = va[i][2] * rsa * gg[2]; o[3] = va[i][3] * rsa * gg[3]; *(f32x4*)(rowa + i * 256 + c.lane * 4) = o;
            o[0] = vb[i][0] * rsb * gg[0]; o[1] = vb[i][1] * rsb * gg[1]; o[2] = vb[i][2] * rsb * gg[2]; o[3] = vb[i][3] * rsb * gg[3]; *(f32x4*)(rowb + i * 256 + c.lane * 4) = o; } }
}

__device__ __forceinline__ void phase0(const P& p, const Ctx& c) {
    const int T0 = 16 * 64, T1 = 16 * 120, T2 = 32 * 16, T3 = 32 * 16, T4 = 16 * 16, T5 = 16 * 16, T6 = 24 * 5;
    const int TT = T0 + T1 + T2 + T3 + T4 + T5 + T6;
    for (int t = c.bid; t < TT; t += c.G) {
        int u = t;
        if (u < T0) { convT_tile<0>(c, p.ml_w_in, ML_W, 1024, (u & 15) * 64, (u >> 4) * 64, (bf16_t*)(p.ws + OFF_WT0), 1024, 0); continue; } u -= T0;
        if (u < T1) { convT_tile<1>(c, p.rw_w_in, RW_W, 1024, (u & 15) * 64, (u >> 4) * 64, (bf16_t*)(p.ws + OFF_WT1), 1024, 0); continue; } u -= T1;
        if (u < T2) { convT_tile<0>(c, p.w_out, DM, 2048, (u & 31) * 64, (u >> 5) * 64, (bf16_t*)(p.ws + OFF_WO0T), 2048, 0); continue; } u -= T2;
        if (u < T3) { convT_tile<0>(c, p.w_out + (size_t)DIN * DM, DM, 2048, (u & 31) * 64, (u >> 5) * 64, (bf16_t*)(p.ws + OFF_WO1T), 2048, 0); continue; } u -= T3;
        if (u < T4) { convT_tile<0>(c, p.mem_kv_w, DM, 1024, (u & 15) * 64, (u >> 4) * 64, (bf16_t*)(p.ws + OFF_WKVT), 1024, 0); continue; } u -= T4;
        if (u < T5) { convT_tile<0>(c, p.mem_kv_w + (size_t)DM * DM, DM, 1024, (u & 15) * 64, (u >> 4) * 64, (bf16_t*)(p.ws + OFF_WKVT + 2 * MiB), 1024, 0); continue; } u -= T5;
        { const int nt = u / 5, j = u % 5; bf16_t* L = (bf16_t*)(p.ws + OFF_LORAT);
          if (j == 0) convT_tile<0>(c, p.rw_w_lora2, DMIX, 64, 0, nt * 64, L, 288, 0);
          else if (j == 1) convT_tile<0>(c, p.rw_a_lora2, DMIX, 64, 0, nt * 64, L, 288, 64);
          else if (j == 2) convT_tile<0>(c, p.rw_v_lora2, DMIX, 32, 0, nt * 64, L, 288, 128);
          else convT_tile<0>(c, p.rw_g_lora2, DMIX, 128, (j - 3) * 64, nt * 64, L, 288, 160); }
    }
    for (int r = c.bid * 8 + c.wv; r < 2 * 2048; r += c.G * 8) { const int l = r >> 11, rr = r & 2047;
        rms_row_bf16(p.mem + (size_t)rr * DM, p.mem_norm_g + l * DM, (bf16_t*)(p.ws + OFF_MEMN) + (size_t)r * DM, c.lane); }
}

struct SchedA0 {
    const unsigned char* ws; unsigned char* seg; int G, c, nextra;
    __device__ __forceinline__ bool next(int i, pg8::Unit& u) const {
        const int L = i * G + c; if (L >= 256 + nextra) return false;
        if (L < 256) { int pm, pn; pg8::remap(L, 16, 16, pm, pn);
            u.A = (const char*)(ws + OFF_H) + (size_t)pm * 256 * 1024 * 2; u.B = (const char*)(ws + OFF_WT0) + (size_t)pn * 256 * 1024 * 2;
            u.O = (char*)(seg + S0_P0) + ((size_t)pm * 256 * ML_W + pn * 256) * 2; u.ldc = ML_W; return true; }
        const int e = L - 256, l = e >> 5, j = e & 31;
        const char* memn = (const char*)(ws + OFF_MEMN) + (size_t)l * 2048 * 1024 * 2; const char* wkv = (const char*)(ws + OFF_WKVT) + (size_t)l * 2 * MiB;
        char* kout = (char*)(ws + OFF_KMEM) + (size_t)l * 4 * MiB;
        if (j < 16) { const int pm = j >> 1, pn = j & 1;
            u.A = memn + (size_t)pm * 256 * 1024 * 2; u.B = wkv + (size_t)pn * 256 * 1024 * 2; u.O = kout + ((size_t)pm * 256 * 512 + pn * 256) * 2; u.ldc = 512; }
        else { const int jj = j - 16, pm = jj >> 3, pn = jj & 7;
            u.A = wkv + (size_t)(512 + pm * 256) * 1024 * 2; u.B = memn + (size_t)pn * 256 * 1024 * 2; u.O = kout + 2 * MiB + ((size_t)pm * 256 * 2048 + pn * 256) * 2; u.ldc = 2048; }
        return true;
    }
};
struct SchedB0 {
    const unsigned char* ws; unsigned char* seg; int G, c;
    __device__ __forceinline__ bool next(int i, pg8::Unit& u) const {
        const int L = i * G + c; if (L >= 480) return false;
        int pm, pn; pg8::remap(L, 16, 30, pm, pn);
        u.A = (const char*)(ws + OFF_H) + (size_t)pm * 256 * 1024 * 2; u.B = (const char*)(ws + OFF_WT1) + (size_t)pn * 256 * 1024 * 2;
        if (pn < 20) { u.O = (char*)(seg + S1_P1) + ((size_t)pm * 256 * P1W + pn * 256) * 2; u.ldc = P1W; }
        else { u.O = (char*)(seg + S1_P2) + ((size_t)pm * 256 * P2W + (pn - 20) * 256) * 2; u.ldc = P2W; }
        return true;
    }
};
struct SchedOut {
    const char* Y; const char* W; char* slab; int G, c;
    __device__ __forceinline__ bool next(int i, pg8::Unit& u) const {
        const int L = i * G + c; if (L >= 256) return false;
        const int ks = L >> 6; int pm, pn; pg8::remap(L & 63, 16, 4, pm, pn);
        u.A = Y + ((size_t)pm * 256 * DIN + ks * 512) * 2; u.B = W + ((size_t)pn * 256 * DIN + ks * 512) * 2;
        u.O = slab + (((size_t)ks * MS + pm * 256) * DM + pn * 256) * 2; u.ldc = DM; return true;
    }
};

__device__ __forceinline__ void phase_a1(const P& p, const Ctx& c, int seg) {
    const bf16_t* P0 = (const bf16_t*)(c.seg + S0_P0);
    bf16_t* Qb = (bf16_t*)(c.seg + S0_Q); bf16_t* Kb = (bf16_t*)(c.seg + S0_K); bf16_t* KT = (bf16_t*)(c.seg + S0_KT); bf16_t* VT = (bf16_t*)(c.seg + S0_VT);
    bf16_t* XC = (bf16_t*)(c.seg + S0_XC); bf16_t* VF = (bf16_t*)(p.ws + OFF_VF);
    float* IPRE = (float*)(c.seg + S0_GATE); float* LOGF = IPRE + 32 * SEGT;
    const bf16_t* UT = (const bf16_t*)(p.ws + OFF_UTAIL);
    LAS float* red = (LAS float*)c.lds;
    LAS bf16_t* kst = (LAS bf16_t*)(c.lds + 98304);
    LAS bf16_t* vst = kst + 1536 * 8;
    const int n = c.tid;
    float wq[4][4], wk[4][4], wv[4][4], G12[4][8], G3[4][8];
    if (n < 384) {
#pragma unroll
        for (int i = 0; i < 4; ++i) { const f32x4 a = *(const f32x4*)(p.ml_wq + n * 16 + i * 4), bb = *(const f32x4*)(p.ml_wk + n * 16 + i * 4), cc = *(const f32x4*)(p.ml_wv + n * 16 + i * 4);
#pragma unroll
            for (int o = 0; o < 4; ++o) { wq[i][o] = a[o]; wk[i][o] = bb[o]; wv[i][o] = cc[o]; } }
#pragma unroll
        for (int i = 0; i < 4; ++i)
#pragma unroll
            for (int g = 0; g < 8; ++g) { G12[i][g] = 0.f; G3[i][g] = 0.f; }
#pragma unroll
        for (int o = 0; o < 4; ++o) {
            const float* gq = p.ml_w_gate + (size_t)(n * 4 + o) * 8; const float* gk = p.ml_w_gate + (size_t)(DMIX + n * 4 + o) * 8; const float* gv = p.ml_w_gate + (size_t)(2 * DMIX + n * 4 + o) * 8;
            const f32x4 q0 = *(const f32x4*)gq, q1 = *(const f32x4*)(gq + 4), k0 = *(const f32x4*)gk, k1 = *(const f32x4*)(gk + 4), v0 = *(const f32x4*)gv, v1 = *(const f32x4*)(gv + 4);
#pragma unroll
            for (int i = 0; i < 4; ++i)
#pragma unroll
                for (int g = 0; g < 4; ++g) { G12[i][g] += wq[i][o] * q0[g] + wk[i][o] * k0[g]; G12[i][g + 4] += wq[i][o] * q1[g] + wk[i][o] * k1[g];
                    G3[i][g] += wv[i][o] * v0[g]; G3[i][g + 4] += wv[i][o] * v1[g]; }
        }
    }
#pragma unroll 1
    for (int it = c.bid; it < MS / 8; it += c.G) {
        const int row0 = it * 8, b = row0 >> 9, tl0 = row0 & 511;
        __syncthreads();
        if (n < 384) {
            float um[3][4];
#pragma unroll
            for (int j = 1; j <= 3; ++j) { u32x2 raw = (u32x2){0u, 0u};
                if (tl0 - j >= 0) raw = *(const u32x2*)(P0 + (unsigned)((row0 - j) * ML_W + n * 4));
                else if (seg > 0) raw = *(const u32x2*)(UT + (unsigned)((b * 3 + (3 - j)) * DMIX + n * 4));
                um[3 - j][0] = bflo(raw.x); um[3 - j][1] = bfhi(raw.x); um[3 - j][2] = bflo(raw.y); um[3 - j][3] = bfhi(raw.y); }
            u32x2 nraw = *(const u32x2*)(P0 + (unsigned)(row0 * ML_W + n * 4));
#pragma unroll 1
            for (int tt = 0; tt < 8; ++tt) {
                const unsigned row = (unsigned)(row0 + tt);
                const u32x2 raw = nraw;
                if (tt + 1 < 8) nraw = *(const u32x2*)(P0 + (unsigned)((row + 1) * ML_W + n * 4));
                float u[4] = {bflo(raw.x), bfhi(raw.x), bflo(raw.y), bfhi(raw.y)}, xc[4], q[4], k[4], v[4];
                { int nn = n; asm volatile("" : "+v"(nn));
                  const f32x4 cb = *(const f32x4*)(p.ml_conv_b + nn * 4), c0 = *(const f32x4*)(p.ml_conv_w + nn * 4), c1 = *(const f32x4*)(p.ml_conv_w + DMIX + nn * 4),
                              c2 = *(const f32x4*)(p.ml_conv_w + 2 * DMIX + nn * 4), c3 = *(const f32x4*)(p.ml_conv_w + 3 * DMIX + nn * 4);
#pragma unroll
                  for (int i = 0; i < 4; ++i) { const float y = cb[i] + c0[i] * um[0][i] + c1[i] * um[1][i] + c2[i] * um[2][i] + c3[i] * u[i]; xc[i] = siluf_(y); } }
                const float ks = 0.05103103630798288f;
#pragma unroll
                for (int o = 0; o < 4; ++o) { q[o] = xc[0] * wq[0][o] + xc[1] * wq[1][o] + xc[2] * wq[2][o] + xc[3] * wq[3][o];
                    k[o] = (xc[0] * wk[0][o] + xc[1] * wk[1][o] + xc[2] * wk[2][o] + xc[3] * wk[3][o]) * ks;
                    v[o] = u[0] * wv[0][o] + u[1] * wv[1][o] + u[2] * wv[2][o] + u[3] * wv[3][o]; }
#pragma unroll
                for (int g = 0; g < 8; ++g) red[(tt * 8 + g) * 384 + n] = xc[0] * G12[0][g] + xc[1] * G12[1][g] + xc[2] * G12[2][g] + xc[3] * G12[3][g] + u[0] * G3[0][g] + u[1] * G3[1][g] + u[2] * G3[2][g] + u[3] * G3[3][g];
                u32x2 w; w.x = pk2(q[0], q[1]); w.y = pk2(q[2], q[3]); *(u32x2*)(Qb + (unsigned)(row * DMIX + n * 4)) = w;
                w.x = pk2(k[0], k[1]); w.y = pk2(k[2], k[3]); *(u32x2*)(Kb + (unsigned)(row * DMIX + n * 4)) = w;
                w.x = pk2(xc[0], xc[1]); w.y = pk2(xc[2], xc[3]); *(u32x2*)(XC + (unsigned)(row * DMIX + n * 4)) = w;
                w.x = pk2(v[0], v[1]); w.y = pk2(v[2], v[3]); *(u32x2*)(VF + (unsigned)(row * DMIX + n * 4)) = w;
#pragma unroll
                for (int o = 0; o < 4; ++o) { kst[(n * 4 + o) * 8 + tt] = f2bf(k[o]); vst[(n * 4 + o) * 8 + tt] = f2bf(v[o]); }
#pragma unroll
                for (int i = 0; i < 4; ++i) { um[0][i] = um[1][i]; um[1][i] = um[2][i]; um[2][i] = u[i]; }
            }
            const int hd = n / 96, dch = (n % 96) * 4;
#pragma unroll
            for (int o = 0; o < 4; ++o) { const unsigned off = (unsigned)(((b * 4 + hd) * 384 + dch + o) * SEGT + tl0);
                *(u32x4*)(KT + off) = *(const LAS u32x4*)(kst + (n * 4 + o) * 8); *(u32x4*)(VT + off) = *(const LAS u32x4*)(vst + (n * 4 + o) * 8); }
        }
        __syncthreads();
        { const int v = c.tid >> 3, part = c.tid & 7; float s = 0.f;
#pragma unroll 8
          for (int i = 0; i < 48; ++i) s += red[v * 384 + part * 48 + i];
          s += __shfl_xor(s, 1); s += __shfl_xor(s, 2); s += __shfl_xor(s, 4);
          if (part == 0) { const int tt = v >> 3, g = v & 7; const float gate = s + p.ml_b_gate[g];
              if (g < 4) IPRE[(b * 4 + g) * SEGT + tl0 + tt] = gate; else LOGF[(b * 4 + g - 4) * SEGT + tl0 + tt] = -softplusf_(-gate); } }
    }
}

__device__ __forceinline__ void attn_item(const P& p, const Ctx& c, int layer, int it, const bf16_t* Qp, int ldq, bf16_t* YM) {
    const int b = it >> 3, head = (it >> 1) & 3, qb = it & 1;
    const bf16_t* Kg = (const bf16_t*)(p.ws + OFF_KMEM + (size_t)layer * 4 * MiB) + (size_t)(b * 256) * 512 + head * 128;
    const bf16_t* Vg = (const bf16_t*)(p.ws + OFF_KMEM + (size_t)layer * 4 * MiB + 2 * MiB) + (size_t)(head * 128) * 2048 + b * 256;
    LAS bf16_t* Ks = (LAS bf16_t*)c.lds;
    LAS bf16_t* Vs = Ks + 256 * 136;
    const int l15 = c.lane & 15, quad = c.lane >> 4;
    __syncthreads();
#pragma unroll
    for (int r = 0; r < 8; ++r) { const int id = c.tid + 512 * r; { const int i = id >> 4, c8 = (id & 15) * 8; *(LAS u32x4*)(Ks + i * 136 + c8) = *(const u32x4*)(Kg + (size_t)i * 512 + c8); }
        { const int i = id >> 5, c8 = (id & 31) * 8; *(LAS u32x4*)(Vs + i * 264 + c8) = *(const u32x4*)(Vg + (size_t)i * 2048 + c8); } }
    __syncthreads();
#pragma unroll 1
    for (int pass = 0; pass < 2; ++pass) {
        const int row0 = b * SEGT + qb * 256 + c.wv * 32 + pass * 16;
        bf16x8 qf[4];
#pragma unroll
        for (int kk = 0; kk < 4; ++kk) qf[kk] = *(const bf16x8*)(Qp + (size_t)(row0 + l15) * ldq + head * 128 + kk * 32 + quad * 8);
        f32x4 acc[16];
#pragma unroll
        for (int mt = 0; mt < 16; ++mt) { acc[mt] = (f32x4){0.f, 0.f, 0.f, 0.f};
#pragma unroll
            for (int kk = 0; kk < 4; ++kk) { const bf16x8 a = *(const LAS bf16x8*)(Ks + (mt * 16 + l15) * 136 + kk * 32 + quad * 8); acc[mt] = mfma16(a, qf[kk], acc[mt]); }
            if ((mt & 3) == 3) __builtin_amdgcn_sched_barrier(0); }
        float mx = -1e30f;
#pragma unroll
        for (int mt = 0; mt < 16; ++mt)
#pragma unroll
            for (int j = 0; j < 4; ++j) mx = fmaxf(mx, acc[mt][j]);
        mx = fmaxf(mx, __shfl_xor(mx, 16)); mx = fmaxf(mx, __shfl_xor(mx, 32));
        const float sc = 0.08838834764831845f * 1.4426950408889634f; float sm = 0.f;
#pragma unroll
        for (int mt = 0; mt < 16; ++mt)
#pragma unroll
            for (int j = 0; j < 4; ++j) { const float e = exp2f((acc[mt][j] - mx) * sc); acc[mt][j] = e; sm += e; }
        sm += __shfl_xor(sm, 16); sm += __shfl_xor(sm, 32);
        const float inv = frcp(sm);
        bf16x8 pa[8];
#pragma unroll
        for (int kp = 0; kp < 8; ++kp) {
            u32x4 aw; aw.x = pk2(acc[2 * kp][0] * inv, acc[2 * kp][1] * inv); aw.y = pk2(acc[2 * kp][2] * inv, acc[2 * kp][3] * inv);
            aw.z = pk2(acc[2 * kp + 1][0] * inv, acc[2 * kp + 1][1] * inv); aw.w = pk2(acc[2 * kp + 1][2] * inv, acc[2 * kp + 1][3] * inv);
            __builtin_memcpy(&pa[kp], &aw, 16); }
        __builtin_amdgcn_sched_barrier(0);
        f32x4 o[8];
#pragma unroll
        for (int nt = 0; nt < 8; ++nt) o[nt] = (f32x4){0.f, 0.f, 0.f, 0.f};
#pragma unroll
        for (int kp = 0; kp < 8; ++kp) {
            const bf16x8 a = pa[kp];
#pragma unroll
            for (int nt = 0; nt < 8; ++nt) { const LAS bf16_t* vp = Vs + (nt * 16 + l15) * 264 + 2 * kp * 16 + quad * 4;
                const u32x2 lo = *(const LAS u32x2*)vp, hi = *(const LAS u32x2*)(vp + 16); u32x4 bw = (u32x4){lo.x, lo.y, hi.x, hi.y}; bf16x8 bfr; __builtin_memcpy(&bfr, &bw, 16);
                o[nt] = mfma16(a, bfr, o[nt]); }
            __builtin_amdgcn_sched_barrier(0);
        }
#pragma unroll
        for (int nt = 0; nt < 8; ++nt)
#pragma unroll
            for (int j = 0; j < 4; ++j) YM[(size_t)(row0 + quad * 4 + j) * DX + head * 128 + nt * 16 + l15] = f2bf(o[nt][j]);
    }
}

__device__ __forceinline__ void mlstm_item(const P& p, const Ctx& c, int seg, int w, bool save) {
    const int b = w / 24, h = (w / 6) & 3, sl = w % 6;
    const bf16_t* Qb = (const bf16_t*)(c.seg + S0_Q); const bf16_t* Kb = (const bf16_t*)(c.seg + S0_K); const bf16_t* KT = (const bf16_t*)(c.seg + S0_KT); const bf16_t* VT = (const bf16_t*)(c.seg + S0_VT);
    const float* IPRE = (const float*)(c.seg + S0_GATE); const float* LOGF = IPRE + 32 * SEGT;
    bf16_t* HR = (bf16_t*)(c.seg + S0_HRAW);
    float* CST = (float*)(p.ws + OFF_CST) + (size_t)w * 64 * 384; float* NST = (float*)(p.ws + OFF_NST) + (size_t)w * 384;
    LAS bf16_t* Cimg = (LAS bf16_t*)c.lds;
    LAS bf16_t* Qs = Cimg + 64 * 392;
    LAS bf16_t* Ks = Qs + 64 * 136;
    LAS bf16_t* KTs = Ks + 64 * 136;
    LAS bf16_t* VTs = KTs + 128 * 72;
    LAS bf16_t* VWs = VTs + 64 * 72;
    LAS bf16_t* Sp = VWs + 64 * 72;
    LAS float* fl = (LAS float*)(Sp + 64 * 72);
    LAS float* bcum = fl; LAS float* ipr = fl + 64; LAS float* wgt = fl + 128; LAS float* gin = fl + 192; LAS float* qn = fl + 256; LAS float* rden = fl + 320;
    LAS float* gtotp = fl + 384; LAS float* nold = fl + 400; LAS float* nnew = fl + 800;
    const int l15c = c.lane & 15, quadc = c.lane >> 4, e16 = c.wv & 3, par = c.wv >> 2;
    f32x4 C[12];
    __syncthreads();
    if (seg > 0) {
#pragma unroll
        for (int j = 0; j < 12; ++j)
#pragma unroll
            for (int jj = 0; jj < 4; ++jj) C[j][jj] = CST[(size_t)(e16 * 16 + quadc * 4 + jj) * 384 + (2 * j + par) * 16 + l15c];
        if (c.tid < 384) nold[c.tid] = NST[c.tid];
    } else {
#pragma unroll
        for (int j = 0; j < 12; ++j) C[j] = (f32x4){0.f, 0.f, 0.f, 0.f};
        if (c.tid < 384) nold[c.tid] = 0.f;
    }
    u32x4 pq[2], pk[2], pt[2], pvt; float plf = 0.f, pip = 0.f;
    auto gl_piece = [&](int ch, int pp, int tidv) {
#pragma unroll
        for (int r = 0; r < 2; ++r) { const int id = tidv + 512 * r;
            { const int i = id >> 4, c8 = (id & 15) * 8; const size_t go = ((size_t)b * SEGT + ch * 64 + i) * DMIX + h * 384 + pp * 128 + c8; pq[r] = *(const u32x4*)(Qb + go); pk[r] = *(const u32x4*)(Kb + go); }
            { const int dd = id >> 3, c8 = (id & 7) * 8; pt[r] = *(const u32x4*)(KT + ((size_t)(b * 4 + h) * 384 + pp * 128 + dd) * SEGT + ch * 64 + c8); } } };
    auto gl_chunk = [&](int ch, int tidv) { const int i = tidv >> 3, c8 = (tidv & 7) * 8;
        pvt = *(const u32x4*)(VT + ((size_t)(b * 4 + h) * 384 + sl * 64 + i) * SEGT + ch * 64 + c8);
        if (c.wv == 0) { plf = LOGF[(b * 4 + h) * SEGT + ch * 64 + c.lane]; pip = IPRE[(b * 4 + h) * SEGT + ch * 64 + c.lane]; } };
    { int t0 = c.tid; asm volatile("" : "+v"(t0)); gl_chunk(0, t0); gl_piece(0, 0, t0); }
#pragma unroll 1
    for (int ch = 0; ch < 8; ++ch) {
        const int tl0 = ch * 64; const size_t row0 = (size_t)b * SEGT + tl0;
        int tidv = c.tid, l15 = l15c, quad = quadc;
        asm volatile("" : "+v"(tidv), "+v"(l15), "+v"(quad));
        lds_barrier();
        if (c.wv == 0) {
            float bc = plf;
#pragma unroll
            for (int o = 1; o < 64; o <<= 1) { const float t = __shfl_up(bc, o); if (c.lane >= o) bc += t; }
            const float bl = __shfl(bc, 63);
            bcum[c.lane] = bc; ipr[c.lane] = pip; wgt[c.lane] = __expf(bl - bc + pip); gin[c.lane] = __expf(bc);
            if (c.lane == 0) gtotp[0] = __expf(bl);
        }
#pragma unroll
        for (int j = 0; j < 12; ++j)
#pragma unroll
            for (int jj = 0; jj < 4; ++jj) Cimg[(e16 * 16 + quad * 4 + jj) * 392 + (2 * j + par) * 16 + l15] = f2bf(C[j][jj]);
        lds_barrier();
        { const int i = tidv >> 3, c8 = (tidv & 7) * 8;
          const u32x4 raw = pvt;
          *(LAS u32x4*)(VTs + i * 72 + c8) = raw;
          const f32x4 w0 = *(const LAS f32x4*)(wgt + c8), w1 = *(const LAS f32x4*)(wgt + c8 + 4);
          u32x4 sw; sw.x = pk2(bflo(raw.x) * w0[0], bfhi(raw.x) * w0[1]); sw.y = pk2(bflo(raw.y) * w0[2], bfhi(raw.y) * w0[3]);
          sw.z = pk2(bflo(raw.z) * w1[0], bfhi(raw.z) * w1[1]); sw.w = pk2(bflo(raw.w) * w1[2], bfhi(raw.w) * w1[3]);
          *(LAS u32x4*)(VWs + i * 72 + c8) = sw; }
        if (ch + 1 < 8) gl_chunk(ch + 1, tidv);
        const float gtot = gtotp[0];
#pragma unroll
        for (int j = 0; j < 12; ++j) C[j] *= gtot;
        f32x4 Sa[2], Ia[2]; Sa[0] = Sa[1] = Ia[0] = Ia[1] = (f32x4){0.f, 0.f, 0.f, 0.f};
        float qnacc = 0.f;
#pragma unroll
        for (int pp = 0; pp < 3; ++pp) {
            const int d0 = pp * 128;
            __builtin_amdgcn_sched_barrier(0);
            asm volatile("" : "+v"(tidv));
            lds_barrier();
#pragma unroll
            for (int r = 0; r < 2; ++r) { const int id = tidv + 512 * r;
                { const int i = id >> 4, c8 = (id & 15) * 8; *(LAS u32x4*)(Qs + i * 136 + c8) = pq[r]; *(LAS u32x4*)(Ks + i * 136 + c8) = pk[r]; }
                { const int dd = id >> 3, c8 = (id & 7) * 8; *(LAS u32x4*)(KTs + dd * 72 + c8) = pt[r]; } }
            lds_barrier();
            if (pp < 2) gl_piece(ch, pp + 1, tidv); else if (ch + 1 < 8) gl_piece(ch + 1, 0, tidv);
            { const int tm = c.wv >> 1, tn0 = (c.wv & 1) * 2;
#pragma unroll
              for (int kk = 0; kk < 4; ++kk) { const bf16x8 a = *(const LAS bf16x8*)(Qs + (tm * 16 + l15) * 136 + kk * 32 + quad * 8);
#pragma unroll
                  for (int x = 0; x < 2; ++x) { const int tn = tn0 + x;
                      const bf16x8 bk = *(const LAS bf16x8*)(Ks + (tn * 16 + l15) * 136 + kk * 32 + quad * 8);
                      const bf16x8 bc = *(const LAS bf16x8*)(Cimg + (tn * 16 + l15) * 392 + d0 + kk * 32 + quad * 8);
                      Sa[x] = mfma16(a, bk, Sa[x]); Ia[x] = mfma16(a, bc, Ia[x]); } } }
            { const bf16x8 va0 = *(const LAS bf16x8*)(VWs + (e16 * 16 + l15) * 72 + quad * 8), va1 = *(const LAS bf16x8*)(VWs + (e16 * 16 + l15) * 72 + 32 + quad * 8);
#pragma unroll
              for (int jl = 0; jl < 4; ++jl) { const int ntl = 2 * jl + par, j = pp * 4 + jl;
                  C[j] = mfma16(va0, *(const LAS bf16x8*)(KTs + (ntl * 16 + l15) * 72 + quad * 8), C[j]);
                  C[j] = mfma16(va1, *(const LAS bf16x8*)(KTs + (ntl * 16 + l15) * 72 + 32 + quad * 8), C[j]); } }
            { const int t = tidv >> 3, part = tidv & 7;
              const u32x4 q0 = *(const LAS u32x4*)(Qs + t * 136 + part * 16), q1 = *(const LAS u32x4*)(Qs + t * 136 + part * 16 + 8);
              const LAS float* np = nold + d0 + part * 16; const f32x4 n0 = *(const LAS f32x4*)np, n1 = *(const LAS f32x4*)(np + 4), n2 = *(const LAS f32x4*)(np + 8), n3 = *(const LAS f32x4*)(np + 12);
              qnacc += bflo(q0.x) * n0[0] + bfhi(q0.x) * n0[1] + bflo(q0.y) * n0[2] + bfhi(q0.y) * n0[3] + bflo(q0.z) * n1[0] + bfhi(q0.z) * n1[1] + bflo(q0.w) * n1[2] + bfhi(q0.w) * n1[3]
                     + bflo(q1.x) * n2[0] + bfhi(q1.x) * n2[1] + bflo(q1.y) * n2[2] + bfhi(q1.y) * n2[3] + bflo(q1.z) * n3[0] + bfhi(q1.z) * n3[1] + bflo(q1.w) * n3[2] + bfhi(q1.w) * n3[3]; }
            { const int dd = tidv >> 2, part = tidv & 3;
              const u32x4 k0 = *(const LAS u32x4*)(KTs + dd * 72 + part * 16), k1 = *(const LAS u32x4*)(KTs + dd * 72 + part * 16 + 8);
              const LAS float* wp = wgt + part * 16; const f32x4 w0 = *(const LAS f32x4*)wp, w1 = *(const LAS f32x4*)(wp + 4), w2 = *(const LAS f32x4*)(wp + 8), w3 = *(const LAS f32x4*)(wp + 12);
              float a = bflo(k0.x) * w0[0] + bfhi(k0.x) * w0[1] + bflo(k0.y) * w0[2] + bfhi(k0.y) * w0[3] + bflo(k0.z) * w1[0] + bfhi(k0.z) * w1[1] + bflo(k0.w) * w1[2] + bfhi(k0.w) * w1[3]
                      + bflo(k1.x) * w2[0] + bfhi(k1.x) * w2[1] + bflo(k1.y) * w2[2] + bfhi(k1.y) * w2[3] + bflo(k1.z) * w3[0] + bfhi(k1.z) * w3[1] + bflo(k1.w) * w3[2] + bfhi(k1.w) * w3[3];
              a = dpp_add<0xB1>(a); a = dpp_add<0x4E>(a);
              if (part == 0) nnew[d0 + dd] = gtot * nold[d0 + dd] + a; }
        }
        qnacc = dpp_add<0xB1>(qnacc); qnacc = dpp_add<0x4E>(qnacc); qnacc = dpp_add<0x141>(qnacc);
        if ((tidv & 7) == 0) qn[tidv >> 3] = qnacc;
#pragma unroll
        for (int x = 0; x < 2; ++x) { const int ti = c.wv * 2 + x, tm = ti >> 2, tn = ti & 3; const int s = tn * 16 + l15; const float bs = bcum[s] - ipr[s];
#pragma unroll
            for (int jj = 0; jj < 4; ++jj) { const int t = tm * 16 + quad * 4 + jj; const float v = (s <= t) ? Sa[x][jj] * __expf(bcum[t] - bs) : 0.f; Sp[t * 72 + s] = f2bf(v); } }
        lds_barrier();
        { const int t = tidv >> 3, part = tidv & 7; const u32x4 sr = *(const LAS u32x4*)(Sp + t * 72 + part * 8);
          float ds = bflo(sr.x) + bfhi(sr.x) + bflo(sr.y) + bfhi(sr.y) + bflo(sr.z) + bfhi(sr.z) + bflo(sr.w) + bfhi(sr.w);
          ds = dpp_add<0xB1>(ds); ds = dpp_add<0x4E>(ds); ds = dpp_add<0x141>(ds);
          if (part == 0) { const float den = ds + gin[t] * qn[t]; rden[t] = frcp(fmaxf(fabsf(den), 1.0f)); } }
#pragma unroll
        for (int x = 0; x < 2; ++x) { const int ti = c.wv * 2 + x, tm = ti >> 2, tn = ti & 3;
#pragma unroll
            for (int jj = 0; jj < 4; ++jj) Ia[x][jj] *= gin[tm * 16 + quad * 4 + jj];
#pragma unroll
            for (int kk = 0; kk < 2; ++kk) { const bf16x8 a = *(const LAS bf16x8*)(Sp + (tm * 16 + l15) * 72 + kk * 32 + quad * 8);
                const bf16x8 bb = *(const LAS bf16x8*)(VTs + (tn * 16 + l15) * 72 + kk * 32 + quad * 8); Ia[x] = mfma16(a, bb, Ia[x]); } }
        lds_barrier();
#pragma unroll
        for (int x = 0; x < 2; ++x) { const int ti = c.wv * 2 + x, tm = ti >> 2, tn = ti & 3;
#pragma unroll
            for (int jj = 0; jj < 4; ++jj) { const int t = tm * 16 + quad * 4 + jj; HR[(row0 + t) * DMIX + h * 384 + sl * 64 + tn * 16 + l15] = f2bf(Ia[x][jj] * rden[t]); } }
        if (c.tid < 384) nold[c.tid] = nnew[c.tid];
    }
    lds_barrier();
    if (!save) return;
#pragma unroll
    for (int j = 0; j < 12; ++j)
#pragma unroll
        for (int jj = 0; jj < 4; ++jj) CST[(size_t)(e16 * 16 + quadc * 4 + jj) * 384 + (2 * j + par) * 16 + l15c] = C[j][jj];
    if (c.tid < 384) NST[c.tid] = nold[c.tid];
}

__device__ __forceinline__ void phase_a3(const P& p, const Ctx& c, int seg) {
    const bf16_t* P0 = (const bf16_t*)(c.seg + S0_P0); const bf16_t* HR = (const bf16_t*)(c.seg + S0_HRAW); const bf16_t* XC = (const bf16_t*)(c.seg + S0_XC);
    const bf16_t* YM = (const bf16_t*)(c.seg + S0_YMEM); bf16_t* Y = (bf16_t*)(c.seg + S0_Y); bf16_t* UT = (bf16_t*)(p.ws + OFF_UTAIL);
#pragma unroll 1
    for (int r = c.bid * 8 + c.wv; r < MS; r += c.G * 8) {
        const int b = r >> 9, tl = r & 511;
        float v[3][8]; float mean[3], rstd[3];
#pragma unroll
        for (int ps = 0; ps < 3; ++ps) { const int ch = ps * 512 + c.lane * 8;
            const u32x4 hr = *(const u32x4*)(HR + (size_t)r * DMIX + ch);
            v[ps][0] = bflo(hr.x); v[ps][1] = bfhi(hr.x); v[ps][2] = bflo(hr.y); v[ps][3] = bfhi(hr.y); v[ps][4] = bflo(hr.z); v[ps][5] = bfhi(hr.z); v[ps][6] = bflo(hr.w); v[ps][7] = bfhi(hr.w); }
        float hs[4], hq[4];
#pragma unroll
        for (int hd = 0; hd < 4; ++hd) { float s = 0.f, q = 0.f;
#pragma unroll
            for (int ps = 0; ps < 3; ++ps) { if (ps * 512 + 511 < hd * 384 || ps * 512 >= (hd + 1) * 384) continue;
                const bool mine = ((ps * 512 + c.lane * 8) / 384) == hd;
                float ls = 0.f, lq = 0.f;
#pragma unroll
                for (int j = 0; j < 8; ++j) { ls += v[ps][j]; lq += v[ps][j] * v[ps][j]; }
                s += mine ? ls : 0.f; q += mine ? lq : 0.f; }
            hs[hd] = wsum(s); hq[hd] = wsum(q); }
#pragma unroll
        for (int ps = 0; ps < 3; ++ps) { const int hd = (ps * 512 + c.lane * 8) / 384;
            const float s = hd == 0 ? hs[0] : (hd == 1 ? hs[1] : (hd == 2 ? hs[2] : hs[3])), q = hd == 0 ? hq[0] : (hd == 1 ? hq[1] : (hd == 2 ? hq[2] : hq[3]));
            const float m = s * (1.0f / 384.0f); mean[ps] = m; rstd[ps] = rsqrtf(fmaxf(q * (1.0f / 384.0f) - m * m, 0.f) + 1e-5f); }
#pragma unroll
        for (int ps = 0; ps < 3; ++ps) { const int ch = ps * 512 + c.lane * 8;
            const u32x4 xr = *(const u32x4*)(XC + (size_t)r * DMIX + ch), zr = *(const u32x4*)(P0 + (size_t)r * ML_W + 2048 + ch);
            const f32x4 g0 = *(const f32x4*)(p.ml_mhn_g + ch), g1 = *(const f32x4*)(p.ml_mhn_g + ch + 4), k0 = *(const f32x4*)(p.ml_skip + ch), k1 = *(const f32x4*)(p.ml_skip + ch + 4);
            const float xx[8] = {bflo(xr.x), bfhi(xr.x), bflo(xr.y), bfhi(xr.y), bflo(xr.z), bfhi(xr.z), bflo(xr.w), bfhi(xr.w)};
            const float zz[8] = {bflo(zr.x), bfhi(zr.x), bflo(zr.y), bfhi(zr.y), bflo(zr.z), bfhi(zr.z), bflo(zr.w), bfhi(zr.w)};
            const float gg[8] = {g0[0], g0[1], g0[2], g0[3], g1[0], g1[1], g1[2], g1[3]}, kk[8] = {k0[0], k0[1], k0[2], k0[3], k1[0], k1[1], k1[2], k1[3]};
            float y[8];
#pragma unroll
            for (int j = 0; j < 8; ++j) y[j] = ((v[ps][j] - mean[ps]) * rstd[ps] * gg[j] + kk[j] * xx[j]) * siluf_(zz[j]);
            *(u32x4*)(Y + (size_t)r * DIN + ch) = (u32x4){pk2(y[0], y[1]), pk2(y[2], y[3]), pk2(y[4], y[5]), pk2(y[6], y[7])}; }
        { const int cm = c.lane * 8; const u32x4 mr = *(const u32x4*)(YM + (size_t)r * DX + cm), zr = *(const u32x4*)(P0 + (size_t)r * ML_W + 2048 + DMIX + cm);
          const float mm[8] = {bflo(mr.x), bfhi(mr.x), bflo(mr.y), bfhi(mr.y), bflo(mr.z), bfhi(mr.z), bflo(mr.w), bfhi(mr.w)};
          const float zz[8] = {bflo(zr.x), bfhi(zr.x), bflo(zr.y), bfhi(zr.y), bflo(zr.z), bfhi(zr.z), bflo(zr.w), bfhi(zr.w)};
          float y[8];
#pragma unroll
          for (int j = 0; j < 8; ++j) y[j] = mm[j] * siluf_(zz[j]);
          *(u32x4*)(Y + (size_t)r * DIN + DMIX + cm) = (u32x4){pk2(y[0], y[1]), pk2(y[2], y[3]), pk2(y[4], y[5]), pk2(y[6], y[7])}; }
        if (tl >= 509) {
#pragma unroll
            for (int ps = 0; ps < 3; ++ps) { const int ch = ps * 512 + c.lane * 8; *(u32x4*)(UT + (size_t)(b * 3 + tl - 509) * DMIX + ch) = *(const u32x4*)(P0 + (size_t)r * ML_W + ch); } }
    }
}

__device__ __forceinline__ void phase_b1(const P& p, const Ctx& c, int seg) {
    const bf16_t* P1 = (const bf16_t*)(c.seg + S1_P1);
    float* GTB = (float*)(c.seg + S1_W); bf16_t* SA = (bf16_t*)(c.seg + S1_A); bf16_t* SB = (bf16_t*)(c.seg + S1_B); bf16_t* SK = (bf16_t*)(c.seg + S1_K);
    bf16_t* SQ = (bf16_t*)(c.seg + S1_Q); bf16_t* SV = (bf16_t*)(c.seg + S1_V); bf16_t* SG = (bf16_t*)(c.seg + S1_G); float* BRKR = (float*)(c.seg + S1_BRKR);
    const bf16_t* VF = (const bf16_t*)(p.ws + OFF_VF); const bf16_t* LT = (const bf16_t*)(p.ws + OFF_LORAT);
    const bf16_t* PTr = (const bf16_t*)(p.ws + OFF_PTAIL) + (size_t)(seg & 1) * NB * RW_SHIFT; bf16_t* PTw = (bf16_t*)(p.ws + OFF_PTAIL) + (size_t)((seg + 1) & 1) * NB * RW_SHIFT;
    LAS bf16_t* XA = (LAS bf16_t*)c.lds;
    const int l15 = c.lane & 15, quad = c.lane >> 4;
    for (int it = c.bid; it < MS / 16; it += c.G) {
        const int r0 = it * 16, b = r0 >> 9, tl0 = r0 & 511;
        __syncthreads();
        for (int e = c.tid; e < 16 * 288; e += 512) { const int row = e / 288, cc = e % 288, col = 4608 + cc;
            const float cur = bf2f(P1[(size_t)(r0 + row) * P1W + col]);
            float prev = 0.f; if (tl0 + row > 0) prev = bf2f(P1[(size_t)(r0 + row - 1) * P1W + col]); else if (seg > 0) prev = bf2f(PTr[(size_t)b * RW_SHIFT + col]);
            const float pv = cur + p.rw_mu[col] * (prev - cur);
            const float f = cc < 64 ? (1.0f - 2.0f / (1.0f + __expf(2.0f * pv)))   : (cc < 160 ? pv : sigmoidf_(pv));
            XA[row * 296 + cc] = f2bf(f); }
        __syncthreads();
        const size_t row = (size_t)r0 + l15; const int tl = tl0 + l15;
        const bf16_t* curp = P1 + row * P1W; const bf16_t* prevp = (tl > 0) ? (P1 + (row - 1) * P1W) : (PTr + (size_t)b * RW_SHIFT); const bool hasprev = (tl > 0) || (seg > 0);
        struct TileIn { u32x4 cr, ck, cv, pr, pk, pv, vf; };
        struct TilePar { f32x4 m0, m1, m2, w0, a0, v0, kkw, kaw, rk; };
#pragma unroll 1
        for (int x = 0; x < 3; ++x) {
            int hh = c.wv * 3 + x; asm volatile("" : "+s"(hh));
            auto load_tile = [&](int ct, TileIn& T) { const int cc = hh * 64 + (ct >> 1) * 32 + quad * 8;
                T.cr = *(const u32x4*)(curp + cc); T.ck = *(const u32x4*)(curp + DMIX + cc); T.cv = *(const u32x4*)(curp + 2 * DMIX + cc);
                T.pr = (u32x4){0u, 0u, 0u, 0u}; T.pk = T.pr; T.pv = T.pr;
                if (hasprev) { T.pr = *(const u32x4*)(prevp + cc); T.pk = *(const u32x4*)(prevp + DMIX + cc); T.pv = *(const u32x4*)(prevp + 2 * DMIX + cc); }
                T.vf = *(const u32x4*)(VF + row * DMIX + cc); };
            TileIn TA;
            load_tile(0, TA);
            float inv;
            { u32x2 kcur[4], kprv[4]; f32x4 km[4], kw[4];
#pragma unroll
              for (int ct = 0; ct < 4; ++ct) { const int cc = hh * 64 + (ct >> 1) * 32 + quad * 8 + 4 * (ct & 1);
                  kcur[ct] = *(const u32x2*)(curp + DMIX + cc); kprv[ct] = (u32x2){0u, 0u}; if (hasprev) kprv[ct] = *(const u32x2*)(prevp + DMIX + cc);
                  km[ct] = *(const f32x4*)(p.rw_mu + DMIX + cc); kw[ct] = *(const f32x4*)(p.rw_k_k + cc); }
              float ss = 0.f;
#pragma unroll
              for (int ct = 0; ct < 4; ++ct) {
                  const float cb[4] = {bflo(kcur[ct].x), bfhi(kcur[ct].x), bflo(kcur[ct].y), bfhi(kcur[ct].y)}, qb[4] = {bflo(kprv[ct].x), bfhi(kprv[ct].x), bflo(kprv[ct].y), bfhi(kprv[ct].y)};
#pragma unroll
                  for (int j = 0; j < 4; ++j) { const float kr = (cb[j] + km[ct][j] * (qb[j] - cb[j])) * kw[ct][j]; ss += kr * kr; } }
              ss += __shfl_xor(ss, 16); ss += __shfl_xor(ss, 32);
              inv = frcp(fmaxf(sqrtf(ss), 1e-12f)); }
            float br = 0.f, kr = 0.f, rkr = 0.f;
            u32x2 st_g, st_a, st_b, st_k, st_q, st_v;
            auto do_tile = [&](int ct, const TileIn& TI) { const int cc = hh * 64 + (ct >> 1) * 32 + quad * 8 + 4 * (ct & 1);
                TilePar T; T.m0 = *(const f32x4*)(p.rw_mu + cc); T.m1 = *(const f32x4*)(p.rw_mu + DMIX + cc); T.m2 = *(const f32x4*)(p.rw_mu + 2 * DMIX + cc);
                T.w0 = *(const f32x4*)(p.rw_w0 + cc); T.a0 = *(const f32x4*)(p.rw_a0 + cc); T.v0 = *(const f32x4*)(p.rw_v0 + cc); T.kkw = *(const f32x4*)(p.rw_k_k + cc); T.kaw = *(const f32x4*)(p.rw_k_a + cc);
                T.rk = *(const f32x4*)(p.rw_r_k + cc);
                bf16x8 lt[9]; { const bf16_t* lrow = LT + (size_t)(hh * 64 + (ct >> 1) * 32 + 8 * (l15 >> 2) + 4 * (ct & 1) + (l15 & 3)) * 288 + quad * 8;
#pragma unroll
                    for (int k = 0; k < 9; ++k) lt[k] = *(const bf16x8*)(lrow + k * 32); }
                bf16x8 xf[9];
#pragma unroll
                for (int k = 0; k < 9; ++k) xf[k] = *(const LAS bf16x8*)(XA + l15 * 296 + k * 32 + quad * 8);
                f32x4 dw = (f32x4){0.f, 0.f, 0.f, 0.f}, da = dw, dv = dw, dg = dw;
#pragma unroll
                for (int k = 0; k < 2; ++k) dw = mfma16(lt[k], xf[k], dw);
#pragma unroll
                for (int k = 0; k < 2; ++k) da = mfma16(lt[2 + k], xf[2 + k], da);
                dv = mfma16(lt[4], xf[4], dv);
#pragma unroll
                for (int k = 0; k < 4; ++k) dg = mfma16(lt[5 + k], xf[5 + k], dg);
                const bool od = (ct & 1) != 0;
                const unsigned r0 = od ? TI.cr.z : TI.cr.x, r1 = od ? TI.cr.w : TI.cr.y, k0 = od ? TI.ck.z : TI.ck.x, k1 = od ? TI.ck.w : TI.ck.y, c0 = od ? TI.cv.z : TI.cv.x, c1 = od ? TI.cv.w : TI.cv.y;
                const unsigned p0 = od ? TI.pr.z : TI.pr.x, p1 = od ? TI.pr.w : TI.pr.y, q0 = od ? TI.pk.z : TI.pk.x, q1 = od ? TI.pk.w : TI.pk.y, d0 = od ? TI.pv.z : TI.pv.x, d1 = od ? TI.pv.w : TI.pv.y;
                const unsigned f0 = od ? TI.vf.z : TI.vf.x, f1 = od ? TI.vf.w : TI.vf.y;
                const float ca[4] = {bflo(r0), bfhi(r0), bflo(r1), bfhi(r1)}, cb[4] = {bflo(k0), bfhi(k0), bflo(k1), bfhi(k1)}, cd[4] = {bflo(c0), bfhi(c0), bflo(c1), bfhi(c1)};
                const float qa[4] = {bflo(p0), bfhi(p0), bflo(p1), bfhi(p1)}, qb[4] = {bflo(q0), bfhi(q0), bflo(q1), bfhi(q1)}, qd[4] = {bflo(d0), bfhi(d0), bflo(d1), bfhi(d1)};
                const float vf[4] = {bflo(f0), bfhi(f0), bflo(f1), bfhi(f1)};
                u32x2 gw; gw.x = pk2(dg[0], dg[1]); gw.y = pk2(dg[2], dg[3]);
                float wv4[4], av[4], bv[4], ktv[4], qv[4], vv[4];
#pragma unroll
                for (int j = 0; j < 4; ++j) {
                    const float rc = ca[j] + T.m0[j] * (qa[j] - ca[j]), kc = cb[j] + T.m1[j] * (qb[j] - cb[j]), vc = cd[j] + T.m2[j] * (qd[j] - cd[j]);
                    const float zz = -(T.w0[j] + dw[j]); const float sp = fmaxf(zz, 0.f) + __logf(1.0f + __expf(-fabsf(zz)));
                    wv4[j] = __expf(-__expf(-sp - 0.5f));
                    const float a = sigmoidf_(T.a0[j] + da[j]);
                    vv[j] = vc + (vf[j] - vc) * sigmoidf_(T.v0[j] + dv[j]);
                    const float kk = kc * T.kkw[j] * inv; av[j] = -kk; bv[j] = kk * a;
                    ktv[j] = kc * (1.0f + (a - 1.0f) * T.kaw[j]); qv[j] = rc;
                    br += bv[j] * rc; kr += ktv[j] * rc; rkr += rc * ktv[j] * T.rk[j]; }
                float gfin[4];
#pragma unroll
                for (int j = 0; j < 4; ++j) { float g = wv4[j];
                    g *= dpp_shr_or1<1>(g); g *= dpp_shr_or1<2>(g); g *= dpp_shr_or1<4>(g); g *= dpp_shr_or1<8>(g);
                    const float gp = dpp_shr_or1<1>(g), ig = frcp(g);
                    av[j] *= gp; qv[j] *= g; bv[j] *= ig; ktv[j] *= ig; gfin[j] = g; }
                if (l15 == 15) *(f32x4*)(GTB + ((size_t)it * 24 + hh) * 64 + (cc - hh * 64)) = (f32x4){gfin[0], gfin[1], gfin[2], gfin[3]};
                const u32x2 ta = (u32x2){pk2(av[0], av[1]), pk2(av[2], av[3])}, tb = (u32x2){pk2(bv[0], bv[1]), pk2(bv[2], bv[3])}, tk = (u32x2){pk2(ktv[0], ktv[1]), pk2(ktv[2], ktv[3])};
                const u32x2 tq = (u32x2){pk2(qv[0], qv[1]), pk2(qv[2], qv[3])}, tv = (u32x2){pk2(vv[0], vv[1]), pk2(vv[2], vv[3])};
                if ((ct & 1) == 0) { st_g = gw; st_a = ta; st_b = tb; st_k = tk; st_q = tq; st_v = tv; }
                else { const size_t o8 = row * DMIX + cc - 4;
                    *(u32x4*)(SG + o8) = (u32x4){st_g.x, st_g.y, gw.x, gw.y}; *(u32x4*)(SA + o8) = (u32x4){st_a.x, st_a.y, ta.x, ta.y}; *(u32x4*)(SB + o8) = (u32x4){st_b.x, st_b.y, tb.x, tb.y};
                    *(u32x4*)(SK + o8) = (u32x4){st_k.x, st_k.y, tk.x, tk.y}; *(u32x4*)(SQ + o8) = (u32x4){st_q.x, st_q.y, tq.x, tq.y}; *(u32x4*)(SV + o8) = (u32x4){st_v.x, st_v.y, tv.x, tv.y}; } };
            do_tile(0, TA); __builtin_amdgcn_sched_barrier(0);
            do_tile(1, TA); __builtin_amdgcn_sched_barrier(0);
            load_tile(2, TA); do_tile(2, TA); __builtin_amdgcn_sched_barrier(0);
            do_tile(3, TA);
            br += __shfl_xor(br, 16); br += __shfl_xor(br, 32); kr += __shfl_xor(kr, 16); kr += __shfl_xor(kr, 32); rkr += __shfl_xor(rkr, 16); rkr += __shfl_xor(rkr, 32);
            if (quad == 0) *(f32x4*)(BRKR + (row * 24 + hh) * 4) = (f32x4){br, kr, rkr, 0.f};
        }
        if (tl0 == 496) { for (int e = c.tid; e < RW_SHIFT; e += 512) PTw[(size_t)b * RW_SHIFT + e] = P1[(size_t)(r0 + 15) * P1W + e]; }
    }
}

__device__ __forceinline__ void rwkv_item(const P& p, const Ctx& c, int seg, int w, bool save) {
    const int b = w / 24, hh = w % 24;
    const float* SW = (const float*)(c.seg + S1_W); const bf16_t* SA = (const bf16_t*)(c.seg + S1_A); const bf16_t* SB = (const bf16_t*)(c.seg + S1_B); const bf16_t* SK = (const bf16_t*)(c.seg + S1_K);
    const bf16_t* SQ = (const bf16_t*)(c.seg + S1_Q); const bf16_t* SV = (const bf16_t*)(c.seg + S1_V); const float* BRKR = (const float*)(c.seg + S1_BRKR);
    float* O = (float*)(c.seg + S1_O); float* RST = (float*)(p.ws + OFF_RST) + (size_t)w * 4096;
    constexpr int TB = 32, REC = 388;
    LAS float* L0 = (LAS float*)c.lds;
    const int rp = c.wv * 4 + (c.lane >> 4), cq = c.lane & 15;
    f32x2 S0a, S0b, S1a, S1b;
    if (seg > 0) { const f32x4 s0 = *(const f32x4*)(RST + (2 * rp) * 64 + cq * 4), s1 = *(const f32x4*)(RST + (2 * rp + 1) * 64 + cq * 4);
        S0a = (f32x2){s0[0], s0[1]}; S0b = (f32x2){s0[2], s0[3]}; S1a = (f32x2){s1[0], s1[1]}; S1b = (f32x2){s1[2], s1[3]}; }
    else { S0a = S0b = S1a = S1b = (f32x2){0.f, 0.f}; }
    const int e4 = c.tid * 4, stt = e4 >> 6, scc = e4 & 63;
    f32x4 gw; u32x2 ga, gb, gk, gq, gv; f32x4 gbr;
    auto gload = [&](int blk) { const size_t go = ((size_t)b * SEGT + blk * TB + stt) * DMIX + hh * 64 + scc;
        gw = *(const f32x4*)(SW + go); ga = *(const u32x2*)(SA + go); gb = *(const u32x2*)(SB + go); gk = *(const u32x2*)(SK + go); gq = *(const u32x2*)(SQ + go); gv = *(const u32x2*)(SV + go);
        if (c.tid < TB) gbr = *(const f32x4*)(BRKR + (((size_t)b * SEGT + blk * TB + c.tid) * 24 + hh) * 4); };
    auto lstore = [&](int buf) { LAS float* r = L0 + buf * (TB * REC) + stt * REC + scc;
        *(LAS f32x4*)(r) = gw; *(LAS f32x4*)(r + 64) = (f32x4){bflo(ga.x), bfhi(ga.x), bflo(ga.y), bfhi(ga.y)}; *(LAS f32x4*)(r + 128) = (f32x4){bflo(gb.x), bfhi(gb.x), bflo(gb.y), bfhi(gb.y)};
        *(LAS f32x4*)(r + 192) = (f32x4){bflo(gk.x), bfhi(gk.x), bflo(gk.y), bfhi(gk.y)}; *(LAS f32x4*)(r + 256) = (f32x4){bflo(gq.x), bfhi(gq.x), bflo(gq.y), bfhi(gq.y)};
        *(LAS f32x4*)(r + 320) = (f32x4){bflo(gv.x), bfhi(gv.x), bflo(gv.y), bfhi(gv.y)};
        if (c.tid < TB) { LAS float* q = L0 + buf * (TB * REC) + c.tid * REC + 384; *(LAS f32x2*)q = (f32x2){gbr[0], gbr[1]}; } };
    __syncthreads();
    gload(0); lstore(0);
    __syncthreads();
#pragma unroll 1
    for (int blk = 0; blk < SEGT / TB; ++blk) {
        const int buf = blk & 1;
        if (blk + 1 < SEGT / TB) gload(blk + 1);
        const LAS float* base = L0 + buf * (TB * REC);
        const size_t rowb = (size_t)b * SEGT + blk * TB;
        f32x4 nw4 = *(const LAS f32x4*)(base + cq * 4), na4 = *(const LAS f32x4*)(base + 64 + cq * 4), nb4 = *(const LAS f32x4*)(base + 128 + cq * 4), nk4 = *(const LAS f32x4*)(base + 192 + cq * 4), nq4 = *(const LAS f32x4*)(base + 256 + cq * 4);
        f32x2 nv2 = *(const LAS f32x2*)(base + 320 + 2 * rp), nbk = *(const LAS f32x2*)(base + 384);
#pragma unroll 2
        for (int tt = 0; tt < TB; ++tt) {
            const f32x4 w4 = nw4, a4 = na4, b4 = nb4, k4 = nk4, q4 = nq4; const f32x2 v2 = nv2, bk = nbk;
            { const LAS float* r = base + (tt + 1 < TB ? tt + 1 : tt) * REC;
              nw4 = *(const LAS f32x4*)(r + cq * 4); na4 = *(const LAS f32x4*)(r + 64 + cq * 4); nb4 = *(const LAS f32x4*)(r + 128 + cq * 4); nk4 = *(const LAS f32x4*)(r + 192 + cq * 4); nq4 = *(const LAS f32x4*)(r + 256 + cq * 4);
              nv2 = *(const LAS f32x2*)(r + 320 + 2 * rp); nbk = *(const LAS f32x2*)(r + 384); }
            const f32x2 wa = (f32x2){w4[0], w4[1]}, wb = (f32x2){w4[2], w4[3]}, aa = (f32x2){a4[0], a4[1]}, ab = (f32x2){a4[2], a4[3]}, ba = (f32x2){b4[0], b4[1]}, bb = (f32x2){b4[2], b4[3]};
            const f32x2 ka = (f32x2){k4[0], k4[1]}, kb = (f32x2){k4[2], k4[3]}, qa = (f32x2){q4[0], q4[1]}, qb = (f32x2){q4[2], q4[3]};
            f32x2 t0 = S0a * aa + S0b * ab, t1 = S0a * qa + S0b * qb, t2 = S1a * aa + S1b * ab, t3 = S1a * qa + S1b * qb;
            float pa0 = t0.x + t0.y, pt0 = t1.x + t1.y, pa1 = t2.x + t2.y, pt1 = t3.x + t3.y;
            row16_allsum4(pa0, pa1, pt0, pt1);
            const f32x2 pa0v = (f32x2){pa0, pa0}, pa1v = (f32x2){pa1, pa1}, v0v = (f32x2){v2.x, v2.x}, v1v = (f32x2){v2.y, v2.y};
            S0a = S0a * wa + pa0v * ba + v0v * ka; S0b = S0b * wb + pa0v * bb + v0v * kb;
            S1a = S1a * wa + pa1v * ba + v1v * ka; S1b = S1b * wb + pa1v * bb + v1v * kb;
            if (cq == 0) { const f32x2 y = (f32x2){pt0 + pa0 * bk.x + v2.x * bk.y, pt1 + pa1 * bk.x + v2.y * bk.y};
                *(f32x2*)(O + (rowb + tt) * DMIX + hh * 64 + 2 * rp) = y; }
        }
        if (blk + 1 < SEGT / TB) lstore(buf ^ 1);
        __syncthreads();
    }
    if (!save) return;
    *(f32x4*)(RST + (2 * rp) * 64 + cq * 4) = (f32x4){S0a.x, S0a.y, S0b.x, S0b.y}; *(f32x4*)(RST + (2 * rp + 1) * 64 + cq * 4) = (f32x4){S1a.x, S1a.y, S1b.x, S1b.y};
}

__device__ __forceinline__ void rwkv_chunk_item(const P& p, const Ctx& c, int seg, int w, bool save) {
    const int b = w / 24, hh = w % 24;
    const bf16_t* SA = (const bf16_t*)(c.seg + S1_A); const bf16_t* SB = (const bf16_t*)(c.seg + S1_B); const bf16_t* SK = (const bf16_t*)(c.seg + S1_K);
    const bf16_t* SR = (const bf16_t*)(c.seg + S1_Q); const bf16_t* SV = (const bf16_t*)(c.seg + S1_V); const float* GTB = (const float*)(c.seg + S1_W);
    bf16_t* O = (bf16_t*)(c.seg + S1_O); float* RST = (float*)(p.ws + OFF_RST) + (size_t)w * 4096;
    constexpr int O_EA = 0  , O_EB = 4608  , O_EBT = 9216  , O_UV = 14336  ,
                  O_MT1 = 19456  , O_NT = 20736  , O_MABT = 22016  ,
                  O_GT = 23296  , OPB = 23552;
    LAS unsigned char* OB = c.lds;
    LAS bf16_t* S0I = (LAS bf16_t*)(c.lds + 2 * OPB);
    LAS float* XF = (LAS float*)(c.lds + 2 * OPB + 9216);
    const int l15c = c.lane & 15, quadc = c.lane >> 4;
    f32x4 S[2];
#pragma unroll
    for (int x = 0; x < 2; ++x) { const int ti = c.wv * 2 + x, mt = ti >> 2, nt = ti & 3;
#pragma unroll
        for (int jj = 0; jj < 4; ++jj) S[x][jj] = (seg > 0) ? RST[(mt * 16 + quadc * 4 + jj) * 64 + nt * 16 + l15c] : 0.f; }
    unsigned ga = 0, gb = 0, gk = 0, gr = 0, gv = 0; float gg = 1.f;
    auto gload = [&](int ch, int tidv) { const int t = tidv >> 5, j0 = (tidv & 31) * 2; const size_t go = ((size_t)b * SEGT + ch * 16 + t) * DMIX + hh * 64 + j0;
        ga = *(const unsigned*)(SA + go); gb = *(const unsigned*)(SB + go); gk = *(const unsigned*)(SK + go); gr = *(const unsigned*)(SR + go); gv = *(const unsigned*)(SV + go);
        if (tidv < 64) gg = GTB[((size_t)(b * 32 + ch) * 24 + hh) * 64 + tidv]; };
    auto lstore = [&](int pb, int tidv) { const int t = tidv >> 5, j0 = (tidv & 31) * 2;
        LAS bf16_t* EA = (LAS bf16_t*)(OB + pb * OPB + O_EA); LAS bf16_t* EB = (LAS bf16_t*)(OB + pb * OPB + O_EB); LAS bf16_t* EBT = (LAS bf16_t*)(OB + pb * OPB + O_EBT);
        LAS bf16_t* UV = (LAS bf16_t*)(OB + pb * OPB + O_UV); LAS float* GT = (LAS float*)(OB + pb * OPB + O_GT);
        *(LAS unsigned*)(EA + t * 72 + j0) = ga; *(LAS unsigned*)(EA + (16 + t) * 72 + j0) = gr;
        *(LAS unsigned*)(EB + t * 72 + j0) = gb; *(LAS unsigned*)(EB + (16 + t) * 72 + j0) = gk;
        EBT[j0 * 40 + t] = (bf16_t)(gb & 0xFFFFu); EBT[(j0 + 1) * 40 + t] = (bf16_t)(gb >> 16); EBT[j0 * 40 + 16 + t] = (bf16_t)(gk & 0xFFFFu); EBT[(j0 + 1) * 40 + 16 + t] = (bf16_t)(gk >> 16);
        UV[j0 * 40 + 16 + t] = (bf16_t)(gv & 0xFFFFu); UV[(j0 + 1) * 40 + 16 + t] = (bf16_t)(gv >> 16); UV[j0 * 40 + t] = 0; UV[(j0 + 1) * 40 + t] = 0;
        if (tidv < 64) GT[tidv] = gg; };
    auto gtile = [&](int pb, int l15, int quad) {
        LAS bf16_t* EA = (LAS bf16_t*)(OB + pb * OPB + O_EA); LAS bf16_t* EB = (LAS bf16_t*)(OB + pb * OPB + O_EB);
        LAS bf16_t* MT1 = (LAS bf16_t*)(OB + pb * OPB + O_MT1); LAS bf16_t* NT = (LAS bf16_t*)(OB + pb * OPB + O_NT); LAS float* MABT = (LAS float*)(OB + pb * OPB + O_MABT);
        const int sb = c.wv >> 1, tb = c.wv & 1; f32x4 g = (f32x4){0.f, 0.f, 0.f, 0.f};
#pragma unroll
        for (int kk = 0; kk < 2; ++kk) g = mfma16(*(const LAS bf16x8*)(EB + (sb * 16 + l15) * 72 + kk * 32 + quad * 8), *(const LAS bf16x8*)(EA + (tb * 16 + l15) * 72 + kk * 32 + quad * 8), g);
#pragma unroll
        for (int jj = 0; jj < 4; ++jj) { const int s2 = quad * 4 + jj, tt = l15; const float v = g[jj];
            if (tb == 0) { const float m = (s2 < tt) ? v : 0.f; if (sb == 0) { MABT[tt * 20 + s2] = m; MT1[tt * 40 + s2] = 0; } else MT1[tt * 40 + 16 + s2] = f2bf(m); }
            else { const float m = (s2 <= tt) ? v : 0.f; NT[tt * 40 + sb * 16 + s2] = f2bf(m); } } };
    auto simg = [&](int l15, int quad) {
#pragma unroll
        for (int x = 0; x < 2; ++x) { const int ti = c.wv * 2 + x, mt = ti >> 2, nt = ti & 3;
#pragma unroll
            for (int jj = 0; jj < 4; ++jj) S0I[(mt * 16 + quad * 4 + jj) * 72 + nt * 16 + l15] = f2bf(S[x][jj]); } };
    __syncthreads();
    { int t0 = c.tid; asm volatile("" : "+v"(t0)); gload(0, t0); lstore(0, t0); simg(l15c, quadc); }
    lds_barrier();
    if (c.wv < 4) gtile(0, l15c, quadc);
    { int t1 = c.tid; asm volatile("" : "+v"(t1)); gload(1, t1); }
    const int mtq = c.wv & 3;
#pragma unroll 1
    for (int ch = 0; ch < SEGT / 16; ++ch) {
        const int pb = ch & 1;
        int tidv = c.tid, l15 = l15c, quad = quadc; asm volatile("" : "+v"(tidv), "+v"(l15), "+v"(quad));
        LAS bf16_t* EA = (LAS bf16_t*)(OB + pb * OPB + O_EA); LAS bf16_t* EBT = (LAS bf16_t*)(OB + pb * OPB + O_EBT); LAS bf16_t* UV = (LAS bf16_t*)(OB + pb * OPB + O_UV);
        LAS bf16_t* MT1 = (LAS bf16_t*)(OB + pb * OPB + O_MT1); LAS bf16_t* NT = (LAS bf16_t*)(OB + pb * OPB + O_NT); LAS float* MABT = (LAS float*)(OB + pb * OPB + O_MABT); LAS float* GT = (LAS float*)(OB + pb * OPB + O_GT);
        lds_barrier();
        f32x4 Zt = (f32x4){0.f, 0.f, 0.f, 0.f};
        if (c.wv >= 4) {
            f32x4 Xt = (f32x4){0.f, 0.f, 0.f, 0.f};
#pragma unroll
            for (int kk = 0; kk < 2; ++kk) { const bf16x8 a = *(const LAS bf16x8*)(S0I + (mtq * 16 + l15) * 72 + kk * 32 + quad * 8);
                Xt = mfma16(a, *(const LAS bf16x8*)(EA + l15 * 72 + kk * 32 + quad * 8), Xt); Zt = mfma16(a, *(const LAS bf16x8*)(EA + (16 + l15) * 72 + kk * 32 + quad * 8), Zt); }
            Xt = mfma16(*(const LAS bf16x8*)(UV + (mtq * 16 + l15) * 40 + quad * 8), *(const LAS bf16x8*)(MT1 + l15 * 40 + quad * 8), Xt);
#pragma unroll
            for (int jj = 0; jj < 4; ++jj) XF[(mtq * 16 + quad * 4 + jj) * 17 + l15] = Xt[jj];
        }
        lds_barrier();
        if (ch + 1 < SEGT / 16) lstore(pb ^ 1, tidv);
        if (ch + 2 < SEGT / 16) gload(ch + 2, tidv);
        if (c.wv == 0) {
            float u[16];
#pragma unroll
            for (int tt = 0; tt < 16; ++tt) { float acc = XF[c.lane * 17 + tt];
#pragma unroll
                for (int s4 = 0; s4 < (tt + 3) / 4; ++s4) { const f32x4 m = *(const LAS f32x4*)(MABT + tt * 20 + s4 * 4);
#pragma unroll
                    for (int e = 0; e < 4; ++e) if (s4 * 4 + e < tt) acc += u[s4 * 4 + e] * m[e]; }
                u[tt] = acc; }
            *(LAS u32x4*)(UV + c.lane * 40) = (u32x4){pk2(u[0], u[1]), pk2(u[2], u[3]), pk2(u[4], u[5]), pk2(u[6], u[7])};
            *(LAS u32x4*)(UV + c.lane * 40 + 8) = (u32x4){pk2(u[8], u[9]), pk2(u[10], u[11]), pk2(u[12], u[13]), pk2(u[14], u[15])};
        }
        lds_barrier();
        if (c.wv >= 4) {
            Zt = mfma16(*(const LAS bf16x8*)(UV + (mtq * 16 + l15) * 40 + quad * 8), *(const LAS bf16x8*)(NT + l15 * 40 + quad * 8), Zt);
            *(u32x2*)(O + ((size_t)b * SEGT + ch * 16 + l15) * DMIX + hh * 64 + mtq * 16 + quad * 4) = (u32x2){pk2(Zt[0], Zt[1]), pk2(Zt[2], Zt[3])};
        }
#pragma unroll
        for (int x = 0; x < 2; ++x) { const int ti = c.wv * 2 + x, mt = ti >> 2, nt = ti & 3;
            S[x] = mfma16(*(const LAS bf16x8*)(UV + (mt * 16 + l15) * 40 + quad * 8), *(const LAS bf16x8*)(EBT + (nt * 16 + l15) * 40 + quad * 8), S[x]);
            const float gt = GT[nt * 16 + l15];
#pragma unroll
            for (int jj = 0; jj < 4; ++jj) S[x][jj] *= gt; }
        simg(l15, quad);
        if (c.wv < 4 && ch + 1 < SEGT / 16) gtile(pb ^ 1, l15, quad);
    }
    if (!save) return;
#pragma unroll
    for (int x = 0; x < 2; ++x) { const int ti = c.wv * 2 + x, mt = ti >> 2, nt = ti & 3;
#pragma unroll
        for (int jj = 0; jj < 4; ++jj) RST[(mt * 16 + quadc * 4 + jj) * 64 + nt * 16 + l15c] = S[x][jj]; }
}

__device__ __forceinline__ void phase_b3(const P& p, const Ctx& c) {
    const bf16_t* O = (const bf16_t*)(c.seg + S1_O); const bf16_t* P2 = (const bf16_t*)(c.seg + S1_P2); const bf16_t* SV = (const bf16_t*)(c.seg + S1_V); const bf16_t* SG = (const bf16_t*)(c.seg + S1_G);
    const float* BRKR = (const float*)(c.seg + S1_BRKR); const bf16_t* YM = (const bf16_t*)(c.seg + S1_YMEM); bf16_t* Y = (bf16_t*)(c.seg + S1_Y);
    for (int r = c.bid * 8 + c.wv; r < MS; r += c.G * 8) {
#pragma unroll
        for (int ps = 0; ps < 3; ++ps) {
            const int hh = ps * 8 + (c.lane >> 3), ch = hh * 64 + (c.lane & 7) * 8;
            const u32x4 orr = *(const u32x4*)(O + (size_t)r * DMIX + ch);
            float v[8] = {bflo(orr.x), bfhi(orr.x), bflo(orr.y), bfhi(orr.y), bflo(orr.z), bfhi(orr.z), bflo(orr.w), bfhi(orr.w)}; float s = 0.f, s2 = 0.f;
#pragma unroll
            for (int j = 0; j < 8; ++j) { s += v[j]; s2 += v[j] * v[j]; }
            s += __shfl_xor(s, 1); s2 += __shfl_xor(s2, 1); s += __shfl_xor(s, 2); s2 += __shfl_xor(s2, 2); s += __shfl_xor(s, 4); s2 += __shfl_xor(s2, 4);
            const float mean = s * (1.0f / 64.0f), var = fmaxf(s2 * (1.0f / 64.0f) - mean * mean, 0.f), rs = rsqrtf(var + 64e-5f);
            const float rkr = BRKR[((size_t)r * 24 + hh) * 4 + 2];
            const u32x4 vr = *(const u32x4*)(SV + (size_t)r * DMIX + ch), gr = *(const u32x4*)(SG + (size_t)r * DMIX + ch), zr = *(const u32x4*)(P2 + (size_t)r * P2W + 512 + ch);
            const float vv[8] = {bflo(vr.x), bfhi(vr.x), bflo(vr.y), bfhi(vr.y), bflo(vr.z), bfhi(vr.z), bflo(vr.w), bfhi(vr.w)};
            const float gg[8] = {bflo(gr.x), bfhi(gr.x), bflo(gr.y), bfhi(gr.y), bflo(gr.z), bfhi(gr.z), bflo(gr.w), bfhi(gr.w)};
            const float zz[8] = {bflo(zr.x), bfhi(zr.x), bflo(zr.y), bfhi(zr.y), bflo(zr.z), bfhi(zr.z), bflo(zr.w), bfhi(zr.w)};
            float y[8];
#pragma unroll
            for (int j = 0; j < 8; ++j) { const float t = ((v[j] - mean) * rs * p.rw_lnx_g[ch + j] + p.rw_lnx_b[ch + j] + rkr * vv[j]) * gg[j]; y[j] = t * siluf_(zz[j]); }
            *(u32x4*)(Y + (size_t)r * DIN + ch) = (u32x4){pk2(y[0], y[1]), pk2(y[2], y[3]), pk2(y[4], y[5]), pk2(y[6], y[7])};
        }
        { const int cm = c.lane * 8; const u32x4 mr = *(const u32x4*)(YM + (size_t)r * DX + cm), zr = *(const u32x4*)(P2 + (size_t)r * P2W + 512 + DMIX + cm);
          const float mm[8] = {bflo(mr.x), bfhi(mr.x), bflo(mr.y), bfhi(mr.y), bflo(mr.z), bfhi(mr.z), bflo(mr.w), bfhi(mr.w)};
          const float zz[8] = {bflo(zr.x), bfhi(zr.x), bflo(zr.y), bfhi(zr.y), bflo(zr.z), bfhi(zr.z), bflo(zr.w), bfhi(zr.w)};
          float y[8];
#pragma unroll
          for (int j = 0; j < 8; ++j) y[j] = mm[j] * siluf_(zz[j]);
          *(u32x4*)(Y + (size_t)r * DIN + DMIX + cm) = (u32x4){pk2(y[0], y[1]), pk2(y[2], y[3]), pk2(y[4], y[5]), pk2(y[6], y[7])}; }
    }
}

__device__ __forceinline__ bool fresh_ctx(Ctx& c, P& p, unsigned char* ws0) { int t = threadIdx.x; asm volatile("" : "+v"(t)); c.tid = t; c.wv = __builtin_amdgcn_readfirstlane(t >> 6); c.lane = t & 63;
    int bb = (int)blockIdx.x, gg = (int)gridDim.x; asm volatile("" : "+s"(bb), "+s"(gg)); c.bid = bb; c.G = gg;
#if defined(__HIP_DEVICE_COMPILE__)
    { typedef const __attribute__((address_space(4))) unsigned long long* KP; KP kp = (KP)__builtin_amdgcn_kernarg_segment_ptr(); asm volatile("" : "+s"(kp));
      typedef __attribute__((address_space(1))) char* GP; char** dst = (char**)&p;
#pragma unroll
      for (int i = 0; i < (int)(sizeof(P) / 8); ++i) dst[i] = (char*)(GP)(kp[i]); }
#endif
    size_t z = 0; asm volatile("" : "+s"(z)); p.ws = ws0 + z; c.seg = ws0 + z + OFF_SEG;
    return true; }
__global__ __launch_bounds__(512) void fwd_megakernel(P p_arg) {
    P p = p_arg;
    extern __shared__ __attribute__((aligned(16))) unsigned char shm[];
    LAS unsigned char* lds = (LAS unsigned char*)shm;
    Ctx c; c.tid = threadIdx.x; c.wv = threadIdx.x >> 6; c.lane = threadIdx.x & 63; c.G = gridDim.x; c.bid = blockIdx.x; c.lds = lds; c.seg = p.ws + OFF_SEG;
    volatile LAS unsigned* st = (volatile LAS unsigned*)(lds + LDS_BYTES - 16);
    if (c.tid == 0) { st[0] = 0u; st[1] = 0u; }
    __syncthreads();
    const XcdBarrier xb = xcd_barrier_post((unsigned*)(p.ws + OFF_BAR), st);
#define GSYNC() do { XcdBarrier _xl = xb; size_t _zz = 0; asm volatile("" : "+s"(_zz)); _xl.bar = xb.bar + _zz; _xl.x = xb_xcc_id();     \
        xcd_barrier(_xl); if (RK == 20) { for (int _q = 1; _q < RN; ++_q) xcd_barrier(_xl); } } while (0)
#ifndef RK
#define RK -1
#endif
#ifndef RN
#define RN 1
#endif
#define NREP(k) ((k) == RK ? RN : 1)
#define PH(k) for (int _r = 0; _r < NREP(k); ++_r) if (fresh_ctx(c, p, p_arg.ws))
#define LASTREP(k) (_r + 1 == NREP(k))
    PH(0) phase0(p, c);
    PH(1) phase_apre(p, c, 0, c.bid, c.G);
    GSYNC();
    for (int seg = 0; seg < NSEG; ++seg) {
        PH(2) { SchedA0 S; S.ws = p.ws; S.seg = c.seg; S.G = c.G; S.c = c.bid; S.nextra = (seg == 0) ? 64 : 0;
          pg8::gemm_phase<pg8::EpiBf, SchedA0>(lds, c.tid, 1024, 1024, S, pg8::EpiBf{}); }
        GSYNC();
        PH(3) phase_a1(p, c, seg);
        GSYNC();
        for (int it0 = c.bid; it0 < 256; it0 += c.G) {
            const int xq = it0 & 7, yq = it0 >> 3; const int it = (yq < 24) ? ((xq * 4 + yq / 6) * 6 + yq % 6) : (192 + (yq - 24) * 8 + xq);
            if (it < 192) { PH(4) mlstm_item(p, c, seg, it, LASTREP(4)); }
            else { PH(5) attn_item(p, c, 0, it - 192, (const bf16_t*)(c.seg + S0_P0) + DMIX, ML_W, (bf16_t*)(c.seg + S0_YMEM)); }
        }
        GSYNC();
        PH(6) phase_a3(p, c, seg);
        GSYNC();
        PH(7) { SchedOut S; S.Y = (const char*)(c.seg + S0_Y); S.W = (const char*)(p.ws + OFF_WO0T); S.slab = (char*)(c.seg + S0_SLAB); S.G = c.G; S.c = c.bid;
          pg8::gemm_phase<pg8::EpiBf, SchedOut>(lds, c.tid, DIN, 512, S, pg8::EpiBf{}); }
        GSYNC();
        PH(8) phase_a5(p, c, seg);
        GSYNC();
        PH(9) { SchedB0 S; S.ws = p.ws; S.seg = c.seg; S.G = c.G; S.c = c.bid;
          pg8::gemm_phase<pg8::EpiBf, SchedB0>(lds, c.tid, 1024, 1024, S, pg8::EpiBf{}); }
        GSYNC();
        PH(10) phase_b1(p, c, seg);
        GSYNC();
        for (int it = c.bid; it < 256; it += c.G) {
            if (it < 192) { PH(11) rwkv_chunk_item(p, c, seg, it, LASTREP(11)); }
            else { PH(5) attn_item(p, c, 1, it - 192, (const bf16_t*)(c.seg + S1_P2), P2W, (bf16_t*)(c.seg + S1_YMEM));
                   if (c.G == 256) { PH(1) if (seg + 1 < NSEG) phase_apre(p, c, seg + 1, it - 192, 64); } }
        }
        GSYNC();
        PH(12) phase_b3(p, c);
        GSYNC();
        PH(13) { SchedOut S; S.Y = (const char*)(c.seg + S1_Y); S.W = (const char*)(p.ws + OFF_WO1T); S.slab = (char*)(c.seg + S1_SLAB); S.G = c.G; S.c = c.bid;
          pg8::gemm_phase<pg8::EpiBf, SchedOut>(lds, c.tid, DIN, 512, S, pg8::EpiBf{}); }
        GSYNC();
        PH(14) phase_b5(p, c, seg);
        if (c.G != 256) { PH(1) if (seg + 1 < NSEG) phase_apre(p, c, seg + 1, c.bid, c.G); GSYNC(); }
    }
}

extern "C" void kernel_launch(void* const* d_in, const int* in_sizes, int n_in, void* d_out, int out_size, void* d_ws, size_t ws_size, hipStream_t stream) {
    static int grid = 0;
    if (grid == 0) {
        int dev = 0, cus = 0, per_cu = 0;
        if (hipGetDevice(&dev) != hipSuccess || hipDeviceGetAttribute(&cus, hipDeviceAttributeMultiprocessorCount, dev) != hipSuccess) { grid = -1; return; }
        if (hipFuncSetAttribute((const void*)fwd_megakernel, hipFuncAttributeMaxDynamicSharedMemorySize, LDS_BYTES) != hipSuccess) { fprintf(stderr, "hipFuncSetAttribute failed\n"); grid = -1; return; }
        if (hipOccupancyMaxActiveBlocksPerMultiprocessor(&per_cu, (const void*)fwd_megakernel, 512, LDS_BYTES) != hipSuccess || per_cu < 1) { fprintf(stderr, "occupancy query: %d\n", per_cu); }
        (void)hipGetLastError();
        grid = cus;
        if (n_in != 31 || ws_size < 256 * MiB) { fprintf(stderr, "unexpected n_in %d / ws %zu\n", n_in, ws_size); grid = -1; return; }
    }
    if (grid < 0) return;
    (void)hipMemsetAsync((char*)d_ws + OFF_BAR, 0, XCD_BAR_WORDS * 4, stream);
    P p{};
    const float** f = (const float**)&p;
    for (int i = 0; i < 31; ++i) f[i] = (const float*)d_in[i];
    p.out = (float*)d_out; p.ws = (unsigned char*)d_ws;
    fwd_megakernel<<<dim3(grid), dim3(512), LDS_BYTES, stream>>>(p);
}
```

```cpp
#include <hip/hip_runtime.h>
#include <cstdio>
#include <cstdint>

#define LAS __attribute__((address_space(3)))
typedef unsigned short bf16_t;
typedef short bf16x8 __attribute__((ext_vector_type(8)));
typedef short bf16x4 __attribute__((ext_vector_type(4)));
typedef float f32x4 __attribute__((ext_vector_type(4)));
typedef float f32x2 __attribute__((ext_vector_type(2)));
typedef unsigned u32x4 __attribute__((ext_vector_type(4)));
typedef unsigned u32x2 __attribute__((ext_vector_type(2)));

constexpr int NB = 8, SEQ = 2048, DM = 1024, NSEG = 4, SEGT = 512, MS = NB * SEGT;
constexpr int DMIX = 1536, DX = 512, DIN = 2048;
constexpr int ML_W = 4096, RW_SHIFT = 4896, RW_W = 7456;
constexpr int P1W = 5120, P2W = 2560;
constexpr size_t MiB = 1u << 20;
constexpr size_t OFF_WT0 = 0, OFF_WT1 = 8 * MiB, OFF_WO0T = 23 * MiB, OFF_WO1T = 27 * MiB, OFF_WKVT = 31 * MiB  ,
                 OFF_KMEM = 35 * MiB  , OFF_LORAT = 43 * MiB, OFF_MISC = 45 * MiB,
                 OFF_CST = 46 * MiB, OFF_NST = 65 * MiB, OFF_RST = 65 * MiB + 512 * 1024, OFF_H = 69 * MiB, OFF_VF = 77 * MiB,
                 OFF_SEG = 89 * MiB, OFF_MEMN = 248 * MiB;
constexpr size_t OFF_BAR = OFF_MISC, OFF_UTAIL = OFF_MISC + 64 * 1024, OFF_PTAIL = OFF_MISC + 256 * 1024;
constexpr size_t S0_P0 = 0, S0_Q = 32 * MiB, S0_K = 44 * MiB, S0_KT = 56 * MiB, S0_VT = 68 * MiB, S0_XC = 80 * MiB, S0_HRAW = 92 * MiB,
                 S0_YMEM = 116 * MiB, S0_Y = 120 * MiB, S0_GATE = 136 * MiB;
constexpr size_t S1_P1 = 0, S1_O = 0, S1_Y = 24 * MiB, S1_P2 = 40 * MiB, S1_W = 60 * MiB, S1_A = 84 * MiB, S1_B = 96 * MiB, S1_K = 108 * MiB,
                 S1_Q = 120 * MiB, S1_V = 132 * MiB, S1_G = 144 * MiB, S1_YMEM = 156 * MiB, S1_BRKR = 160 * MiB;
constexpr size_t S0_SLAB = 0  , S1_SLAB = 84 * MiB  ;
constexpr int LDS_BYTES = 150 * 1024;

struct P {
    const float *x, *mem, *norm_g, *mem_norm_g, *mem_kv_w, *w_out, *ml_w_in, *ml_conv_w, *ml_conv_b, *ml_wq, *ml_wk, *ml_wv, *ml_w_gate, *ml_b_gate,
        *ml_mhn_g, *ml_skip, *rw_w_in, *rw_mu, *rw_w_lora2, *rw_w0, *rw_a_lora2, *rw_a0, *rw_v_lora2, *rw_v0, *rw_g_lora2, *rw_k_k, *rw_k_a, *rw_r_k,
        *rw_lnx_g, *rw_lnx_b, *final_g;
    float* out; unsigned char* ws;
};

__device__ __forceinline__ bf16_t f2bf(float f) { const __bf16 r = (__bf16)f; bf16_t u; __builtin_memcpy(&u, &r, 2); return u; }
__device__ __forceinline__ float bf2f(bf16_t b) { return __uint_as_float(((unsigned)b) << 16); }
typedef __bf16 bf2_t __attribute__((ext_vector_type(2)));
__device__ __forceinline__ unsigned pk2(float lo, float hi) { const bf2_t r = __builtin_convertvector((f32x2){lo, hi}, bf2_t); unsigned u; __builtin_memcpy(&u, &r, 4); return u; }
__device__ __forceinline__ float bflo(unsigned u) { return __uint_as_float(u << 16); }
__device__ __forceinline__ float bfhi(unsigned u) { return __uint_as_float(u & 0xFFFF0000u); }
__device__ __forceinline__ float wsum(float v) {
#pragma unroll
    for (int o = 32; o >= 1; o >>= 1) v += __shfl_xor(v, o);
    return v;
}
__device__ __forceinline__ float frcp(float x) { return __builtin_amdgcn_rcpf(x); }
__device__ __forceinline__ float sigmoidf_(float x) { return frcp(1.0f + __expf(-x)); }
__device__ __forceinline__ float siluf_(float x) { return x * frcp(1.0f + __expf(-x)); }
__device__ __forceinline__ float softplusf_(float z) { return fmaxf(z, 0.f) + __logf(1.0f + __expf(-fabsf(z))); }
template <int CTRL> __device__ __forceinline__ float dpp_add(float v) {
    return v + __int_as_float(__builtin_amdgcn_update_dpp(0, __float_as_int(v), CTRL, 0xF, 0xF, true));
}
__device__ __forceinline__ float row16_allsum(float v) {
    v = dpp_add<0xB1>(v);
    v = dpp_add<0x4E>(v);
    v = dpp_add<0x141>(v);
    v = dpp_add<0x140>(v);
    return v;
}
__device__ __forceinline__ void row16_allsum4(float& a, float& b, float& c, float& d) {
    asm volatile("s_nop 1\n\t"
        "v_add_f32_dpp %0, %0, %0 quad_perm:[1,0,3,2] row_mask:0xf bank_mask:0xf\n\t" "v_add_f32_dpp %1, %1, %1 quad_perm:[1,0,3,2] row_mask:0xf bank_mask:0xf\n\t"
        "v_add_f32_dpp %2, %2, %2 quad_perm:[1,0,3,2] row_mask:0xf bank_mask:0xf\n\t" "v_add_f32_dpp %3, %3, %3 quad_perm:[1,0,3,2] row_mask:0xf bank_mask:0xf\n\t"
        "v_add_f32_dpp %0, %0, %0 quad_perm:[2,3,0,1] row_mask:0xf bank_mask:0xf\n\t" "v_add_f32_dpp %1, %1, %1 quad_perm:[2,3,0,1] row_mask:0xf bank_mask:0xf\n\t"
        "v_add_f32_dpp %2, %2, %2 quad_perm:[2,3,0,1] row_mask:0xf bank_mask:0xf\n\t" "v_add_f32_dpp %3, %3, %3 quad_perm:[2,3,0,1] row_mask:0xf bank_mask:0xf\n\t"
        "v_add_f32_dpp %0, %0, %0 row_half_mirror row_mask:0xf bank_mask:0xf\n\t" "v_add_f32_dpp %1, %1, %1 row_half_mirror row_mask:0xf bank_mask:0xf\n\t"
        "v_add_f32_dpp %2, %2, %2 row_half_mirror row_mask:0xf bank_mask:0xf\n\t" "v_add_f32_dpp %3, %3, %3 row_half_mirror row_mask:0xf bank_mask:0xf\n\t"
        "v_add_f32_dpp %0, %0, %0 row_mirror row_mask:0xf bank_mask:0xf\n\t" "v_add_f32_dpp %1, %1, %1 row_mirror row_mask:0xf bank_mask:0xf\n\t"
        "v_add_f32_dpp %2, %2, %2 row_mirror row_mask:0xf bank_mask:0xf\n\t" "v_add_f32_dpp %3, %3, %3 row_mirror row_mask:0xf bank_mask:0xf\n\t"
        "s_nop 1"
        : "+v"(a), "+v"(b), "+v"(c), "+v"(d));
}
template <int N> __device__ __forceinline__ float dpp_shr_or1(float v) {
    return __int_as_float(__builtin_amdgcn_update_dpp(0x3f800000, __float_as_int(v), 0x110 + N, 0xF, 0xF, false));
}
__device__ __forceinline__ f32x4 mfma16(bf16x8 a, bf16x8 b, f32x4 c) { return __builtin_amdgcn_mfma_f32_16x16x32_bf16(a, b, c, 0, 0, 0); }

namespace pg8 {
constexpr int BM = 256, BK = 64, HALF = 128, HTB = HALF * BK * 2, STAGE_BYTES = 8 * HTB, NXCD = 8, WGM = 8;
__host__ __device__ __forceinline__ int lds_byte(int r, int c) { const int st = (r >> 4) * 2 + (c >> 5), rr = r & 15, cc = c & 31, ob = rr * 64 + cc * 2; return st * 1024 + (ob ^ (((ob >> 9) & 1) << 5)); }
__host__ __device__ __forceinline__ void stage_rc(int b, int& R, int& C) { const int st = b / 1024, sb = b % 1024, swz = sb ^ (((sb >> 9) & 1) << 5); R = (st >> 1) * 16 + swz / 64; C = (st & 1) * 32 + (swz % 64) / 2; }
__host__ __device__ __forceinline__ int perm32(int rho) { const int n = rho >> 4, i = rho & 15; return 8 * (i >> 2) + 4 * n + (i & 3); }

struct Unit { const char* A; const char* B; char* O; int ldc; int pad; };

__device__ __forceinline__ void remap(int wgid, int nM, int nN, int& pm, int& pn) {
    const int nwg = nM * nN;
    { const int q = nwg / NXCD, r = nwg % NXCD, xcd = wgid % NXCD, off = wgid / NXCD; wgid = (xcd < r ? xcd * (q + 1) : r * (q + 1) + (xcd - r) * q) + off; }
    const int nig = WGM * nN, gid = wgid / nig, fm = gid * WGM, gsz = (nM - fm) < WGM ? (nM - fm) : WGM;
    pm = fm + ((wgid % nig) % gsz); pn = (wgid % nig) / gsz;
}

struct EpiBf {
    static constexpr bool PERM = true;
    __device__ __forceinline__ void operator()(const f32x4 (&acc)[2][2][4][2], const Unit& u, int wr, int wc, int fr, int fq) const {
        asm volatile("" : "+v"(fr), "+v"(fq));
        bf16_t* base = (bf16_t*)u.O;
#pragma unroll
        for (int ai = 0; ai < 2; ++ai)
#pragma unroll
            for (int m = 0; m < 4; ++m) { bf16_t* rowp = base + (size_t)(ai * HALF + wr * 64 + m * 16 + fr) * u.ldc + wc * 32 + 8 * fq;
#pragma unroll
                for (int bj = 0; bj < 2; ++bj) { const f32x4 v0 = acc[ai][bj][m][0], v1 = acc[ai][bj][m][1];
                    u32x4 w; w.x = pk2(v0[0], v0[1]); w.y = pk2(v0[2], v0[3]); w.z = pk2(v1[0], v1[1]); w.w = pk2(v1[2], v1[3]);
                    *(u32x4*)(rowp + bj * HALF) = w; } }
    }
};
struct EpiAtomic {
    static constexpr bool PERM = false;
    __device__ __forceinline__ void operator()(const f32x4 (&acc)[2][2][4][2], const Unit& u, int wr, int wc, int fr, int fq) const {
        asm volatile("" : "+v"(fr), "+v"(fq));
        float* base = (float*)u.O;
#pragma unroll
        for (int ai = 0; ai < 2; ++ai)
#pragma unroll
            for (int m = 0; m < 4; ++m) { float* rowp = base + (size_t)(ai * HALF + wr * 64 + m * 16 + fr) * u.ldc + wc * 32 + 4 * fq;
#pragma unroll
                for (int bj = 0; bj < 2; ++bj)
#pragma unroll
                    for (int n = 0; n < 2; ++n) { const f32x4 v = acc[ai][bj][m][n]; float* q = rowp + bj * HALF + n * 16;
#pragma unroll
                        for (int e = 0; e < 4; ++e) (void)__hip_atomic_fetch_add(q + e, v[e], __ATOMIC_RELAXED, __HIP_MEMORY_SCOPE_AGENT); }
                __builtin_amdgcn_sched_barrier(0); }
    }
};

template <class Epi, class Sched>
__device__ __forceinline__ void gemm_phase(LAS unsigned char* lds, const int tid, const int ldk, const int Kloop, const Sched& S, const Epi& E) {
    const int wid = __builtin_amdgcn_readfirstlane(tid >> 6), lane = tid & 63, wr = wid >> 2, wc = wid & 3, fr = lane & 15, fq = lane >> 4;
    const int nt = Kloop / BK;
    unsigned voffA[2], voffB[2];
#pragma unroll
    for (int i = 0; i < 2; ++i) { int R, C; stage_rc(tid * 16 + i * 8192, R, C); const int Rb = Epi::PERM ? ((R & ~31) + perm32(R & 31)) : R;
        voffA[i] = (unsigned)(R * ldk + C) * 2u; voffB[i] = (unsigned)(Rb * ldk + C) * 2u; }
    const size_t kstep = (size_t)(BK * 2);
    const size_t hstep = (size_t)HALF * ldk * 2;
    const unsigned ldsw = (unsigned)wid * 1024u;
    const int aoff = lds_byte(wr * 64 + fr, fq * 8), boff = lds_byte(wc * 32 + fr, fq * 8);
#define PG8_SA(b, h) (((b) * 2 + (h)) * HTB)
#define PG8_SB(b, h) ((4 + (b) * 2 + (h)) * HTB)
#define PG8_STAGE(bufoff, gbase, voff) do { _Pragma("unroll") for (int _i = 0; _i < 2; ++_i) \
        __builtin_amdgcn_global_load_lds((const unsigned*)((const char*)(gbase) + (voff)[_i]), (LAS unsigned*)(lds + (bufoff) + ldsw + _i * 8192), 16, 0, 0); } while (0)
#define PG8_LDA(dst, b, h) do { _Pragma("unroll") for (int m = 0; m < 4; ++m) _Pragma("unroll") for (int k = 0; k < 2; ++k) dst[m][k] = *(const LAS bf16x8*)(lds + PG8_SA(b, h) + aoff + m * 2048 + k * 1024); } while (0)
#define PG8_LDB(dst, b, h) do { _Pragma("unroll") for (int n = 0; n < 2; ++n) _Pragma("unroll") for (int k = 0; k < 2; ++k) dst[n][k] = *(const LAS bf16x8*)(lds + PG8_SB(b, h) + boff + n * 2048 + k * 1024); } while (0)
#define PG8_MMA(ai, bj, At, Bt) do { __builtin_amdgcn_s_setprio(1); _Pragma("unroll") for (int m = 0; m < 4; ++m) _Pragma("unroll") for (int n = 0; n < 2; ++n) _Pragma("unroll") for (int k = 0; k < 2; ++k) \
        acc[ai][bj][m][n] = __builtin_amdgcn_mfma_f32_16x16x32_bf16(Bt[n][k], At[m][k], acc[ai][bj][m][n], 0, 0, 0); __builtin_amdgcn_s_setprio(0); } while (0)
#define PG8_WAIT_V(n) asm volatile("s_waitcnt vmcnt(" #n ")" ::: "memory")
#define PG8_WAIT_L(n) asm volatile("s_waitcnt lgkmcnt(" #n ")" ::: "memory")
#define PG8_BAR __builtin_amdgcn_s_barrier()
#define PG8_SCHED __builtin_amdgcn_sched_barrier(0)
    Unit cur, nxt; int ui = 0;
    if (!S.next(0, cur)) return;
    f32x4 acc[2][2][4][2];
#pragma unroll
    for (int a = 0; a < 2; ++a)
#pragma unroll
        for (int b = 0; b < 2; ++b)
#pragma unroll
            for (int m = 0; m < 4; ++m)
#pragma unroll
                for (int n = 0; n < 2; ++n) acc[a][b][m][n] = (f32x4){0.f, 0.f, 0.f, 0.f};
    bf16x8 At[4][2], B0[2][2], B1[2][2];
    const char* cA = cur.A; const char* cB = cur.B;
    PG8_STAGE(PG8_SB(0, 0), cB, voffB); PG8_STAGE(PG8_SA(0, 0), cA, voffA); PG8_STAGE(PG8_SB(0, 1), cB + hstep, voffB); PG8_STAGE(PG8_SA(0, 1), cA + hstep, voffA);
    if (wr == 1) PG8_BAR;
    PG8_WAIT_V(4); PG8_BAR;
    PG8_STAGE(PG8_SB(1, 0), cB + kstep, voffB); PG8_STAGE(PG8_SA(1, 0), cA + kstep, voffA); PG8_STAGE(PG8_SB(1, 1), cB + hstep + kstep, voffB);
    PG8_WAIT_V(6); PG8_BAR;
    for (;;) {
        const bool has_next = S.next(ui + 1, nxt);
        const char* nA = has_next ? nxt.A : cA; const char* nB = has_next ? nxt.B : cB;
        for (int t = 0; t < nt; t += 2) {
            const bool last = (t == nt - 2);
            const char* a1 = cA + (size_t)(t + 1) * kstep;
            const char* a2 = last ? nA : cA + (size_t)(t + 2) * kstep; const char* b2 = last ? nB : cB + (size_t)(t + 2) * kstep;
            const char* a3 = a2 + kstep; const char* b3 = b2 + kstep;
            PG8_LDB(B0, 0, 0); PG8_SCHED; PG8_LDA(At, 0, 0); PG8_STAGE(PG8_SA(1, 1), a1 + hstep, voffA);
            PG8_WAIT_L(8); PG8_BAR; PG8_WAIT_L(0); PG8_MMA(0, 0, At, B0); PG8_BAR; PG8_SCHED;
            PG8_LDB(B1, 0, 1); PG8_STAGE(PG8_SB(0, 0), b2, voffB);
            PG8_BAR; PG8_WAIT_L(0); PG8_MMA(0, 1, At, B1); PG8_BAR;
            PG8_LDA(At, 0, 1); PG8_STAGE(PG8_SA(0, 0), a2, voffA);
            PG8_BAR; PG8_WAIT_L(0); PG8_MMA(1, 0, At, B0); PG8_BAR; PG8_SCHED;
            PG8_STAGE(PG8_SB(0, 1), b2 + hstep, voffB);
            PG8_WAIT_V(6); PG8_BAR; PG8_MMA(1, 1, At, B1); PG8_BAR;
            PG8_LDB(B0, 1, 0); PG8_SCHED; PG8_LDA(At, 1, 0); PG8_STAGE(PG8_SA(0, 1), a2 + hstep, voffA);
            PG8_WAIT_L(8); PG8_BAR; PG8_WAIT_L(0); PG8_MMA(0, 0, At, B0); PG8_BAR; PG8_SCHED;
            PG8_LDB(B1, 1, 1); PG8_STAGE(PG8_SB(1, 0), b3, voffB);
            PG8_BAR; PG8_WAIT_L(0); PG8_MMA(0, 1, At, B1); PG8_BAR;
            PG8_LDA(At, 1, 1); PG8_STAGE(PG8_SA(1, 0), a3, voffA);
            PG8_BAR; PG8_WAIT_L(0); PG8_MMA(1, 0, At, B0); PG8_BAR; PG8_SCHED;
            PG8_STAGE(PG8_SB(1, 1), b3 + hstep, voffB);
            PG8_WAIT_V(6); PG8_BAR; PG8_MMA(1, 1, At, B1); PG8_BAR;
        }
        E(acc, cur, wr, wc, fr, fq);
        if (!has_next) break;
#pragma unroll
        for (int a = 0; a < 2; ++a)
#pragma unroll
            for (int b = 0; b < 2; ++b)
#pragma unroll
                for (int m = 0; m < 4; ++m)
#pragma unroll
                    for (int n = 0; n < 2; ++n) acc[a][b][m][n] = (f32x4){0.f, 0.f, 0.f, 0.f};
        cur = nxt; cA = nA; cB = nB; ++ui;
    }
    PG8_WAIT_V(0);
    if (wr == 0) PG8_BAR;
    PG8_BAR;
#undef PG8_SA
#undef PG8_SB
#undef PG8_STAGE
#undef PG8_LDA
#undef PG8_LDB
#undef PG8_MMA
#undef PG8_WAIT_V
#undef PG8_WAIT_L
#undef PG8_BAR
#undef PG8_SCHED
}
}

#define XB_TMO      128
#define XB_XCNT(j)  (256  + 64 * (j))
#define XB_XSUB(j)  (1280 + 64 * (j))
#define XB_XGEN(j)  (2304 + 64 * (j))
#define XB_TOP      3328
#define XB_TOPGEN   3392
#define XCD_BAR_WORDS 3456
#define XB_SPIN_CAP (1u << 18)
__device__ __forceinline__ unsigned xb_ld(unsigned* p)              { return __hip_atomic_load(p, __ATOMIC_RELAXED, __HIP_MEMORY_SCOPE_AGENT); }
__device__ __forceinline__ unsigned xb_add(unsigned* p, unsigned v) { return __hip_atomic_fetch_add(p, v, __ATOMIC_RELAXED, __HIP_MEMORY_SCOPE_AGENT); }
__device__ __forceinline__ unsigned xb_xcc_id() { return (unsigned)__builtin_amdgcn_s_getreg((3 << 11) | 20) & 0xFu; }
#define XB_SPIN(cond, bar) do { unsigned _sp = 0; while (cond) { __builtin_amdgcn_s_sleep(1); \
    if ((++_sp & 255u) == 0u) { if (xb_ld(&(bar)[XB_TMO])) break; if (_sp > XB_SPIN_CAP) { atomicAdd(&(bar)[XB_TMO], 1u); break; } } } } while (0)
struct XcdBarrier { unsigned* bar; unsigned x; volatile LAS unsigned* st; };
__device__ __forceinline__ XcdBarrier xcd_barrier_post(unsigned* bar, volatile LAS unsigned* st) {
    XcdBarrier b; b.bar = bar; b.x = xb_xcc_id(); b.st = st;
    if (threadIdx.x == 0) (void)xb_add(&bar[XB_XCNT(b.x)], 1u);
    return b;
}
__device__ __forceinline__ void xcd_barrier_complete(unsigned* bar, unsigned x, unsigned& nloc, unsigned& nx) {
    const unsigned G = gridDim.x * gridDim.y * gridDim.z;
    unsigned sum, cnt, mine, sp = 0u;
    for (;;) {
        sum = 0u; cnt = 0u; mine = 0u;
#pragma unroll
        for (unsigned j = 0; j < 16; ++j) { const unsigned c = xb_ld(&bar[XB_XCNT(j)]); sum += c; cnt += (c > 0u) ? 1u : 0u; mine = (j == x) ? c : mine; }
        if (sum == G) break;
        __builtin_amdgcn_s_sleep(1);
        if ((++sp & 255u) == 0u) { if (xb_ld(&bar[XB_TMO])) break; if (sp > XB_SPIN_CAP) { atomicAdd(&bar[XB_TMO], 1u); break; } }
    }
    nloc = mine > 0u ? mine : 1u; nx = cnt > 0u ? cnt : 1u;
}
__device__ __forceinline__ void xcd_barrier(const XcdBarrier& b) {
    asm volatile("s_waitcnt vmcnt(0)" ::: "memory");
    __syncthreads();
    int tid0 = threadIdx.x; asm volatile("" : "+v"(tid0));
    if (tid0 == 0) {
        unsigned* bar = b.bar;
        __builtin_amdgcn_s_waitcnt(0);
        unsigned nloc = b.st[0], nx = b.st[1];
        if (nloc == 0u) { xcd_barrier_complete(bar, b.x, nloc, nx); b.st[0] = nloc; b.st[1] = nx; }
        const unsigned old = xb_add(&bar[XB_XSUB(b.x)], 1u);
        const unsigned gen = old / nloc;
        if (old + 1u == (gen + 1u) * nloc) {
            __builtin_amdgcn_fence(__ATOMIC_RELEASE, "agent");
            asm volatile("s_waitcnt vmcnt(0)" ::: "memory");
            const unsigned og = xb_add(&bar[XB_TOP], 1u);
            const unsigned tg = og / nx;
            if (og + 1u == (tg + 1u) * nx) xb_add(&bar[XB_TOPGEN], 1u);
            else XB_SPIN(xb_ld(&bar[XB_TOPGEN]) == tg, bar);
            __builtin_amdgcn_fence(__ATOMIC_ACQUIRE, "agent");
            xb_add(&bar[XB_XGEN(b.x)], 1u);
            asm volatile("s_waitcnt vmcnt(0)" ::: "memory");
        } else {
            XB_SPIN(xb_ld(&bar[XB_XGEN(b.x)]) == gen, bar);
            __builtin_amdgcn_fence(__ATOMIC_ACQUIRE, "agent");
            asm volatile("s_waitcnt vmcnt(0)" ::: "memory");
        }
    }
    __syncthreads();
}

__device__ __forceinline__ void lds_barrier() { asm volatile("s_waitcnt lgkmcnt(0)" ::: "memory"); __builtin_amdgcn_s_barrier(); asm volatile("" ::: "memory"); }
struct Ctx { int tid, wv, lane, G, bid; LAS unsigned char* lds; unsigned char* seg; };

template <int MODE>
__device__ __forceinline__ void convT_tile(const Ctx& c, const float* src, int ldsrc, int Ksrc, int k0, int n0, bf16_t* dst, int ldd, int koff) {
    LAS float* tile = (LAS float*)c.lds;
    __syncthreads();
#pragma unroll
    for (int rep = 0; rep < 2; ++rep) {
        const int i = (c.tid >> 4) + 32 * rep, j4 = (c.tid & 15) * 4; const int n = n0 + j4; int sc = n;
        if (MODE == 1) sc = (n < RW_SHIFT) ? n : (n < P1W ? -1 : n - (P1W - RW_SHIFT));
        f32x4 v = (f32x4){0.f, 0.f, 0.f, 0.f};
        if (sc >= 0 && (k0 + i) < Ksrc) v = *(const f32x4*)(src + (size_t)(k0 + i) * ldsrc + sc);
        tile[i * 65 + j4 + 0] = v[0]; tile[i * 65 + j4 + 1] = v[1]; tile[i * 65 + j4 + 2] = v[2]; tile[i * 65 + j4 + 3] = v[3];
    }
    __syncthreads();
    { const int j = c.tid >> 3, i8 = (c.tid & 7) * 8;
      if (k0 + i8 < Ksrc) {
        u32x4 w; w.x = pk2(tile[(i8 + 0) * 65 + j], tile[(i8 + 1) * 65 + j]); w.y = pk2(tile[(i8 + 2) * 65 + j], tile[(i8 + 3) * 65 + j]);
        w.z = pk2(tile[(i8 + 4) * 65 + j], tile[(i8 + 5) * 65 + j]); w.w = pk2(tile[(i8 + 6) * 65 + j], tile[(i8 + 7) * 65 + j]);
        *(u32x4*)(dst + (size_t)(n0 + j) * ldd + koff + k0 + i8) = w; } }
}

__device__ __forceinline__ void rms_row_bf16(const float* src, const float* g, bf16_t* dst, int lane) {
    f32x4 v[4]; float ss = 0.f;
#pragma unroll
    for (int i = 0; i < 4; ++i) { v[i] = *(const f32x4*)(src + i * 256 + lane * 4); ss += v[i][0] * v[i][0] + v[i][1] * v[i][1] + v[i][2] * v[i][2] + v[i][3] * v[i][3]; }
    ss = wsum(ss); const float rs = rsqrtf(ss * (1.0f / 1024.0f) + 1e-6f);
#pragma unroll
    for (int i = 0; i < 4; ++i) { const f32x4 gg = *(const f32x4*)(g + i * 256 + lane * 4);
        u32x2 w; w.x = pk2(v[i][0] * rs * gg[0], v[i][1] * rs * gg[1]); w.y = pk2(v[i][2] * rs * gg[2], v[i][3] * rs * gg[3]);
        *(u32x2*)(dst + i * 256 + lane * 4) = w; }
}
__device__ __forceinline__ float add_slabs(const float* src, const bf16_t* slab, int r, int lane, f32x4 (&v)[4]) {
    float ss = 0.f;
#pragma unroll
    for (int i = 0; i < 4; ++i) { v[i] = *(const f32x4*)(src + i * 256 + lane * 4);
#pragma unroll
        for (int ks = 0; ks < 4; ++ks) { const u32x2 t = *(const u32x2*)(slab + ((size_t)ks * MS + r) * DM + i * 256 + lane * 4);
            v[i][0] += bflo(t.x); v[i][1] += bfhi(t.x); v[i][2] += bflo(t.y); v[i][3] += bfhi(t.y); }
        ss += v[i][0] * v[i][0] + v[i][1] * v[i][1] + v[i][2] * v[i][2] + v[i][3] * v[i][3]; }
    return wsum(ss);
}

__device__ __forceinline__ void phase_apre(const P& p, const Ctx& c, int seg, int wg, int nwg) {
    bf16_t* H = (bf16_t*)(p.ws + OFF_H);
    for (int r = wg * 8 + c.wv; r < MS; r += nwg * 8) { const int b = r >> 9, tl = r & 511; const size_t grow = (size_t)b * SEQ + seg * SEGT + tl;
        rms_row_bf16(p.x + grow * DM, p.norm_g, H + (size_t)r * DM, c.lane); }
}
__device__ __forceinline__ void phase_a5(const P& p, const Ctx& c, int seg) {
    bf16_t* H = (bf16_t*)(p.ws + OFF_H); const bf16_t* slab = (const bf16_t*)(c.seg + S0_SLAB);
    for (int r = c.bid * 8 + c.wv; r < MS / 2; r += c.G * 8) {
        const int ra = r, rb = r + MS / 2;
        const size_t ga = (size_t)(ra >> 9) * SEQ + seg * SEGT + (ra & 511), gb = (size_t)(rb >> 9) * SEQ + seg * SEGT + (rb & 511);
        f32x4 va[4], vb[4]; const float sa = add_slabs(p.x + ga * DM, slab, ra, c.lane, va); const float sb = add_slabs(p.x + gb * DM, slab, rb, c.lane, vb);
        const float rsa = rsqrtf(sa * (1.0f / 1024.0f) + 1e-6f), rsb = rsqrtf(sb * (1.0f / 1024.0f) + 1e-6f);
#pragma unroll
        for (int i = 0; i < 4; ++i) { const f32x4 gg = *(const f32x4*)(p.norm_g + DM + i * 256 + c.lane * 4);
            *(f32x4*)(p.out + ga * DM + i * 256 + c.lane * 4) = va[i]; *(f32x4*)(p.out + gb * DM + i * 256 + c.lane * 4) = vb[i];
            u32x2 w; w.x = pk2(va[i][0] * rsa * gg[0], va[i][1] * rsa * gg[1]); w.y = pk2(va[i][2] * rsa * gg[2], va[i][3] * rsa * gg[3]);
            *(u32x2*)(H + (size_t)ra * DM + i * 256 + c.lane * 4) = w;
            w.x = pk2(vb[i][0] * rsb * gg[0], vb[i][1] * rsb * gg[1]); w.y = pk2(vb[i][2] * rsb * gg[2], vb[i][3] * rsb * gg[3]);
            *(u32x2*)(H + (size_t)rb * DM + i * 256 + c.lane * 4) = w; } }
}
__device__ __forceinline__ void phase_b5(const P& p, const Ctx& c, int seg) {
    const bf16_t* slab = (const bf16_t*)(c.seg + S1_SLAB);
    for (int r = c.bid * 8 + c.wv; r < MS / 2; r += c.G * 8) {
        const int ra = r, rb = r + MS / 2;
        float* rowa = p.out + ((size_t)(ra >> 9) * SEQ + seg * SEGT + (ra & 511)) * DM; float* rowb = p.out + ((size_t)(rb >> 9) * SEQ + seg * SEGT + (rb & 511)) * DM;
        f32x4 va[4], vb[4]; const float sa = add_slabs(rowa, slab, ra, c.lane, va); const float sb = add_slabs(rowb, slab, rb, c.lane, vb);
        const float rsa = rsqrtf(sa * (1.0f / 1024.0f) + 1e-6f), rsb = rsqrtf(sb * (1.0f / 1024.0f) + 1e-6f);
#pragma unroll
        for (int i = 0; i < 4; ++i) { const f32x4 gg = *(const f32x4*)(p.final_g + i * 256 + c.lane * 4); f32x4 o;
            o[0] = va[i][0] * rsa * gg[0]; o[1] = va[i][1] * rsa * gg[1]; o[2] = va[i][2] * rsa * gg[2]; o[3] = va[i][3] * rsa * gg[3]; *(f32x4*)(rowa + i * 256 + c.lane * 4) = o;
            o[0] = vb[i][0] * rsb * gg[0]; o[1] = vb[i][1] * rsb * gg[1]; o[2] = vb[i][2] * rsb * gg[2]; o[3] = vb[i][3] * rsb * gg[3]; *(f32x4*)(rowb + i * 256 + c.lane * 4) = o; } }
}

__device__ __forceinline__ void phase0(const P& p, const Ctx& c) {
    const int T0 = 16 * 64, T1 = 16 * 120, T2 = 32 * 16, T3 = 32 * 16, T4 = 16 * 16, T5 = 16 * 16, T6 = 24 * 5;
    const int TT = T0 + T1 + T2 + T3 + T4 + T5 + T6;
    for (int t = c.bid; t < TT; t += c.G) {
        int u = t;
        if (u < T0) { convT_tile<0>(c, p.ml_w_in, ML_W, 1024, (u & 15) * 64, (u >> 4) * 64, (bf16_t*)(p.ws + OFF_WT0), 1024, 0); continue; } u -= T0;
        if (u < T1) { convT_tile<1>(c, p.rw_w_in, RW_W, 1024, (u & 15) * 64, (u >> 4) * 64, (bf16_t*)(p.ws + OFF_WT1), 1024, 0); continue; } u -= T1;
        if (u < T2) { convT_tile<0>(c, p.w_out, DM, 2048, (u & 31) * 64, (u >> 5) * 64, (bf16_t*)(p.ws + OFF_WO0T), 2048, 0); continue; } u -= T2;
        if (u < T3) { convT_tile<0>(c, p.w_out + (size_t)DIN * DM, DM, 2048, (u & 31) * 64, (u >> 5) * 64, (bf16_t*)(p.ws + OFF_WO1T), 2048, 0); continue; } u -= T3;
        if (u < T4) { convT_tile<0>(c, p.mem_kv_w, DM, 1024, (u & 15) * 64, (u >> 4) * 64, (bf16_t*)(p.ws + OFF_WKVT), 1024, 0); continue; } u -= T4;
        if (u < T5) { convT_tile<0>(c, p.mem_kv_w + (size_t)DM * DM, DM, 1024, (u & 15) * 64, (u >> 4) * 64, (bf16_t*)(p.ws + OFF_WKVT + 2 * MiB), 1024, 0); continue; } u -= T5;
        { const int nt = u / 5, j = u % 5; bf16_t* L = (bf16_t*)(p.ws + OFF_LORAT);
          if (j == 0) convT_tile<0>(c, p.rw_w_lora2, DMIX, 64, 0, nt * 64, L, 288, 0);
          else if (j == 1) convT_tile<0>(c, p.rw_a_lora2, DMIX, 64, 0, nt * 64, L, 288, 64);
          else if (j == 2) convT_tile<0>(c, p.rw_v_lora2, DMIX, 32, 0, nt * 64, L, 288, 128);
          else convT_tile<0>(c, p.rw_g_lora2, DMIX, 128, (j - 3) * 64, nt * 64, L, 288, 160); }
    }
    for (int r = c.bid * 8 + c.wv; r < 2 * 2048; r += c.G * 8) { const int l = r >> 11, rr = r & 2047;
        rms_row_bf16(p.mem + (size_t)rr * DM, p.mem_norm_g + l * DM, (bf16_t*)(p.ws + OFF_MEMN) + (size_t)r * DM, c.lane); }
}

struct SchedA0 {
    const unsigned char* ws; unsigned char* seg; int G, c, nextra;
    __device__ __forceinline__ bool next(int i, pg8::Unit& u) const {
        const int L = i * G + c; if (L >= 256 + nextra) return false;
        if (L < 256) { int pm, pn; pg8::remap(L, 16, 16, pm, pn);
            u.A = (const char*)(ws + OFF_H) + (size_t)pm * 256 * 1024 * 2; u.B = (const char*)(ws + OFF_WT0) + (size_t)pn * 256 * 1024 * 2;
            u.O = (char*)(seg + S0_P0) + ((size_t)pm * 256 * ML_W + pn * 256) * 2; u.ldc = ML_W; return true; }
        const int e = L - 256, l = e >> 5, j = e & 31;
        const char* memn = (const char*)(ws + OFF_MEMN) + (size_t)l * 2048 * 1024 * 2; const char* wkv = (const char*)(ws + OFF_WKVT) + (size_t)l * 2 * MiB;
        char* kout = (char*)(ws + OFF_KMEM) + (size_t)l * 4 * MiB;
        if (j < 16) { const int pm = j >> 1, pn = j & 1;
            u.A = memn + (size_t)pm * 256 * 1024 * 2; u.B = wkv + (size_t)pn * 256 * 1024 * 2; u.O = kout + ((size_t)pm * 256 * 512 + pn * 256) * 2; u.ldc = 512; }
        else { const int jj = j - 16, pm = jj >> 3, pn = jj & 7;
            u.A = wkv + (size_t)(512 + pm * 256) * 1024 * 2; u.B = memn + (size_t)pn * 256 * 1024 * 2; u.O = kout + 2 * MiB + ((size_t)pm * 256 * 2048 + pn * 256) * 2; u.ldc = 2048; }
        return true;
    }
};
struct SchedB0 {
    const unsigned char* ws; unsigned char* seg; int G, c;
    __device__ __forceinline__ bool next(int i, pg8::Unit& u) const {
        const int L = i * G + c; if (L >= 480) return false;
        int pm, pn; pg8::remap(L, 16, 30, pm, pn);
        u.A = (const char*)(ws + OFF_H) + (size_t)pm * 256 * 1024 * 2; u.B = (const char*)(ws + OFF_WT1) + (size_t)pn * 256 * 1024 * 2;
        if (pn < 20) { u.O = (char*)(seg + S1_P1) + ((size_t)pm * 256 * P1W + pn * 256) * 2; u.ldc = P1W; }
        else { u.O = (char*)(seg + S1_P2) + ((size_t)pm * 256 * P2W + (pn - 20) * 256) * 2; u.ldc = P2W; }
        return true;
    }
};
struct SchedOut {
    const char* Y; const char* W; char* slab; int G, c;
    __device__ __forceinline__ bool next(int i, pg8::Unit& u) const {
        const int L = i * G + c; if (L >= 256) return false;
        const int ks = L >> 6; int pm, pn; pg8::remap(L & 63, 16, 4, pm, pn);
        u.A = Y + ((size_t)pm * 256 * DIN + ks * 512) * 2; u.B = W + ((size_t)pn * 256 * DIN + ks * 512) * 2;
        u.O = slab + (((size_t)ks * MS + pm * 256) * DM + pn * 256) * 2; u.ldc = DM; return true;
    }
};

__device__ __forceinline__ void phase_a1(const P& p, const Ctx& c, int seg) {
    const bf16_t* P0 = (const bf16_t*)(c.seg + S0_P0);
    bf16_t* Qb = (bf16_t*)(c.seg + S0_Q); bf16_t* Kb = (bf16_t*)(c.seg + S0_K); bf16_t* KT = (bf16_t*)(c.seg + S0_KT); bf16_t* VT = (bf16_t*)(c.seg + S0_VT);
    bf16_t* XC = (bf16_t*)(c.seg + S0_XC); bf16_t* VF = (bf16_t*)(p.ws + OFF_VF);
    float* IPRE = (float*)(c.seg + S0_GATE); float* LOGF = IPRE + 32 * SEGT;
    const bf16_t* UT = (const bf16_t*)(p.ws + OFF_UTAIL);
    LAS float* red = (LAS float*)c.lds;
    LAS bf16_t* kst = (LAS bf16_t*)(c.lds + 98304);
    LAS bf16_t* vst = kst + 1536 * 8;
    const int n = c.tid;
    float wq[4][4], wk[4][4], wv[4][4], G12[4][8], G3[4][8];
    if (n < 384) {
#pragma unroll
        for (int i = 0; i < 4; ++i) { const f32x4 a = *(const f32x4*)(p.ml_wq + n * 16 + i * 4), bb = *(const f32x4*)(p.ml_wk + n * 16 + i * 4), cc = *(const f32x4*)(p.ml_wv + n * 16 + i * 4);
#pragma unroll
            for (int o = 0; o < 4; ++o) { wq[i][o] = a[o]; wk[i][o] = bb[o]; wv[i][o] = cc[o]; } }
#pragma unroll
        for (int i = 0; i < 4; ++i)
#pragma unroll
            for (int g = 0; g < 8; ++g) { G12[i][g] = 0.f; G3[i][g] = 0.f; }
#pragma unroll
        for (int o = 0; o < 4; ++o) {
            const float* gq = p.ml_w_gate + (size_t)(n * 4 + o) * 8; const float* gk = p.ml_w_gate + (size_t)(DMIX + n * 4 + o) * 8; const float* gv = p.ml_w_gate + (size_t)(2 * DMIX + n * 4 + o) * 8;
            const f32x4 q0 = *(const f32x4*)gq, q1 = *(const f32x4*)(gq + 4), k0 = *(const f32x4*)gk, k1 = *(const f32x4*)(gk + 4), v0 = *(const f32x4*)gv, v1 = *(const f32x4*)(gv + 4);
#pragma unroll
            for (int i = 0; i < 4; ++i)
#pragma unroll
                for (int g = 0; g < 4; ++g) { G12[i][g] += wq[i][o] * q0[g] + wk[i][o] * k0[g]; G12[i][g + 4] += wq[i][o] * q1[g] + wk[i][o] * k1[g];
                    G3[i][g] += wv[i][o] * v0[g]; G3[i][g + 4] += wv[i][o] * v1[g]; }
        }
    }
#pragma unroll 1
    for (int it = c.bid; it < MS / 8; it += c.G) {
        const int row0 = it * 8, b = row0 >> 9, tl0 = row0 & 511;
        __syncthreads();
        if (n < 384) {
            float um[3][4];
#pragma unroll
            for (int j = 1; j <= 3; ++j) { u32x2 raw = (u32x2){0u, 0u};
                if (tl0 - j >= 0) raw = *(const u32x2*)(P0 + (unsigned)((row0 - j) * ML_W + n * 4));
                else if (seg > 0) raw = *(const u32x2*)(UT + (unsigned)((b * 3 + (3 - j)) * DMIX + n * 4));
                um[3 - j][0] = bflo(raw.x); um[3 - j][1] = bfhi(raw.x); um[3 - j][2] = bflo(raw.y); um[3 - j][3] = bfhi(raw.y); }
            u32x2 nraw = *(const u32x2*)(P0 + (unsigned)(row0 * ML_W + n * 4));
#pragma unroll 1
            for (int tt = 0; tt < 8; ++tt) {
                const unsigned row = (unsigned)(row0 + tt);
                const u32x2 raw = nraw;
                if (tt + 1 < 8) nraw = *(const u32x2*)(P0 + (unsigned)((row + 1) * ML_W + n * 4));
                float u[4] = {bflo(raw.x), bfhi(raw.x), bflo(raw.y), bfhi(raw.y)}, xc[4], q[4], k[4], v[4];
                { int nn = n; asm volatile("" : "+v"(nn));
                  const f32x4 cb = *(const f32x4*)(p.ml_conv_b + nn * 4), c0 = *(const f32x4*)(p.ml_conv_w + nn * 4), c1 = *(const f32x4*)(p.ml_conv_w + DMIX + nn * 4),
                              c2 = *(const f32x4*)(p.ml_conv_w + 2 * DMIX + nn * 4), c3 = *(const f32x4*)(p.ml_conv_w + 3 * DMIX + nn * 4);
#pragma unroll
                  for (int i = 0; i < 4; ++i) { const float y = cb[i] + c0[i] * um[0][i] + c1[i] * um[1][i] + c2[i] * um[2][i] + c3[i] * u[i]; xc[i] = siluf_(y); } }
                const float ks = 0.05103103630798288f;
#pragma unroll
                for (int o = 0; o < 4; ++o) { q[o] = xc[0] * wq[0][o] + xc[1] * wq[1][o] + xc[2] * wq[2][o] + xc[3] * wq[3][o];
                    k[o] = (xc[0] * wk[0][o] + xc[1] * wk[1][o] + xc[2] * wk[2][o] + xc[3] * wk[3][o]) * ks;
                    v[o] = u[0] * wv[0][o] + u[1] * wv[1][o] + u[2] * wv[2][o] + u[3] * wv[3][o]; }
#pragma unroll
                for (int g = 0; g < 8; ++g) red[(tt * 8 + g) * 384 + n] = xc[0] * G12[0][g] + xc[1] * G12[1][g] + xc[2] * G12[2][g] + xc[3] * G12[3][g] + u[0] * G3[0][g] + u[1] * G3[1][g] + u[2] * G3[2][g] + u[3] * G3[3][g];
                u32x2 w; w.x = pk2(q[0], q[1]); w.y = pk2(q[2], q[3]); *(u32x2*)(Qb + (unsigned)(row * DMIX + n * 4)) = w;
                w.x = pk2(k[0], k[1]); w.y = pk2(k[2], k[3]); *(u32x2*)(Kb + (unsigned)(row * DMIX + n * 4)) = w;
                w.x = pk2(xc[0], xc[1]); w.y = pk2(xc[2], xc[3]); *(u32x2*)(XC + (unsigned)(row * DMIX + n * 4)) = w;
                w.x = pk2(v[0], v[1]); w.y = pk2(v[2], v[3]); *(u32x2*)(VF + (unsigned)(row * DMIX + n * 4)) = w;
#pragma unroll
                for (int o = 0; o < 4; ++o) { kst[(o * 384 + n) * 8 + tt] = f2bf(k[o]); vst[(o * 384 + n) * 8 + tt] = f2bf(v[o]); }
#pragma unroll
                for (int i = 0; i < 4; ++i) { um[0][i] = um[1][i]; um[1][i] = um[2][i]; um[2][i] = u[i]; }
            }
            const int hd = n / 96, dch = (n % 96) * 4;
#pragma unroll
            for (int o = 0; o < 4; ++o) { const unsigned off = (unsigned)(((b * 4 + hd) * 384 + dch + o) * SEGT + tl0);
                *(u32x4*)(KT + off) = *(const LAS u32x4*)(kst + (o * 384 + n) * 8); *(u32x4*)(VT + off) = *(const LAS u32x4*)(vst + (o * 384 + n) * 8); }
        }
        __syncthreads();
        { const int v = c.tid >> 3, part = c.tid & 7; float s = 0.f;
#pragma unroll 8
          for (int i = 0; i < 48; ++i) s += red[v * 384 + part * 48 + i];
          s += __shfl_xor(s, 1); s += __shfl_xor(s, 2); s += __shfl_xor(s, 4);
          if (part == 0) { const int tt = v >> 3, g = v & 7; const float gate = s + p.ml_b_gate[g];
              if (g < 4) IPRE[(b * 4 + g) * SEGT + tl0 + tt] = gate; else LOGF[(b * 4 + g - 4) * SEGT + tl0 + tt] = -softplusf_(-gate); } }
    }
}

__device__ __forceinline__ void attn_item(const P& p, const Ctx& c, int layer, int it, const bf16_t* Qp, int ldq, bf16_t* YM) {
    const int b = it >> 3, head = (it >> 1) & 3, qb = it & 1;
    const bf16_t* Kg = (const bf16_t*)(p.ws + OFF_KMEM + (size_t)layer * 4 * MiB) + (size_t)(b * 256) * 512 + head * 128;
    const bf16_t* Vg = (const bf16_t*)(p.ws + OFF_KMEM + (size_t)layer * 4 * MiB + 2 * MiB) + (size_t)(head * 128) * 2048 + b * 256;
    LAS bf16_t* Ks = (LAS bf16_t*)c.lds;
    LAS bf16_t* Vs = Ks + 256 * 136;
    const int l15 = c.lane & 15, quad = c.lane >> 4;
    __syncthreads();
#pragma unroll
    for (int r = 0; r < 8; ++r) { const int id = c.tid + 512 * r; { const int i = id >> 4, c8 = (id & 15) * 8; *(LAS u32x4*)(Ks + i * 136 + c8) = *(const u32x4*)(Kg + (size_t)i * 512 + c8); }
        { const int i = id >> 5, c8 = (id & 31) * 8; *(LAS u32x4*)(Vs + i * 264 + c8) = *(const u32x4*)(Vg + (size_t)i * 2048 + c8); } }
    __syncthreads();
#pragma unroll 1
    for (int pass = 0; pass < 2; ++pass) {
        const int row0 = b * SEGT + qb * 256 + c.wv * 32 + pass * 16;
        bf16x8 qf[4];
#pragma unroll
        for (int kk = 0; kk < 4; ++kk) qf[kk] = *(const bf16x8*)(Qp + (size_t)(row0 + l15) * ldq + head * 128 + kk * 32 + quad * 8);
        f32x4 acc[16];
#pragma unroll
        for (int mt = 0; mt < 16; ++mt) { acc[mt] = (f32x4){0.f, 0.f, 0.f, 0.f};
#pragma unroll
            for (int kk = 0; kk < 4; ++kk) { const bf16x8 a = *(const LAS bf16x8*)(Ks + (mt * 16 + l15) * 136 + kk * 32 + quad * 8); acc[mt] = mfma16(a, qf[kk], acc[mt]); }
            if ((mt & 3) == 3) __builtin_amdgcn_sched_barrier(0); }
        float mx = -1e30f;
#pragma unroll
        for (int mt = 0; mt < 16; ++mt)
#pragma unroll
            for (int j = 0; j < 4; ++j) mx = fmaxf(mx, acc[mt][j]);
        mx = fmaxf(mx, __shfl_xor(mx, 16)); mx = fmaxf(mx, __shfl_xor(mx, 32));
        const float sc = 0.08838834764831845f * 1.4426950408889634f; float sm = 0.f;
#pragma unroll
        for (int mt = 0; mt < 16; ++mt)
#pragma unroll
            for (int j = 0; j < 4; ++j) { const float e = exp2f((acc[mt][j] - mx) * sc); acc[mt][j] = e; sm += e; }
        sm += __shfl_xor(sm, 16); sm += __shfl_xor(sm, 32);
        const float inv = frcp(sm);
        bf16x8 pa[8];
#pragma unroll
        for (int kp = 0; kp < 8; ++kp) {
            u32x4 aw; aw.x = pk2(acc[2 * kp][0] * inv, acc[2 * kp][1] * inv); aw.y = pk2(acc[2 * kp][2] * inv, acc[2 * kp][3] * inv);
            aw.z = pk2(acc[2 * kp + 1][0] * inv, acc[2 * kp + 1][1] * inv); aw.w = pk2(acc[2 * kp + 1][2] * inv, acc[2 * kp + 1][3] * inv);
            __builtin_memcpy(&pa[kp], &aw, 16); }
        __builtin_amdgcn_sched_barrier(0);
        f32x4 o[8];
#pragma unroll
        for (int nt = 0; nt < 8; ++nt) o[nt] = (f32x4){0.f, 0.f, 0.f, 0.f};
#pragma unroll
        for (int kp = 0; kp < 8; ++kp) {
            const bf16x8 a = pa[kp];
#pragma unroll
            for (int nt = 0; nt < 8; ++nt) { const LAS bf16_t* vp = Vs + (nt * 16 + l15) * 264 + 2 * kp * 16 + quad * 4;
                const u32x2 lo = *(const LAS u32x2*)vp, hi = *(const LAS u32x2*)(vp + 16); u32x4 bw = (u32x4){lo.x, lo.y, hi.x, hi.y}; bf16x8 bfr; __builtin_memcpy(&bfr, &bw, 16);
                o[nt] = mfma16(a, bfr, o[nt]); }
            __builtin_amdgcn_sched_barrier(0);
        }
#pragma unroll
        for (int nt = 0; nt < 8; ++nt)
#pragma unroll
            for (int j = 0; j < 4; ++j) YM[(size_t)(row0 + quad * 4 + j) * DX + head * 128 + nt * 16 + l15] = f2bf(o[nt][j]);
    }
}

__device__ __forceinline__ void mlstm_item(const P& p, const Ctx& c, int seg, int w, bool save) {
    const int b = w / 24, h = (w / 6) & 3, sl = w % 6;
    const bf16_t* Qb = (const bf16_t*)(c.seg + S0_Q); const bf16_t* Kb = (const bf16_t*)(c.seg + S0_K); const bf16_t* KT = (const bf16_t*)(c.seg + S0_KT); const bf16_t* VT = (const bf16_t*)(c.seg + S0_VT);
    const float* IPRE = (const float*)(c.seg + S0_GATE); const float* LOGF = IPRE + 32 * SEGT;
    bf16_t* HR = (bf16_t*)(c.seg + S0_HRAW);
    float* CST = (float*)(p.ws + OFF_CST) + (size_t)w * 64 * 384; float* NST = (float*)(p.ws + OFF_NST) + (size_t)w * 384;
    LAS bf16_t* Cimg = (LAS bf16_t*)c.lds;
    LAS bf16_t* Qs = Cimg + 64 * 392;
    LAS bf16_t* Ks = Qs + 64 * 136;
    LAS bf16_t* KTs = Ks + 64 * 136;
    LAS bf16_t* VTs = KTs + 128 * 72;
    LAS bf16_t* VWs = VTs + 64 * 72;
    LAS bf16_t* Sp = VWs + 64 * 72;
    LAS float* fl = (LAS float*)(Sp + 64 * 72);
    LAS float* bcum = fl; LAS float* ipr = fl + 64; LAS float* wgt = fl + 128; LAS float* gin = fl + 192; LAS float* qn = fl + 256; LAS float* rden = fl + 320;
    LAS float* gtotp = fl + 384; LAS float* nold = fl + 400; LAS float* nnew = fl + 800;
    const int l15c = c.lane & 15, quadc = c.lane >> 4, e16 = c.wv & 3, par = c.wv >> 2;
    f32x4 C[12];
    __syncthreads();
    if (seg > 0) {
#pragma unroll
        for (int j = 0; j < 12; ++j)
#pragma unroll
            for (int jj = 0; jj < 4; ++jj) C[j][jj] = CST[(size_t)(e16 * 16 + quadc * 4 + jj) * 384 + (2 * j + par) * 16 + l15c];
        if (c.tid < 384) nold[c.tid] = NST[c.tid];
    } else {
#pragma unroll
        for (int j = 0; j < 12; ++j) C[j] = (f32x4){0.f, 0.f, 0.f, 0.f};
        if (c.tid < 384) nold[c.tid] = 0.f;
    }
    u32x4 pq[2], pk[2], pt[2], pvt; float plf = 0.f, pip = 0.f;
    auto gl_piece = [&](int ch, int pp, int tidv) {
#pragma unroll
        for (int r = 0; r < 2; ++r) { const int id = tidv + 512 * r;
            { const int i = id >> 4, c8 = (id & 15) * 8; const size_t go = ((size_t)b * SEGT + ch * 64 + i) * DMIX + h * 384 + pp * 128 + c8; pq[r] = *(const u32x4*)(Qb + go); pk[r] = *(const u32x4*)(Kb + go); }
            { const int dd = id >> 3, c8 = (id & 7) * 8; pt[r] = *(const u32x4*)(KT + ((size_t)(b * 4 + h) * 384 + pp * 128 + dd) * SEGT + ch * 64 + c8); } } };
    auto gl_chunk = [&](int ch, int tidv) { const int i = tidv >> 3, c8 = (tidv & 7) * 8;
        pvt = *(const u32x4*)(VT + ((size_t)(b * 4 + h) * 384 + sl * 64 + i) * SEGT + ch * 64 + c8);
        if (c.wv == 0) { plf = LOGF[(b * 4 + h) * SEGT + ch * 64 + c.lane]; pip = IPRE[(b * 4 + h) * SEGT + ch * 64 + c.lane]; } };
    { int t0 = c.tid; asm volatile("" : "+v"(t0)); gl_chunk(0, t0); gl_piece(0, 0, t0); }
#pragma unroll 1
    for (int ch = 0; ch < 8; ++ch) {
        const int tl0 = ch * 64; const size_t row0 = (size_t)b * SEGT + tl0;
        int tidv = c.tid, l15 = l15c, quad = quadc;
        asm volatile("" : "+v"(tidv), "+v"(l15), "+v"(quad));
        lds_barrier();
        if (c.wv == 0) {
            float bc = plf;
#pragma unroll
            for (int o = 1; o < 64; o <<= 1) { const float t = __shfl_up(bc, o); if (c.lane >= o) bc += t; }
            const float bl = __shfl(bc, 63);
            bcum[c.lane] = bc; ipr[c.lane] = pip; wgt[c.lane] = __expf(bl - bc + pip); gin[c.lane] = __expf(bc);
            if (c.lane == 0) gtotp[0] = __expf(bl);
        }
#pragma unroll
        for (int j = 0; j < 12; ++j)
#pragma unroll
            for (int jj = 0; jj < 4; ++jj) Cimg[(e16 * 16 + quad * 4 + jj) * 392 + (2 * j + par) * 16 + l15] = f2bf(C[j][jj]);
        lds_barrier();
        { const int i = tidv >> 3, c8 = (tidv & 7) * 8;
          const u32x4 raw = pvt;
          *(LAS u32x4*)(VTs + i * 72 + c8) = raw;
          const f32x4 w0 = *(const LAS f32x4*)(wgt + c8), w1 = *(const LAS f32x4*)(wgt + c8 + 4);
          u32x4 sw; sw.x = pk2(bflo(raw.x) * w0[0], bfhi(raw.x) * w0[1]); sw.y = pk2(bflo(raw.y) * w0[2], bfhi(raw.y) * w0[3]);
          sw.z = pk2(bflo(raw.z) * w1[0], bfhi(raw.z) * w1[1]); sw.w = pk2(bflo(raw.w) * w1[2], bfhi(raw.w) * w1[3]);
          *(LAS u32x4*)(VWs + i * 72 + c8) = sw; }
        if (ch + 1 < 8) gl_chunk(ch + 1, tidv);
        const float gtot = gtotp[0];
#pragma unroll
        for (int j = 0; j < 12; ++j) C[j] *= gtot;
        f32x4 Sa[2], Ia[2]; Sa[0] = Sa[1] = Ia[0] = Ia[1] = (f32x4){0.f, 0.f, 0.f, 0.f};
        float qnacc = 0.f;
#pragma unroll
        for (int pp = 0; pp < 3; ++pp) {
            const int d0 = pp * 128;
            __builtin_amdgcn_sched_barrier(0);
            asm volatile("" : "+v"(tidv));
            lds_barrier();
#pragma unroll
            for (int r = 0; r < 2; ++r) { const int id = tidv + 512 * r;
                { const int i = id >> 4, c8 = (id & 15) * 8; *(LAS u32x4*)(Qs + i * 136 + c8) = pq[r]; *(LAS u32x4*)(Ks + i * 136 + c8) = pk[r]; }
                { const int dd = id >> 3, c8 = (id & 7) * 8; *(LAS u32x4*)(KTs + dd * 72 + c8) = pt[r]; } }
            lds_barrier();
            if (pp < 2) gl_piece(ch, pp + 1, tidv); else if (ch + 1 < 8) gl_piece(ch + 1, 0, tidv);
            { const int tm = c.wv >> 1, tn0 = (c.wv & 1) * 2;
#pragma unroll
              for (int kk = 0; kk < 4; ++kk) { const bf16x8 a = *(const LAS bf16x8*)(Qs + (tm * 16 + l15) * 136 + kk * 32 + quad * 8);
#pragma unroll
                  for (int x = 0; x < 2; ++x) { const int tn = tn0 + x;
                      const bf16x8 bk = *(const LAS bf16x8*)(Ks + (tn * 16 + l15) * 136 + kk * 32 + quad * 8);
                      const bf16x8 bc = *(const LAS bf16x8*)(Cimg + (tn * 16 + l15) * 392 + d0 + kk * 32 + quad * 8);
                      Sa[x] = mfma16(a, bk, Sa[x]); Ia[x] = mfma16(a, bc, Ia[x]); } } }
            { const bf16x8 va0 = *(const LAS bf16x8*)(VWs + (e16 * 16 + l15) * 72 + quad * 8), va1 = *(const LAS bf16x8*)(VWs + (e16 * 16 + l15) * 72 + 32 + quad * 8);
#pragma unroll
              for (int jl = 0; jl < 4; ++jl) { const int ntl = 2 * jl + par, j = pp * 4 + jl;
                  C[j] = mfma16(va0, *(const LAS bf16x8*)(KTs + (ntl * 16 + l15) * 72 + quad * 8), C[j]);
                  C[j] = mfma16(va1, *(const LAS bf16x8*)(KTs + (ntl * 16 + l15) * 72 + 32 + quad * 8), C[j]); } }
            { const int t = tidv >> 3, part = tidv & 7;
              const u32x4 q0 = *(const LAS u32x4*)(Qs + t * 136 + part * 16), q1 = *(const LAS u32x4*)(Qs + t * 136 + part * 16 + 8);
              const LAS float* np = nold + d0 + part * 16; const f32x4 n0 = *(const LAS f32x4*)np, n1 = *(const LAS f32x4*)(np + 4), n2 = *(const LAS f32x4*)(np + 8), n3 = *(const LAS f32x4*)(np + 12);
              qnacc += bflo(q0.x) * n0[0] + bfhi(q0.x) * n0[1] + bflo(q0.y) * n0[2] + bfhi(q0.y) * n0[3] + bflo(q0.z) * n1[0] + bfhi(q0.z) * n1[1] + bflo(q0.w) * n1[2] + bfhi(q0.w) * n1[3]
                     + bflo(q1.x) * n2[0] + bfhi(q1.x) * n2[1] + bflo(q1.y) * n2[2] + bfhi(q1.y) * n2[3] + bflo(q1.z) * n3[0] + bfhi(q1.z) * n3[1] + bflo(q1.w) * n3[2] + bfhi(q1.w) * n3[3]; }
            { const int dd = tidv >> 2, part = tidv & 3;
              const u32x4 k0 = *(const LAS u32x4*)(KTs + dd * 72 + part * 16), k1 = *(const LAS u32x4*)(KTs + dd * 72 + part * 16 + 8);
              const LAS float* wp = wgt + part * 16; const f32x4 w0 = *(const LAS f32x4*)wp, w1 = *(const LAS f32x4*)(wp + 4), w2 = *(const LAS f32x4*)(wp + 8), w3 = *(const LAS f32x4*)(wp + 12);
              float a = bflo(k0.x) * w0[0] + bfhi(k0.x) * w0[1] + bflo(k0.y) * w0[2] + bfhi(k0.y) * w0[3] + bflo(k0.z) * w1[0] + bfhi(k0.z) * w1[1] + bflo(k0.w) * w1[2] + bfhi(k0.w) * w1[3]
                      + bflo(k1.x) * w2[0] + bfhi(k1.x) * w2[1] + bflo(k1.y) * w2[2] + bfhi(k1.y) * w2[3] + bflo(k1.z) * w3[0] + bfhi(k1.z) * w3[1] + bflo(k1.w) * w3[2] + bfhi(k1.w) * w3[3];
              a = dpp_add<0xB1>(a); a = dpp_add<0x4E>(a);
              if (part == 0) nnew[d0 + dd] = gtot * nold[d0 + dd] + a; }
        }
        qnacc = dpp_add<0xB1>(qnacc); qnacc = dpp_add<0x4E>(qnacc); qnacc = dpp_add<0x141>(qnacc);
        if ((tidv & 7) == 0) qn[tidv >> 3] = qnacc;
#pragma unroll
        for (int x = 0; x < 2; ++x) { const int ti = c.wv * 2 + x, tm = ti >> 2, tn = ti & 3; const int s = tn * 16 + l15; const float bs = bcum[s] - ipr[s];
#pragma unroll
            for (int jj = 0; jj < 4; ++jj) { const int t = tm * 16 + quad * 4 + jj; const float v = (s <= t) ? Sa[x][jj] * __expf(bcum[t] - bs) : 0.f; Sp[t * 72 + s] = f2bf(v); } }
        lds_barrier();
        { const int t = tidv >> 3, part = tidv & 7; const u32x4 sr = *(const LAS u32x4*)(Sp + t * 72 + part * 8);
          float ds = bflo(sr.x) + bfhi(sr.x) + bflo(sr.y) + bfhi(sr.y) + bflo(sr.z) + bfhi(sr.z) + bflo(sr.w) + bfhi(sr.w);
          ds = dpp_add<0xB1>(ds); ds = dpp_add<0x4E>(ds); ds = dpp_add<0x141>(ds);
          if (part == 0) { const float den = ds + gin[t] * qn[t]; rden[t] = frcp(fmaxf(fabsf(den), 1.0f)); } }
#pragma unroll
        for (int x = 0; x < 2; ++x) { const int ti = c.wv * 2 + x, tm = ti >> 2, tn = ti & 3;
#pragma unroll
            for (int jj = 0; jj < 4; ++jj) Ia[x][jj] *= gin[tm * 16 + quad * 4 + jj];
#pragma unroll
            for (int kk = 0; kk < 2; ++kk) { const bf16x8 a = *(const LAS bf16x8*)(Sp + (tm * 16 + l15) * 72 + kk * 32 + quad * 8);
                const bf16x8 bb = *(const LAS bf16x8*)(VTs + (tn * 16 + l15) * 72 + kk * 32 + quad * 8); Ia[x] = mfma16(a, bb, Ia[x]); } }
        lds_barrier();
#pragma unroll
        for (int x = 0; x < 2; ++x) { const int ti = c.wv * 2 + x, tm = ti >> 2, tn = ti & 3;
#pragma unroll
            for (int jj = 0; jj < 4; ++jj) { const int t = tm * 16 + quad * 4 + jj; HR[(row0 + t) * DMIX + h * 384 + sl * 64 + tn * 16 + l15] = f2bf(Ia[x][jj] * rden[t]); } }
        if (c.tid < 384) nold[c.tid] = nnew[c.tid];
    }
    lds_barrier();
    if (!save) return;
#pragma unroll
    for (int j = 0; j < 12; ++j)
#pragma unroll
        for (int jj = 0; jj < 4; ++jj) CST[(size_t)(e16 * 16 + quadc * 4 + jj) * 384 + (2 * j + par) * 16 + l15c] = C[j][jj];
    if (c.tid < 384) NST[c.tid] = nold[c.tid];
}

__device__ __forceinline__ void phase_a3(const P& p, const Ctx& c, int seg) {
    const bf16_t* P0 = (const bf16_t*)(c.seg + S0_P0); const bf16_t* HR = (const bf16_t*)(c.seg + S0_HRAW); const bf16_t* XC = (const bf16_t*)(c.seg + S0_XC);
    const bf16_t* YM = (const bf16_t*)(c.seg + S0_YMEM); bf16_t* Y = (bf16_t*)(c.seg + S0_Y); bf16_t* UT = (bf16_t*)(p.ws + OFF_UTAIL);
#pragma unroll 1
    for (int r = c.bid * 8 + c.wv; r < MS; r += c.G * 8) {
        const int b = r >> 9, tl = r & 511;
        float v[3][8]; float mean[3], rstd[3];
#pragma unroll
        for (int ps = 0; ps < 3; ++ps) { const int ch = ps * 512 + c.lane * 8;
            const u32x4 hr = *(const u32x4*)(HR + (size_t)r * DMIX + ch);
            v[ps][0] = bflo(hr.x); v[ps][1] = bfhi(hr.x); v[ps][2] = bflo(hr.y); v[ps][3] = bfhi(hr.y); v[ps][4] = bflo(hr.z); v[ps][5] = bfhi(hr.z); v[ps][6] = bflo(hr.w); v[ps][7] = bfhi(hr.w); }
        float hs[4], hq[4];
#pragma unroll
        for (int hd = 0; hd < 4; ++hd) { float s = 0.f, q = 0.f;
#pragma unroll
            for (int ps = 0; ps < 3; ++ps) { if (ps * 512 + 511 < hd * 384 || ps * 512 >= (hd + 1) * 384) continue;
                const bool mine = ((ps * 512 + c.lane * 8) / 384) == hd;
                float ls = 0.f, lq = 0.f;
#pragma unroll
                for (int j = 0; j < 8; ++j) { ls += v[ps][j]; lq += v[ps][j] * v[ps][j]; }
                s += mine ? ls : 0.f; q += mine ? lq : 0.f; }
            hs[hd] = wsum(s); hq[hd] = wsum(q); }
#pragma unroll
        for (int ps = 0; ps < 3; ++ps) { const int hd = (ps * 512 + c.lane * 8) / 384;
            const float s = hd == 0 ? hs[0] : (hd == 1 ? hs[1] : (hd == 2 ? hs[2] : hs[3])), q = hd == 0 ? hq[0] : (hd == 1 ? hq[1] : (hd == 2 ? hq[2] : hq[3]));
            const float m = s * (1.0f / 384.0f); mean[ps] = m; rstd[ps] = rsqrtf(fmaxf(q * (1.0f / 384.0f) - m * m, 0.f) + 1e-5f); }
#pragma unroll
        for (int ps = 0; ps < 3; ++ps) { const int ch = ps * 512 + c.lane * 8;
            const u32x4 xr = *(const u32x4*)(XC + (size_t)r * DMIX + ch), zr = *(const u32x4*)(P0 + (size_t)r * ML_W + 2048 + ch);
            const f32x4 g0 = *(const f32x4*)(p.ml_mhn_g + ch), g1 = *(const f32x4*)(p.ml_mhn_g + ch + 4), k0 = *(const f32x4*)(p.ml_skip + ch), k1 = *(const f32x4*)(p.ml_skip + ch + 4);
            const float xx[8] = {bflo(xr.x), bfhi(xr.x), bflo(xr.y), bfhi(xr.y), bflo(xr.z), bfhi(xr.z), bflo(xr.w), bfhi(xr.w)};
            const float zz[8] = {bflo(zr.x), bfhi(zr.x), bflo(zr.y), bfhi(zr.y), bflo(zr.z), bfhi(zr.z), bflo(zr.w), bfhi(zr.w)};
            const float gg[8] = {g0[0], g0[1], g0[2], g0[3], g1[0], g1[1], g1[2], g1[3]}, kk[8] = {k0[0], k0[1], k0[2], k0[3], k1[0], k1[1], k1[2], k1[3]};
            float y[8];
#pragma unroll
            for (int j = 0; j < 8; ++j) y[j] = ((v[ps][j] - mean[ps]) * rstd[ps] * gg[j] + kk[j] * xx[j]) * siluf_(zz[j]);
            *(u32x4*)(Y + (size_t)r * DIN + ch) = (u32x4){pk2(y[0], y[1]), pk2(y[2], y[3]), pk2(y[4], y[5]), pk2(y[6], y[7])}; }
        { const int cm = c.lane * 8; const u32x4 mr = *(const u32x4*)(YM + (size_t)r * DX + cm), zr = *(const u32x4*)(P0 + (size_t)r * ML_W + 2048 + DMIX + cm);
          const float mm[8] = {bflo(mr.x), bfhi(mr.x), bflo(mr.y), bfhi(mr.y), bflo(mr.z), bfhi(mr.z), bflo(mr.w), bfhi(mr.w)};
          const float zz[8] = {bflo(zr.x), bfhi(zr.x), bflo(zr.y), bfhi(zr.y), bflo(zr.z), bfhi(zr.z), bflo(zr.w), bfhi(zr.w)};
          float y[8];
#pragma unroll
          for (int j = 0; j < 8; ++j) y[j] = mm[j] * siluf_(zz[j]);
          *(u32x4*)(Y + (size_t)r * DIN + DMIX + cm) = (u32x4){pk2(y[0], y[1]), pk2(y[2], y[3]), pk2(y[4], y[5]), pk2(y[6], y[7])}; }
        if (tl >= 509) {
#pragma unroll
            for (int ps = 0; ps < 3; ++ps) { const int ch = ps * 512 + c.lane * 8; *(u32x4*)(UT + (size_t)(b * 3 + tl - 509) * DMIX + ch) = *(const u32x4*)(P0 + (size_t)r * ML_W + ch); } }
    }
}

__device__ __forceinline__ void phase_b1(const P& p, const Ctx& c, int seg) {
    const bf16_t* P1 = (const bf16_t*)(c.seg + S1_P1);
    float* GTB = (float*)(c.seg + S1_W); bf16_t* SA = (bf16_t*)(c.seg + S1_A); bf16_t* SB = (bf16_t*)(c.seg + S1_B); bf16_t* SK = (bf16_t*)(c.seg + S1_K);
    bf16_t* SQ = (bf16_t*)(c.seg + S1_Q); bf16_t* SV = (bf16_t*)(c.seg + S1_V); bf16_t* SG = (bf16_t*)(c.seg + S1_G); float* BRKR = (float*)(c.seg + S1_BRKR);
    const bf16_t* VF = (const bf16_t*)(p.ws + OFF_VF); const bf16_t* LT = (const bf16_t*)(p.ws + OFF_LORAT);
    const bf16_t* PTr = (const bf16_t*)(p.ws + OFF_PTAIL) + (size_t)(seg & 1) * NB * RW_SHIFT; bf16_t* PTw = (bf16_t*)(p.ws + OFF_PTAIL) + (size_t)((seg + 1) & 1) * NB * RW_SHIFT;
    LAS bf16_t* XA = (LAS bf16_t*)c.lds;
    const int l15 = c.lane & 15, quad = c.lane >> 4;
    for (int it = c.bid; it < MS / 16; it += c.G) {
        const int r0 = it * 16, b = r0 >> 9, tl0 = r0 & 511;
        __syncthreads();
        for (int e = c.tid; e < 16 * 288; e += 512) { const int row = e / 288, cc = e % 288, col = 4608 + cc;
            const float cur = bf2f(P1[(size_t)(r0 + row) * P1W + col]);
            float prev = 0.f; if (tl0 + row > 0) prev = bf2f(P1[(size_t)(r0 + row - 1) * P1W + col]); else if (seg > 0) prev = bf2f(PTr[(size_t)b * RW_SHIFT + col]);
            const float pv = cur + p.rw_mu[col] * (prev - cur);
            const float f = cc < 64 ? (1.0f - 2.0f / (1.0f + __expf(2.0f * pv)))   : (cc < 160 ? pv : sigmoidf_(pv));
            XA[row * 296 + cc] = f2bf(f); }
        __syncthreads();
        const size_t row = (size_t)r0 + l15; const int tl = tl0 + l15;
        const bf16_t* curp = P1 + row * P1W; const bf16_t* prevp = (tl > 0) ? (P1 + (row - 1) * P1W) : (PTr + (size_t)b * RW_SHIFT); const bool hasprev = (tl > 0) || (seg > 0);
        struct TileIn { u32x4 cr, ck, cv, pr, pk, pv, vf; };
        struct TilePar { f32x4 m0, m1, m2, w0, a0, v0, kkw, kaw, rk; };
#pragma unroll 1
        for (int x = 0; x < 3; ++x) {
            int hh = c.wv * 3 + x; asm volatile("" : "+s"(hh));
            auto load_tile = [&](int ct, TileIn& T) { const int cc = hh * 64 + (ct >> 1) * 32 + quad * 8;
                T.cr = *(const u32x4*)(curp + cc); T.ck = *(const u32x4*)(curp + DMIX + cc); T.cv = *(const u32x4*)(curp + 2 * DMIX + cc);
                T.pr = (u32x4){0u, 0u, 0u, 0u}; T.pk = T.pr; T.pv = T.pr;
                if (hasprev) { T.pr = *(const u32x4*)(prevp + cc); T.pk = *(const u32x4*)(prevp + DMIX + cc); T.pv = *(const u32x4*)(prevp + 2 * DMIX + cc); }
                T.vf = *(const u32x4*)(VF + row * DMIX + cc); };
            TileIn TA;
            load_tile(0, TA);
            float inv;
            { u32x2 kcur[4], kprv[4]; f32x4 km[4], kw[4];
#pragma unroll
              for (int ct = 0; ct < 4; ++ct) { const int cc = hh * 64 + (ct >> 1) * 32 + quad * 8 + 4 * (ct & 1);
                  kcur[ct] = *(const u32x2*)(curp + DMIX + cc); kprv[ct] = (u32x2){0u, 0u}; if (hasprev) kprv[ct] = *(const u32x2*)(prevp + DMIX + cc);
                  km[ct] = *(const f32x4*)(p.rw_mu + DMIX + cc); kw[ct] = *(const f32x4*)(p.rw_k_k + cc); }
              float ss = 0.f;
#pragma unroll
              for (int ct = 0; ct < 4; ++ct) {
                  const float cb[4] = {bflo(kcur[ct].x), bfhi(kcur[ct].x), bflo(kcur[ct].y), bfhi(kcur[ct].y)}, qb[4] = {bflo(kprv[ct].x), bfhi(kprv[ct].x), bflo(kprv[ct].y), bfhi(kprv[ct].y)};
#pragma unroll
                  for (int j = 0; j < 4; ++j) { const float kr = (cb[j] + km[ct][j] * (qb[j] - cb[j])) * kw[ct][j]; ss += kr * kr; } }
              ss += __shfl_xor(ss, 16); ss += __shfl_xor(ss, 32);
              inv = frcp(fmaxf(sqrtf(ss), 1e-12f)); }
            float br = 0.f, kr = 0.f, rkr = 0.f;
            u32x2 st_g, st_a, st_b, st_k, st_q, st_v;
            auto do_tile = [&](int ct, const TileIn& TI) { const int cc = hh * 64 + (ct >> 1) * 32 + quad * 8 + 4 * (ct & 1);
                TilePar T; T.m0 = *(const f32x4*)(p.rw_mu + cc); T.m1 = *(const f32x4*)(p.rw_mu + DMIX + cc); T.m2 = *(const f32x4*)(p.rw_mu + 2 * DMIX + cc);
                T.w0 = *(const f32x4*)(p.rw_w0 + cc); T.a0 = *(const f32x4*)(p.rw_a0 + cc); T.v0 = *(const f32x4*)(p.rw_v0 + cc); T.kkw = *(const f32x4*)(p.rw_k_k + cc); T.kaw = *(const f32x4*)(p.rw_k_a + cc);
                T.rk = *(const f32x4*)(p.rw_r_k + cc);
                bf16x8 lt[9]; { const bf16_t* lrow = LT + (size_t)(hh * 64 + (ct >> 1) * 32 + 8 * (l15 >> 2) + 4 * (ct & 1) + (l15 & 3)) * 288 + quad * 8;
#pragma unroll
                    for (int k = 0; k < 9; ++k) lt[k] = *(const bf16x8*)(lrow + k * 32); }
                bf16x8 xf[9];
#pragma unroll
                for (int k = 0; k < 9; ++k) xf[k] = *(const LAS bf16x8*)(XA + l15 * 296 + k * 32 + quad * 8);
                f32x4 dw = (f32x4){0.f, 0.f, 0.f, 0.f}, da = dw, dv = dw, dg = dw;
#pragma unroll
                for (int k = 0; k < 2; ++k) dw = mfma16(lt[k], xf[k], dw);
#pragma unroll
                for (int k = 0; k < 2; ++k) da = mfma16(lt[2 + k], xf[2 + k], da);
                dv = mfma16(lt[4], xf[4], dv);
#pragma unroll
                for (int k = 0; k < 4; ++k) dg = mfma16(lt[5 + k], xf[5 + k], dg);
                const bool od = (ct & 1) != 0;
                const unsigned r0 = od ? TI.cr.z : TI.cr.x, r1 = od ? TI.cr.w : TI.cr.y, k0 = od ? TI.ck.z : TI.ck.x, k1 = od ? TI.ck.w : TI.ck.y, c0 = od ? TI.cv.z : TI.cv.x, c1 = od ? TI.cv.w : TI.cv.y;
                const unsigned p0 = od ? TI.pr.z : TI.pr.x, p1 = od ? TI.pr.w : TI.pr.y, q0 = od ? TI.pk.z : TI.pk.x, q1 = od ? TI.pk.w : TI.pk.y, d0 = od ? TI.pv.z : TI.pv.x, d1 = od ? TI.pv.w : TI.pv.y;
                const unsigned f0 = od ? TI.vf.z : TI.vf.x, f1 = od ? TI.vf.w : TI.vf.y;
                const float ca[4] = {bflo(r0), bfhi(r0), bflo(r1), bfhi(r1)}, cb[4] = {bflo(k0), bfhi(k0), bflo(k1), bfhi(k1)}, cd[4] = {bflo(c0), bfhi(c0), bflo(c1), bfhi(c1)};
                const float qa[4] = {bflo(p0), bfhi(p0), bflo(p1), bfhi(p1)}, qb[4] = {bflo(q0), bfhi(q0), bflo(q1), bfhi(q1)}, qd[4] = {bflo(d0), bfhi(d0), bflo(d1), bfhi(d1)};
                const float vf[4] = {bflo(f0), bfhi(f0), bflo(f1), bfhi(f1)};
                u32x2 gw; gw.x = pk2(dg[0], dg[1]); gw.y = pk2(dg[2], dg[3]);
                float wv4[4], av[4], bv[4], ktv[4], qv[4], vv[4];
#pragma unroll
                for (int j = 0; j < 4; ++j) {
                    const float rc = ca[j] + T.m0[j] * (qa[j] - ca[j]), kc = cb[j] + T.m1[j] * (qb[j] - cb[j]), vc = cd[j] + T.m2[j] * (qd[j] - cd[j]);
                    const float zz = -(T.w0[j] + dw[j]); const float sp = fmaxf(zz, 0.f) + __logf(1.0f + __expf(-fabsf(zz)));
                    wv4[j] = __expf(-__expf(-sp - 0.5f));
                    const float a = sigmoidf_(T.a0[j] + da[j]);
                    vv[j] = vc + (vf[j] - vc) * sigmoidf_(T.v0[j] + dv[j]);
                    const float kk = kc * T.kkw[j] * inv; av[j] = -kk; bv[j] = kk * a;
                    ktv[j] = kc * (1.0f + (a - 1.0f) * T.kaw[j]); qv[j] = rc;
                    br += bv[j] * rc; kr += ktv[j] * rc; rkr += rc * ktv[j] * T.rk[j]; }
                float gfin[4];
#pragma unroll
                for (int j = 0; j < 4; ++j) { float g = wv4[j];
                    g *= dpp_shr_or1<1>(g); g *= dpp_shr_or1<2>(g); g *= dpp_shr_or1<4>(g); g *= dpp_shr_or1<8>(g);
                    const float gp = dpp_shr_or1<1>(g), ig = frcp(g);
                    av[j] *= gp; qv[j] *= g; bv[j] *= ig; ktv[j] *= ig; gfin[j] = g; }
                if (l15 == 15) *(f32x4*)(GTB + ((size_t)it * 24 + hh) * 64 + (cc - hh * 64)) = (f32x4){gfin[0], gfin[1], gfin[2], gfin[3]};
                const u32x2 ta = (u32x2){pk2(av[0], av[1]), pk2(av[2], av[3])}, tb = (u32x2){pk2(bv[0], bv[1]), pk2(bv[2], bv[3])}, tk = (u32x2){pk2(ktv[0], ktv[1]), pk2(ktv[2], ktv[3])};
                const u32x2 tq = (u32x2){pk2(qv[0], qv[1]), pk2(qv[2], qv[3])}, tv = (u32x2){pk2(vv[0], vv[1]), pk2(vv[2], vv[3])};
                if ((ct & 1) == 0) { st_g = gw; st_a = ta; st_b = tb; st_k = tk; st_q = tq; st_v = tv; }
                else { const size_t o8 = row * DMIX + cc - 4;
                    *(u32x4*)(SG + o8) = (u32x4){st_g.x, st_g.y, gw.x, gw.y}; *(u32x4*)(SA + o8) = (u32x4){st_a.x, st_a.y, ta.x, ta.y}; *(u32x4*)(SB + o8) = (u32x4){st_b.x, st_b.y, tb.x, tb.y};
                    *(u32x4*)(SK + o8) = (u32x4){st_k.x, st_k.y, tk.x, tk.y}; *(u32x4*)(SQ + o8) = (u32x4){st_q.x, st_q.y, tq.x, tq.y}; *(u32x4*)(SV + o8) = (u32x4){st_v.x, st_v.y, tv.x, tv.y}; } };
            do_tile(0, TA); __builtin_amdgcn_sched_barrier(0);
            do_tile(1, TA); __builtin_amdgcn_sched_barrier(0);
            load_tile(2, TA); do_tile(2, TA); __builtin_amdgcn_sched_barrier(0);
            do_tile(3, TA);
            br += __shfl_xor(br, 16); br += __shfl_xor(br, 32); kr += __shfl_xor(kr, 16); kr += __shfl_xor(kr, 32); rkr += __shfl_xor(rkr, 16); rkr += __shfl_xor(rkr, 32);
            if (quad == 0) *(f32x4*)(BRKR + (row * 24 + hh) * 4) = (f32x4){br, kr, rkr, 0.f};
        }
        if (tl0 == 496) { for (int e = c.tid; e < RW_SHIFT; e += 512) PTw[(size_t)b * RW_SHIFT + e] = P1[(size_t)(r0 + 15) * P1W + e]; }
    }
}

__device__ __forceinline__ void rwkv_item(const P& p, const Ctx& c, int seg, int w, bool save) {
    const int b = w / 24, hh = w % 24;
    const float* SW = (const float*)(c.seg + S1_W); const bf16_t* SA = (const bf16_t*)(c.seg + S1_A); const bf16_t* SB = (const bf16_t*)(c.seg + S1_B); const bf16_t* SK = (const bf16_t*)(c.seg + S1_K);
    const bf16_t* SQ = (const bf16_t*)(c.seg + S1_Q); const bf16_t* SV = (const bf16_t*)(c.seg + S1_V); const float* BRKR = (const float*)(c.seg + S1_BRKR);
    float* O = (float*)(c.seg + S1_O); float* RST = (float*)(p.ws + OFF_RST) + (size_t)w * 4096;
    constexpr int TB = 32, REC = 388;
    LAS float* L0 = (LAS float*)c.lds;
    const int rp = c.wv * 4 + (c.lane >> 4), cq = c.lane & 15;
    f32x2 S0a, S0b, S1a, S1b;
    if (seg > 0) { const f32x4 s0 = *(const f32x4*)(RST + (2 * rp) * 64 + cq * 4), s1 = *(const f32x4*)(RST + (2 * rp + 1) * 64 + cq * 4);
        S0a = (f32x2){s0[0], s0[1]}; S0b = (f32x2){s0[2], s0[3]}; S1a = (f32x2){s1[0], s1[1]}; S1b = (f32x2){s1[2], s1[3]}; }
    else { S0a = S0b = S1a = S1b = (f32x2){0.f, 0.f}; }
    const int e4 = c.tid * 4, stt = e4 >> 6, scc = e4 & 63;
    f32x4 gw; u32x2 ga, gb, gk, gq, gv; f32x4 gbr;
    auto gload = [&](int blk) { const size_t go = ((size_t)b * SEGT + blk * TB + stt) * DMIX + hh * 64 + scc;
        gw = *(const f32x4*)(SW + go); ga = *(const u32x2*)(SA + go); gb = *(const u32x2*)(SB + go); gk = *(const u32x2*)(SK + go); gq = *(const u32x2*)(SQ + go); gv = *(const u32x2*)(SV + go);
        if (c.tid < TB) gbr = *(const f32x4*)(BRKR + (((size_t)b * SEGT + blk * TB + c.tid) * 24 + hh) * 4); };
    auto lstore = [&](int buf) { LAS float* r = L0 + buf * (TB * REC) + stt * REC + scc;
        *(LAS f32x4*)(r) = gw; *(LAS f32x4*)(r + 64) = (f32x4){bflo(ga.x), bfhi(ga.x), bflo(ga.y), bfhi(ga.y)}; *(LAS f32x4*)(r + 128) = (f32x4){bflo(gb.x), bfhi(gb.x), bflo(gb.y), bfhi(gb.y)};
        *(LAS f32x4*)(r + 192) = (f32x4){bflo(gk.x), bfhi(gk.x), bflo(gk.y), bfhi(gk.y)}; *(LAS f32x4*)(r + 256) = (f32x4){bflo(gq.x), bfhi(gq.x), bflo(gq.y), bfhi(gq.y)};
        *(LAS f32x4*)(r + 320) = (f32x4){bflo(gv.x), bfhi(gv.x), bflo(gv.y), bfhi(gv.y)};
        if (c.tid < TB) { LAS float* q = L0 + buf * (TB * REC) + c.tid * REC + 384; *(LAS f32x2*)q = (f32x2){gbr[0], gbr[1]}; } };
    __syncthreads();
    gload(0); lstore(0);
    __syncthreads();
#pragma unroll 1
    for (int blk = 0; blk < SEGT / TB; ++blk) {
        const int buf = blk & 1;
        if (blk + 1 < SEGT / TB) gload(blk + 1);
        const LAS float* base = L0 + buf * (TB * REC);
        const size_t rowb = (size_t)b * SEGT + blk * TB;
        f32x4 nw4 = *(const LAS f32x4*)(base + cq * 4), na4 = *(const LAS f32x4*)(base + 64 + cq * 4), nb4 = *(const LAS f32x4*)(base + 128 + cq * 4), nk4 = *(const LAS f32x4*)(base + 192 + cq * 4), nq4 = *(const LAS f32x4*)(base + 256 + cq * 4);
        f32x2 nv2 = *(const LAS f32x2*)(base + 320 + 2 * rp), nbk = *(const LAS f32x2*)(base + 384);
#pragma unroll 2
        for (int tt = 0; tt < TB; ++tt) {
            const f32x4 w4 = nw4, a4 = na4, b4 = nb4, k4 = nk4, q4 = nq4; const f32x2 v2 = nv2, bk = nbk;
            { const LAS float* r = base + (tt + 1 < TB ? tt + 1 : tt) * REC;
              nw4 = *(const LAS f32x4*)(r + cq * 4); na4 = *(const LAS f32x4*)(r + 64 + cq * 4); nb4 = *(const LAS f32x4*)(r + 128 + cq * 4); nk4 = *(const LAS f32x4*)(r + 192 + cq * 4); nq4 = *(const LAS f32x4*)(r + 256 + cq * 4);
              nv2 = *(const LAS f32x2*)(r + 320 + 2 * rp); nbk = *(const LAS f32x2*)(r + 384); }
            const f32x2 wa = (f32x2){w4[0], w4[1]}, wb = (f32x2){w4[2], w4[3]}, aa = (f32x2){a4[0], a4[1]}, ab = (f32x2){a4[2], a4[3]}, ba = (f32x2){b4[0], b4[1]}, bb = (f32x2){b4[2], b4[3]};
            const f32x2 ka = (f32x2){k4[0], k4[1]}, kb = (f32x2){k4[2], k4[3]}, qa = (f32x2){q4[0], q4[1]}, qb = (f32x2){q4[2], q4[3]};
            f32x2 t0 = S0a * aa + S0b * ab, t1 = S0a * qa + S0b * qb, t2 = S1a * aa + S1b * ab, t3 = S1a * qa + S1b * qb;
            float pa0 = t0.x + t0.y, pt0 = t1.x + t1.y, pa1 = t2.x + t2.y, pt1 = t3.x + t3.y;
            row16_allsum4(pa0, pa1, pt0, pt1);
            const f32x2 pa0v = (f32x2){pa0, pa0}, pa1v = (f32x2){pa1, pa1}, v0v = (f32x2){v2.x, v2.x}, v1v = (f32x2){v2.y, v2.y};
            S0a = S0a * wa + pa0v * ba + v0v * ka; S0b = S0b * wb + pa0v * bb + v0v * kb;
            S1a = S1a * wa + pa1v * ba + v1v * ka; S1b = S1b * wb + pa1v * bb + v1v * kb;
            if (cq == 0) { const f32x2 y = (f32x2){pt0 + pa0 * bk.x + v2.x * bk.y, pt1 + pa1 * bk.x + v2.y * bk.y};
                *(f32x2*)(O + (rowb + tt) * DMIX + hh * 64 + 2 * rp) = y; }
        }
        if (blk + 1 < SEGT / TB) lstore(buf ^ 1);
        __syncthreads();
    }
    if (!save) return;
    *(f32x4*)(RST + (2 * rp) * 64 + cq * 4) = (f32x4){S0a.x, S0a.y, S0b.x, S0b.y}; *(f32x4*)(RST + (2 * rp + 1) * 64 + cq * 4) = (f32x4){S1a.x, S1a.y, S1b.x, S1b.y};
}

__device__ __forceinline__ void rwkv_chunk_item(const P& p, const Ctx& c, int seg, int w, bool save) {
    const int b = w / 24, hh = w % 24;
    const bf16_t* SA = (const bf16_t*)(c.seg + S1_A); const bf16_t* SB = (const bf16_t*)(c.seg + S1_B); const bf16_t* SK = (const bf16_t*)(c.seg + S1_K);
    const bf16_t* SR = (const bf16_t*)(c.seg + S1_Q); const bf16_t* SV = (const bf16_t*)(c.seg + S1_V); const float* GTB = (const float*)(c.seg + S1_W);
    bf16_t* O = (bf16_t*)(c.seg + S1_O); float* RST = (float*)(p.ws + OFF_RST) + (size_t)w * 4096;
    constexpr int O_EA = 0  , O_EB = 4608  , O_EBT = 9216  , O_UV = 14336  ,
                  O_MT1 = 19456  , O_NT = 20736  , O_MABT = 22016  ,
                  O_GT = 23296  , OPB = 23552;
    LAS unsigned char* OB = c.lds;
    LAS bf16_t* S0I = (LAS bf16_t*)(c.lds + 2 * OPB);
    LAS float* XF = (LAS float*)(c.lds + 2 * OPB + 9216);
    const int l15c = c.lane & 15, quadc = c.lane >> 4;
    f32x4 S[2];
#pragma unroll
    for (int x = 0; x < 2; ++x) { const int ti = c.wv * 2 + x, mt = ti >> 2, nt = ti & 3;
#pragma unroll
        for (int jj = 0; jj < 4; ++jj) S[x][jj] = (seg > 0) ? RST[(mt * 16 + quadc * 4 + jj) * 64 + nt * 16 + l15c] : 0.f; }
    unsigned ga = 0, gb = 0, gk = 0, gr = 0, gv = 0; float gg = 1.f;
    auto gload = [&](int ch, int tidv) { const int t = tidv >> 5, j0 = (tidv & 31) * 2; const size_t go = ((size_t)b * SEGT + ch * 16 + t) * DMIX + hh * 64 + j0;
        ga = *(const unsigned*)(SA + go); gb = *(const unsigned*)(SB + go); gk = *(const unsigned*)(SK + go); gr = *(const unsigned*)(SR + go); gv = *(const unsigned*)(SV + go);
        if (tidv < 64) gg = GTB[((size_t)(b * 32 + ch) * 24 + hh) * 64 + tidv]; };
    auto lstore = [&](int pb, int tidv) { const int t = tidv >> 5, j0 = (tidv & 31) * 2;
        LAS bf16_t* EA = (LAS bf16_t*)(OB + pb * OPB + O_EA); LAS bf16_t* EB = (LAS bf16_t*)(OB + pb * OPB + O_EB); LAS bf16_t* EBT = (LAS bf16_t*)(OB + pb * OPB + O_EBT);
        LAS bf16_t* UV = (LAS bf16_t*)(OB + pb * OPB + O_UV); LAS float* GT = (LAS float*)(OB + pb * OPB + O_GT);
        *(LAS unsigned*)(EA + t * 72 + j0) = ga; *(LAS unsigned*)(EA + (16 + t) * 72 + j0) = gr;
        *(LAS unsigned*)(EB + t * 72 + j0) = gb; *(LAS unsigned*)(EB + (16 + t) * 72 + j0) = gk;
        EBT[j0 * 40 + t] = (bf16_t)(gb & 0xFFFFu); EBT[(j0 + 1) * 40 + t] = (bf16_t)(gb >> 16); EBT[j0 * 40 + 16 + t] = (bf16_t)(gk & 0xFFFFu); EBT[(j0 + 1) * 40 + 16 + t] = (bf16_t)(gk >> 16);
        UV[j0 * 40 + 16 + t] = (bf16_t)(gv & 0xFFFFu); UV[(j0 + 1) * 40 + 16 + t] = (bf16_t)(gv >> 16); UV[j0 * 40 + t] = 0; UV[(j0 + 1) * 40 + t] = 0;
        if (tidv < 64) GT[tidv] = gg; };
    auto gtile = [&](int pb, int l15, int quad) {
        LAS bf16_t* EA = (LAS bf16_t*)(OB + pb * OPB + O_EA); LAS bf16_t* EB = (LAS bf16_t*)(OB + pb * OPB + O_EB);
        LAS bf16_t* MT1 = (LAS bf16_t*)(OB + pb * OPB + O_MT1); LAS bf16_t* NT = (LAS bf16_t*)(OB + pb * OPB + O_NT); LAS float* MABT = (LAS float*)(OB + pb * OPB + O_MABT);
        const int sb = c.wv >> 1, tb = c.wv & 1; f32x4 g = (f32x4){0.f, 0.f, 0.f, 0.f};
#pragma unroll
        for (int kk = 0; kk < 2; ++kk) g = mfma16(*(const LAS bf16x8*)(EB + (sb * 16 + l15) * 72 + kk * 32 + quad * 8), *(const LAS bf16x8*)(EA + (tb * 16 + l15) * 72 + kk * 32 + quad * 8), g);
#pragma unroll
        for (int jj = 0; jj < 4; ++jj) { const int s2 = quad * 4 + jj, tt = l15; const float v = g[jj];
            if (tb == 0) { const float m = (s2 < tt) ? v : 0.f; if (sb == 0) { MABT[tt * 20 + s2] = m; MT1[tt * 40 + s2] = 0; } else MT1[tt * 40 + 16 + s2] = f2bf(m); }
            else { const float m = (s2 <= tt) ? v : 0.f; NT[tt * 40 + sb * 16 + s2] = f2bf(m); } } };
    auto simg = [&](int l15, int quad) {
#pragma unroll
        for (int x = 0; x < 2; ++x) { const int ti = c.wv * 2 + x, mt = ti >> 2, nt = ti & 3;
#pragma unroll
            for (int jj = 0; jj < 4; ++jj) S0I[(mt * 16 + quad * 4 + jj) * 72 + nt * 16 + l15] = f2bf(S[x][jj]); } };
    __syncthreads();
    { int t0 = c.tid; asm volatile("" : "+v"(t0)); gload(0, t0); lstore(0, t0); simg(l15c, quadc); }
    lds_barrier();
    if (c.wv < 4) gtile(0, l15c, quadc);
    { int t1 = c.tid; asm volatile("" : "+v"(t1)); gload(1, t1); }
    const int mtq = c.wv & 3;
#pragma unroll 1
    for (int ch = 0; ch < SEGT / 16; ++ch) {
        const int pb = ch & 1;
        int tidv = c.tid, l15 = l15c, quad = quadc; asm volatile("" : "+v"(tidv), "+v"(l15), "+v"(quad));
        LAS bf16_t* EA = (LAS bf16_t*)(OB + pb * OPB + O_EA); LAS bf16_t* EBT = (LAS bf16_t*)(OB + pb * OPB + O_EBT); LAS bf16_t* UV = (LAS bf16_t*)(OB + pb * OPB + O_UV);
        LAS bf16_t* MT1 = (LAS bf16_t*)(OB + pb * OPB + O_MT1); LAS bf16_t* NT = (LAS bf16_t*)(OB + pb * OPB + O_NT); LAS float* MABT = (LAS float*)(OB + pb * OPB + O_MABT); LAS float* GT = (LAS float*)(OB + pb * OPB + O_GT);
        lds_barrier();
        f32x4 Zt = (f32x4){0.f, 0.f, 0.f, 0.f};
        if (c.wv >= 4) {
            f32x4 Xt = (f32x4){0.f, 0.f, 0.f, 0.f};
#pragma unroll
            for (int kk = 0; kk < 2; ++kk) { const bf16x8 a = *(const LAS bf16x8*)(S0I + (mtq * 16 + l15) * 72 + kk * 32 + quad * 8);
                Xt = mfma16(a, *(const LAS bf16x8*)(EA + l15 * 72 + kk * 32 + quad * 8), Xt); Zt = mfma16(a, *(const LAS bf16x8*)(EA + (16 + l15) * 72 + kk * 32 + quad * 8), Zt); }
            Xt = mfma16(*(const LAS bf16x8*)(UV + (mtq * 16 + l15) * 40 + quad * 8), *(const LAS bf16x8*)(MT1 + l15 * 40 + quad * 8), Xt);
#pragma unroll
            for (int jj = 0; jj < 4; ++jj) XF[(mtq * 16 + quad * 4 + jj) * 17 + l15] = Xt[jj];
        }
        lds_barrier();
        if (ch + 1 < SEGT / 16) lstore(pb ^ 1, tidv);
        if (ch + 2 < SEGT / 16) gload(ch + 2, tidv);
        if (c.wv == 0) {
            float u[16];
#pragma unroll
            for (int tt = 0; tt < 16; ++tt) { float acc = XF[c.lane * 17 + tt];
#pragma unroll
                for (int s4 = 0; s4 < (tt + 3) / 4; ++s4) { const f32x4 m = *(const LAS f32x4*)(MABT + tt * 20 + s4 * 4);
#pragma unroll
                    for (int e = 0; e < 4; ++e) if (s4 * 4 + e < tt) acc += u[s4 * 4 + e] * m[e]; }
                u[tt] = acc; }
            *(LAS u32x4*)(UV + c.lane * 40) = (u32x4){pk2(u[0], u[1]), pk2(u[2], u[3]), pk2(u[4], u[5]), pk2(u[6], u[7])};
            *(LAS u32x4*)(UV + c.lane * 40 + 8) = (u32x4){pk2(u[8], u[9]), pk2(u[10], u[11]), pk2(u[12], u[13]), pk2(u[14], u[15])};
        }
        lds_barrier();
        if (c.wv >= 4) {
            Zt = mfma16(*(const LAS bf16x8*)(UV + (mtq * 16 + l15) * 40 + quad * 8), *(const LAS bf16x8*)(NT + l15 * 40 + quad * 8), Zt);
            *(u32x2*)(O + ((size_t)b * SEGT + ch * 16 + l15) * DMIX + hh * 64 + mtq * 16 + quad * 4) = (u32x2){pk2(Zt[0], Zt[1]), pk2(Zt[2], Zt[3])};
        }
#pragma unroll
        for (int x = 0; x < 2; ++x) { const int ti = c.wv * 2 + x, mt = ti >> 2, nt = ti & 3;
            S[x] = mfma16(*(const LAS bf16x8*)(UV + (mt * 16 + l15) * 40 + quad * 8), *(const LAS bf16x8*)(EBT + (nt * 16 + l15) * 40 + quad * 8), S[x]);
            const float gt = GT[nt * 16 + l15];
#pragma unroll
            for (int jj = 0; jj < 4; ++jj) S[x][jj] *= gt; }
        simg(l15, quad);
        if (c.wv < 4 && ch + 1 < SEGT / 16) gtile(pb ^ 1, l15, quad);
    }
    if (!save) return;
#pragma unroll
    for (int x = 0; x < 2; ++x) { const int ti = c.wv * 2 + x, mt = ti >> 2, nt = ti & 3;
#pragma unroll
        for (int jj = 0; jj < 4; ++jj) RST[(mt * 16 + quadc * 4 + jj) * 64 + nt * 16 + l15c] = S[x][jj]; }
}

__device__ __forceinline__ void phase_b3(const P& p, const Ctx& c) {
    const bf16_t* O = (const bf16_t*)(c.seg + S1_O); const bf16_t* P2 = (const bf16_t*)(c.seg + S1_P2); const bf16_t* SV = (const bf16_t*)(c.seg + S1_V); const bf16_t* SG = (const bf16_t*)(c.seg + S1_G);
    const float* BRKR = (const float*)(c.seg + S1_BRKR); const bf16_t* YM = (const bf16_t*)(c.seg + S1_YMEM); bf16_t* Y = (bf16_t*)(c.seg + S1_Y);
    for (int r = c.bid * 8 + c.wv; r < MS; r += c.G * 8) {
#pragma unroll
        for (int ps = 0; ps < 3; ++ps) {
            const int hh = ps * 8 + (c.lane >> 3), ch = hh * 64 + (c.lane & 7) * 8;
            const u32x4 orr = *(const u32x4*)(O + (size_t)r * DMIX + ch);
            float v[8] = {bflo(orr.x), bfhi(orr.x), bflo(orr.y), bfhi(orr.y), bflo(orr.z), bfhi(orr.z), bflo(orr.w), bfhi(orr.w)}; float s = 0.f, s2 = 0.f;
#pragma unroll
            for (int j = 0; j < 8; ++j) { s += v[j]; s2 += v[j] * v[j]; }
            s += __shfl_xor(s, 1); s2 += __shfl_xor(s2, 1); s += __shfl_xor(s, 2); s2 += __shfl_xor(s2, 2); s += __shfl_xor(s, 4); s2 += __shfl_xor(s2, 4);
            const float mean = s * (1.0f / 64.0f), var = fmaxf(s2 * (1.0f / 64.0f) - mean * mean, 0.f), rs = rsqrtf(var + 64e-5f);
            const float rkr = BRKR[((size_t)r * 24 + hh) * 4 + 2];
            const u32x4 vr = *(const u32x4*)(SV + (size_t)r * DMIX + ch), gr = *(const u32x4*)(SG + (size_t)r * DMIX + ch), zr = *(const u32x4*)(P2 + (size_t)r * P2W + 512 + ch);
            const float vv[8] = {bflo(vr.x), bfhi(vr.x), bflo(vr.y), bfhi(vr.y), bflo(vr.z), bfhi(vr.z), bflo(vr.w), bfhi(vr.w)};
            const float gg[8] = {bflo(gr.x), bfhi(gr.x), bflo(gr.y), bfhi(gr.y), bflo(gr.z), bfhi(gr.z), bflo(gr.w), bfhi(gr.w)};
            const float zz[8] = {bflo(zr.x), bfhi(zr.x), bflo(zr.y), bfhi(zr.y), bflo(zr.z), bfhi(zr.z), bflo(zr.w), bfhi(zr.w)};
            float y[8];
#pragma unroll
            for (int j = 0; j < 8; ++j) { const float t = ((v[j] - mean) * rs * p.rw_lnx_g[ch + j] + p.rw_lnx_b[ch + j] + rkr * vv[j]) * gg[j]; y[j] = t * siluf_(zz[j]); }
            *(u32x4*)(Y + (size_t)r * DIN + ch) = (u32x4){pk2(y[0], y[1]), pk2(y[2], y[3]), pk2(y[4], y[5]), pk2(y[6], y[7])};
        }
        { const int cm = c.lane * 8; const u32x4 mr = *(const u32x4*)(YM + (size_t)r * DX + cm), zr = *(const u32x4*)(P2 + (size_t)r * P2W + 512 + DMIX + cm);
          const float mm[8] = {bflo(mr.x), bfhi(mr.x), bflo(mr.y), bfhi(mr.y), bflo(mr.z), bfhi(mr.z), bflo(mr.w), bfhi(mr.w)};
          const float zz[8] = {bflo(zr.x), bfhi(zr.x), bflo(zr.y), bfhi(zr.y), bflo(zr.z), bfhi(zr.z), bflo(zr.w), bfhi(zr.w)};
          float y[8];
#pragma unroll
          for (int j = 0; j < 8; ++j) y[j] = mm[j] * siluf_(zz[j]);
          *(u32x4*)(Y + (size_t)r * DIN + DMIX + cm) = (u32x4){pk2(y[0], y[1]), pk2(y[2], y[3]), pk2(y[4], y[5]), pk2(y[6], y[7])}; }
    }
}

__device__ __forceinline__ bool fresh_ctx(Ctx& c, P& p, unsigned char* ws0) { int t = threadIdx.x; asm volatile("" : "+v"(t)); c.tid = t; c.wv = __builtin_amdgcn_readfirstlane(t >> 6); c.lane = t & 63;
    int bb = (int)blockIdx.x, gg = (int)gridDim.x; asm volatile("" : "+s"(bb), "+s"(gg)); c.bid = bb; c.G = gg;
#if defined(__HIP_DEVICE_COMPILE__)
    { typedef const __attribute__((address_space(4))) unsigned long long* KP; KP kp = (KP)__builtin_amdgcn_kernarg_segment_ptr(); asm volatile("" : "+s"(kp));
      typedef __attribute__((address_space(1))) char* GP; char** dst = (char**)&p;
#pragma unroll
      for (int i = 0; i < (int)(sizeof(P) / 8); ++i) dst[i] = (char*)(GP)(kp[i]); }
#endif
    size_t z = 0; asm volatile("" : "+s"(z)); p.ws = ws0 + z; c.seg = ws0 + z + OFF_SEG;
    return true; }
__global__ __launch_bounds__(512) void fwd_megakernel(P p_arg) {
    P p = p_arg;
    extern __shared__ __attribute__((aligned(16))) unsigned char shm[];
    LAS unsigned char* lds = (LAS unsigned char*)shm;
    Ctx c; c.tid = threadIdx.x; c.wv = threadIdx.x >> 6; c.lane = threadIdx.x & 63; c.G = gridDim.x; c.bid = blockIdx.x; c.lds = lds; c.seg = p.ws + OFF_SEG;
    volatile LAS unsigned* st = (volatile LAS unsigned*)(lds + LDS_BYTES - 16);
    if (c.tid == 0) { st[0] = 0u; st[1] = 0u; }
    __syncthreads();
    const XcdBarrier xb = xcd_barrier_post((unsigned*)(p.ws + OFF_BAR), st);
#define GSYNC() do { XcdBarrier _xl = xb; size_t _zz = 0; asm volatile("" : "+s"(_zz)); _xl.bar = xb.bar + _zz; _xl.x = xb_xcc_id();     \
        xcd_barrier(_xl); if (RK == 20) { for (int _q = 1; _q < RN; ++_q) xcd_barrier(_xl); } } while (0)
#ifndef RK
#define RK -1
#endif
#ifndef RN
#define RN 1
#endif
#define NREP(k) ((k) == RK ? RN : 1)
#define PH(k) for (int _r = 0; _r < NREP(k); ++_r) if (fresh_ctx(c, p, p_arg.ws))
#define LASTREP(k) (_r + 1 == NREP(k))
    PH(0) phase0(p, c);
    PH(1) phase_apre(p, c, 0, c.bid, c.G);
    GSYNC();
    for (int seg = 0; seg < NSEG; ++seg) {
        PH(2) { SchedA0 S; S.ws = p.ws; S.seg = c.seg; S.G = c.G; S.c = c.bid; S.nextra = (seg == 0) ? 64 : 0;
          pg8::gemm_phase<pg8::EpiBf, SchedA0>(lds, c.tid, 1024, 1024, S, pg8::EpiBf{}); }
        GSYNC();
        PH(3) phase_a1(p, c, seg);
        GSYNC();
        for (int it0 = c.bid; it0 < 256; it0 += c.G) {
            const int xq = it0 & 7, yq = it0 >> 3; const int it = (yq < 24) ? ((xq * 4 + yq / 6) * 6 + yq % 6) : (192 + (yq - 24) * 8 + xq);
            if (it < 192) { PH(4) mlstm_item(p, c, seg, it, LASTREP(4)); }
            else { PH(5) attn_item(p, c, 0, it - 192, (const bf16_t*)(c.seg + S0_P0) + DMIX, ML_W, (bf16_t*)(c.seg + S0_YMEM)); }
        }
        GSYNC();
        PH(6) phase_a3(p, c, seg);
        GSYNC();
        PH(7) { SchedOut S; S.Y = (const char*)(c.seg + S0_Y); S.W = (const char*)(p.ws + OFF_WO0T); S.slab = (char*)(c.seg + S0_SLAB); S.G = c.G; S.c = c.bid;
          pg8::gemm_phase<pg8::EpiBf, SchedOut>(lds, c.tid, DIN, 512, S, pg8::EpiBf{}); }
        GSYNC();
        PH(8) phase_a5(p, c, seg);
        GSYNC();
        PH(9) { SchedB0 S; S.ws = p.ws; S.seg = c.seg; S.G = c.G; S.c = c.bid;
          pg8::gemm_phase<pg8::EpiBf, SchedB0>(lds, c.tid, 1024, 1024, S, pg8::EpiBf{}); }
        GSYNC();
        PH(10) phase_b1(p, c, seg);
        GSYNC();
        for (int it = c.bid; it < 256; it += c.G) {
            if (it < 192) { PH(11) rwkv_chunk_item(p, c, seg, it, LASTREP(11)); }
            else { PH(5) attn_item(p, c, 1, it - 192, (const bf16_t*)(c.seg + S1_P2), P2W, (bf16_t*)(c.seg + S1_YMEM));
                   if (c.G == 256) { PH(1) if (seg + 1 < NSEG) phase_apre(p, c, seg + 1, it - 192, 64); } }
        }
        GSYNC();
        PH(12) phase_b3(p, c);
        GSYNC();
        PH(13) { SchedOut S; S.Y = (const char*)(c.seg + S1_Y); S.W = (const char*)(p.ws + OFF_WO1T); S.slab = (char*)(c.seg + S1_SLAB); S.G = c.G; S.c = c.bid;
          pg8::gemm_phase<pg8::EpiBf, SchedOut>(lds, c.tid, DIN, 512, S, pg8::EpiBf{}); }
        GSYNC();
        PH(14) phase_b5(p, c, seg);
        if (c.G != 256) { PH(1) if (seg + 1 < NSEG) phase_apre(p, c, seg + 1, c.bid, c.G); GSYNC(); }
    }
}

extern "C" void kernel_launch(void* const* d_in, const int* in_sizes, int n_in, void* d_out, int out_size, void* d_ws, size_t ws_size, hipStream_t stream) {
    static int grid = 0;
    if (grid == 0) {
        int dev = 0, cus = 0, per_cu = 0;
        if (hipGetDevice(&dev) != hipSuccess || hipDeviceGetAttribute(&cus, hipDeviceAttributeMultiprocessorCount, dev) != hipSuccess) { grid = -1; return; }
        if (hipFuncSetAttribute((const void*)fwd_megakernel, hipFuncAttributeMaxDynamicSharedMemorySize, LDS_BYTES) != hipSuccess) { fprintf(stderr, "hipFuncSetAttribute failed\n"); grid = -1; return; }
        if (hipOccupancyMaxActiveBlocksPerMultiprocessor(&per_cu, (const void*)fwd_megakernel, 512, LDS_BYTES) != hipSuccess || per_cu < 1) { fprintf(stderr, "occupancy query: %d\n", per_cu); }
        (void)hipGetLastError();
        grid = cus;
        if (n_in != 31 || ws_size < 256 * MiB) { fprintf(stderr, "unexpected n_in %d / ws %zu\n", n_in, ws_size); grid = -1; return; }
    }
    if (grid < 0) return;
    (void)hipMemsetAsync((char*)d_ws + OFF_BAR, 0, XCD_BAR_WORDS * 4, stream);
    P p{};
    const float** f = (const float**)&p;
    for (int i = 0; i < 31; ++i) f[i] = (const float*)d_in[i];
    p.out = (float*)d_out; p.ws = (unsigned char*)d_ws;
    fwd_megakernel<<<dim3(grid), dim3(512), LDS_BYTES, stream>>>(p);
}
```

```cpp
#include <hip/hip_runtime.h>
#include <cstdio>
#include <cstdint>

#define LAS __attribute__((address_space(3)))
typedef unsigned short bf16_t;
typedef short bf16x8 __attribute__((ext_vector_type(8)));
typedef short bf16x4 __attribute__((ext_vector_type(4)));
typedef float f32x4 __attribute__((ext_vector_type(4)));
typedef float f32x2 __attribute__((ext_vector_type(2)));
typedef unsigned u32x4 __attribute__((ext_vector_type(4)));
typedef unsigned u32x2 __attribute__((ext_vector_type(2)));

constexpr int NB = 8, SEQ = 2048, DM = 1024, NSEG = 4, SEGT = 512, MS = NB * SEGT;
constexpr int DMIX = 1536, DX = 512, DIN = 2048;
constexpr int ML_W = 4096, RW_SHIFT = 4896, RW_W = 7456;
constexpr int P1W = 5120, P2W = 2560;
constexpr size_t MiB = 1u << 20;
constexpr size_t OFF_WT0 = 0, OFF_WT1 = 8 * MiB, OFF_WO0T = 23 * MiB, OFF_WO1T = 27 * MiB, OFF_WKVT = 31 * MiB  ,
                 OFF_KMEM = 35 * MiB  , OFF_LORAT = 43 * MiB, OFF_MISC = 45 * MiB,
                 OFF_CST = 46 * MiB, OFF_NST = 65 * MiB, OFF_RST = 65 * MiB + 512 * 1024, OFF_H = 69 * MiB, OFF_VF = 77 * MiB,
                 OFF_SEG = 89 * MiB, OFF_MEMN = 248 * MiB;
constexpr size_t OFF_BAR = OFF_MISC, OFF_UTAIL = OFF_MISC + 64 * 1024, OFF_PTAIL = OFF_MISC + 256 * 1024;
constexpr size_t S0_P0 = 0, S0_Q = 32 * MiB, S0_K = 44 * MiB, S0_KT = 56 * MiB, S0_VT = 68 * MiB, S0_XC = 80 * MiB, S0_HRAW = 92 * MiB,
                 S0_YMEM = 116 * MiB, S0_Y = 120 * MiB, S0_GATE = 136 * MiB;
constexpr size_t S1_P1 = 0, S1_O = 0, S1_Y = 24 * MiB, S1_P2 = 40 * MiB, S1_W = 60 * MiB, S1_A = 84 * MiB, S1_B = 96 * MiB, S1_K = 108 * MiB,
                 S1_Q = 120 * MiB, S1_V = 132 * MiB, S1_G = 144 * MiB, S1_YMEM = 156 * MiB, S1_BRKR = 160 * MiB;
constexpr size_t S0_SLAB = 0  , S1_SLAB = 84 * MiB  ;
constexpr int LDS_BYTES = 150 * 1024;

struct P {
    const float *x, *mem, *norm_g, *mem_norm_g, *mem_kv_w, *w_out, *ml_w_in, *ml_conv_w, *ml_conv_b, *ml_wq, *ml_wk, *ml_wv, *ml_w_gate, *ml_b_gate,
        *ml_mhn_g, *ml_skip, *rw_w_in, *rw_mu, *rw_w_lora2, *rw_w0, *rw_a_lora2, *rw_a0, *rw_v_lora2, *rw_v0, *rw_g_lora2, *rw_k_k, *rw_k_a, *rw_r_k,
        *rw_lnx_g, *rw_lnx_b, *final_g;
    float* out; unsigned char* ws;
};

__device__ __forceinline__ bf16_t f2bf(float f) { const __bf16 r = (__bf16)f; bf16_t u; __builtin_memcpy(&u, &r, 2); return u; }
__device__ __forceinline__ float bf2f(bf16_t b) { return __uint_as_float(((unsigned)b) << 16); }
typedef __bf16 bf2_t __attribute__((ext_vector_type(2)));
__device__ __forceinline__ unsigned pk2(float lo, float hi) { const bf2_t r = __builtin_convertvector((f32x2){lo, hi}, bf2_t); unsigned u; __builtin_memcpy(&u, &r, 4); return u; }
__device__ __forceinline__ float bflo(unsigned u) { return __uint_as_float(u << 16); }
__device__ __forceinline__ float bfhi(unsigned u) { return __uint_as_float(u & 0xFFFF0000u); }
__device__ __forceinline__ float wsum(float v) {
#pragma unroll
    for (int o = 32; o >= 1; o >>= 1) v += __shfl_xor(v, o);
    return v;
}
__device__ __forceinline__ float frcp(float x) { return __builtin_amdgcn_rcpf(x); }
__device__ __forceinline__ float sigmoidf_(float x) { return frcp(1.0f + __expf(-x)); }
__device__ __forceinline__ float siluf_(float x) { return x * frcp(1.0f + __expf(-x)); }
__device__ __forceinline__ float softplusf_(float z) { return fmaxf(z, 0.f) + __logf(1.0f + __expf(-fabsf(z))); }
template <int CTRL> __device__ __forceinline__ float dpp_add(float v) {
    return v + __int_as_float(__builtin_amdgcn_update_dpp(0, __float_as_int(v), CTRL, 0xF, 0xF, true));
}
__device__ __forceinline__ float row16_allsum(float v) {
    v = dpp_add<0xB1>(v);
    v = dpp_add<0x4E>(v);
    v = dpp_add<0x141>(v);
    v = dpp_add<0x140>(v);
    return v;
}
__device__ __forceinline__ void row16_allsum4(float& a, float& b, float& c, float& d) {
    asm volatile("s_nop 1\n\t"
        "v_add_f32_dpp %0, %0, %0 quad_perm:[1,0,3,2] row_mask:0xf bank_mask:0xf\n\t" "v_add_f32_dpp %1, %1, %1 quad_perm:[1,0,3,2] row_mask:0xf bank_mask:0xf\n\t"
        "v_add_f32_dpp %2, %2, %2 quad_perm:[1,0,3,2] row_mask:0xf bank_mask:0xf\n\t" "v_add_f32_dpp %3, %3, %3 quad_perm:[1,0,3,2] row_mask:0xf bank_mask:0xf\n\t"
        "v_add_f32_dpp %0, %0, %0 quad_perm:[2,3,0,1] row_mask:0xf bank_mask:0xf\n\t" "v_add_f32_dpp %1, %1, %1 quad_perm:[2,3,0,1] row_mask:0xf bank_mask:0xf\n\t"
        "v_add_f32_dpp %2, %2, %2 quad_perm:[2,3,0,1] row_mask:0xf bank_mask:0xf\n\t" "v_add_f32_dpp %3, %3, %3 quad_perm:[2,3,0,1] row_mask:0xf bank_mask:0xf\n\t"
        "v_add_f32_dpp %0, %0, %0 row_half_mirror row_mask:0xf bank_mask:0xf\n\t" "v_add_f32_dpp %1, %1, %1 row_half_mirror row_mask:0xf bank_mask:0xf\n\t"
        "v_add_f32_dpp %2, %2, %2 row_half_mirror row_mask:0xf bank_mask:0xf\n\t" "v_add_f32_dpp %3, %3, %3 row_half_mirror row_mask:0xf bank_mask:0xf\n\t"
        "v_add_f32_dpp %0, %0, %0 row_mirror row_mask:0xf bank_mask:0xf\n\t" "v_add_f32_dpp %1, %1, %1 row_mirror row_mask:0xf bank_mask:0xf\n\t"
        "v_add_f32_dpp %2, %2, %2 row_mirror row_mask:0xf bank_mask:0xf\n\t" "v_add_f32_dpp %3, %3, %3 row_mirror row_mask:0xf bank_mask:0xf\n\t"
        "s_nop 1"
        : "+v"(a), "+v"(b), "+v"(c), "+v"(d));
}
template <int N> __device__ __forceinline__ float dpp_shr_or1(float v) {
    return __int_as_float(__builtin_amdgcn_update_dpp(0x3f800000, __float_as_int(v), 0x110 + N, 0xF, 0xF, false));
}
__device__ __forceinline__ f32x4 mfma16(bf16x8 a, bf16x8 b, f32x4 c) { return __builtin_amdgcn_mfma_f32_16x16x32_bf16(a, b, c, 0, 0, 0); }

namespace pg8 {
constexpr int BM = 256, BK = 64, HALF = 128, HTB = HALF * BK * 2, STAGE_BYTES = 8 * HTB, NXCD = 8, WGM = 8;
__host__ __device__ __forceinline__ int lds_byte(int r, int c) { const int st = (r >> 4) * 2 + (c >> 5), rr = r & 15, cc = c & 31, ob = rr * 64 + cc * 2; return st * 1024 + (ob ^ (((ob >> 9) & 1) << 5)); }
__host__ __device__ __forceinline__ void stage_rc(int b, int& R, int& C) { const int st = b / 1024, sb = b % 1024, swz = sb ^ (((sb >> 9) & 1) << 5); R = (st >> 1) * 16 + swz / 64; C = (st & 1) * 32 + (swz % 64) / 2; }
__host__ __device__ __forceinline__ int perm32(int rho) { const int n = rho >> 4, i = rho & 15; return 8 * (i >> 2) + 4 * n + (i & 3); }

struct Unit { const char* A; const char* B; char* O; int ldc; int pad; };

__device__ __forceinline__ void remap(int wgid, int nM, int nN, int& pm, int& pn) {
    const int nwg = nM * nN;
    { const int q = nwg / NXCD, r = nwg % NXCD, xcd = wgid % NXCD, off = wgid / NXCD; wgid = (xcd < r ? xcd * (q + 1) : r * (q + 1) + (xcd - r) * q) + off; }
    const int nig = WGM * nN, gid = wgid / nig, fm = gid * WGM, gsz = (nM - fm) < WGM ? (nM - fm) : WGM;
    pm = fm + ((wgid % nig) % gsz); pn = (wgid % nig) / gsz;
}

struct EpiBf {
    static constexpr bool PERM = true;
    __device__ __forceinline__ void operator()(const f32x4 (&acc)[2][2][4][2], const Unit& u, int wr, int wc, int fr, int fq) const {
        asm volatile("" : "+v"(fr), "+v"(fq));
        bf16_t* base = (bf16_t*)u.O;
#pragma unroll
        for (int ai = 0; ai < 2; ++ai)
#pragma unroll
            for (int m = 0; m < 4; ++m) { bf16_t* rowp = base + (size_t)(ai * HALF + wr * 64 + m * 16 + fr) * u.ldc + wc * 32 + 8 * fq;
#pragma unroll
                for (int bj = 0; bj < 2; ++bj) { const f32x4 v0 = acc[ai][bj][m][0], v1 = acc[ai][bj][m][1];
                    u32x4 w; w.x = pk2(v0[0], v0[1]); w.y = pk2(v0[2], v0[3]); w.z = pk2(v1[0], v1[1]); w.w = pk2(v1[2], v1[3]);
                    *(u32x4*)(rowp + bj * HALF) = w; } }
    }
};
struct EpiAtomic {
    static constexpr bool PERM = false;
    __device__ __forceinline__ void operator()(const f32x4 (&acc)[2][2][4][2], const Unit& u, int wr, int wc, int fr, int fq) const {
        asm volatile("" : "+v"(fr), "+v"(fq));
        float* base = (float*)u.O;
#pragma unroll
        for (int ai = 0; ai < 2; ++ai)
#pragma unroll
            for (int m = 0; m < 4; ++m) { float* rowp = base + (size_t)(ai * HALF + wr * 64 + m * 16 + fr) * u.ldc + wc * 32 + 4 * fq;
#pragma unroll
                for (int bj = 0; bj < 2; ++bj)
#pragma unroll
                    for (int n = 0; n < 2; ++n) { const f32x4 v = acc[ai][bj][m][n]; float* q = rowp + bj * HALF + n * 16;
#pragma unroll
                        for (int e = 0; e < 4; ++e) (void)__hip_atomic_fetch_add(q + e, v[e], __ATOMIC_RELAXED, __HIP_MEMORY_SCOPE_AGENT); }
                __builtin_amdgcn_sched_barrier(0); }
    }
};

template <class Epi, class Sched>
__device__ __forceinline__ void gemm_phase(LAS unsigned char* lds, const int tid, const int ldk, const int Kloop, const Sched& S, const Epi& E) {
    const int wid = __builtin_amdgcn_readfirstlane(tid >> 6), lane = tid & 63, wr = wid >> 2, wc = wid & 3, fr = lane & 15, fq = lane >> 4;
    const int nt = Kloop / BK;
    unsigned voffA[2], voffB[2];
#pragma unroll
    for (int i = 0; i < 2; ++i) { int R, C; stage_rc(tid * 16 + i * 8192, R, C); const int Rb = Epi::PERM ? ((R & ~31) + perm32(R & 31)) : R;
        voffA[i] = (unsigned)(R * ldk + C) * 2u; voffB[i] = (unsigned)(Rb * ldk + C) * 2u; }
    const size_t kstep = (size_t)(BK * 2);
    const size_t hstep = (size_t)HALF * ldk * 2;
    const unsigned ldsw = (unsigned)wid * 1024u;
    const int aoff = lds_byte(wr * 64 + fr, fq * 8), boff = lds_byte(wc * 32 + fr, fq * 8);
#define PG8_SA(b, h) (((b) * 2 + (h)) * HTB)
#define PG8_SB(b, h) ((4 + (b) * 2 + (h)) * HTB)
#define PG8_STAGE(bufoff, gbase, voff) do { _Pragma("unroll") for (int _i = 0; _i < 2; ++_i) \
        __builtin_amdgcn_global_load_lds((const unsigned*)((const char*)(gbase) + (voff)[_i]), (LAS unsigned*)(lds + (bufoff) + ldsw + _i * 8192), 16, 0, 0); } while (0)
#define PG8_LDA(dst, b, h) do { _Pragma("unroll") for (int m = 0; m < 4; ++m) _Pragma("unroll") for (int k = 0; k < 2; ++k) dst[m][k] = *(const LAS bf16x8*)(lds + PG8_SA(b, h) + aoff + m * 2048 + k * 1024); } while (0)
#define PG8_LDB(dst, b, h) do { _Pragma("unroll") for (int n = 0; n < 2; ++n) _Pragma("unroll") for (int k = 0; k < 2; ++k) dst[n][k] = *(const LAS bf16x8*)(lds + PG8_SB(b, h) + boff + n * 2048 + k * 1024); } while (0)
#define PG8_MMA(ai, bj, At, Bt) do { __builtin_amdgcn_s_setprio(1); _Pragma("unroll") for (int m = 0; m < 4; ++m) _Pragma("unroll") for (int n = 0; n < 2; ++n) _Pragma("unroll") for (int k = 0; k < 2; ++k) \
        acc[ai][bj][m][n] = __builtin_amdgcn_mfma_f32_16x16x32_bf16(Bt[n][k], At[m][k], acc[ai][bj][m][n], 0, 0, 0); __builtin_amdgcn_s_setprio(0); } while (0)
#define PG8_WAIT_V(n) asm volatile("s_waitcnt vmcnt(" #n ")" ::: "memory")
#define PG8_WAIT_L(n) asm volatile("s_waitcnt lgkmcnt(" #n ")" ::: "memory")
#define PG8_BAR __builtin_amdgcn_s_barrier()
#define PG8_SCHED __builtin_amdgcn_sched_barrier(0)
    Unit cur, nxt; int ui = 0;
    if (!S.next(0, cur)) return;
    f32x4 acc[2][2][4][2];
#pragma unroll
    for (int a = 0; a < 2; ++a)
#pragma unroll
        for (int b = 0; b < 2; ++b)
#pragma unroll
            for (int m = 0; m < 4; ++m)
#pragma unroll
                for (int n = 0; n < 2; ++n) acc[a][b][m][n] = (f32x4){0.f, 0.f, 0.f, 0.f};
    bf16x8 At[4][2], B0[2][2], B1[2][2];
    const char* cA = cur.A; const char* cB = cur.B;
    PG8_STAGE(PG8_SB(0, 0), cB, voffB); PG8_STAGE(PG8_SA(0, 0), cA, voffA); PG8_STAGE(PG8_SB(0, 1), cB + hstep, voffB); PG8_STAGE(PG8_SA(0, 1), cA + hstep, voffA);
    if (wr == 1) PG8_BAR;
    PG8_WAIT_V(4); PG8_BAR;
    PG8_STAGE(PG8_SB(1, 0), cB + kstep, voffB); PG8_STAGE(PG8_SA(1, 0), cA + kstep, voffA); PG8_STAGE(PG8_SB(1, 1), cB + hstep + kstep, voffB);
    PG8_WAIT_V(6); PG8_BAR;
    for (;;) {
        const bool has_next = S.next(ui + 1, nxt);
        const char* nA = has_next ? nxt.A : cA; const char* nB = has_next ? nxt.B : cB;
        for (int t = 0; t < nt; t += 2) {
            const bool last = (t == nt - 2);
            const char* a1 = cA + (size_t)(t + 1) * kstep;
            const char* a2 = last ? nA : cA + (size_t)(t + 2) * kstep; const char* b2 = last ? nB : cB + (size_t)(t + 2) * kstep;
            const char* a3 = a2 + kstep; const char* b3 = b2 + kstep;
            PG8_LDB(B0, 0, 0); PG8_SCHED; PG8_LDA(At, 0, 0); PG8_STAGE(PG8_SA(1, 1), a1 + hstep, voffA);
            PG8_WAIT_L(8); PG8_BAR; PG8_WAIT_L(0); PG8_MMA(0, 0, At, B0); PG8_BAR; PG8_SCHED;
            PG8_LDB(B1, 0, 1); PG8_STAGE(PG8_SB(0, 0), b2, voffB);
            PG8_BAR; PG8_WAIT_L(0); PG8_MMA(0, 1, At, B1); PG8_BAR;
            PG8_LDA(At, 0, 1); PG8_STAGE(PG8_SA(0, 0), a2, voffA);
            PG8_BAR; PG8_WAIT_L(0); PG8_MMA(1, 0, At, B0); PG8_BAR; PG8_SCHED;
            PG8_STAGE(PG8_SB(0, 1), b2 + hstep, voffB);
            PG8_WAIT_V(6); PG8_BAR; PG8_MMA(1, 1, At, B1); PG8_BAR;
            PG8_LDB(B0, 1, 0); PG8_SCHED; PG8_LDA(At, 1, 0); PG8_STAGE(PG8_SA(0, 1), a2 + hstep, voffA);
            PG8_WAIT_L(8); PG8_BAR; PG8_WAIT_L(0); PG8_MMA(0, 0, At, B0); PG8_BAR; PG8_SCHED;
            PG8_LDB(B1, 1, 1); PG8_STAGE(PG8_SB(1, 0), b3, voffB);
            PG8_BAR; PG8_WAIT_L(0); PG8_MMA(0, 1, At, B1); PG8_BAR;
            PG8_LDA(At, 1, 1); PG8_STAGE(PG8_SA(1, 0), a3, voffA);
            PG8_BAR; PG8_WAIT_L(0); PG8_MMA(1, 0, At, B0); PG8_BAR; PG8_SCHED;
            PG8_STAGE(PG8_SB(1, 1), b3 + hstep, voffB);
            PG8_WAIT_V(6); PG8_BAR; PG8_MMA(1, 1, At, B1); PG8_BAR;
        }
        E(acc, cur, wr, wc, fr, fq);
        if (!has_next) break;
#pragma unroll
        for (int a = 0; a < 2; ++a)
#pragma unroll
            for (int b = 0; b < 2; ++b)
#pragma unroll
                for (int m = 0; m < 4; ++m)
#pragma unroll
                    for (int n = 0; n < 2; ++n) acc[a][b][m][n] = (f32x4){0.f, 0.f, 0.f, 0.f};
        cur = nxt; cA = nA; cB = nB; ++ui;
    }
    PG8_WAIT_V(0);
    if (wr == 0) PG8_BAR;
    PG8_BAR;
#undef PG8_SA
#undef PG8_SB
#undef PG8_STAGE
#undef PG8_LDA
#undef PG8_LDB
#undef PG8_MMA
#undef PG8_WAIT_V
#undef PG8_WAIT_L
#undef PG8_BAR
#undef PG8_SCHED
}
}

#define XB_TMO      128
#define XB_XCNT(j)  (256  + 64 * (j))
#define XB_XSUB(j)  (1280 + 64 * (j))
#define XB_XGEN(j)  (2304 + 64 * (j))
#define XB_TOP      3328
#define XB_TOPGEN   3392
#define XCD_BAR_WORDS 3456
#define XB_SPIN_CAP (1u << 18)
__device__ __forceinline__ unsigned xb_ld(unsigned* p)              { return __hip_atomic_load(p, __ATOMIC_RELAXED, __HIP_MEMORY_SCOPE_AGENT); }
__device__ __forceinline__ unsigned xb_add(unsigned* p, unsigned v) { return __hip_atomic_fetch_add(p, v, __ATOMIC_RELAXED, __HIP_MEMORY_SCOPE_AGENT); }
__device__ __forceinline__ unsigned xb_xcc_id() { return (unsigned)__builtin_amdgcn_s_getreg((3 << 11) | 20) & 0xFu; }
#define XB_SPIN(cond, bar) do { unsigned _sp = 0; while (cond) { __builtin_amdgcn_s_sleep(1); \
    if ((++_sp & 255u) == 0u) { if (xb_ld(&(bar)[XB_TMO])) break; if (_sp > XB_SPIN_CAP) { atomicAdd(&(bar)[XB_TMO], 1u); break; } } } } while (0)
struct XcdBarrier { unsigned* bar; unsigned x; volatile LAS unsigned* st; };
__device__ __forceinline__ XcdBarrier xcd_barrier_post(unsigned* bar, volatile LAS unsigned* st) {
    XcdBarrier b; b.bar = bar; b.x = xb_xcc_id(); b.st = st;
    if (threadIdx.x == 0) (void)xb_add(&bar[XB_XCNT(b.x)], 1u);
    return b;
}
__device__ __forceinline__ void xcd_barrier_complete(unsigned* bar, unsigned x, unsigned& nloc, unsigned& nx) {
    const unsigned G = gridDim.x * gridDim.y * gridDim.z;
    unsigned sum, cnt, mine, sp = 0u;
    for (;;) {
        sum = 0u; cnt = 0u; mine = 0u;
#pragma unroll
        for (unsigned j = 0; j < 16; ++j) { const unsigned c = xb_ld(&bar[XB_XCNT(j)]); sum += c; cnt += (c > 0u) ? 1u : 0u; mine = (j == x) ? c : mine; }
        if (sum == G) break;
        __builtin_amdgcn_s_sleep(1);
        if ((++sp & 255u) == 0u) { if (xb_ld(&bar[XB_TMO])) break; if (sp > XB_SPIN_CAP) { atomicAdd(&bar[XB_TMO], 1u); break; } }
    }
    nloc = mine > 0u ? mine : 1u; nx = cnt > 0u ? cnt : 1u;
}
__device__ __forceinline__ void xcd_barrier(const XcdBarrier& b) {
    asm volatile("s_waitcnt vmcnt(0)" ::: "memory");
    __syncthreads();
    int tid0 = threadIdx.x; asm volatile("" : "+v"(tid0));
    if (tid0 == 0) {
        unsigned* bar = b.bar;
        __builtin_amdgcn_s_waitcnt(0);
        unsigned nloc = b.st[0], nx = b.st[1];
        if (nloc == 0u) { xcd_barrier_complete(bar, b.x, nloc, nx); b.st[0] = nloc; b.st[1] = nx; }
        const unsigned old = xb_add(&bar[XB_XSUB(b.x)], 1u);
        const unsigned gen = old / nloc;
        if (old + 1u == (gen + 1u) * nloc) {
            __builtin_amdgcn_fence(__ATOMIC_RELEASE, "agent");
            asm volatile("s_waitcnt vmcnt(0)" ::: "memory");
            const unsigned og = xb_add(&bar[XB_TOP], 1u);
            const unsigned tg = og / nx;
            if (og + 1u == (tg + 1u) * nx) xb_add(&bar[XB_TOPGEN], 1u);
            else XB_SPIN(xb_ld(&bar[XB_TOPGEN]) == tg, bar);
            __builtin_amdgcn_fence(__ATOMIC_ACQUIRE, "agent");
            xb_add(&bar[XB_XGEN(b.x)], 1u);
            asm volatile("s_waitcnt vmcnt(0)" ::: "memory");
        } else {
            XB_SPIN(xb_ld(&bar[XB_XGEN(b.x)]) == gen, bar);
            __builtin_amdgcn_fence(__ATOMIC_ACQUIRE, "agent");
            asm volatile("s_waitcnt vmcnt(0)" ::: "memory");
        }
    }
    __syncthreads();
}

__device__ __forceinline__ void lds_barrier() { asm volatile("s_waitcnt lgkmcnt(0)" ::: "memory"); __builtin_amdgcn_s_barrier(); asm volatile("" ::: "memory"); }
struct Ctx { int tid, wv, lane, G, bid; LAS unsigned char* lds; unsigned char* seg; };

template <int MODE>
__device__ __forceinline__ void convT_tile(const Ctx& c, const float* src, int ldsrc, int Ksrc, int k0, int n0, bf16_t* dst, int ldd, int koff) {
    LAS float* tile = (LAS float*)c.lds;
    __syncthreads();
#pragma unroll
    for (int rep = 0; rep < 2; ++rep) {
        const int i = (c.tid >> 4) + 32 * rep, j4 = (c.tid & 15) * 4; const int n = n0 + j4; int sc = n;
        if (MODE == 1) sc = (n < RW_SHIFT) ? n : (n < P1W ? -1 : n - (P1W - RW_SHIFT));
        f32x4 v = (f32x4){0.f, 0.f, 0.f, 0.f};
        if (sc >= 0 && (k0 + i) < Ksrc) v = *(const f32x4*)(src + (size_t)(k0 + i) * ldsrc + sc);
        tile[i * 65 + j4 + 0] = v[0]; tile[i * 65 + j4 + 1] = v[1]; tile[i * 65 + j4 + 2] = v[2]; tile[i * 65 + j4 + 3] = v[3];
    }
    __syncthreads();
    { const int j = c.tid >> 3, i8 = (c.tid & 7) * 8;
      if (k0 + i8 < Ksrc) {
        u32x4 w; w.x = pk2(tile[(i8 + 0) * 65 + j], tile[(i8 + 1) * 65 + j]); w.y = pk2(tile[(i8 + 2) * 65 + j], tile[(i8 + 3) * 65 + j]);
        w.z = pk2(tile[(i8 + 4) * 65 + j], tile[(i8 + 5) * 65 + j]); w.w = pk2(tile[(i8 + 6) * 65 + j], tile[(i8 + 7) * 65 + j]);
        *(u32x4*)(dst + (size_t)(n0 + j) * ldd + koff + k0 + i8) = w; } }
}

__device__ __forceinline__ void rms_row_bf16(const float* src, const float* g, bf16_t* dst, int lane) {
    f32x4 v[4]; float ss = 0.f;
#pragma unroll
    for (int i = 0; i < 4; ++i) { v[i] = *(const f32x4*)(src + i * 256 + lane * 4); ss += v[i][0] * v[i][0] + v[i][1] * v[i][1] + v[i][2] * v[i][2] + v[i][3] * v[i][3]; }
    ss = wsum(ss); const float rs = rsqrtf(ss * (1.0f / 1024.0f) + 1e-6f);
#pragma unroll
    for (int i = 0; i < 4; ++i) { const f32x4 gg = *(const f32x4*)(g + i * 256 + lane * 4);
        u32x2 w; w.x = pk2(v[i][0] * rs * gg[0], v[i][1] * rs * gg[1]); w.y = pk2(v[i][2] * rs * gg[2], v[i][3] * rs * gg[3]);
        *(u32x2*)(dst + i * 256 + lane * 4) = w; }
}
__device__ __forceinline__ float add_slabs(const float* src, const bf16_t* slab, int r, int lane, f32x4 (&v)[4]) {
    float ss = 0.f;
#pragma unroll
    for (int i = 0; i < 4; ++i) { v[i] = *(const f32x4*)(src + i * 256 + lane * 4);
#pragma unroll
        for (int ks = 0; ks < 4; ++ks) { const u32x2 t = *(const u32x2*)(slab + ((size_t)ks * MS + r) * DM + i * 256 + lane * 4);
            v[i][0] += bflo(t.x); v[i][1] += bfhi(t.x); v[i][2] += bflo(t.y); v[i][3] += bfhi(t.y); }
        ss += v[i][0] * v[i][0] + v[i][1] * v[i][1] + v[i][2] * v[i][2] + v[i][3] * v[i][3]; }
    return wsum(ss);
}

__device__ __forceinline__ void phase_apre(const P& p, const Ctx& c, int seg, int wg, int nwg) {
    bf16_t* H = (bf16_t*)(p.ws + OFF_H);
    for (int r = wg * 8 + c.wv; r < MS; r += nwg * 8) { const int b = r >> 9, tl = r & 511; const size_t grow = (size_t)b * SEQ + seg * SEGT + tl;
        rms_row_bf16(p.x + grow * DM, p.norm_g, H + (size_t)r * DM, c.lane); }
}
__device__ __forceinline__ void phase_a5(const P& p, const Ctx& c, int seg) {
    bf16_t* H = (bf16_t*)(p.ws + OFF_H); const bf16_t* slab = (const bf16_t*)(c.seg + S0_SLAB);
    for (int r = c.bid * 8 + c.wv; r < MS / 2; r += c.G * 8) {
        const int ra = r, rb = r + MS / 2;
        const size_t ga = (size_t)(ra >> 9) * SEQ + seg * SEGT + (ra & 511), gb = (size_t)(rb >> 9) * SEQ + seg * SEGT + (rb & 511);
        f32x4 va[4], vb[4]; const float sa = add_slabs(p.x + ga * DM, slab, ra, c.lane, va); const float sb = add_slabs(p.x + gb * DM, slab, rb, c.lane, vb);
        const float rsa = rsqrtf(sa * (1.0f / 1024.0f) + 1e-6f), rsb = rsqrtf(sb * (1.0f / 1024.0f) + 1e-6f);
#pragma unroll
        for (int i = 0; i < 4; ++i) { const f32x4 gg = *(const f32x4*)(p.norm_g + DM + i * 256 + c.lane * 4);
            *(f32x4*)(p.out + ga * DM + i * 256 + c.lane * 4) = va[i]; *(f32x4*)(p.out + gb * DM + i * 256 + c.lane * 4) = vb[i];
            u32x2 w; w.x = pk2(va[i][0] * rsa * gg[0], va[i][1] * rsa * gg[1]); w.y = pk2(va[i][2] * rsa * gg[2], va[i][3] * rsa * gg[3]);
            *(u32x2*)(H + (size_t)ra * DM + i * 256 + c.lane * 4) = w;
            w.x = pk2(vb[i][0] * rsb * gg[0], vb[i][1] * rsb * gg[1]); w.y = pk2(vb[i][2] * rsb * gg[2], vb[i][3] * rsb * gg[3]);
            *(u32x2*)(H + (size_t)rb * DM + i * 256 + c.lane * 4) = w; } }
}
__device__ __forceinline__ void phase_b5(const P& p, const Ctx& c, int seg) {
    const bf16_t* slab = (const bf16_t*)(c.seg + S1_SLAB);
    for (int r = c.bid * 8 + c.wv; r < MS / 2; r += c.G * 8) {
        const int ra = r, rb = r + MS / 2;
        float* rowa = p.out + ((size_t)(ra >> 9) * SEQ + seg * SEGT + (ra & 511)) * DM; float* rowb = p.out + ((size_t)(rb >> 9) * SEQ + seg * SEGT + (rb & 511)) * DM;
        f32x4 va[4], vb[4]; const float sa = add_slabs(rowa, slab, ra, c.lane, va); const float sb = add_slabs(rowb, slab, rb, c.lane, vb);
        const float rsa = rsqrtf(sa * (1.0f / 1024.0f) + 1e-6f), rsb = rsqrtf(sb * (1.0f / 1024.0f) + 1e-6f);
#pragma unroll
        for (int i = 0; i < 4; ++i) { const f32x4 gg = *(const f32x4*)(p.final_g + i * 256 + c.lane * 4); f32x4 o;
            o[0] = va[i][0] * rsa * gg[0]; o[1] = va[i][1] * rsa * gg[1]; o[2] = va[i][2] * rsa * gg[2]; o[3] = va[i][3] * rsa * gg[3]; *(f32x4*)(rowa + i * 256 + c.lane * 4) = o;
            o[0] = vb[i][0] * rsb * gg[0]; o[1] = vb[i][1] * rsb * gg[1]; o[2] = vb[i][2] * rsb * gg[2]; o[3] = vb[i][3] * rsb * gg[3]; *(f32x4*)(rowb + i * 256 + c.lane * 4) = o; } }
}

__device__ __forceinline__ void phase0(const P& p, const Ctx& c) {
    const int T0 = 16 * 64, T1 = 16 * 120, T2 = 32 * 16, T3 = 32 * 16, T4 = 16 * 16, T5 = 16 * 16, T6 = 24 * 5;
    const int TT = T0 + T1 + T2 + T3 + T4 + T5 + T6;
    for (int t = c.bid; t < TT; t += c.G) {
        int u = t;
        if (u < T0) { convT_tile<0>(c, p.ml_w_in, ML_W, 1024, (u & 15) * 64, (u >> 4) * 64, (bf16_t*)(p.ws + OFF_WT0), 1024, 0); continue; } u -= T0;
        if (u < T1) { convT_tile<1>(c, p.rw_w_in, RW_W, 1024, (u & 15) * 64, (u >> 4) * 64, (bf16_t*)(p.ws + OFF_WT1), 1024, 0); continue; } u -= T1;
        if (u < T2) { convT_tile<0>(c, p.w_out, DM, 2048, (u & 31) * 64, (u >> 5) * 64, (bf16_t*)(p.ws + OFF_WO0T), 2048, 0); continue; } u -= T2;
        if (u < T3) { convT_tile<0>(c, p.w_out + (size_t)DIN * DM, DM, 2048, (u & 31) * 64, (u >> 5) * 64, (bf16_t*)(p.ws + OFF_WO1T), 2048, 0); continue; } u -= T3;
        if (u < T4) { convT_tile<0>(c, p.mem_kv_w, DM, 1024, (u & 15) * 64, (u >> 4) * 64, (bf16_t*)(p.ws + OFF_WKVT), 1024, 0); continue; } u -= T4;
        if (u < T5) { convT_tile<0>(c, p.mem_kv_w + (size_t)DM * DM, DM, 1024, (u & 15) * 64, (u >> 4) * 64, (bf16_t*)(p.ws + OFF_WKVT + 2 * MiB), 1024, 0); continue; } u -= T5;
        { const int nt = u / 5, j = u % 5; bf16_t* L = (bf16_t*)(p.ws + OFF_LORAT);
          if (j == 0) convT_tile<0>(c, p.rw_w_lora2, DMIX, 64, 0, nt * 64, L, 288, 0);
          else if (j == 1) convT_tile<0>(c, p.rw_a_lora2, DMIX, 64, 0, nt * 64, L, 288, 64);
          else if (j == 2) convT_tile<0>(c, p.rw_v_lora2, DMIX, 32, 0, nt * 64, L, 288, 128);
          else convT_tile<0>(c, p.rw_g_lora2, DMIX, 128, (j - 3) * 64, nt * 64, L, 288, 160); }
    }
    for (int r = c.bid * 8 + c.wv; r < 2 * 2048; r += c.G * 8) { const int l = r >> 11, rr = r & 2047;
        rms_row_bf16(p.mem + (size_t)rr * DM, p.mem_norm_g + l * DM, (bf16_t*)(p.ws + OFF_MEMN) + (size_t)r * DM, c.lane); }
}

struct SchedA0 {
    const unsigned char* ws; unsigned char* seg; int G, c, nextra;
    __device__ __forceinline__ bool next(int i, pg8::Unit& u) const {
        const int L = i * G + c; if (L >= 256 + nextra) return false;
        if (L < 256) { int pm, pn; pg8::remap(L, 16, 16, pm, pn);
            u.A = (const char*)(ws + OFF_H) + (size_t)pm * 256 * 1024 * 2; u.B = (const char*)(ws + OFF_WT0) + (size_t)pn * 256 * 1024 * 2;
            u.O = (char*)(seg + S0_P0) + ((size_t)pm * 256 * ML_W + pn * 256) * 2; u.ldc = ML_W; return true; }
        const int e = L - 256, l = e >> 5, j = e & 31;
        const char* memn = (const char*)(ws + OFF_MEMN) + (size_t)l * 2048 * 1024 * 2; const char* wkv = (const char*)(ws + OFF_WKVT) + (size_t)l * 2 * MiB;
        char* kout = (char*)(ws + OFF_KMEM) + (size_t)l * 4 * MiB;
        if (j < 16) { const int pm = j >> 1, pn = j & 1;
            u.A = memn + (size_t)pm * 256 * 1024 * 2; u.B = wkv + (size_t)pn * 256 * 1024 * 2; u.O = kout + ((size_t)pm * 256 * 512 + pn * 256) * 2; u.ldc = 512; }
        else { const int jj = j - 16, pm = jj >> 3, pn = jj & 7;
            u.A = wkv + (size_t)(512 + pm * 256) * 1024 * 2; u.B = memn + (size_t)pn * 256 * 1024 * 2; u.O = kout + 2 * MiB + ((size_t)pm * 256 * 2048 + pn * 256) * 2; u.ldc = 2048; }
        return true;
    }
};
struct SchedB0 {
    const unsigned char* ws; unsigned char* seg; int G, c;
    __device__ __forceinline__ bool next(int i, pg8::Unit& u) const {
        const int L = i * G + c; if (L >= 480) return false;
        int pm, pn; pg8::remap(L, 16, 30, pm, pn);
        u.A = (const char*)(ws + OFF_H) + (size_t)pm * 256 * 1024 * 2; u.B = (const char*)(ws + OFF_WT1) + (size_t)pn * 256 * 1024 * 2;
        if (pn < 20) { u.O = (char*)(seg + S1_P1) + ((size_t)pm * 256 * P1W + pn * 256) * 2; u.ldc = P1W; }
        else { u.O = (char*)(seg + S1_P2) + ((size_t)pm * 256 * P2W + (pn - 20) * 256) * 2; u.ldc = P2W; }
        return true;
    }
};
struct SchedOut {
    const char* Y; const char* W; char* slab; int G, c;
    __device__ __forceinline__ bool next(int i, pg8::Unit& u) const {
        const int L = i * G + c; if (L >= 256) return false;
        const int ks = L >> 6; int pm, pn; pg8::remap(L & 63, 16, 4, pm, pn);
        u.A = Y + ((size_t)pm * 256 * DIN + ks * 512) * 2; u.B = W + ((size_t)pn * 256 * DIN + ks * 512) * 2;
        u.O = slab + (((size_t)ks * MS + pm * 256) * DM + pn * 256) * 2; u.ldc = DM; return true;
    }
};

__device__ __forceinline__ void phase_a1(const P& p, const Ctx& c, int seg) {
    const bf16_t* P0 = (const bf16_t*)(c.seg + S0_P0);
    bf16_t* Qb = (bf16_t*)(c.seg + S0_Q); bf16_t* Kb = (bf16_t*)(c.seg + S0_K); bf16_t* KT = (bf16_t*)(c.seg + S0_KT); bf16_t* VT = (bf16_t*)(c.seg + S0_VT);
    bf16_t* XC = (bf16_t*)(c.seg + S0_XC); bf16_t* VF = (bf16_t*)(p.ws + OFF_VF);
    float* IPRE = (float*)(c.seg + S0_GATE); float* LOGF = IPRE + 32 * SEGT;
    const bf16_t* UT = (const bf16_t*)(p.ws + OFF_UTAIL);
    LAS float* red = (LAS float*)c.lds;
    LAS bf16_t* kst = (LAS bf16_t*)(c.lds + 98304);
    LAS bf16_t* vst = kst + 1536 * 8;
    const int n = c.tid;
    float wq[4][4], wk[4][4], wv[4][4], G12[4][8], G3[4][8];
    if (n < 384) {
#pragma unroll
        for (int i = 0; i < 4; ++i) { const f32x4 a = *(const f32x4*)(p.ml_wq + n * 16 + i * 4), bb = *(const f32x4*)(p.ml_wk + n * 16 + i * 4), cc = *(const f32x4*)(p.ml_wv + n * 16 + i * 4);
#pragma unroll
            for (int o = 0; o < 4; ++o) { wq[i][o] = a[o]; wk[i][o] = bb[o]; wv[i][o] = cc[o]; } }
#pragma unroll
        for (int i = 0; i < 4; ++i)
#pragma unroll
            for (int g = 0; g < 8; ++g) { G12[i][g] = 0.f; G3[i][g] = 0.f; }
#pragma unroll
        for (int o = 0; o < 4; ++o) {
            const float* gq = p.ml_w_gate + (size_t)(n * 4 + o) * 8; const float* gk = p.ml_w_gate + (size_t)(DMIX + n * 4 + o) * 8; const float* gv = p.ml_w_gate + (size_t)(2 * DMIX + n * 4 + o) * 8;
            const f32x4 q0 = *(const f32x4*)gq, q1 = *(const f32x4*)(gq + 4), k0 = *(const f32x4*)gk, k1 = *(const f32x4*)(gk + 4), v0 = *(const f32x4*)gv, v1 = *(const f32x4*)(gv + 4);
#pragma unroll
            for (int i = 0; i < 4; ++i)
#pragma unroll
                for (int g = 0; g < 4; ++g) { G12[i][g] += wq[i][o] * q0[g] + wk[i][o] * k0[g]; G12[i][g + 4] += wq[i][o] * q1[g] + wk[i][o] * k1[g];
                    G3[i][g] += wv[i][o] * v0[g]; G3[i][g + 4] += wv[i][o] * v1[g]; }
        }
    }
#pragma unroll 1
    for (int it = c.bid; it < MS / 8; it += c.G) {
        const int row0 = it * 8, b = row0 >> 9, tl0 = row0 & 511;
        __syncthreads();
        if (n < 384) {
            float um[3][4];
#pragma unroll
            for (int j = 1; j <= 3; ++j) { u32x2 raw = (u32x2){0u, 0u};
                if (tl0 - j >= 0) raw = *(const u32x2*)(P0 + (unsigned)((row0 - j) * ML_W + n * 4));
                else if (seg > 0) raw = *(const u32x2*)(UT + (unsigned)((b * 3 + (3 - j)) * DMIX + n * 4));
                um[3 - j][0] = bflo(raw.x); um[3 - j][1] = bfhi(raw.x); um[3 - j][2] = bflo(raw.y); um[3 - j][3] = bfhi(raw.y); }
            u32x2 nraw = *(const u32x2*)(P0 + (unsigned)(row0 * ML_W + n * 4));
#pragma unroll 1
            for (int tt = 0; tt < 8; ++tt) {
                const unsigned row = (unsigned)(row0 + tt);
                const u32x2 raw = nraw;
                if (tt + 1 < 8) nraw = *(const u32x2*)(P0 + (unsigned)((row + 1) * ML_W + n * 4));
                float u[4] = {bflo(raw.x), bfhi(raw.x), bflo(raw.y), bfhi(raw.y)}, xc[4], q[4], k[4], v[4];
                { int nn = n; asm volatile("" : "+v"(nn));
                  const f32x4 cb = *(const f32x4*)(p.ml_conv_b + nn * 4), c0 = *(const f32x4*)(p.ml_conv_w + nn * 4), c1 = *(const f32x4*)(p.ml_conv_w + DMIX + nn * 4),
                              c2 = *(const f32x4*)(p.ml_conv_w + 2 * DMIX + nn * 4), c3 = *(const f32x4*)(p.ml_conv_w + 3 * DMIX + nn * 4);
#pragma unroll
                  for (int i = 0; i < 4; ++i) { const float y = cb[i] + c0[i] * um[0][i] + c1[i] * um[1][i] + c2[i] * um[2][i] + c3[i] * u[i]; xc[i] = siluf_(y); } }
                const float ks = 0.05103103630798288f;
#pragma unroll
                for (int o = 0; o < 4; ++o) { q[o] = xc[0] * wq[0][o] + xc[1] * wq[1][o] + xc[2] * wq[2][o] + xc[3] * wq[3][o];
                    k[o] = (xc[0] * wk[0][o] + xc[1] * wk[1][o] + xc[2] * wk[2][o] + xc[3] * wk[3][o]) * ks;
                    v[o] = u[0] * wv[0][o] + u[1] * wv[1][o] + u[2] * wv[2][o] + u[3] * wv[3][o]; }
#pragma unroll
                for (int g = 0; g < 8; ++g) red[(tt * 8 + g) * 384 + n] = xc[0] * G12[0][g] + xc[1] * G12[1][g] + xc[2] * G12[2][g] + xc[3] * G12[3][g] + u[0] * G3[0][g] + u[1] * G3[1][g] + u[2] * G3[2][g] + u[3] * G3[3][g];
                u32x2 w; w.x = pk2(q[0], q[1]); w.y = pk2(q[2], q[3]); *(u32x2*)(Qb + (unsigned)(row * DMIX + n * 4)) = w;
                w.x = pk2(k[0], k[1]); w.y = pk2(k[2], k[3]); *(u32x2*)(Kb + (unsigned)(row * DMIX + n * 4)) = w;
                w.x = pk2(xc[0], xc[1]); w.y = pk2(xc[2], xc[3]); *(u32x2*)(XC + (unsigned)(row * DMIX + n * 4)) = w;
                w.x = pk2(v[0], v[1]); w.y = pk2(v[2], v[3]); *(u32x2*)(VF + (unsigned)(row * DMIX + n * 4)) = w;
#pragma unroll
                for (int o = 0; o < 4; ++o) { kst[(o * 384 + n) * 8 + tt] = f2bf(k[o]); vst[(o * 384 + n) * 8 + tt] = f2bf(v[o]); }
#pragma unroll
                for (int i = 0; i < 4; ++i) { um[0][i] = um[1][i]; um[1][i] = um[2][i]; um[2][i] = u[i]; }
            }
            const int hd = n / 96, dch = (n % 96) * 4;
#pragma unroll
            for (int o = 0; o < 4; ++o) { const unsigned off = (unsigned)(((b * 4 + hd) * 384 + dch + o) * SEGT + tl0);
                *(u32x4*)(KT + off) = *(const LAS u32x4*)(kst + (o * 384 + n) * 8); *(u32x4*)(VT + off) = *(const LAS u32x4*)(vst + (o * 384 + n) * 8); }
        }
        __syncthreads();
        { const int v = c.tid >> 3, part = c.tid & 7; float s = 0.f;
#pragma unroll 8
          for (int i = 0; i < 48; ++i) s += red[v * 384 + part * 48 + i];
          s += __shfl_xor(s, 1); s += __shfl_xor(s, 2); s += __shfl_xor(s, 4);
          if (part == 0) { const int tt = v >> 3, g = v & 7; const float gate = s + p.ml_b_gate[g];
              if (g < 4) IPRE[(b * 4 + g) * SEGT + tl0 + tt] = gate; else LOGF[(b * 4 + g - 4) * SEGT + tl0 + tt] = -softplusf_(-gate); } }
    }
}

__device__ __forceinline__ void attn_item(const P& p, const Ctx& c, int layer, int it, const bf16_t* Qp, int ldq, bf16_t* YM, int ldy, const bf16_t* Zp, int ldz) {
    const int b = it >> 3, head = (it >> 1) & 3, qb = it & 1;
    const bf16_t* Kg = (const bf16_t*)(p.ws + OFF_KMEM + (size_t)layer * 4 * MiB) + (size_t)(b * 256) * 512 + head * 128;
    const bf16_t* Vg = (const bf16_t*)(p.ws + OFF_KMEM + (size_t)layer * 4 * MiB + 2 * MiB) + (size_t)(head * 128) * 2048 + b * 256;
    LAS bf16_t* Ks = (LAS bf16_t*)c.lds;
    LAS bf16_t* Vs = Ks + 256 * 136;
    const int l15 = c.lane & 15, quad = c.lane >> 4;
    __syncthreads();
#pragma unroll
    for (int r = 0; r < 8; ++r) { const int id = c.tid + 512 * r; { const int i = id >> 4, c8 = (id & 15) * 8; *(LAS u32x4*)(Ks + i * 136 + c8) = *(const u32x4*)(Kg + (size_t)i * 512 + c8); }
        { const int i = id >> 5, c8 = (id & 31) * 8; *(LAS u32x4*)(Vs + i * 264 + c8) = *(const u32x4*)(Vg + (size_t)i * 2048 + c8); } }
    __syncthreads();
#pragma unroll 1
    for (int pass = 0; pass < 2; ++pass) {
        const int row0 = b * SEGT + qb * 256 + c.wv * 32 + pass * 16;
        bf16x8 qf[4];
#pragma unroll
        for (int kk = 0; kk < 4; ++kk) qf[kk] = *(const bf16x8*)(Qp + (size_t)(row0 + l15) * ldq + head * 128 + kk * 32 + quad * 8);
        f32x4 acc[16];
#pragma unroll
        for (int mt = 0; mt < 16; ++mt) { acc[mt] = (f32x4){0.f, 0.f, 0.f, 0.f};
#pragma unroll
            for (int kk = 0; kk < 4; ++kk) { const bf16x8 a = *(const LAS bf16x8*)(Ks + (mt * 16 + l15) * 136 + kk * 32 + quad * 8); acc[mt] = mfma16(a, qf[kk], acc[mt]); }
            if ((mt & 3) == 3) __builtin_amdgcn_sched_barrier(0); }
        float mx = -1e30f;
#pragma unroll
        for (int mt = 0; mt < 16; ++mt)
#pragma unroll
            for (int j = 0; j < 4; ++j) mx = fmaxf(mx, acc[mt][j]);
        mx = fmaxf(mx, __shfl_xor(mx, 16)); mx = fmaxf(mx, __shfl_xor(mx, 32));
        const float sc = 0.08838834764831845f * 1.4426950408889634f; float sm = 0.f;
#pragma unroll
        for (int mt = 0; mt < 16; ++mt)
#pragma unroll
            for (int j = 0; j < 4; ++j) { const float e = exp2f((acc[mt][j] - mx) * sc); acc[mt][j] = e; sm += e; }
        sm += __shfl_xor(sm, 16); sm += __shfl_xor(sm, 32);
        const float inv = frcp(sm);
        bf16x8 pa[8];
#pragma unroll
        for (int kp = 0; kp < 8; ++kp) {
            u32x4 aw; aw.x = pk2(acc[2 * kp][0] * inv, acc[2 * kp][1] * inv); aw.y = pk2(acc[2 * kp][2] * inv, acc[2 * kp][3] * inv);
            aw.z = pk2(acc[2 * kp + 1][0] * inv, acc[2 * kp + 1][1] * inv); aw.w = pk2(acc[2 * kp + 1][2] * inv, acc[2 * kp + 1][3] * inv);
            __builtin_memcpy(&pa[kp], &aw, 16); }
        __builtin_amdgcn_sched_barrier(0);
        f32x4 o[8];
#pragma unroll
        for (int nt = 0; nt < 8; ++nt) o[nt] = (f32x4){0.f, 0.f, 0.f, 0.f};
#pragma unroll
        for (int kp = 0; kp < 8; ++kp) {
            const bf16x8 a = pa[kp];
#pragma unroll
            for (int nt = 0; nt < 8; ++nt) { const LAS bf16_t* vp = Vs + (nt * 16 + l15) * 264 + 2 * kp * 16 + quad * 4;
                const u32x2 lo = *(const LAS u32x2*)vp, hi = *(const LAS u32x2*)(vp + 16); u32x4 bw = (u32x4){lo.x, lo.y, hi.x, hi.y}; bf16x8 bfr; __builtin_memcpy(&bfr, &bw, 16);
                o[nt] = mfma16(a, bfr, o[nt]); }
            __builtin_amdgcn_sched_barrier(0);
        }
#pragma unroll
        for (int nt = 0; nt < 8; ++nt)
#pragma unroll
            for (int j = 0; j < 4; ++j) { const size_t rr = (size_t)(row0 + quad * 4 + j); const int cc = head * 128 + nt * 16 + l15; float ov = o[nt][j];
                if (Zp) ov *= siluf_(bf2f(Zp[rr * ldz + cc]));
                YM[rr * ldy + cc] = f2bf(ov); }
    }
}

__device__ __forceinline__ void mlstm_item(const P& p, const Ctx& c, int seg, int w, bool save) {
    const int b = w / 24, h = (w / 6) & 3, sl = w % 6;
    const bf16_t* Qb = (const bf16_t*)(c.seg + S0_Q); const bf16_t* Kb = (const bf16_t*)(c.seg + S0_K); const bf16_t* KT = (const bf16_t*)(c.seg + S0_KT); const bf16_t* VT = (const bf16_t*)(c.seg + S0_VT);
    const float* IPRE = (const float*)(c.seg + S0_GATE); const float* LOGF = IPRE + 32 * SEGT;
    bf16_t* HR = (bf16_t*)(c.seg + S0_HRAW);
    float* CST = (float*)(p.ws + OFF_CST) + (size_t)w * 64 * 384; float* NST = (float*)(p.ws + OFF_NST) + (size_t)w * 384;
    LAS bf16_t* Cimg = (LAS bf16_t*)c.lds;
    LAS bf16_t* Qs = Cimg + 64 * 392;
    LAS bf16_t* Ks = Qs + 64 * 136;
    LAS bf16_t* KTs = Ks + 64 * 136;
    LAS bf16_t* VTs = KTs + 128 * 72;
    LAS bf16_t* VWs = VTs + 64 * 72;
    LAS bf16_t* Sp = VWs + 64 * 72;
    LAS float* fl = (LAS float*)(Sp + 64 * 72);
    LAS float* bcum = fl; LAS float* ipr = fl + 64; LAS float* wgt = fl + 128; LAS float* gin = fl + 192; LAS float* qn = fl + 256; LAS float* rden = fl + 320;
    LAS float* gtotp = fl + 384; LAS float* nold = fl + 400; LAS float* nnew = fl + 800;
    const int l15c = c.lane & 15, quadc = c.lane >> 4, e16 = c.wv & 3, par = c.wv >> 2;
    f32x4 C[12];
    __syncthreads();
    if (seg > 0) {
#pragma unroll
        for (int j = 0; j < 12; ++j)
#pragma unroll
            for (int jj = 0; jj < 4; ++jj) C[j][jj] = CST[(size_t)(e16 * 16 + quadc * 4 + jj) * 384 + (2 * j + par) * 16 + l15c];
        if (c.tid < 384) nold[c.tid] = NST[c.tid];
    } else {
#pragma unroll
        for (int j = 0; j < 12; ++j) C[j] = (f32x4){0.f, 0.f, 0.f, 0.f};
        if (c.tid < 384) nold[c.tid] = 0.f;
    }
    u32x4 pq[2], pk[2], pt[2], pvt; float plf = 0.f, pip = 0.f;
    auto gl_piece = [&](int ch, int pp, int tidv) {
#pragma unroll
        for (int r = 0; r < 2; ++r) { const int id = tidv + 512 * r;
            { const int i = id >> 4, c8 = (id & 15) * 8; const size_t go = ((size_t)b * SEGT + ch * 64 + i) * DMIX + h * 384 + pp * 128 + c8; pq[r] = *(const u32x4*)(Qb + go); pk[r] = *(const u32x4*)(Kb + go); }
            { const int dd = id >> 3, c8 = (id & 7) * 8; pt[r] = *(const u32x4*)(KT + ((size_t)(b * 4 + h) * 384 + pp * 128 + dd) * SEGT + ch * 64 + c8); } } };
    auto gl_chunk = [&](int ch, int tidv) { const int i = tidv >> 3, c8 = (tidv & 7) * 8;
        pvt = *(const u32x4*)(VT + ((size_t)(b * 4 + h) * 384 + sl * 64 + i) * SEGT + ch * 64 + c8);
        if (c.wv == 0) { plf = LOGF[(b * 4 + h) * SEGT + ch * 64 + c.lane]; pip = IPRE[(b * 4 + h) * SEGT + ch * 64 + c.lane]; } };
    { int t0 = c.tid; asm volatile("" : "+v"(t0)); gl_chunk(0, t0); gl_piece(0, 0, t0); }
#pragma unroll 1
    for (int ch = 0; ch < 8; ++ch) {
        const int tl0 = ch * 64; const size_t row0 = (size_t)b * SEGT + tl0;
        int tidv = c.tid, l15 = l15c, quad = quadc;
        asm volatile("" : "+v"(tidv), "+v"(l15), "+v"(quad));
        lds_barrier();
        if (c.wv == 0) {
            float bc = plf;
#pragma unroll
            for (int o = 1; o < 64; o <<= 1) { const float t = __shfl_up(bc, o); if (c.lane >= o) bc += t; }
            const float bl = __shfl(bc, 63);
            bcum[c.lane] = bc; ipr[c.lane] = pip; wgt[c.lane] = __expf(bl - bc + pip); gin[c.lane] = __expf(bc);
            if (c.lane == 0) gtotp[0] = __expf(bl);
        }
#pragma unroll
        for (int j = 0; j < 12; ++j)
#pragma unroll
            for (int jj = 0; jj < 4; ++jj) Cimg[(e16 * 16 + quad * 4 + jj) * 392 + (2 * j + par) * 16 + l15] = f2bf(C[j][jj]);
        lds_barrier();
        { const int i = tidv >> 3, c8 = (tidv & 7) * 8;
          const u32x4 raw = pvt;
          *(LAS u32x4*)(VTs + i * 72 + c8) = raw;
          const f32x4 w0 = *(const LAS f32x4*)(wgt + c8), w1 = *(const LAS f32x4*)(wgt + c8 + 4);
          u32x4 sw; sw.x = pk2(bflo(raw.x) * w0[0], bfhi(raw.x) * w0[1]); sw.y = pk2(bflo(raw.y) * w0[2], bfhi(raw.y) * w0[3]);
          sw.z = pk2(bflo(raw.z) * w1[0], bfhi(raw.z) * w1[1]); sw.w = pk2(bflo(raw.w) * w1[2], bfhi(raw.w) * w1[3]);
          *(LAS u32x4*)(VWs + i * 72 + c8) = sw; }
        if (ch + 1 < 8) gl_chunk(ch + 1, tidv);
        const float gtot = gtotp[0];
#pragma unroll
        for (int j = 0; j < 12; ++j) C[j] *= gtot;
        f32x4 Sa[2], Ia[2]; Sa[0] = Sa[1] = Ia[0] = Ia[1] = (f32x4){0.f, 0.f, 0.f, 0.f};
        float qnacc = 0.f;
#pragma unroll
        for (int pp = 0; pp < 3; ++pp) {
            const int d0 = pp * 128;
            __builtin_amdgcn_sched_barrier(0);
            asm volatile("" : "+v"(tidv));
            lds_barrier();
#pragma unroll
            for (int r = 0; r < 2; ++r) { const int id = tidv + 512 * r;
                { const int i = id >> 4, c8 = (id & 15) * 8; *(LAS u32x4*)(Qs + i * 136 + c8) = pq[r]; *(LAS u32x4*)(Ks + i * 136 + c8) = pk[r]; }
                { const int dd = id >> 3, c8 = (id & 7) * 8; *(LAS u32x4*)(KTs + dd * 72 + c8) = pt[r]; } }
            lds_barrier();
            if (pp < 2) gl_piece(ch, pp + 1, tidv); else if (ch + 1 < 8) gl_piece(ch + 1, 0, tidv);
            { const int tm = c.wv >> 1, tn0 = (c.wv & 1) * 2;
#pragma unroll
              for (int kk = 0; kk < 4; ++kk) { const bf16x8 a = *(const LAS bf16x8*)(Qs + (tm * 16 + l15) * 136 + kk * 32 + quad * 8);
#pragma unroll
                  for (int x = 0; x < 2; ++x) { const int tn = tn0 + x;
                      const bf16x8 bk = *(const LAS bf16x8*)(Ks + (tn * 16 + l15) * 136 + kk * 32 + quad * 8);
                      const bf16x8 bc = *(const LAS bf16x8*)(Cimg + (tn * 16 + l15) * 392 + d0 + kk * 32 + quad * 8);
                      Sa[x] = mfma16(a, bk, Sa[x]); Ia[x] = mfma16(a, bc, Ia[x]); } } }
            { const bf16x8 va0 = *(const LAS bf16x8*)(VWs + (e16 * 16 + l15) * 72 + quad * 8), va1 = *(const LAS bf16x8*)(VWs + (e16 * 16 + l15) * 72 + 32 + quad * 8);
#pragma unroll
              for (int jl = 0; jl < 4; ++jl) { const int ntl = 2 * jl + par, j = pp * 4 + jl;
                  C[j] = mfma16(va0, *(const LAS bf16x8*)(KTs + (ntl * 16 + l15) * 72 + quad * 8), C[j]);
                  C[j] = mfma16(va1, *(const LAS bf16x8*)(KTs + (ntl * 16 + l15) * 72 + 32 + quad * 8), C[j]); } }
            { const int t = tidv >> 3, part = tidv & 7;
              const u32x4 q0 = *(const LAS u32x4*)(Qs + t * 136 + part * 16), q1 = *(const LAS u32x4*)(Qs + t * 136 + part * 16 + 8);
              const LAS float* np = nold + d0 + part * 16; const f32x4 n0 = *(const LAS f32x4*)np, n1 = *(const LAS f32x4*)(np + 4), n2 = *(const LAS f32x4*)(np + 8), n3 = *(const LAS f32x4*)(np + 12);
              qnacc += bflo(q0.x) * n0[0] + bfhi(q0.x) * n0[1] + bflo(q0.y) * n0[2] + bfhi(q0.y) * n0[3] + bflo(q0.z) * n1[0] + bfhi(q0.z) * n1[1] + bflo(q0.w) * n1[2] + bfhi(q0.w) * n1[3]
                     + bflo(q1.x) * n2[0] + bfhi(q1.x) * n2[1] + bflo(q1.y) * n2[2] + bfhi(q1.y) * n2[3] + bflo(q1.z) * n3[0] + bfhi(q1.z) * n3[1] + bflo(q1.w) * n3[2] + bfhi(q1.w) * n3[3]; }
            { const int dd = tidv >> 2, part = tidv & 3;
              const u32x4 k0 = *(const LAS u32x4*)(KTs + dd * 72 + part * 16), k1 = *(const LAS u32x4*)(KTs + dd * 72 + part * 16 + 8);
              const LAS float* wp = wgt + part * 16; const f32x4 w0 = *(const LAS f32x4*)wp, w1 = *(const LAS f32x4*)(wp + 4), w2 = *(const LAS f32x4*)(wp + 8), w3 = *(const LAS f32x4*)(wp + 12);
              float a = bflo(k0.x) * w0[0] + bfhi(k0.x) * w0[1] + bflo(k0.y) * w0[2] + bfhi(k0.y) * w0[3] + bflo(k0.z) * w1[0] + bfhi(k0.z) * w1[1] + bflo(k0.w) * w1[2] + bfhi(k0.w) * w1[3]
                      + bflo(k1.x) * w2[0] + bfhi(k1.x) * w2[1] + bflo(k1.y) * w2[2] + bfhi(k1.y) * w2[3] + bflo(k1.z) * w3[0] + bfhi(k1.z) * w3[1] + bflo(k1.w) * w3[2] + bfhi(k1.w) * w3[3];
              a = dpp_add<0xB1>(a); a = dpp_add<0x4E>(a);
              if (part == 0) nnew[d0 + dd] = gtot * nold[d0 + dd] + a; }
        }
        qnacc = dpp_add<0xB1>(qnacc); qnacc = dpp_add<0x4E>(qnacc); qnacc = dpp_add<0x141>(qnacc);
        if ((tidv & 7) == 0) qn[tidv >> 3] = qnacc;
#pragma unroll
        for (int x = 0; x < 2; ++x) { const int ti = c.wv * 2 + x, tm = ti >> 2, tn = ti & 3; const int s = tn * 16 + l15; const float bs = bcum[s] - ipr[s];
#pragma unroll
            for (int jj = 0; jj < 4; ++jj) { const int t = tm * 16 + quad * 4 + jj; const float v = (s <= t) ? Sa[x][jj] * __expf(bcum[t] - bs) : 0.f; Sp[t * 72 + s] = f2bf(v); } }
        lds_barrier();
        { const int t = tidv >> 3, part = tidv & 7; const u32x4 sr = *(const LAS u32x4*)(Sp + t * 72 + part * 8);
          float ds = bflo(sr.x) + bfhi(sr.x) + bflo(sr.y) + bfhi(sr.y) + bflo(sr.z) + bfhi(sr.z) + bflo(sr.w) + bfhi(sr.w);
          ds = dpp_add<0xB1>(ds); ds = dpp_add<0x4E>(ds); ds = dpp_add<0x141>(ds);
          if (part == 0) { const float den = ds + gin[t] * qn[t]; rden[t] = frcp(fmaxf(fabsf(den), 1.0f)); } }
#pragma unroll
        for (int x = 0; x < 2; ++x) { const int ti = c.wv * 2 + x, tm = ti >> 2, tn = ti & 3;
#pragma unroll
            for (int jj = 0; jj < 4; ++jj) Ia[x][jj] *= gin[tm * 16 + quad * 4 + jj];
#pragma unroll
            for (int kk = 0; kk < 2; ++kk) { const bf16x8 a = *(const LAS bf16x8*)(Sp + (tm * 16 + l15) * 72 + kk * 32 + quad * 8);
                const bf16x8 bb = *(const LAS bf16x8*)(VTs + (tn * 16 + l15) * 72 + kk * 32 + quad * 8); Ia[x] = mfma16(a, bb, Ia[x]); } }
        lds_barrier();
#pragma unroll
        for (int x = 0; x < 2; ++x) { const int ti = c.wv * 2 + x, tm = ti >> 2, tn = ti & 3;
#pragma unroll
            for (int jj = 0; jj < 4; ++jj) { const int t = tm * 16 + quad * 4 + jj; HR[(row0 + t) * DMIX + h * 384 + sl * 64 + tn * 16 + l15] = f2bf(Ia[x][jj] * rden[t]); } }
        if (c.tid < 384) nold[c.tid] = nnew[c.tid];
    }
    lds_barrier();
    if (!save) return;
#pragma unroll
    for (int j = 0; j < 12; ++j)
#pragma unroll
        for (int jj = 0; jj < 4; ++jj) CST[(size_t)(e16 * 16 + quadc * 4 + jj) * 384 + (2 * j + par) * 16 + l15c] = C[j][jj];
    if (c.tid < 384) NST[c.tid] = nold[c.tid];
}

__device__ __forceinline__ void phase_a3(const P& p, const Ctx& c, int seg) {
    const bf16_t* P0 = (const bf16_t*)(c.seg + S0_P0); const bf16_t* HR = (const bf16_t*)(c.seg + S0_HRAW); const bf16_t* XC = (const bf16_t*)(c.seg + S0_XC);
    const bf16_t* YM = (const bf16_t*)(c.seg + S0_YMEM); bf16_t* Y = (bf16_t*)(c.seg + S0_Y); bf16_t* UT = (bf16_t*)(p.ws + OFF_UTAIL);
#pragma unroll 1
    for (int r = c.bid * 8 + c.wv; r < MS; r += c.G * 8) {
        const int b = r >> 9, tl = r & 511;
        float v[3][8]; float mean[3], rstd[3];
#pragma unroll
        for (int ps = 0; ps < 3; ++ps) { const int ch = ps * 512 + c.lane * 8;
            const u32x4 hr = *(const u32x4*)(HR + (size_t)r * DMIX + ch);
            v[ps][0] = bflo(hr.x); v[ps][1] = bfhi(hr.x); v[ps][2] = bflo(hr.y); v[ps][3] = bfhi(hr.y); v[ps][4] = bflo(hr.z); v[ps][5] = bfhi(hr.z); v[ps][6] = bflo(hr.w); v[ps][7] = bfhi(hr.w); }
        float hs[4], hq[4];
#pragma unroll
        for (int hd = 0; hd < 4; ++hd) { float s = 0.f, q = 0.f;
#pragma unroll
            for (int ps = 0; ps < 3; ++ps) { if (ps * 512 + 511 < hd * 384 || ps * 512 >= (hd + 1) * 384) continue;
                const bool mine = ((ps * 512 + c.lane * 8) / 384) == hd;
                float ls = 0.f, lq = 0.f;
#pragma unroll
                for (int j = 0; j < 8; ++j) { ls += v[ps][j]; lq += v[ps][j] * v[ps][j]; }
                s += mine ? ls : 0.f; q += mine ? lq : 0.f; }
            hs[hd] = wsum(s); hq[hd] = wsum(q); }
#pragma unroll
        for (int ps = 0; ps < 3; ++ps) { const int hd = (ps * 512 + c.lane * 8) / 384;
            const float s = hd == 0 ? hs[0] : (hd == 1 ? hs[1] : (hd == 2 ? hs[2] : hs[3])), q = hd == 0 ? hq[0] : (hd == 1 ? hq[1] : (hd == 2 ? hq[2] : hq[3]));
            const float m = s * (1.0f / 384.0f); mean[ps] = m; rstd[ps] = rsqrtf(fmaxf(q * (1.0f / 384.0f) - m * m, 0.f) + 1e-5f); }
#pragma unroll
        for (int ps = 0; ps < 3; ++ps) { const int ch = ps * 512 + c.lane * 8;
            const u32x4 xr = *(const u32x4*)(XC + (size_t)r * DMIX + ch), zr = *(const u32x4*)(P0 + (size_t)r * ML_W + 2048 + ch);
            const f32x4 g0 = *(const f32x4*)(p.ml_mhn_g + ch), g1 = *(const f32x4*)(p.ml_mhn_g + ch + 4), k0 = *(const f32x4*)(p.ml_skip + ch), k1 = *(const f32x4*)(p.ml_skip + ch + 4);
            const float xx[8] = {bflo(xr.x), bfhi(xr.x), bflo(xr.y), bfhi(xr.y), bflo(xr.z), bfhi(xr.z), bflo(xr.w), bfhi(xr.w)};
            const float zz[8] = {bflo(zr.x), bfhi(zr.x), bflo(zr.y), bfhi(zr.y), bflo(zr.z), bfhi(zr.z), bflo(zr.w), bfhi(zr.w)};
            const float gg[8] = {g0[0], g0[1], g0[2], g0[3], g1[0], g1[1], g1[2], g1[3]}, kk[8] = {k0[0], k0[1], k0[2], k0[3], k1[0], k1[1], k1[2], k1[3]};
            float y[8];
#pragma unroll
            for (int j = 0; j < 8; ++j) y[j] = ((v[ps][j] - mean[ps]) * rstd[ps] * gg[j] + kk[j] * xx[j]) * siluf_(zz[j]);
            *(u32x4*)(Y + (size_t)r * DIN + ch) = (u32x4){pk2(y[0], y[1]), pk2(y[2], y[3]), pk2(y[4], y[5]), pk2(y[6], y[7])}; }
        { const int cm = c.lane * 8; const u32x4 mr = *(const u32x4*)(YM + (size_t)r * DX + cm), zr = *(const u32x4*)(P0 + (size_t)r * ML_W + 2048 + DMIX + cm);
          const float mm[8] = {bflo(mr.x), bfhi(mr.x), bflo(mr.y), bfhi(mr.y), bflo(mr.z), bfhi(mr.z), bflo(mr.w), bfhi(mr.w)};
          const float zz[8] = {bflo(zr.x), bfhi(zr.x), bflo(zr.y), bfhi(zr.y), bflo(zr.z), bfhi(zr.z), bflo(zr.w), bfhi(zr.w)};
          float y[8];
#pragma unroll
          for (int j = 0; j < 8; ++j) y[j] = mm[j] * siluf_(zz[j]);
          *(u32x4*)(Y + (size_t)r * DIN + DMIX + cm) = (u32x4){pk2(y[0], y[1]), pk2(y[2], y[3]), pk2(y[4], y[5]), pk2(y[6], y[7])}; }
        if (tl >= 509) {
#pragma unroll
            for (int ps = 0; ps < 3; ++ps) { const int ch = ps * 512 + c.lane * 8; *(u32x4*)(UT + (size_t)(b * 3 + tl - 509) * DMIX + ch) = *(const u32x4*)(P0 + (size_t)r * ML_W + ch); } }
    }
}

__device__ __forceinline__ void phase_b1(const P& p, const Ctx& c, int seg) {
    const bf16_t* P1 = (const bf16_t*)(c.seg + S1_P1);
    float* GTB = (float*)(c.seg + S1_W); bf16_t* SA = (bf16_t*)(c.seg + S1_A); bf16_t* SB = (bf16_t*)(c.seg + S1_B); bf16_t* SK = (bf16_t*)(c.seg + S1_K);
    bf16_t* SQ = (bf16_t*)(c.seg + S1_Q); bf16_t* SV = (bf16_t*)(c.seg + S1_V); bf16_t* SG = (bf16_t*)(c.seg + S1_G); float* BRKR = (float*)(c.seg + S1_BRKR);
    const bf16_t* VF = (const bf16_t*)(p.ws + OFF_VF); const bf16_t* LT = (const bf16_t*)(p.ws + OFF_LORAT);
    const bf16_t* PTr = (const bf16_t*)(p.ws + OFF_PTAIL) + (size_t)(seg & 1) * NB * RW_SHIFT; bf16_t* PTw = (bf16_t*)(p.ws + OFF_PTAIL) + (size_t)((seg + 1) & 1) * NB * RW_SHIFT;
    LAS bf16_t* XA = (LAS bf16_t*)c.lds;
    const int l15 = c.lane & 15, quad = c.lane >> 4;
    for (int it = c.bid; it < MS / 16; it += c.G) {
        const int r0 = it * 16, b = r0 >> 9, tl0 = r0 & 511;
        __syncthreads();
        for (int e = c.tid; e < 16 * 288; e += 512) { const int row = e / 288, cc = e % 288, col = 4608 + cc;
            const float cur = bf2f(P1[(size_t)(r0 + row) * P1W + col]);
            float prev = 0.f; if (tl0 + row > 0) prev = bf2f(P1[(size_t)(r0 + row - 1) * P1W + col]); else if (seg > 0) prev = bf2f(PTr[(size_t)b * RW_SHIFT + col]);
            const float pv = cur + p.rw_mu[col] * (prev - cur);
            const float f = cc < 64 ? (1.0f - 2.0f / (1.0f + __expf(2.0f * pv)))   : (cc < 160 ? pv : sigmoidf_(pv));
            XA[row * 296 + cc] = f2bf(f); }
        __syncthreads();
        const size_t row = (size_t)r0 + l15; const int tl = tl0 + l15;
        const bf16_t* curp = P1 + row * P1W; const bf16_t* prevp = (tl > 0) ? (P1 + (row - 1) * P1W) : (PTr + (size_t)b * RW_SHIFT); const bool hasprev = (tl > 0) || (seg > 0);
        struct TileIn { u32x4 cr, ck, cv, pr, pk, pv, vf; };
        struct TilePar { f32x4 m0, m1, m2, w0, a0, v0, kkw, kaw, rk; };
#pragma unroll 1
        for (int x = 0; x < 3; ++x) {
            int hh = c.wv * 3 + x; asm volatile("" : "+s"(hh));
            auto load_tile = [&](int ct, TileIn& T) { const int cc = hh * 64 + (ct >> 1) * 32 + quad * 8;
                T.cr = *(const u32x4*)(curp + cc); T.ck = *(const u32x4*)(curp + DMIX + cc); T.cv = *(const u32x4*)(curp + 2 * DMIX + cc);
                T.pr = (u32x4){0u, 0u, 0u, 0u}; T.pk = T.pr; T.pv = T.pr;
                if (hasprev) { T.pr = *(const u32x4*)(prevp + cc); T.pk = *(const u32x4*)(prevp + DMIX + cc); T.pv = *(const u32x4*)(prevp + 2 * DMIX + cc); }
                T.vf = *(const u32x4*)(VF + row * DMIX + cc); };
            TileIn TA;
            load_tile(0, TA);
            float inv;
            { u32x2 kcur[4], kprv[4]; f32x4 km[4], kw[4];
#pragma unroll
              for (int ct = 0; ct < 4; ++ct) { const int cc = hh * 64 + (ct >> 1) * 32 + quad * 8 + 4 * (ct & 1);
                  kcur[ct] = *(const u32x2*)(curp + DMIX + cc); kprv[ct] = (u32x2){0u, 0u}; if (hasprev) kprv[ct] = *(const u32x2*)(prevp + DMIX + cc);
                  km[ct] = *(const f32x4*)(p.rw_mu + DMIX + cc); kw[ct] = *(const f32x4*)(p.rw_k_k + cc); }
              float ss = 0.f;
#pragma unroll
              for (int ct = 0; ct < 4; ++ct) {
                  const float cb[4] = {bflo(kcur[ct].x), bfhi(kcur[ct].x), bflo(kcur[ct].y), bfhi(kcur[ct].y)}, qb[4] = {bflo(kprv[ct].x), bfhi(kprv[ct].x), bflo(kprv[ct].y), bfhi(kprv[ct].y)};
#pragma unroll
                  for (int j = 0; j < 4; ++j) { const float kr = (cb[j] + km[ct][j] * (qb[j] - cb[j])) * kw[ct][j]; ss += kr * kr; } }
              ss += __shfl_xor(ss, 16); ss += __shfl_xor(ss, 32);
              inv = frcp(fmaxf(sqrtf(ss), 1e-12f)); }
            float br = 0.f, kr = 0.f, rkr = 0.f;
            u32x2 st_g, st_a, st_b, st_k, st_q, st_v;
            auto do_tile = [&](int ct, const TileIn& TI) { const int cc = hh * 64 + (ct >> 1) * 32 + quad * 8 + 4 * (ct & 1);
                TilePar T; T.m0 = *(const f32x4*)(p.rw_mu + cc); T.m1 = *(const f32x4*)(p.rw_mu + DMIX + cc); T.m2 = *(const f32x4*)(p.rw_mu + 2 * DMIX + cc);
                T.w0 = *(const f32x4*)(p.rw_w0 + cc); T.a0 = *(const f32x4*)(p.rw_a0 + cc); T.v0 = *(const f32x4*)(p.rw_v0 + cc); T.kkw = *(const f32x4*)(p.rw_k_k + cc); T.kaw = *(const f32x4*)(p.rw_k_a + cc);
                T.rk = *(const f32x4*)(p.rw_r_k + cc);
                bf16x8 lt[9]; { const bf16_t* lrow = LT + (size_t)(hh * 64 + (ct >> 1) * 32 + 8 * (l15 >> 2) + 4 * (ct & 1) + (l15 & 3)) * 288 + quad * 8;
#pragma unroll
                    for (int k = 0; k < 9; ++k) lt[k] = *(const bf16x8*)(lrow + k * 32); }
                bf16x8 xf[9];
#pragma unroll
                for (int k = 0; k < 9; ++k) xf[k] = *(const LAS bf16x8*)(XA + l15 * 296 + k * 32 + quad * 8);
                f32x4 dw = (f32x4){0.f, 0.f, 0.f, 0.f}, da = dw, dv = dw, dg = dw;
#pragma unroll
                for (int k = 0; k < 2; ++k) dw = mfma16(lt[k], xf[k], dw);
#pragma unroll
                for (int k = 0; k < 2; ++k) da = mfma16(lt[2 + k], xf[2 + k], da);
                dv = mfma16(lt[4], xf[4], dv);
#pragma unroll
                for (int k = 0; k < 4; ++k) dg = mfma16(lt[5 + k], xf[5 + k], dg);
                const bool od = (ct & 1) != 0;
                const unsigned r0 = od ? TI.cr.z : TI.cr.x, r1 = od ? TI.cr.w : TI.cr.y, k0 = od ? TI.ck.z : TI.ck.x, k1 = od ? TI.ck.w : TI.ck.y, c0 = od ? TI.cv.z : TI.cv.x, c1 = od ? TI.cv.w : TI.cv.y;
                const unsigned p0 = od ? TI.pr.z : TI.pr.x, p1 = od ? TI.pr.w : TI.pr.y, q0 = od ? TI.pk.z : TI.pk.x, q1 = od ? TI.pk.w : TI.pk.y, d0 = od ? TI.pv.z : TI.pv.x, d1 = od ? TI.pv.w : TI.pv.y;
                const unsigned f0 = od ? TI.vf.z : TI.vf.x, f1 = od ? TI.vf.w : TI.vf.y;
                const float ca[4] = {bflo(r0), bfhi(r0), bflo(r1), bfhi(r1)}, cb[4] = {bflo(k0), bfhi(k0), bflo(k1), bfhi(k1)}, cd[4] = {bflo(c0), bfhi(c0), bflo(c1), bfhi(c1)};
                const float qa[4] = {bflo(p0), bfhi(p0), bflo(p1), bfhi(p1)}, qb[4] = {bflo(q0), bfhi(q0), bflo(q1), bfhi(q1)}, qd[4] = {bflo(d0), bfhi(d0), bflo(d1), bfhi(d1)};
                const float vf[4] = {bflo(f0), bfhi(f0), bflo(f1), bfhi(f1)};
                u32x2 gw; gw.x = pk2(dg[0], dg[1]); gw.y = pk2(dg[2], dg[3]);
                float wv4[4], av[4], bv[4], ktv[4], qv[4], vv[4];
#pragma unroll
                for (int j = 0; j < 4; ++j) {
                    const float rc = ca[j] + T.m0[j] * (qa[j] - ca[j]), kc = cb[j] + T.m1[j] * (qb[j] - cb[j]), vc = cd[j] + T.m2[j] * (qd[j] - cd[j]);
                    const float zz = -(T.w0[j] + dw[j]); const float sp = fmaxf(zz, 0.f) + __logf(1.0f + __expf(-fabsf(zz)));
                    wv4[j] = __expf(-__expf(-sp - 0.5f));
                    const float a = sigmoidf_(T.a0[j] + da[j]);
                    vv[j] = vc + (vf[j] - vc) * sigmoidf_(T.v0[j] + dv[j]);
                    const float kk = kc * T.kkw[j] * inv; av[j] = -kk; bv[j] = kk * a;
                    ktv[j] = kc * (1.0f + (a - 1.0f) * T.kaw[j]); qv[j] = rc;
                    br += bv[j] * rc; kr += ktv[j] * rc; rkr += rc * ktv[j] * T.rk[j]; }
                float gfin[4];
#pragma unroll
                for (int j = 0; j < 4; ++j) { float g = wv4[j];
                    g *= dpp_shr_or1<1>(g); g *= dpp_shr_or1<2>(g); g *= dpp_shr_or1<4>(g); g *= dpp_shr_or1<8>(g);
                    const float gp = dpp_shr_or1<1>(g), ig = frcp(g);
                    av[j] *= gp; qv[j] *= g; bv[j] *= ig; ktv[j] *= ig; gfin[j] = g; }
                if (l15 == 15) *(f32x4*)(GTB + ((size_t)it * 24 + hh) * 64 + (cc - hh * 64)) = (f32x4){gfin[0], gfin[1], gfin[2], gfin[3]};
                const u32x2 ta = (u32x2){pk2(av[0], av[1]), pk2(av[2], av[3])}, tb = (u32x2){pk2(bv[0], bv[1]), pk2(bv[2], bv[3])}, tk = (u32x2){pk2(ktv[0], ktv[1]), pk2(ktv[2], ktv[3])};
                const u32x2 tq = (u32x2){pk2(qv[0], qv[1]), pk2(qv[2], qv[3])}, tv = (u32x2){pk2(vv[0], vv[1]), pk2(vv[2], vv[3])};
                if ((ct & 1) == 0) { st_g = gw; st_a = ta; st_b = tb; st_k = tk; st_q = tq; st_v = tv; }
                else { const size_t o8 = row * DMIX + cc - 4;
                    *(u32x4*)(SG + o8) = (u32x4){st_g.x, st_g.y, gw.x, gw.y}; *(u32x4*)(SA + o8) = (u32x4){st_a.x, st_a.y, ta.x, ta.y}; *(u32x4*)(SB + o8) = (u32x4){st_b.x, st_b.y, tb.x, tb.y};
                    *(u32x4*)(SK + o8) = (u32x4){st_k.x, st_k.y, tk.x, tk.y}; *(u32x4*)(SQ + o8) = (u32x4){st_q.x, st_q.y, tq.x, tq.y}; *(u32x4*)(SV + o8) = (u32x4){st_v.x, st_v.y, tv.x, tv.y}; } };
            do_tile(0, TA); __builtin_amdgcn_sched_barrier(0);
            do_tile(1, TA); __builtin_amdgcn_sched_barrier(0);
            load_tile(2, TA); do_tile(2, TA); __builtin_amdgcn_sched_barrier(0);
            do_tile(3, TA);
            br += __shfl_xor(br, 16); br += __shfl_xor(br, 32); kr += __shfl_xor(kr, 16); kr += __shfl_xor(kr, 32); rkr += __shfl_xor(rkr, 16); rkr += __shfl_xor(rkr, 32);
            if (quad == 0) *(f32x4*)(BRKR + (row * 24 + hh) * 4) = (f32x4){br, kr, rkr, 0.f};
        }
        if (tl0 == 496) { for (int e = c.tid; e < RW_SHIFT; e += 512) PTw[(size_t)b * RW_SHIFT + e] = P1[(size_t)(r0 + 15) * P1W + e]; }
    }
}

__device__ __forceinline__ void rwkv_item(const P& p, const Ctx& c, int seg, int w, bool save) {
    const int b = w / 24, hh = w % 24;
    const float* SW = (const float*)(c.seg + S1_W); const bf16_t* SA = (const bf16_t*)(c.seg + S1_A); const bf16_t* SB = (const bf16_t*)(c.seg + S1_B); const bf16_t* SK = (const bf16_t*)(c.seg + S1_K);
    const bf16_t* SQ = (const bf16_t*)(c.seg + S1_Q); const bf16_t* SV = (const bf16_t*)(c.seg + S1_V); const float* BRKR = (const float*)(c.seg + S1_BRKR);
    float* O = (float*)(c.seg + S1_O); float* RST = (float*)(p.ws + OFF_RST) + (size_t)w * 4096;
    constexpr int TB = 32, REC = 388;
    LAS float* L0 = (LAS float*)c.lds;
    const int rp = c.wv * 4 + (c.lane >> 4), cq = c.lane & 15;
    f32x2 S0a, S0b, S1a, S1b;
    if (seg > 0) { const f32x4 s0 = *(const f32x4*)(RST + (2 * rp) * 64 + cq * 4), s1 = *(const f32x4*)(RST + (2 * rp + 1) * 64 + cq * 4);
        S0a = (f32x2){s0[0], s0[1]}; S0b = (f32x2){s0[2], s0[3]}; S1a = (f32x2){s1[0], s1[1]}; S1b = (f32x2){s1[2], s1[3]}; }
    else { S0a = S0b = S1a = S1b = (f32x2){0.f, 0.f}; }
    const int e4 = c.tid * 4, stt = e4 >> 6, scc = e4 & 63;
    f32x4 gw; u32x2 ga, gb, gk, gq, gv; f32x4 gbr;
    auto gload = [&](int blk) { const size_t go = ((size_t)b * SEGT + blk * TB + stt) * DMIX + hh * 64 + scc;
        gw = *(const f32x4*)(SW + go); ga = *(const u32x2*)(SA + go); gb = *(const u32x2*)(SB + go); gk = *(const u32x2*)(SK + go); gq = *(const u32x2*)(SQ + go); gv = *(const u32x2*)(SV + go);
        if (c.tid < TB) gbr = *(const f32x4*)(BRKR + (((size_t)b * SEGT + blk * TB + c.tid) * 24 + hh) * 4); };
    auto lstore = [&](int buf) { LAS float* r = L0 + buf * (TB * REC) + stt * REC + scc;
        *(LAS f32x4*)(r) = gw; *(LAS f32x4*)(r + 64) = (f32x4){bflo(ga.x), bfhi(ga.x), bflo(ga.y), bfhi(ga.y)}; *(LAS f32x4*)(r + 128) = (f32x4){bflo(gb.x), bfhi(gb.x), bflo(gb.y), bfhi(gb.y)};
        *(LAS f32x4*)(r + 192) = (f32x4){bflo(gk.x), bfhi(gk.x), bflo(gk.y), bfhi(gk.y)}; *(LAS f32x4*)(r + 256) = (f32x4){bflo(gq.x), bfhi(gq.x), bflo(gq.y), bfhi(gq.y)};
        *(LAS f32x4*)(r + 320) = (f32x4){bflo(gv.x), bfhi(gv.x), bflo(gv.y), bfhi(gv.y)};
        if (c.tid < TB) { LAS float* q = L0 + buf * (TB * REC) + c.tid * REC + 384; *(LAS f32x2*)q = (f32x2){gbr[0], gbr[1]}; } };
    __syncthreads();
    gload(0); lstore(0);
    __syncthreads();
#pragma unroll 1
    for (int blk = 0; blk < SEGT / TB; ++blk) {
        const int buf = blk & 1;
        if (blk + 1 < SEGT / TB) gload(blk + 1);
        const LAS float* base = L0 + buf * (TB * REC);
        const size_t rowb = (size_t)b * SEGT + blk * TB;
        f32x4 nw4 = *(const LAS f32x4*)(base + cq * 4), na4 = *(const LAS f32x4*)(base + 64 + cq * 4), nb4 = *(const LAS f32x4*)(base + 128 + cq * 4), nk4 = *(const LAS f32x4*)(base + 192 + cq * 4), nq4 = *(const LAS f32x4*)(base + 256 + cq * 4);
        f32x2 nv2 = *(const LAS f32x2*)(base + 320 + 2 * rp), nbk = *(const LAS f32x2*)(base + 384);
#pragma unroll 2
        for (int tt = 0; tt < TB; ++tt) {
            const f32x4 w4 = nw4, a4 = na4, b4 = nb4, k4 = nk4, q4 = nq4; const f32x2 v2 = nv2, bk = nbk;
            { const LAS float* r = base + (tt + 1 < TB ? tt + 1 : tt) * REC;
              nw4 = *(const LAS f32x4*)(r + cq * 4); na4 = *(const LAS f32x4*)(r + 64 + cq * 4); nb4 = *(const LAS f32x4*)(r + 128 + cq * 4); nk4 = *(const LAS f32x4*)(r + 192 + cq * 4); nq4 = *(const LAS f32x4*)(r + 256 + cq * 4);
              nv2 = *(const LAS f32x2*)(r + 320 + 2 * rp); nbk = *(const LAS f32x2*)(r + 384); }
            const f32x2 wa = (f32x2){w4[0], w4[1]}, wb = (f32x2){w4[2], w4[3]}, aa = (f32x2){a4[0], a4[1]}, ab = (f32x2){a4[2], a4[3]}, ba = (f32x2){b4[0], b4[1]}, bb = (f32x2){b4[2], b4[3]};
            const f32x2 ka = (f32x2){k4[0], k4[1]}, kb = (f32x2){k4[2], k4[3]}, qa = (f32x2){q4[0], q4[1]}, qb = (f32x2){q4[2], q4[3]};
            f32x2 t0 = S0a * aa + S0b * ab, t1 = S0a * qa + S0b * qb, t2 = S1a * aa + S1b * ab, t3 = S1a * qa + S1b * qb;
            float pa0 = t0.x + t0.y, pt0 = t1.x + t1.y, pa1 = t2.x + t2.y, pt1 = t3.x + t3.y;
            row16_allsum4(pa0, pa1, pt0, pt1);
            const f32x2 pa0v = (f32x2){pa0, pa0}, pa1v = (f32x2){pa1, pa1}, v0v = (f32x2){v2.x, v2.x}, v1v = (f32x2){v2.y, v2.y};
            S0a = S0a * wa + pa0v * ba + v0v * ka; S0b = S0b * wb + pa0v * bb + v0v * kb;
            S1a = S1a * wa + pa1v * ba + v1v * ka; S1b = S1b * wb + pa1v * bb + v1v * kb;
            if (cq == 0) { const f32x2 y = (f32x2){pt0 + pa0 * bk.x + v2.x * bk.y, pt1 + pa1 * bk.x + v2.y * bk.y};
                *(f32x2*)(O + (rowb + tt) * DMIX + hh * 64 + 2 * rp) = y; }
        }
        if (blk + 1 < SEGT / TB) lstore(buf ^ 1);
        __syncthreads();
    }
    if (!save) return;
    *(f32x4*)(RST + (2 * rp) * 64 + cq * 4) = (f32x4){S0a.x, S0a.y, S0b.x, S0b.y}; *(f32x4*)(RST + (2 * rp + 1) * 64 + cq * 4) = (f32x4){S1a.x, S1a.y, S1b.x, S1b.y};
}

__device__ __forceinline__ void rwkv_chunk_item(const P& p, const Ctx& c, int seg, int w, bool save) {
    const int b = w / 24, hh = w % 24;
    const bf16_t* SA = (const bf16_t*)(c.seg + S1_A); const bf16_t* SB = (const bf16_t*)(c.seg + S1_B); const bf16_t* SK = (const bf16_t*)(c.seg + S1_K);
    const bf16_t* SR = (const bf16_t*)(c.seg + S1_Q); const bf16_t* SV = (const bf16_t*)(c.seg + S1_V); const float* GTB = (const float*)(c.seg + S1_W);
    bf16_t* Y = (bf16_t*)(c.seg + S1_Y); const bf16_t* SG = (const bf16_t*)(c.seg + S1_G); const bf16_t* P2 = (const bf16_t*)(c.seg + S1_P2); const float* BRKR = (const float*)(c.seg + S1_BRKR); float* RST = (float*)(p.ws + OFF_RST) + (size_t)w * 4096;
    constexpr int O_EA = 0  , O_EB = 4608  , O_EBT = 9216  , O_UV = 14336  ,
                  O_MT1 = 19456  , O_NT = 20736  , O_MABT = 22016  ,
                  O_GT = 23296  , OPB = 23552;
    LAS unsigned char* OB = c.lds;
    LAS bf16_t* S0I = (LAS bf16_t*)(c.lds + 2 * OPB);
    LAS float* XF = (LAS float*)(c.lds + 2 * OPB + 9216);
    LAS float* YB = (LAS float*)(c.lds + 2 * OPB + 9216 + 4352);
    const int l15c = c.lane & 15, quadc = c.lane >> 4;
    f32x4 S[2];
#pragma unroll
    for (int x = 0; x < 2; ++x) { const int ti = c.wv * 2 + x, mt = ti >> 2, nt = ti & 3;
#pragma unroll
        for (int jj = 0; jj < 4; ++jj) S[x][jj] = (seg > 0) ? RST[(mt * 16 + quadc * 4 + jj) * 64 + nt * 16 + l15c] : 0.f; }
    unsigned ga = 0, gb = 0, gk = 0, gr = 0, gv = 0; float gg = 1.f;
    auto gload = [&](int ch, int tidv) { const int t = tidv >> 5, j0 = (tidv & 31) * 2; const size_t go = ((size_t)b * SEGT + ch * 16 + t) * DMIX + hh * 64 + j0;
        ga = *(const unsigned*)(SA + go); gb = *(const unsigned*)(SB + go); gk = *(const unsigned*)(SK + go); gr = *(const unsigned*)(SR + go); gv = *(const unsigned*)(SV + go);
        if (tidv < 64) gg = GTB[((size_t)(b * 32 + ch) * 24 + hh) * 64 + tidv]; };
    auto lstore = [&](int pb, int tidv) { const int t = tidv >> 5, j0 = (tidv & 31) * 2;
        LAS bf16_t* EA = (LAS bf16_t*)(OB + pb * OPB + O_EA); LAS bf16_t* EB = (LAS bf16_t*)(OB + pb * OPB + O_EB); LAS bf16_t* EBT = (LAS bf16_t*)(OB + pb * OPB + O_EBT);
        LAS bf16_t* UV = (LAS bf16_t*)(OB + pb * OPB + O_UV); LAS float* GT = (LAS float*)(OB + pb * OPB + O_GT);
        *(LAS unsigned*)(EA + t * 72 + j0) = ga; *(LAS unsigned*)(EA + (16 + t) * 72 + j0) = gr;
        *(LAS unsigned*)(EB + t * 72 + j0) = gb; *(LAS unsigned*)(EB + (16 + t) * 72 + j0) = gk;
        EBT[j0 * 40 + t] = (bf16_t)(gb & 0xFFFFu); EBT[(j0 + 1) * 40 + t] = (bf16_t)(gb >> 16); EBT[j0 * 40 + 16 + t] = (bf16_t)(gk & 0xFFFFu); EBT[(j0 + 1) * 40 + 16 + t] = (bf16_t)(gk >> 16);
        UV[j0 * 40 + 16 + t] = (bf16_t)(gv & 0xFFFFu); UV[(j0 + 1) * 40 + 16 + t] = (bf16_t)(gv >> 16); UV[j0 * 40 + t] = 0; UV[(j0 + 1) * 40 + t] = 0;
        if (tidv < 64) GT[tidv] = gg; };
    auto gtile = [&](int pb, int l15, int quad) {
        LAS bf16_t* EA = (LAS bf16_t*)(OB + pb * OPB + O_EA); LAS bf16_t* EB = (LAS bf16_t*)(OB + pb * OPB + O_EB);
        LAS bf16_t* MT1 = (LAS bf16_t*)(OB + pb * OPB + O_MT1); LAS bf16_t* NT = (LAS bf16_t*)(OB + pb * OPB + O_NT); LAS float* MABT = (LAS float*)(OB + pb * OPB + O_MABT);
        const int sb = c.wv >> 1, tb = c.wv & 1; f32x4 g = (f32x4){0.f, 0.f, 0.f, 0.f};
#pragma unroll
        for (int kk = 0; kk < 2; ++kk) g = mfma16(*(const LAS bf16x8*)(EB + (sb * 16 + l15) * 72 + kk * 32 + quad * 8), *(const LAS bf16x8*)(EA + (tb * 16 + l15) * 72 + kk * 32 + quad * 8), g);
#pragma unroll
        for (int jj = 0; jj < 4; ++jj) { const int s2 = quad * 4 + jj, tt = l15; const float v = g[jj];
            if (tb == 0) { const float m = (s2 < tt) ? v : 0.f; if (sb == 0) { MABT[tt * 20 + s2] = m; MT1[tt * 40 + s2] = 0; } else MT1[tt * 40 + 16 + s2] = f2bf(m); }
            else { const float m = (s2 <= tt) ? v : 0.f; NT[tt * 40 + sb * 16 + s2] = f2bf(m); } } };
    auto simg = [&](int l15, int quad) {
#pragma unroll
        for (int x = 0; x < 2; ++x) { const int ti = c.wv * 2 + x, mt = ti >> 2, nt = ti & 3;
#pragma unroll
            for (int jj = 0; jj < 4; ++jj) S0I[(mt * 16 + quad * 4 + jj) * 72 + nt * 16 + l15] = f2bf(S[x][jj]); } };
    const int et = (c.tid >> 4) & 15, eg = c.tid & 15; const int ech = hh * 64 + eg * 4;
    const f32x4 elg = *(const f32x4*)(p.rw_lnx_g + ech), elb = *(const f32x4*)(p.rw_lnx_b + ech);
    u32x2 e_g = (u32x2){0u, 0u}, e_z = e_g, e_v = e_g; float e_rkr = 0.f;
    auto eload = [&](int ch) { const size_t rr = (size_t)b * SEGT + ch * 16 + et;
        e_g = *(const u32x2*)(SG + rr * DMIX + ech); e_v = *(const u32x2*)(SV + rr * DMIX + ech); e_z = *(const u32x2*)(P2 + rr * P2W + 512 + ech); e_rkr = BRKR[(rr * 24 + hh) * 4 + 2]; };
    auto efinish = [&](int ch) { const f32x4 o4 = *(const LAS f32x4*)(YB + et * 68 + eg * 4);
        float s1 = (o4[0] + o4[1]) + (o4[2] + o4[3]), s2 = (o4[0] * o4[0] + o4[1] * o4[1]) + (o4[2] * o4[2] + o4[3] * o4[3]);
        s1 = dpp_add<0xB1>(s1); s2 = dpp_add<0xB1>(s2); s1 = dpp_add<0x4E>(s1); s2 = dpp_add<0x4E>(s2); s1 = dpp_add<0x141>(s1); s2 = dpp_add<0x141>(s2); s1 = dpp_add<0x140>(s1); s2 = dpp_add<0x140>(s2);
        const float mean = s1 * (1.0f / 64.0f), var = fmaxf(s2 * (1.0f / 64.0f) - mean * mean, 0.f), rs = rsqrtf(var + 64e-5f);
        const float gg[4] = {bflo(e_g.x), bfhi(e_g.x), bflo(e_g.y), bfhi(e_g.y)}, vv[4] = {bflo(e_v.x), bfhi(e_v.x), bflo(e_v.y), bfhi(e_v.y)}, zz[4] = {bflo(e_z.x), bfhi(e_z.x), bflo(e_z.y), bfhi(e_z.y)};
        float y[4];
#pragma unroll
        for (int j = 0; j < 4; ++j) y[j] = ((o4[j] - mean) * rs * elg[j] + elb[j] + e_rkr * vv[j]) * gg[j] * siluf_(zz[j]);
        *(u32x2*)(Y + ((size_t)b * SEGT + ch * 16 + et) * DIN + ech) = (u32x2){pk2(y[0], y[1]), pk2(y[2], y[3])}; };
    __syncthreads();
    { int t0 = c.tid; asm volatile("" : "+v"(t0)); gload(0, t0); lstore(0, t0); simg(l15c, quadc); }
    lds_barrier();
    if (c.wv < 4) gtile(0, l15c, quadc);
    { int t1 = c.tid; asm volatile("" : "+v"(t1)); gload(1, t1); }
    const int mtq = c.wv & 3;
#pragma unroll 1
    for (int ch = 0; ch < SEGT / 16; ++ch) {
        const int pb = ch & 1;
        int tidv = c.tid, l15 = l15c, quad = quadc; asm volatile("" : "+v"(tidv), "+v"(l15), "+v"(quad));
        LAS bf16_t* EA = (LAS bf16_t*)(OB + pb * OPB + O_EA); LAS bf16_t* EBT = (LAS bf16_t*)(OB + pb * OPB + O_EBT); LAS bf16_t* UV = (LAS bf16_t*)(OB + pb * OPB + O_UV);
        LAS bf16_t* MT1 = (LAS bf16_t*)(OB + pb * OPB + O_MT1); LAS bf16_t* NT = (LAS bf16_t*)(OB + pb * OPB + O_NT); LAS float* MABT = (LAS float*)(OB + pb * OPB + O_MABT); LAS float* GT = (LAS float*)(OB + pb * OPB + O_GT);
        lds_barrier();
        f32x4 Zt = (f32x4){0.f, 0.f, 0.f, 0.f};
        if (c.wv < 4 && ch > 0) efinish(ch - 1);
        if (c.wv >= 4) {
            f32x4 Xt = (f32x4){0.f, 0.f, 0.f, 0.f};
#pragma unroll
            for (int kk = 0; kk < 2; ++kk) { const bf16x8 a = *(const LAS bf16x8*)(S0I + (mtq * 16 + l15) * 72 + kk * 32 + quad * 8);
                Xt = mfma16(a, *(const LAS bf16x8*)(EA + l15 * 72 + kk * 32 + quad * 8), Xt); Zt = mfma16(a, *(const LAS bf16x8*)(EA + (16 + l15) * 72 + kk * 32 + quad * 8), Zt); }
            Xt = mfma16(*(const LAS bf16x8*)(UV + (mtq * 16 + l15) * 40 + quad * 8), *(const LAS bf16x8*)(MT1 + l15 * 40 + quad * 8), Xt);
#pragma unroll
            for (int jj = 0; jj < 4; ++jj) XF[(mtq * 16 + quad * 4 + jj) * 17 + l15] = Xt[jj];
        }
        lds_barrier();
        if (ch + 1 < SEGT / 16) lstore(pb ^ 1, tidv);
        if (ch + 2 < SEGT / 16) gload(ch + 2, tidv);
        if (c.wv == 0) {
            float u[16];
#pragma unroll
            for (int tt = 0; tt < 16; ++tt) { float acc = XF[c.lane * 17 + tt];
#pragma unroll
                for (int s4 = 0; s4 < (tt + 3) / 4; ++s4) { const f32x4 m = *(const LAS f32x4*)(MABT + tt * 20 + s4 * 4);
#pragma unroll
                    for (int e = 0; e < 4; ++e) if (s4 * 4 + e < tt) acc += u[s4 * 4 + e] * m[e]; }
                u[tt] = acc; }
            *(LAS u32x4*)(UV + c.lane * 40) = (u32x4){pk2(u[0], u[1]), pk2(u[2], u[3]), pk2(u[4], u[5]), pk2(u[6], u[7])};
            *(LAS u32x4*)(UV + c.lane * 40 + 8) = (u32x4){pk2(u[8], u[9]), pk2(u[10], u[11]), pk2(u[12], u[13]), pk2(u[14], u[15])};
        }
        lds_barrier();
        if (c.wv >= 4) {
            Zt = mfma16(*(const LAS bf16x8*)(UV + (mtq * 16 + l15) * 40 + quad * 8), *(const LAS bf16x8*)(NT + l15 * 40 + quad * 8), Zt);
            *(LAS f32x4*)(YB + l15 * 68 + mtq * 16 + quad * 4) = Zt;
        } else eload(ch);
#pragma unroll
        for (int x = 0; x < 2; ++x) { const int ti = c.wv * 2 + x, mt = ti >> 2, nt = ti & 3;
            S[x] = mfma16(*(const LAS bf16x8*)(UV + (mt * 16 + l15) * 40 + quad * 8), *(const LAS bf16x8*)(EBT + (nt * 16 + l15) * 40 + quad * 8), S[x]);
            const float gt = GT[nt * 16 + l15];
#pragma unroll
            for (int jj = 0; jj < 4; ++jj) S[x][jj] *= gt; }
        simg(l15, quad);
        if (c.wv < 4 && ch + 1 < SEGT / 16) gtile(pb ^ 1, l15, quad);
    }
    lds_barrier();
    if (c.wv < 4) efinish(SEGT / 16 - 1);
    if (!save) return;
#pragma unroll
    for (int x = 0; x < 2; ++x) { const int ti = c.wv * 2 + x, mt = ti >> 2, nt = ti & 3;
#pragma unroll
        for (int jj = 0; jj < 4; ++jj) RST[(mt * 16 + quadc * 4 + jj) * 64 + nt * 16 + l15c] = S[x][jj]; }
}

__device__ __forceinline__ void phase_b3(const P& p, const Ctx& c) {
    const bf16_t* O = (const bf16_t*)(c.seg + S1_O); const bf16_t* P2 = (const bf16_t*)(c.seg + S1_P2); const bf16_t* SV = (const bf16_t*)(c.seg + S1_V); const bf16_t* SG = (const bf16_t*)(c.seg + S1_G);
    const float* BRKR = (const float*)(c.seg + S1_BRKR); const bf16_t* YM = (const bf16_t*)(c.seg + S1_YMEM); bf16_t* Y = (bf16_t*)(c.seg + S1_Y);
    for (int r = c.bid * 8 + c.wv; r < MS; r += c.G * 8) {
#pragma unroll
        for (int ps = 0; ps < 3; ++ps) {
            const int hh = ps * 8 + (c.lane >> 3), ch = hh * 64 + (c.lane & 7) * 8;
            const u32x4 orr = *(const u32x4*)(O + (size_t)r * DMIX + ch);
            float v[8] = {bflo(orr.x), bfhi(orr.x), bflo(orr.y), bfhi(orr.y), bflo(orr.z), bfhi(orr.z), bflo(orr.w), bfhi(orr.w)}; float s = 0.f, s2 = 0.f;
#pragma unroll
            for (int j = 0; j < 8; ++j) { s += v[j]; s2 += v[j] * v[j]; }
            s += __shfl_xor(s, 1); s2 += __shfl_xor(s2, 1); s += __shfl_xor(s, 2); s2 += __shfl_xor(s2, 2); s += __shfl_xor(s, 4); s2 += __shfl_xor(s2, 4);
            const float mean = s * (1.0f / 64.0f), var = fmaxf(s2 * (1.0f / 64.0f) - mean * mean, 0.f), rs = rsqrtf(var + 64e-5f);
            const float rkr = BRKR[((size_t)r * 24 + hh) * 4 + 2];
            const u32x4 vr = *(const u32x4*)(SV + (size_t)r * DMIX + ch), gr = *(const u32x4*)(SG + (size_t)r * DMIX + ch), zr = *(const u32x4*)(P2 + (size_t)r * P2W + 512 + ch);
            const float vv[8] = {bflo(vr.x), bfhi(vr.x), bflo(vr.y), bfhi(vr.y), bflo(vr.z), bfhi(vr.z), bflo(vr.w), bfhi(vr.w)};
            const float gg[8] = {bflo(gr.x), bfhi(gr.x), bflo(gr.y), bfhi(gr.y), bflo(gr.z), bfhi(gr.z), bflo(gr.w), bfhi(gr.w)};
            const float zz[8] = {bflo(zr.x), bfhi(zr.x), bflo(zr.y), bfhi(zr.y), bflo(zr.z), bfhi(zr.z), bflo(zr.w), bfhi(zr.w)};
            float y[8];
#pragma unroll
            for (int j = 0; j < 8; ++j) { const float t = ((v[j] - mean) * rs * p.rw_lnx_g[ch + j] + p.rw_lnx_b[ch + j] + rkr * vv[j]) * gg[j]; y[j] = t * siluf_(zz[j]); }
            *(u32x4*)(Y + (size_t)r * DIN + ch) = (u32x4){pk2(y[0], y[1]), pk2(y[2], y[3]), pk2(y[4], y[5]), pk2(y[6], y[7])};
        }
        { const int cm = c.lane * 8; const u32x4 mr = *(const u32x4*)(YM + (size_t)r * DX + cm), zr = *(const u32x4*)(P2 + (size_t)r * P2W + 512 + DMIX + cm);
          const float mm[8] = {bflo(mr.x), bfhi(mr.x), bflo(mr.y), bfhi(mr.y), bflo(mr.z), bfhi(mr.z), bflo(mr.w), bfhi(mr.w)};
          const float zz[8] = {bflo(zr.x), bfhi(zr.x), bflo(zr.y), bfhi(zr.y), bflo(zr.z), bfhi(zr.z), bflo(zr.w), bfhi(zr.w)};
          float y[8];
#pragma unroll
          for (int j = 0; j < 8; ++j) y[j] = mm[j] * siluf_(zz[j]);
          *(u32x4*)(Y + (size_t)r * DIN + DMIX + cm) = (u32x4){pk2(y[0], y[1]), pk2(y[2], y[3]), pk2(y[4], y[5]), pk2(y[6], y[7])}; }
    }
}

__device__ __forceinline__ bool fresh_ctx(Ctx& c, P& p, unsigned char* ws0) { int t = threadIdx.x; asm volatile("" : "+v"(t)); c.tid = t; c.wv = __builtin_amdgcn_readfirstlane(t >> 6); c.lane = t & 63;
    int bb = (int)blockIdx.x, gg = (int)gridDim.x; asm volatile("" : "+s"(bb), "+s"(gg)); c.bid = bb; c.G = gg;
#if defined(__HIP_DEVICE_COMPILE__)
    { typedef const __attribute__((address_space(4))) unsigned long long* KP; KP kp = (KP)__builtin_amdgcn_kernarg_segment_ptr(); asm volatile("" : "+s"(kp));
      typedef __attribute__((address_space(1))) char* GP; char** dst = (char**)&p;
#pragma unroll
      for (int i = 0; i < (int)(sizeof(P) / 8); ++i) dst[i] = (char*)(GP)(kp[i]); }
#endif
    size_t z = 0; asm volatile("" : "+s"(z)); p.ws = ws0 + z; c.seg = ws0 + z + OFF_SEG;
    return true; }
__global__ __launch_bounds__(512) void fwd_megakernel(P p_arg) {
    P p = p_arg;
    extern __shared__ __attribute__((aligned(16))) unsigned char shm[];
    LAS unsigned char* lds = (LAS unsigned char*)shm;
    Ctx c; c.tid = threadIdx.x; c.wv = threadIdx.x >> 6; c.lane = threadIdx.x & 63; c.G = gridDim.x; c.bid = blockIdx.x; c.lds = lds; c.seg = p.ws + OFF_SEG;
    volatile LAS unsigned* st = (volatile LAS unsigned*)(lds + LDS_BYTES - 16);
    if (c.tid == 0) { st[0] = 0u; st[1] = 0u; }
    __syncthreads();
    const XcdBarrier xb = xcd_barrier_post((unsigned*)(p.ws + OFF_BAR), st);
#define GSYNC() do { XcdBarrier _xl = xb; size_t _zz = 0; asm volatile("" : "+s"(_zz)); _xl.bar = xb.bar + _zz; _xl.x = xb_xcc_id();     \
        xcd_barrier(_xl); if (RK == 20) { for (int _q = 1; _q < RN; ++_q) xcd_barrier(_xl); } } while (0)
#ifndef RK
#define RK -1
#endif
#ifndef RN
#define RN 1
#endif
#define NREP(k) ((k) == RK ? RN : 1)
#define PH(k) for (int _r = 0; _r < NREP(k); ++_r) if (fresh_ctx(c, p, p_arg.ws))
#define LASTREP(k) (_r + 1 == NREP(k))
    PH(0) phase0(p, c);
    PH(1) phase_apre(p, c, 0, c.bid, c.G);
    GSYNC();
    for (int seg = 0; seg < NSEG; ++seg) {
        PH(2) { SchedA0 S; S.ws = p.ws; S.seg = c.seg; S.G = c.G; S.c = c.bid; S.nextra = (seg == 0) ? 64 : 0;
          pg8::gemm_phase<pg8::EpiBf, SchedA0>(lds, c.tid, 1024, 1024, S, pg8::EpiBf{}); }
        GSYNC();
        PH(3) phase_a1(p, c, seg);
        GSYNC();
        for (int it0 = c.bid; it0 < 256; it0 += c.G) {
            const int xq = it0 & 7, yq = it0 >> 3; const int it = (yq < 24) ? ((xq * 4 + yq / 6) * 6 + yq % 6) : (192 + (yq - 24) * 8 + xq);
            if (it < 192) { PH(4) mlstm_item(p, c, seg, it, LASTREP(4)); }
            else { PH(5) attn_item(p, c, 0, it - 192, (const bf16_t*)(c.seg + S0_P0) + DMIX, ML_W, (bf16_t*)(c.seg + S0_YMEM), DX, nullptr, 0); }
        }
        GSYNC();
        PH(6) phase_a3(p, c, seg);
        GSYNC();
        PH(7) { SchedOut S; S.Y = (const char*)(c.seg + S0_Y); S.W = (const char*)(p.ws + OFF_WO0T); S.slab = (char*)(c.seg + S0_SLAB); S.G = c.G; S.c = c.bid;
          pg8::gemm_phase<pg8::EpiBf, SchedOut>(lds, c.tid, DIN, 512, S, pg8::EpiBf{}); }
        GSYNC();
        PH(8) phase_a5(p, c, seg);
        GSYNC();
        PH(9) { SchedB0 S; S.ws = p.ws; S.seg = c.seg; S.G = c.G; S.c = c.bid;
          pg8::gemm_phase<pg8::EpiBf, SchedB0>(lds, c.tid, 1024, 1024, S, pg8::EpiBf{}); }
        GSYNC();
        PH(10) phase_b1(p, c, seg);
        GSYNC();
        for (int it = c.bid; it < 256; it += c.G) {
            if (it < 192) { PH(11) rwkv_chunk_item(p, c, seg, it, LASTREP(11)); }
            else { PH(5) attn_item(p, c, 1, it - 192, (const bf16_t*)(c.seg + S1_P2), P2W, (bf16_t*)(c.seg + S1_Y) + DMIX, DIN, (const bf16_t*)(c.seg + S1_P2) + 512 + DMIX, P2W);
                   if (c.G == 256) { PH(1) if (seg + 1 < NSEG) phase_apre(p, c, seg + 1, it - 192, 64); } }
        }
        GSYNC();
        PH(13) { SchedOut S; S.Y = (const char*)(c.seg + S1_Y); S.W = (const char*)(p.ws + OFF_WO1T); S.slab = (char*)(c.seg + S1_SLAB); S.G = c.G; S.c = c.bid;
          pg8::gemm_phase<pg8::EpiBf, SchedOut>(lds, c.tid, DIN, 512, S, pg8::EpiBf{}); }
        GSYNC();
        PH(14) phase_b5(p, c, seg);
        if (c.G != 256) { PH(1) if (seg + 1 < NSEG) phase_apre(p, c, seg + 1, c.bid, c.G); GSYNC(); }
    }
}

extern "C" void kernel_launch(void* const* d_in, const int* in_sizes, int n_in, void* d_out, int out_size, void* d_ws, size_t ws_size, hipStream_t stream) {
    static int grid = 0;
    if (grid == 0) {
        int dev = 0, cus = 0, per_cu = 0;
        if (hipGetDevice(&dev) != hipSuccess || hipDeviceGetAttribute(&cus, hipDeviceAttributeMultiprocessorCount, dev) != hipSuccess) { grid = -1; return; }
        if (hipFuncSetAttribute((const void*)fwd_megakernel, hipFuncAttributeMaxDynamicSharedMemorySize, LDS_BYTES) != hipSuccess) { fprintf(stderr, "hipFuncSetAttribute failed\n"); grid = -1; return; }
        if (hipOccupancyMaxActiveBlocksPerMultiprocessor(&per_cu, (const void*)fwd_megakernel, 512, LDS_BYTES) != hipSuccess || per_cu < 1) { fprintf(stderr, "occupancy query: %d\n", per_cu); }
        (void)hipGetLastError();
        grid = cus;
        if (n_in != 31 || ws_size < 256 * MiB) { fprintf(stderr, "unexpected n_in %d / ws %zu\n", n_in, ws_size); grid = -1; return; }
    }
    if (grid < 0) return;
    (void)hipMemsetAsync((char*)d_ws + OFF_BAR, 0, XCD_BAR_WORDS * 4, stream);
    P p{};
    const float** f = (const float**)&p;
    for (int i = 0; i < 31; ++i) f[i] = (const float*)d_in[i];
    p.out = (float*)d_out; p.ws = (unsigned char*)d_ws;
    fwd_megakernel<<<dim3(grid), dim3(512), LDS_BYTES, stream>>>(p);
}
```

```cpp
#include <hip/hip_runtime.h>
#include <cstdio>
#include <cstdint>

#define LAS __attribute__((address_space(3)))
typedef unsigned short bf16_t;
typedef short bf16x8 __attribute__((ext_vector_type(8)));
typedef short bf16x4 __attribute__((ext_vector_type(4)));
typedef float f32x4 __attribute__((ext_vector_type(4)));
typedef float f32x2 __attribute__((ext_vector_type(2)));
typedef unsigned u32x4 __attribute__((ext_vector_type(4)));
typedef unsigned u32x2 __attribute__((ext_vector_type(2)));

constexpr int NB = 8, SEQ = 2048, DM = 1024, NSEG = 4, SEGT = 512, MS = NB * SEGT;
constexpr int DMIX = 1536, DX = 512, DIN = 2048;
constexpr int ML_W = 4096, RW_SHIFT = 4896, RW_W = 7456;
constexpr int P1W = 5120, P2W = 2560;
constexpr size_t MiB = 1u << 20;
constexpr size_t OFF_WT0 = 0, OFF_WT1 = 8 * MiB, OFF_WO0T = 23 * MiB, OFF_WO1T = 27 * MiB, OFF_WKVT = 31 * MiB  ,
                 OFF_KMEM = 35 * MiB  , OFF_LORAT = 43 * MiB, OFF_MISC = 45 * MiB,
                 OFF_CST = 46 * MiB, OFF_NST = 65 * MiB, OFF_RST = 65 * MiB + 512 * 1024, OFF_H = 69 * MiB, OFF_VF = 77 * MiB,
                 OFF_SEG = 89 * MiB, OFF_MEMN = 248 * MiB;
constexpr size_t OFF_BAR = OFF_MISC, OFF_UTAIL = OFF_MISC + 64 * 1024, OFF_PTAIL = OFF_MISC + 256 * 1024;
constexpr size_t S0_P0 = 0, S0_Q = 32 * MiB, S0_K = 44 * MiB, S0_KT = 56 * MiB, S0_VT = 68 * MiB, S0_XC = 80 * MiB, S0_HRAW = 92 * MiB,
                 S0_Y = 104 * MiB  , S0_GATE = 120 * MiB, S0_YMEM = 121 * MiB  ;
constexpr size_t S1_P1 = 0, S1_O = 0, S1_Y = 24 * MiB, S1_P2 = 40 * MiB, S1_W = 60 * MiB, S1_A = 84 * MiB, S1_B = 96 * MiB, S1_K = 108 * MiB,
                 S1_Q = 120 * MiB, S1_V = 132 * MiB, S1_G = 144 * MiB, S1_YMEM = 156 * MiB, S1_BRKR = 160 * MiB;
constexpr size_t S0_SLAB = 0  , S1_SLAB = 126 * MiB  ;
constexpr int LDS_BYTES = 150 * 1024;

struct P {
    const float *x, *mem, *norm_g, *mem_norm_g, *mem_kv_w, *w_out, *ml_w_in, *ml_conv_w, *ml_conv_b, *ml_wq, *ml_wk, *ml_wv, *ml_w_gate, *ml_b_gate,
        *ml_mhn_g, *ml_skip, *rw_w_in, *rw_mu, *rw_w_lora2, *rw_w0, *rw_a_lora2, *rw_a0, *rw_v_lora2, *rw_v0, *rw_g_lora2, *rw_k_k, *rw_k_a, *rw_r_k,
        *rw_lnx_g, *rw_lnx_b, *final_g;
    float* out; unsigned char* ws;
};

__device__ __forceinline__ bf16_t f2bf(float f) { const __bf16 r = (__bf16)f; bf16_t u; __builtin_memcpy(&u, &r, 2); return u; }
__device__ __forceinline__ float bf2f(bf16_t b) { return __uint_as_float(((unsigned)b) << 16); }
typedef __bf16 bf2_t __attribute__((ext_vector_type(2)));
__device__ __forceinline__ unsigned pk2(float lo, float hi) { const bf2_t r = __builtin_convertvector((f32x2){lo, hi}, bf2_t); unsigned u; __builtin_memcpy(&u, &r, 4); return u; }
__device__ __forceinline__ float bflo(unsigned u) { return __uint_as_float(u << 16); }
__device__ __forceinline__ float bfhi(unsigned u) { return __uint_as_float(u & 0xFFFF0000u); }
__device__ __forceinline__ float wsum(float v) {
#pragma unroll
    for (int o = 32; o >= 1; o >>= 1) v += __shfl_xor(v, o);
    return v;
}
__device__ __forceinline__ float frcp(float x) { return __builtin_amdgcn_rcpf(x); }
__device__ __forceinline__ float sigmoidf_(float x) { return frcp(1.0f + __expf(-x)); }
__device__ __forceinline__ float siluf_(float x) { return x * frcp(1.0f + __expf(-x)); }
__device__ __forceinline__ float softplusf_(float z) { return fmaxf(z, 0.f) + __logf(1.0f + __expf(-fabsf(z))); }
template <int CTRL> __device__ __forceinline__ float dpp_add(float v) {
    return v + __int_as_float(__builtin_amdgcn_update_dpp(0, __float_as_int(v), CTRL, 0xF, 0xF, true));
}
__device__ __forceinline__ float row16_allsum(float v) {
    v = dpp_add<0xB1>(v);
    v = dpp_add<0x4E>(v);
    v = dpp_add<0x141>(v);
    v = dpp_add<0x140>(v);
    return v;
}
__device__ __forceinline__ void row16_allsum4(float& a, float& b, float& c, float& d) {
    asm volatile("s_nop 1\n\t"
        "v_add_f32_dpp %0, %0, %0 quad_perm:[1,0,3,2] row_mask:0xf bank_mask:0xf\n\t" "v_add_f32_dpp %1, %1, %1 quad_perm:[1,0,3,2] row_mask:0xf bank_mask:0xf\n\t"
        "v_add_f32_dpp %2, %2, %2 quad_perm:[1,0,3,2] row_mask:0xf bank_mask:0xf\n\t" "v_add_f32_dpp %3, %3, %3 quad_perm:[1,0,3,2] row_mask:0xf bank_mask:0xf\n\t"
        "v_add_f32_dpp %0, %0, %0 quad_perm:[2,3,0,1] row_mask:0xf bank_mask:0xf\n\t" "v_add_f32_dpp %1, %1, %1 quad_perm:[2,3,0,1] row_mask:0xf bank_mask:0xf\n\t"
        "v_add_f32_dpp %2, %2, %2 quad_perm:[2,3,0,1] row_mask:0xf bank_mask:0xf\n\t" "v_add_f32_dpp %3, %3, %3 quad_perm:[2,3,0,1] row_mask:0xf bank_mask:0xf\n\t"
        "v_add_f32_dpp %0, %0, %0 row_half_mirror row_mask:0xf bank_mask:0xf\n\t" "v_add_f32_dpp %1, %1, %1 row_half_mirror row_mask:0xf bank_mask:0xf\n\t"
        "v_add_f32_dpp %2, %2, %2 row_half_mirror row_mask:0xf bank_mask:0xf\n\t" "v_add_f32_dpp %3, %3, %3 row_half_mirror row_mask:0xf bank_mask:0xf\n\t"
        "v_add_f32_dpp %0, %0, %0 row_mirror row_mask:0xf bank_mask:0xf\n\t" "v_add_f32_dpp %1, %1, %1 row_mirror row_mask:0xf bank_mask:0xf\n\t"
        "v_add_f32_dpp %2, %2, %2 row_mirror row_mask:0xf bank_mask:0xf\n\t" "v_add_f32_dpp %3, %3, %3 row_mirror row_mask:0xf bank_mask:0xf\n\t"
        "s_nop 1"
        : "+v"(a), "+v"(b), "+v"(c), "+v"(d));
}
template <int N> __device__ __forceinline__ float dpp_shr_or1(float v) {
    return __int_as_float(__builtin_amdgcn_update_dpp(0x3f800000, __float_as_int(v), 0x110 + N, 0xF, 0xF, false));
}
__device__ __forceinline__ f32x4 mfma16(bf16x8 a, bf16x8 b, f32x4 c) { return __builtin_amdgcn_mfma_f32_16x16x32_bf16(a, b, c, 0, 0, 0); }

namespace pg8 {
constexpr int BM = 256, BK = 64, HALF = 128, HTB = HALF * BK * 2, STAGE_BYTES = 8 * HTB, NXCD = 8, WGM = 8;
__host__ __device__ __forceinline__ int lds_byte(int r, int c) { const int st = (r >> 4) * 2 + (c >> 5), rr = r & 15, cc = c & 31, ob = rr * 64 + cc * 2; return st * 1024 + (ob ^ (((ob >> 9) & 1) << 5)); }
__host__ __device__ __forceinline__ void stage_rc(int b, int& R, int& C) { const int st = b / 1024, sb = b % 1024, swz = sb ^ (((sb >> 9) & 1) << 5); R = (st >> 1) * 16 + swz / 64; C = (st & 1) * 32 + (swz % 64) / 2; }
__host__ __device__ __forceinline__ int perm32(int rho) { const int n = rho >> 4, i = rho & 15; return 8 * (i >> 2) + 4 * n + (i & 3); }

struct Unit { const char* A; const char* B; char* O; int ldc; int pad; };

__device__ __forceinline__ void remap(int wgid, int nM, int nN, int& pm, int& pn) {
    const int nwg = nM * nN;
    { const int q = nwg / NXCD, r = nwg % NXCD, xcd = wgid % NXCD, off = wgid / NXCD; wgid = (xcd < r ? xcd * (q + 1) : r * (q + 1) + (xcd - r) * q) + off; }
    const int nig = WGM * nN, gid = wgid / nig, fm = gid * WGM, gsz = (nM - fm) < WGM ? (nM - fm) : WGM;
    pm = fm + ((wgid % nig) % gsz); pn = (wgid % nig) / gsz;
}

struct EpiBf {
    static constexpr bool PERM = true;
    __device__ __forceinline__ void operator()(const f32x4 (&acc)[2][2][4][2], const Unit& u, int wr, int wc, int fr, int fq) const {
        asm volatile("" : "+v"(fr), "+v"(fq));
        bf16_t* base = (bf16_t*)u.O;
#pragma unroll
        for (int ai = 0; ai < 2; ++ai)
#pragma unroll
            for (int m = 0; m < 4; ++m) { bf16_t* rowp = base + (size_t)(ai * HALF + wr * 64 + m * 16 + fr) * u.ldc + wc * 32 + 8 * fq;
#pragma unroll
                for (int bj = 0; bj < 2; ++bj) { const f32x4 v0 = acc[ai][bj][m][0], v1 = acc[ai][bj][m][1];
                    u32x4 w; w.x = pk2(v0[0], v0[1]); w.y = pk2(v0[2], v0[3]); w.z = pk2(v1[0], v1[1]); w.w = pk2(v1[2], v1[3]);
                    *(u32x4*)(rowp + bj * HALF) = w; } }
    }
};
struct EpiAtomic {
    static constexpr bool PERM = false;
    __device__ __forceinline__ void operator()(const f32x4 (&acc)[2][2][4][2], const Unit& u, int wr, int wc, int fr, int fq) const {
        asm volatile("" : "+v"(fr), "+v"(fq));
        float* base = (float*)u.O;
#pragma unroll
        for (int ai = 0; ai < 2; ++ai)
#pragma unroll
            for (int m = 0; m < 4; ++m) { float* rowp = base + (size_t)(ai * HALF + wr * 64 + m * 16 + fr) * u.ldc + wc * 32 + 4 * fq;
#pragma unroll
                for (int bj = 0; bj < 2; ++bj)
#pragma unroll
                    for (int n = 0; n < 2; ++n) { const f32x4 v = acc[ai][bj][m][n]; float* q = rowp + bj * HALF + n * 16;
#pragma unroll
                        for (int e = 0; e < 4; ++e) (void)__hip_atomic_fetch_add(q + e, v[e], __ATOMIC_RELAXED, __HIP_MEMORY_SCOPE_AGENT); }
                __builtin_amdgcn_sched_barrier(0); }
    }
};

template <class Epi, class Sched>
__device__ __forceinline__ void gemm_phase(LAS unsigned char* lds, const int tid, const int ldk, const int Kloop, const Sched& S, const Epi& E) {
    const int wid = __builtin_amdgcn_readfirstlane(tid >> 6), lane = tid & 63, wr = wid >> 2, wc = wid & 3, fr = lane & 15, fq = lane >> 4;
    const int nt = Kloop / BK;
    unsigned voffA[2], voffB[2];
#pragma unroll
    for (int i = 0; i < 2; ++i) { int R, C; stage_rc(tid * 16 + i * 8192, R, C); const int Rb = Epi::PERM ? ((R & ~31) + perm32(R & 31)) : R;
        voffA[i] = (unsigned)(R * ldk + C) * 2u; voffB[i] = (unsigned)(Rb * ldk + C) * 2u; }
    const size_t kstep = (size_t)(BK * 2);
    const size_t hstep = (size_t)HALF * ldk * 2;
    const unsigned ldsw = (unsigned)wid * 1024u;
    const int aoff = lds_byte(wr * 64 + fr, fq * 8), boff = lds_byte(wc * 32 + fr, fq * 8);
#define PG8_SA(b, h) (((b) * 2 + (h)) * HTB)
#define PG8_SB(b, h) ((4 + (b) * 2 + (h)) * HTB)
#define PG8_STAGE(bufoff, gbase, voff) do { _Pragma("unroll") for (int _i = 0; _i < 2; ++_i) \
        __builtin_amdgcn_global_load_lds((const unsigned*)((const char*)(gbase) + (voff)[_i]), (LAS unsigned*)(lds + (bufoff) + ldsw + _i * 8192), 16, 0, 0); } while (0)
#define PG8_LDA(dst, b, h) do { _Pragma("unroll") for (int m = 0; m < 4; ++m) _Pragma("unroll") for (int k = 0; k < 2; ++k) dst[m][k] = *(const LAS bf16x8*)(lds + PG8_SA(b, h) + aoff + m * 2048 + k * 1024); } while (0)
#define PG8_LDB(dst, b, h) do { _Pragma("unroll") for (int n = 0; n < 2; ++n) _Pragma("unroll") for (int k = 0; k < 2; ++k) dst[n][k] = *(const LAS bf16x8*)(lds + PG8_SB(b, h) + boff + n * 2048 + k * 1024); } while (0)
#define PG8_MMA(ai, bj, At, Bt) do { __builtin_amdgcn_s_setprio(1); _Pragma("unroll") for (int m = 0; m < 4; ++m) _Pragma("unroll") for (int n = 0; n < 2; ++n) _Pragma("unroll") for (int k = 0; k < 2; ++k) \
        acc[ai][bj][m][n] = __builtin_amdgcn_mfma_f32_16x16x32_bf16(Bt[n][k], At[m][k], acc[ai][bj][m][n], 0, 0, 0); __builtin_amdgcn_s_setprio(0); } while (0)
#define PG8_WAIT_V(n) asm volatile("s_waitcnt vmcnt(" #n ")" ::: "memory")
#define PG8_WAIT_L(n) asm volatile("s_waitcnt lgkmcnt(" #n ")" ::: "memory")
#define PG8_BAR __builtin_amdgcn_s_barrier()
#define PG8_SCHED __builtin_amdgcn_sched_barrier(0)
    Unit cur, nxt; int ui = 0;
    if (!S.next(0, cur)) return;
    f32x4 acc[2][2][4][2];
#pragma unroll
    for (int a = 0; a < 2; ++a)
#pragma unroll
        for (int b = 0; b < 2; ++b)
#pragma unroll
            for (int m = 0; m < 4; ++m)
#pragma unroll
                for (int n = 0; n < 2; ++n) acc[a][b][m][n] = (f32x4){0.f, 0.f, 0.f, 0.f};
    bf16x8 At[4][2], B0[2][2], B1[2][2];
    const char* cA = cur.A; const char* cB = cur.B;
    PG8_STAGE(PG8_SB(0, 0), cB, voffB); PG8_STAGE(PG8_SA(0, 0), cA, voffA); PG8_STAGE(PG8_SB(0, 1), cB + hstep, voffB); PG8_STAGE(PG8_SA(0, 1), cA + hstep, voffA);
    if (wr == 1) PG8_BAR;
    PG8_WAIT_V(4); PG8_BAR;
    PG8_STAGE(PG8_SB(1, 0), cB + kstep, voffB); PG8_STAGE(PG8_SA(1, 0), cA + kstep, voffA); PG8_STAGE(PG8_SB(1, 1), cB + hstep + kstep, voffB);
    PG8_WAIT_V(6); PG8_BAR;
    for (;;) {
        const bool has_next = S.next(ui + 1, nxt);
        const char* nA = has_next ? nxt.A : cA; const char* nB = has_next ? nxt.B : cB;
        for (int t = 0; t < nt; t += 2) {
            const bool last = (t == nt - 2);
            const char* a1 = cA + (size_t)(t + 1) * kstep;
            const char* a2 = last ? nA : cA + (size_t)(t + 2) * kstep; const char* b2 = last ? nB : cB + (size_t)(t + 2) * kstep;
            const char* a3 = a2 + kstep; const char* b3 = b2 + kstep;
            PG8_LDB(B0, 0, 0); PG8_SCHED; PG8_LDA(At, 0, 0); PG8_STAGE(PG8_SA(1, 1), a1 + hstep, voffA);
            PG8_WAIT_L(8); PG8_BAR; PG8_WAIT_L(0); PG8_MMA(0, 0, At, B0); PG8_BAR; PG8_SCHED;
            PG8_LDB(B1, 0, 1); PG8_STAGE(PG8_SB(0, 0), b2, voffB);
            PG8_BAR; PG8_WAIT_L(0); PG8_MMA(0, 1, At, B1); PG8_BAR;
            PG8_LDA(At, 0, 1); PG8_STAGE(PG8_SA(0, 0), a2, voffA);
            PG8_BAR; PG8_WAIT_L(0); PG8_MMA(1, 0, At, B0); PG8_BAR; PG8_SCHED;
            PG8_STAGE(PG8_SB(0, 1), b2 + hstep, voffB);
            PG8_WAIT_V(6); PG8_BAR; PG8_MMA(1, 1, At, B1); PG8_BAR;
            PG8_LDB(B0, 1, 0); PG8_SCHED; PG8_LDA(At, 1, 0); PG8_STAGE(PG8_SA(0, 1), a2 + hstep, voffA);
            PG8_WAIT_L(8); PG8_BAR; PG8_WAIT_L(0); PG8_MMA(0, 0, At, B0); PG8_BAR; PG8_SCHED;
            PG8_LDB(B1, 1, 1); PG8_STAGE(PG8_SB(1, 0), b3, voffB);
            PG8_BAR; PG8_WAIT_L(0); PG8_MMA(0, 1, At, B1); PG8_BAR;
            PG8_LDA(At, 1, 1); PG8_STAGE(PG8_SA(1, 0), a3, voffA);
            PG8_BAR; PG8_WAIT_L(0); PG8_MMA(1, 0, At, B0); PG8_BAR; PG8_SCHED;
            PG8_STAGE(PG8_SB(1, 1), b3 + hstep, voffB);
            PG8_WAIT_V(6); PG8_BAR; PG8_MMA(1, 1, At, B1); PG8_BAR;
        }
        E(acc, cur, wr, wc, fr, fq);
        if (!has_next) break;
#pragma unroll
        for (int a = 0; a < 2; ++a)
#pragma unroll
            for (int b = 0; b < 2; ++b)
#pragma unroll
                for (int m = 0; m < 4; ++m)
#pragma unroll
                    for (int n = 0; n < 2; ++n) acc[a][b][m][n] = (f32x4){0.f, 0.f, 0.f, 0.f};
        cur = nxt; cA = nA; cB = nB; ++ui;
    }
    PG8_WAIT_V(0);
    if (wr == 0) PG8_BAR;
    PG8_BAR;
#undef PG8_SA
#undef PG8_SB
#undef PG8_STAGE
#undef PG8_LDA
#undef PG8_LDB
#undef PG8_MMA
#undef PG8_WAIT_V
#undef PG8_WAIT_L
#undef PG8_BAR
#undef PG8_SCHED
}
}

#define XB_TMO      128
#define XB_XCNT(j)  (256  + 64 * (j))
#define XB_XSUB(j)  (1280 + 64 * (j))
#define XB_XGEN(j)  (2304 + 64 * (j))
#define XB_TOP      3328
#define XB_TOPGEN   3392
#define XCD_BAR_WORDS 3456
#define XB_SPIN_CAP (1u << 18)
__device__ __forceinline__ unsigned xb_ld(unsigned* p)              { return __hip_atomic_load(p, __ATOMIC_RELAXED, __HIP_MEMORY_SCOPE_AGENT); }
__device__ __forceinline__ unsigned xb_add(unsigned* p, unsigned v) { return __hip_atomic_fetch_add(p, v, __ATOMIC_RELAXED, __HIP_MEMORY_SCOPE_AGENT); }
__device__ __forceinline__ unsigned xb_xcc_id() { return (unsigned)__builtin_amdgcn_s_getreg((3 << 11) | 20) & 0xFu; }
#define XB_SPIN(cond, bar) do { unsigned _sp = 0; while (cond) { __builtin_amdgcn_s_sleep(1); \
    if ((++_sp & 255u) == 0u) { if (xb_ld(&(bar)[XB_TMO])) break; if (_sp > XB_SPIN_CAP) { atomicAdd(&(bar)[XB_TMO], 1u); break; } } } } while (0)
struct XcdBarrier { unsigned* bar; unsigned x; volatile LAS unsigned* st; };
__device__ __forceinline__ XcdBarrier xcd_barrier_post(unsigned* bar, volatile LAS unsigned* st) {
    XcdBarrier b; b.bar = bar; b.x = xb_xcc_id(); b.st = st;
    if (threadIdx.x == 0) (void)xb_add(&bar[XB_XCNT(b.x)], 1u);
    return b;
}
__device__ __forceinline__ void xcd_barrier_complete(unsigned* bar, unsigned x, unsigned& nloc, unsigned& nx) {
    const unsigned G = gridDim.x * gridDim.y * gridDim.z;
    unsigned sum, cnt, mine, sp = 0u;
    for (;;) {
        sum = 0u; cnt = 0u; mine = 0u;
#pragma unroll
        for (unsigned j = 0; j < 16; ++j) { const unsigned c = xb_ld(&bar[XB_XCNT(j)]); sum += c; cnt += (c > 0u) ? 1u : 0u; mine = (j == x) ? c : mine; }
        if (sum == G) break;
        __builtin_amdgcn_s_sleep(1);
        if ((++sp & 255u) == 0u) { if (xb_ld(&bar[XB_TMO])) break; if (sp > XB_SPIN_CAP) { atomicAdd(&bar[XB_TMO], 1u); break; } }
    }
    nloc = mine > 0u ? mine : 1u; nx = cnt > 0u ? cnt : 1u;
}
__device__ __forceinline__ void xcd_barrier(const XcdBarrier& b) {
    asm volatile("s_waitcnt vmcnt(0)" ::: "memory");
    __syncthreads();
    int tid0 = threadIdx.x; asm volatile("" : "+v"(tid0));
    if (tid0 == 0) {
        unsigned* bar = b.bar;
        __builtin_amdgcn_s_waitcnt(0);
        unsigned nloc = b.st[0], nx = b.st[1];
        if (nloc == 0u) { xcd_barrier_complete(bar, b.x, nloc, nx); b.st[0] = nloc; b.st[1] = nx; }
        const unsigned old = xb_add(&bar[XB_XSUB(b.x)], 1u);
        const unsigned gen = old / nloc;
        if (old + 1u == (gen + 1u) * nloc) {
            __builtin_amdgcn_fence(__ATOMIC_RELEASE, "agent");
            asm volatile("s_waitcnt vmcnt(0)" ::: "memory");
            const unsigned og = xb_add(&bar[XB_TOP], 1u);
            const unsigned tg = og / nx;
            if (og + 1u == (tg + 1u) * nx) xb_add(&bar[XB_TOPGEN], 1u);
            else XB_SPIN(xb_ld(&bar[XB_TOPGEN]) == tg, bar);
            __builtin_amdgcn_fence(__ATOMIC_ACQUIRE, "agent");
            xb_add(&bar[XB_XGEN(b.x)], 1u);
            asm volatile("s_waitcnt vmcnt(0)" ::: "memory");
        } else {
            XB_SPIN(xb_ld(&bar[XB_XGEN(b.x)]) == gen, bar);
            __builtin_amdgcn_fence(__ATOMIC_ACQUIRE, "agent");
            asm volatile("s_waitcnt vmcnt(0)" ::: "memory");
        }
    }
    __syncthreads();
}

__device__ __forceinline__ void lds_barrier() { asm volatile("s_waitcnt lgkmcnt(0)" ::: "memory"); __builtin_amdgcn_s_barrier(); asm volatile("" ::: "memory"); }
struct Ctx { int tid, wv, lane, G, bid; LAS unsigned char* lds; unsigned char* seg; };

template <int MODE>
__device__ __forceinline__ void convT_tile(const Ctx& c, const float* src, int ldsrc, int Ksrc, int k0, int n0, bf16_t* dst, int ldd, int koff) {
    LAS float* tile = (LAS float*)c.lds;
    __syncthreads();
#pragma unroll
    for (int rep = 0; rep < 2; ++rep) {
        const int i = (c.tid >> 4) + 32 * rep, j4 = (c.tid & 15) * 4; const int n = n0 + j4; int sc = n;
        if (MODE == 1) sc = (n < RW_SHIFT) ? n : (n < P1W ? -1 : n - (P1W - RW_SHIFT));
        f32x4 v = (f32x4){0.f, 0.f, 0.f, 0.f};
        if (sc >= 0 && (k0 + i) < Ksrc) v = *(const f32x4*)(src + (size_t)(k0 + i) * ldsrc + sc);
        tile[i * 65 + j4 + 0] = v[0]; tile[i * 65 + j4 + 1] = v[1]; tile[i * 65 + j4 + 2] = v[2]; tile[i * 65 + j4 + 3] = v[3];
    }
    __syncthreads();
    { const int j = c.tid >> 3, i8 = (c.tid & 7) * 8;
      if (k0 + i8 < Ksrc) {
        u32x4 w; w.x = pk2(tile[(i8 + 0) * 65 + j], tile[(i8 + 1) * 65 + j]); w.y = pk2(tile[(i8 + 2) * 65 + j], tile[(i8 + 3) * 65 + j]);
        w.z = pk2(tile[(i8 + 4) * 65 + j], tile[(i8 + 5) * 65 + j]); w.w = pk2(tile[(i8 + 6) * 65 + j], tile[(i8 + 7) * 65 + j]);
        *(u32x4*)(dst + (size_t)(n0 + j) * ldd + koff + k0 + i8) = w; } }
}

__device__ __forceinline__ void rms_row_bf16(const float* src, const float* g, bf16_t* dst, int lane) {
    f32x4 v[4]; float ss = 0.f;
#pragma unroll
    for (int i = 0; i < 4; ++i) { v[i] = *(const f32x4*)(src + i * 256 + lane * 4); ss += v[i][0] * v[i][0] + v[i][1] * v[i][1] + v[i][2] * v[i][2] + v[i][3] * v[i][3]; }
    ss = wsum(ss); const float rs = rsqrtf(ss * (1.0f / 1024.0f) + 1e-6f);
#pragma unroll
    for (int i = 0; i < 4; ++i) { const f32x4 gg = *(const f32x4*)(g + i * 256 + lane * 4);
        u32x2 w; w.x = pk2(v[i][0] * rs * gg[0], v[i][1] * rs * gg[1]); w.y = pk2(v[i][2] * rs * gg[2], v[i][3] * rs * gg[3]);
        *(u32x2*)(dst + i * 256 + lane * 4) = w; }
}
__device__ __forceinline__ float add_slabs(const float* src, const bf16_t* slab, int r, int lane, f32x4 (&v)[4]) {
    float ss = 0.f;
#pragma unroll
    for (int i = 0; i < 4; ++i) { v[i] = *(const f32x4*)(src + i * 256 + lane * 4);
#pragma unroll
        for (int ks = 0; ks < 4; ++ks) { const u32x2 t = *(const u32x2*)(slab + ((size_t)ks * MS + r) * DM + i * 256 + lane * 4);
            v[i][0] += bflo(t.x); v[i][1] += bfhi(t.x); v[i][2] += bflo(t.y); v[i][3] += bfhi(t.y); }
        ss += v[i][0] * v[i][0] + v[i][1] * v[i][1] + v[i][2] * v[i][2] + v[i][3] * v[i][3]; }
    return wsum(ss);
}

__device__ __forceinline__ void phase_apre(const P& p, const Ctx& c, int seg, int wg, int nwg) {
    bf16_t* H = (bf16_t*)(p.ws + OFF_H);
    for (int r = wg * 8 + c.wv; r < MS; r += nwg * 8) { const int b = r >> 9, tl = r & 511; const size_t grow = (size_t)b * SEQ + seg * SEGT + tl;
        rms_row_bf16(p.x + grow * DM, p.norm_g, H + (size_t)r * DM, c.lane); }
}
__device__ __forceinline__ void phase_a5(const P& p, const Ctx& c, int seg) {
    bf16_t* H = (bf16_t*)(p.ws + OFF_H); const bf16_t* slab = (const bf16_t*)(c.seg + S0_SLAB);
    for (int r = c.bid * 8 + c.wv; r < MS / 2; r += c.G * 8) {
        const int ra = r, rb = r + MS / 2;
        const size_t ga = (size_t)(ra >> 9) * SEQ + seg * SEGT + (ra & 511), gb = (size_t)(rb >> 9) * SEQ + seg * SEGT + (rb & 511);
        f32x4 va[4], vb[4]; const float sa = add_slabs(p.x + ga * DM, slab, ra, c.lane, va); const float sb = add_slabs(p.x + gb * DM, slab, rb, c.lane, vb);
        const float rsa = rsqrtf(sa * (1.0f / 1024.0f) + 1e-6f), rsb = rsqrtf(sb * (1.0f / 1024.0f) + 1e-6f);
#pragma unroll
        for (int i = 0; i < 4; ++i) { const f32x4 gg = *(const f32x4*)(p.norm_g + DM + i * 256 + c.lane * 4);
            *(f32x4*)(p.out + ga * DM + i * 256 + c.lane * 4) = va[i]; *(f32x4*)(p.out + gb * DM + i * 256 + c.lane * 4) = vb[i];
            u32x2 w; w.x = pk2(va[i][0] * rsa * gg[0], va[i][1] * rsa * gg[1]); w.y = pk2(va[i][2] * rsa * gg[2], va[i][3] * rsa * gg[3]);
            *(u32x2*)(H + (size_t)ra * DM + i * 256 + c.lane * 4) = w;
            w.x = pk2(vb[i][0] * rsb * gg[0], vb[i][1] * rsb * gg[1]); w.y = pk2(vb[i][2] * rsb * gg[2], vb[i][3] * rsb * gg[3]);
            *(u32x2*)(H + (size_t)rb * DM + i * 256 + c.lane * 4) = w; } }
}
__device__ __forceinline__ void phase_b5(const P& p, const Ctx& c, int seg, int wg, int nwg) {
    const bf16_t* slab = (const bf16_t*)(c.seg + S1_SLAB);
    for (int r = wg * 8 + c.wv; r < MS / 2; r += nwg * 8) {
        const int ra = r, rb = r + MS / 2;
        float* rowa = p.out + ((size_t)(ra >> 9) * SEQ + seg * SEGT + (ra & 511)) * DM; float* rowb = p.out + ((size_t)(rb >> 9) * SEQ + seg * SEGT + (rb & 511)) * DM;
        f32x4 va[4], vb[4]; const float sa = add_slabs(rowa, slab, ra, c.lane, va); const float sb = add_slabs(rowb, slab, rb, c.lane, vb);
        const float rsa = rsqrtf(sa * (1.0f / 1024.0f) + 1e-6f), rsb = rsqrtf(sb * (1.0f / 1024.0f) + 1e-6f);
#pragma unroll
        for (int i = 0; i < 4; ++i) { const f32x4 gg = *(const f32x4*)(p.final_g + i * 256 + c.lane * 4); f32x4 o;
            o[0] = va[i][0] * rsa * gg[0]; o[1] = va[i][1] * rsa * gg[1]; o[2] = va[i][2] * rsa * gg[2]; o[3] = va[i][3] * rsa * gg[3]; *(f32x4*)(rowa + i * 256 + c.lane * 4) = o;
            o[0] = vb[i][0] * rsb * gg[0]; o[1] = vb[i][1] * rsb * gg[1]; o[2] = vb[i][2] * rsb * gg[2]; o[3] = vb[i][3] * rsb * gg[3]; *(f32x4*)(rowb + i * 256 + c.lane * 4) = o; } }
}

__device__ __forceinline__ void phase0(const P& p, const Ctx& c) {
    const int T0 = 16 * 64, T1 = 16 * 120, T2 = 32 * 16, T3 = 32 * 16, T4 = 16 * 16, T5 = 16 * 16, T6 = 24 * 5;
    const int TT = T0 + T1 + T2 + T3 + T4 + T5 + T6;
    for (int t = c.bid; t < TT; t += c.G) {
        int u = t;
        if (u < T0) { convT_tile<0>(c, p.ml_w_in, ML_W, 1024, (u & 15) * 64, (u >> 4) * 64, (bf16_t*)(p.ws + OFF_WT0), 1024, 0); continue; } u -= T0;
        if (u < T1) { convT_tile<1>(c, p.rw_w_in, RW_W, 1024, (u & 15) * 64, (u >> 4) * 64, (bf16_t*)(p.ws + OFF_WT1), 1024, 0); continue; } u -= T1;
        if (u < T2) { convT_tile<0>(c, p.w_out, DM, 2048, (u & 31) * 64, (u >> 5) * 64, (bf16_t*)(p.ws + OFF_WO0T), 2048, 0); continue; } u -= T2;
        if (u < T3) { convT_tile<0>(c, p.w_out + (size_t)DIN * DM, DM, 2048, (u & 31) * 64, (u >> 5) * 64, (bf16_t*)(p.ws + OFF_WO1T), 2048, 0); continue; } u -= T3;
        if (u < T4) { convT_tile<0>(c, p.mem_kv_w, DM, 1024, (u & 15) * 64, (u >> 4) * 64, (bf16_t*)(p.ws + OFF_WKVT), 1024, 0); continue; } u -= T4;
        if (u < T5) { convT_tile<0>(c, p.mem_kv_w + (size_t)DM * DM, DM, 1024, (u & 15) * 64, (u >> 4) * 64, (bf16_t*)(p.ws + OFF_WKVT + 2 * MiB), 1024, 0); continue; } u -= T5;
        { const int nt = u / 5, j = u % 5; bf16_t* L = (bf16_t*)(p.ws + OFF_LORAT);
          if (j == 0) convT_tile<0>(c, p.rw_w_lora2, DMIX, 64, 0, nt * 64, L, 288, 0);
          else if (j == 1) convT_tile<0>(c, p.rw_a_lora2, DMIX, 64, 0, nt * 64, L, 288, 64);
          else if (j == 2) convT_tile<0>(c, p.rw_v_lora2, DMIX, 32, 0, nt * 64, L, 288, 128);
          else convT_tile<0>(c, p.rw_g_lora2, DMIX, 128, (j - 3) * 64, nt * 64, L, 288, 160); }
    }
    for (int r = c.bid * 8 + c.wv; r < 2 * 2048; r += c.G * 8) { const int l = r >> 11, rr = r & 2047;
        rms_row_bf16(p.mem + (size_t)rr * DM, p.mem_norm_g + l * DM, (bf16_t*)(p.ws + OFF_MEMN) + (size_t)r * DM, c.lane); }
}

struct SchedA0 {
    const unsigned char* ws; unsigned char* seg; int G, c, nextra;
    __device__ __forceinline__ bool next(int i, pg8::Unit& u) const {
        const int L = i * G + c; if (L >= 256 + nextra) return false;
        if (L < 256) { int pm, pn; pg8::remap(L, 16, 16, pm, pn);
            u.A = (const char*)(ws + OFF_H) + (size_t)pm * 256 * 1024 * 2; u.B = (const char*)(ws + OFF_WT0) + (size_t)pn * 256 * 1024 * 2;
            u.O = (char*)(seg + S0_P0) + ((size_t)pm * 256 * ML_W + pn * 256) * 2; u.ldc = ML_W; return true; }
        const int e = L - 256, l = e >> 5, j = e & 31;
        const char* memn = (const char*)(ws + OFF_MEMN) + (size_t)l * 2048 * 1024 * 2; const char* wkv = (const char*)(ws + OFF_WKVT) + (size_t)l * 2 * MiB;
        char* kout = (char*)(ws + OFF_KMEM) + (size_t)l * 4 * MiB;
        if (j < 16) { const int pm = j >> 1, pn = j & 1;
            u.A = memn + (size_t)pm * 256 * 1024 * 2; u.B = wkv + (size_t)pn * 256 * 1024 * 2; u.O = kout + ((size_t)pm * 256 * 512 + pn * 256) * 2; u.ldc = 512; }
        else { const int jj = j - 16, pm = jj >> 3, pn = jj & 7;
            u.A = wkv + (size_t)(512 + pm * 256) * 1024 * 2; u.B = memn + (size_t)pn * 256 * 1024 * 2; u.O = kout + 2 * MiB + ((size_t)pm * 256 * 2048 + pn * 256) * 2; u.ldc = 2048; }
        return true;
    }
};
struct SchedB0 {
    const unsigned char* ws; unsigned char* seg; int G, c;
    __device__ __forceinline__ bool next(int i, pg8::Unit& u) const {
        const int L = i * G + c; if (L >= 480) return false;
        int pm, pn; pg8::remap(L, 16, 30, pm, pn);
        u.A = (const char*)(ws + OFF_H) + (size_t)pm * 256 * 1024 * 2; u.B = (const char*)(ws + OFF_WT1) + (size_t)pn * 256 * 1024 * 2;
        if (pn < 20) { u.O = (char*)(seg + S1_P1) + ((size_t)pm * 256 * P1W + pn * 256) * 2; u.ldc = P1W; }
        else { u.O = (char*)(seg + S1_P2) + ((size_t)pm * 256 * P2W + (pn - 20) * 256) * 2; u.ldc = P2W; }
        return true;
    }
};
struct SchedOut {
    const char* Y; const char* W; char* slab; int G, c;
    __device__ __forceinline__ bool next(int i, pg8::Unit& u) const {
        const int L = i * G + c; if (L >= 256) return false;
        const int ks = L >> 6; int pm, pn; pg8::remap(L & 63, 16, 4, pm, pn);
        u.A = Y + ((size_t)pm * 256 * DIN + ks * 512) * 2; u.B = W + ((size_t)pn * 256 * DIN + ks * 512) * 2;
        u.O = slab + (((size_t)ks * MS + pm * 256) * DM + pn * 256) * 2; u.ldc = DM; return true;
    }
};

__device__ __forceinline__ void phase_a1(const P& p, const Ctx& c, int seg) {
    const bf16_t* P0 = (const bf16_t*)(c.seg + S0_P0);
    bf16_t* Qb = (bf16_t*)(c.seg + S0_Q); bf16_t* Kb = (bf16_t*)(c.seg + S0_K); bf16_t* KT = (bf16_t*)(c.seg + S0_KT); bf16_t* VT = (bf16_t*)(c.seg + S0_VT);
    bf16_t* XC = (bf16_t*)(c.seg + S0_XC); bf16_t* VF = (bf16_t*)(p.ws + OFF_VF);
    float* IPRE = (float*)(c.seg + S0_GATE); float* LOGF = IPRE + 32 * SEGT;
    const bf16_t* UT = (const bf16_t*)(p.ws + OFF_UTAIL);
    LAS float* red = (LAS float*)c.lds;
    LAS bf16_t* kst = (LAS bf16_t*)(c.lds + 98304);
    LAS bf16_t* vst = kst + 1536 * 8;
    const int n = c.tid;
    float wq[4][4], wk[4][4], wv[4][4], G12[4][8], G3[4][8];
    if (n < 384) {
#pragma unroll
        for (int i = 0; i < 4; ++i) { const f32x4 a = *(const f32x4*)(p.ml_wq + n * 16 + i * 4), bb = *(const f32x4*)(p.ml_wk + n * 16 + i * 4), cc = *(const f32x4*)(p.ml_wv + n * 16 + i * 4);
#pragma unroll
            for (int o = 0; o < 4; ++o) { wq[i][o] = a[o]; wk[i][o] = bb[o]; wv[i][o] = cc[o]; } }
#pragma unroll
        for (int i = 0; i < 4; ++i)
#pragma unroll
            for (int g = 0; g < 8; ++g) { G12[i][g] = 0.f; G3[i][g] = 0.f; }
#pragma unroll
        for (int o = 0; o < 4; ++o) {
            const float* gq = p.ml_w_gate + (size_t)(n * 4 + o) * 8; const float* gk = p.ml_w_gate + (size_t)(DMIX + n * 4 + o) * 8; const float* gv = p.ml_w_gate + (size_t)(2 * DMIX + n * 4 + o) * 8;
            const f32x4 q0 = *(const f32x4*)gq, q1 = *(const f32x4*)(gq + 4), k0 = *(const f32x4*)gk, k1 = *(const f32x4*)(gk + 4), v0 = *(const f32x4*)gv, v1 = *(const f32x4*)(gv + 4);
#pragma unroll
            for (int i = 0; i < 4; ++i)
#pragma unroll
                for (int g = 0; g < 4; ++g) { G12[i][g] += wq[i][o] * q0[g] + wk[i][o] * k0[g]; G12[i][g + 4] += wq[i][o] * q1[g] + wk[i][o] * k1[g];
                    G3[i][g] += wv[i][o] * v0[g]; G3[i][g + 4] += wv[i][o] * v1[g]; }
        }
    }
#pragma unroll 1
    for (int it = c.bid; it < MS / 8; it += c.G) {
        const int row0 = it * 8, b = row0 >> 9, tl0 = row0 & 511;
        __syncthreads();
        if (n < 384) {
            float um[3][4];
#pragma unroll
            for (int j = 1; j <= 3; ++j) { u32x2 raw = (u32x2){0u, 0u};
                if (tl0 - j >= 0) raw = *(const u32x2*)(P0 + (unsigned)((row0 - j) * ML_W + n * 4));
                else if (seg > 0) raw = *(const u32x2*)(UT + (unsigned)((b * 3 + (3 - j)) * DMIX + n * 4));
                um[3 - j][0] = bflo(raw.x); um[3 - j][1] = bfhi(raw.x); um[3 - j][2] = bflo(raw.y); um[3 - j][3] = bfhi(raw.y); }
            u32x2 nraw = *(const u32x2*)(P0 + (unsigned)(row0 * ML_W + n * 4));
#pragma unroll 1
            for (int tt = 0; tt < 8; ++tt) {
                const unsigned row = (unsigned)(row0 + tt);
                const u32x2 raw = nraw;
                if (tt + 1 < 8) nraw = *(const u32x2*)(P0 + (unsigned)((row + 1) * ML_W + n * 4));
                float u[4] = {bflo(raw.x), bfhi(raw.x), bflo(raw.y), bfhi(raw.y)}, xc[4], q[4], k[4], v[4];
                { int nn = n; asm volatile("" : "+v"(nn));
                  const f32x4 cb = *(const f32x4*)(p.ml_conv_b + nn * 4), c0 = *(const f32x4*)(p.ml_conv_w + nn * 4), c1 = *(const f32x4*)(p.ml_conv_w + DMIX + nn * 4),
                              c2 = *(const f32x4*)(p.ml_conv_w + 2 * DMIX + nn * 4), c3 = *(const f32x4*)(p.ml_conv_w + 3 * DMIX + nn * 4);
#pragma unroll
                  for (int i = 0; i < 4; ++i) { const float y = cb[i] + c0[i] * um[0][i] + c1[i] * um[1][i] + c2[i] * um[2][i] + c3[i] * u[i]; xc[i] = siluf_(y); } }
                const float ks = 0.05103103630798288f;
#pragma unroll
                for (int o = 0; o < 4; ++o) { q[o] = xc[0] * wq[0][o] + xc[1] * wq[1][o] + xc[2] * wq[2][o] + xc[3] * wq[3][o];
                    k[o] = (xc[0] * wk[0][o] + xc[1] * wk[1][o] + xc[2] * wk[2][o] + xc[3] * wk[3][o]) * ks;
                    v[o] = u[0] * wv[0][o] + u[1] * wv[1][o] + u[2] * wv[2][o] + u[3] * wv[3][o]; }
#pragma unroll
                for (int g = 0; g < 8; ++g) red[(tt * 8 + g) * 384 + n] = xc[0] * G12[0][g] + xc[1] * G12[1][g] + xc[2] * G12[2][g] + xc[3] * G12[3][g] + u[0] * G3[0][g] + u[1] * G3[1][g] + u[2] * G3[2][g] + u[3] * G3[3][g];
                u32x2 w; w.x = pk2(q[0], q[1]); w.y = pk2(q[2], q[3]); *(u32x2*)(Qb + (unsigned)(row * DMIX + n * 4)) = w;
                w.x = pk2(k[0], k[1]); w.y = pk2(k[2], k[3]); *(u32x2*)(Kb + (unsigned)(row * DMIX + n * 4)) = w;
                w.x = pk2(xc[0], xc[1]); w.y = pk2(xc[2], xc[3]); *(u32x2*)(XC + (unsigned)(row * DMIX + n * 4)) = w;
                w.x = pk2(v[0], v[1]); w.y = pk2(v[2], v[3]); *(u32x2*)(VF + (unsigned)(row * DMIX + n * 4)) = w;
#pragma unroll
                for (int o = 0; o < 4; ++o) { kst[(o * 384 + n) * 8 + tt] = f2bf(k[o]); vst[(o * 384 + n) * 8 + tt] = f2bf(v[o]); }
#pragma unroll
                for (int i = 0; i < 4; ++i) { um[0][i] = um[1][i]; um[1][i] = um[2][i]; um[2][i] = u[i]; }
            }
            const int hd = n / 96, dch = (n % 96) * 4;
#pragma unroll
            for (int o = 0; o < 4; ++o) { const unsigned off = (unsigned)(((b * 4 + hd) * 384 + dch + o) * SEGT + tl0);
                *(u32x4*)(KT + off) = *(const LAS u32x4*)(kst + (o * 384 + n) * 8); *(u32x4*)(VT + off) = *(const LAS u32x4*)(vst + (o * 384 + n) * 8); }
        }
        __syncthreads();
        { const int v = c.tid >> 3, part = c.tid & 7; float s = 0.f;
#pragma unroll 8
          for (int i = 0; i < 48; ++i) s += red[v * 384 + part * 48 + i];
          s += __shfl_xor(s, 1); s += __shfl_xor(s, 2); s += __shfl_xor(s, 4);
          if (part == 0) { const int tt = v >> 3, g = v & 7; const float gate = s + p.ml_b_gate[g];
              if (g < 4) IPRE[(b * 4 + g) * SEGT + tl0 + tt] = gate; else LOGF[(b * 4 + g - 4) * SEGT + tl0 + tt] = -softplusf_(-gate); } }
    }
}

__device__ __forceinline__ void attn_item(const P& p, const Ctx& c, int layer, int it, const bf16_t* Qp, int ldq, bf16_t* YM, int ldy, const bf16_t* Zp, int ldz) {
    const int b = it >> 3, head = (it >> 1) & 3, qb = it & 1;
    const bf16_t* Kg = (const bf16_t*)(p.ws + OFF_KMEM + (size_t)layer * 4 * MiB) + (size_t)(b * 256) * 512 + head * 128;
    const bf16_t* Vg = (const bf16_t*)(p.ws + OFF_KMEM + (size_t)layer * 4 * MiB + 2 * MiB) + (size_t)(head * 128) * 2048 + b * 256;
    LAS bf16_t* Ks = (LAS bf16_t*)c.lds;
    LAS bf16_t* Vs = Ks + 256 * 136;
    const int l15 = c.lane & 15, quad = c.lane >> 4;
    __syncthreads();
#pragma unroll
    for (int r = 0; r < 8; ++r) { const int id = c.tid + 512 * r; { const int i = id >> 4, c8 = (id & 15) * 8; *(LAS u32x4*)(Ks + i * 136 + c8) = *(const u32x4*)(Kg + (size_t)i * 512 + c8); }
        { const int i = id >> 5, c8 = (id & 31) * 8; *(LAS u32x4*)(Vs + i * 264 + c8) = *(const u32x4*)(Vg + (size_t)i * 2048 + c8); } }
    __syncthreads();
#pragma unroll 1
    for (int pass = 0; pass < 2; ++pass) {
        const int row0 = b * SEGT + qb * 256 + c.wv * 32 + pass * 16;
        bf16x8 qf[4];
#pragma unroll
        for (int kk = 0; kk < 4; ++kk) qf[kk] = *(const bf16x8*)(Qp + (size_t)(row0 + l15) * ldq + head * 128 + kk * 32 + quad * 8);
        f32x4 acc[16];
#pragma unroll
        for (int mt = 0; mt < 16; ++mt) { acc[mt] = (f32x4){0.f, 0.f, 0.f, 0.f};
#pragma unroll
            for (int kk = 0; kk < 4; ++kk) { const bf16x8 a = *(const LAS bf16x8*)(Ks + (mt * 16 + l15) * 136 + kk * 32 + quad * 8); acc[mt] = mfma16(a, qf[kk], acc[mt]); }
            if ((mt & 3) == 3) __builtin_amdgcn_sched_barrier(0); }
        float mx = -1e30f;
#pragma unroll
        for (int mt = 0; mt < 16; ++mt)
#pragma unroll
            for (int j = 0; j < 4; ++j) mx = fmaxf(mx, acc[mt][j]);
        mx = fmaxf(mx, __shfl_xor(mx, 16)); mx = fmaxf(mx, __shfl_xor(mx, 32));
        const float sc = 0.08838834764831845f * 1.4426950408889634f; float sm = 0.f;
#pragma unroll
        for (int mt = 0; mt < 16; ++mt)
#pragma unroll
            for (int j = 0; j < 4; ++j) { const float e = exp2f((acc[mt][j] - mx) * sc); acc[mt][j] = e; sm += e; }
        sm += __shfl_xor(sm, 16); sm += __shfl_xor(sm, 32);
        const float inv = frcp(sm);
        bf16x8 pa[8];
#pragma unroll
        for (int kp = 0; kp < 8; ++kp) {
            u32x4 aw; aw.x = pk2(acc[2 * kp][0] * inv, acc[2 * kp][1] * inv); aw.y = pk2(acc[2 * kp][2] * inv, acc[2 * kp][3] * inv);
            aw.z = pk2(acc[2 * kp + 1][0] * inv, acc[2 * kp + 1][1] * inv); aw.w = pk2(acc[2 * kp + 1][2] * inv, acc[2 * kp + 1][3] * inv);
            __builtin_memcpy(&pa[kp], &aw, 16); }
        __builtin_amdgcn_sched_barrier(0);
        f32x4 o[8];
#pragma unroll
        for (int nt = 0; nt < 8; ++nt) o[nt] = (f32x4){0.f, 0.f, 0.f, 0.f};
#pragma unroll
        for (int kp = 0; kp < 8; ++kp) {
            const bf16x8 a = pa[kp];
#pragma unroll
            for (int nt = 0; nt < 8; ++nt) { const LAS bf16_t* vp = Vs + (nt * 16 + l15) * 264 + 2 * kp * 16 + quad * 4;
                const u32x2 lo = *(const LAS u32x2*)vp, hi = *(const LAS u32x2*)(vp + 16); u32x4 bw = (u32x4){lo.x, lo.y, hi.x, hi.y}; bf16x8 bfr; __builtin_memcpy(&bfr, &bw, 16);
                o[nt] = mfma16(a, bfr, o[nt]); }
            __builtin_amdgcn_sched_barrier(0);
        }
#pragma unroll
        for (int nt = 0; nt < 8; ++nt)
#pragma unroll
            for (int j = 0; j < 4; ++j) { const size_t rr = (size_t)(row0 + quad * 4 + j); const int cc = head * 128 + nt * 16 + l15; float ov = o[nt][j];
                if (Zp) ov *= siluf_(bf2f(Zp[rr * ldz + cc]));
                YM[rr * ldy + cc] = f2bf(ov); }
    }
}

__device__ __forceinline__ void mlstm_item(const P& p, const Ctx& c, int seg, int w, bool save) {
    const int b = w / 24, h = (w / 6) & 3, sl = w % 6;
    const bf16_t* Qb = (const bf16_t*)(c.seg + S0_Q); const bf16_t* Kb = (const bf16_t*)(c.seg + S0_K); const bf16_t* KT = (const bf16_t*)(c.seg + S0_KT); const bf16_t* VT = (const bf16_t*)(c.seg + S0_VT);
    const float* IPRE = (const float*)(c.seg + S0_GATE); const float* LOGF = IPRE + 32 * SEGT;
    bf16_t* HR = (bf16_t*)(c.seg + S0_HRAW);
    float* CST = (float*)(p.ws + OFF_CST) + (size_t)w * 64 * 384; float* NST = (float*)(p.ws + OFF_NST) + (size_t)w * 384;
    LAS bf16_t* Cimg = (LAS bf16_t*)c.lds;
    LAS bf16_t* Qs = Cimg + 64 * 392;
    LAS bf16_t* Ks = Qs + 64 * 136;
    LAS bf16_t* KTs = Ks + 64 * 136;
    LAS bf16_t* VTs = KTs + 128 * 72;
    LAS bf16_t* VWs = VTs + 64 * 72;
    LAS bf16_t* Sp = VWs + 64 * 72;
    LAS float* fl = (LAS float*)(Sp + 64 * 72);
    LAS float* bcum = fl; LAS float* ipr = fl + 64; LAS float* wgt = fl + 128; LAS float* gin = fl + 192; LAS float* qn = fl + 256; LAS float* rden = fl + 320;
    LAS float* gtotp = fl + 384; LAS float* nold = fl + 400; LAS float* nnew = fl + 800;
    const int l15c = c.lane & 15, quadc = c.lane >> 4, e16 = c.wv & 3, par = c.wv >> 2;
    f32x4 C[12];
    __syncthreads();
    if (seg > 0) {
#pragma unroll
        for (int j = 0; j < 12; ++j)
#pragma unroll
            for (int jj = 0; jj < 4; ++jj) C[j][jj] = CST[(size_t)(e16 * 16 + quadc * 4 + jj) * 384 + (2 * j + par) * 16 + l15c];
        if (c.tid < 384) nold[c.tid] = NST[c.tid];
    } else {
#pragma unroll
        for (int j = 0; j < 12; ++j) C[j] = (f32x4){0.f, 0.f, 0.f, 0.f};
        if (c.tid < 384) nold[c.tid] = 0.f;
    }
    u32x4 pq[2], pk[2], pt[2], pvt; float plf = 0.f, pip = 0.f;
    auto gl_piece = [&](int ch, int pp, int tidv) {
#pragma unroll
        for (int r = 0; r < 2; ++r) { const int id = tidv + 512 * r;
            { const int i = id >> 4, c8 = (id & 15) * 8; const size_t go = ((size_t)b * SEGT + ch * 64 + i) * DMIX + h * 384 + pp * 128 + c8; pq[r] = *(const u32x4*)(Qb + go); pk[r] = *(const u32x4*)(Kb + go); }
            { const int dd = id >> 3, c8 = (id & 7) * 8; pt[r] = *(const u32x4*)(KT + ((size_t)(b * 4 + h) * 384 + pp * 128 + dd) * SEGT + ch * 64 + c8); } } };
    auto gl_chunk = [&](int ch, int tidv) { const int i = tidv >> 3, c8 = (tidv & 7) * 8;
        pvt = *(const u32x4*)(VT + ((size_t)(b * 4 + h) * 384 + sl * 64 + i) * SEGT + ch * 64 + c8);
        if (c.wv == 0) { plf = LOGF[(b * 4 + h) * SEGT + ch * 64 + c.lane]; pip = IPRE[(b * 4 + h) * SEGT + ch * 64 + c.lane]; } };
    { int t0 = c.tid; asm volatile("" : "+v"(t0)); gl_chunk(0, t0); gl_piece(0, 0, t0); }
#pragma unroll 1
    for (int ch = 0; ch < 8; ++ch) {
        const int tl0 = ch * 64; const size_t row0 = (size_t)b * SEGT + tl0;
        int tidv = c.tid, l15 = l15c, quad = quadc;
        asm volatile("" : "+v"(tidv), "+v"(l15), "+v"(quad));
        lds_barrier();
        if (c.wv == 0) {
            float bc = plf;
#pragma unroll
            for (int o = 1; o < 64; o <<= 1) { const float t = __shfl_up(bc, o); if (c.lane >= o) bc += t; }
            const float bl = __shfl(bc, 63);
            bcum[c.lane] = bc; ipr[c.lane] = pip; wgt[c.lane] = __expf(bl - bc + pip); gin[c.lane] = __expf(bc);
            if (c.lane == 0) gtotp[0] = __expf(bl);
        }
#pragma unroll
        for (int j = 0; j < 12; ++j)
#pragma unroll
            for (int jj = 0; jj < 4; ++jj) Cimg[(e16 * 16 + quad * 4 + jj) * 392 + (2 * j + par) * 16 + l15] = f2bf(C[j][jj]);
        lds_barrier();
        { const int i = tidv >> 3, c8 = (tidv & 7) * 8;
          const u32x4 raw = pvt;
          *(LAS u32x4*)(VTs + i * 72 + c8) = raw;
          const f32x4 w0 = *(const LAS f32x4*)(wgt + c8), w1 = *(const LAS f32x4*)(wgt + c8 + 4);
          u32x4 sw; sw.x = pk2(bflo(raw.x) * w0[0], bfhi(raw.x) * w0[1]); sw.y = pk2(bflo(raw.y) * w0[2], bfhi(raw.y) * w0[3]);
          sw.z = pk2(bflo(raw.z) * w1[0], bfhi(raw.z) * w1[1]); sw.w = pk2(bflo(raw.w) * w1[2], bfhi(raw.w) * w1[3]);
          *(LAS u32x4*)(VWs + i * 72 + c8) = sw; }
        if (ch + 1 < 8) gl_chunk(ch + 1, tidv);
        const float gtot = gtotp[0];
#pragma unroll
        for (int j = 0; j < 12; ++j) C[j] *= gtot;
        f32x4 Sa[2], Ia[2]; Sa[0] = Sa[1] = Ia[0] = Ia[1] = (f32x4){0.f, 0.f, 0.f, 0.f};
        float qnacc = 0.f;
#pragma unroll
        for (int pp = 0; pp < 3; ++pp) {
            const int d0 = pp * 128;
            __builtin_amdgcn_sched_barrier(0);
            asm volatile("" : "+v"(tidv));
            lds_barrier();
#pragma unroll
            for (int r = 0; r < 2; ++r) { const int id = tidv + 512 * r;
                { const int i = id >> 4, c8 = (id & 15) * 8; *(LAS u32x4*)(Qs + i * 136 + c8) = pq[r]; *(LAS u32x4*)(Ks + i * 136 + c8) = pk[r]; }
                { const int dd = id >> 3, c8 = (id & 7) * 8; *(LAS u32x4*)(KTs + dd * 72 + c8) = pt[r]; } }
            lds_barrier();
            if (pp < 2) gl_piece(ch, pp + 1, tidv); else if (ch + 1 < 8) gl_piece(ch + 1, 0, tidv);
            { const int tm = c.wv >> 1, tn0 = (c.wv & 1) * 2;
#pragma unroll
              for (int kk = 0; kk < 4; ++kk) { const bf16x8 a = *(const LAS bf16x8*)(Qs + (tm * 16 + l15) * 136 + kk * 32 + quad * 8);
#pragma unroll
                  for (int x = 0; x < 2; ++x) { const int tn = tn0 + x;
                      const bf16x8 bk = *(const LAS bf16x8*)(Ks + (tn * 16 + l15) * 136 + kk * 32 + quad * 8);
                      const bf16x8 bc = *(const LAS bf16x8*)(Cimg + (tn * 16 + l15) * 392 + d0 + kk * 32 + quad * 8);
                      Sa[x] = mfma16(a, bk, Sa[x]); Ia[x] = mfma16(a, bc, Ia[x]); } } }
            { const bf16x8 va0 = *(const LAS bf16x8*)(VWs + (e16 * 16 + l15) * 72 + quad * 8), va1 = *(const LAS bf16x8*)(VWs + (e16 * 16 + l15) * 72 + 32 + quad * 8);
#pragma unroll
              for (int jl = 0; jl < 4; ++jl) { const int ntl = 2 * jl + par, j = pp * 4 + jl;
                  C[j] = mfma16(va0, *(const LAS bf16x8*)(KTs + (ntl * 16 + l15) * 72 + quad * 8), C[j]);
                  C[j] = mfma16(va1, *(const LAS bf16x8*)(KTs + (ntl * 16 + l15) * 72 + 32 + quad * 8), C[j]); } }
            { const int t = tidv >> 3, part = tidv & 7;
              const u32x4 q0 = *(const LAS u32x4*)(Qs + t * 136 + part * 16), q1 = *(const LAS u32x4*)(Qs + t * 136 + part * 16 + 8);
              const LAS float* np = nold + d0 + part * 16; const f32x4 n0 = *(const LAS f32x4*)np, n1 = *(const LAS f32x4*)(np + 4), n2 = *(const LAS f32x4*)(np + 8), n3 = *(const LAS f32x4*)(np + 12);
              qnacc += bflo(q0.x) * n0[0] + bfhi(q0.x) * n0[1] + bflo(q0.y) * n0[2] + bfhi(q0.y) * n0[3] + bflo(q0.z) * n1[0] + bfhi(q0.z) * n1[1] + bflo(q0.w) * n1[2] + bfhi(q0.w) * n1[3]
                     + bflo(q1.x) * n2[0] + bfhi(q1.x) * n2[1] + bflo(q1.y) * n2[2] + bfhi(q1.y) * n2[3] + bflo(q1.z) * n3[0] + bfhi(q1.z) * n3[1] + bflo(q1.w) * n3[2] + bfhi(q1.w) * n3[3]; }
            { const int dd = tidv >> 2, part = tidv & 3;
              const u32x4 k0 = *(const LAS u32x4*)(KTs + dd * 72 + part * 16), k1 = *(const LAS u32x4*)(KTs + dd * 72 + part * 16 + 8);
              const LAS float* wp = wgt + part * 16; const f32x4 w0 = *(const LAS f32x4*)wp, w1 = *(const LAS f32x4*)(wp + 4), w2 = *(const LAS f32x4*)(wp + 8), w3 = *(const LAS f32x4*)(wp + 12);
              float a = bflo(k0.x) * w0[0] + bfhi(k0.x) * w0[1] + bflo(k0.y) * w0[2] + bfhi(k0.y) * w0[3] + bflo(k0.z) * w1[0] + bfhi(k0.z) * w1[1] + bflo(k0.w) * w1[2] + bfhi(k0.w) * w1[3]
                      + bflo(k1.x) * w2[0] + bfhi(k1.x) * w2[1] + bflo(k1.y) * w2[2] + bfhi(k1.y) * w2[3] + bflo(k1.z) * w3[0] + bfhi(k1.z) * w3[1] + bflo(k1.w) * w3[2] + bfhi(k1.w) * w3[3];
              a = dpp_add<0xB1>(a); a = dpp_add<0x4E>(a);
              if (part == 0) nnew[d0 + dd] = gtot * nold[d0 + dd] + a; }
        }
        qnacc = dpp_add<0xB1>(qnacc); qnacc = dpp_add<0x4E>(qnacc); qnacc = dpp_add<0x141>(qnacc);
        if ((tidv & 7) == 0) qn[tidv >> 3] = qnacc;
#pragma unroll
        for (int x = 0; x < 2; ++x) { const int ti = c.wv * 2 + x, tm = ti >> 2, tn = ti & 3; const int s = tn * 16 + l15; const float bs = bcum[s] - ipr[s];
#pragma unroll
            for (int jj = 0; jj < 4; ++jj) { const int t = tm * 16 + quad * 4 + jj; const float v = (s <= t) ? Sa[x][jj] * __expf(bcum[t] - bs) : 0.f; Sp[t * 72 + s] = f2bf(v); } }
        lds_barrier();
        { const int t = tidv >> 3, part = tidv & 7; const u32x4 sr = *(const LAS u32x4*)(Sp + t * 72 + part * 8);
          float ds = bflo(sr.x) + bfhi(sr.x) + bflo(sr.y) + bfhi(sr.y) + bflo(sr.z) + bfhi(sr.z) + bflo(sr.w) + bfhi(sr.w);
          ds = dpp_add<0xB1>(ds); ds = dpp_add<0x4E>(ds); ds = dpp_add<0x141>(ds);
          if (part == 0) { const float den = ds + gin[t] * qn[t]; rden[t] = frcp(fmaxf(fabsf(den), 1.0f)); } }
#pragma unroll
        for (int x = 0; x < 2; ++x) { const int ti = c.wv * 2 + x, tm = ti >> 2, tn = ti & 3;
#pragma unroll
            for (int jj = 0; jj < 4; ++jj) Ia[x][jj] *= gin[tm * 16 + quad * 4 + jj];
#pragma unroll
            for (int kk = 0; kk < 2; ++kk) { const bf16x8 a = *(const LAS bf16x8*)(Sp + (tm * 16 + l15) * 72 + kk * 32 + quad * 8);
                const bf16x8 bb = *(const LAS bf16x8*)(VTs + (tn * 16 + l15) * 72 + kk * 32 + quad * 8); Ia[x] = mfma16(a, bb, Ia[x]); } }
        lds_barrier();
#pragma unroll
        for (int x = 0; x < 2; ++x) { const int ti = c.wv * 2 + x, tm = ti >> 2, tn = ti & 3;
#pragma unroll
            for (int jj = 0; jj < 4; ++jj) { const int t = tm * 16 + quad * 4 + jj; HR[(row0 + t) * DMIX + h * 384 + sl * 64 + tn * 16 + l15] = f2bf(Ia[x][jj] * rden[t]); } }
        if (c.tid < 384) nold[c.tid] = nnew[c.tid];
    }
    lds_barrier();
    if (!save) return;
#pragma unroll
    for (int j = 0; j < 12; ++j)
#pragma unroll
        for (int jj = 0; jj < 4; ++jj) CST[(size_t)(e16 * 16 + quadc * 4 + jj) * 384 + (2 * j + par) * 16 + l15c] = C[j][jj];
    if (c.tid < 384) NST[c.tid] = nold[c.tid];
}

__device__ __forceinline__ void phase_a3(const P& p, const Ctx& c, int seg) {
    const bf16_t* P0 = (const bf16_t*)(c.seg + S0_P0); const bf16_t* HR = (const bf16_t*)(c.seg + S0_HRAW); const bf16_t* XC = (const bf16_t*)(c.seg + S0_XC);
    const bf16_t* YM = (const bf16_t*)(c.seg + S0_YMEM); bf16_t* Y = (bf16_t*)(c.seg + S0_Y); bf16_t* UT = (bf16_t*)(p.ws + OFF_UTAIL);
#pragma unroll 1
    for (int r = c.bid * 8 + c.wv; r < MS; r += c.G * 8) {
        const int b = r >> 9, tl = r & 511;
        float v[3][8]; float mean[3], rstd[3];
#pragma unroll
        for (int ps = 0; ps < 3; ++ps) { const int ch = ps * 512 + c.lane * 8;
            const u32x4 hr = *(const u32x4*)(HR + (size_t)r * DMIX + ch);
            v[ps][0] = bflo(hr.x); v[ps][1] = bfhi(hr.x); v[ps][2] = bflo(hr.y); v[ps][3] = bfhi(hr.y); v[ps][4] = bflo(hr.z); v[ps][5] = bfhi(hr.z); v[ps][6] = bflo(hr.w); v[ps][7] = bfhi(hr.w); }
        float hs[4], hq[4];
#pragma unroll
        for (int hd = 0; hd < 4; ++hd) { float s = 0.f, q = 0.f;
#pragma unroll
            for (int ps = 0; ps < 3; ++ps) { if (ps * 512 + 511 < hd * 384 || ps * 512 >= (hd + 1) * 384) continue;
                const bool mine = ((ps * 512 + c.lane * 8) / 384) == hd;
                float ls = 0.f, lq = 0.f;
#pragma unroll
                for (int j = 0; j < 8; ++j) { ls += v[ps][j]; lq += v[ps][j] * v[ps][j]; }
                s += mine ? ls : 0.f; q += mine ? lq : 0.f; }
            hs[hd] = wsum(s); hq[hd] = wsum(q); }
#pragma unroll
        for (int ps = 0; ps < 3; ++ps) { const int hd = (ps * 512 + c.lane * 8) / 384;
            const float s = hd == 0 ? hs[0] : (hd == 1 ? hs[1] : (hd == 2 ? hs[2] : hs[3])), q = hd == 0 ? hq[0] : (hd == 1 ? hq[1] : (hd == 2 ? hq[2] : hq[3]));
            const float m = s * (1.0f / 384.0f); mean[ps] = m; rstd[ps] = rsqrtf(fmaxf(q * (1.0f / 384.0f) - m * m, 0.f) + 1e-5f); }
#pragma unroll
        for (int ps = 0; ps < 3; ++ps) { const int ch = ps * 512 + c.lane * 8;
            const u32x4 xr = *(const u32x4*)(XC + (size_t)r * DMIX + ch), zr = *(const u32x4*)(P0 + (size_t)r * ML_W + 2048 + ch);
            const f32x4 g0 = *(const f32x4*)(p.ml_mhn_g + ch), g1 = *(const f32x4*)(p.ml_mhn_g + ch + 4), k0 = *(const f32x4*)(p.ml_skip + ch), k1 = *(const f32x4*)(p.ml_skip + ch + 4);
            const float xx[8] = {bflo(xr.x), bfhi(xr.x), bflo(xr.y), bfhi(xr.y), bflo(xr.z), bfhi(xr.z), bflo(xr.w), bfhi(xr.w)};
            const float zz[8] = {bflo(zr.x), bfhi(zr.x), bflo(zr.y), bfhi(zr.y), bflo(zr.z), bfhi(zr.z), bflo(zr.w), bfhi(zr.w)};
            const float gg[8] = {g0[0], g0[1], g0[2], g0[3], g1[0], g1[1], g1[2], g1[3]}, kk[8] = {k0[0], k0[1], k0[2], k0[3], k1[0], k1[1], k1[2], k1[3]};
            float y[8];
#pragma unroll
            for (int j = 0; j < 8; ++j) y[j] = ((v[ps][j] - mean[ps]) * rstd[ps] * gg[j] + kk[j] * xx[j]) * siluf_(zz[j]);
            *(u32x4*)(Y + (size_t)r * DIN + ch) = (u32x4){pk2(y[0], y[1]), pk2(y[2], y[3]), pk2(y[4], y[5]), pk2(y[6], y[7])}; }
        { const int cm = c.lane * 8; const u32x4 mr = *(const u32x4*)(YM + (size_t)r * DX + cm), zr = *(const u32x4*)(P0 + (size_t)r * ML_W + 2048 + DMIX + cm);
          const float mm[8] = {bflo(mr.x), bfhi(mr.x), bflo(mr.y), bfhi(mr.y), bflo(mr.z), bfhi(mr.z), bflo(mr.w), bfhi(mr.w)};
          const float zz[8] = {bflo(zr.x), bfhi(zr.x), bflo(zr.y), bfhi(zr.y), bflo(zr.z), bfhi(zr.z), bflo(zr.w), bfhi(zr.w)};
          float y[8];
#pragma unroll
          for (int j = 0; j < 8; ++j) y[j] = mm[j] * siluf_(zz[j]);
          *(u32x4*)(Y + (size_t)r * DIN + DMIX + cm) = (u32x4){pk2(y[0], y[1]), pk2(y[2], y[3]), pk2(y[4], y[5]), pk2(y[6], y[7])}; }
        if (tl >= 509) {
#pragma unroll
            for (int ps = 0; ps < 3; ++ps) { const int ch = ps * 512 + c.lane * 8; *(u32x4*)(UT + (size_t)(b * 3 + tl - 509) * DMIX + ch) = *(const u32x4*)(P0 + (size_t)r * ML_W + ch); } }
    }
}

__device__ __forceinline__ void phase_b1(const P& p, const Ctx& c, int seg) {
    const bf16_t* P1 = (const bf16_t*)(c.seg + S1_P1);
    float* GTB = (float*)(c.seg + S1_W); bf16_t* SA = (bf16_t*)(c.seg + S1_A); bf16_t* SB = (bf16_t*)(c.seg + S1_B); bf16_t* SK = (bf16_t*)(c.seg + S1_K);
    bf16_t* SQ = (bf16_t*)(c.seg + S1_Q); bf16_t* SV = (bf16_t*)(c.seg + S1_V); bf16_t* SG = (bf16_t*)(c.seg + S1_G); float* BRKR = (float*)(c.seg + S1_BRKR);
    const bf16_t* VF = (const bf16_t*)(p.ws + OFF_VF); const bf16_t* LT = (const bf16_t*)(p.ws + OFF_LORAT);
    const bf16_t* PTr = (const bf16_t*)(p.ws + OFF_PTAIL) + (size_t)(seg & 1) * NB * RW_SHIFT; bf16_t* PTw = (bf16_t*)(p.ws + OFF_PTAIL) + (size_t)((seg + 1) & 1) * NB * RW_SHIFT;
    LAS bf16_t* XA = (LAS bf16_t*)c.lds;
    const int l15 = c.lane & 15, quad = c.lane >> 4;
    for (int it = c.bid; it < MS / 16; it += c.G) {
        const int r0 = it * 16, b = r0 >> 9, tl0 = r0 & 511;
        __syncthreads();
        for (int e = c.tid; e < 16 * 288; e += 512) { const int row = e / 288, cc = e % 288, col = 4608 + cc;
            const float cur = bf2f(P1[(size_t)(r0 + row) * P1W + col]);
            float prev = 0.f; if (tl0 + row > 0) prev = bf2f(P1[(size_t)(r0 + row - 1) * P1W + col]); else if (seg > 0) prev = bf2f(PTr[(size_t)b * RW_SHIFT + col]);
            const float pv = cur + p.rw_mu[col] * (prev - cur);
            const float f = cc < 64 ? (1.0f - 2.0f / (1.0f + __expf(2.0f * pv)))   : (cc < 160 ? pv : sigmoidf_(pv));
            XA[row * 296 + cc] = f2bf(f); }
        __syncthreads();
        const size_t row = (size_t)r0 + l15; const int tl = tl0 + l15;
        const bf16_t* curp = P1 + row * P1W; const bf16_t* prevp = (tl > 0) ? (P1 + (row - 1) * P1W) : (PTr + (size_t)b * RW_SHIFT); const bool hasprev = (tl > 0) || (seg > 0);
        struct TileIn { u32x4 cr, ck, cv, pr, pk, pv, vf; };
        struct TilePar { f32x4 m0, m1, m2, w0, a0, v0, kkw, kaw, rk; };
#pragma unroll 1
        for (int x = 0; x < 3; ++x) {
            int hh = c.wv * 3 + x; asm volatile("" : "+s"(hh));
            auto load_tile = [&](int ct, TileIn& T) { const int cc = hh * 64 + (ct >> 1) * 32 + quad * 8;
                T.cr = *(const u32x4*)(curp + cc); T.ck = *(const u32x4*)(curp + DMIX + cc); T.cv = *(const u32x4*)(curp + 2 * DMIX + cc);
                T.pr = (u32x4){0u, 0u, 0u, 0u}; T.pk = T.pr; T.pv = T.pr;
                if (hasprev) { T.pr = *(const u32x4*)(prevp + cc); T.pk = *(const u32x4*)(prevp + DMIX + cc); T.pv = *(const u32x4*)(prevp + 2 * DMIX + cc); }
                T.vf = *(const u32x4*)(VF + row * DMIX + cc); };
            TileIn TA;
            load_tile(0, TA);
            float inv;
            { u32x2 kcur[4], kprv[4]; f32x4 km[4], kw[4];
#pragma unroll
              for (int ct = 0; ct < 4; ++ct) { const int cc = hh * 64 + (ct >> 1) * 32 + quad * 8 + 4 * (ct & 1);
                  kcur[ct] = *(const u32x2*)(curp + DMIX + cc); kprv[ct] = (u32x2){0u, 0u}; if (hasprev) kprv[ct] = *(const u32x2*)(prevp + DMIX + cc);
                  km[ct] = *(const f32x4*)(p.rw_mu + DMIX + cc); kw[ct] = *(const f32x4*)(p.rw_k_k + cc); }
              float ss = 0.f;
#pragma unroll
              for (int ct = 0; ct < 4; ++ct) {
                  const float cb[4] = {bflo(kcur[ct].x), bfhi(kcur[ct].x), bflo(kcur[ct].y), bfhi(kcur[ct].y)}, qb[4] = {bflo(kprv[ct].x), bfhi(kprv[ct].x), bflo(kprv[ct].y), bfhi(kprv[ct].y)};
#pragma unroll
                  for (int j = 0; j < 4; ++j) { const float kr = (cb[j] + km[ct][j] * (qb[j] - cb[j])) * kw[ct][j]; ss += kr * kr; } }
              ss += __shfl_xor(ss, 16); ss += __shfl_xor(ss, 32);
              inv = frcp(fmaxf(sqrtf(ss), 1e-12f)); }
            float br = 0.f, kr = 0.f, rkr = 0.f;
            u32x2 st_g, st_a, st_b, st_k, st_q, st_v;
            auto do_tile = [&](int ct, const TileIn& TI) { const int cc = hh * 64 + (ct >> 1) * 32 + quad * 8 + 4 * (ct & 1);
                TilePar T; T.m0 = *(const f32x4*)(p.rw_mu + cc); T.m1 = *(const f32x4*)(p.rw_mu + DMIX + cc); T.m2 = *(const f32x4*)(p.rw_mu + 2 * DMIX + cc);
                T.w0 = *(const f32x4*)(p.rw_w0 + cc); T.a0 = *(const f32x4*)(p.rw_a0 + cc); T.v0 = *(const f32x4*)(p.rw_v0 + cc); T.kkw = *(const f32x4*)(p.rw_k_k + cc); T.kaw = *(const f32x4*)(p.rw_k_a + cc);
                T.rk = *(const f32x4*)(p.rw_r_k + cc);
                bf16x8 lt[9]; { const bf16_t* lrow = LT + (size_t)(hh * 64 + (ct >> 1) * 32 + 8 * (l15 >> 2) + 4 * (ct & 1) + (l15 & 3)) * 288 + quad * 8;
#pragma unroll
                    for (int k = 0; k < 9; ++k) lt[k] = *(const bf16x8*)(lrow + k * 32); }
                bf16x8 xf[9];
#pragma unroll
                for (int k = 0; k < 9; ++k) xf[k] = *(const LAS bf16x8*)(XA + l15 * 296 + k * 32 + quad * 8);
                f32x4 dw = (f32x4){0.f, 0.f, 0.f, 0.f}, da = dw, dv = dw, dg = dw;
#pragma unroll
                for (int k = 0; k < 2; ++k) dw = mfma16(lt[k], xf[k], dw);
#pragma unroll
                for (int k = 0; k < 2; ++k) da = mfma16(lt[2 + k], xf[2 + k], da);
                dv = mfma16(lt[4], xf[4], dv);
#pragma unroll
                for (int k = 0; k < 4; ++k) dg = mfma16(lt[5 + k], xf[5 + k], dg);
                const bool od = (ct & 1) != 0;
                const unsigned r0 = od ? TI.cr.z : TI.cr.x, r1 = od ? TI.cr.w : TI.cr.y, k0 = od ? TI.ck.z : TI.ck.x, k1 = od ? TI.ck.w : TI.ck.y, c0 = od ? TI.cv.z : TI.cv.x, c1 = od ? TI.cv.w : TI.cv.y;
                const unsigned p0 = od ? TI.pr.z : TI.pr.x, p1 = od ? TI.pr.w : TI.pr.y, q0 = od ? TI.pk.z : TI.pk.x, q1 = od ? TI.pk.w : TI.pk.y, d0 = od ? TI.pv.z : TI.pv.x, d1 = od ? TI.pv.w : TI.pv.y;
                const unsigned f0 = od ? TI.vf.z : TI.vf.x, f1 = od ? TI.vf.w : TI.vf.y;
                const float ca[4] = {bflo(r0), bfhi(r0), bflo(r1), bfhi(r1)}, cb[4] = {bflo(k0), bfhi(k0), bflo(k1), bfhi(k1)}, cd[4] = {bflo(c0), bfhi(c0), bflo(c1), bfhi(c1)};
                const float qa[4] = {bflo(p0), bfhi(p0), bflo(p1), bfhi(p1)}, qb[4] = {bflo(q0), bfhi(q0), bflo(q1), bfhi(q1)}, qd[4] = {bflo(d0), bfhi(d0), bflo(d1), bfhi(d1)};
                const float vf[4] = {bflo(f0), bfhi(f0), bflo(f1), bfhi(f1)};
                u32x2 gw; gw.x = pk2(dg[0], dg[1]); gw.y = pk2(dg[2], dg[3]);
                float wv4[4], av[4], bv[4], ktv[4], qv[4], vv[4];
#pragma unroll
                for (int j = 0; j < 4; ++j) {
                    const float rc = ca[j] + T.m0[j] * (qa[j] - ca[j]), kc = cb[j] + T.m1[j] * (qb[j] - cb[j]), vc = cd[j] + T.m2[j] * (qd[j] - cd[j]);
                    const float zz = -(T.w0[j] + dw[j]); const float sp = fmaxf(zz, 0.f) + __logf(1.0f + __expf(-fabsf(zz)));
                    wv4[j] = __expf(-__expf(-sp - 0.5f));
                    const float a = sigmoidf_(T.a0[j] + da[j]);
                    vv[j] = vc + (vf[j] - vc) * sigmoidf_(T.v0[j] + dv[j]);
                    const float kk = kc * T.kkw[j] * inv; av[j] = -kk; bv[j] = kk * a;
                    ktv[j] = kc * (1.0f + (a - 1.0f) * T.kaw[j]); qv[j] = rc;
                    br += bv[j] * rc; kr += ktv[j] * rc; rkr += rc * ktv[j] * T.rk[j]; }
                float gfin[4];
#pragma unroll
                for (int j = 0; j < 4; ++j) { float g = wv4[j];
                    g *= dpp_shr_or1<1>(g); g *= dpp_shr_or1<2>(g); g *= dpp_shr_or1<4>(g); g *= dpp_shr_or1<8>(g);
                    const float gp = dpp_shr_or1<1>(g), ig = frcp(g);
                    av[j] *= gp; qv[j] *= g; bv[j] *= ig; ktv[j] *= ig; gfin[j] = g; }
                if (l15 == 15) *(f32x4*)(GTB + ((size_t)it * 24 + hh) * 64 + (cc - hh * 64)) = (f32x4){gfin[0], gfin[1], gfin[2], gfin[3]};
                const u32x2 ta = (u32x2){pk2(av[0], av[1]), pk2(av[2], av[3])}, tb = (u32x2){pk2(bv[0], bv[1]), pk2(bv[2], bv[3])}, tk = (u32x2){pk2(ktv[0], ktv[1]), pk2(ktv[2], ktv[3])};
                const u32x2 tq = (u32x2){pk2(qv[0], qv[1]), pk2(qv[2], qv[3])}, tv = (u32x2){pk2(vv[0], vv[1]), pk2(vv[2], vv[3])};
                if ((ct & 1) == 0) { st_g = gw; st_a = ta; st_b = tb; st_k = tk; st_q = tq; st_v = tv; }
                else { const size_t o8 = row * DMIX + cc - 4;
                    *(u32x4*)(SG + o8) = (u32x4){st_g.x, st_g.y, gw.x, gw.y}; *(u32x4*)(SA + o8) = (u32x4){st_a.x, st_a.y, ta.x, ta.y}; *(u32x4*)(SB + o8) = (u32x4){st_b.x, st_b.y, tb.x, tb.y};
                    *(u32x4*)(SK + o8) = (u32x4){st_k.x, st_k.y, tk.x, tk.y}; *(u32x4*)(SQ + o8) = (u32x4){st_q.x, st_q.y, tq.x, tq.y}; *(u32x4*)(SV + o8) = (u32x4){st_v.x, st_v.y, tv.x, tv.y}; } };
            do_tile(0, TA); __builtin_amdgcn_sched_barrier(0);
            do_tile(1, TA); __builtin_amdgcn_sched_barrier(0);
            load_tile(2, TA); do_tile(2, TA); __builtin_amdgcn_sched_barrier(0);
            do_tile(3, TA);
            br += __shfl_xor(br, 16); br += __shfl_xor(br, 32); kr += __shfl_xor(kr, 16); kr += __shfl_xor(kr, 32); rkr += __shfl_xor(rkr, 16); rkr += __shfl_xor(rkr, 32);
            if (quad == 0) *(f32x4*)(BRKR + (row * 24 + hh) * 4) = (f32x4){br, kr, rkr, 0.f};
        }
        if (tl0 == 496) { for (int e = c.tid; e < RW_SHIFT; e += 512) PTw[(size_t)b * RW_SHIFT + e] = P1[(size_t)(r0 + 15) * P1W + e]; }
    }
}

__device__ __forceinline__ void rwkv_item(const P& p, const Ctx& c, int seg, int w, bool save) {
    const int b = w / 24, hh = w % 24;
    const float* SW = (const float*)(c.seg + S1_W); const bf16_t* SA = (const bf16_t*)(c.seg + S1_A); const bf16_t* SB = (const bf16_t*)(c.seg + S1_B); const bf16_t* SK = (const bf16_t*)(c.seg + S1_K);
    const bf16_t* SQ = (const bf16_t*)(c.seg + S1_Q); const bf16_t* SV = (const bf16_t*)(c.seg + S1_V); const float* BRKR = (const float*)(c.seg + S1_BRKR);
    float* O = (float*)(c.seg + S1_O); float* RST = (float*)(p.ws + OFF_RST) + (size_t)w * 4096;
    constexpr int TB = 32, REC = 388;
    LAS float* L0 = (LAS float*)c.lds;
    const int rp = c.wv * 4 + (c.lane >> 4), cq = c.lane & 15;
    f32x2 S0a, S0b, S1a, S1b;
    if (seg > 0) { const f32x4 s0 = *(const f32x4*)(RST + (2 * rp) * 64 + cq * 4), s1 = *(const f32x4*)(RST + (2 * rp + 1) * 64 + cq * 4);
        S0a = (f32x2){s0[0], s0[1]}; S0b = (f32x2){s0[2], s0[3]}; S1a = (f32x2){s1[0], s1[1]}; S1b = (f32x2){s1[2], s1[3]}; }
    else { S0a = S0b = S1a = S1b = (f32x2){0.f, 0.f}; }
    const int e4 = c.tid * 4, stt = e4 >> 6, scc = e4 & 63;
    f32x4 gw; u32x2 ga, gb, gk, gq, gv; f32x4 gbr;
    auto gload = [&](int blk) { const size_t go = ((size_t)b * SEGT + blk * TB + stt) * DMIX + hh * 64 + scc;
        gw = *(const f32x4*)(SW + go); ga = *(const u32x2*)(SA + go); gb = *(const u32x2*)(SB + go); gk = *(const u32x2*)(SK + go); gq = *(const u32x2*)(SQ + go); gv = *(const u32x2*)(SV + go);
        if (c.tid < TB) gbr = *(const f32x4*)(BRKR + (((size_t)b * SEGT + blk * TB + c.tid) * 24 + hh) * 4); };
    auto lstore = [&](int buf) { LAS float* r = L0 + buf * (TB * REC) + stt * REC + scc;
        *(LAS f32x4*)(r) = gw; *(LAS f32x4*)(r + 64) = (f32x4){bflo(ga.x), bfhi(ga.x), bflo(ga.y), bfhi(ga.y)}; *(LAS f32x4*)(r + 128) = (f32x4){bflo(gb.x), bfhi(gb.x), bflo(gb.y), bfhi(gb.y)};
        *(LAS f32x4*)(r + 192) = (f32x4){bflo(gk.x), bfhi(gk.x), bflo(gk.y), bfhi(gk.y)}; *(LAS f32x4*)(r + 256) = (f32x4){bflo(gq.x), bfhi(gq.x), bflo(gq.y), bfhi(gq.y)};
        *(LAS f32x4*)(r + 320) = (f32x4){bflo(gv.x), bfhi(gv.x), bflo(gv.y), bfhi(gv.y)};
        if (c.tid < TB) { LAS float* q = L0 + buf * (TB * REC) + c.tid * REC + 384; *(LAS f32x2*)q = (f32x2){gbr[0], gbr[1]}; } };
    __syncthreads();
    gload(0); lstore(0);
    __syncthreads();
#pragma unroll 1
    for (int blk = 0; blk < SEGT / TB; ++blk) {
        const int buf = blk & 1;
        if (blk + 1 < SEGT / TB) gload(blk + 1);
        const LAS float* base = L0 + buf * (TB * REC);
        const size_t rowb = (size_t)b * SEGT + blk * TB;
        f32x4 nw4 = *(const LAS f32x4*)(base + cq * 4), na4 = *(const LAS f32x4*)(base + 64 + cq * 4), nb4 = *(const LAS f32x4*)(base + 128 + cq * 4), nk4 = *(const LAS f32x4*)(base + 192 + cq * 4), nq4 = *(const LAS f32x4*)(base + 256 + cq * 4);
        f32x2 nv2 = *(const LAS f32x2*)(base + 320 + 2 * rp), nbk = *(const LAS f32x2*)(base + 384);
#pragma unroll 2
        for (int tt = 0; tt < TB; ++tt) {
            const f32x4 w4 = nw4, a4 = na4, b4 = nb4, k4 = nk4, q4 = nq4; const f32x2 v2 = nv2, bk = nbk;
            { const LAS float* r = base + (tt + 1 < TB ? tt + 1 : tt) * REC;
              nw4 = *(const LAS f32x4*)(r + cq * 4); na4 = *(const LAS f32x4*)(r + 64 + cq * 4); nb4 = *(const LAS f32x4*)(r + 128 + cq * 4); nk4 = *(const LAS f32x4*)(r + 192 + cq * 4); nq4 = *(const LAS f32x4*)(r + 256 + cq * 4);
              nv2 = *(const LAS f32x2*)(r + 320 + 2 * rp); nbk = *(const LAS f32x2*)(r + 384); }
            const f32x2 wa = (f32x2){w4[0], w4[1]}, wb = (f32x2){w4[2], w4[3]}, aa = (f32x2){a4[0], a4[1]}, ab = (f32x2){a4[2], a4[3]}, ba = (f32x2){b4[0], b4[1]}, bb = (f32x2){b4[2], b4[3]};
            const f32x2 ka = (f32x2){k4[0], k4[1]}, kb = (f32x2){k4[2], k4[3]}, qa = (f32x2){q4[0], q4[1]}, qb = (f32x2){q4[2], q4[3]};
            f32x2 t0 = S0a * aa + S0b * ab, t1 = S0a * qa + S0b * qb, t2 = S1a * aa + S1b * ab, t3 = S1a * qa + S1b * qb;
            float pa0 = t0.x + t0.y, pt0 = t1.x + t1.y, pa1 = t2.x + t2.y, pt1 = t3.x + t3.y;
            row16_allsum4(pa0, pa1, pt0, pt1);
            const f32x2 pa0v = (f32x2){pa0, pa0}, pa1v = (f32x2){pa1, pa1}, v0v = (f32x2){v2.x, v2.x}, v1v = (f32x2){v2.y, v2.y};
            S0a = S0a * wa + pa0v * ba + v0v * ka; S0b = S0b * wb + pa0v * bb + v0v * kb;
            S1a = S1a * wa + pa1v * ba + v1v * ka; S1b = S1b * wb + pa1v * bb + v1v * kb;
            if (cq == 0) { const f32x2 y = (f32x2){pt0 + pa0 * bk.x + v2.x * bk.y, pt1 + pa1 * bk.x + v2.y * bk.y};
                *(f32x2*)(O + (rowb + tt) * DMIX + hh * 64 + 2 * rp) = y; }
        }
        if (blk + 1 < SEGT / TB) lstore(buf ^ 1);
        __syncthreads();
    }
    if (!save) return;
    *(f32x4*)(RST + (2 * rp) * 64 + cq * 4) = (f32x4){S0a.x, S0a.y, S0b.x, S0b.y}; *(f32x4*)(RST + (2 * rp + 1) * 64 + cq * 4) = (f32x4){S1a.x, S1a.y, S1b.x, S1b.y};
}

__device__ __forceinline__ void rwkv_chunk_item(const P& p, const Ctx& c, int seg, int w, bool save) {
    const int b = w / 24, hh = w % 24;
    const bf16_t* SA = (const bf16_t*)(c.seg + S1_A); const bf16_t* SB = (const bf16_t*)(c.seg + S1_B); const bf16_t* SK = (const bf16_t*)(c.seg + S1_K);
    const bf16_t* SR = (const bf16_t*)(c.seg + S1_Q); const bf16_t* SV = (const bf16_t*)(c.seg + S1_V); const float* GTB = (const float*)(c.seg + S1_W);
    bf16_t* Y = (bf16_t*)(c.seg + S1_Y); const bf16_t* SG = (const bf16_t*)(c.seg + S1_G); const bf16_t* P2 = (const bf16_t*)(c.seg + S1_P2); const float* BRKR = (const float*)(c.seg + S1_BRKR); float* RST = (float*)(p.ws + OFF_RST) + (size_t)w * 4096;
    constexpr int O_EA = 0  , O_EB = 4608  , O_EBT = 9216  , O_UV = 14336  ,
                  O_MT1 = 19456  , O_NT = 20736  , O_MABT = 22016  ,
                  O_GT = 23296  , OPB = 23552;
    LAS unsigned char* OB = c.lds;
    LAS bf16_t* S0I = (LAS bf16_t*)(c.lds + 2 * OPB);
    LAS float* XF = (LAS float*)(c.lds + 2 * OPB + 9216);
    LAS float* YB = (LAS float*)(c.lds + 2 * OPB + 9216 + 4352);
    const int l15c = c.lane & 15, quadc = c.lane >> 4;
    f32x4 S[2];
#pragma unroll
    for (int x = 0; x < 2; ++x) { const int ti = c.wv * 2 + x, mt = ti >> 2, nt = ti & 3;
#pragma unroll
        for (int jj = 0; jj < 4; ++jj) S[x][jj] = (seg > 0) ? RST[(mt * 16 + quadc * 4 + jj) * 64 + nt * 16 + l15c] : 0.f; }
    unsigned ga = 0, gb = 0, gk = 0, gr = 0, gv = 0; float gg = 1.f;
    auto gload = [&](int ch, int tidv) { const int t = tidv >> 5, j0 = (tidv & 31) * 2; const size_t go = ((size_t)b * SEGT + ch * 16 + t) * DMIX + hh * 64 + j0;
        ga = *(const unsigned*)(SA + go); gb = *(const unsigned*)(SB + go); gk = *(const unsigned*)(SK + go); gr = *(const unsigned*)(SR + go); gv = *(const unsigned*)(SV + go);
        if (tidv < 64) gg = GTB[((size_t)(b * 32 + ch) * 24 + hh) * 64 + tidv]; };
    auto lstore = [&](int pb, int tidv) { const int t = tidv >> 5, j0 = (tidv & 31) * 2;
        LAS bf16_t* EA = (LAS bf16_t*)(OB + pb * OPB + O_EA); LAS bf16_t* EB = (LAS bf16_t*)(OB + pb * OPB + O_EB); LAS bf16_t* EBT = (LAS bf16_t*)(OB + pb * OPB + O_EBT);
        LAS bf16_t* UV = (LAS bf16_t*)(OB + pb * OPB + O_UV); LAS float* GT = (LAS float*)(OB + pb * OPB + O_GT);
        *(LAS unsigned*)(EA + t * 72 + j0) = ga; *(LAS unsigned*)(EA + (16 + t) * 72 + j0) = gr;
        *(LAS unsigned*)(EB + t * 72 + j0) = gb; *(LAS unsigned*)(EB + (16 + t) * 72 + j0) = gk;
        EBT[j0 * 40 + t] = (bf16_t)(gb & 0xFFFFu); EBT[(j0 + 1) * 40 + t] = (bf16_t)(gb >> 16); EBT[j0 * 40 + 16 + t] = (bf16_t)(gk & 0xFFFFu); EBT[(j0 + 1) * 40 + 16 + t] = (bf16_t)(gk >> 16);
        UV[j0 * 40 + 16 + t] = (bf16_t)(gv & 0xFFFFu); UV[(j0 + 1) * 40 + 16 + t] = (bf16_t)(gv >> 16); UV[j0 * 40 + t] = 0; UV[(j0 + 1) * 40 + t] = 0;
        if (tidv < 64) GT[tidv] = gg; };
    auto gtile = [&](int pb, int l15, int quad) {
        LAS bf16_t* EA = (LAS bf16_t*)(OB + pb * OPB + O_EA); LAS bf16_t* EB = (LAS bf16_t*)(OB + pb * OPB + O_EB);
        LAS bf16_t* MT1 = (LAS bf16_t*)(OB + pb * OPB + O_MT1); LAS bf16_t* NT = (LAS bf16_t*)(OB + pb * OPB + O_NT); LAS float* MABT = (LAS float*)(OB + pb * OPB + O_MABT);
        const int sb = c.wv >> 1, tb = c.wv & 1; f32x4 g = (f32x4){0.f, 0.f, 0.f, 0.f};
#pragma unroll
        for (int kk = 0; kk < 2; ++kk) g = mfma16(*(const LAS bf16x8*)(EB + (sb * 16 + l15) * 72 + kk * 32 + quad * 8), *(const LAS bf16x8*)(EA + (tb * 16 + l15) * 72 + kk * 32 + quad * 8), g);
#pragma unroll
        for (int jj = 0; jj < 4; ++jj) { const int s2 = quad * 4 + jj, tt = l15; const float v = g[jj];
            if (tb == 0) { const float m = (s2 < tt) ? v : 0.f; if (sb == 0) { MABT[tt * 20 + s2] = m; MT1[tt * 40 + s2] = 0; } else MT1[tt * 40 + 16 + s2] = f2bf(m); }
            else { const float m = (s2 <= tt) ? v : 0.f; NT[tt * 40 + sb * 16 + s2] = f2bf(m); } } };
    auto simg = [&](int l15, int quad) {
#pragma unroll
        for (int x = 0; x < 2; ++x) { const int ti = c.wv * 2 + x, mt = ti >> 2, nt = ti & 3;
#pragma unroll
            for (int jj = 0; jj < 4; ++jj) S0I[(mt * 16 + quad * 4 + jj) * 72 + nt * 16 + l15] = f2bf(S[x][jj]); } };
    const int et = (c.tid >> 4) & 15, eg = c.tid & 15; const int ech = hh * 64 + eg * 4;
    const f32x4 elg = *(const f32x4*)(p.rw_lnx_g + ech), elb = *(const f32x4*)(p.rw_lnx_b + ech);
    u32x2 e_g = (u32x2){0u, 0u}, e_z = e_g, e_v = e_g; float e_rkr = 0.f;
    auto eload = [&](int ch) { const size_t rr = (size_t)b * SEGT + ch * 16 + et;
        e_g = *(const u32x2*)(SG + rr * DMIX + ech); e_v = *(const u32x2*)(SV + rr * DMIX + ech); e_z = *(const u32x2*)(P2 + rr * P2W + 512 + ech); e_rkr = BRKR[(rr * 24 + hh) * 4 + 2]; };
    auto efinish = [&](int ch) { const f32x4 o4 = *(const LAS f32x4*)(YB + et * 68 + eg * 4);
        float s1 = (o4[0] + o4[1]) + (o4[2] + o4[3]), s2 = (o4[0] * o4[0] + o4[1] * o4[1]) + (o4[2] * o4[2] + o4[3] * o4[3]);
        s1 = dpp_add<0xB1>(s1); s2 = dpp_add<0xB1>(s2); s1 = dpp_add<0x4E>(s1); s2 = dpp_add<0x4E>(s2); s1 = dpp_add<0x141>(s1); s2 = dpp_add<0x141>(s2); s1 = dpp_add<0x140>(s1); s2 = dpp_add<0x140>(s2);
        const float mean = s1 * (1.0f / 64.0f), var = fmaxf(s2 * (1.0f / 64.0f) - mean * mean, 0.f), rs = rsqrtf(var + 64e-5f);
        const float gg[4] = {bflo(e_g.x), bfhi(e_g.x), bflo(e_g.y), bfhi(e_g.y)}, vv[4] = {bflo(e_v.x), bfhi(e_v.x), bflo(e_v.y), bfhi(e_v.y)}, zz[4] = {bflo(e_z.x), bfhi(e_z.x), bflo(e_z.y), bfhi(e_z.y)};
        float y[4];
#pragma unroll
        for (int j = 0; j < 4; ++j) y[j] = ((o4[j] - mean) * rs * elg[j] + elb[j] + e_rkr * vv[j]) * gg[j] * siluf_(zz[j]);
        *(u32x2*)(Y + ((size_t)b * SEGT + ch * 16 + et) * DIN + ech) = (u32x2){pk2(y[0], y[1]), pk2(y[2], y[3])}; };
    __syncthreads();
    { int t0 = c.tid; asm volatile("" : "+v"(t0)); gload(0, t0); lstore(0, t0); simg(l15c, quadc); }
    lds_barrier();
    if (c.wv < 4) gtile(0, l15c, quadc);
    { int t1 = c.tid; asm volatile("" : "+v"(t1)); gload(1, t1); }
    const int mtq = c.wv & 3;
#pragma unroll 1
    for (int ch = 0; ch < SEGT / 16; ++ch) {
        const int pb = ch & 1;
        int tidv = c.tid, l15 = l15c, quad = quadc; asm volatile("" : "+v"(tidv), "+v"(l15), "+v"(quad));
        LAS bf16_t* EA = (LAS bf16_t*)(OB + pb * OPB + O_EA); LAS bf16_t* EBT = (LAS bf16_t*)(OB + pb * OPB + O_EBT); LAS bf16_t* UV = (LAS bf16_t*)(OB + pb * OPB + O_UV);
        LAS bf16_t* MT1 = (LAS bf16_t*)(OB + pb * OPB + O_MT1); LAS bf16_t* NT = (LAS bf16_t*)(OB + pb * OPB + O_NT); LAS float* MABT = (LAS float*)(OB + pb * OPB + O_MABT); LAS float* GT = (LAS float*)(OB + pb * OPB + O_GT);
        lds_barrier();
        f32x4 Zt = (f32x4){0.f, 0.f, 0.f, 0.f};
        if (c.wv < 4 && ch > 0) efinish(ch - 1);
        if (c.wv >= 4) {
            f32x4 Xt = (f32x4){0.f, 0.f, 0.f, 0.f};
#pragma unroll
            for (int kk = 0; kk < 2; ++kk) { const bf16x8 a = *(const LAS bf16x8*)(S0I + (mtq * 16 + l15) * 72 + kk * 32 + quad * 8);
                Xt = mfma16(a, *(const LAS bf16x8*)(EA + l15 * 72 + kk * 32 + quad * 8), Xt); Zt = mfma16(a, *(const LAS bf16x8*)(EA + (16 + l15) * 72 + kk * 32 + quad * 8), Zt); }
            Xt = mfma16(*(const LAS bf16x8*)(UV + (mtq * 16 + l15) * 40 + quad * 8), *(const LAS bf16x8*)(MT1 + l15 * 40 + quad * 8), Xt);
#pragma unroll
            for (int jj = 0; jj < 4; ++jj) XF[(mtq * 16 + quad * 4 + jj) * 17 + l15] = Xt[jj];
        }
        lds_barrier();
        if (ch + 1 < SEGT / 16) lstore(pb ^ 1, tidv);
        if (ch + 2 < SEGT / 16) gload(ch + 2, tidv);
        if (c.wv == 0) {
            float u[16];
#pragma unroll
            for (int tt = 0; tt < 16; ++tt) { float acc = XF[c.lane * 17 + tt];
#pragma unroll
                for (int s4 = 0; s4 < (tt + 3) / 4; ++s4) { const f32x4 m = *(const LAS f32x4*)(MABT + tt * 20 + s4 * 4);
#pragma unroll
                    for (int e = 0; e < 4; ++e) if (s4 * 4 + e < tt) acc += u[s4 * 4 + e] * m[e]; }
                u[tt] = acc; }
            *(LAS u32x4*)(UV + c.lane * 40) = (u32x4){pk2(u[0], u[1]), pk2(u[2], u[3]), pk2(u[4], u[5]), pk2(u[6], u[7])};
            *(LAS u32x4*)(UV + c.lane * 40 + 8) = (u32x4){pk2(u[8], u[9]), pk2(u[10], u[11]), pk2(u[12], u[13]), pk2(u[14], u[15])};
        }
        lds_barrier();
        if (c.wv >= 4) {
            Zt = mfma16(*(const LAS bf16x8*)(UV + (mtq * 16 + l15) * 40 + quad * 8), *(const LAS bf16x8*)(NT + l15 * 40 + quad * 8), Zt);
            *(LAS f32x4*)(YB + l15 * 68 + mtq * 16 + quad * 4) = Zt;
        } else eload(ch);
#pragma unroll
        for (int x = 0; x < 2; ++x) { const int ti = c.wv * 2 + x, mt = ti >> 2, nt = ti & 3;
            S[x] = mfma16(*(const LAS bf16x8*)(UV + (mt * 16 + l15) * 40 + quad * 8), *(const LAS bf16x8*)(EBT + (nt * 16 + l15) * 40 + quad * 8), S[x]);
            const float gt = GT[nt * 16 + l15];
#pragma unroll
            for (int jj = 0; jj < 4; ++jj) S[x][jj] *= gt; }
        simg(l15, quad);
        if (c.wv < 4 && ch + 1 < SEGT / 16) gtile(pb ^ 1, l15, quad);
    }
    lds_barrier();
    if (c.wv < 4) efinish(SEGT / 16 - 1);
    if (!save) return;
#pragma unroll
    for (int x = 0; x < 2; ++x) { const int ti = c.wv * 2 + x, mt = ti >> 2, nt = ti & 3;
#pragma unroll
        for (int jj = 0; jj < 4; ++jj) RST[(mt * 16 + quadc * 4 + jj) * 64 + nt * 16 + l15c] = S[x][jj]; }
}

__device__ __forceinline__ void phase_b3(const P& p, const Ctx& c) {
    const bf16_t* O = (const bf16_t*)(c.seg + S1_O); const bf16_t* P2 = (const bf16_t*)(c.seg + S1_P2); const bf16_t* SV = (const bf16_t*)(c.seg + S1_V); const bf16_t* SG = (const bf16_t*)(c.seg + S1_G);
    const float* BRKR = (const float*)(c.seg + S1_BRKR); const bf16_t* YM = (const bf16_t*)(c.seg + S1_YMEM); bf16_t* Y = (bf16_t*)(c.seg + S1_Y);
    for (int r = c.bid * 8 + c.wv; r < MS; r += c.G * 8) {
#pragma unroll
        for (int ps = 0; ps < 3; ++ps) {
            const int hh = ps * 8 + (c.lane >> 3), ch = hh * 64 + (c.lane & 7) * 8;
            const u32x4 orr = *(const u32x4*)(O + (size_t)r * DMIX + ch);
            float v[8] = {bflo(orr.x), bfhi(orr.x), bflo(orr.y), bfhi(orr.y), bflo(orr.z), bfhi(orr.z), bflo(orr.w), bfhi(orr.w)}; float s = 0.f, s2 = 0.f;
#pragma unroll
            for (int j = 0; j < 8; ++j) { s += v[j]; s2 += v[j] * v[j]; }
            s += __shfl_xor(s, 1); s2 += __shfl_xor(s2, 1); s += __shfl_xor(s, 2); s2 += __shfl_xor(s2, 2); s += __shfl_xor(s, 4); s2 += __shfl_xor(s2, 4);
            const float mean = s * (1.0f / 64.0f), var = fmaxf(s2 * (1.0f / 64.0f) - mean * mean, 0.f), rs = rsqrtf(var + 64e-5f);
            const float rkr = BRKR[((size_t)r * 24 + hh) * 4 + 2];
            const u32x4 vr = *(const u32x4*)(SV + (size_t)r * DMIX + ch), gr = *(const u32x4*)(SG + (size_t)r * DMIX + ch), zr = *(const u32x4*)(P2 + (size_t)r * P2W + 512 + ch);
            const float vv[8] = {bflo(vr.x), bfhi(vr.x), bflo(vr.y), bfhi(vr.y), bflo(vr.z), bfhi(vr.z), bflo(vr.w), bfhi(vr.w)};
            const float gg[8] = {bflo(gr.x), bfhi(gr.x), bflo(gr.y), bfhi(gr.y), bflo(gr.z), bfhi(gr.z), bflo(gr.w), bfhi(gr.w)};
            const float zz[8] = {bflo(zr.x), bfhi(zr.x), bflo(zr.y), bfhi(zr.y), bflo(zr.z), bfhi(zr.z), bflo(zr.w), bfhi(zr.w)};
            float y[8];
#pragma unroll
            for (int j = 0; j < 8; ++j) { const float t = ((v[j] - mean) * rs * p.rw_lnx_g[ch + j] + p.rw_lnx_b[ch + j] + rkr * vv[j]) * gg[j]; y[j] = t * siluf_(zz[j]); }
            *(u32x4*)(Y + (size_t)r * DIN + ch) = (u32x4){pk2(y[0], y[1]), pk2(y[2], y[3]), pk2(y[4], y[5]), pk2(y[6], y[7])};
        }
        { const int cm = c.lane * 8; const u32x4 mr = *(const u32x4*)(YM + (size_t)r * DX + cm), zr = *(const u32x4*)(P2 + (size_t)r * P2W + 512 + DMIX + cm);
          const float mm[8] = {bflo(mr.x), bfhi(mr.x), bflo(mr.y), bfhi(mr.y), bflo(mr.z), bfhi(mr.z), bflo(mr.w), bfhi(mr.w)};
          const float zz[8] = {bflo(zr.x), bfhi(zr.x), bflo(zr.y), bfhi(zr.y), bflo(zr.z), bfhi(zr.z), bflo(zr.w), bfhi(zr.w)};
          float y[8];
#pragma unroll
          for (int j = 0; j < 8; ++j) y[j] = mm[j] * siluf_(zz[j]);
          *(u32x4*)(Y + (size_t)r * DIN + DMIX + cm) = (u32x4){pk2(y[0], y[1]), pk2(y[2], y[3]), pk2(y[4], y[5]), pk2(y[6], y[7])}; }
    }
}

__device__ __forceinline__ bool fresh_ctx(Ctx& c, P& p, unsigned char* ws0) { int t = threadIdx.x; asm volatile("" : "+v"(t)); c.tid = t; c.wv = __builtin_amdgcn_readfirstlane(t >> 6); c.lane = t & 63;
    int bb = (int)blockIdx.x, gg = (int)gridDim.x; asm volatile("" : "+s"(bb), "+s"(gg)); c.bid = bb; c.G = gg;
#if defined(__HIP_DEVICE_COMPILE__)
    { typedef const __attribute__((address_space(4))) unsigned long long* KP; KP kp = (KP)__builtin_amdgcn_kernarg_segment_ptr(); asm volatile("" : "+s"(kp));
      typedef __attribute__((address_space(1))) char* GP; char** dst = (char**)&p;
#pragma unroll
      for (int i = 0; i < (int)(sizeof(P) / 8); ++i) dst[i] = (char*)(GP)(kp[i]); }
#endif
    size_t z = 0; asm volatile("" : "+s"(z)); p.ws = ws0 + z; c.seg = ws0 + z + OFF_SEG;
    return true; }
__global__ __launch_bounds__(512) void fwd_megakernel(P p_arg) {
    P p = p_arg;
    extern __shared__ __attribute__((aligned(16))) unsigned char shm[];
    LAS unsigned char* lds = (LAS unsigned char*)shm;
    Ctx c; c.tid = threadIdx.x; c.wv = threadIdx.x >> 6; c.lane = threadIdx.x & 63; c.G = gridDim.x; c.bid = blockIdx.x; c.lds = lds; c.seg = p.ws + OFF_SEG;
    volatile LAS unsigned* st = (volatile LAS unsigned*)(lds + LDS_BYTES - 16);
    if (c.tid == 0) { st[0] = 0u; st[1] = 0u; }
    __syncthreads();
    const XcdBarrier xb = xcd_barrier_post((unsigned*)(p.ws + OFF_BAR), st);
#define GSYNC() do { XcdBarrier _xl = xb; size_t _zz = 0; asm volatile("" : "+s"(_zz)); _xl.bar = xb.bar + _zz; _xl.x = xb_xcc_id();     \
        xcd_barrier(_xl); if (RK == 20) { for (int _q = 1; _q < RN; ++_q) xcd_barrier(_xl); } } while (0)
#ifndef RK
#define RK -1
#endif
#ifndef RN
#define RN 1
#endif
#define NREP(k) ((k) == RK ? RN : 1)
#define PH(k) for (int _r = 0; _r < NREP(k); ++_r) if (fresh_ctx(c, p, p_arg.ws))
#define LASTREP(k) (_r + 1 == NREP(k))
    PH(0) phase0(p, c);
    PH(1) phase_apre(p, c, 0, c.bid, c.G);
    GSYNC();
    for (int seg = 0; seg < NSEG; ++seg) {
        PH(2) { SchedA0 S; S.ws = p.ws; S.seg = c.seg; S.G = c.G; S.c = c.bid; S.nextra = (seg == 0) ? 64 : 0;
          pg8::gemm_phase<pg8::EpiBf, SchedA0>(lds, c.tid, 1024, 1024, S, pg8::EpiBf{}); }
        GSYNC();
        PH(3) phase_a1(p, c, seg);
        GSYNC();
        for (int it0 = c.bid; it0 < 256; it0 += c.G) {
            const int xq = it0 & 7, yq = it0 >> 3; const int it = (yq < 24) ? ((xq * 4 + yq / 6) * 6 + yq % 6) : (192 + (yq - 24) * 8 + xq);
            if (it < 192) { PH(4) mlstm_item(p, c, seg, it, LASTREP(4)); }
            else { PH(5) attn_item(p, c, 0, it - 192, (const bf16_t*)(c.seg + S0_P0) + DMIX, ML_W, (bf16_t*)(c.seg + S0_YMEM), DX, nullptr, 0);
                   if (c.G == 256 && seg > 0) { PH(14) phase_b5(p, c, seg - 1, it - 192, 64); } }
        }
        GSYNC();
        PH(6) phase_a3(p, c, seg);
        GSYNC();
        PH(7) { SchedOut S; S.Y = (const char*)(c.seg + S0_Y); S.W = (const char*)(p.ws + OFF_WO0T); S.slab = (char*)(c.seg + S0_SLAB); S.G = c.G; S.c = c.bid;
          pg8::gemm_phase<pg8::EpiBf, SchedOut>(lds, c.tid, DIN, 512, S, pg8::EpiBf{}); }
        GSYNC();
        PH(8) phase_a5(p, c, seg);
        GSYNC();
        PH(9) { SchedB0 S; S.ws = p.ws; S.seg = c.seg; S.G = c.G; S.c = c.bid;
          pg8::gemm_phase<pg8::EpiBf, SchedB0>(lds, c.tid, 1024, 1024, S, pg8::EpiBf{}); }
        GSYNC();
        PH(10) phase_b1(p, c, seg);
        GSYNC();
        for (int it = c.bid; it < 256; it += c.G) {
            if (it < 192) { PH(11) rwkv_chunk_item(p, c, seg, it, LASTREP(11)); }
            else { PH(5) attn_item(p, c, 1, it - 192, (const bf16_t*)(c.seg + S1_P2), P2W, (bf16_t*)(c.seg + S1_Y) + DMIX, DIN, (const bf16_t*)(c.seg + S1_P2) + 512 + DMIX, P2W);
                   if (c.G == 256) { PH(1) if (seg + 1 < NSEG) phase_apre(p, c, seg + 1, it - 192, 64); } }
        }
        GSYNC();
        PH(13) { SchedOut S; S.Y = (const char*)(c.seg + S1_Y); S.W = (const char*)(p.ws + OFF_WO1T); S.slab = (char*)(c.seg + S1_SLAB); S.G = c.G; S.c = c.bid;
          pg8::gemm_phase<pg8::EpiBf, SchedOut>(lds, c.tid, DIN, 512, S, pg8::EpiBf{}); }
        GSYNC();
        if (c.G != 256 || seg + 1 == NSEG) { PH(14) phase_b5(p, c, seg, c.bid, c.G); }
        if (c.G != 256) { PH(1) if (seg + 1 < NSEG) phase_apre(p, c, seg + 1, c.bid, c.G); GSYNC(); }
    }
}

extern "C" void kernel_launch(void* const* d_in, const int* in_sizes, int n_in, void* d_out, int out_size, void* d_ws, size_t ws_size, hipStream_t stream) {
    static int grid = 0;
    if (grid == 0) {
        int dev = 0, cus = 0, per_cu = 0;
        if (hipGetDevice(&dev) != hipSuccess || hipDeviceGetAttribute(&cus, hipDeviceAttributeMultiprocessorCount, dev) != hipSuccess) { grid = -1; return; }
        if (hipFuncSetAttribute((const void*)fwd_megakernel, hipFuncAttributeMaxDynamicSharedMemorySize, LDS_BYTES) != hipSuccess) { fprintf(stderr, "hipFuncSetAttribute failed\n"); grid = -1; return; }
        if (hipOccupancyMaxActiveBlocksPerMultiprocessor(&per_cu, (const void*)fwd_megakernel, 512, LDS_BYTES) != hipSuccess || per_cu < 1) { fprintf(stderr, "occupancy query: %d\n", per_cu); }
        (void)hipGetLastError();
        grid = cus;
        if (n_in != 31 || ws_size < 256 * MiB) { fprintf(stderr, "unexpected n_in %d / ws %zu\n", n_in, ws_size); grid = -1; return; }
    }
    if (grid < 0) return;
    (void)hipMemsetAsync((char*)d_ws + OFF_BAR, 0, XCD_BAR_WORDS * 4, stream);
    P p{};
    const float** f = (const float**)&p;
    for (int i = 0; i < 31; ++i) f[i] = (const float*)d_in[i];
    p.out = (float*)d_out; p.ws = (unsigned char*)d_ws;
    fwd_megakernel<<<dim3(grid), dim3(512), LDS_BYTES, stream>>>(p);
}
```

```cpp
#include <hip/hip_runtime.h>
#include <cstdio>
#include <cstdint>

#define LAS __attribute__((address_space(3)))
typedef unsigned short bf16_t;
typedef short bf16x8 __attribute__((ext_vector_type(8)));
typedef short bf16x4 __attribute__((ext_vector_type(4)));
typedef float f32x4 __attribute__((ext_vector_type(4)));
typedef float f32x2 __attribute__((ext_vector_type(2)));
typedef unsigned u32x4 __attribute__((ext_vector_type(4)));
typedef unsigned u32x2 __attribute__((ext_vector_type(2)));

constexpr int NB = 8, SEQ = 2048, DM = 1024, NSEG = 4, SEGT = 512, MS = NB * SEGT;
constexpr int DMIX = 1536, DX = 512, DIN = 2048;
constexpr int ML_W = 4096, RW_SHIFT = 4896, RW_W = 7456;
constexpr int P1W = 5120, P2W = 2560;
constexpr size_t MiB = 1u << 20;
constexpr size_t OFF_WT0 = 0, OFF_WT1 = 8 * MiB, OFF_WO0T = 23 * MiB, OFF_WO1T = 27 * MiB, OFF_WKVT = 31 * MiB  ,
                 OFF_KMEM = 35 * MiB  , OFF_LORAT = 43 * MiB, OFF_MISC = 45 * MiB,
                 OFF_CST = 46 * MiB, OFF_NST = 65 * MiB, OFF_RST = 65 * MiB + 512 * 1024, OFF_H = 69 * MiB, OFF_VF = 77 * MiB,
                 OFF_SEG = 89 * MiB, OFF_MEMN = 248 * MiB;
constexpr size_t OFF_BAR = OFF_MISC, OFF_UTAIL = OFF_MISC + 64 * 1024, OFF_PTAIL = OFF_MISC + 256 * 1024;
constexpr size_t S0_P0 = 0, S0_Q = 32 * MiB, S0_K = 44 * MiB, S0_KT = 56 * MiB, S0_VT = 68 * MiB, S0_XC = 80 * MiB, S0_HRAW = 92 * MiB,
                 S0_Y = 104 * MiB  , S0_GATE = 120 * MiB, S0_YMEM = 121 * MiB  ;
constexpr size_t S1_P1 = 0, S1_O = 0, S1_Y = 62 * MiB  , S1_P2 = 40 * MiB, S1_W = 60 * MiB, S1_A = 84 * MiB, S1_B = 96 * MiB, S1_K = 108 * MiB,
                 S1_Q = 120 * MiB, S1_V = 132 * MiB, S1_G = 144 * MiB, S1_YMEM = 156 * MiB, S1_BRKR = 160 * MiB;
constexpr size_t S0_SLAB = 0  , S1_SLAB = 126 * MiB  ;
constexpr int LDS_BYTES = 150 * 1024;

struct P {
    const float *x, *mem, *norm_g, *mem_norm_g, *mem_kv_w, *w_out, *ml_w_in, *ml_conv_w, *ml_conv_b, *ml_wq, *ml_wk, *ml_wv, *ml_w_gate, *ml_b_gate,
        *ml_mhn_g, *ml_skip, *rw_w_in, *rw_mu, *rw_w_lora2, *rw_w0, *rw_a_lora2, *rw_a0, *rw_v_lora2, *rw_v0, *rw_g_lora2, *rw_k_k, *rw_k_a, *rw_r_k,
        *rw_lnx_g, *rw_lnx_b, *final_g;
    float* out; unsigned char* ws;
};

__device__ __forceinline__ bf16_t f2bf(float f) { const __bf16 r = (__bf16)f; bf16_t u; __builtin_memcpy(&u, &r, 2); return u; }
__device__ __forceinline__ float bf2f(bf16_t b) { return __uint_as_float(((unsigned)b) << 16); }
typedef __bf16 bf2_t __attribute__((ext_vector_type(2)));
__device__ __forceinline__ unsigned pk2(float lo, float hi) { const bf2_t r = __builtin_convertvector((f32x2){lo, hi}, bf2_t); unsigned u; __builtin_memcpy(&u, &r, 4); return u; }
__device__ __forceinline__ float bflo(unsigned u) { return __uint_as_float(u << 16); }
__device__ __forceinline__ float bfhi(unsigned u) { return __uint_as_float(u & 0xFFFF0000u); }
__device__ __forceinline__ float wsum(float v) {
#pragma unroll
    for (int o = 32; o >= 1; o >>= 1) v += __shfl_xor(v, o);
    return v;
}
__device__ __forceinline__ float frcp(float x) { return __builtin_amdgcn_rcpf(x); }
__device__ __forceinline__ float sigmoidf_(float x) { return frcp(1.0f + __expf(-x)); }
__device__ __forceinline__ float siluf_(float x) { return x * frcp(1.0f + __expf(-x)); }
__device__ __forceinline__ float softplusf_(float z) { return fmaxf(z, 0.f) + __logf(1.0f + __expf(-fabsf(z))); }
template <int CTRL> __device__ __forceinline__ float dpp_add(float v) {
    return v + __int_as_float(__builtin_amdgcn_update_dpp(0, __float_as_int(v), CTRL, 0xF, 0xF, true));
}
__device__ __forceinline__ float row16_allsum(float v) {
    v = dpp_add<0xB1>(v);
    v = dpp_add<0x4E>(v);
    v = dpp_add<0x141>(v);
    v = dpp_add<0x140>(v);
    return v;
}
__device__ __forceinline__ void row16_allsum4(float& a, float& b, float& c, float& d) {
    asm volatile("s_nop 1\n\t"
        "v_add_f32_dpp %0, %0, %0 quad_perm:[1,0,3,2] row_mask:0xf bank_mask:0xf\n\t" "v_add_f32_dpp %1, %1, %1 quad_perm:[1,0,3,2] row_mask:0xf bank_mask:0xf\n\t"
        "v_add_f32_dpp %2, %2, %2 quad_perm:[1,0,3,2] row_mask:0xf bank_mask:0xf\n\t" "v_add_f32_dpp %3, %3, %3 quad_perm:[1,0,3,2] row_mask:0xf bank_mask:0xf\n\t"
        "v_add_f32_dpp %0, %0, %0 quad_perm:[2,3,0,1] row_mask:0xf bank_mask:0xf\n\t" "v_add_f32_dpp %1, %1, %1 quad_perm:[2,3,0,1] row_mask:0xf bank_mask:0xf\n\t"
        "v_add_f32_dpp %2, %2, %2 quad_perm:[2,3,0,1] row_mask:0xf bank_mask:0xf\n\t" "v_add_f32_dpp %3, %3, %3 quad_perm:[2,3,0,1] row_mask:0xf bank_mask:0xf\n\t"
        "v_add_f32_dpp %0, %0, %0 row_half_mirror row_mask:0xf bank_mask:0xf\n\t" "v_add_f32_dpp %1, %1, %1 row_half_mirror row_mask:0xf bank_mask:0xf\n\t"
        "v_add_f32_dpp %2, %2, %2 row_half_mirror row_mask:0xf bank_mask:0xf\n\t" "v_add_f32_dpp %3, %3, %3 row_half_mirror row_mask:0xf bank_mask:0xf\n\t"
        "v_add_f32_dpp %0, %0, %0 row_mirror row_mask:0xf bank_mask:0xf\n\t" "v_add_f32_dpp %1, %1, %1 row_mirror row_mask:0xf bank_mask:0xf\n\t"
        "v_add_f32_dpp %2, %2, %2 row_mirror row_mask:0xf bank_mask:0xf\n\t" "v_add_f32_dpp %3, %3, %3 row_mirror row_mask:0xf bank_mask:0xf\n\t"
        "s_nop 1"
        : "+v"(a), "+v"(b), "+v"(c), "+v"(d));
}
template <int N> __device__ __forceinline__ float dpp_shr_or1(float v) {
    return __int_as_float(__builtin_amdgcn_update_dpp(0x3f800000, __float_as_int(v), 0x110 + N, 0xF, 0xF, false));
}
__device__ __forceinline__ f32x4 mfma16(bf16x8 a, bf16x8 b, f32x4 c) { return __builtin_amdgcn_mfma_f32_16x16x32_bf16(a, b, c, 0, 0, 0); }

namespace pg8 {
constexpr int BM = 256, BK = 64, HALF = 128, HTB = HALF * BK * 2, STAGE_BYTES = 8 * HTB, NXCD = 8, WGM = 8;
__host__ __device__ __forceinline__ int lds_byte(int r, int c) { const int st = (r >> 4) * 2 + (c >> 5), rr = r & 15, cc = c & 31, ob = rr * 64 + cc * 2; return st * 1024 + (ob ^ (((ob >> 9) & 1) << 5)); }
__host__ __device__ __forceinline__ void stage_rc(int b, int& R, int& C) { const int st = b / 1024, sb = b % 1024, swz = sb ^ (((sb >> 9) & 1) << 5); R = (st >> 1) * 16 + swz / 64; C = (st & 1) * 32 + (swz % 64) / 2; }
__host__ __device__ __forceinline__ int perm32(int rho) { const int n = rho >> 4, i = rho & 15; return 8 * (i >> 2) + 4 * n + (i & 3); }

struct Unit { const char* A; const char* B; char* O; int ldc; int pad; };

__device__ __forceinline__ void remap(int wgid, int nM, int nN, int& pm, int& pn) {
    const int nwg = nM * nN;
    { const int q = nwg / NXCD, r = nwg % NXCD, xcd = wgid % NXCD, off = wgid / NXCD; wgid = (xcd < r ? xcd * (q + 1) : r * (q + 1) + (xcd - r) * q) + off; }
    const int nig = WGM * nN, gid = wgid / nig, fm = gid * WGM, gsz = (nM - fm) < WGM ? (nM - fm) : WGM;
    pm = fm + ((wgid % nig) % gsz); pn = (wgid % nig) / gsz;
}

struct EpiBf {
    static constexpr bool PERM = true;
    __device__ __forceinline__ void operator()(const f32x4 (&acc)[2][2][4][2], const Unit& u, int wr, int wc, int fr, int fq) const {
        asm volatile("" : "+v"(fr), "+v"(fq));
        bf16_t* base = (bf16_t*)u.O;
#pragma unroll
        for (int ai = 0; ai < 2; ++ai)
#pragma unroll
            for (int m = 0; m < 4; ++m) { bf16_t* rowp = base + (size_t)(ai * HALF + wr * 64 + m * 16 + fr) * u.ldc + wc * 32 + 8 * fq;
#pragma unroll
                for (int bj = 0; bj < 2; ++bj) { const f32x4 v0 = acc[ai][bj][m][0], v1 = acc[ai][bj][m][1];
                    u32x4 w; w.x = pk2(v0[0], v0[1]); w.y = pk2(v0[2], v0[3]); w.z = pk2(v1[0], v1[1]); w.w = pk2(v1[2], v1[3]);
                    *(u32x4*)(rowp + bj * HALF) = w; } }
    }
};
struct EpiAtomic {
    static constexpr bool PERM = false;
    __device__ __forceinline__ void operator()(const f32x4 (&acc)[2][2][4][2], const Unit& u, int wr, int wc, int fr, int fq) const {
        asm volatile("" : "+v"(fr), "+v"(fq));
        float* base = (float*)u.O;
#pragma unroll
        for (int ai = 0; ai < 2; ++ai)
#pragma unroll
            for (int m = 0; m < 4; ++m) { float* rowp = base + (size_t)(ai * HALF + wr * 64 + m * 16 + fr) * u.ldc + wc * 32 + 4 * fq;
#pragma unroll
                for (int bj = 0; bj < 2; ++bj)
#pragma unroll
                    for (int n = 0; n < 2; ++n) { const f32x4 v = acc[ai][bj][m][n]; float* q = rowp + bj * HALF + n * 16;
#pragma unroll
                        for (int e = 0; e < 4; ++e) (void)__hip_atomic_fetch_add(q + e, v[e], __ATOMIC_RELAXED, __HIP_MEMORY_SCOPE_AGENT); }
                __builtin_amdgcn_sched_barrier(0); }
    }
};

template <class Epi, class Sched>
__device__ __forceinline__ void gemm_phase(LAS unsigned char* lds, const int tid, const int ldk, const int Kloop, const Sched& S, const Epi& E) {
    const int wid = __builtin_amdgcn_readfirstlane(tid >> 6), lane = tid & 63, wr = wid >> 2, wc = wid & 3, fr = lane & 15, fq = lane >> 4;
    const int nt = Kloop / BK;
    unsigned voffA[2], voffB[2];
#pragma unroll
    for (int i = 0; i < 2; ++i) { int R, C; stage_rc(tid * 16 + i * 8192, R, C); const int Rb = Epi::PERM ? ((R & ~31) + perm32(R & 31)) : R;
        voffA[i] = (unsigned)(R * ldk + C) * 2u; voffB[i] = (unsigned)(Rb * ldk + C) * 2u; }
    const size_t kstep = (size_t)(BK * 2);
    const size_t hstep = (size_t)HALF * ldk * 2;
    const unsigned ldsw = (unsigned)wid * 1024u;
    const int aoff = lds_byte(wr * 64 + fr, fq * 8), boff = lds_byte(wc * 32 + fr, fq * 8);
#define PG8_SA(b, h) (((b) * 2 + (h)) * HTB)
#define PG8_SB(b, h) ((4 + (b) * 2 + (h)) * HTB)
#define PG8_STAGE(bufoff, gbase, voff) do { _Pragma("unroll") for (int _i = 0; _i < 2; ++_i) \
        __builtin_amdgcn_global_load_lds((const unsigned*)((const char*)(gbase) + (voff)[_i]), (LAS unsigned*)(lds + (bufoff) + ldsw + _i * 8192), 16, 0, 0); } while (0)
#define PG8_LDA(dst, b, h) do { _Pragma("unroll") for (int m = 0; m < 4; ++m) _Pragma("unroll") for (int k = 0; k < 2; ++k) dst[m][k] = *(const LAS bf16x8*)(lds + PG8_SA(b, h) + aoff + m * 2048 + k * 1024); } while (0)
#define PG8_LDB(dst, b, h) do { _Pragma("unroll") for (int n = 0; n < 2; ++n) _Pragma("unroll") for (int k = 0; k < 2; ++k) dst[n][k] = *(const LAS bf16x8*)(lds + PG8_SB(b, h) + boff + n * 2048 + k * 1024); } while (0)
#define PG8_MMA(ai, bj, At, Bt) do { __builtin_amdgcn_s_setprio(1); _Pragma("unroll") for (int m = 0; m < 4; ++m) _Pragma("unroll") for (int n = 0; n < 2; ++n) _Pragma("unroll") for (int k = 0; k < 2; ++k) \
        acc[ai][bj][m][n] = __builtin_amdgcn_mfma_f32_16x16x32_bf16(Bt[n][k], At[m][k], acc[ai][bj][m][n], 0, 0, 0); __builtin_amdgcn_s_setprio(0); } while (0)
#define PG8_WAIT_V(n) asm volatile("s_waitcnt vmcnt(" #n ")" ::: "memory")
#define PG8_WAIT_L(n) asm volatile("s_waitcnt lgkmcnt(" #n ")" ::: "memory")
#define PG8_BAR __builtin_amdgcn_s_barrier()
#define PG8_SCHED __builtin_amdgcn_sched_barrier(0)
    Unit cur, nxt; int ui = 0;
    if (!S.next(0, cur)) return;
    f32x4 acc[2][2][4][2];
#pragma unroll
    for (int a = 0; a < 2; ++a)
#pragma unroll
        for (int b = 0; b < 2; ++b)
#pragma unroll
            for (int m = 0; m < 4; ++m)
#pragma unroll
                for (int n = 0; n < 2; ++n) acc[a][b][m][n] = (f32x4){0.f, 0.f, 0.f, 0.f};
    bf16x8 At[4][2], B0[2][2], B1[2][2];
    const char* cA = cur.A; const char* cB = cur.B;
    PG8_STAGE(PG8_SB(0, 0), cB, voffB); PG8_STAGE(PG8_SA(0, 0), cA, voffA); PG8_STAGE(PG8_SB(0, 1), cB + hstep, voffB); PG8_STAGE(PG8_SA(0, 1), cA + hstep, voffA);
    if (wr == 1) PG8_BAR;
    PG8_WAIT_V(4); PG8_BAR;
    PG8_STAGE(PG8_SB(1, 0), cB + kstep, voffB); PG8_STAGE(PG8_SA(1, 0), cA + kstep, voffA); PG8_STAGE(PG8_SB(1, 1), cB + hstep + kstep, voffB);
    PG8_WAIT_V(6); PG8_BAR;
    for (;;) {
        const bool has_next = S.next(ui + 1, nxt);
        const char* nA = has_next ? nxt.A : cA; const char* nB = has_next ? nxt.B : cB;
        for (int t = 0; t < nt; t += 2) {
            const bool last = (t == nt - 2);
            const char* a1 = cA + (size_t)(t + 1) * kstep;
            const char* a2 = last ? nA : cA + (size_t)(t + 2) * kstep; const char* b2 = last ? nB : cB + (size_t)(t + 2) * kstep;
            const char* a3 = a2 + kstep; const char* b3 = b2 + kstep;
            PG8_LDB(B0, 0, 0); PG8_SCHED; PG8_LDA(At, 0, 0); PG8_STAGE(PG8_SA(1, 1), a1 + hstep, voffA);
            PG8_WAIT_L(8); PG8_BAR; PG8_WAIT_L(0); PG8_MMA(0, 0, At, B0); PG8_BAR; PG8_SCHED;
            PG8_LDB(B1, 0, 1); PG8_STAGE(PG8_SB(0, 0), b2, voffB);
            PG8_BAR; PG8_WAIT_L(0); PG8_MMA(0, 1, At, B1); PG8_BAR;
            PG8_LDA(At, 0, 1); PG8_STAGE(PG8_SA(0, 0), a2, voffA);
            PG8_BAR; PG8_WAIT_L(0); PG8_MMA(1, 0, At, B0); PG8_BAR; PG8_SCHED;
            PG8_STAGE(PG8_SB(0, 1), b2 + hstep, voffB);
            PG8_WAIT_V(6); PG8_BAR; PG8_MMA(1, 1, At, B1); PG8_BAR;
            PG8_LDB(B0, 1, 0); PG8_SCHED; PG8_LDA(At, 1, 0); PG8_STAGE(PG8_SA(0, 1), a2 + hstep, voffA);
            PG8_WAIT_L(8); PG8_BAR; PG8_WAIT_L(0); PG8_MMA(0, 0, At, B0); PG8_BAR; PG8_SCHED;
            PG8_LDB(B1, 1, 1); PG8_STAGE(PG8_SB(1, 0), b3, voffB);
            PG8_BAR; PG8_WAIT_L(0); PG8_MMA(0, 1, At, B1); PG8_BAR;
            PG8_LDA(At, 1, 1); PG8_STAGE(PG8_SA(1, 0), a3, voffA);
            PG8_BAR; PG8_WAIT_L(0); PG8_MMA(1, 0, At, B0); PG8_BAR; PG8_SCHED;
            PG8_STAGE(PG8_SB(1, 1), b3 + hstep, voffB);
            PG8_WAIT_V(6); PG8_BAR; PG8_MMA(1, 1, At, B1); PG8_BAR;
        }
        E(acc, cur, wr, wc, fr, fq);
        if (!has_next) break;
#pragma unroll
        for (int a = 0; a < 2; ++a)
#pragma unroll
            for (int b = 0; b < 2; ++b)
#pragma unroll
                for (int m = 0; m < 4; ++m)
#pragma unroll
                    for (int n = 0; n < 2; ++n) acc[a][b][m][n] = (f32x4){0.f, 0.f, 0.f, 0.f};
        cur = nxt; cA = nA; cB = nB; ++ui;
    }
    PG8_WAIT_V(0);
    if (wr == 0) PG8_BAR;
    PG8_BAR;
#undef PG8_SA
#undef PG8_SB
#undef PG8_STAGE
#undef PG8_LDA
#undef PG8_LDB
#undef PG8_MMA
#undef PG8_WAIT_V
#undef PG8_WAIT_L
#undef PG8_BAR
#undef PG8_SCHED
}
}

#define XB_TMO      128
#define XB_XCNT(j)  (256  + 64 * (j))
#define XB_XSUB(j)  (1280 + 64 * (j))
#define XB_XGEN(j)  (2304 + 64 * (j))
#define XB_TOP      3328
#define XB_TOPGEN   3392
#define XCD_BAR_WORDS 3456
#define XB_SPIN_CAP (1u << 18)
__device__ __forceinline__ unsigned xb_ld(unsigned* p)              { return __hip_atomic_load(p, __ATOMIC_RELAXED, __HIP_MEMORY_SCOPE_AGENT); }
__device__ __forceinline__ unsigned xb_add(unsigned* p, unsigned v) { return __hip_atomic_fetch_add(p, v, __ATOMIC_RELAXED, __HIP_MEMORY_SCOPE_AGENT); }
__device__ __forceinline__ unsigned xb_xcc_id() { return (unsigned)__builtin_amdgcn_s_getreg((3 << 11) | 20) & 0xFu; }
#define XB_SPIN(cond, bar) do { unsigned _sp = 0; while (cond) { __builtin_amdgcn_s_sleep(1); \
    if ((++_sp & 255u) == 0u) { if (xb_ld(&(bar)[XB_TMO])) break; if (_sp > XB_SPIN_CAP) { atomicAdd(&(bar)[XB_TMO], 1u); break; } } } } while (0)
struct XcdBarrier { unsigned* bar; unsigned x; volatile LAS unsigned* st; };
__device__ __forceinline__ XcdBarrier xcd_barrier_post(unsigned* bar, volatile LAS unsigned* st) {
    XcdBarrier b; b.bar = bar; b.x = xb_xcc_id(); b.st = st;
    if (threadIdx.x == 0) (void)xb_add(&bar[XB_XCNT(b.x)], 1u);
    return b;
}
__device__ __forceinline__ void xcd_barrier_complete(unsigned* bar, unsigned x, unsigned& nloc, unsigned& nx) {
    const unsigned G = gridDim.x * gridDim.y * gridDim.z;
    unsigned sum, cnt, mine, sp = 0u;
    for (;;) {
        sum = 0u; cnt = 0u; mine = 0u;
#pragma unroll
        for (unsigned j = 0; j < 16; ++j) { const unsigned c = xb_ld(&bar[XB_XCNT(j)]); sum += c; cnt += (c > 0u) ? 1u : 0u; mine = (j == x) ? c : mine; }
        if (sum == G) break;
        __builtin_amdgcn_s_sleep(1);
        if ((++sp & 255u) == 0u) { if (xb_ld(&bar[XB_TMO])) break; if (sp > XB_SPIN_CAP) { atomicAdd(&bar[XB_TMO], 1u); break; } }
    }
    nloc = mine > 0u ? mine : 1u; nx = cnt > 0u ? cnt : 1u;
}
__device__ __forceinline__ void xcd_barrier(const XcdBarrier& b) {
    asm volatile("s_waitcnt vmcnt(0)" ::: "memory");
    __syncthreads();
    int tid0 = threadIdx.x; asm volatile("" : "+v"(tid0));
    if (tid0 == 0) {
        unsigned* bar = b.bar;
        __builtin_amdgcn_s_waitcnt(0);
        unsigned nloc = b.st[0], nx = b.st[1];
        if (nloc == 0u) { xcd_barrier_complete(bar, b.x, nloc, nx); b.st[0] = nloc; b.st[1] = nx; }
        const unsigned old = xb_add(&bar[XB_XSUB(b.x)], 1u);
        const unsigned gen = old / nloc;
        if (old + 1u == (gen + 1u) * nloc) {
            __builtin_amdgcn_fence(__ATOMIC_RELEASE, "agent");
            asm volatile("s_waitcnt vmcnt(0)" ::: "memory");
            const unsigned og = xb_add(&bar[XB_TOP], 1u);
            const unsigned tg = og / nx;
            if (og + 1u == (tg + 1u) * nx) xb_add(&bar[XB_TOPGEN], 1u);
            else XB_SPIN(xb_ld(&bar[XB_TOPGEN]) == tg, bar);
            __builtin_amdgcn_fence(__ATOMIC_ACQUIRE, "agent");
            xb_add(&bar[XB_XGEN(b.x)], 1u);
            asm volatile("s_waitcnt vmcnt(0)" ::: "memory");
        } else {
            XB_SPIN(xb_ld(&bar[XB_XGEN(b.x)]) == gen, bar);
            __builtin_amdgcn_fence(__ATOMIC_ACQUIRE, "agent");
            asm volatile("s_waitcnt vmcnt(0)" ::: "memory");
        }
    }
    __syncthreads();
}

__device__ __forceinline__ void lds_barrier() { asm volatile("s_waitcnt lgkmcnt(0)" ::: "memory"); __builtin_amdgcn_s_barrier(); asm volatile("" ::: "memory"); }
struct Ctx { int tid, wv, lane, G, bid; LAS unsigned char* lds; unsigned char* seg; };

template <int MODE>
__device__ __forceinline__ void convT_tile(const Ctx& c, const float* src, int ldsrc, int Ksrc, int k0, int n0, bf16_t* dst, int ldd, int koff) {
    LAS float* tile = (LAS float*)c.lds;
    __syncthreads();
#pragma unroll
    for (int rep = 0; rep < 2; ++rep) {
        const int i = (c.tid >> 4) + 32 * rep, j4 = (c.tid & 15) * 4; const int n = n0 + j4; int sc = n;
        if (MODE == 1) sc = (n < RW_SHIFT) ? n : (n < P1W ? -1 : n - (P1W - RW_SHIFT));
        f32x4 v = (f32x4){0.f, 0.f, 0.f, 0.f};
        if (sc >= 0 && (k0 + i) < Ksrc) v = *(const f32x4*)(src + (size_t)(k0 + i) * ldsrc + sc);
        tile[i * 65 + j4 + 0] = v[0]; tile[i * 65 + j4 + 1] = v[1]; tile[i * 65 + j4 + 2] = v[2]; tile[i * 65 + j4 + 3] = v[3];
    }
    __syncthreads();
    { const int j = c.tid >> 3, i8 = (c.tid & 7) * 8;
      if (k0 + i8 < Ksrc) {
        u32x4 w; w.x = pk2(tile[(i8 + 0) * 65 + j], tile[(i8 + 1) * 65 + j]); w.y = pk2(tile[(i8 + 2) * 65 + j], tile[(i8 + 3) * 65 + j]);
        w.z = pk2(tile[(i8 + 4) * 65 + j], tile[(i8 + 5) * 65 + j]); w.w = pk2(tile[(i8 + 6) * 65 + j], tile[(i8 + 7) * 65 + j]);
        *(u32x4*)(dst + (size_t)(n0 + j) * ldd + koff + k0 + i8) = w; } }
}

__device__ __forceinline__ void rms_row_bf16(const float* src, const float* g, bf16_t* dst, int lane) {
    f32x4 v[4]; float ss = 0.f;
#pragma unroll
    for (int i = 0; i < 4; ++i) { v[i] = *(const f32x4*)(src + i * 256 + lane * 4); ss += v[i][0] * v[i][0] + v[i][1] * v[i][1] + v[i][2] * v[i][2] + v[i][3] * v[i][3]; }
    ss = wsum(ss); const float rs = rsqrtf(ss * (1.0f / 1024.0f) + 1e-6f);
#pragma unroll
    for (int i = 0; i < 4; ++i) { const f32x4 gg = *(const f32x4*)(g + i * 256 + lane * 4);
        u32x2 w; w.x = pk2(v[i][0] * rs * gg[0], v[i][1] * rs * gg[1]); w.y = pk2(v[i][2] * rs * gg[2], v[i][3] * rs * gg[3]);
        *(u32x2*)(dst + i * 256 + lane * 4) = w; }
}
__device__ __forceinline__ float add_slabs(const float* src, const bf16_t* slab, int r, int lane, f32x4 (&v)[4]) {
    float ss = 0.f;
#pragma unroll
    for (int i = 0; i < 4; ++i) { v[i] = *(const f32x4*)(src + i * 256 + lane * 4);
#pragma unroll
        for (int ks = 0; ks < 4; ++ks) { const u32x2 t = *(const u32x2*)(slab + ((size_t)ks * MS + r) * DM + i * 256 + lane * 4);
            v[i][0] += bflo(t.x); v[i][1] += bfhi(t.x); v[i][2] += bflo(t.y); v[i][3] += bfhi(t.y); }
        ss += v[i][0] * v[i][0] + v[i][1] * v[i][1] + v[i][2] * v[i][2] + v[i][3] * v[i][3]; }
    return wsum(ss);
}

__device__ __forceinline__ void phase_apre(const P& p, const Ctx& c, int seg, int wg, int nwg) {
    bf16_t* H = (bf16_t*)(p.ws + OFF_H);
    for (int r = wg * 8 + c.wv; r < MS; r += nwg * 8) { const int b = r >> 9, tl = r & 511; const size_t grow = (size_t)b * SEQ + seg * SEGT + tl;
        rms_row_bf16(p.x + grow * DM, p.norm_g, H + (size_t)r * DM, c.lane); }
}
__device__ __forceinline__ void phase_a5(const P& p, const Ctx& c, int seg) {
    bf16_t* H = (bf16_t*)(p.ws + OFF_H); const bf16_t* slab = (const bf16_t*)(c.seg + S0_SLAB);
    for (int r = c.bid * 8 + c.wv; r < MS / 2; r += c.G * 8) {
        const int ra = r, rb = r + MS / 2;
        const size_t ga = (size_t)(ra >> 9) * SEQ + seg * SEGT + (ra & 511), gb = (size_t)(rb >> 9) * SEQ + seg * SEGT + (rb & 511);
        f32x4 va[4], vb[4]; const float sa = add_slabs(p.x + ga * DM, slab, ra, c.lane, va); const float sb = add_slabs(p.x + gb * DM, slab, rb, c.lane, vb);
        const float rsa = rsqrtf(sa * (1.0f / 1024.0f) + 1e-6f), rsb = rsqrtf(sb * (1.0f / 1024.0f) + 1e-6f);
#pragma unroll
        for (int i = 0; i < 4; ++i) { const f32x4 gg = *(const f32x4*)(p.norm_g + DM + i * 256 + c.lane * 4);
            *(f32x4*)(p.out + ga * DM + i * 256 + c.lane * 4) = va[i]; *(f32x4*)(p.out + gb * DM + i * 256 + c.lane * 4) = vb[i];
            u32x2 w; w.x = pk2(va[i][0] * rsa * gg[0], va[i][1] * rsa * gg[1]); w.y = pk2(va[i][2] * rsa * gg[2], va[i][3] * rsa * gg[3]);
            *(u32x2*)(H + (size_t)ra * DM + i * 256 + c.lane * 4) = w;
            w.x = pk2(vb[i][0] * rsb * gg[0], vb[i][1] * rsb * gg[1]); w.y = pk2(vb[i][2] * rsb * gg[2], vb[i][3] * rsb * gg[3]);
            *(u32x2*)(H + (size_t)rb * DM + i * 256 + c.lane * 4) = w; } }
}
__device__ __forceinline__ void phase_b5(const P& p, const Ctx& c, int seg, int wg, int nwg) {
    const bf16_t* slab = (const bf16_t*)(c.seg + S1_SLAB);
    for (int r = wg * 8 + c.wv; r < MS / 2; r += nwg * 8) {
        const int ra = r, rb = r + MS / 2;
        float* rowa = p.out + ((size_t)(ra >> 9) * SEQ + seg * SEGT + (ra & 511)) * DM; float* rowb = p.out + ((size_t)(rb >> 9) * SEQ + seg * SEGT + (rb & 511)) * DM;
        f32x4 va[4], vb[4]; const float sa = add_slabs(rowa, slab, ra, c.lane, va); const float sb = add_slabs(rowb, slab, rb, c.lane, vb);
        const float rsa = rsqrtf(sa * (1.0f / 1024.0f) + 1e-6f), rsb = rsqrtf(sb * (1.0f / 1024.0f) + 1e-6f);
#pragma unroll
        for (int i = 0; i < 4; ++i) { const f32x4 gg = *(const f32x4*)(p.final_g + i * 256 + c.lane * 4); f32x4 o;
            o[0] = va[i][0] * rsa * gg[0]; o[1] = va[i][1] * rsa * gg[1]; o[2] = va[i][2] * rsa * gg[2]; o[3] = va[i][3] * rsa * gg[3]; *(f32x4*)(rowa + i * 256 + c.lane * 4) = o;
            o[0] = vb[i][0] * rsb * gg[0]; o[1] = vb[i][1] * rsb * gg[1]; o[2] = vb[i][2] * rsb * gg[2]; o[3] = vb[i][3] * rsb * gg[3]; *(f32x4*)(rowb + i * 256 + c.lane * 4) = o; } }
}

__device__ __forceinline__ void phase0(const P& p, const Ctx& c) {
    const int T0 = 16 * 64, T1 = 16 * 120, T2 = 32 * 16, T3 = 32 * 16, T4 = 16 * 16, T5 = 16 * 16, T6 = 24 * 5;
    const int TT = T0 + T1 + T2 + T3 + T4 + T5 + T6;
    for (int t = c.bid; t < TT; t += c.G) {
        int u = t;
        if (u < T0) { convT_tile<0>(c, p.ml_w_in, ML_W, 1024, (u & 15) * 64, (u >> 4) * 64, (bf16_t*)(p.ws + OFF_WT0), 1024, 0); continue; } u -= T0;
        if (u < T1) { convT_tile<1>(c, p.rw_w_in, RW_W, 1024, (u & 15) * 64, (u >> 4) * 64, (bf16_t*)(p.ws + OFF_WT1), 1024, 0); continue; } u -= T1;
        if (u < T2) { convT_tile<0>(c, p.w_out, DM, 2048, (u & 31) * 64, (u >> 5) * 64, (bf16_t*)(p.ws + OFF_WO0T), 2048, 0); continue; } u -= T2;
        if (u < T3) { convT_tile<0>(c, p.w_out + (size_t)DIN * DM, DM, 2048, (u & 31) * 64, (u >> 5) * 64, (bf16_t*)(p.ws + OFF_WO1T), 2048, 0); continue; } u -= T3;
        if (u < T4) { convT_tile<0>(c, p.mem_kv_w, DM, 1024, (u & 15) * 64, (u >> 4) * 64, (bf16_t*)(p.ws + OFF_WKVT), 1024, 0); continue; } u -= T4;
        if (u < T5) { convT_tile<0>(c, p.mem_kv_w + (size_t)DM * DM, DM, 1024, (u & 15) * 64, (u >> 4) * 64, (bf16_t*)(p.ws + OFF_WKVT + 2 * MiB), 1024, 0); continue; } u -= T5;
        { const int nt = u / 5, j = u % 5; bf16_t* L = (bf16_t*)(p.ws + OFF_LORAT);
          if (j == 0) convT_tile<0>(c, p.rw_w_lora2, DMIX, 64, 0, nt * 64, L, 288, 0);
          else if (j == 1) convT_tile<0>(c, p.rw_a_lora2, DMIX, 64, 0, nt * 64, L, 288, 64);
          else if (j == 2) convT_tile<0>(c, p.rw_v_lora2, DMIX, 32, 0, nt * 64, L, 288, 128);
          else convT_tile<0>(c, p.rw_g_lora2, DMIX, 128, (j - 3) * 64, nt * 64, L, 288, 160); }
    }
    for (int r = c.bid * 8 + c.wv; r < 2 * 2048; r += c.G * 8) { const int l = r >> 11, rr = r & 2047;
        rms_row_bf16(p.mem + (size_t)rr * DM, p.mem_norm_g + l * DM, (bf16_t*)(p.ws + OFF_MEMN) + (size_t)r * DM, c.lane); }
}

struct SchedA0 {
    const unsigned char* ws; unsigned char* seg; int G, c, nextra;
    __device__ __forceinline__ bool next(int i, pg8::Unit& u) const {
        const int L = i * G + c; if (L >= 256 + nextra) return false;
        if (L < 256) { int pm, pn; pg8::remap(L, 16, 16, pm, pn);
            u.A = (const char*)(ws + OFF_H) + (size_t)pm * 256 * 1024 * 2; u.B = (const char*)(ws + OFF_WT0) + (size_t)pn * 256 * 1024 * 2;
            u.O = (char*)(seg + S0_P0) + ((size_t)pm * 256 * ML_W + pn * 256) * 2; u.ldc = ML_W; return true; }
        const int e = L - 256, l = e >> 5, j = e & 31;
        const char* memn = (const char*)(ws + OFF_MEMN) + (size_t)l * 2048 * 1024 * 2; const char* wkv = (const char*)(ws + OFF_WKVT) + (size_t)l * 2 * MiB;
        char* kout = (char*)(ws + OFF_KMEM) + (size_t)l * 4 * MiB;
        if (j < 16) { const int pm = j >> 1, pn = j & 1;
            u.A = memn + (size_t)pm * 256 * 1024 * 2; u.B = wkv + (size_t)pn * 256 * 1024 * 2; u.O = kout + ((size_t)pm * 256 * 512 + pn * 256) * 2; u.ldc = 512; }
        else { const int jj = j - 16, pm = jj >> 3, pn = jj & 7;
            u.A = wkv + (size_t)(512 + pm * 256) * 1024 * 2; u.B = memn + (size_t)pn * 256 * 1024 * 2; u.O = kout + 2 * MiB + ((size_t)pm * 256 * 2048 + pn * 256) * 2; u.ldc = 2048; }
        return true;
    }
};
struct SchedB0 {
    const unsigned char* ws; unsigned char* seg; int G, c;
    __device__ __forceinline__ bool next(int i, pg8::Unit& u) const {
        const int L = i * G + c; if (L >= 480) return false;
        int pm, pn; pg8::remap(L, 16, 30, pm, pn);
        u.A = (const char*)(ws + OFF_H) + (size_t)pm * 256 * 1024 * 2; u.B = (const char*)(ws + OFF_WT1) + (size_t)pn * 256 * 1024 * 2;
        if (pn < 20) { u.O = (char*)(seg + S1_P1) + ((size_t)pm * 256 * P1W + pn * 256) * 2; u.ldc = P1W; }
        else { u.O = (char*)(seg + S1_P2) + ((size_t)pm * 256 * P2W + (pn - 20) * 256) * 2; u.ldc = P2W; }
        return true;
    }
};
struct SchedOut {
    const char* Y; const char* W; char* slab; int G, c;
    __device__ __forceinline__ bool next(int i, pg8::Unit& u) const {
        const int L = i * G + c; if (L >= 256) return false;
        const int ks = L >> 6; int pm, pn; pg8::remap(L & 63, 16, 4, pm, pn);
        u.A = Y + ((size_t)pm * 256 * DIN + ks * 512) * 2; u.B = W + ((size_t)pn * 256 * DIN + ks * 512) * 2;
        u.O = slab + (((size_t)ks * MS + pm * 256) * DM + pn * 256) * 2; u.ldc = DM; return true;
    }
};

__device__ __forceinline__ void phase_a1(const P& p, const Ctx& c, int seg) {
    const bf16_t* P0 = (const bf16_t*)(c.seg + S0_P0);
    bf16_t* Qb = (bf16_t*)(c.seg + S0_Q); bf16_t* Kb = (bf16_t*)(c.seg + S0_K); bf16_t* KT = (bf16_t*)(c.seg + S0_KT); bf16_t* VT = (bf16_t*)(c.seg + S0_VT);
    bf16_t* XC = (bf16_t*)(c.seg + S0_XC); bf16_t* VF = (bf16_t*)(p.ws + OFF_VF);
    float* IPRE = (float*)(c.seg + S0_GATE); float* LOGF = IPRE + 32 * SEGT;
    const bf16_t* UT = (const bf16_t*)(p.ws + OFF_UTAIL);
    LAS float* red = (LAS float*)c.lds;
    LAS bf16_t* kst = (LAS bf16_t*)(c.lds + 98304);
    LAS bf16_t* vst = kst + 1536 * 8;
    const int n = c.tid;
    float wq[4][4], wk[4][4], wv[4][4], G12[4][8], G3[4][8];
    if (n < 384) {
#pragma unroll
        for (int i = 0; i < 4; ++i) { const f32x4 a = *(const f32x4*)(p.ml_wq + n * 16 + i * 4), bb = *(const f32x4*)(p.ml_wk + n * 16 + i * 4), cc = *(const f32x4*)(p.ml_wv + n * 16 + i * 4);
#pragma unroll
            for (int o = 0; o < 4; ++o) { wq[i][o] = a[o]; wk[i][o] = bb[o]; wv[i][o] = cc[o]; } }
#pragma unroll
        for (int i = 0; i < 4; ++i)
#pragma unroll
            for (int g = 0; g < 8; ++g) { G12[i][g] = 0.f; G3[i][g] = 0.f; }
#pragma unroll
        for (int o = 0; o < 4; ++o) {
            const float* gq = p.ml_w_gate + (size_t)(n * 4 + o) * 8; const float* gk = p.ml_w_gate + (size_t)(DMIX + n * 4 + o) * 8; const float* gv = p.ml_w_gate + (size_t)(2 * DMIX + n * 4 + o) * 8;
            const f32x4 q0 = *(const f32x4*)gq, q1 = *(const f32x4*)(gq + 4), k0 = *(const f32x4*)gk, k1 = *(const f32x4*)(gk + 4), v0 = *(const f32x4*)gv, v1 = *(const f32x4*)(gv + 4);
#pragma unroll
            for (int i = 0; i < 4; ++i)
#pragma unroll
                for (int g = 0; g < 4; ++g) { G12[i][g] += wq[i][o] * q0[g] + wk[i][o] * k0[g]; G12[i][g + 4] += wq[i][o] * q1[g] + wk[i][o] * k1[g];
                    G3[i][g] += wv[i][o] * v0[g]; G3[i][g + 4] += wv[i][o] * v1[g]; }
        }
    }
#pragma unroll 1
    for (int it = c.bid; it < MS / 8; it += c.G) {
        const int row0 = it * 8, b = row0 >> 9, tl0 = row0 & 511;
        __syncthreads();
        if (n < 384) {
            float um[3][4];
#pragma unroll
            for (int j = 1; j <= 3; ++j) { u32x2 raw = (u32x2){0u, 0u};
                if (tl0 - j >= 0) raw = *(const u32x2*)(P0 + (unsigned)((row0 - j) * ML_W + n * 4));
                else if (seg > 0) raw = *(const u32x2*)(UT + (unsigned)((b * 3 + (3 - j)) * DMIX + n * 4));
                um[3 - j][0] = bflo(raw.x); um[3 - j][1] = bfhi(raw.x); um[3 - j][2] = bflo(raw.y); um[3 - j][3] = bfhi(raw.y); }
            u32x2 nraw = *(const u32x2*)(P0 + (unsigned)(row0 * ML_W + n * 4));
#pragma unroll 1
            for (int tt = 0; tt < 8; ++tt) {
                const unsigned row = (unsigned)(row0 + tt);
                const u32x2 raw = nraw;
                if (tt + 1 < 8) nraw = *(const u32x2*)(P0 + (unsigned)((row + 1) * ML_W + n * 4));
                float u[4] = {bflo(raw.x), bfhi(raw.x), bflo(raw.y), bfhi(raw.y)}, xc[4], q[4], k[4], v[4];
                { int nn = n; asm volatile("" : "+v"(nn));
                  const f32x4 cb = *(const f32x4*)(p.ml_conv_b + nn * 4), c0 = *(const f32x4*)(p.ml_conv_w + nn * 4), c1 = *(const f32x4*)(p.ml_conv_w + DMIX + nn * 4),
                              c2 = *(const f32x4*)(p.ml_conv_w + 2 * DMIX + nn * 4), c3 = *(const f32x4*)(p.ml_conv_w + 3 * DMIX + nn * 4);
#pragma unroll
                  for (int i = 0; i < 4; ++i) { const float y = cb[i] + c0[i] * um[0][i] + c1[i] * um[1][i] + c2[i] * um[2][i] + c3[i] * u[i]; xc[i] = siluf_(y); } }
                const float ks = 0.05103103630798288f;
#pragma unroll
                for (int o = 0; o < 4; ++o) { q[o] = xc[0] * wq[0][o] + xc[1] * wq[1][o] + xc[2] * wq[2][o] + xc[3] * wq[3][o];
                    k[o] = (xc[0] * wk[0][o] + xc[1] * wk[1][o] + xc[2] * wk[2][o] + xc[3] * wk[3][o]) * ks;
                    v[o] = u[0] * wv[0][o] + u[1] * wv[1][o] + u[2] * wv[2][o] + u[3] * wv[3][o]; }
#pragma unroll
                for (int g = 0; g < 8; ++g) red[(tt * 8 + g) * 384 + n] = xc[0] * G12[0][g] + xc[1] * G12[1][g] + xc[2] * G12[2][g] + xc[3] * G12[3][g] + u[0] * G3[0][g] + u[1] * G3[1][g] + u[2] * G3[2][g] + u[3] * G3[3][g];
                u32x2 w; w.x = pk2(q[0], q[1]); w.y = pk2(q[2], q[3]); *(u32x2*)(Qb + (unsigned)(row * DMIX + n * 4)) = w;
                w.x = pk2(k[0], k[1]); w.y = pk2(k[2], k[3]); *(u32x2*)(Kb + (unsigned)(row * DMIX + n * 4)) = w;
                w.x = pk2(xc[0], xc[1]); w.y = pk2(xc[2], xc[3]); *(u32x2*)(XC + (unsigned)(row * DMIX + n * 4)) = w;
                w.x = pk2(v[0], v[1]); w.y = pk2(v[2], v[3]); *(u32x2*)(VF + (unsigned)(row * DMIX + n * 4)) = w;
#pragma unroll
                for (int o = 0; o < 4; ++o) { kst[(o * 384 + n) * 8 + tt] = f2bf(k[o]); vst[(o * 384 + n) * 8 + tt] = f2bf(v[o]); }
#pragma unroll
                for (int i = 0; i < 4; ++i) { um[0][i] = um[1][i]; um[1][i] = um[2][i]; um[2][i] = u[i]; }
            }
            const int hd = n / 96, dch = (n % 96) * 4;
#pragma unroll
            for (int o = 0; o < 4; ++o) { const unsigned off = (unsigned)(((b * 4 + hd) * 384 + dch + o) * SEGT + tl0);
                *(u32x4*)(KT + off) = *(const LAS u32x4*)(kst + (o * 384 + n) * 8); *(u32x4*)(VT + off) = *(const LAS u32x4*)(vst + (o * 384 + n) * 8); }
        }
        __syncthreads();
        { const int v = c.tid >> 3, part = c.tid & 7; float s = 0.f;
#pragma unroll 8
          for (int i = 0; i < 48; ++i) s += red[v * 384 + part * 48 + i];
          s += __shfl_xor(s, 1); s += __shfl_xor(s, 2); s += __shfl_xor(s, 4);
          if (part == 0) { const int tt = v >> 3, g = v & 7; const float gate = s + p.ml_b_gate[g];
              if (g < 4) IPRE[(b * 4 + g) * SEGT + tl0 + tt] = gate; else LOGF[(b * 4 + g - 4) * SEGT + tl0 + tt] = -softplusf_(-gate); } }
    }
}

__device__ __forceinline__ void attn_item(const P& p, const Ctx& c, int layer, int it, const bf16_t* Qp, int ldq, bf16_t* YM, int ldy, const bf16_t* Zp, int ldz) {
    const int b = it >> 3, head = (it >> 1) & 3, qb = it & 1;
    const bf16_t* Kg = (const bf16_t*)(p.ws + OFF_KMEM + (size_t)layer * 4 * MiB) + (size_t)(b * 256) * 512 + head * 128;
    const bf16_t* Vg = (const bf16_t*)(p.ws + OFF_KMEM + (size_t)layer * 4 * MiB + 2 * MiB) + (size_t)(head * 128) * 2048 + b * 256;
    LAS bf16_t* Ks = (LAS bf16_t*)c.lds;
    LAS bf16_t* Vs = Ks + 256 * 136;
    const int l15 = c.lane & 15, quad = c.lane >> 4;
    __syncthreads();
#pragma unroll
    for (int r = 0; r < 8; ++r) { const int id = c.tid + 512 * r; { const int i = id >> 4, c8 = (id & 15) * 8; *(LAS u32x4*)(Ks + i * 136 + c8) = *(const u32x4*)(Kg + (size_t)i * 512 + c8); }
        { const int i = id >> 5, c8 = (id & 31) * 8; *(LAS u32x4*)(Vs + i * 264 + c8) = *(const u32x4*)(Vg + (size_t)i * 2048 + c8); } }
    __syncthreads();
#pragma unroll 1
    for (int pass = 0; pass < 2; ++pass) {
        const int row0 = b * SEGT + qb * 256 + c.wv * 32 + pass * 16;
        bf16x8 qf[4];
#pragma unroll
        for (int kk = 0; kk < 4; ++kk) qf[kk] = *(const bf16x8*)(Qp + (size_t)(row0 + l15) * ldq + head * 128 + kk * 32 + quad * 8);
        f32x4 acc[16];
#pragma unroll
        for (int mt = 0; mt < 16; ++mt) { acc[mt] = (f32x4){0.f, 0.f, 0.f, 0.f};
#pragma unroll
            for (int kk = 0; kk < 4; ++kk) { const bf16x8 a = *(const LAS bf16x8*)(Ks + (mt * 16 + l15) * 136 + kk * 32 + quad * 8); acc[mt] = mfma16(a, qf[kk], acc[mt]); }
            if ((mt & 3) == 3) __builtin_amdgcn_sched_barrier(0); }
        float mx = -1e30f;
#pragma unroll
        for (int mt = 0; mt < 16; ++mt)
#pragma unroll
            for (int j = 0; j < 4; ++j) mx = fmaxf(mx, acc[mt][j]);
        mx = fmaxf(mx, __shfl_xor(mx, 16)); mx = fmaxf(mx, __shfl_xor(mx, 32));
        const float sc = 0.08838834764831845f * 1.4426950408889634f; float sm = 0.f;
#pragma unroll
        for (int mt = 0; mt < 16; ++mt)
#pragma unroll
            for (int j = 0; j < 4; ++j) { const float e = exp2f((acc[mt][j] - mx) * sc); acc[mt][j] = e; sm += e; }
        sm += __shfl_xor(sm, 16); sm += __shfl_xor(sm, 32);
        const float inv = frcp(sm);
        bf16x8 pa[8];
#pragma unroll
        for (int kp = 0; kp < 8; ++kp) {
            u32x4 aw; aw.x = pk2(acc[2 * kp][0] * inv, acc[2 * kp][1] * inv); aw.y = pk2(acc[2 * kp][2] * inv, acc[2 * kp][3] * inv);
            aw.z = pk2(acc[2 * kp + 1][0] * inv, acc[2 * kp + 1][1] * inv); aw.w = pk2(acc[2 * kp + 1][2] * inv, acc[2 * kp + 1][3] * inv);
            __builtin_memcpy(&pa[kp], &aw, 16); }
        __builtin_amdgcn_sched_barrier(0);
        f32x4 o[8];
#pragma unroll
        for (int nt = 0; nt < 8; ++nt) o[nt] = (f32x4){0.f, 0.f, 0.f, 0.f};
#pragma unroll
        for (int kp = 0; kp < 8; ++kp) {
            const bf16x8 a = pa[kp];
#pragma unroll
            for (int nt = 0; nt < 8; ++nt) { const LAS bf16_t* vp = Vs + (nt * 16 + l15) * 264 + 2 * kp * 16 + quad * 4;
                const u32x2 lo = *(const LAS u32x2*)vp, hi = *(const LAS u32x2*)(vp + 16); u32x4 bw = (u32x4){lo.x, lo.y, hi.x, hi.y}; bf16x8 bfr; __builtin_memcpy(&bfr, &bw, 16);
                o[nt] = mfma16(a, bfr, o[nt]); }
            __builtin_amdgcn_sched_barrier(0);
        }
#pragma unroll
        for (int nt = 0; nt < 8; ++nt)
#pragma unroll
            for (int j = 0; j < 4; ++j) { const size_t rr = (size_t)(row0 + quad * 4 + j); const int cc = head * 128 + nt * 16 + l15; float ov = o[nt][j];
                if (Zp) ov *= siluf_(bf2f(Zp[rr * ldz + cc]));
                YM[rr * ldy + cc] = f2bf(ov); }
    }
}

__device__ __forceinline__ void mlstm_item(const P& p, const Ctx& c, int seg, int w, bool save) {
    const int b = w / 24, h = (w / 6) & 3, sl = w % 6;
    const bf16_t* Qb = (const bf16_t*)(c.seg + S0_Q); const bf16_t* Kb = (const bf16_t*)(c.seg + S0_K); const bf16_t* KT = (const bf16_t*)(c.seg + S0_KT); const bf16_t* VT = (const bf16_t*)(c.seg + S0_VT);
    const float* IPRE = (const float*)(c.seg + S0_GATE); const float* LOGF = IPRE + 32 * SEGT;
    bf16_t* HR = (bf16_t*)(c.seg + S0_HRAW);
    float* CST = (float*)(p.ws + OFF_CST) + (size_t)w * 64 * 384; float* NST = (float*)(p.ws + OFF_NST) + (size_t)w * 384;
    LAS bf16_t* Cimg = (LAS bf16_t*)c.lds;
    LAS bf16_t* Qs = Cimg + 64 * 392;
    LAS bf16_t* Ks = Qs + 64 * 136;
    LAS bf16_t* KTs = Ks + 64 * 136;
    LAS bf16_t* VTs = KTs + 128 * 72;
    LAS bf16_t* VWs = VTs + 64 * 72;
    LAS bf16_t* Sp = VWs + 64 * 72;
    LAS float* fl = (LAS float*)(Sp + 64 * 72);
    LAS float* bcum = fl; LAS float* ipr = fl + 64; LAS float* wgt = fl + 128; LAS float* gin = fl + 192; LAS float* qn = fl + 256; LAS float* rden = fl + 320;
    LAS float* gtotp = fl + 384; LAS float* nold = fl + 400; LAS float* nnew = fl + 800;
    const int l15c = c.lane & 15, quadc = c.lane >> 4, e16 = c.wv & 3, par = c.wv >> 2;
    f32x4 C[12];
    __syncthreads();
    if (seg > 0) {
#pragma unroll
        for (int j = 0; j < 12; ++j)
#pragma unroll
            for (int jj = 0; jj < 4; ++jj) C[j][jj] = CST[(size_t)(e16 * 16 + quadc * 4 + jj) * 384 + (2 * j + par) * 16 + l15c];
        if (c.tid < 384) nold[c.tid] = NST[c.tid];
    } else {
#pragma unroll
        for (int j = 0; j < 12; ++j) C[j] = (f32x4){0.f, 0.f, 0.f, 0.f};
        if (c.tid < 384) nold[c.tid] = 0.f;
    }
    u32x4 pq[2], pk[2], pt[2], pvt; float plf = 0.f, pip = 0.f;
    auto gl_piece = [&](int ch, int pp, int tidv) {
#pragma unroll
        for (int r = 0; r < 2; ++r) { const int id = tidv + 512 * r;
            { const int i = id >> 4, c8 = (id & 15) * 8; const size_t go = ((size_t)b * SEGT + ch * 64 + i) * DMIX + h * 384 + pp * 128 + c8; pq[r] = *(const u32x4*)(Qb + go); pk[r] = *(const u32x4*)(Kb + go); }
            { const int dd = id >> 3, c8 = (id & 7) * 8; pt[r] = *(const u32x4*)(KT + ((size_t)(b * 4 + h) * 384 + pp * 128 + dd) * SEGT + ch * 64 + c8); } } };
    auto gl_chunk = [&](int ch, int tidv) { const int i = tidv >> 3, c8 = (tidv & 7) * 8;
        pvt = *(const u32x4*)(VT + ((size_t)(b * 4 + h) * 384 + sl * 64 + i) * SEGT + ch * 64 + c8);
        if (c.wv == 0) { plf = LOGF[(b * 4 + h) * SEGT + ch * 64 + c.lane]; pip = IPRE[(b * 4 + h) * SEGT + ch * 64 + c.lane]; } };
    { int t0 = c.tid; asm volatile("" : "+v"(t0)); gl_chunk(0, t0); gl_piece(0, 0, t0); }
#pragma unroll 1
    for (int ch = 0; ch < 8; ++ch) {
        const int tl0 = ch * 64; const size_t row0 = (size_t)b * SEGT + tl0;
        int tidv = c.tid, l15 = l15c, quad = quadc;
        asm volatile("" : "+v"(tidv), "+v"(l15), "+v"(quad));
        lds_barrier();
        if (c.wv == 0) {
            float bc = plf;
#pragma unroll
            for (int o = 1; o < 64; o <<= 1) { const float t = __shfl_up(bc, o); if (c.lane >= o) bc += t; }
            const float bl = __shfl(bc, 63);
            bcum[c.lane] = bc; ipr[c.lane] = pip; wgt[c.lane] = __expf(bl - bc + pip); gin[c.lane] = __expf(bc);
            if (c.lane == 0) gtotp[0] = __expf(bl);
        }
#pragma unroll
        for (int j = 0; j < 12; ++j)
#pragma unroll
            for (int jj = 0; jj < 4; ++jj) Cimg[(e16 * 16 + quad * 4 + jj) * 392 + (2 * j + par) * 16 + l15] = f2bf(C[j][jj]);
        lds_barrier();
        { const int i = tidv >> 3, c8 = (tidv & 7) * 8;
          const u32x4 raw = pvt;
          *(LAS u32x4*)(VTs + i * 72 + c8) = raw;
          const f32x4 w0 = *(const LAS f32x4*)(wgt + c8), w1 = *(const LAS f32x4*)(wgt + c8 + 4);
          u32x4 sw; sw.x = pk2(bflo(raw.x) * w0[0], bfhi(raw.x) * w0[1]); sw.y = pk2(bflo(raw.y) * w0[2], bfhi(raw.y) * w0[3]);
          sw.z = pk2(bflo(raw.z) * w1[0], bfhi(raw.z) * w1[1]); sw.w = pk2(bflo(raw.w) * w1[2], bfhi(raw.w) * w1[3]);
          *(LAS u32x4*)(VWs + i * 72 + c8) = sw; }
        if (ch + 1 < 8) gl_chunk(ch + 1, tidv);
        const float gtot = gtotp[0];
#pragma unroll
        for (int j = 0; j < 12; ++j) C[j] *= gtot;
        f32x4 Sa[2], Ia[2]; Sa[0] = Sa[1] = Ia[0] = Ia[1] = (f32x4){0.f, 0.f, 0.f, 0.f};
        float qnacc = 0.f;
#pragma unroll
        for (int pp = 0; pp < 3; ++pp) {
            const int d0 = pp * 128;
            __builtin_amdgcn_sched_barrier(0);
            asm volatile("" : "+v"(tidv));
            lds_barrier();
#pragma unroll
            for (int r = 0; r < 2; ++r) { const int id = tidv + 512 * r;
                { const int i = id >> 4, c8 = (id & 15) * 8; *(LAS u32x4*)(Qs + i * 136 + c8) = pq[r]; *(LAS u32x4*)(Ks + i * 136 + c8) = pk[r]; }
                { const int dd = id >> 3, c8 = (id & 7) * 8; *(LAS u32x4*)(KTs + dd * 72 + c8) = pt[r]; } }
            lds_barrier();
            if (pp < 2) gl_piece(ch, pp + 1, tidv); else if (ch + 1 < 8) gl_piece(ch + 1, 0, tidv);
            { const int tm = c.wv >> 1, tn0 = (c.wv & 1) * 2;
#pragma unroll
              for (int kk = 0; kk < 4; ++kk) { const bf16x8 a = *(const LAS bf16x8*)(Qs + (tm * 16 + l15) * 136 + kk * 32 + quad * 8);
#pragma unroll
                  for (int x = 0; x < 2; ++x) { const int tn = tn0 + x;
                      const bf16x8 bk = *(const LAS bf16x8*)(Ks + (tn * 16 + l15) * 136 + kk * 32 + quad * 8);
                      const bf16x8 bc = *(const LAS bf16x8*)(Cimg + (tn * 16 + l15) * 392 + d0 + kk * 32 + quad * 8);
                      Sa[x] = mfma16(a, bk, Sa[x]); Ia[x] = mfma16(a, bc, Ia[x]); } } }
            { const bf16x8 va0 = *(const LAS bf16x8*)(VWs + (e16 * 16 + l15) * 72 + quad * 8), va1 = *(const LAS bf16x8*)(VWs + (e16 * 16 + l15) * 72 + 32 + quad * 8);
#pragma unroll
              for (int jl = 0; jl < 4; ++jl) { const int ntl = 2 * jl + par, j = pp * 4 + jl;
                  C[j] = mfma16(va0, *(const LAS bf16x8*)(KTs + (ntl * 16 + l15) * 72 + quad * 8), C[j]);
                  C[j] = mfma16(va1, *(const LAS bf16x8*)(KTs + (ntl * 16 + l15) * 72 + 32 + quad * 8), C[j]); } }
            { const int t = tidv >> 3, part = tidv & 7;
              const u32x4 q0 = *(const LAS u32x4*)(Qs + t * 136 + part * 16), q1 = *(const LAS u32x4*)(Qs + t * 136 + part * 16 + 8);
              const LAS float* np = nold + d0 + part * 16; const f32x4 n0 = *(const LAS f32x4*)np, n1 = *(const LAS f32x4*)(np + 4), n2 = *(const LAS f32x4*)(np + 8), n3 = *(const LAS f32x4*)(np + 12);
              qnacc += bflo(q0.x) * n0[0] + bfhi(q0.x) * n0[1] + bflo(q0.y) * n0[2] + bfhi(q0.y) * n0[3] + bflo(q0.z) * n1[0] + bfhi(q0.z) * n1[1] + bflo(q0.w) * n1[2] + bfhi(q0.w) * n1[3]
                     + bflo(q1.x) * n2[0] + bfhi(q1.x) * n2[1] + bflo(q1.y) * n2[2] + bfhi(q1.y) * n2[3] + bflo(q1.z) * n3[0] + bfhi(q1.z) * n3[1] + bflo(q1.w) * n3[2] + bfhi(q1.w) * n3[3]; }
            { const int dd = tidv >> 2, part = tidv & 3;
              const u32x4 k0 = *(const LAS u32x4*)(KTs + dd * 72 + part * 16), k1 = *(const LAS u32x4*)(KTs + dd * 72 + part * 16 + 8);
              const LAS float* wp = wgt + part * 16; const f32x4 w0 = *(const LAS f32x4*)wp, w1 = *(const LAS f32x4*)(wp + 4), w2 = *(const LAS f32x4*)(wp + 8), w3 = *(const LAS f32x4*)(wp + 12);
              float a = bflo(k0.x) * w0[0] + bfhi(k0.x) * w0[1] + bflo(k0.y) * w0[2] + bfhi(k0.y) * w0[3] + bflo(k0.z) * w1[0] + bfhi(k0.z) * w1[1] + bflo(k0.w) * w1[2] + bfhi(k0.w) * w1[3]
                      + bflo(k1.x) * w2[0] + bfhi(k1.x) * w2[1] + bflo(k1.y) * w2[2] + bfhi(k1.y) * w2[3] + bflo(k1.z) * w3[0] + bfhi(k1.z) * w3[1] + bflo(k1.w) * w3[2] + bfhi(k1.w) * w3[3];
              a = dpp_add<0xB1>(a); a = dpp_add<0x4E>(a);
              if (part == 0) nnew[d0 + dd] = gtot * nold[d0 + dd] + a; }
        }
        qnacc = dpp_add<0xB1>(qnacc); qnacc = dpp_add<0x4E>(qnacc); qnacc = dpp_add<0x141>(qnacc);
        if ((tidv & 7) == 0) qn[tidv >> 3] = qnacc;
#pragma unroll
        for (int x = 0; x < 2; ++x) { const int ti = c.wv * 2 + x, tm = ti >> 2, tn = ti & 3; const int s = tn * 16 + l15; const float bs = bcum[s] - ipr[s];
#pragma unroll
            for (int jj = 0; jj < 4; ++jj) { const int t = tm * 16 + quad * 4 + jj; const float v = (s <= t) ? Sa[x][jj] * __expf(bcum[t] - bs) : 0.f; Sp[t * 72 + s] = f2bf(v); } }
        lds_barrier();
        { const int t = tidv >> 3, part = tidv & 7; const u32x4 sr = *(const LAS u32x4*)(Sp + t * 72 + part * 8);
          float ds = bflo(sr.x) + bfhi(sr.x) + bflo(sr.y) + bfhi(sr.y) + bflo(sr.z) + bfhi(sr.z) + bflo(sr.w) + bfhi(sr.w);
          ds = dpp_add<0xB1>(ds); ds = dpp_add<0x4E>(ds); ds = dpp_add<0x141>(ds);
          if (part == 0) { const float den = ds + gin[t] * qn[t]; rden[t] = frcp(fmaxf(fabsf(den), 1.0f)); } }
#pragma unroll
        for (int x = 0; x < 2; ++x) { const int ti = c.wv * 2 + x, tm = ti >> 2, tn = ti & 3;
#pragma unroll
            for (int jj = 0; jj < 4; ++jj) Ia[x][jj] *= gin[tm * 16 + quad * 4 + jj];
#pragma unroll
            for (int kk = 0; kk < 2; ++kk) { const bf16x8 a = *(const LAS bf16x8*)(Sp + (tm * 16 + l15) * 72 + kk * 32 + quad * 8);
                const bf16x8 bb = *(const LAS bf16x8*)(VTs + (tn * 16 + l15) * 72 + kk * 32 + quad * 8); Ia[x] = mfma16(a, bb, Ia[x]); } }
        lds_barrier();
#pragma unroll
        for (int x = 0; x < 2; ++x) { const int ti = c.wv * 2 + x, tm = ti >> 2, tn = ti & 3;
#pragma unroll
            for (int jj = 0; jj < 4; ++jj) { const int t = tm * 16 + quad * 4 + jj; HR[(row0 + t) * DMIX + h * 384 + sl * 64 + tn * 16 + l15] = f2bf(Ia[x][jj] * rden[t]); } }
        if (c.tid < 384) nold[c.tid] = nnew[c.tid];
    }
    lds_barrier();
    if (!save) return;
#pragma unroll
    for (int j = 0; j < 12; ++j)
#pragma unroll
        for (int jj = 0; jj < 4; ++jj) CST[(size_t)(e16 * 16 + quadc * 4 + jj) * 384 + (2 * j + par) * 16 + l15c] = C[j][jj];
    if (c.tid < 384) NST[c.tid] = nold[c.tid];
}

__device__ __forceinline__ void phase_a3(const P& p, const Ctx& c, int seg) {
    const bf16_t* P0 = (const bf16_t*)(c.seg + S0_P0); const bf16_t* HR = (const bf16_t*)(c.seg + S0_HRAW); const bf16_t* XC = (const bf16_t*)(c.seg + S0_XC);
    const bf16_t* YM = (const bf16_t*)(c.seg + S0_YMEM); bf16_t* Y = (bf16_t*)(c.seg + S0_Y); bf16_t* UT = (bf16_t*)(p.ws + OFF_UTAIL);
#pragma unroll 1
    for (int r = c.bid * 8 + c.wv; r < MS; r += c.G * 8) {
        const int b = r >> 9, tl = r & 511;
        float v[3][8]; float mean[3], rstd[3];
#pragma unroll
        for (int ps = 0; ps < 3; ++ps) { const int ch = ps * 512 + c.lane * 8;
            const u32x4 hr = *(const u32x4*)(HR + (size_t)r * DMIX + ch);
            v[ps][0] = bflo(hr.x); v[ps][1] = bfhi(hr.x); v[ps][2] = bflo(hr.y); v[ps][3] = bfhi(hr.y); v[ps][4] = bflo(hr.z); v[ps][5] = bfhi(hr.z); v[ps][6] = bflo(hr.w); v[ps][7] = bfhi(hr.w); }
        float hs[4], hq[4];
#pragma unroll
        for (int hd = 0; hd < 4; ++hd) { float s = 0.f, q = 0.f;
#pragma unroll
            for (int ps = 0; ps < 3; ++ps) { if (ps * 512 + 511 < hd * 384 || ps * 512 >= (hd + 1) * 384) continue;
                const bool mine = ((ps * 512 + c.lane * 8) / 384) == hd;
                float ls = 0.f, lq = 0.f;
#pragma unroll
                for (int j = 0; j < 8; ++j) { ls += v[ps][j]; lq += v[ps][j] * v[ps][j]; }
                s += mine ? ls : 0.f; q += mine ? lq : 0.f; }
            hs[hd] = wsum(s); hq[hd] = wsum(q); }
#pragma unroll
        for (int ps = 0; ps < 3; ++ps) { const int hd = (ps * 512 + c.lane * 8) / 384;
            const float s = hd == 0 ? hs[0] : (hd == 1 ? hs[1] : (hd == 2 ? hs[2] : hs[3])), q = hd == 0 ? hq[0] : (hd == 1 ? hq[1] : (hd == 2 ? hq[2] : hq[3]));
            const float m = s * (1.0f / 384.0f); mean[ps] = m; rstd[ps] = rsqrtf(fmaxf(q * (1.0f / 384.0f) - m * m, 0.f) + 1e-5f); }
#pragma unroll
        for (int ps = 0; ps < 3; ++ps) { const int ch = ps * 512 + c.lane * 8;
            const u32x4 xr = *(const u32x4*)(XC + (size_t)r * DMIX + ch), zr = *(const u32x4*)(P0 + (size_t)r * ML_W + 2048 + ch);
            const f32x4 g0 = *(const f32x4*)(p.ml_mhn_g + ch), g1 = *(const f32x4*)(p.ml_mhn_g + ch + 4), k0 = *(const f32x4*)(p.ml_skip + ch), k1 = *(const f32x4*)(p.ml_skip + ch + 4);
            const float xx[8] = {bflo(xr.x), bfhi(xr.x), bflo(xr.y), bfhi(xr.y), bflo(xr.z), bfhi(xr.z), bflo(xr.w), bfhi(xr.w)};
            const float zz[8] = {bflo(zr.x), bfhi(zr.x), bflo(zr.y), bfhi(zr.y), bflo(zr.z), bfhi(zr.z), bflo(zr.w), bfhi(zr.w)};
            const float gg[8] = {g0[0], g0[1], g0[2], g0[3], g1[0], g1[1], g1[2], g1[3]}, kk[8] = {k0[0], k0[1], k0[2], k0[3], k1[0], k1[1], k1[2], k1[3]};
            float y[8];
#pragma unroll
            for (int j = 0; j < 8; ++j) y[j] = ((v[ps][j] - mean[ps]) * rstd[ps] * gg[j] + kk[j] * xx[j]) * siluf_(zz[j]);
            *(u32x4*)(Y + (size_t)r * DIN + ch) = (u32x4){pk2(y[0], y[1]), pk2(y[2], y[3]), pk2(y[4], y[5]), pk2(y[6], y[7])}; }
        { const int cm = c.lane * 8; const u32x4 mr = *(const u32x4*)(YM + (size_t)r * DX + cm), zr = *(const u32x4*)(P0 + (size_t)r * ML_W + 2048 + DMIX + cm);
          const float mm[8] = {bflo(mr.x), bfhi(mr.x), bflo(mr.y), bfhi(mr.y), bflo(mr.z), bfhi(mr.z), bflo(mr.w), bfhi(mr.w)};
          const float zz[8] = {bflo(zr.x), bfhi(zr.x), bflo(zr.y), bfhi(zr.y), bflo(zr.z), bfhi(zr.z), bflo(zr.w), bfhi(zr.w)};
          float y[8];
#pragma unroll
          for (int j = 0; j < 8; ++j) y[j] = mm[j] * siluf_(zz[j]);
          *(u32x4*)(Y + (size_t)r * DIN + DMIX + cm) = (u32x4){pk2(y[0], y[1]), pk2(y[2], y[3]), pk2(y[4], y[5]), pk2(y[6], y[7])}; }
        if (tl >= 509) {
#pragma unroll
            for (int ps = 0; ps < 3; ++ps) { const int ch = ps * 512 + c.lane * 8; *(u32x4*)(UT + (size_t)(b * 3 + tl - 509) * DMIX + ch) = *(const u32x4*)(P0 + (size_t)r * ML_W + ch); } }
    }
}

__device__ __forceinline__ void phase_b1(const P& p, const Ctx& c, int seg) {
    const bf16_t* P1 = (const bf16_t*)(c.seg + S1_P1);
    float* GTB = (float*)(c.seg + S1_W); bf16_t* SA = (bf16_t*)(c.seg + S1_A); bf16_t* SB = (bf16_t*)(c.seg + S1_B); bf16_t* SK = (bf16_t*)(c.seg + S1_K);
    bf16_t* SQ = (bf16_t*)(c.seg + S1_Q); bf16_t* SV = (bf16_t*)(c.seg + S1_V); bf16_t* SG = (bf16_t*)(c.seg + S1_G); float* BRKR = (float*)(c.seg + S1_BRKR);
    const bf16_t* VF = (const bf16_t*)(p.ws + OFF_VF); const bf16_t* LT = (const bf16_t*)(p.ws + OFF_LORAT);
    const bf16_t* PTr = (const bf16_t*)(p.ws + OFF_PTAIL) + (size_t)(seg & 1) * NB * RW_SHIFT; bf16_t* PTw = (bf16_t*)(p.ws + OFF_PTAIL) + (size_t)((seg + 1) & 1) * NB * RW_SHIFT;
    LAS bf16_t* XA = (LAS bf16_t*)c.lds;
    const int l15 = c.lane & 15, quad = c.lane >> 4;
    for (int it = c.bid; it < MS / 16; it += c.G) {
        const int r0 = it * 16, b = r0 >> 9, tl0 = r0 & 511;
        __syncthreads();
        for (int e = c.tid; e < 16 * 288; e += 512) { const int row = e / 288, cc = e % 288, col = 4608 + cc;
            const float cur = bf2f(P1[(size_t)(r0 + row) * P1W + col]);
            float prev = 0.f; if (tl0 + row > 0) prev = bf2f(P1[(size_t)(r0 + row - 1) * P1W + col]); else if (seg > 0) prev = bf2f(PTr[(size_t)b * RW_SHIFT + col]);
            const float pv = cur + p.rw_mu[col] * (prev - cur);
            const float f = cc < 64 ? (1.0f - 2.0f / (1.0f + __expf(2.0f * pv)))   : (cc < 160 ? pv : sigmoidf_(pv));
            XA[row * 296 + cc] = f2bf(f); }
        __syncthreads();
        const size_t row = (size_t)r0 + l15; const int tl = tl0 + l15;
        const bf16_t* curp = P1 + row * P1W; const bf16_t* prevp = (tl > 0) ? (P1 + (row - 1) * P1W) : (PTr + (size_t)b * RW_SHIFT); const bool hasprev = (tl > 0) || (seg > 0);
        struct TileIn { u32x4 cr, ck, cv, pr, pk, pv, vf; };
        struct TilePar { f32x4 m0, m1, m2, w0, a0, v0, kkw, kaw, rk; };
#pragma unroll 1
        for (int x = 0; x < 3; ++x) {
            int hh = c.wv * 3 + x; asm volatile("" : "+s"(hh));
            auto load_tile = [&](int ct, TileIn& T) { const int cc = hh * 64 + (ct >> 1) * 32 + quad * 8;
                T.cr = *(const u32x4*)(curp + cc); T.ck = *(const u32x4*)(curp + DMIX + cc); T.cv = *(const u32x4*)(curp + 2 * DMIX + cc);
                T.pr = (u32x4){0u, 0u, 0u, 0u}; T.pk = T.pr; T.pv = T.pr;
                if (hasprev) { T.pr = *(const u32x4*)(prevp + cc); T.pk = *(const u32x4*)(prevp + DMIX + cc); T.pv = *(const u32x4*)(prevp + 2 * DMIX + cc); }
                T.vf = *(const u32x4*)(VF + row * DMIX + cc); };
            TileIn TA;
            load_tile(0, TA);
            float inv;
            { u32x2 kcur[4], kprv[4]; f32x4 km[4], kw[4];
#pragma unroll
              for (int ct = 0; ct < 4; ++ct) { const int cc = hh * 64 + (ct >> 1) * 32 + quad * 8 + 4 * (ct & 1);
                  kcur[ct] = *(const u32x2*)(curp + DMIX + cc); kprv[ct] = (u32x2){0u, 0u}; if (hasprev) kprv[ct] = *(const u32x2*)(prevp + DMIX + cc);
                  km[ct] = *(const f32x4*)(p.rw_mu + DMIX + cc); kw[ct] = *(const f32x4*)(p.rw_k_k + cc); }
              float ss = 0.f;
#pragma unroll
              for (int ct = 0; ct < 4; ++ct) {
                  const float cb[4] = {bflo(kcur[ct].x), bfhi(kcur[ct].x), bflo(kcur[ct].y), bfhi(kcur[ct].y)}, qb[4] = {bflo(kprv[ct].x), bfhi(kprv[ct].x), bflo(kprv[ct].y), bfhi(kprv[ct].y)};
#pragma unroll
                  for (int j = 0; j < 4; ++j) { const float kr = (cb[j] + km[ct][j] * (qb[j] - cb[j])) * kw[ct][j]; ss += kr * kr; } }
              ss += __shfl_xor(ss, 16); ss += __shfl_xor(ss, 32);
              inv = frcp(fmaxf(sqrtf(ss), 1e-12f)); }
            float br = 0.f, kr = 0.f, rkr = 0.f;
            u32x2 st_g, st_a, st_b, st_k, st_q, st_v;
            auto do_tile = [&](int ct, const TileIn& TI) { const int cc = hh * 64 + (ct >> 1) * 32 + quad * 8 + 4 * (ct & 1);
                TilePar T; T.m0 = *(const f32x4*)(p.rw_mu + cc); T.m1 = *(const f32x4*)(p.rw_mu + DMIX + cc); T.m2 = *(const f32x4*)(p.rw_mu + 2 * DMIX + cc);
                T.w0 = *(const f32x4*)(p.rw_w0 + cc); T.a0 = *(const f32x4*)(p.rw_a0 + cc); T.v0 = *(const f32x4*)(p.rw_v0 + cc); T.kkw = *(const f32x4*)(p.rw_k_k + cc); T.kaw = *(const f32x4*)(p.rw_k_a + cc);
                T.rk = *(const f32x4*)(p.rw_r_k + cc);
                bf16x8 lt[9]; { const bf16_t* lrow = LT + (size_t)(hh * 64 + (ct >> 1) * 32 + 8 * (l15 >> 2) + 4 * (ct & 1) + (l15 & 3)) * 288 + quad * 8;
#pragma unroll
                    for (int k = 0; k < 9; ++k) lt[k] = *(const bf16x8*)(lrow + k * 32); }
                bf16x8 xf[9];
#pragma unroll
                for (int k = 0; k < 9; ++k) xf[k] = *(const LAS bf16x8*)(XA + l15 * 296 + k * 32 + quad * 8);
                f32x4 dw = (f32x4){0.f, 0.f, 0.f, 0.f}, da = dw, dv = dw, dg = dw;
#pragma unroll
                for (int k = 0; k < 2; ++k) dw = mfma16(lt[k], xf[k], dw);
#pragma unroll
                for (int k = 0; k < 2; ++k) da = mfma16(lt[2 + k], xf[2 + k], da);
                dv = mfma16(lt[4], xf[4], dv);
#pragma unroll
                for (int k = 0; k < 4; ++k) dg = mfma16(lt[5 + k], xf[5 + k], dg);
                const bool od = (ct & 1) != 0;
                const unsigned r0 = od ? TI.cr.z : TI.cr.x, r1 = od ? TI.cr.w : TI.cr.y, k0 = od ? TI.ck.z : TI.ck.x, k1 = od ? TI.ck.w : TI.ck.y, c0 = od ? TI.cv.z : TI.cv.x, c1 = od ? TI.cv.w : TI.cv.y;
                const unsigned p0 = od ? TI.pr.z : TI.pr.x, p1 = od ? TI.pr.w : TI.pr.y, q0 = od ? TI.pk.z : TI.pk.x, q1 = od ? TI.pk.w : TI.pk.y, d0 = od ? TI.pv.z : TI.pv.x, d1 = od ? TI.pv.w : TI.pv.y;
                const unsigned f0 = od ? TI.vf.z : TI.vf.x, f1 = od ? TI.vf.w : TI.vf.y;
                const float ca[4] = {bflo(r0), bfhi(r0), bflo(r1), bfhi(r1)}, cb[4] = {bflo(k0), bfhi(k0), bflo(k1), bfhi(k1)}, cd[4] = {bflo(c0), bfhi(c0), bflo(c1), bfhi(c1)};
                const float qa[4] = {bflo(p0), bfhi(p0), bflo(p1), bfhi(p1)}, qb[4] = {bflo(q0), bfhi(q0), bflo(q1), bfhi(q1)}, qd[4] = {bflo(d0), bfhi(d0), bflo(d1), bfhi(d1)};
                const float vf[4] = {bflo(f0), bfhi(f0), bflo(f1), bfhi(f1)};
                u32x2 gw; gw.x = pk2(dg[0], dg[1]); gw.y = pk2(dg[2], dg[3]);
                float wv4[4], av[4], bv[4], ktv[4], qv[4], vv[4];
#pragma unroll
                for (int j = 0; j < 4; ++j) {
                    const float rc = ca[j] + T.m0[j] * (qa[j] - ca[j]), kc = cb[j] + T.m1[j] * (qb[j] - cb[j]), vc = cd[j] + T.m2[j] * (qd[j] - cd[j]);
                    const float zz = -(T.w0[j] + dw[j]); const float sp = fmaxf(zz, 0.f) + __logf(1.0f + __expf(-fabsf(zz)));
                    wv4[j] = __expf(-__expf(-sp - 0.5f));
                    const float a = sigmoidf_(T.a0[j] + da[j]);
                    vv[j] = vc + (vf[j] - vc) * sigmoidf_(T.v0[j] + dv[j]);
                    const float kk = kc * T.kkw[j] * inv; av[j] = -kk; bv[j] = kk * a;
                    ktv[j] = kc * (1.0f + (a - 1.0f) * T.kaw[j]); qv[j] = rc;
                    br += bv[j] * rc; kr += ktv[j] * rc; rkr += rc * ktv[j] * T.rk[j]; }
                float gfin[4];
#pragma unroll
                for (int j = 0; j < 4; ++j) { float g = wv4[j];
                    g *= dpp_shr_or1<1>(g); g *= dpp_shr_or1<2>(g); g *= dpp_shr_or1<4>(g); g *= dpp_shr_or1<8>(g);
                    const float gp = dpp_shr_or1<1>(g), ig = frcp(g);
                    av[j] *= gp; qv[j] *= g; bv[j] *= ig; ktv[j] *= ig; gfin[j] = g; }
                if (l15 == 15) *(f32x4*)(GTB + ((size_t)it * 24 + hh) * 64 + (cc - hh * 64)) = (f32x4){gfin[0], gfin[1], gfin[2], gfin[3]};
                const u32x2 ta = (u32x2){pk2(av[0], av[1]), pk2(av[2], av[3])}, tb = (u32x2){pk2(bv[0], bv[1]), pk2(bv[2], bv[3])}, tk = (u32x2){pk2(ktv[0], ktv[1]), pk2(ktv[2], ktv[3])};
                const u32x2 tq = (u32x2){pk2(qv[0], qv[1]), pk2(qv[2], qv[3])}, tv = (u32x2){pk2(vv[0], vv[1]), pk2(vv[2], vv[3])};
                if ((ct & 1) == 0) { st_g = gw; st_a = ta; st_b = tb; st_k = tk; st_q = tq; st_v = tv; }
                else { const size_t o8 = row * DMIX + cc - 4;
                    *(u32x4*)(SG + o8) = (u32x4){st_g.x, st_g.y, gw.x, gw.y}; *(u32x4*)(SA + o8) = (u32x4){st_a.x, st_a.y, ta.x, ta.y}; *(u32x4*)(SB + o8) = (u32x4){st_b.x, st_b.y, tb.x, tb.y};
                    *(u32x4*)(SK + o8) = (u32x4){st_k.x, st_k.y, tk.x, tk.y}; *(u32x4*)(SQ + o8) = (u32x4){st_q.x, st_q.y, tq.x, tq.y}; *(u32x4*)(SV + o8) = (u32x4){st_v.x, st_v.y, tv.x, tv.y}; } };
            do_tile(0, TA); __builtin_amdgcn_sched_barrier(0);
            do_tile(1, TA); __builtin_amdgcn_sched_barrier(0);
            load_tile(2, TA); do_tile(2, TA); __builtin_amdgcn_sched_barrier(0);
            do_tile(3, TA);
            br += __shfl_xor(br, 16); br += __shfl_xor(br, 32); kr += __shfl_xor(kr, 16); kr += __shfl_xor(kr, 32); rkr += __shfl_xor(rkr, 16); rkr += __shfl_xor(rkr, 32);
            if (quad == 0) *(f32x4*)(BRKR + (row * 24 + hh) * 4) = (f32x4){br, kr, rkr, 0.f};
        }
        if (tl0 == 496) { for (int e = c.tid; e < RW_SHIFT; e += 512) PTw[(size_t)b * RW_SHIFT + e] = P1[(size_t)(r0 + 15) * P1W + e]; }
    }
}

__device__ __forceinline__ void rwkv_item(const P& p, const Ctx& c, int seg, int w, bool save) {
    const int b = w / 24, hh = w % 24;
    const float* SW = (const float*)(c.seg + S1_W); const bf16_t* SA = (const bf16_t*)(c.seg + S1_A); const bf16_t* SB = (const bf16_t*)(c.seg + S1_B); const bf16_t* SK = (const bf16_t*)(c.seg + S1_K);
    const bf16_t* SQ = (const bf16_t*)(c.seg + S1_Q); const bf16_t* SV = (const bf16_t*)(c.seg + S1_V); const float* BRKR = (const float*)(c.seg + S1_BRKR);
    float* O = (float*)(c.seg + S1_O); float* RST = (float*)(p.ws + OFF_RST) + (size_t)w * 4096;
    constexpr int TB = 32, REC = 388;
    LAS float* L0 = (LAS float*)c.lds;
    const int rp = c.wv * 4 + (c.lane >> 4), cq = c.lane & 15;
    f32x2 S0a, S0b, S1a, S1b;
    if (seg > 0) { const f32x4 s0 = *(const f32x4*)(RST + (2 * rp) * 64 + cq * 4), s1 = *(const f32x4*)(RST + (2 * rp + 1) * 64 + cq * 4);
        S0a = (f32x2){s0[0], s0[1]}; S0b = (f32x2){s0[2], s0[3]}; S1a = (f32x2){s1[0], s1[1]}; S1b = (f32x2){s1[2], s1[3]}; }
    else { S0a = S0b = S1a = S1b = (f32x2){0.f, 0.f}; }
    const int e4 = c.tid * 4, stt = e4 >> 6, scc = e4 & 63;
    f32x4 gw; u32x2 ga, gb, gk, gq, gv; f32x4 gbr;
    auto gload = [&](int blk) { const size_t go = ((size_t)b * SEGT + blk * TB + stt) * DMIX + hh * 64 + scc;
        gw = *(const f32x4*)(SW + go); ga = *(const u32x2*)(SA + go); gb = *(const u32x2*)(SB + go); gk = *(const u32x2*)(SK + go); gq = *(const u32x2*)(SQ + go); gv = *(const u32x2*)(SV + go);
        if (c.tid < TB) gbr = *(const f32x4*)(BRKR + (((size_t)b * SEGT + blk * TB + c.tid) * 24 + hh) * 4); };
    auto lstore = [&](int buf) { LAS float* r = L0 + buf * (TB * REC) + stt * REC + scc;
        *(LAS f32x4*)(r) = gw; *(LAS f32x4*)(r + 64) = (f32x4){bflo(ga.x), bfhi(ga.x), bflo(ga.y), bfhi(ga.y)}; *(LAS f32x4*)(r + 128) = (f32x4){bflo(gb.x), bfhi(gb.x), bflo(gb.y), bfhi(gb.y)};
        *(LAS f32x4*)(r + 192) = (f32x4){bflo(gk.x), bfhi(gk.x), bflo(gk.y), bfhi(gk.y)}; *(LAS f32x4*)(r + 256) = (f32x4){bflo(gq.x), bfhi(gq.x), bflo(gq.y), bfhi(gq.y)};
        *(LAS f32x4*)(r + 320) = (f32x4){bflo(gv.x), bfhi(gv.x), bflo(gv.y), bfhi(gv.y)};
        if (c.tid < TB) { LAS float* q = L0 + buf * (TB * REC) + c.tid * REC + 384; *(LAS f32x2*)q = (f32x2){gbr[0], gbr[1]}; } };
    __syncthreads();
    gload(0); lstore(0);
    __syncthreads();
#pragma unroll 1
    for (int blk = 0; blk < SEGT / TB; ++blk) {
        const int buf = blk & 1;
        if (blk + 1 < SEGT / TB) gload(blk + 1);
        const LAS float* base = L0 + buf * (TB * REC);
        const size_t rowb = (size_t)b * SEGT + blk * TB;
        f32x4 nw4 = *(const LAS f32x4*)(base + cq * 4), na4 = *(const LAS f32x4*)(base + 64 + cq * 4), nb4 = *(const LAS f32x4*)(base + 128 + cq * 4), nk4 = *(const LAS f32x4*)(base + 192 + cq * 4), nq4 = *(const LAS f32x4*)(base + 256 + cq * 4);
        f32x2 nv2 = *(const LAS f32x2*)(base + 320 + 2 * rp), nbk = *(const LAS f32x2*)(base + 384);
#pragma unroll 2
        for (int tt = 0; tt < TB; ++tt) {
            const f32x4 w4 = nw4, a4 = na4, b4 = nb4, k4 = nk4, q4 = nq4; const f32x2 v2 = nv2, bk = nbk;
            { const LAS float* r = base + (tt + 1 < TB ? tt + 1 : tt) * REC;
              nw4 = *(const LAS f32x4*)(r + cq * 4); na4 = *(const LAS f32x4*)(r + 64 + cq * 4); nb4 = *(const LAS f32x4*)(r + 128 + cq * 4); nk4 = *(const LAS f32x4*)(r + 192 + cq * 4); nq4 = *(const LAS f32x4*)(r + 256 + cq * 4);
              nv2 = *(const LAS f32x2*)(r + 320 + 2 * rp); nbk = *(const LAS f32x2*)(r + 384); }
            const f32x2 wa = (f32x2){w4[0], w4[1]}, wb = (f32x2){w4[2], w4[3]}, aa = (f32x2){a4[0], a4[1]}, ab = (f32x2){a4[2], a4[3]}, ba = (f32x2){b4[0], b4[1]}, bb = (f32x2){b4[2], b4[3]};
            const f32x2 ka = (f32x2){k4[0], k4[1]}, kb = (f32x2){k4[2], k4[3]}, qa = (f32x2){q4[0], q4[1]}, qb = (f32x2){q4[2], q4[3]};
            f32x2 t0 = S0a * aa + S0b * ab, t1 = S0a * qa + S0b * qb, t2 = S1a * aa + S1b * ab, t3 = S1a * qa + S1b * qb;
            float pa0 = t0.x + t0.y, pt0 = t1.x + t1.y, pa1 = t2.x + t2.y, pt1 = t3.x + t3.y;
            row16_allsum4(pa0, pa1, pt0, pt1);
            const f32x2 pa0v = (f32x2){pa0, pa0}, pa1v = (f32x2){pa1, pa1}, v0v = (f32x2){v2.x, v2.x}, v1v = (f32x2){v2.y, v2.y};
            S0a = S0a * wa + pa0v * ba + v0v * ka; S0b = S0b * wb + pa0v * bb + v0v * kb;
            S1a = S1a * wa + pa1v * ba + v1v * ka; S1b = S1b * wb + pa1v * bb + v1v * kb;
            if (cq == 0) { const f32x2 y = (f32x2){pt0 + pa0 * bk.x + v2.x * bk.y, pt1 + pa1 * bk.x + v2.y * bk.y};
                *(f32x2*)(O + (rowb + tt) * DMIX + hh * 64 + 2 * rp) = y; }
        }
        if (blk + 1 < SEGT / TB) lstore(buf ^ 1);
        __syncthreads();
    }
    if (!save) return;
    *(f32x4*)(RST + (2 * rp) * 64 + cq * 4) = (f32x4){S0a.x, S0a.y, S0b.x, S0b.y}; *(f32x4*)(RST + (2 * rp + 1) * 64 + cq * 4) = (f32x4){S1a.x, S1a.y, S1b.x, S1b.y};
}

__device__ __forceinline__ void rwkv_chunk_item(const P& p, const Ctx& c, int seg, int w, bool save) {
    const int b = w / 24, hh = w % 24;
    const bf16_t* SA = (const bf16_t*)(c.seg + S1_A); const bf16_t* SB = (const bf16_t*)(c.seg + S1_B); const bf16_t* SK = (const bf16_t*)(c.seg + S1_K);
    const bf16_t* SR = (const bf16_t*)(c.seg + S1_Q); const bf16_t* SV = (const bf16_t*)(c.seg + S1_V); const float* GTB = (const float*)(c.seg + S1_W);
    bf16_t* Y = (bf16_t*)(c.seg + S1_Y); const bf16_t* SG = (const bf16_t*)(c.seg + S1_G); const bf16_t* P2 = (const bf16_t*)(c.seg + S1_P2); const float* BRKR = (const float*)(c.seg + S1_BRKR); float* RST = (float*)(p.ws + OFF_RST) + (size_t)w * 4096;
    constexpr int O_EA = 0  , O_EB = 4608  , O_EBT = 9216  , O_UV = 14336  ,
                  O_MT1 = 19456  , O_NT = 20736  , O_MABT = 22016  ,
                  O_GT = 23296  , OPB = 23552;
    LAS unsigned char* OB = c.lds;
    LAS bf16_t* S0I = (LAS bf16_t*)(c.lds + 2 * OPB);
    LAS float* XF = (LAS float*)(c.lds + 2 * OPB + 9216);
    LAS float* YB = (LAS float*)(c.lds + 2 * OPB + 9216 + 4352);
    const int l15c = c.lane & 15, quadc = c.lane >> 4;
    f32x4 S[2];
#pragma unroll
    for (int x = 0; x < 2; ++x) { const int ti = c.wv * 2 + x, mt = ti >> 2, nt = ti & 3;
#pragma unroll
        for (int jj = 0; jj < 4; ++jj) S[x][jj] = (seg > 0) ? RST[(mt * 16 + quadc * 4 + jj) * 64 + nt * 16 + l15c] : 0.f; }
    unsigned ga = 0, gb = 0, gk = 0, gr = 0, gv = 0; float gg = 1.f;
    auto gload = [&](int ch, int tidv) { const int t = tidv >> 5, j0 = (tidv & 31) * 2; const size_t go = ((size_t)b * SEGT + ch * 16 + t) * DMIX + hh * 64 + j0;
        ga = *(const unsigned*)(SA + go); gb = *(const unsigned*)(SB + go); gk = *(const unsigned*)(SK + go); gr = *(const unsigned*)(SR + go); gv = *(const unsigned*)(SV + go);
        if (tidv < 64) gg = GTB[((size_t)(b * 32 + ch) * 24 + hh) * 64 + tidv]; };
    auto lstore = [&](int pb, int tidv) { const int t = tidv >> 5, j0 = (tidv & 31) * 2;
        LAS bf16_t* EA = (LAS bf16_t*)(OB + pb * OPB + O_EA); LAS bf16_t* EB = (LAS bf16_t*)(OB + pb * OPB + O_EB); LAS bf16_t* EBT = (LAS bf16_t*)(OB + pb * OPB + O_EBT);
        LAS bf16_t* UV = (LAS bf16_t*)(OB + pb * OPB + O_UV); LAS float* GT = (LAS float*)(OB + pb * OPB + O_GT);
        *(LAS unsigned*)(EA + t * 72 + j0) = ga; *(LAS unsigned*)(EA + (16 + t) * 72 + j0) = gr;
        *(LAS unsigned*)(EB + t * 72 + j0) = gb; *(LAS unsigned*)(EB + (16 + t) * 72 + j0) = gk;
        EBT[j0 * 40 + t] = (bf16_t)(gb & 0xFFFFu); EBT[(j0 + 1) * 40 + t] = (bf16_t)(gb >> 16); EBT[j0 * 40 + 16 + t] = (bf16_t)(gk & 0xFFFFu); EBT[(j0 + 1) * 40 + 16 + t] = (bf16_t)(gk >> 16);
        UV[j0 * 40 + 16 + t] = (bf16_t)(gv & 0xFFFFu); UV[(j0 + 1) * 40 + 16 + t] = (bf16_t)(gv >> 16); UV[j0 * 40 + t] = 0; UV[(j0 + 1) * 40 + t] = 0;
        if (tidv < 64) GT[tidv] = gg; };
    auto gtile = [&](int pb, int l15, int quad) {
        LAS bf16_t* EA = (LAS bf16_t*)(OB + pb * OPB + O_EA); LAS bf16_t* EB = (LAS bf16_t*)(OB + pb * OPB + O_EB);
        LAS bf16_t* MT1 = (LAS bf16_t*)(OB + pb * OPB + O_MT1); LAS bf16_t* NT = (LAS bf16_t*)(OB + pb * OPB + O_NT); LAS float* MABT = (LAS float*)(OB + pb * OPB + O_MABT);
        const int sb = c.wv >> 1, tb = c.wv & 1; f32x4 g = (f32x4){0.f, 0.f, 0.f, 0.f};
#pragma unroll
        for (int kk = 0; kk < 2; ++kk) g = mfma16(*(const LAS bf16x8*)(EB + (sb * 16 + l15) * 72 + kk * 32 + quad * 8), *(const LAS bf16x8*)(EA + (tb * 16 + l15) * 72 + kk * 32 + quad * 8), g);
#pragma unroll
        for (int jj = 0; jj < 4; ++jj) { const int s2 = quad * 4 + jj, tt = l15; const float v = g[jj];
            if (tb == 0) { const float m = (s2 < tt) ? v : 0.f; if (sb == 0) { MABT[tt * 20 + s2] = m; MT1[tt * 40 + s2] = 0; } else MT1[tt * 40 + 16 + s2] = f2bf(m); }
            else { const float m = (s2 <= tt) ? v : 0.f; NT[tt * 40 + sb * 16 + s2] = f2bf(m); } } };
    auto simg = [&](int l15, int quad) {
#pragma unroll
        for (int x = 0; x < 2; ++x) { const int ti = c.wv * 2 + x, mt = ti >> 2, nt = ti & 3;
#pragma unroll
            for (int jj = 0; jj < 4; ++jj) S0I[(mt * 16 + quad * 4 + jj) * 72 + nt * 16 + l15] = f2bf(S[x][jj]); } };
    const int et = (c.tid >> 4) & 15, eg = c.tid & 15; const int ech = hh * 64 + eg * 4;
    const f32x4 elg = *(const f32x4*)(p.rw_lnx_g + ech), elb = *(const f32x4*)(p.rw_lnx_b + ech);
    u32x2 e_g = (u32x2){0u, 0u}, e_z = e_g, e_v = e_g; float e_rkr = 0.f;
    auto eload = [&](int ch) { const size_t rr = (size_t)b * SEGT + ch * 16 + et;
        e_g = *(const u32x2*)(SG + rr * DMIX + ech); e_v = *(const u32x2*)(SV + rr * DMIX + ech); e_z = *(const u32x2*)(P2 + rr * P2W + 512 + ech); e_rkr = BRKR[(rr * 24 + hh) * 4 + 2]; };
    auto efinish = [&](int ch) { const f32x4 o4 = *(const LAS f32x4*)(YB + et * 68 + eg * 4);
        float s1 = (o4[0] + o4[1]) + (o4[2] + o4[3]), s2 = (o4[0] * o4[0] + o4[1] * o4[1]) + (o4[2] * o4[2] + o4[3] * o4[3]);
        s1 = dpp_add<0xB1>(s1); s2 = dpp_add<0xB1>(s2); s1 = dpp_add<0x4E>(s1); s2 = dpp_add<0x4E>(s2); s1 = dpp_add<0x141>(s1); s2 = dpp_add<0x141>(s2); s1 = dpp_add<0x140>(s1); s2 = dpp_add<0x140>(s2);
        const float mean = s1 * (1.0f / 64.0f), var = fmaxf(s2 * (1.0f / 64.0f) - mean * mean, 0.f), rs = rsqrtf(var + 64e-5f);
        const float gg[4] = {bflo(e_g.x), bfhi(e_g.x), bflo(e_g.y), bfhi(e_g.y)}, vv[4] = {bflo(e_v.x), bfhi(e_v.x), bflo(e_v.y), bfhi(e_v.y)}, zz[4] = {bflo(e_z.x), bfhi(e_z.x), bflo(e_z.y), bfhi(e_z.y)};
        float y[4];
#pragma unroll
        for (int j = 0; j < 4; ++j) y[j] = ((o4[j] - mean) * rs * elg[j] + elb[j] + e_rkr * vv[j]) * gg[j] * siluf_(zz[j]);
        *(u32x2*)(Y + ((size_t)b * SEGT + ch * 16 + et) * DIN + ech) = (u32x2){pk2(y[0], y[1]), pk2(y[2], y[3])}; };
    __syncthreads();
    { int t0 = c.tid; asm volatile("" : "+v"(t0)); gload(0, t0); lstore(0, t0); simg(l15c, quadc); }
    lds_barrier();
    if (c.wv < 4) gtile(0, l15c, quadc);
    { int t1 = c.tid; asm volatile("" : "+v"(t1)); gload(1, t1); }
    const int mtq = c.wv & 3;
#pragma unroll 1
    for (int ch = 0; ch < SEGT / 16; ++ch) {
        const int pb = ch & 1;
        int tidv = c.tid, l15 = l15c, quad = quadc; asm volatile("" : "+v"(tidv), "+v"(l15), "+v"(quad));
        LAS bf16_t* EA = (LAS bf16_t*)(OB + pb * OPB + O_EA); LAS bf16_t* EBT = (LAS bf16_t*)(OB + pb * OPB + O_EBT); LAS bf16_t* UV = (LAS bf16_t*)(OB + pb * OPB + O_UV);
        LAS bf16_t* MT1 = (LAS bf16_t*)(OB + pb * OPB + O_MT1); LAS bf16_t* NT = (LAS bf16_t*)(OB + pb * OPB + O_NT); LAS float* MABT = (LAS float*)(OB + pb * OPB + O_MABT); LAS float* GT = (LAS float*)(OB + pb * OPB + O_GT);
        lds_barrier();
        f32x4 Zt = (f32x4){0.f, 0.f, 0.f, 0.f};
        if (c.wv < 4 && ch > 0) efinish(ch - 1);
        if (c.wv >= 4) {
            f32x4 Xt = (f32x4){0.f, 0.f, 0.f, 0.f};
#pragma unroll
            for (int kk = 0; kk < 2; ++kk) { const bf16x8 a = *(const LAS bf16x8*)(S0I + (mtq * 16 + l15) * 72 + kk * 32 + quad * 8);
                Xt = mfma16(a, *(const LAS bf16x8*)(EA + l15 * 72 + kk * 32 + quad * 8), Xt); Zt = mfma16(a, *(const LAS bf16x8*)(EA + (16 + l15) * 72 + kk * 32 + quad * 8), Zt); }
            Xt = mfma16(*(const LAS bf16x8*)(UV + (mtq * 16 + l15) * 40 + quad * 8), *(const LAS bf16x8*)(MT1 + l15 * 40 + quad * 8), Xt);
#pragma unroll
            for (int jj = 0; jj < 4; ++jj) XF[(mtq * 16 + quad * 4 + jj) * 17 + l15] = Xt[jj];
        }
        lds_barrier();
        if (ch + 1 < SEGT / 16) lstore(pb ^ 1, tidv);
        if (ch + 2 < SEGT / 16) gload(ch + 2, tidv);
        if (c.wv == 0) {
            float u[16];
#pragma unroll
            for (int tt = 0; tt < 16; ++tt) { float acc = XF[c.lane * 17 + tt];
#pragma unroll
                for (int s4 = 0; s4 < (tt + 3) / 4; ++s4) { const f32x4 m = *(const LAS f32x4*)(MABT + tt * 20 + s4 * 4);
#pragma unroll
                    for (int e = 0; e < 4; ++e) if (s4 * 4 + e < tt) acc += u[s4 * 4 + e] * m[e]; }
                u[tt] = acc; }
            *(LAS u32x4*)(UV + c.lane * 40) = (u32x4){pk2(u[0], u[1]), pk2(u[2], u[3]), pk2(u[4], u[5]), pk2(u[6], u[7])};
            *(LAS u32x4*)(UV + c.lane * 40 + 8) = (u32x4){pk2(u[8], u[9]), pk2(u[10], u[11]), pk2(u[12], u[13]), pk2(u[14], u[15])};
        }
        lds_barrier();
        if (c.wv >= 4) {
            Zt = mfma16(*(const LAS bf16x8*)(UV + (mtq * 16 + l15) * 40 + quad * 8), *(const LAS bf16x8*)(NT + l15 * 40 + quad * 8), Zt);
            *(LAS f32x4*)(YB + l15 * 68 + mtq * 16 + quad * 4) = Zt;
        } else eload(ch);
#pragma unroll
        for (int x = 0; x < 2; ++x) { const int ti = c.wv * 2 + x, mt = ti >> 2, nt = ti & 3;
            S[x] = mfma16(*(const LAS bf16x8*)(UV + (mt * 16 + l15) * 40 + quad * 8), *(const LAS bf16x8*)(EBT + (nt * 16 + l15) * 40 + quad * 8), S[x]);
            const float gt = GT[nt * 16 + l15];
#pragma unroll
            for (int jj = 0; jj < 4; ++jj) S[x][jj] *= gt; }
        simg(l15, quad);
        if (c.wv < 4 && ch + 1 < SEGT / 16) gtile(pb ^ 1, l15, quad);
    }
    lds_barrier();
    if (c.wv < 4) efinish(SEGT / 16 - 1);
    if (!save) return;
#pragma unroll
    for (int x = 0; x < 2; ++x) { const int ti = c.wv * 2 + x, mt = ti >> 2, nt = ti & 3;
#pragma unroll
        for (int jj = 0; jj < 4; ++jj) RST[(mt * 16 + quadc * 4 + jj) * 64 + nt * 16 + l15c] = S[x][jj]; }
}

__device__ __forceinline__ void phase_b3(const P& p, const Ctx& c) {
    const bf16_t* O = (const bf16_t*)(c.seg + S1_O); const bf16_t* P2 = (const bf16_t*)(c.seg + S1_P2); const bf16_t* SV = (const bf16_t*)(c.seg + S1_V); const bf16_t* SG = (const bf16_t*)(c.seg + S1_G);
    const float* BRKR = (const float*)(c.seg + S1_BRKR); const bf16_t* YM = (const bf16_t*)(c.seg + S1_YMEM); bf16_t* Y = (bf16_t*)(c.seg + S1_Y);
    for (int r = c.bid * 8 + c.wv; r < MS; r += c.G * 8) {
#pragma unroll
        for (int ps = 0; ps < 3; ++ps) {
            const int hh = ps * 8 + (c.lane >> 3), ch = hh * 64 + (c.lane & 7) * 8;
            const u32x4 orr = *(const u32x4*)(O + (size_t)r * DMIX + ch);
            float v[8] = {bflo(orr.x), bfhi(orr.x), bflo(orr.y), bfhi(orr.y), bflo(orr.z), bfhi(orr.z), bflo(orr.w), bfhi(orr.w)}; float s = 0.f, s2 = 0.f;
#pragma unroll
            for (int j = 0; j < 8; ++j) { s += v[j]; s2 += v[j] * v[j]; }
            s += __shfl_xor(s, 1); s2 += __shfl_xor(s2, 1); s += __shfl_xor(s, 2); s2 += __shfl_xor(s2, 2); s += __shfl_xor(s, 4); s2 += __shfl_xor(s2, 4);
            const float mean = s * (1.0f / 64.0f), var = fmaxf(s2 * (1.0f / 64.0f) - mean * mean, 0.f), rs = rsqrtf(var + 64e-5f);
            const float rkr = BRKR[((size_t)r * 24 + hh) * 4 + 2];
            const u32x4 vr = *(const u32x4*)(SV + (size_t)r * DMIX + ch), gr = *(const u32x4*)(SG + (size_t)r * DMIX + ch), zr = *(const u32x4*)(P2 + (size_t)r * P2W + 512 + ch);
            const float vv[8] = {bflo(vr.x), bfhi(vr.x), bflo(vr.y), bfhi(vr.y), bflo(vr.z), bfhi(vr.z), bflo(vr.w), bfhi(vr.w)};
            const float gg[8] = {bflo(gr.x), bfhi(gr.x), bflo(gr.y), bfhi(gr.y), bflo(gr.z), bfhi(gr.z), bflo(gr.w), bfhi(gr.w)};
            const float zz[8] = {bflo(zr.x), bfhi(zr.x), bflo(zr.y), bfhi(zr.y), bflo(zr.z), bfhi(zr.z), bflo(zr.w), bfhi(zr.w)};
            float y[8];
#pragma unroll
            for (int j = 0; j < 8; ++j) { const float t = ((v[j] - mean) * rs * p.rw_lnx_g[ch + j] + p.rw_lnx_b[ch + j] + rkr * vv[j]) * gg[j]; y[j] = t * siluf_(zz[j]); }
            *(u32x4*)(Y + (size_t)r * DIN + ch) = (u32x4){pk2(y[0], y[1]), pk2(y[2], y[3]), pk2(y[4], y[5]), pk2(y[6], y[7])};
        }
        { const int cm = c.lane * 8; const u32x4 mr = *(const u32x4*)(YM + (size_t)r * DX + cm), zr = *(const u32x4*)(P2 + (size_t)r * P2W + 512 + DMIX + cm);
          const float mm[8] = {bflo(mr.x), bfhi(mr.x), bflo(mr.y), bfhi(mr.y), bflo(mr.z), bfhi(mr.z), bflo(mr.w), bfhi(mr.w)};
          const float zz[8] = {bflo(zr.x), bfhi(zr.x), bflo(zr.y), bfhi(zr.y), bflo(zr.z), bfhi(zr.z), bflo(zr.w), bfhi(zr.w)};
          float y[8];
#pragma unroll
          for (int j = 0; j < 8; ++j) y[j] = mm[j] * siluf_(zz[j]);
          *(u32x4*)(Y + (size_t)r * DIN + DMIX + cm) = (u32x4){pk2(y[0], y[1]), pk2(y[2], y[3]), pk2(y[4], y[5]), pk2(y[6], y[7])}; }
    }
}

__device__ __forceinline__ bool fresh_ctx(Ctx& c, P& p, unsigned char* ws0) { int t = threadIdx.x; asm volatile("" : "+v"(t)); c.tid = t; c.wv = __builtin_amdgcn_readfirstlane(t >> 6); c.lane = t & 63;
    int bb = (int)blockIdx.x, gg = (int)gridDim.x; asm volatile("" : "+s"(bb), "+s"(gg)); c.bid = bb; c.G = gg;
#if defined(__HIP_DEVICE_COMPILE__)
    { typedef const __attribute__((address_space(4))) unsigned long long* KP; KP kp = (KP)__builtin_amdgcn_kernarg_segment_ptr(); asm volatile("" : "+s"(kp));
      typedef __attribute__((address_space(1))) char* GP; char** dst = (char**)&p;
#pragma unroll
      for (int i = 0; i < (int)(sizeof(P) / 8); ++i) dst[i] = (char*)(GP)(kp[i]); }
#endif
    size_t z = 0; asm volatile("" : "+s"(z)); p.ws = ws0 + z; c.seg = ws0 + z + OFF_SEG;
    return true; }
__global__ __launch_bounds__(512) void fwd_megakernel(P p_arg) {
    P p = p_arg;
    extern __shared__ __attribute__((aligned(16))) unsigned char shm[];
    LAS unsigned char* lds = (LAS unsigned char*)shm;
    Ctx c; c.tid = threadIdx.x; c.wv = threadIdx.x >> 6; c.lane = threadIdx.x & 63; c.G = gridDim.x; c.bid = blockIdx.x; c.lds = lds; c.seg = p.ws + OFF_SEG;
    volatile LAS unsigned* st = (volatile LAS unsigned*)(lds + LDS_BYTES - 16);
    if (c.tid == 0) { st[0] = 0u; st[1] = 0u; }
    __syncthreads();
    const XcdBarrier xb = xcd_barrier_post((unsigned*)(p.ws + OFF_BAR), st);
#define GSYNC() do { XcdBarrier _xl = xb; size_t _zz = 0; asm volatile("" : "+s"(_zz)); _xl.bar = xb.bar + _zz; _xl.x = xb_xcc_id();     \
        xcd_barrier(_xl); if (RK == 20) { for (int _q = 1; _q < RN; ++_q) xcd_barrier(_xl); } } while (0)
#ifndef RK
#define RK -1
#endif
#ifndef RN
#define RN 1
#endif
#define NREP(k) ((k) == RK ? RN : 1)
#define PH(k) for (int _r = 0; _r < NREP(k); ++_r) if (fresh_ctx(c, p, p_arg.ws))
#define LASTREP(k) (_r + 1 == NREP(k))
    PH(0) phase0(p, c);
    PH(1) phase_apre(p, c, 0, c.bid, c.G);
    GSYNC();
    for (int seg = 0; seg < NSEG; ++seg) {
        if (seg == 0) {
            PH(2) { SchedA0 S; S.ws = p.ws; S.seg = c.seg; S.G = c.G; S.c = c.bid; S.nextra = 64;
              pg8::gemm_phase<pg8::EpiBf, SchedA0>(lds, c.tid, 1024, 1024, S, pg8::EpiBf{}); }
            GSYNC();
        }
        PH(3) phase_a1(p, c, seg);
        GSYNC();
        for (int it0 = c.bid; it0 < 256; it0 += c.G) {
            const int xq = it0 & 7, yq = it0 >> 3; const int it = (yq < 24) ? ((xq * 4 + yq / 6) * 6 + yq % 6) : (192 + (yq - 24) * 8 + xq);
            if (it < 192) { PH(4) mlstm_item(p, c, seg, it, LASTREP(4)); }
            else { PH(5) attn_item(p, c, 0, it - 192, (const bf16_t*)(c.seg + S0_P0) + DMIX, ML_W, (bf16_t*)(c.seg + S0_YMEM), DX, nullptr, 0);
                   if (c.G == 256 && seg > 0) { PH(14) phase_b5(p, c, seg - 1, it - 192, 64); } }
        }
        GSYNC();
        PH(6) phase_a3(p, c, seg);
        GSYNC();
        PH(7) { SchedOut S; S.Y = (const char*)(c.seg + S0_Y); S.W = (const char*)(p.ws + OFF_WO0T); S.slab = (char*)(c.seg + S0_SLAB); S.G = c.G; S.c = c.bid;
          pg8::gemm_phase<pg8::EpiBf, SchedOut>(lds, c.tid, DIN, 512, S, pg8::EpiBf{}); }
        GSYNC();
        PH(8) phase_a5(p, c, seg);
        GSYNC();
        PH(9) { SchedB0 S; S.ws = p.ws; S.seg = c.seg; S.G = c.G; S.c = c.bid;
          pg8::gemm_phase<pg8::EpiBf, SchedB0>(lds, c.tid, 1024, 1024, S, pg8::EpiBf{}); }
        GSYNC();
        PH(10) phase_b1(p, c, seg);
        GSYNC();
        if (c.G != 256) { PH(1) if (seg + 1 < NSEG) phase_apre(p, c, seg + 1, c.bid, c.G); }
        for (int it = c.bid; it < 256; it += c.G) {
            if (it < 192) { PH(11) rwkv_chunk_item(p, c, seg, it, LASTREP(11)); }
            else { PH(5) attn_item(p, c, 1, it - 192, (const bf16_t*)(c.seg + S1_P2), P2W, (bf16_t*)(c.seg + S1_Y) + DMIX, DIN, (const bf16_t*)(c.seg + S1_P2) + 512 + DMIX, P2W);
                   if (c.G == 256) { PH(1) if (seg + 1 < NSEG) phase_apre(p, c, seg + 1, it - 192, 64); } }
        }
        GSYNC();
        PH(13) { SchedOut S; S.Y = (const char*)(c.seg + S1_Y); S.W = (const char*)(p.ws + OFF_WO1T); S.slab = (char*)(c.seg + S1_SLAB); S.G = c.G; S.c = c.bid;
          pg8::gemm_phase<pg8::EpiBf, SchedOut>(lds, c.tid, DIN, 512, S, pg8::EpiBf{}); }
        if (seg + 1 < NSEG) {
            PH(2) { SchedA0 S; S.ws = p.ws; S.seg = c.seg; S.G = c.G; S.c = c.bid; S.nextra = 0;
              pg8::gemm_phase<pg8::EpiBf, SchedA0>(lds, c.tid, 1024, 1024, S, pg8::EpiBf{}); }
        }
        GSYNC();
        if (c.G != 256 || seg + 1 == NSEG) { PH(14) phase_b5(p, c, seg, c.bid, c.G); }
    }
}

extern "C" void kernel_launch(void* const* d_in, const int* in_sizes, int n_in, void* d_out, int out_size, void* d_ws, size_t ws_size, hipStream_t stream) {
    static int grid = 0;
    if (grid == 0) {
        int dev = 0, cus = 0, per_cu = 0;
        if (hipGetDevice(&dev) != hipSuccess || hipDeviceGetAttribute(&cus, hipDeviceAttributeMultiprocessorCount, dev) != hipSuccess) { grid = -1; return; }
        if (hipFuncSetAttribute((const void*)fwd_megakernel, hipFuncAttributeMaxDynamicSharedMemorySize, LDS_BYTES) != hipSuccess) { fprintf(stderr, "hipFuncSetAttribute failed\n"); grid = -1; return; }
        if (hipOccupancyMaxActiveBlocksPerMultiprocessor(&per_cu, (const void*)fwd_megakernel, 512, LDS_BYTES) != hipSuccess || per_cu < 1) { fprintf(stderr, "occupancy query: %d\n", per_cu); }
        (void)hipGetLastError();
        grid = cus;
        if (n_in != 31 || ws_size < 256 * MiB) { fprintf(stderr, "unexpected n_in %d / ws %zu\n", n_in, ws_size); grid = -1; return; }
    }
    if (grid < 0) return;
    (void)hipMemsetAsync((char*)d_ws + OFF_BAR, 0, XCD_BAR_WORDS * 4, stream);
    P p{};
    const float** f = (const float**)&p;
    for (int i = 0; i < 31; ++i) f[i] = (const float*)d_in[i];
    p.out = (float*)d_out; p.ws = (unsigned char*)d_ws;
    fwd_megakernel<<<dim3(grid), dim3(512), LDS_BYTES, stream>>>(p);
}
```
